# Optimizing an MI355X kernel written in HIP

```python
import jax, jax.numpy as jnp
from jax import lax
import numpy as np

D_MODEL = 1024
BATCH = 4
SEQ = 8192
DEPTH = 1

CHUNK = 64
N_MEM = 256
NORM_EPS = 1e-6

RW_HEAD = 64
RW_HEADS = D_MODEL // RW_HEAD
RW_WIDTH = RW_HEADS * RW_HEAD
RW_DECAY_RANK = 64
RW_ICLR_RANK = 64
RW_GATE_RANK = 160
RW_LN_EPS = 64e-5
RW_COLS = 3 * RW_WIDTH + RW_DECAY_RANK + RW_ICLR_RANK + RW_GATE_RANK
RW_SPLITS = (RW_WIDTH, 2 * RW_WIDTH, 3 * RW_WIDTH,
             3 * RW_WIDTH + RW_DECAY_RANK,
             3 * RW_WIDTH + RW_DECAY_RANK + RW_ICLR_RANK)

HG_KEY = 128
HG_HEADS = D_MODEL // HG_KEY
HG_VAL = D_MODEL // HG_HEADS
HG_WIDTH = HG_HEADS * HG_KEY
HG_VWIDTH = HG_HEADS * HG_VAL
HG_COLS = 2 * HG_WIDTH + 2 * HG_VWIDTH
HG_SPLITS = (HG_WIDTH, 2 * HG_WIDTH, 2 * HG_WIDTH + HG_VWIDTH)

GATE_COLS = 2 * D_MODEL
IN_COLS = RW_COLS + HG_COLS + GATE_COLS

XA_HEADS = 4
XA_HEAD = D_MODEL // XA_HEADS

D_FF = ((8 * D_MODEL + 3 * 256 - 1) // (3 * 256)) * 256

kernel_name = 'rwkv7_hgrn2_griffin_merge_block'


def rmsnorm(x, g, eps=NORM_EPS):
    xf = x.astype(jnp.float32)
    y = xf * lax.rsqrt(jnp.mean(xf * xf, axis=-1, keepdims=True) + eps)
    return (y * g.astype(jnp.float32)).astype(x.dtype)


def token_shift(u):
    return jnp.pad(u[:, :-1], ((0, 0), (1, 0), (0, 0)))


def rwkv7_branch(cols, mu, w0, w2, a0, a2, g2, k_k, k_a, r_k, ln_w, ln_b):
    B, S, _ = cols.shape
    f32 = jnp.float32
    cols = cols + mu * (token_shift(cols) - cols)
    r, k, v, w_lo, a_lo, g_lo = jnp.split(cols, RW_SPLITS, axis=-1)
    w_log = -jax.nn.softplus(-(w0 + jnp.tanh(w_lo) @ w2)) - 0.5
    decay = jnp.exp(-jnp.exp(w_log.astype(f32)))
    a = jax.nn.sigmoid(a0 + a_lo @ a2)
    g = jax.nn.sigmoid(g_lo) @ g2

    def heads(t):
        return t.astype(f32).reshape(B, S, RW_HEADS, RW_HEAD)

    kk = heads(k * k_k)
    kk = kk * lax.rsqrt(jnp.maximum(jnp.sum(kk * kk, axis=-1, keepdims=True), 1e-24))
    k_mod = heads(k * (1 + (a - 1) * k_a))
    r_h, v_h, a_h, w_h = heads(r), heads(v), heads(a), heads(decay)

    def step(state, inp):
        r_t, w_t, k_t, v_t, a_t, b_t = inp
        sa = jnp.einsum('bhvk,bhk->bhv', state, a_t)
        state = (state * w_t[:, :, None, :] + sa[..., None] * b_t[:, :, None, :]
                 + v_t[..., None] * k_t[:, :, None, :])
        return state, jnp.einsum('bhvk,bhk->bhv', state, r_t)

    tm = lambda t: jnp.swapaxes(t, 0, 1)
    s0 = jnp.zeros((B, RW_HEADS, RW_HEAD, RW_HEAD), f32)
    _, o = lax.scan(step, s0, (tm(r_h), tm(w_h), tm(k_mod), tm(v_h), tm(-kk), tm(kk * a_h)))
    o = jnp.swapaxes(o, 0, 1)
    mean = jnp.mean(o, axis=-1, keepdims=True)
    var = jnp.mean(jnp.square(o - mean), axis=-1, keepdims=True)
    o = ((o - mean) * lax.rsqrt(var + RW_LN_EPS)).reshape(B, S, RW_WIDTH) * ln_w + ln_b
    bonus = jnp.sum(r_h * k_mod * r_k, axis=-1, keepdims=True) * v_h
    o = o + bonus.reshape(B, S, RW_WIDTH)
    return (o * g).astype(cols.dtype)


def hgrn2_branch(cols, lb, norm_g):
    B, S, _ = cols.shape
    f32 = jnp.float32
    q, f_raw, i, g = jnp.split(cols, HG_SPLITS, axis=-1)
    f = lb + (1 - lb) * jax.nn.sigmoid(f_raw.astype(f32))
    log_f = jnp.log(f)
    k = 1 - f
    q = jax.nn.silu(q.astype(f32))
    n_chunks = S // CHUNK

    def chunked(t, d):
        return t.astype(f32).reshape(B, n_chunks, CHUNK, HG_HEADS, d).transpose(1, 0, 3, 2, 4)

    causal = jnp.tril(jnp.ones((CHUNK, CHUNK), dtype=bool))[:, :, None]

    def chunk_step(state, inp):
        q_c, k_c, i_c, lf_c = inp
        b = jnp.cumsum(lf_c, axis=2)
        rel = jnp.exp(jnp.where(causal, b[:, :, :, None, :] - b[:, :, None, :, :], -jnp.inf))
        scores = jnp.einsum('bhtk,bhtsk,bhsk->bhts', q_c, rel, k_c)
        o = (jnp.einsum('bhts,bhsv->bhtv', scores, i_c)
             + jnp.einsum('bhtk,bhkv->bhtv', q_c * jnp.exp(b), state))
        b_end = b[:, :, -1:, :]
        state = (jnp.exp(b_end[:, :, 0, :])[..., None] * state
                 + jnp.einsum('bhsk,bhsv->bhkv', k_c * jnp.exp(b_end - b), i_c))
        return state, o

    s0 = jnp.zeros((B, HG_HEADS, HG_KEY, HG_VAL), f32)
    _, o = lax.scan(chunk_step, s0, (chunked(q, HG_KEY), chunked(k, HG_KEY),
                                     chunked(i, HG_VAL), chunked(log_f, HG_KEY)))
    o = o.transpose(1, 0, 3, 2, 4).reshape(B, S, HG_HEADS, HG_VAL)
    o = o * lax.rsqrt(jnp.mean(o * o, axis=-1, keepdims=True) + NORM_EPS) * norm_g
    o = o.reshape(B, S, HG_VWIDTH) * jax.nn.silu(g.astype(f32))
    return o.astype(cols.dtype)


def setup_inputs(seed: int = 0) -> dict:
    key = jax.random.key(seed)
    ks = iter(jax.random.split(key, 32))
    L, D = DEPTH, D_MODEL

    def nrm(shape, scale):
        return scale * jax.random.normal(next(ks), shape, jnp.float32)

    def gain(shape):
        return 1.0 + nrm(shape, 0.02)

    return {
        'x': nrm((BATCH, SEQ, D), 1.0),
        'mem': nrm((BATCH, N_MEM, D), 1.0),
        'norm_mix_g': gain((L, D)),
        'w_in': nrm((L, D, IN_COLS), D ** -0.5),
        'rw_mu': jax.random.uniform(next(ks), (L, RW_COLS), jnp.float32),
        'rw_w0': -1.0 + nrm((L, RW_WIDTH), 0.5),
        'rw_w2': nrm((L, RW_DECAY_RANK, RW_WIDTH), 0.5 * RW_DECAY_RANK ** -0.5),
        'rw_a0': nrm((L, RW_WIDTH), 0.1),
        'rw_a2': nrm((L, RW_ICLR_RANK, RW_WIDTH), 0.5 * RW_ICLR_RANK ** -0.5),
        'rw_g2': nrm((L, RW_GATE_RANK, RW_WIDTH), RW_GATE_RANK ** -0.5),
        'rw_k_k': 0.85 + nrm((L, RW_WIDTH), 0.02),
        'rw_k_a': gain((L, RW_WIDTH)),
        'rw_r_k': nrm((L, RW_HEADS, RW_HEAD), 0.1),
        'rw_ln_w': gain((L, RW_WIDTH)),
        'rw_ln_b': nrm((L, RW_WIDTH), 0.02),
        'hg_lb_logits': nrm((L + 1, HG_WIDTH), 0.5),
        'hg_norm_g': gain((L, HG_VAL)),
        'w_out': nrm((L, D, D), D ** -0.5),
        'norm_xa_g': gain((L, D)),
        'norm_mem_g': gain((L, D)),
        'xa_wq': nrm((L, D, D), D ** -0.5),
        'xa_wk': nrm((L, D, D), D ** -0.5),
        'xa_wv': nrm((L, D, D), D ** -0.5),
        'xa_wo': nrm((L, D, D), D ** -0.5),
        'norm_ffn_g': gain((L, D)),
        'ffn_w1': nrm((L, D, D_FF), D ** -0.5),
        'ffn_w3': nrm((L, D, D_FF), D ** -0.5),
        'ffn_w2': nrm((L, D_FF, D), D_FF ** -0.5),
        'norm_final_g': gain((D,)),
    }


def reference(x, mem, norm_mix_g, w_in, rw_mu, rw_w0, rw_w2, rw_a0, rw_a2, rw_g2,
              rw_k_k, rw_k_a, rw_r_k, rw_ln_w, rw_ln_b, hg_lb_logits, hg_norm_g, w_out,
              norm_xa_g, norm_mem_g, xa_wq, xa_wk, xa_wv, xa_wo,
              norm_ffn_g, ffn_w1, ffn_w3, ffn_w2, norm_final_g):
    B, S, _ = x.shape
    n_mem = mem.shape[1]
    lb_all = jnp.cumsum(jax.nn.softmax(hg_lb_logits.astype(jnp.float32), axis=0), axis=0)
    h = x
    for l in range(DEPTH):
        u = rmsnorm(h, norm_mix_g[l])
        cols = u @ w_in[l]
        rw_cols, hg_cols, gate_cols = jnp.split(cols, (RW_COLS, RW_COLS + HG_COLS), axis=-1)
        y_a = rwkv7_branch(rw_cols, rw_mu[l], rw_w0[l], rw_w2[l], rw_a0[l], rw_a2[l], rw_g2[l],
                           rw_k_k[l], rw_k_a[l], rw_r_k[l], rw_ln_w[l], rw_ln_b[l])
        y_b = hgrn2_branch(hg_cols, lb_all[l], hg_norm_g[l])
        gate_a, gate_b = jnp.split(jax.nn.sigmoid(gate_cols), 2, axis=-1)
        h = h + (gate_a * y_a + gate_b * y_b) @ w_out[l]

        u = rmsnorm(h, norm_xa_g[l])
        m = rmsnorm(mem, norm_mem_g[l])
        q = (u @ xa_wq[l]).reshape(B, S, XA_HEADS, XA_HEAD)
        k = (m @ xa_wk[l]).reshape(B, n_mem, XA_HEADS, XA_HEAD)
        v = (m @ xa_wv[l]).reshape(B, n_mem, XA_HEADS, XA_HEAD)
        s = jnp.einsum('bqhd,bmhd->bhqm', q, k).astype(jnp.float32) * (XA_HEAD ** -0.5)
        p = jax.nn.softmax(s, axis=-1).astype(v.dtype)
        o = jnp.einsum('bhqm,bmhd->bqhd', p, v).reshape(B, S, D_MODEL)
        h = h + o @ xa_wo[l]

        u = rmsnorm(h, norm_ffn_g[l])
        h = h + (jax.nn.silu(u @ ffn_w1[l]) * (u @ ffn_w3[l])) @ ffn_w2[l]
    return rmsnorm(h, norm_final_g)
```

```cpp
#include <hip/hip_runtime.h>
#include <hip/hip_cooperative_groups.h>
#include <cstdint>
#include <cstdio>
namespace cg = cooperative_groups;
#define MK_G_VALU 1
namespace pg8 {
#define PG8_LAS __attribute__((address_space(3)))
typedef unsigned short bf16_t;
typedef short bf16x8 __attribute__((ext_vector_type(8)));
typedef float f32x4 __attribute__((ext_vector_type(4)));
typedef unsigned u32x4 __attribute__((ext_vector_type(4)));
constexpr int BM = 256, BK = 64, HALF = 128, HTB = HALF * BK * 2  , STAGE_BYTES = 8 * HTB, NXCD = 8, WGM = 8;

__host__ __device__ __forceinline__ int lds_byte(int r, int c) { const int st = (r >> 4) * 2 + (c >> 5), rr = r & 15, cc = c & 31, ob = rr * 64 + cc * 2; return st * 1024 + (ob ^ (((ob >> 9) & 1) << 5)); }
__host__ __device__ __forceinline__ void stage_rc(int b, int& R, int& C) { const int st = b / 1024, sb = b % 1024, swz = sb ^ (((sb >> 9) & 1) << 5); R = (st >> 1) * 16 + swz / 64; C = (st & 1) * 32 + (swz % 64) / 2; }
__host__ __device__ __forceinline__ int perm32(int rho) { const int n = rho >> 4, i = rho & 15; return 8 * (i >> 2) + 4 * n + (i & 3); }

struct Unit { int pm, pn; };
struct Gemm { const bf16_t* A; const bf16_t* Bt; int M, N, K; };

struct StaticOrder {
    int nM, nN, nwg, G, c;
    __host__ __device__ void init(int M, int N, int G_, int c_) { nM = M / BM; nN = N / BM; nwg = nM * nN; G = G_; c = c_; }
    __host__ __device__ bool next(int i, Unit& u) const {
        const long L = (long)i * G + c; if (L >= nwg) return false;
        int wgid = (int)L; { const int q = nwg / NXCD, r = nwg % NXCD, xcd = wgid % NXCD, off = wgid / NXCD; wgid = (xcd < r ? xcd * (q + 1) : r * (q + 1) + (xcd - r) * q) + off; }
        const int nig = WGM * nN, gid = wgid / nig, fm = gid * WGM, gsz = (nM - fm) < WGM ? (nM - fm) : WGM;
        u.pm = fm + ((wgid % nig) % gsz); u.pn = (wgid % nig) / gsz; return true;
    }
    __device__ __forceinline__ void a_ready(const Unit&) const {}
    __device__ __forceinline__ void done(const Unit&) const {}
};

__device__ __forceinline__ unsigned cvt_pk_bf16(float lo, float hi) { unsigned r; asm volatile("v_cvt_pk_bf16_f32 %0, %1, %2" : "=v"(r) : "v"(lo), "v"(hi)); return r; }
__device__ __forceinline__ float fast_sigmoid(float x) { return __builtin_amdgcn_rcpf(1.0f + __expf(-x)); }
__device__ __forceinline__ float fast_silu(float x) { return x * fast_sigmoid(x); }
struct EpiStoreBf16 {
    static constexpr bool PERM = true, AFTER_DRAIN = false;
    bf16_t* O; int ldc;
    __device__ __forceinline__ void operator()(const f32x4 (&acc)[2][2][4][2], const Unit& u, int wr, int wc, int fr, int fq) const {
        const int row0 = u.pm * BM + wr * 64 + fr, col0 = u.pn * BM + wc * 32 + 8 * fq;
#pragma unroll
        for (int ai = 0; ai < 2; ++ai)
#pragma unroll
            for (int m = 0; m < 4; ++m) { bf16_t* rowp = O + (size_t)(row0 + ai * HALF + m * 16) * ldc + col0;
#pragma unroll
                for (int bj = 0; bj < 2; ++bj) { const f32x4 v0 = acc[ai][bj][m][0], v1 = acc[ai][bj][m][1];
                    u32x4 w; w.x = cvt_pk_bf16(v0[0], v0[1]); w.y = cvt_pk_bf16(v0[2], v0[3]); w.z = cvt_pk_bf16(v1[0], v1[1]); w.w = cvt_pk_bf16(v1[2], v1[3]);
                    *(u32x4*)(rowp + bj * HALF) = w; } }
    }
};
struct EpiResF32 {
    static constexpr bool PERM = true, AFTER_DRAIN = false;
    const float* base; float* out; int ldc;
    __device__ __forceinline__ void operator()(const f32x4 (&acc)[2][2][4][2], const Unit& u, int wr, int wc, int fr, int fq) const {
        const int row0 = u.pm * BM + wr * 64 + fr, col0 = u.pn * BM + wc * 32 + 8 * fq;
#pragma unroll
        for (int ai = 0; ai < 2; ++ai)
#pragma unroll
            for (int m = 0; m < 4; ++m) { const size_t off = (size_t)(row0 + ai * HALF + m * 16) * ldc + col0;
#pragma unroll
                for (int bj = 0; bj < 2; ++bj)
#pragma unroll
                    for (int n = 0; n < 2; ++n) { const size_t p = off + bj * HALF + 4 * n; const f32x4 b = *(const f32x4*)(base + p); *(f32x4*)(out + p) = b + acc[ai][bj][m][n]; } }
    }
};
struct EpiSwiGLU {
    static constexpr bool PERM = true, AFTER_DRAIN = false;
    bf16_t* O; int ldc;
    __device__ __forceinline__ void operator()(const f32x4 (&acc)[2][2][4][2], const Unit& u, int wr, int wc, int fr, int fq) const {
        const int row0 = u.pm * BM + wr * 64 + fr, col0 = u.pn * HALF + wc * 32 + 8 * fq;
#pragma unroll
        for (int ai = 0; ai < 2; ++ai)
#pragma unroll
            for (int m = 0; m < 4; ++m) { bf16_t* rowp = O + (size_t)(row0 + ai * HALF + m * 16) * ldc + col0;
                f32x4 v0, v1;
#pragma unroll
                for (int j = 0; j < 4; ++j) { v0[j] = fast_silu(acc[ai][0][m][0][j]) * acc[ai][1][m][0][j]; v1[j] = fast_silu(acc[ai][0][m][1][j]) * acc[ai][1][m][1][j]; }
                u32x4 w; w.x = cvt_pk_bf16(v0[0], v0[1]); w.y = cvt_pk_bf16(v0[2], v0[3]); w.z = cvt_pk_bf16(v1[0], v1[1]); w.w = cvt_pk_bf16(v1[2], v1[3]);
                *(u32x4*)rowp = w; }
    }
};
template <class Epi, class Sched, bool ALIGN_EPI = false, bool SP2 = false>
__device__ __forceinline__ void gemm_phase(PG8_LAS unsigned char* lds, const Gemm g, const Sched& S, const Epi& E) {
    int tid = threadIdx.x; asm volatile("" : "+v"(tid));
    const int wid = __builtin_amdgcn_readfirstlane(tid >> 6), lane = tid & 63, wr = wid >> 2, wc = wid & 3, fr = lane & 15, fq = lane >> 4;
    const int K = g.K, nt = K / BK;
    unsigned voffA[2], voffB[2];
#pragma unroll
    for (int i = 0; i < 2; ++i) { int R, C; stage_rc(tid * 16 + i * 8192, R, C); const int Rb = Epi::PERM ? ((R & ~31) + perm32(R & 31)) : R;
        voffA[i] = (unsigned)(R * K + C) * 2u; voffB[i] = (unsigned)(Rb * K + C) * 2u; }
    const size_t kstep = (size_t)(BK * 2);
    const size_t hstep = (size_t)HALF * K * 2;
    const size_t tstep = 2 * hstep;
    const unsigned ldsw = (unsigned)wid * 1024u;
    const int aoff = lds_byte(wr * 64 + fr, fq * 8), boff = lds_byte(wc * 32 + fr, fq * 8);
#define PG8_SA(b, h) (((b) * 2 + (h)) * HTB)
#define PG8_SB(b, h) ((4 + (b) * 2 + (h)) * HTB)
#define PG8_STAGE(bufoff, gbase, voff) do { _Pragma("unroll") for (int _i = 0; _i < 2; ++_i) \
        __builtin_amdgcn_global_load_lds((const unsigned*)((const char*)(gbase) + (voff)[_i]), (PG8_LAS unsigned*)(lds + (bufoff) + ldsw + _i * 8192), 16, 0, 0); } while (0)
#define PG8_LDA(dst, b, h) do { _Pragma("unroll") for (int m = 0; m < 4; ++m) _Pragma("unroll") for (int k = 0; k < 2; ++k) dst[m][k] = *(const PG8_LAS bf16x8*)(lds + PG8_SA(b, h) + aoff + m * 2048 + k * 1024); } while (0)
#define PG8_LDB(dst, b, h) do { _Pragma("unroll") for (int n = 0; n < 2; ++n) _Pragma("unroll") for (int k = 0; k < 2; ++k) dst[n][k] = *(const PG8_LAS bf16x8*)(lds + PG8_SB(b, h) + boff + n * 2048 + k * 1024); } while (0)
#define PG8_MMA(ai, bj, At, Bt) do { __builtin_amdgcn_s_setprio(1); _Pragma("unroll") for (int m = 0; m < 4; ++m) _Pragma("unroll") for (int n = 0; n < 2; ++n) _Pragma("unroll") for (int k = 0; k < 2; ++k) \
        acc[ai][bj][m][n] = __builtin_amdgcn_mfma_f32_16x16x32_bf16(Bt[n][k], At[m][k], acc[ai][bj][m][n], 0, 0, 0); __builtin_amdgcn_s_setprio(0); } while (0)
#define PG8_WAIT_V(n) asm volatile("s_waitcnt vmcnt(" #n ")" ::: "memory")
#define PG8_WAIT_L(n) asm volatile("s_waitcnt lgkmcnt(" #n ")" ::: "memory")
#define PG8_BAR __builtin_amdgcn_s_barrier()
#define PG8_SCHED __builtin_amdgcn_sched_barrier(0)
    Unit cur, nxt; int ui = 0;
    if (!S.next(0, cur)) return;
    f32x4 acc[2][2][4][2];
#pragma unroll
    for (int a = 0; a < 2; ++a)
#pragma unroll
        for (int b = 0; b < 2; ++b)
#pragma unroll
            for (int m = 0; m < 4; ++m)
#pragma unroll
                for (int n = 0; n < 2; ++n) acc[a][b][m][n] = (f32x4){0.f, 0.f, 0.f, 0.f};
    bf16x8 At[4][2], B0[2][2], B1[2][2];
    const char* cA = (const char*)g.A + (size_t)cur.pm * tstep; const char* cB = (const char*)g.Bt + (size_t)cur.pn * tstep;
    S.a_ready(cur);
    if constexpr (SP2) {
        PG8_STAGE(PG8_SB(0, 0), cB, voffB); PG8_STAGE(PG8_SB(0, 1), cB + hstep, voffB); PG8_STAGE(PG8_SA(0, 0), cA, voffA); PG8_STAGE(PG8_SA(0, 1), cA + hstep, voffA);
        if (wr == 1) PG8_BAR;
        PG8_WAIT_V(2); PG8_BAR;
        PG8_STAGE(PG8_SB(1, 0), cB + kstep, voffB); PG8_STAGE(PG8_SA(1, 0), cA + kstep, voffA); PG8_STAGE(PG8_SB(1, 1), cB + hstep + kstep, voffB);
        PG8_WAIT_V(6); PG8_BAR;
    } else {
        PG8_STAGE(PG8_SB(0, 0), cB, voffB); PG8_STAGE(PG8_SA(0, 0), cA, voffA); PG8_STAGE(PG8_SB(0, 1), cB + hstep, voffB); PG8_STAGE(PG8_SA(0, 1), cA + hstep, voffA);
        if (wr == 1) PG8_BAR;
        PG8_WAIT_V(4); PG8_BAR;
        PG8_STAGE(PG8_SB(1, 0), cB + kstep, voffB); PG8_STAGE(PG8_SA(1, 0), cA + kstep, voffA); PG8_STAGE(PG8_SB(1, 1), cB + hstep + kstep, voffB);
        PG8_WAIT_V(6); PG8_BAR;
    }
    for (;;) {
        const bool has_next = S.next(ui + 1, nxt);
        const char* nA = has_next ? (const char*)g.A + (size_t)nxt.pm * tstep : cA; const char* nB = has_next ? (const char*)g.Bt + (size_t)nxt.pn * tstep : cB;
        for (int t = 0; t < nt; t += 2) {
            const bool last = (t == nt - 2);
            const char* a1 = cA + (size_t)(t + 1) * kstep;
            const char* a2 = last ? nA : cA + (size_t)(t + 2) * kstep; const char* b2 = last ? nB : cB + (size_t)(t + 2) * kstep;
            const char* a3 = a2 + kstep; const char* b3 = b2 + kstep;
            if (last && has_next) S.a_ready(nxt);
            if constexpr (SP2) {
            PG8_LDB(B0, 0, 0); PG8_LDB(B1, 0, 1); PG8_SCHED; PG8_LDA(At, 0, 0); PG8_STAGE(PG8_SA(1, 1), a1 + hstep, voffA);
            PG8_WAIT_V(8); PG8_WAIT_L(0); PG8_BAR; PG8_MMA(0, 0, At, B0); PG8_MMA(0, 1, At, B1); PG8_BAR; PG8_SCHED;
            PG8_LDA(At, 0, 1); PG8_STAGE(PG8_SB(0, 0), b2, voffB); PG8_STAGE(PG8_SB(0, 1), b2 + hstep, voffB); PG8_STAGE(PG8_SA(0, 0), a2, voffA);
            PG8_WAIT_V(8); PG8_WAIT_L(0); PG8_BAR; PG8_MMA(1, 0, At, B0); PG8_MMA(1, 1, At, B1); PG8_BAR; PG8_SCHED;
            PG8_LDB(B0, 1, 0); PG8_LDB(B1, 1, 1); PG8_SCHED; PG8_LDA(At, 1, 0); PG8_STAGE(PG8_SA(0, 1), a2 + hstep, voffA);
            PG8_WAIT_V(8); PG8_WAIT_L(0); PG8_BAR; PG8_MMA(0, 0, At, B0); PG8_MMA(0, 1, At, B1); PG8_BAR; PG8_SCHED;
            PG8_LDA(At, 1, 1); PG8_STAGE(PG8_SB(1, 0), b3, voffB); PG8_STAGE(PG8_SB(1, 1), b3 + hstep, voffB); PG8_STAGE(PG8_SA(1, 0), a3, voffA);
            PG8_WAIT_V(8); PG8_WAIT_L(0); PG8_BAR; PG8_MMA(1, 0, At, B0); PG8_MMA(1, 1, At, B1); PG8_BAR; PG8_SCHED;
            } else {
            PG8_LDB(B0, 0, 0); PG8_SCHED; PG8_LDA(At, 0, 0); PG8_STAGE(PG8_SA(1, 1), a1 + hstep, voffA);
            PG8_WAIT_L(8); PG8_BAR; PG8_WAIT_L(0); PG8_MMA(0, 0, At, B0); PG8_BAR; PG8_SCHED;
            PG8_LDB(B1, 0, 1); PG8_STAGE(PG8_SB(0, 0), b2, voffB);
            PG8_BAR; PG8_WAIT_L(0); PG8_MMA(0, 1, At, B1); PG8_BAR;
            PG8_LDA(At, 0, 1); PG8_STAGE(PG8_SA(0, 0), a2, voffA);
            PG8_BAR; PG8_WAIT_L(0); PG8_MMA(1, 0, At, B0); PG8_BAR; PG8_SCHED;
            PG8_STAGE(PG8_SB(0, 1), b2 + hstep, voffB);
            PG8_WAIT_V(6); PG8_BAR; PG8_MMA(1, 1, At, B1); PG8_BAR;
            PG8_LDB(B0, 1, 0); PG8_SCHED; PG8_LDA(At, 1, 0); PG8_STAGE(PG8_SA(0, 1), a2 + hstep, voffA);
            PG8_WAIT_L(8); PG8_BAR; PG8_WAIT_L(0); PG8_MMA(0, 0, At, B0); PG8_BAR; PG8_SCHED;
            PG8_LDB(B1, 1, 1); PG8_STAGE(PG8_SB(1, 0), b3, voffB);
            PG8_BAR; PG8_WAIT_L(0); PG8_MMA(0, 1, At, B1); PG8_BAR;
            PG8_LDA(At, 1, 1); PG8_STAGE(PG8_SA(1, 0), a3, voffA);
            PG8_BAR; PG8_WAIT_L(0); PG8_MMA(1, 0, At, B0); PG8_BAR; PG8_SCHED;
            PG8_STAGE(PG8_SB(1, 1), b3 + hstep, voffB);
            PG8_WAIT_V(6); PG8_BAR; PG8_MMA(1, 1, At, B1); PG8_BAR;
            }
        }
        if constexpr (ALIGN_EPI) { if (wr == 0) PG8_BAR; }
        if constexpr (!Epi::AFTER_DRAIN) { E(acc, cur, wr, wc, fr, fq); S.done(cur); }
        if (!has_next) break;
#pragma unroll
        for (int a = 0; a < 2; ++a)
#pragma unroll
            for (int b = 0; b < 2; ++b)
#pragma unroll
                for (int m = 0; m < 4; ++m)
#pragma unroll
                    for (int n = 0; n < 2; ++n) acc[a][b][m][n] = (f32x4){0.f, 0.f, 0.f, 0.f};
        cur = nxt; cA = nA; cB = nB; ++ui;
        if constexpr (ALIGN_EPI) { if (wr == 1) PG8_BAR; }
    }
    PG8_WAIT_V(0);
    if constexpr (!ALIGN_EPI) { if (wr == 0) PG8_BAR; }
    PG8_BAR;
    if constexpr (Epi::AFTER_DRAIN) { E.fused(acc, cur, wr, wc, fr, fq, lds, wid, lane); S.done(cur); }
#undef PG8_SA
#undef PG8_SB
#undef PG8_STAGE
#undef PG8_LDA
#undef PG8_LDB
#undef PG8_MMA
#undef PG8_WAIT_V
#undef PG8_WAIT_L
#undef PG8_BAR
#undef PG8_SCHED
}
}

#define LAS __attribute__((address_space(3)))
typedef pg8::bf16_t bf16_t;
typedef pg8::bf16x8 bf16x8;
typedef pg8::f32x4 f32x4;
typedef pg8::u32x4 u32x4;
typedef unsigned u32x2 __attribute__((ext_vector_type(2)));
typedef float f32x2v __attribute__((ext_vector_type(2)));
using pg8::cvt_pk_bf16;
using pg8::fast_sigmoid;
using pg8::fast_silu;

constexpr int D = 1024, NB = 4, SEQ = 8192, NTOK = NB * SEQ;
#ifndef MK_NSPLIT
#define MK_NSPLIT 4
#endif
constexpr int NSPLIT = MK_NSPLIT, TS = SEQ / NSPLIT, MS = NB * TS;
constexpr int CL = 9728;
constexpr int C_R = 0, C_K = 1024, C_V = 2048, C_WLO = 3072, C_ALO = 3136, C_GLO = 3200, C_HQ = 3584, C_HF = 4608, C_HI = 5632, C_HG = 6656, C_GA = 7680, C_GB = 8704;
constexpr int CARRY_LD = 3584;
constexpr int DFF = 2816;
constexpr size_t MiB = 1u << 20, KiB = 1u << 10;
constexpr size_t WS_WIN = 0, WS_WOUT = 19 * MiB, WS_WQ = 21 * MiB, WS_WO = 23 * MiB, WS_WKV = 25 * MiB, WS_W13 = 29 * MiB, WS_W2 = 40 * MiB;
constexpr size_t WS_RW2T = 46 * MiB, WS_RA2T = 46 * MiB + 128 * KiB, WS_RG2T = 46 * MiB + 256 * KiB, WS_CARRY = 46 * MiB + 640 * KiB, WS_LB = 46 * MiB + 704 * KiB;
constexpr size_t WS_MBF = 47 * MiB, WS_KV = 49 * MiB, WS_VT = 53 * MiB, WS_RWST = 55 * MiB, WS_HGST = 56 * MiB, WS_BONUS = 58 * MiB;
constexpr size_t WS_MERGED = 64 * MiB;
constexpr size_t WS_U1 = 128 * MiB, WS_COLS = 144 * MiB, WS_PR = 296 * MiB, WS_PK = 312 * MiB, WS_PA = 328 * MiB, WS_PB = 344 * MiB, WS_PV = 360 * MiB, WS_PW = 376 * MiB, WS_ORAW = 408 * MiB, WS_HGO = 440 * MiB;
constexpr size_t WS_U = 128 * MiB, WS_Q = 192 * MiB, WS_AO = 256 * MiB, WS_FF = 320 * MiB, WS_END = 496 * MiB;
constexpr int LDS_BYTES = 147456;
constexpr int T0 = 1 + 5 * NSPLIT, N_PHASES = T0 + 9;

__device__ __forceinline__ float bflo(unsigned u) { return __uint_as_float(u << 16); }
__device__ __forceinline__ float bfhi(unsigned u) { return __uint_as_float(u & 0xffff0000u); }
__device__ __forceinline__ unsigned f2bf(float f) { unsigned u = __float_as_uint(f); return (u + 0x7fffu + ((u >> 16) & 1u)) >> 16; }
__device__ __forceinline__ f32x4 ld4bf(const bf16_t* p) { const u32x2 u = *(const u32x2*)p; return (f32x4){bflo(u.x), bfhi(u.x), bflo(u.y), bfhi(u.y)}; }
__device__ __forceinline__ void ld8bf(const bf16_t* p, float (&o)[8]) { const u32x4 u = *(const u32x4*)p; o[0] = bflo(u.x); o[1] = bfhi(u.x); o[2] = bflo(u.y); o[3] = bfhi(u.y); o[4] = bflo(u.z); o[5] = bfhi(u.z); o[6] = bflo(u.w); o[7] = bfhi(u.w); }
__device__ __forceinline__ void st4bf(bf16_t* p, f32x4 v) { u32x2 w; w.x = cvt_pk_bf16(v[0], v[1]); w.y = cvt_pk_bf16(v[2], v[3]); *(u32x2*)p = w; }
__device__ __forceinline__ bf16x8 pack8(const float (&t)[8]) { u32x4 w; w.x = cvt_pk_bf16(t[0], t[1]); w.y = cvt_pk_bf16(t[2], t[3]); w.z = cvt_pk_bf16(t[4], t[5]); w.w = cvt_pk_bf16(t[6], t[7]); return __builtin_bit_cast(bf16x8, w); }
__device__ __forceinline__ float tanh_fast(float x) { return 1.0f - 2.0f * __builtin_amdgcn_rcpf(1.0f + __expf(2.0f * x)); }
__device__ __forceinline__ float wave_sum(float v) {
#pragma unroll
    for (int o = 1; o < 64; o <<= 1) v += __shfl_xor(v, o);
    return v;
}
__device__ __forceinline__ float fq_sum(float v) { v += __shfl_xor(v, 16); v += __shfl_xor(v, 32); return v; }
template <int CTRL> __device__ __forceinline__ float dpp_add(float x) { return x + __builtin_bit_cast(float, __builtin_amdgcn_update_dpp(0, __builtin_bit_cast(int, x), CTRL, 0xf, 0xf, false)); }
#ifdef MK_SHFL_REDUCE
__device__ __forceinline__ float allreduce16(float x) { x += __shfl_xor(x, 1); x += __shfl_xor(x, 2); x += __shfl_xor(x, 4); x += __shfl_xor(x, 8); return x; }
#else
__device__ __forceinline__ float allreduce16(float x) { x = dpp_add<0xB1>(x); x = dpp_add<0x4E>(x); x = dpp_add<0x141>(x); x = dpp_add<0x140>(x); return x; }
#endif
#define MFMA16(a, b, c) __builtin_amdgcn_mfma_f32_16x16x32_bf16((a), (b), (c), 0, 0, 0)

__device__ __forceinline__ void rms_row_bf16(const float* src, const float* g, bf16_t* dst, int lane) {
    f32x4 v[4]; float s = 0.f;
#pragma unroll
    for (int j = 0; j < 4; ++j) { v[j] = ((const f32x4*)src)[lane + 64 * j]; s += (v[j][0] * v[j][0] + v[j][1] * v[j][1]) + (v[j][2] * v[j][2] + v[j][3] * v[j][3]); }
    const float rs = 1.0f / sqrtf(wave_sum(s) * (1.0f / 1024.0f) + 1e-6f);
#pragma unroll
    for (int j = 0; j < 4; ++j) { const f32x4 gv = ((const f32x4*)g)[lane + 64 * j]; st4bf(dst + 4 * (lane + 64 * j), v[j] * rs * gv); }
}
__device__ __forceinline__ void tr_item(const float* W, int K, int N, bf16_t* WT, int kb, int n0, int row_base, LAS float* scr, int lane) {
    const int k0 = 64 * kb;
#pragma unroll 8
    for (int i = 0; i < 32; ++i) { const int kk = 2 * i + (lane >> 5); scr[kk * 33 + (lane & 31)] = W[(size_t)(k0 + kk) * N + n0 + (lane & 31)]; }
    asm volatile("s_waitcnt lgkmcnt(0)" ::: "memory");
    const int c = lane & 7;
#pragma unroll
    for (int j = 0; j < 4; ++j) { const int n = (lane >> 3) + 8 * j; const LAS float* sp = scr + (8 * c) * 33 + n;
        u32x4 o; o.x = cvt_pk_bf16(sp[0 * 33], sp[1 * 33]); o.y = cvt_pk_bf16(sp[2 * 33], sp[3 * 33]); o.z = cvt_pk_bf16(sp[4 * 33], sp[5 * 33]); o.w = cvt_pk_bf16(sp[6 * 33], sp[7 * 33]);
        *(u32x4*)(WT + (size_t)(row_base + n) * K + k0 + 8 * c) = o; }
    asm volatile("s_waitcnt lgkmcnt(0)" ::: "memory");
}

__device__ __forceinline__ void prep_phase(int s, int gw, int NGW, int lane, const bf16_t* cols, const bf16_t* carry,
        const float* mu, const float* w0, const float* a0, const float* k_k, const float* k_a, const float* r_k,
        const bf16_t* w2T, const bf16_t* a2T, bf16_t* PR, bf16_t* PK, bf16_t* PA, bf16_t* PB, bf16_t* PV, float* PW, float* bonus) {
    const int fr = lane & 15, fq = lane >> 4;
    for (int item = gw; item < (MS / 16) * 4; item += NGW) {
        const int tile = item >> 2, hg4 = item & 3;
        const int lt = tile * 16 + fr, b = lt / TS, tl = lt % TS;
        const bf16_t* crow = cols + (size_t)lt * CL;
        const bf16_t* prow = tl > 0 ? crow - CL : carry + ((s & 1) * 4 + b) * CARRY_LD;
        bf16x8 Aw[2], Aa[2];
#pragma unroll
        for (int ks = 0; ks < 2; ++ks) {
            { const int c = C_WLO + ks * 32 + fq * 8; float cur[8], prv[8], t[8]; ld8bf(crow + c, cur); ld8bf(prow + c, prv);
              const f32x4 m0 = *(const f32x4*)(mu + c), m1 = *(const f32x4*)(mu + c + 4);
#pragma unroll
              for (int e = 0; e < 8; ++e) { const float mm = e < 4 ? m0[e & 3] : m1[e & 3]; t[e] = tanh_fast(cur[e] + mm * (prv[e] - cur[e])); }
              Aw[ks] = pack8(t); }
            { const int c = C_ALO + ks * 32 + fq * 8; float cur[8], prv[8], t[8]; ld8bf(crow + c, cur); ld8bf(prow + c, prv);
              const f32x4 m0 = *(const f32x4*)(mu + c), m1 = *(const f32x4*)(mu + c + 4);
#pragma unroll
              for (int e = 0; e < 8; ++e) { const float mm = e < 4 ? m0[e & 3] : m1[e & 3]; t[e] = cur[e] + mm * (prv[e] - cur[e]); }
              Aa[ks] = pack8(t); }
        }
#pragma unroll 1
        for (int hh = 0; hh < 4; ++hh) {
            const int h = hg4 * 4 + hh;
            f32x4 aw[4], aa[4];
#pragma unroll
            for (int nt = 0; nt < 4; ++nt) { aw[nt] = (f32x4){0.f, 0.f, 0.f, 0.f}; aa[nt] = (f32x4){0.f, 0.f, 0.f, 0.f};
                const int n = h * 64 + nt * 16 + fr;
#pragma unroll
                for (int ks = 0; ks < 2; ++ks) { const bf16x8 bw = *(const bf16x8*)(w2T + n * 64 + ks * 32 + fq * 8); aw[nt] = MFMA16(bw, Aw[ks], aw[nt]);
                    const bf16x8 ba = *(const bf16x8*)(a2T + n * 64 + ks * 32 + fq * 8); aa[nt] = MFMA16(ba, Aa[ks], aa[nt]); } }
            f32x4 kkv[4], av[4]; float ssq = 0.f, bon = 0.f;
#pragma unroll
            for (int nt = 0; nt < 4; ++nt) {
                const int c = h * 64 + nt * 16 + 4 * fq; const size_t o = (size_t)lt * 1024 + c;
                const f32x4 rc = ld4bf(crow + C_R + c), rp = ld4bf(prow + C_R + c), kc = ld4bf(crow + C_K + c), kp = ld4bf(prow + C_K + c), vc = ld4bf(crow + C_V + c), vp = ld4bf(prow + C_V + c);
                const f32x4 r = rc + *(const f32x4*)(mu + C_R + c) * (rp - rc), k = kc + *(const f32x4*)(mu + C_K + c) * (kp - kc), v = vc + *(const f32x4*)(mu + C_V + c) * (vp - vc);
                const f32x4 w0v = *(const f32x4*)(w0 + c), a0v = *(const f32x4*)(a0 + c), kkp = *(const f32x4*)(k_k + c), kap = *(const f32x4*)(k_a + c), rkp = *(const f32x4*)(r_k + c);
                f32x4 wv, a, kk, kmod;
#pragma unroll
                for (int j = 0; j < 4; ++j) {
                    const float z = -(w0v[j] + aw[nt][j]);
                    const float sp = fmaxf(z, 0.f) + __logf(1.0f + __expf(-fabsf(z)));
                    wv[j] = __expf(-__expf(-sp - 0.5f));
                    a[j] = fast_sigmoid(a0v[j] + aa[nt][j]);
                    kk[j] = k[j] * kkp[j]; kmod[j] = k[j] * (1.0f + (a[j] - 1.0f) * kap[j]);
                    ssq += kk[j] * kk[j]; bon += r[j] * kmod[j] * rkp[j];
                }
                kkv[nt] = kk; av[nt] = a;
                st4bf(PR + o, r); st4bf(PK + o, kmod); st4bf(PV + o, v); *(f32x4*)(PW + o) = wv;
            }
            ssq = fq_sum(ssq); bon = fq_sum(bon);
            const float rs = 1.0f / sqrtf(fmaxf(ssq, 1e-24f));
#pragma unroll
            for (int nt = 0; nt < 4; ++nt) { const int c = h * 64 + nt * 16 + 4 * fq; const size_t o = (size_t)lt * 1024 + c;
                const f32x4 kn = kkv[nt] * rs; st4bf(PA + o, -kn); st4bf(PB + o, kn * av[nt]); }
            if (fq == 0) bonus[lt * 16 + h] = bon;
        }
    }
}

__device__ __forceinline__ void post_phase(int s, int gw, int NGW, int lane, const bf16_t* cols, const bf16_t* carry, const float* mu, const bf16_t* g2T,
        const float* ln_w, const float* ln_b, const float* hg_g, const float* oraw, const float* hgo, const bf16_t* PV, const float* bonus, bf16_t* merged, LAS unsigned char* lds, const float* g2f, int wave) {
    const int fr = lane & 15, fq = lane >> 4;
    for (int item = gw; item < (MS / 16) * 4; item += NGW) {
        const int tile = item >> 2, q4 = item & 3;
        const int lt = tile * 16 + fr, b = lt / TS, tl = lt % TS;
        const size_t gt = (size_t)b * SEQ + s * TS + tl;
        const bf16_t* crow = cols + (size_t)lt * CL;
        const bf16_t* prow = tl > 0 ? crow - CL : carry + ((s & 1) * 4 + b) * CARRY_LD;
        bf16x8 Ag[5];
#pragma unroll
        for (int ks = 0; ks < 5; ++ks) { const int c = C_GLO + ks * 32 + fq * 8; float cur[8], prv[8], t[8]; ld8bf(crow + c, cur); ld8bf(prow + c, prv);
            const f32x4 m0 = *(const f32x4*)(mu + c), m1 = *(const f32x4*)(mu + c + 4);
#pragma unroll
            for (int e = 0; e < 8; ++e) { const float mm = e < 4 ? m0[e & 3] : m1[e & 3]; t[e] = fast_sigmoid(cur[e] + mm * (prv[e] - cur[e])); }
            Ag[ks] = pack8(t);
#ifdef MK_G_VALU
            { LAS float* sg = (LAS float*)(lds + wave * 10240) + fr * 160 + ks * 32 + fq * 8;
#pragma unroll
              for (int e = 0; e < 8; ++e) sg[e] = t[e]; }
#endif
        }
#ifdef MK_G_VALU
        asm volatile("s_waitcnt lgkmcnt(0)" ::: "memory");
#endif
#pragma unroll 1
        for (int hgh = 0; hgh < 2; ++hgh) {
            const int h8 = q4 * 2 + hgh;
            f32x4 ho[8]; float ss = 0.f;
#pragma unroll
            for (int n8 = 0; n8 < 8; ++n8) { ho[n8] = *(const f32x4*)(hgo + ((size_t)((b * 8 + h8) * 8 + n8) * TS + tl) * 16 + 4 * fq); ss += (ho[n8][0] * ho[n8][0] + ho[n8][1] * ho[n8][1]) + (ho[n8][2] * ho[n8][2] + ho[n8][3] * ho[n8][3]); }
            ss = fq_sum(ss);
            const float rsh = 1.0f / sqrtf(ss * (1.0f / 128.0f) + 1e-6f);
#pragma unroll
            for (int rwh = 0; rwh < 2; ++rwh) {
                const int h = q4 * 4 + hgh * 2 + rwh;
                f32x4 ag[4], o[4]; float sm = 0.f;
#pragma unroll
                for (int nt = 0; nt < 4; ++nt) { ag[nt] = (f32x4){0.f, 0.f, 0.f, 0.f}; const int n = h * 64 + nt * 16 + fr;
#pragma unroll
                    for (int ks = 0; ks < 5; ++ks) { const bf16x8 bg = *(const bf16x8*)(g2T + n * 160 + ks * 32 + fq * 8); ag[nt] = MFMA16(bg, Ag[ks], ag[nt]); }
#ifdef MK_G_VALU
                    { f32x4 gacc = (f32x4){0.f, 0.f, 0.f, 0.f}; const LAS float* sg = (const LAS float*)(lds + wave * 10240) + fr * 160; const float* gp = g2f + h * 64 + nt * 16 + 4 * fq;
                      for (int k = 0; k < 160; ++k) gacc = gacc + *(const f32x4*)(gp + (size_t)k * 1024) * sg[k];
                      ag[nt] = gacc; }
#endif
                    o[nt] = *(const f32x4*)(oraw + ((size_t)((b * 16 + h) * 4 + nt) * TS + tl) * 16 + 4 * fq); sm += (o[nt][0] + o[nt][1]) + (o[nt][2] + o[nt][3]); }
                const float mean = fq_sum(sm) * (1.0f / 64.0f); float vq = 0.f;
#pragma unroll
                for (int nt = 0; nt < 4; ++nt) { o[nt] = o[nt] - mean; vq += (o[nt][0] * o[nt][0] + o[nt][1] * o[nt][1]) + (o[nt][2] * o[nt][2] + o[nt][3] * o[nt][3]); }
                const float rstd = 1.0f / sqrtf(fq_sum(vq) * (1.0f / 64.0f) + 64e-5f);
#ifdef MK_NO_BONUS
                const float bon = 0.f;
#else
                const float bon = bonus[lt * 16 + h];
#endif
#pragma unroll
                for (int nt = 0; nt < 4; ++nt) {
                    const int c = h * 64 + nt * 16 + 4 * fq;
                    const f32x4 lw = *(const f32x4*)(ln_w + c), lb = *(const f32x4*)(ln_b + c), v = ld4bf(PV + (size_t)lt * 1024 + c);
                    const f32x4 ya = (o[nt] * rstd * lw + lb + v * bon) * ag[nt];
                    const f32x4 ng = *(const f32x4*)(hg_g + (c & 127)), gh = ld4bf(crow + C_HG + c), gar = ld4bf(crow + C_GA + c), gbr = ld4bf(crow + C_GB + c);
                    const f32x4 hv = ho[rwh * 4 + nt] * rsh * ng;
                    f32x4 m;
#pragma unroll
                    for (int j = 0; j < 4; ++j) {
#if defined(MK_ZERO_YA)
                        m[j] = fast_sigmoid(gbr[j]) * (hv[j] * fast_silu(gh[j]));
#elif defined(MK_ZERO_YB)
                        m[j] = fast_sigmoid(gar[j]) * ya[j];
#else
                        m[j] = fast_sigmoid(gar[j]) * ya[j] + fast_sigmoid(gbr[j]) * (hv[j] * fast_silu(gh[j]));
#endif
                    }
                    st4bf(merged + gt * 1024 + c, m);
                }
            }
        }
    }
}

constexpr int RWB = 43008;
__device__ __forceinline__ void rw_load(LAS unsigned char* bp, int lt2, size_t ltok0, int h, int rg, const bf16_t* PA, const float* PW, const bf16_t* PB, const bf16_t* PK, const bf16_t* PR, const bf16_t* PV) {
    const int tok = lt2 >> 3, c8 = (lt2 & 7) * 8; const size_t base = (ltok0 + tok) * 1024 + h * 64 + c8;
    const u32x4 ra = *(const u32x4*)(PA + base), rb = *(const u32x4*)(PB + base), rk = *(const u32x4*)(PK + base), rr = *(const u32x4*)(PR + base);
    const f32x4 w0 = *(const f32x4*)(PW + base), w1 = *(const f32x4*)(PW + base + 4);
    const unsigned rv = *(const unsigned*)(PV + (ltok0 + tok) * 1024 + h * 64 + rg * 16 + (lt2 & 7) * 2);
    const int off = (tok * 64 + c8) * 4;
#define RW_PUT(arr, u) do { *(LAS f32x4*)(bp + (arr) * 8192 + off) = (f32x4){bflo(u.x), bfhi(u.x), bflo(u.y), bfhi(u.y)}; *(LAS f32x4*)(bp + (arr) * 8192 + off + 16) = (f32x4){bflo(u.z), bfhi(u.z), bflo(u.w), bfhi(u.w)}; } while (0)
    RW_PUT(0, ra); RW_PUT(2, rb); RW_PUT(3, rk); RW_PUT(4, rr);
#undef RW_PUT
    *(LAS f32x4*)(bp + 8192 + off) = w0; *(LAS f32x4*)(bp + 8192 + off + 16) = w1;
    *(LAS f32x2v*)(bp + 40960 + (tok * 16 + (lt2 & 7) * 2) * 4) = (f32x2v){bflo(rv), bfhi(rv)};
}
__device__ __forceinline__ void rwkv_scan(int s, int bid, int G, int tid, int lane, int wave, LAS unsigned char* lds,
        const bf16_t* PA, const float* PW, const bf16_t* PB, const bf16_t* PK, const bf16_t* PR, const bf16_t* PV, float* oraw, float* state) {
    constexpr int NBLK = TS / 32;
    const int rowl = lane >> 4, j = lane & 15, row = (wave & 3) * 4 + rowl;
    for (int it = bid; it < 256; it += G) {
        const int b = it >> 6, h = (it >> 2) & 15, rg = it & 3;
        const size_t tok0 = (size_t)b * TS;
        float* stp = state + ((size_t)((b * 16 + h) * 64 + rg * 16 + row) * 64 + 4 * j);
        f32x4 st = (f32x4){0.f, 0.f, 0.f, 0.f};
        if (wave < 4 && s > 0) st = *(const f32x4*)stp;
        if (wave >= 4) rw_load(lds, tid - 256, tok0, h, rg, PA, PW, PB, PK, PR, PV);
        __syncthreads();
#pragma unroll 1
        for (int blk = 0; blk < NBLK; ++blk) {
            if (wave >= 4) { if (blk + 1 < NBLK) rw_load(lds + ((blk + 1) & 1) * RWB, tid - 256, tok0 + (blk + 1) * 32, h, rg, PA, PW, PB, PK, PR, PV); }
            else {
                const LAS unsigned char* bp = lds + (blk & 1) * RWB;
                float* orow = oraw + ((size_t)it * TS + blk * 32) * 16 + row;
#pragma unroll 4
                for (int t = 0; t < 32; ++t) {
                    const int o4 = (t * 64 + 4 * j) * 4;
                    const f32x4 a4 = *(const LAS f32x4*)(bp + o4), w4 = *(const LAS f32x4*)(bp + 8192 + o4), b4 = *(const LAS f32x4*)(bp + 16384 + o4), k4 = *(const LAS f32x4*)(bp + 24576 + o4), r4 = *(const LAS f32x4*)(bp + 32768 + o4);
                    const float vv = *(const LAS float*)(bp + 40960 + (t * 16 + row) * 4);
                    float sa = (st[0] * a4[0] + st[1] * a4[1]) + (st[2] * a4[2] + st[3] * a4[3]);
                    sa = allreduce16(sa);
                    st = st * w4 + (b4 * sa + k4 * vv);
                    float y = (st[0] * r4[0] + st[1] * r4[1]) + (st[2] * r4[2] + st[3] * r4[3]);
                    y = allreduce16(y);
                    if (j == 0) orow[t * 16] = y;
                }
            }
            __syncthreads();
        }
        if (wave < 4) *(f32x4*)stp = st;
    }
}


__device__ __forceinline__ void rwkv_scan_naive(int s, int gw, int NGW, int lane, int wave, LAS unsigned char* lds,
        const bf16_t* PA, const float* PW, const bf16_t* PB, const bf16_t* PK, const bf16_t* PR, const bf16_t* PV, float* oraw, float* state) {
    LAS float* slab = (LAS float*)(lds + wave * 2048);
    for (int it = gw; it < 64; it += NGW) {
        const int b = it >> 4, h = it & 15;
        float st[64];
        float* stp = state + (size_t)((b * 16 + h) * 64 + lane) * 64;
#pragma unroll
        for (int k = 0; k < 64; ++k) st[k] = (s > 0) ? stp[k] : 0.f;
        for (int tl = 0; tl < TS; ++tl) {
            const size_t base = ((size_t)b * TS + tl) * 1024 + h * 64 + lane;
            slab[lane] = bflo((unsigned)PA[base]); slab[64 + lane] = PW[base]; slab[128 + lane] = bflo((unsigned)PB[base]); slab[192 + lane] = bflo((unsigned)PK[base]); slab[256 + lane] = bflo((unsigned)PR[base]);
            const float vv = bflo((unsigned)PV[base]);
            asm volatile("s_waitcnt lgkmcnt(0)" ::: "memory");
            float sa = 0.f;
#pragma unroll
            for (int k = 0; k < 64; ++k) sa += st[k] * slab[k];
            float y = 0.f;
#pragma unroll
            for (int k = 0; k < 64; ++k) { st[k] = st[k] * slab[64 + k] + (sa * slab[128 + k] + vv * slab[192 + k]); y += st[k] * slab[256 + k]; }
            asm volatile("s_waitcnt lgkmcnt(0)" ::: "memory");
            oraw[((size_t)(it * 4 + (lane >> 4)) * TS + tl) * 16 + (lane & 15)] = y;
        }
#pragma unroll
        for (int k = 0; k < 64; ++k) stp[k] = st[k];
    }
}
constexpr int HGB = 51200;
__device__ __forceinline__ void hg_load(LAS unsigned char* bp, int lt2, size_t ltok0, int h8, int rg, const bf16_t* cols, const float* lbv) {
    const int tok = lt2 >> 3, c16 = (lt2 & 7) * 16; const bf16_t* crow = cols + (ltok0 + tok) * CL;
    float q[16], f[16];
    { float t[8]; ld8bf(crow + C_HQ + h8 * 128 + c16, t);
#pragma unroll
      for (int e = 0; e < 8; ++e) q[e] = t[e];
      ld8bf(crow + C_HQ + h8 * 128 + c16 + 8, t);
#pragma unroll
      for (int e = 0; e < 8; ++e) q[8 + e] = t[e];
      ld8bf(crow + C_HF + h8 * 128 + c16, t);
#pragma unroll
      for (int e = 0; e < 8; ++e) f[e] = t[e];
      ld8bf(crow + C_HF + h8 * 128 + c16 + 8, t);
#pragma unroll
      for (int e = 0; e < 8; ++e) f[8 + e] = t[e]; }
    const unsigned rv = *(const unsigned*)(crow + C_HI + h8 * 128 + rg * 16 + (lt2 & 7) * 2);
    const int off = (tok * 128 + c16) * 4;
#pragma unroll
    for (int g = 0; g < 4; ++g) { const f32x4 lb = *(const f32x4*)(lbv + h8 * 128 + c16 + 4 * g); f32x4 fv, kv, qv;
#pragma unroll
        for (int e = 0; e < 4; ++e) { fv[e] = lb[e] + (1.0f - lb[e]) * fast_sigmoid(f[4 * g + e]); kv[e] = 1.0f - fv[e]; qv[e] = fast_silu(q[4 * g + e]); }
        *(LAS f32x4*)(bp + off + 16 * g) = fv; *(LAS f32x4*)(bp + 16384 + off + 16 * g) = kv; *(LAS f32x4*)(bp + 32768 + off + 16 * g) = qv; }
    *(LAS f32x2v*)(bp + 49152 + (tok * 16 + (lt2 & 7) * 2) * 4) = (f32x2v){bflo(rv), bfhi(rv)};
}
__device__ __forceinline__ void hgrn_scan(int s, int bid, int G, int tid, int lane, int wave, LAS unsigned char* lds, const bf16_t* cols, const float* lbv, float* hgo, float* state) {
    constexpr int NBLK = TS / 32;
    const int rowl = lane >> 4, j = lane & 15, row = (wave & 3) * 4 + rowl;
    for (int it = bid; it < 256; it += G) {
        const int b = it >> 6, h8 = (it >> 3) & 7, rg = it & 7;
        const size_t tok0 = (size_t)b * TS;
        float* stp = state + ((size_t)((b * 8 + h8) * 128 + rg * 16 + row) * 128 + 4 * j);
        f32x4 s0 = (f32x4){0.f, 0.f, 0.f, 0.f}, s1 = s0;
        if (wave < 4 && s > 0) { s0 = *(const f32x4*)stp; s1 = *(const f32x4*)(stp + 64); }
        if (wave >= 4) hg_load(lds, tid - 256, tok0, h8, rg, cols, lbv);
        __syncthreads();
#pragma unroll 1
        for (int blk = 0; blk < NBLK; ++blk) {
            if (wave >= 4) { if (blk + 1 < NBLK) hg_load(lds + ((blk + 1) & 1) * HGB, tid - 256, tok0 + (blk + 1) * 32, h8, rg, cols, lbv); }
            else {
                const LAS unsigned char* bp = lds + (blk & 1) * HGB;
                float* orow = hgo + ((size_t)it * TS + blk * 32) * 16 + row;
#pragma unroll 4
                for (int t = 0; t < 32; ++t) {
                    const int o4 = (t * 128 + 4 * j) * 4;
                    const f32x4 f0 = *(const LAS f32x4*)(bp + o4), f1 = *(const LAS f32x4*)(bp + o4 + 256), k0 = *(const LAS f32x4*)(bp + 16384 + o4), k1 = *(const LAS f32x4*)(bp + 16384 + o4 + 256);
                    const f32x4 q0 = *(const LAS f32x4*)(bp + 32768 + o4), q1 = *(const LAS f32x4*)(bp + 32768 + o4 + 256);
                    const float iv = *(const LAS float*)(bp + 49152 + (t * 16 + row) * 4);
                    s0 = s0 * f0 + k0 * iv; s1 = s1 * f1 + k1 * iv;
                    float y = ((s0[0] * q0[0] + s0[1] * q0[1]) + (s0[2] * q0[2] + s0[3] * q0[3])) + ((s1[0] * q1[0] + s1[1] * q1[1]) + (s1[2] * q1[2] + s1[3] * q1[3]));
                    y = allreduce16(y);
                    if (j == 0) orow[t * 16] = y;
                }
            }
            __syncthreads();
        }
        if (wave < 4) { *(f32x4*)stp = s0; *(f32x4*)(stp + 64) = s1; }
    }
}

__device__ __forceinline__ void attn_phase(int gw, int NGW, int lane, const bf16_t* Q, const bf16_t* KV, const bf16_t* Vt, bf16_t* AO) {
    const int fr = lane & 15, fq = lane >> 4;
    for (int item = gw; item < 8192; item += NGW) {
        const int bh = item >> 9, tile = item & 511, b = bh >> 2, hd = bh & 3;
        const size_t gt = (size_t)b * SEQ + tile * 16 + fr;
        bf16x8 qf[8];
#pragma unroll
        for (int ks = 0; ks < 8; ++ks) qf[ks] = *(const bf16x8*)(Q + gt * 1024 + hd * 256 + ks * 32 + fq * 8);
        f32x4 sc[16]; float mx = -3.0e38f;
#pragma unroll
        for (int kt = 0; kt < 16; ++kt) { f32x4 acc = (f32x4){0.f, 0.f, 0.f, 0.f}; const bf16_t* kp = KV + (size_t)(b * 256 + kt * 16 + fr) * 2048 + hd * 256 + fq * 8;
#pragma unroll
            for (int ks = 0; ks < 8; ++ks) acc = MFMA16(*(const bf16x8*)(kp + ks * 32), qf[ks], acc);
            sc[kt] = acc * 0.0625f; mx = fmaxf(mx, fmaxf(fmaxf(sc[kt][0], sc[kt][1]), fmaxf(sc[kt][2], sc[kt][3]))); }
        mx = fmaxf(mx, __shfl_xor(mx, 16)); mx = fmaxf(mx, __shfl_xor(mx, 32));
        float sum = 0.f;
#pragma unroll
        for (int kt = 0; kt < 16; ++kt) {
#pragma unroll
            for (int jj = 0; jj < 4; ++jj) { sc[kt][jj] = __expf(sc[kt][jj] - mx); sum += sc[kt][jj]; } }
        sum = fq_sum(sum);
        const float inv = 1.0f / sum;
        bf16x8 pf[8];
#pragma unroll
        for (int k2 = 0; k2 < 8; ++k2) { u32x4 w; w.x = cvt_pk_bf16(sc[2 * k2][0], sc[2 * k2][1]); w.y = cvt_pk_bf16(sc[2 * k2][2], sc[2 * k2][3]); w.z = cvt_pk_bf16(sc[2 * k2 + 1][0], sc[2 * k2 + 1][1]); w.w = cvt_pk_bf16(sc[2 * k2 + 1][2], sc[2 * k2 + 1][3]); pf[k2] = __builtin_bit_cast(bf16x8, w); }
#pragma unroll 2
        for (int dt = 0; dt < 16; ++dt) { f32x4 acc = (f32x4){0.f, 0.f, 0.f, 0.f}; const bf16_t* vp = Vt + (size_t)((b * 4 + hd) * 256 + dt * 16 + fr) * 256 + fq * 8;
#pragma unroll
            for (int k2 = 0; k2 < 8; ++k2) acc = MFMA16(*(const bf16x8*)(vp + k2 * 32), pf[k2], acc);
            st4bf(AO + gt * 1024 + hd * 256 + dt * 16 + 4 * fq, acc * inv); }
    }
}

__device__ __forceinline__ int tid_fresh() { int t = threadIdx.x; asm volatile("" : "+v"(t)); return t; }
#define WinT ((bf16_t*)(a.ws + WS_WIN))
#define WoutT ((bf16_t*)(a.ws + WS_WOUT))
#define WqT ((bf16_t*)(a.ws + WS_WQ))
#define WoT ((bf16_t*)(a.ws + WS_WO))
#define WkvT ((bf16_t*)(a.ws + WS_WKV))
#define W13T ((bf16_t*)(a.ws + WS_W13))
#define W2T ((bf16_t*)(a.ws + WS_W2))
#define rw2T ((bf16_t*)(a.ws + WS_RW2T))
#define ra2T ((bf16_t*)(a.ws + WS_RA2T))
#define rg2T ((bf16_t*)(a.ws + WS_RG2T))
#define carry ((bf16_t*)(a.ws + WS_CARRY))
#define lbv ((float*)(a.ws + WS_LB))
#define mbf ((bf16_t*)(a.ws + WS_MBF))
#define KV ((bf16_t*)(a.ws + WS_KV))
#define Vt ((bf16_t*)(a.ws + WS_VT))
#define rwst ((float*)(a.ws + WS_RWST))
#define hgst ((float*)(a.ws + WS_HGST))
#define bonus ((float*)(a.ws + WS_BONUS))
#define merged ((bf16_t*)(a.ws + WS_MERGED))
#define u1 ((bf16_t*)(a.ws + WS_U1))
#define cols ((bf16_t*)(a.ws + WS_COLS))
#define PR ((bf16_t*)(a.ws + WS_PR))
#define PK ((bf16_t*)(a.ws + WS_PK))
#define PA ((bf16_t*)(a.ws + WS_PA))
#define PB ((bf16_t*)(a.ws + WS_PB))
#define PV ((bf16_t*)(a.ws + WS_PV))
#define PW ((float*)(a.ws + WS_PW))
#define oraw ((float*)(a.ws + WS_ORAW))
#define hgo ((float*)(a.ws + WS_HGO))
#define U ((bf16_t*)(a.ws + WS_U))
#define Qb ((bf16_t*)(a.ws + WS_Q))
#define AO ((bf16_t*)(a.ws + WS_AO))
#define FF ((bf16_t*)(a.ws + WS_FF))
#define XIN (a.in[0])
#define OUTP (a.out)
struct Args { const float* in[29]; float* out; unsigned char* ws; int ph_lo, ph_hi; };

typedef const __attribute__((address_space(4))) Args* CArgsP;
__device__ __forceinline__ CArgsP args_fresh() { CArgsP p = (CArgsP)__builtin_amdgcn_kernarg_segment_ptr(); asm volatile("" : "+s"(p)); return p; }
__global__ void __launch_bounds__(512, 2) mega(Args a0) {
    extern __shared__ __attribute__((aligned(16))) unsigned char lds_raw[];
    LAS unsigned char* lds = (LAS unsigned char*)lds_raw;
    cg::grid_group grid = cg::this_grid();
    const int G = gridDim.x, bid = blockIdx.x, NGW = G * 8, NGT = G * 512;
#define IDS const auto& a = *args_fresh(); const int tid = tid_fresh(), lane = tid & 63, wave = __builtin_amdgcn_readfirstlane(tid >> 6), gw = bid * 8 + wave, gtid = bid * 512 + tid; (void)lane; (void)gw; (void)gtid
    const int lo = a0.ph_lo, hi = a0.ph_hi;
#define IN(k) (lo <= (k) && (k) < hi)
#define SEAM(k) do { if (IN(k) && IN((k) + 1)) { asm volatile("s_waitcnt vmcnt(0) lgkmcnt(0)" ::: "memory"); grid.sync(); __builtin_amdgcn_fence(__ATOMIC_ACQUIRE, "agent"); asm volatile("s_waitcnt vmcnt(0)" ::: "memory"); } } while (0)

    if (IN(0)) { IDS;
        LAS float* scr = (LAS float*)(lds + wave * 16384);
        constexpr int I_IN = 16 * 297, I_SQ = 16 * 32, I_13 = 16 * 88, I_2 = 44 * 32;
        constexpr int NITEMS = I_IN + 5 * I_SQ + 2 * I_13 + I_2;
        for (int it = gw; it < NITEMS; it += NGW) {
            int r = it;
            if (r < I_IN) { const int kb = r / 297, n0 = (r % 297) * 32; tr_item(a.in[3], 1024, 9504, WinT, kb, n0, n0 + (n0 >= 3360 ? 224 : 0), scr, lane); continue; } r -= I_IN;
            if (r < I_SQ) { tr_item(a.in[17], 1024, 1024, WoutT, r / 32, (r % 32) * 32, (r % 32) * 32, scr, lane); continue; } r -= I_SQ;
            if (r < I_SQ) { tr_item(a.in[20], 1024, 1024, WqT, r / 32, (r % 32) * 32, (r % 32) * 32, scr, lane); continue; } r -= I_SQ;
            if (r < I_SQ) { tr_item(a.in[23], 1024, 1024, WoT, r / 32, (r % 32) * 32, (r % 32) * 32, scr, lane); continue; } r -= I_SQ;
            if (r < I_SQ) { tr_item(a.in[21], 1024, 1024, WkvT, r / 32, (r % 32) * 32, (r % 32) * 32, scr, lane); continue; } r -= I_SQ;
            if (r < I_SQ) { tr_item(a.in[22], 1024, 1024, WkvT, r / 32, (r % 32) * 32, 1024 + (r % 32) * 32, scr, lane); continue; } r -= I_SQ;
            if (r < I_13) { const int n0 = (r % 88) * 32; tr_item(a.in[25], 1024, DFF, W13T, r / 88, n0, (n0 / 128) * 256 + (n0 % 128), scr, lane); continue; } r -= I_13;
            if (r < I_13) { const int n0 = (r % 88) * 32; tr_item(a.in[26], 1024, DFF, W13T, r / 88, n0, (n0 / 128) * 256 + 128 + (n0 % 128), scr, lane); continue; } r -= I_13;
            tr_item(a.in[27], DFF, 1024, W2T, r / 32, (r % 32) * 32, (r % 32) * 32, scr, lane);
        }
        for (int i = gtid; i < 28672; i += NGT) ((u32x4*)(WinT + 3360 * 1024))[i] = (u32x4){0u, 0u, 0u, 0u};
        for (int i = gtid; i < 1792; i += NGT) ((u32x4*)carry)[i] = (u32x4){0u, 0u, 0u, 0u};
        for (int n = gw; n < 1024; n += NGW) { rw2T[n * 64 + lane] = (bf16_t)f2bf(a.in[6][lane * 1024 + n]); ra2T[n * 64 + lane] = (bf16_t)f2bf(a.in[8][lane * 1024 + n]); }
        for (int m = gw; m < 512; m += NGW) {
            for (int e = lane; e < 320; e += 64) { const int n = 2 * m + (e >= 160 ? 1 : 0), k = e >= 160 ? e - 160 : e; rg2T[n * 160 + k] = (bf16_t)f2bf(a.in[9][k * 1024 + n]); } }
        for (int i = gtid; i < 1024; i += NGT) lbv[i] = 1.0f / (1.0f + __expf(a.in[15][1024 + i] - a.in[15][i]));
        for (int m = gw; m < 1024; m += NGW) rms_row_bf16(a.in[1] + (size_t)m * 1024, a.in[19], mbf + (size_t)m * 1024, lane);
        __syncthreads();
    }
    SEAM(0);

#pragma unroll 1
    for (int s = 0; s < NSPLIT; ++s) {
        const int pb = 1 + 5 * s;
        if (IN(pb)) { IDS;
            for (int lt = gw; lt < MS; lt += NGW) { const int b = lt / TS, tl = lt % TS; const size_t gt = (size_t)b * SEQ + s * TS + tl; rms_row_bf16(XIN + gt * 1024, a.in[2], u1 + (size_t)lt * 1024, lane); }
        }
        SEAM(pb);
        if (IN(pb + 1)) { const auto& a = *args_fresh();
            pg8::Gemm g{u1, WinT, MS, CL, 1024}; pg8::StaticOrder S; S.init(MS, CL, G, bid);
            pg8::EpiStoreBf16 E{cols, CL};
            pg8::gemm_phase<pg8::EpiStoreBf16, pg8::StaticOrder, true, true>(lds, g, S, E);
        }
        SEAM(pb + 1);
#ifndef SKIP_PREP
        if (IN(pb + 2)) { IDS; prep_phase(s, gw, NGW, lane, cols, carry, a.in[4], a.in[5], a.in[7], a.in[10], a.in[11], a.in[12], rw2T, ra2T, PR, PK, PA, PB, PV, PW, bonus); }
#endif
        SEAM(pb + 2);
        if (IN(pb + 3)) { IDS;
#ifdef MK_ZERO_SCAN
            for (int i = gtid; i < MS * 256; i += NGT) { ((f32x4*)oraw)[i] = (f32x4){0.f, 0.f, 0.f, 0.f}; ((f32x4*)hgo)[i] = (f32x4){0.01f, 0.02f, 0.03f, 0.04f}; }
#endif
#ifdef MK_NAIVE_RW
            rwkv_scan_naive(s, gw, NGW, lane, wave, lds, PA, PW, PB, PK, PR, PV, oraw, rwst);
#endif
#ifndef SKIP_RW
            rwkv_scan(s, bid, G, tid, lane, wave, lds, PA, PW, PB, PK, PR, PV, oraw, rwst);
#endif
            __syncthreads();
#ifndef SKIP_HG
            hgrn_scan(s, bid, G, tid, lane, wave, lds, cols, lbv, hgo, hgst);
#endif
        }
        SEAM(pb + 3);
        if (IN(pb + 4)) { IDS;
#ifdef MK_NOMIX
            for (int i = gtid; i < MS * 128; i += NGT) { const int lt = i >> 7, b = lt / TS, tl = lt % TS; const size_t gt = (size_t)b * SEQ + s * TS + tl; ((u32x4*)(merged + gt * 1024))[i & 127] = (u32x4){0u, 0u, 0u, 0u}; }
#endif
#ifndef SKIP_POST
            post_phase(s, gw, NGW, lane, cols, carry, a.in[4], rg2T, a.in[13], a.in[14], a.in[16], oraw, hgo, PV, bonus, merged, lds, a.in[9], wave);
#endif
            if (bid < 4 && s + 1 < NSPLIT) { const u32x4* src = (const u32x4*)(cols + (size_t)(bid * TS + TS - 1) * CL); u32x4* dst = (u32x4*)(carry + (((s + 1) & 1) * 4 + bid) * CARRY_LD);
                for (int i = tid; i < CARRY_LD / 8; i += 512) dst[i] = src[i]; }
        }
        SEAM(pb + 4);
    }

    if (IN(T0 + 0)) { const auto& a = *args_fresh();
        { pg8::Gemm g{merged, WoutT, NTOK, 1024, 1024}; pg8::StaticOrder S; S.init(NTOK, 1024, G, bid); pg8::EpiResF32 E{XIN, OUTP, 1024};
          pg8::gemm_phase<pg8::EpiResF32, pg8::StaticOrder, true, true>(lds, g, S, E); }
        { pg8::Gemm g{mbf, WkvT, 1024, 2048, 1024}; pg8::StaticOrder S; S.init(1024, 2048, G, bid); pg8::EpiStoreBf16 E{KV, 2048};
          pg8::gemm_phase<pg8::EpiStoreBf16, pg8::StaticOrder, true, true>(lds, g, S, E); }
    }
    SEAM(T0 + 0);
    if (IN(T0 + 1)) { IDS;
        for (int gt = gw; gt < NTOK; gt += NGW) rms_row_bf16(OUTP + (size_t)gt * 1024, a.in[18], U + (size_t)gt * 1024, lane);
        for (int i = gtid; i < 4 * 4 * 256 * 256; i += NGT) { const int kp = i & 255, dim = (i >> 8) & 255, hd = (i >> 16) & 3, b = i >> 18;
            const int k2 = kp >> 5, fq = (kp >> 3) & 3, sl = kp & 7; const int key = 32 * k2 + (sl < 4 ? 4 * fq + sl : 16 + 4 * fq + sl - 4);
            Vt[i] = KV[(size_t)(b * 256 + key) * 2048 + 1024 + hd * 256 + dim]; }
    }
    SEAM(T0 + 1);
    if (IN(T0 + 2)) { const auto& a = *args_fresh(); pg8::Gemm g{U, WqT, NTOK, 1024, 1024}; pg8::StaticOrder S; S.init(NTOK, 1024, G, bid); pg8::EpiStoreBf16 E{Qb, 1024};
        pg8::gemm_phase<pg8::EpiStoreBf16, pg8::StaticOrder, true, true>(lds, g, S, E); }
    SEAM(T0 + 2);
#ifndef SKIP_ATTN
    if (IN(T0 + 3)) { IDS; attn_phase(gw, NGW, lane, Qb, KV, Vt, AO); }
#endif
    SEAM(T0 + 3);
#ifndef MK_NOATT
    if (IN(T0 + 4)) { const auto& a = *args_fresh(); pg8::Gemm g{AO, WoT, NTOK, 1024, 1024}; pg8::StaticOrder S; S.init(NTOK, 1024, G, bid); pg8::EpiResF32 E{OUTP, OUTP, 1024};
        pg8::gemm_phase<pg8::EpiResF32, pg8::StaticOrder, true, true>(lds, g, S, E); }
#endif
    SEAM(T0 + 4);
    if (IN(T0 + 5)) { IDS; for (int gt = gw; gt < NTOK; gt += NGW) rms_row_bf16(OUTP + (size_t)gt * 1024, a.in[24], U + (size_t)gt * 1024, lane); }
    SEAM(T0 + 5);
    if (IN(T0 + 6)) { const auto& a = *args_fresh(); pg8::Gemm g{U, W13T, NTOK, 2 * DFF, 1024}; pg8::StaticOrder S; S.init(NTOK, 2 * DFF, G, bid); pg8::EpiSwiGLU E{FF, DFF};
        pg8::gemm_phase<pg8::EpiSwiGLU, pg8::StaticOrder, true, true>(lds, g, S, E); }
    SEAM(T0 + 6);
    if (IN(T0 + 7)) { const auto& a = *args_fresh(); pg8::Gemm g{FF, W2T, NTOK, 1024, DFF}; pg8::StaticOrder S; S.init(NTOK, 1024, G, bid); pg8::EpiResF32 E{OUTP, OUTP, 1024};
        pg8::gemm_phase<pg8::EpiResF32, pg8::StaticOrder, true, true>(lds, g, S, E); }
    SEAM(T0 + 7);
    if (IN(T0 + 8)) { IDS;
        const float* gf = a.in[28];
        for (int gt = gw; gt < NTOK; gt += NGW) { f32x4* row = (f32x4*)(OUTP + (size_t)gt * 1024); f32x4 v[4]; float sq = 0.f;
#pragma unroll
            for (int j = 0; j < 4; ++j) { v[j] = row[lane + 64 * j]; sq += (v[j][0] * v[j][0] + v[j][1] * v[j][1]) + (v[j][2] * v[j][2] + v[j][3] * v[j][3]); }
            const float rs = 1.0f / sqrtf(wave_sum(sq) * (1.0f / 1024.0f) + 1e-6f);
#pragma unroll
            for (int j = 0; j < 4; ++j) row[lane + 64 * j] = v[j] * rs * ((const f32x4*)gf)[lane + 64 * j]; }
    }
#undef IN
#undef SEAM
}

#ifndef MK_MULTI
#define MK_MULTI 0
#endif
extern "C" void kernel_launch(void* const* d_in, const int* in_sizes, int n_in, void* d_out, int out_size, void* d_ws, size_t ws_size, hipStream_t stream) {
    static int grid = 0;
    if (grid == 0) {
        if (n_in != 29 || in_sizes[0] != NTOK * D || out_size != NTOK * D || ws_size < WS_END) { fprintf(stderr, "kernel_launch: unexpected shapes / workspace (%d inputs, ws %zu)\n", n_in, ws_size); grid = -1; return; }
        int dev = 0, cus = 0, per_cu = 0;
        hipGetDevice(&dev); hipDeviceGetAttribute(&cus, hipDeviceAttributeMultiprocessorCount, dev);
        hipFuncSetAttribute((const void*)mega, hipFuncAttributeMaxDynamicSharedMemorySize, LDS_BYTES);
        hipOccupancyMaxActiveBlocksPerMultiprocessor(&per_cu, (const void*)mega, 512, LDS_BYTES);
        (void)hipGetLastError();
        if (per_cu < 1) per_cu = 1;
        grid = cus;
    }
    if (grid < 0) return;
    Args a{};
    for (int i = 0; i < 29; ++i) a.in[i] = (const float*)d_in[i];
    a.out = (float*)d_out; a.ws = (unsigned char*)d_ws;
    void* args[] = {&a};
#if MK_MULTI
    for (int ph = 0; ph < N_PHASES; ++ph) { a.ph_lo = ph; a.ph_hi = ph + 1; hipLaunchCooperativeKernel((const void*)mega, dim3(grid), dim3(512), args, LDS_BYTES, stream); }
#else
    a.ph_lo = 0; a.ph_hi = N_PHASES;
    hipError_t e = hipLaunchCooperativeKernel((const void*)mega, dim3(grid), dim3(512), args, LDS_BYTES, stream);
    if (e != hipSuccess) fprintf(stderr, "cooperative launch failed: %s (grid %d)\n", hipGetErrorString(e), grid);
#endif
}
```

```cpp
#include <hip/hip_runtime.h>
#include <hip/hip_cooperative_groups.h>
#include <cstdint>
#include <cstdio>
namespace cg = cooperative_groups;
namespace pg8 {
#define PG8_LAS __attribute__((address_space(3)))
typedef unsigned short bf16_t;
typedef short bf16x8 __attribute__((ext_vector_type(8)));
typedef float f32x4 __attribute__((ext_vector_type(4)));
typedef unsigned u32x4 __attribute__((ext_vector_type(4)));
constexpr int BM = 256, BK = 64, HALF = 128, HTB = HALF * BK * 2  , STAGE_BYTES = 8 * HTB, NXCD = 8, WGM = 8;

__host__ __device__ __forceinline__ int lds_byte(int r, int c) { const int st = (r >> 4) * 2 + (c >> 5), rr = r & 15, cc = c & 31, ob = rr * 64 + cc * 2; return st * 1024 + (ob ^ (((ob >> 9) & 1) << 5)); }
__host__ __device__ __forceinline__ void stage_rc(int b, int& R, int& C) { const int st = b / 1024, sb = b % 1024, swz = sb ^ (((sb >> 9) & 1) << 5); R = (st >> 1) * 16 + swz / 64; C = (st & 1) * 32 + (swz % 64) / 2; }
__host__ __device__ __forceinline__ int perm32(int rho) { const int n = rho >> 4, i = rho & 15; return 8 * (i >> 2) + 4 * n + (i & 3); }

struct Unit { int pm, pn; };
struct Gemm { const bf16_t* A; const bf16_t* Bt; int M, N, K; };

struct StaticOrder {
    int nM, nN, nwg, G, c;
    __host__ __device__ void init(int M, int N, int G_, int c_) { nM = M / BM; nN = N / BM; nwg = nM * nN; G = G_; c = c_; }
    __host__ __device__ bool next(int i, Unit& u) const {
        const long L = (long)i * G + c; if (L >= nwg) return false;
        int wgid = (int)L; { const int q = nwg / NXCD, r = nwg % NXCD, xcd = wgid % NXCD, off = wgid / NXCD; wgid = (xcd < r ? xcd * (q + 1) : r * (q + 1) + (xcd - r) * q) + off; }
        const int nig = WGM * nN, gid = wgid / nig, fm = gid * WGM, gsz = (nM - fm) < WGM ? (nM - fm) : WGM;
        u.pm = fm + ((wgid % nig) % gsz); u.pn = (wgid % nig) / gsz; return true;
    }
    __device__ __forceinline__ void a_ready(const Unit&) const {}
    __device__ __forceinline__ void done(const Unit&) const {}
};

__device__ __forceinline__ unsigned cvt_pk_bf16(float lo, float hi) { unsigned r; asm volatile("v_cvt_pk_bf16_f32 %0, %1, %2" : "=v"(r) : "v"(lo), "v"(hi)); return r; }
__device__ __forceinline__ float fast_sigmoid(float x) { return __builtin_amdgcn_rcpf(1.0f + __expf(-x)); }
__device__ __forceinline__ float fast_silu(float x) { return x * fast_sigmoid(x); }
struct EpiStoreBf16 {
    static constexpr bool PERM = true, AFTER_DRAIN = false;
    bf16_t* O; int ldc;
    __device__ __forceinline__ void operator()(const f32x4 (&acc)[2][2][4][2], const Unit& u, int wr, int wc, int fr, int fq) const {
        const int row0 = u.pm * BM + wr * 64 + fr, col0 = u.pn * BM + wc * 32 + 8 * fq;
#pragma unroll
        for (int ai = 0; ai < 2; ++ai)
#pragma unroll
            for (int m = 0; m < 4; ++m) { bf16_t* rowp = O + (size_t)(row0 + ai * HALF + m * 16) * ldc + col0;
#pragma unroll
                for (int bj = 0; bj < 2; ++bj) { const f32x4 v0 = acc[ai][bj][m][0], v1 = acc[ai][bj][m][1];
                    u32x4 w; w.x = cvt_pk_bf16(v0[0], v0[1]); w.y = cvt_pk_bf16(v0[2], v0[3]); w.z = cvt_pk_bf16(v1[0], v1[1]); w.w = cvt_pk_bf16(v1[2], v1[3]);
                    *(u32x4*)(rowp + bj * HALF) = w; } }
    }
};
struct EpiResF32 {
    static constexpr bool PERM = true, AFTER_DRAIN = false;
    const float* base; float* out; int ldc;
    __device__ __forceinline__ void operator()(const f32x4 (&acc)[2][2][4][2], const Unit& u, int wr, int wc, int fr, int fq) const {
        const int row0 = u.pm * BM + wr * 64 + fr, col0 = u.pn * BM + wc * 32 + 8 * fq;
#pragma unroll
        for (int ai = 0; ai < 2; ++ai)
#pragma unroll
            for (int m = 0; m < 4; ++m) { const size_t off = (size_t)(row0 + ai * HALF + m * 16) * ldc + col0;
#pragma unroll
                for (int bj = 0; bj < 2; ++bj)
#pragma unroll
                    for (int n = 0; n < 2; ++n) { const size_t p = off + bj * HALF + 4 * n; const f32x4 b = *(const f32x4*)(base + p); *(f32x4*)(out + p) = b + acc[ai][bj][m][n]; } }
    }
};
struct EpiSwiGLU {
    static constexpr bool PERM = true, AFTER_DRAIN = false;
    bf16_t* O; int ldc;
    __device__ __forceinline__ void operator()(const f32x4 (&acc)[2][2][4][2], const Unit& u, int wr, int wc, int fr, int fq) const {
        const int row0 = u.pm * BM + wr * 64 + fr, col0 = u.pn * HALF + wc * 32 + 8 * fq;
#pragma unroll
        for (int ai = 0; ai < 2; ++ai)
#pragma unroll
            for (int m = 0; m < 4; ++m) { bf16_t* rowp = O + (size_t)(row0 + ai * HALF + m * 16) * ldc + col0;
                f32x4 v0, v1;
#pragma unroll
                for (int j = 0; j < 4; ++j) { v0[j] = fast_silu(acc[ai][0][m][0][j]) * acc[ai][1][m][0][j]; v1[j] = fast_silu(acc[ai][0][m][1][j]) * acc[ai][1][m][1][j]; }
                u32x4 w; w.x = cvt_pk_bf16(v0[0], v0[1]); w.y = cvt_pk_bf16(v0[2], v0[3]); w.z = cvt_pk_bf16(v1[0], v1[1]); w.w = cvt_pk_bf16(v1[2], v1[3]);
                *(u32x4*)rowp = w; }
    }
};
template <class Epi, class Sched, bool ALIGN_EPI = false, bool SP2 = false>
__device__ __forceinline__ void gemm_phase(PG8_LAS unsigned char* lds, const Gemm g, const Sched& S, const Epi& E) {
    int tid = threadIdx.x; asm volatile("" : "+v"(tid));
    const int wid = __builtin_amdgcn_readfirstlane(tid >> 6), lane = tid & 63, wr = wid >> 2, wc = wid & 3, fr = lane & 15, fq = lane >> 4;
    const int K = g.K, nt = K / BK;
    unsigned voffA[2], voffB[2];
#pragma unroll
    for (int i = 0; i < 2; ++i) { int R, C; stage_rc(tid * 16 + i * 8192, R, C); const int Rb = Epi::PERM ? ((R & ~31) + perm32(R & 31)) : R;
        voffA[i] = (unsigned)(R * K + C) * 2u; voffB[i] = (unsigned)(Rb * K + C) * 2u; }
    const size_t kstep = (size_t)(BK * 2);
    const size_t hstep = (size_t)HALF * K * 2;
    const size_t tstep = 2 * hstep;
    const unsigned ldsw = (unsigned)wid * 1024u;
    const int aoff = lds_byte(wr * 64 + fr, fq * 8), boff = lds_byte(wc * 32 + fr, fq * 8);
#define PG8_SA(b, h) (((b) * 2 + (h)) * HTB)
#define PG8_SB(b, h) ((4 + (b) * 2 + (h)) * HTB)
#define PG8_STAGE(bufoff, gbase, voff) do { _Pragma("unroll") for (int _i = 0; _i < 2; ++_i) \
        __builtin_amdgcn_global_load_lds((const unsigned*)((const char*)(gbase) + (voff)[_i]), (PG8_LAS unsigned*)(lds + (bufoff) + ldsw + _i * 8192), 16, 0, 0); } while (0)
#define PG8_LDA(dst, b, h) do { _Pragma("unroll") for (int m = 0; m < 4; ++m) _Pragma("unroll") for (int k = 0; k < 2; ++k) dst[m][k] = *(const PG8_LAS bf16x8*)(lds + PG8_SA(b, h) + aoff + m * 2048 + k * 1024); } while (0)
#define PG8_LDB(dst, b, h) do { _Pragma("unroll") for (int n = 0; n < 2; ++n) _Pragma("unroll") for (int k = 0; k < 2; ++k) dst[n][k] = *(const PG8_LAS bf16x8*)(lds + PG8_SB(b, h) + boff + n * 2048 + k * 1024); } while (0)
#define PG8_MMA(ai, bj, At, Bt) do { __builtin_amdgcn_s_setprio(1); _Pragma("unroll") for (int m = 0; m < 4; ++m) _Pragma("unroll") for (int n = 0; n < 2; ++n) _Pragma("unroll") for (int k = 0; k < 2; ++k) \
        acc[ai][bj][m][n] = __builtin_amdgcn_mfma_f32_16x16x32_bf16(Bt[n][k], At[m][k], acc[ai][bj][m][n], 0, 0, 0); __builtin_amdgcn_s_setprio(0); } while (0)
#define PG8_WAIT_V(n) asm volatile("s_waitcnt vmcnt(" #n ")" ::: "memory")
#define PG8_WAIT_L(n) asm volatile("s_waitcnt lgkmcnt(" #n ")" ::: "memory")
#define PG8_BAR __builtin_amdgcn_s_barrier()
#define PG8_SCHED __builtin_amdgcn_sched_barrier(0)
    Unit cur, nxt; int ui = 0;
    if (!S.next(0, cur)) return;
    f32x4 acc[2][2][4][2];
#pragma unroll
    for (int a = 0; a < 2; ++a)
#pragma unroll
        for (int b = 0; b < 2; ++b)
#pragma unroll
            for (int m = 0; m < 4; ++m)
#pragma unroll
                for (int n = 0; n < 2; ++n) acc[a][b][m][n] = (f32x4){0.f, 0.f, 0.f, 0.f};
    bf16x8 At[4][2], B0[2][2], B1[2][2];
    const char* cA = (const char*)g.A + (size_t)cur.pm * tstep; const char* cB = (const char*)g.Bt + (size_t)cur.pn * tstep;
    S.a_ready(cur);
    if constexpr (SP2) {
        PG8_STAGE(PG8_SB(0, 0), cB, voffB); PG8_STAGE(PG8_SB(0, 1), cB + hstep, voffB); PG8_STAGE(PG8_SA(0, 0), cA, voffA); PG8_STAGE(PG8_SA(0, 1), cA + hstep, voffA);
        if (wr == 1) PG8_BAR;
        PG8_WAIT_V(2); PG8_BAR;
        PG8_STAGE(PG8_SB(1, 0), cB + kstep, voffB); PG8_STAGE(PG8_SA(1, 0), cA + kstep, voffA); PG8_STAGE(PG8_SB(1, 1), cB + hstep + kstep, voffB);
        PG8_WAIT_V(6); PG8_BAR;
    } else {
        PG8_STAGE(PG8_SB(0, 0), cB, voffB); PG8_STAGE(PG8_SA(0, 0), cA, voffA); PG8_STAGE(PG8_SB(0, 1), cB + hstep, voffB); PG8_STAGE(PG8_SA(0, 1), cA + hstep, voffA);
        if (wr == 1) PG8_BAR;
        PG8_WAIT_V(4); PG8_BAR;
        PG8_STAGE(PG8_SB(1, 0), cB + kstep, voffB); PG8_STAGE(PG8_SA(1, 0), cA + kstep, voffA); PG8_STAGE(PG8_SB(1, 1), cB + hstep + kstep, voffB);
        PG8_WAIT_V(6); PG8_BAR;
    }
    for (;;) {
        const bool has_next = S.next(ui + 1, nxt);
        const char* nA = has_next ? (const char*)g.A + (size_t)nxt.pm * tstep : cA; const char* nB = has_next ? (const char*)g.Bt + (size_t)nxt.pn * tstep : cB;
        for (int t = 0; t < nt; t += 2) {
            const bool last = (t == nt - 2);
            const char* a1 = cA + (size_t)(t + 1) * kstep;
            const char* a2 = last ? nA : cA + (size_t)(t + 2) * kstep; const char* b2 = last ? nB : cB + (size_t)(t + 2) * kstep;
            const char* a3 = a2 + kstep; const char* b3 = b2 + kstep;
            if (last && has_next) S.a_ready(nxt);
            if constexpr (SP2) {
            PG8_LDB(B0, 0, 0); PG8_LDB(B1, 0, 1); PG8_SCHED; PG8_LDA(At, 0, 0); PG8_STAGE(PG8_SA(1, 1), a1 + hstep, voffA);
            PG8_WAIT_V(8); PG8_WAIT_L(0); PG8_BAR; PG8_MMA(0, 0, At, B0); PG8_MMA(0, 1, At, B1); PG8_BAR; PG8_SCHED;
            PG8_LDA(At, 0, 1); PG8_STAGE(PG8_SB(0, 0), b2, voffB); PG8_STAGE(PG8_SB(0, 1), b2 + hstep, voffB); PG8_STAGE(PG8_SA(0, 0), a2, voffA);
            PG8_WAIT_V(8); PG8_WAIT_L(0); PG8_BAR; PG8_MMA(1, 0, At, B0); PG8_MMA(1, 1, At, B1); PG8_BAR; PG8_SCHED;
            PG8_LDB(B0, 1, 0); PG8_LDB(B1, 1, 1); PG8_SCHED; PG8_LDA(At, 1, 0); PG8_STAGE(PG8_SA(0, 1), a2 + hstep, voffA);
            PG8_WAIT_V(8); PG8_WAIT_L(0); PG8_BAR; PG8_MMA(0, 0, At, B0); PG8_MMA(0, 1, At, B1); PG8_BAR; PG8_SCHED;
            PG8_LDA(At, 1, 1); PG8_STAGE(PG8_SB(1, 0), b3, voffB); PG8_STAGE(PG8_SB(1, 1), b3 + hstep, voffB); PG8_STAGE(PG8_SA(1, 0), a3, voffA);
            PG8_WAIT_V(8); PG8_WAIT_L(0); PG8_BAR; PG8_MMA(1, 0, At, B0); PG8_MMA(1, 1, At, B1); PG8_BAR; PG8_SCHED;
            } else {
            PG8_LDB(B0, 0, 0); PG8_SCHED; PG8_LDA(At, 0, 0); PG8_STAGE(PG8_SA(1, 1), a1 + hstep, voffA);
            PG8_WAIT_L(8); PG8_BAR; PG8_WAIT_L(0); PG8_MMA(0, 0, At, B0); PG8_BAR; PG8_SCHED;
            PG8_LDB(B1, 0, 1); PG8_STAGE(PG8_SB(0, 0), b2, voffB);
            PG8_BAR; PG8_WAIT_L(0); PG8_MMA(0, 1, At, B1); PG8_BAR;
            PG8_LDA(At, 0, 1); PG8_STAGE(PG8_SA(0, 0), a2, voffA);
            PG8_BAR; PG8_WAIT_L(0); PG8_MMA(1, 0, At, B0); PG8_BAR; PG8_SCHED;
            PG8_STAGE(PG8_SB(0, 1), b2 + hstep, voffB);
            PG8_WAIT_V(6); PG8_BAR; PG8_MMA(1, 1, At, B1); PG8_BAR;
            PG8_LDB(B0, 1, 0); PG8_SCHED; PG8_LDA(At, 1, 0); PG8_STAGE(PG8_SA(0, 1), a2 + hstep, voffA);
            PG8_WAIT_L(8); PG8_BAR; PG8_WAIT_L(0); PG8_MMA(0, 0, At, B0); PG8_BAR; PG8_SCHED;
            PG8_LDB(B1, 1, 1); PG8_STAGE(PG8_SB(1, 0), b3, voffB);
            PG8_BAR; PG8_WAIT_L(0); PG8_MMA(0, 1, At, B1); PG8_BAR;
            PG8_LDA(At, 1, 1); PG8_STAGE(PG8_SA(1, 0), a3, voffA);
            PG8_BAR; PG8_WAIT_L(0); PG8_MMA(1, 0, At, B0); PG8_BAR; PG8_SCHED;
            PG8_STAGE(PG8_SB(1, 1), b3 + hstep, voffB);
            PG8_WAIT_V(6); PG8_BAR; PG8_MMA(1, 1, At, B1); PG8_BAR;
            }
        }
        if constexpr (ALIGN_EPI) { if (wr == 0) PG8_BAR; }
        if constexpr (!Epi::AFTER_DRAIN) { E(acc, cur, wr, wc, fr, fq); S.done(cur); }
        if (!has_next) break;
#pragma unroll
        for (int a = 0; a < 2; ++a)
#pragma unroll
            for (int b = 0; b < 2; ++b)
#pragma unroll
                for (int m = 0; m < 4; ++m)
#pragma unroll
                    for (int n = 0; n < 2; ++n) acc[a][b][m][n] = (f32x4){0.f, 0.f, 0.f, 0.f};
        cur = nxt; cA = nA; cB = nB; ++ui;
        if constexpr (ALIGN_EPI) { if (wr == 1) PG8_BAR; }
    }
    PG8_WAIT_V(0);
    if constexpr (!ALIGN_EPI) { if (wr == 0) PG8_BAR; }
    PG8_BAR;
    if constexpr (Epi::AFTER_DRAIN) { E.fused(acc, cur, wr, wc, fr, fq, lds, wid, lane); S.done(cur); }
#undef PG8_SA
#undef PG8_SB
#undef PG8_STAGE
#undef PG8_LDA
#undef PG8_LDB
#undef PG8_MMA
#undef PG8_WAIT_V
#undef PG8_WAIT_L
#undef PG8_BAR
#undef PG8_SCHED
}
}

#define LAS __attribute__((address_space(3)))
typedef pg8::bf16_t bf16_t;
typedef pg8::bf16x8 bf16x8;
typedef pg8::f32x4 f32x4;
typedef pg8::u32x4 u32x4;
typedef unsigned u32x2 __attribute__((ext_vector_type(2)));
typedef float f32x2v __attribute__((ext_vector_type(2)));
using pg8::cvt_pk_bf16;
using pg8::fast_sigmoid;
using pg8::fast_silu;

constexpr int D = 1024, NB = 4, SEQ = 8192, NTOK = NB * SEQ;
#ifndef MK_NSPLIT
#define MK_NSPLIT 4
#endif
constexpr int NSPLIT = MK_NSPLIT, TS = SEQ / NSPLIT, MS = NB * TS;
constexpr int CL = 9728;
constexpr int C_R = 0, C_K = 1024, C_V = 2048, C_WLO = 3072, C_ALO = 3136, C_GLO = 3200, C_HQ = 3584, C_HF = 4608, C_HI = 5632, C_HG = 6656, C_GA = 7680, C_GB = 8704;
constexpr int CARRY_LD = 3584;
constexpr int DFF = 2816;
constexpr size_t MiB = 1u << 20, KiB = 1u << 10;
constexpr size_t WS_WIN = 0, WS_WOUT = 19 * MiB, WS_WQ = 21 * MiB, WS_WO = 23 * MiB, WS_WKV = 25 * MiB, WS_W13 = 29 * MiB, WS_W2 = 40 * MiB;
constexpr size_t WS_RW2T = 46 * MiB, WS_RA2T = 46 * MiB + 128 * KiB, WS_RG2T = 46 * MiB + 256 * KiB, WS_CARRY = 46 * MiB + 640 * KiB, WS_LB = 46 * MiB + 704 * KiB;
constexpr size_t WS_MBF = 47 * MiB, WS_KV = 49 * MiB, WS_VT = 53 * MiB, WS_RWST = 55 * MiB, WS_HGST = 56 * MiB, WS_BONUS = 58 * MiB;
constexpr size_t WS_G2TP = 59 * MiB;
constexpr size_t WS_MERGED = 64 * MiB;
constexpr size_t WS_U1 = 128 * MiB, WS_COLS = 144 * MiB, WS_PR = 296 * MiB, WS_PK = 312 * MiB, WS_PA = 328 * MiB, WS_PB = 344 * MiB, WS_PV = 360 * MiB, WS_PW = 376 * MiB, WS_ORAW = 408 * MiB, WS_HGO = 440 * MiB;
constexpr size_t WS_GATE = 472 * MiB, WS_ASG = 488 * MiB;
constexpr size_t WS_U = 128 * MiB, WS_Q = 192 * MiB, WS_AO = 256 * MiB, WS_FF = 320 * MiB, WS_END = 496 * MiB;
constexpr int LDS_BYTES = 147456;
constexpr int T0 = 1 + 5 * NSPLIT, N_PHASES = T0 + 9;

__device__ __forceinline__ float bflo(unsigned u) { return __uint_as_float(u << 16); }
__device__ __forceinline__ float bfhi(unsigned u) { return __uint_as_float(u & 0xffff0000u); }
__device__ __forceinline__ unsigned f2bf(float f) { unsigned u = __float_as_uint(f); return (u + 0x7fffu + ((u >> 16) & 1u)) >> 16; }
__device__ __forceinline__ f32x4 ld4bf(const bf16_t* p) { const u32x2 u = *(const u32x2*)p; return (f32x4){bflo(u.x), bfhi(u.x), bflo(u.y), bfhi(u.y)}; }
__device__ __forceinline__ void ld8bf(const bf16_t* p, float (&o)[8]) { const u32x4 u = *(const u32x4*)p; o[0] = bflo(u.x); o[1] = bfhi(u.x); o[2] = bflo(u.y); o[3] = bfhi(u.y); o[4] = bflo(u.z); o[5] = bfhi(u.z); o[6] = bflo(u.w); o[7] = bfhi(u.w); }
__device__ __forceinline__ void st4bf(bf16_t* p, f32x4 v) { u32x2 w; w.x = cvt_pk_bf16(v[0], v[1]); w.y = cvt_pk_bf16(v[2], v[3]); *(u32x2*)p = w; }
__device__ __forceinline__ bf16x8 pack8(const float (&t)[8]) { u32x4 w; w.x = cvt_pk_bf16(t[0], t[1]); w.y = cvt_pk_bf16(t[2], t[3]); w.z = cvt_pk_bf16(t[4], t[5]); w.w = cvt_pk_bf16(t[6], t[7]); return __builtin_bit_cast(bf16x8, w); }
__device__ __forceinline__ float tanh_fast(float x) { return 1.0f - 2.0f * __builtin_amdgcn_rcpf(1.0f + __expf(2.0f * x)); }
__device__ __forceinline__ float wave_sum(float v) {
#pragma unroll
    for (int o = 1; o < 64; o <<= 1) v += __shfl_xor(v, o);
    return v;
}
__device__ __forceinline__ float fq_sum(float v) { v += __shfl_xor(v, 16); v += __shfl_xor(v, 32); return v; }
template <int CTRL> __device__ __forceinline__ float dpp_add(float x) { return x + __builtin_bit_cast(float, __builtin_amdgcn_update_dpp(0, __builtin_bit_cast(int, x), CTRL, 0xf, 0xf, false)); }
#ifdef MK_SHFL_REDUCE
__device__ __forceinline__ float allreduce16(float x) { x += __shfl_xor(x, 1); x += __shfl_xor(x, 2); x += __shfl_xor(x, 4); x += __shfl_xor(x, 8); return x; }
#else
__device__ __forceinline__ float allreduce16(float x) { x = dpp_add<0xB1>(x); x = dpp_add<0x4E>(x); x = dpp_add<0x141>(x); x = dpp_add<0x140>(x); return x; }
#endif
#define MFMA16(a, b, c) __builtin_amdgcn_mfma_f32_16x16x32_bf16((a), (b), (c), 0, 0, 0)

__device__ __forceinline__ void rms_row_bf16(const float* src, const float* g, bf16_t* dst, int lane) {
    f32x4 v[4]; float s = 0.f;
#pragma unroll
    for (int j = 0; j < 4; ++j) { v[j] = ((const f32x4*)src)[lane + 64 * j]; s += (v[j][0] * v[j][0] + v[j][1] * v[j][1]) + (v[j][2] * v[j][2] + v[j][3] * v[j][3]); }
    const float rs = 1.0f / sqrtf(wave_sum(s) * (1.0f / 1024.0f) + 1e-6f);
#pragma unroll
    for (int j = 0; j < 4; ++j) { const f32x4 gv = ((const f32x4*)g)[lane + 64 * j]; st4bf(dst + 4 * (lane + 64 * j), v[j] * rs * gv); }
}
__device__ __forceinline__ void tr_item(const float* W, int K, int N, bf16_t* WT, int kb, int n0, int row_base, LAS float* scr, int lane) {
    const int k0 = 64 * kb;
#pragma unroll 8
    for (int i = 0; i < 32; ++i) { const int kk = 2 * i + (lane >> 5); scr[kk * 33 + (lane & 31)] = W[(size_t)(k0 + kk) * N + n0 + (lane & 31)]; }
    asm volatile("s_waitcnt lgkmcnt(0)" ::: "memory");
    const int c = lane & 7;
#pragma unroll
    for (int j = 0; j < 4; ++j) { const int n = (lane >> 3) + 8 * j; const LAS float* sp = scr + (8 * c) * 33 + n;
        u32x4 o; o.x = cvt_pk_bf16(sp[0 * 33], sp[1 * 33]); o.y = cvt_pk_bf16(sp[2 * 33], sp[3 * 33]); o.z = cvt_pk_bf16(sp[4 * 33], sp[5 * 33]); o.w = cvt_pk_bf16(sp[6 * 33], sp[7 * 33]);
        *(u32x4*)(WT + (size_t)(row_base + n) * K + k0 + 8 * c) = o; }
    asm volatile("s_waitcnt lgkmcnt(0)" ::: "memory");
}

__device__ __forceinline__ void prep_phase(int s, int gw, int NGW, int lane, const bf16_t* cols, const bf16_t* carry,
        const float* mu, const float* w0, const float* a0, const float* k_k, const float* k_a, const float* r_k,
        const bf16_t* w2T, const bf16_t* a2T, bf16_t* PR, bf16_t* PK, bf16_t* PA, bf16_t* PB, bf16_t* PV, float* PW, float* bonus, bf16_t* ASG) {
    const int fr = lane & 15, fq = lane >> 4;
    for (int item = gw; item < (MS / 16) * 4; item += NGW) {
        const int tile = item >> 2, hg4 = item & 3;
        const int lt = tile * 16 + fr, b = lt / TS, tl = lt % TS;
        const bf16_t* crow = cols + (size_t)lt * CL;
        const bf16_t* prow = tl > 0 ? crow - CL : carry + ((s & 1) * 4 + b) * CARRY_LD;
        bf16x8 Aw[2], Aa[2];
#pragma unroll
        for (int ks = 0; ks < 2; ++ks) {
            { const int c = C_WLO + ks * 32 + fq * 8; float cur[8], prv[8], t[8]; ld8bf(crow + c, cur); ld8bf(prow + c, prv);
              const f32x4 m0 = *(const f32x4*)(mu + c), m1 = *(const f32x4*)(mu + c + 4);
#pragma unroll
              for (int e = 0; e < 8; ++e) { const float mm = e < 4 ? m0[e & 3] : m1[e & 3]; t[e] = tanh_fast(cur[e] + mm * (prv[e] - cur[e])); }
              Aw[ks] = pack8(t); }
            { const int c = C_ALO + ks * 32 + fq * 8; float cur[8], prv[8], t[8]; ld8bf(crow + c, cur); ld8bf(prow + c, prv);
              const f32x4 m0 = *(const f32x4*)(mu + c), m1 = *(const f32x4*)(mu + c + 4);
#pragma unroll
              for (int e = 0; e < 8; ++e) { const float mm = e < 4 ? m0[e & 3] : m1[e & 3]; t[e] = cur[e] + mm * (prv[e] - cur[e]); }
              Aa[ks] = pack8(t); }
        }
        if (hg4 == 0) {
#pragma unroll
            for (int ks = 0; ks < 5; ++ks) { const int c = C_GLO + ks * 32 + fq * 8; float cur[8], prv[8], t[8]; ld8bf(crow + c, cur); ld8bf(prow + c, prv);
                const f32x4 m0 = *(const f32x4*)(mu + c), m1 = *(const f32x4*)(mu + c + 4);
#pragma unroll
                for (int e = 0; e < 8; ++e) { const float mm = e < 4 ? m0[e & 3] : m1[e & 3]; t[e] = fast_sigmoid(cur[e] + mm * (prv[e] - cur[e])); }
                *(bf16x8*)(ASG + (size_t)lt * 256 + ks * 32 + fq * 8) = pack8(t); }
#pragma unroll
            for (int ks = 5; ks < 8; ++ks) *(u32x4*)(ASG + (size_t)lt * 256 + ks * 32 + fq * 8) = (u32x4){0u, 0u, 0u, 0u};
        }
#pragma unroll 1
        for (int hh = 0; hh < 4; ++hh) {
            const int h = hg4 * 4 + hh;
            f32x4 aw[4], aa[4];
#pragma unroll
            for (int nt = 0; nt < 4; ++nt) { aw[nt] = (f32x4){0.f, 0.f, 0.f, 0.f}; aa[nt] = (f32x4){0.f, 0.f, 0.f, 0.f};
                const int n = h * 64 + nt * 16 + fr;
#pragma unroll
                for (int ks = 0; ks < 2; ++ks) { const bf16x8 bw = *(const bf16x8*)(w2T + n * 64 + ks * 32 + fq * 8); aw[nt] = MFMA16(bw, Aw[ks], aw[nt]);
                    const bf16x8 ba = *(const bf16x8*)(a2T + n * 64 + ks * 32 + fq * 8); aa[nt] = MFMA16(ba, Aa[ks], aa[nt]); } }
            f32x4 kkv[4], av[4]; float ssq = 0.f, bon = 0.f;
#pragma unroll
            for (int nt = 0; nt < 4; ++nt) {
                const int c = h * 64 + nt * 16 + 4 * fq; const size_t o = (size_t)lt * 1024 + c;
                const f32x4 rc = ld4bf(crow + C_R + c), rp = ld4bf(prow + C_R + c), kc = ld4bf(crow + C_K + c), kp = ld4bf(prow + C_K + c), vc = ld4bf(crow + C_V + c), vp = ld4bf(prow + C_V + c);
                const f32x4 r = rc + *(const f32x4*)(mu + C_R + c) * (rp - rc), k = kc + *(const f32x4*)(mu + C_K + c) * (kp - kc), v = vc + *(const f32x4*)(mu + C_V + c) * (vp - vc);
                const f32x4 w0v = *(const f32x4*)(w0 + c), a0v = *(const f32x4*)(a0 + c), kkp = *(const f32x4*)(k_k + c), kap = *(const f32x4*)(k_a + c), rkp = *(const f32x4*)(r_k + c);
                f32x4 wv, a, kk, kmod;
#pragma unroll
                for (int j = 0; j < 4; ++j) {
                    const float z = -(w0v[j] + aw[nt][j]);
                    const float sp = fmaxf(z, 0.f) + __logf(1.0f + __expf(-fabsf(z)));
                    wv[j] = __expf(-__expf(-sp - 0.5f));
                    a[j] = fast_sigmoid(a0v[j] + aa[nt][j]);
                    kk[j] = k[j] * kkp[j]; kmod[j] = k[j] * (1.0f + (a[j] - 1.0f) * kap[j]);
                    ssq += kk[j] * kk[j]; bon += r[j] * kmod[j] * rkp[j];
                }
                kkv[nt] = kk; av[nt] = a;
                st4bf(PR + o, r); st4bf(PK + o, kmod); st4bf(PV + o, v); *(f32x4*)(PW + o) = wv;
            }
            ssq = fq_sum(ssq); bon = fq_sum(bon);
            const float rs = 1.0f / sqrtf(fmaxf(ssq, 1e-24f));
#pragma unroll
            for (int nt = 0; nt < 4; ++nt) { const int c = h * 64 + nt * 16 + 4 * fq; const size_t o = (size_t)lt * 1024 + c;
                const f32x4 kn = kkv[nt] * rs; st4bf(PA + o, -kn); st4bf(PB + o, kn * av[nt]); }
            if (fq == 0) bonus[lt * 16 + h] = bon;
        }
    }
}

__device__ __forceinline__ void post_phase(int s, int gw, int NGW, int lane, const bf16_t* cols, const bf16_t* carry, const float* mu, const bf16_t* gate,
        const float* ln_w, const float* ln_b, const float* hg_g, const float* oraw, const float* hgo, const bf16_t* PV, const float* bonus, bf16_t* merged) {
    const int fr = lane & 15, fq = lane >> 4;
    for (int item = gw; item < (MS / 16) * 4; item += NGW) {
        const int tile = item >> 2, q4 = item & 3;
        const int lt = tile * 16 + fr, b = lt / TS, tl = lt % TS;
        const size_t gt = (size_t)b * SEQ + s * TS + tl;
        const bf16_t* crow = cols + (size_t)lt * CL;
        const bf16_t* prow = tl > 0 ? crow - CL : carry + ((s & 1) * 4 + b) * CARRY_LD;
#pragma unroll 1
        for (int hgh = 0; hgh < 2; ++hgh) {
            const int h8 = q4 * 2 + hgh;
            f32x4 ho[8]; float ss = 0.f;
#pragma unroll
            for (int n8 = 0; n8 < 8; ++n8) { ho[n8] = *(const f32x4*)(hgo + ((size_t)((b * 8 + h8) * 8 + n8) * TS + tl) * 16 + 4 * fq); ss += (ho[n8][0] * ho[n8][0] + ho[n8][1] * ho[n8][1]) + (ho[n8][2] * ho[n8][2] + ho[n8][3] * ho[n8][3]); }
            ss = fq_sum(ss);
            const float rsh = 1.0f / sqrtf(ss * (1.0f / 128.0f) + 1e-6f);
#pragma unroll
            for (int rwh = 0; rwh < 2; ++rwh) {
                const int h = q4 * 4 + hgh * 2 + rwh;
                f32x4 ag[4], o[4]; float sm = 0.f;
#pragma unroll
                for (int nt = 0; nt < 4; ++nt) { ag[nt] = ld4bf(gate + (size_t)lt * 1024 + h * 64 + nt * 16 + 4 * fq);
                    o[nt] = *(const f32x4*)(oraw + ((size_t)((b * 16 + h) * 4 + nt) * TS + tl) * 16 + 4 * fq); sm += (o[nt][0] + o[nt][1]) + (o[nt][2] + o[nt][3]); }
                const float mean = fq_sum(sm) * (1.0f / 64.0f); float vq = 0.f;
#pragma unroll
                for (int nt = 0; nt < 4; ++nt) { o[nt] = o[nt] - mean; vq += (o[nt][0] * o[nt][0] + o[nt][1] * o[nt][1]) + (o[nt][2] * o[nt][2] + o[nt][3] * o[nt][3]); }
                const float rstd = 1.0f / sqrtf(fq_sum(vq) * (1.0f / 64.0f) + 64e-5f);
#ifdef MK_NO_BONUS
                const float bon = 0.f;
#else
                const float bon = bonus[lt * 16 + h];
#endif
#pragma unroll
                for (int nt = 0; nt < 4; ++nt) {
                    const int c = h * 64 + nt * 16 + 4 * fq;
                    const f32x4 lw = *(const f32x4*)(ln_w + c), lb = *(const f32x4*)(ln_b + c), v = ld4bf(PV + (size_t)lt * 1024 + c);
                    const f32x4 ya = (o[nt] * rstd * lw + lb + v * bon) * ag[nt];
                    const f32x4 ng = *(const f32x4*)(hg_g + (c & 127)), gh = ld4bf(crow + C_HG + c), gar = ld4bf(crow + C_GA + c), gbr = ld4bf(crow + C_GB + c);
                    const f32x4 hv = ho[rwh * 4 + nt] * rsh * ng;
                    f32x4 m;
#pragma unroll
                    for (int j = 0; j < 4; ++j) {
#if defined(MK_ZERO_YA)
                        m[j] = fast_sigmoid(gbr[j]) * (hv[j] * fast_silu(gh[j]));
#elif defined(MK_ZERO_YB)
                        m[j] = fast_sigmoid(gar[j]) * ya[j];
#else
                        m[j] = fast_sigmoid(gar[j]) * ya[j] + fast_sigmoid(gbr[j]) * (hv[j] * fast_silu(gh[j]));
#endif
                    }
                    st4bf(merged + gt * 1024 + c, m);
                }
            }
        }
    }
}

constexpr int RWB = 43008;
__device__ __forceinline__ void rw_load(LAS unsigned char* bp, int lt2, size_t ltok0, int h, int rg, const bf16_t* PA, const float* PW, const bf16_t* PB, const bf16_t* PK, const bf16_t* PR, const bf16_t* PV) {
    const int tok = lt2 >> 3, c8 = (lt2 & 7) * 8; const size_t base = (ltok0 + tok) * 1024 + h * 64 + c8;
    const u32x4 ra = *(const u32x4*)(PA + base), rb = *(const u32x4*)(PB + base), rk = *(const u32x4*)(PK + base), rr = *(const u32x4*)(PR + base);
    const f32x4 w0 = *(const f32x4*)(PW + base), w1 = *(const f32x4*)(PW + base + 4);
    const unsigned rv = *(const unsigned*)(PV + (ltok0 + tok) * 1024 + h * 64 + rg * 16 + (lt2 & 7) * 2);
    const int off = (tok * 64 + c8) * 4;
#define RW_PUT(arr, u) do { *(LAS f32x4*)(bp + (arr) * 8192 + off) = (f32x4){bflo(u.x), bfhi(u.x), bflo(u.y), bfhi(u.y)}; *(LAS f32x4*)(bp + (arr) * 8192 + off + 16) = (f32x4){bflo(u.z), bfhi(u.z), bflo(u.w), bfhi(u.w)}; } while (0)
    RW_PUT(0, ra); RW_PUT(2, rb); RW_PUT(3, rk); RW_PUT(4, rr);
#undef RW_PUT
    *(LAS f32x4*)(bp + 8192 + off) = w0; *(LAS f32x4*)(bp + 8192 + off + 16) = w1;
    *(LAS f32x2v*)(bp + 40960 + (tok * 16 + (lt2 & 7) * 2) * 4) = (f32x2v){bflo(rv), bfhi(rv)};
}
__device__ __forceinline__ void rwkv_scan(int s, int bid, int G, int tid, int lane, int wave, LAS unsigned char* lds,
        const bf16_t* PA, const float* PW, const bf16_t* PB, const bf16_t* PK, const bf16_t* PR, const bf16_t* PV, float* oraw, float* state, bool save) {
    constexpr int NBLK = TS / 32;
    const int rowl = lane >> 4, j = lane & 15, row = (wave & 3) * 4 + rowl;
    for (int it = bid; it < 256; it += G) {
        const int b = it >> 6, h = (it >> 2) & 15, rg = it & 3;
        const size_t tok0 = (size_t)b * TS;
        float* stp = state + ((size_t)((b * 16 + h) * 64 + rg * 16 + row) * 64 + 4 * j);
        f32x4 st = (f32x4){0.f, 0.f, 0.f, 0.f};
        if (wave < 4 && s > 0) st = *(const f32x4*)stp;
        if (wave >= 4) rw_load(lds, tid - 256, tok0, h, rg, PA, PW, PB, PK, PR, PV);
        __syncthreads();
#pragma unroll 1
        for (int blk = 0; blk < NBLK; ++blk) {
            if (wave >= 4) { if (blk + 1 < NBLK) rw_load(lds + ((blk + 1) & 1) * RWB, tid - 256, tok0 + (blk + 1) * 32, h, rg, PA, PW, PB, PK, PR, PV); }
            else {
                const LAS unsigned char* bp = lds + (blk & 1) * RWB;
                float* orow = oraw + ((size_t)it * TS + blk * 32) * 16 + row;
#pragma unroll 4
                for (int t = 0; t < 32; ++t) {
                    const int o4 = (t * 64 + 4 * j) * 4;
                    const f32x4 a4 = *(const LAS f32x4*)(bp + o4), w4 = *(const LAS f32x4*)(bp + 8192 + o4), b4 = *(const LAS f32x4*)(bp + 16384 + o4), k4 = *(const LAS f32x4*)(bp + 24576 + o4), r4 = *(const LAS f32x4*)(bp + 32768 + o4);
                    const float vv = *(const LAS float*)(bp + 40960 + (t * 16 + row) * 4);
                    float sa = (st[0] * a4[0] + st[1] * a4[1]) + (st[2] * a4[2] + st[3] * a4[3]);
                    sa = allreduce16(sa);
                    st = st * w4 + (b4 * sa + k4 * vv);
                    float y = (st[0] * r4[0] + st[1] * r4[1]) + (st[2] * r4[2] + st[3] * r4[3]);
                    y = allreduce16(y);
                    if (j == 0) orow[t * 16] = y;
                }
            }
            __syncthreads();
        }
        if (wave < 4 && save) *(f32x4*)stp = st;
    }
}


__device__ __forceinline__ void rwkv_scan_naive(int s, int gw, int NGW, int lane, int wave, LAS unsigned char* lds,
        const bf16_t* PA, const float* PW, const bf16_t* PB, const bf16_t* PK, const bf16_t* PR, const bf16_t* PV, float* oraw, float* state) {
    LAS float* slab = (LAS float*)(lds + wave * 2048);
    for (int it = gw; it < 64; it += NGW) {
        const int b = it >> 4, h = it & 15;
        float st[64];
        float* stp = state + (size_t)((b * 16 + h) * 64 + lane) * 64;
#pragma unroll
        for (int k = 0; k < 64; ++k) st[k] = (s > 0) ? stp[k] : 0.f;
        for (int tl = 0; tl < TS; ++tl) {
            const size_t base = ((size_t)b * TS + tl) * 1024 + h * 64 + lane;
            slab[lane] = bflo((unsigned)PA[base]); slab[64 + lane] = PW[base]; slab[128 + lane] = bflo((unsigned)PB[base]); slab[192 + lane] = bflo((unsigned)PK[base]); slab[256 + lane] = bflo((unsigned)PR[base]);
            const float vv = bflo((unsigned)PV[base]);
            asm volatile("s_waitcnt lgkmcnt(0)" ::: "memory");
            float sa = 0.f;
#pragma unroll
            for (int k = 0; k < 64; ++k) sa += st[k] * slab[k];
            float y = 0.f;
#pragma unroll
            for (int k = 0; k < 64; ++k) { st[k] = st[k] * slab[64 + k] + (sa * slab[128 + k] + vv * slab[192 + k]); y += st[k] * slab[256 + k]; }
            asm volatile("s_waitcnt lgkmcnt(0)" ::: "memory");
            oraw[((size_t)(it * 4 + (lane >> 4)) * TS + tl) * 16 + (lane & 15)] = y;
        }
#pragma unroll
        for (int k = 0; k < 64; ++k) stp[k] = st[k];
    }
}
constexpr int HGB = 51200;
__device__ __forceinline__ void hg_load(LAS unsigned char* bp, int lt2, size_t ltok0, int h8, int rg, const bf16_t* cols, const float* lbv) {
    const int tok = lt2 >> 3, c16 = (lt2 & 7) * 16; const bf16_t* crow = cols + (ltok0 + tok) * CL;
    float q[16], f[16];
    { float t[8]; ld8bf(crow + C_HQ + h8 * 128 + c16, t);
#pragma unroll
      for (int e = 0; e < 8; ++e) q[e] = t[e];
      ld8bf(crow + C_HQ + h8 * 128 + c16 + 8, t);
#pragma unroll
      for (int e = 0; e < 8; ++e) q[8 + e] = t[e];
      ld8bf(crow + C_HF + h8 * 128 + c16, t);
#pragma unroll
      for (int e = 0; e < 8; ++e) f[e] = t[e];
      ld8bf(crow + C_HF + h8 * 128 + c16 + 8, t);
#pragma unroll
      for (int e = 0; e < 8; ++e) f[8 + e] = t[e]; }
    const unsigned rv = *(const unsigned*)(crow + C_HI + h8 * 128 + rg * 16 + (lt2 & 7) * 2);
    const int off = (tok * 128 + c16) * 4;
#pragma unroll
    for (int g = 0; g < 4; ++g) { const f32x4 lb = *(const f32x4*)(lbv + h8 * 128 + c16 + 4 * g); f32x4 fv, kv, qv;
#pragma unroll
        for (int e = 0; e < 4; ++e) { fv[e] = lb[e] + (1.0f - lb[e]) * fast_sigmoid(f[4 * g + e]); kv[e] = 1.0f - fv[e]; qv[e] = fast_silu(q[4 * g + e]); }
        *(LAS f32x4*)(bp + off + 16 * g) = fv; *(LAS f32x4*)(bp + 16384 + off + 16 * g) = kv; *(LAS f32x4*)(bp + 32768 + off + 16 * g) = qv; }
    *(LAS f32x2v*)(bp + 49152 + (tok * 16 + (lt2 & 7) * 2) * 4) = (f32x2v){bflo(rv), bfhi(rv)};
}
__device__ __forceinline__ void hgrn_scan(int s, int bid, int G, int tid, int lane, int wave, LAS unsigned char* lds, const bf16_t* cols, const float* lbv, float* hgo, float* state, bool save) {
    constexpr int NBLK = TS / 32;
    const int rowl = lane >> 4, j = lane & 15, row = (wave & 3) * 4 + rowl;
    for (int it = bid; it < 256; it += G) {
        const int b = it >> 6, h8 = (it >> 3) & 7, rg = it & 7;
        const size_t tok0 = (size_t)b * TS;
        float* stp = state + ((size_t)((b * 8 + h8) * 128 + rg * 16 + row) * 128 + 4 * j);
        f32x4 s0 = (f32x4){0.f, 0.f, 0.f, 0.f}, s1 = s0;
        if (wave < 4 && s > 0) { s0 = *(const f32x4*)stp; s1 = *(const f32x4*)(stp + 64); }
        if (wave >= 4) hg_load(lds, tid - 256, tok0, h8, rg, cols, lbv);
        __syncthreads();
#pragma unroll 1
        for (int blk = 0; blk < NBLK; ++blk) {
            if (wave >= 4) { if (blk + 1 < NBLK) hg_load(lds + ((blk + 1) & 1) * HGB, tid - 256, tok0 + (blk + 1) * 32, h8, rg, cols, lbv); }
            else {
                const LAS unsigned char* bp = lds + (blk & 1) * HGB;
                float* orow = hgo + ((size_t)it * TS + blk * 32) * 16 + row;
#pragma unroll 4
                for (int t = 0; t < 32; ++t) {
                    const int o4 = (t * 128 + 4 * j) * 4;
                    const f32x4 f0 = *(const LAS f32x4*)(bp + o4), f1 = *(const LAS f32x4*)(bp + o4 + 256), k0 = *(const LAS f32x4*)(bp + 16384 + o4), k1 = *(const LAS f32x4*)(bp + 16384 + o4 + 256);
                    const f32x4 q0 = *(const LAS f32x4*)(bp + 32768 + o4), q1 = *(const LAS f32x4*)(bp + 32768 + o4 + 256);
                    const float iv = *(const LAS float*)(bp + 49152 + (t * 16 + row) * 4);
                    s0 = s0 * f0 + k0 * iv; s1 = s1 * f1 + k1 * iv;
                    float y = ((s0[0] * q0[0] + s0[1] * q0[1]) + (s0[2] * q0[2] + s0[3] * q0[3])) + ((s1[0] * q1[0] + s1[1] * q1[1]) + (s1[2] * q1[2] + s1[3] * q1[3]));
                    y = allreduce16(y);
                    if (j == 0) orow[t * 16] = y;
                }
            }
            __syncthreads();
        }
        if (wave < 4 && save) { *(f32x4*)stp = s0; *(f32x4*)(stp + 64) = s1; }
    }
}

__device__ __forceinline__ void attn_phase(int gw, int NGW, int lane, const bf16_t* Q, const bf16_t* KV, const bf16_t* Vt, bf16_t* AO) {
    const int fr = lane & 15, fq = lane >> 4;
    for (int item = gw; item < 8192; item += NGW) {
        const int bh = item >> 9, tile = item & 511, b = bh >> 2, hd = bh & 3;
        const size_t gt = (size_t)b * SEQ + tile * 16 + fr;
        bf16x8 qf[8];
#pragma unroll
        for (int ks = 0; ks < 8; ++ks) qf[ks] = *(const bf16x8*)(Q + gt * 1024 + hd * 256 + ks * 32 + fq * 8);
        f32x4 sc[16]; float mx = -3.0e38f;
#pragma unroll
        for (int kt = 0; kt < 16; ++kt) { f32x4 acc = (f32x4){0.f, 0.f, 0.f, 0.f}; const bf16_t* kp = KV + (size_t)(b * 256 + kt * 16 + fr) * 2048 + hd * 256 + fq * 8;
#pragma unroll
            for (int ks = 0; ks < 8; ++ks) acc = MFMA16(*(const bf16x8*)(kp + ks * 32), qf[ks], acc);
            sc[kt] = acc * 0.0625f; mx = fmaxf(mx, fmaxf(fmaxf(sc[kt][0], sc[kt][1]), fmaxf(sc[kt][2], sc[kt][3]))); }
        mx = fmaxf(mx, __shfl_xor(mx, 16)); mx = fmaxf(mx, __shfl_xor(mx, 32));
        float sum = 0.f;
#pragma unroll
        for (int kt = 0; kt < 16; ++kt) {
#pragma unroll
            for (int jj = 0; jj < 4; ++jj) { sc[kt][jj] = __expf(sc[kt][jj] - mx); sum += sc[kt][jj]; } }
        sum = fq_sum(sum);
        const float inv = 1.0f / sum;
        bf16x8 pf[8];
#pragma unroll
        for (int k2 = 0; k2 < 8; ++k2) { u32x4 w; w.x = cvt_pk_bf16(sc[2 * k2][0], sc[2 * k2][1]); w.y = cvt_pk_bf16(sc[2 * k2][2], sc[2 * k2][3]); w.z = cvt_pk_bf16(sc[2 * k2 + 1][0], sc[2 * k2 + 1][1]); w.w = cvt_pk_bf16(sc[2 * k2 + 1][2], sc[2 * k2 + 1][3]); pf[k2] = __builtin_bit_cast(bf16x8, w); }
#pragma unroll 2
        for (int dt = 0; dt < 16; ++dt) { f32x4 acc = (f32x4){0.f, 0.f, 0.f, 0.f}; const bf16_t* vp = Vt + (size_t)((b * 4 + hd) * 256 + dt * 16 + fr) * 256 + fq * 8;
#pragma unroll
            for (int k2 = 0; k2 < 8; ++k2) acc = MFMA16(*(const bf16x8*)(vp + k2 * 32), pf[k2], acc);
            st4bf(AO + gt * 1024 + hd * 256 + dt * 16 + 4 * fq, acc * inv); }
    }
}

__device__ __forceinline__ int tid_fresh() { int t = threadIdx.x; asm volatile("" : "+v"(t)); return t; }
#define WinT ((bf16_t*)(a.ws + WS_WIN))
#define WoutT ((bf16_t*)(a.ws + WS_WOUT))
#define WqT ((bf16_t*)(a.ws + WS_WQ))
#define WoT ((bf16_t*)(a.ws + WS_WO))
#define WkvT ((bf16_t*)(a.ws + WS_WKV))
#define W13T ((bf16_t*)(a.ws + WS_W13))
#define W2T ((bf16_t*)(a.ws + WS_W2))
#define rw2T ((bf16_t*)(a.ws + WS_RW2T))
#define ra2T ((bf16_t*)(a.ws + WS_RA2T))
#define rg2T ((bf16_t*)(a.ws + WS_RG2T))
#define g2Tp ((bf16_t*)(a.ws + WS_G2TP))
#define GATE ((bf16_t*)(a.ws + WS_GATE))
#define ASG ((bf16_t*)(a.ws + WS_ASG))
#define carry ((bf16_t*)(a.ws + WS_CARRY))
#define lbv ((float*)(a.ws + WS_LB))
#define mbf ((bf16_t*)(a.ws + WS_MBF))
#define KV ((bf16_t*)(a.ws + WS_KV))
#define Vt ((bf16_t*)(a.ws + WS_VT))
#define rwst ((float*)(a.ws + WS_RWST))
#define hgst ((float*)(a.ws + WS_HGST))
#define bonus ((float*)(a.ws + WS_BONUS))
#define merged ((bf16_t*)(a.ws + WS_MERGED))
#define u1 ((bf16_t*)(a.ws + WS_U1))
#define cols ((bf16_t*)(a.ws + WS_COLS))
#define PR ((bf16_t*)(a.ws + WS_PR))
#define PK ((bf16_t*)(a.ws + WS_PK))
#define PA ((bf16_t*)(a.ws + WS_PA))
#define PB ((bf16_t*)(a.ws + WS_PB))
#define PV ((bf16_t*)(a.ws + WS_PV))
#define PW ((float*)(a.ws + WS_PW))
#define oraw ((float*)(a.ws + WS_ORAW))
#define hgo ((float*)(a.ws + WS_HGO))
#define U ((bf16_t*)(a.ws + WS_U))
#define Qb ((bf16_t*)(a.ws + WS_Q))
#define AO ((bf16_t*)(a.ws + WS_AO))
#define FF ((bf16_t*)(a.ws + WS_FF))
#define XIN (a.in[0])
#define OUTP (a.out)
struct Args { const float* in[29]; float* out; unsigned char* ws; int ph_lo, ph_hi; };

typedef const __attribute__((address_space(4))) Args* CArgsP;
__device__ __forceinline__ CArgsP args_fresh() { CArgsP p = (CArgsP)__builtin_amdgcn_kernarg_segment_ptr(); asm volatile("" : "+s"(p)); return p; }
__global__ void __launch_bounds__(512, 2) mega(Args a0) {
    extern __shared__ __attribute__((aligned(16))) unsigned char lds_raw[];
    LAS unsigned char* lds = (LAS unsigned char*)lds_raw;
    cg::grid_group grid = cg::this_grid();
    const int G = gridDim.x, bid = blockIdx.x, NGW = G * 8, NGT = G * 512;
#define IDS const auto& a = *args_fresh(); const int tid = tid_fresh(), lane = tid & 63, wave = __builtin_amdgcn_readfirstlane(tid >> 6), gw = bid * 8 + wave, gtid = bid * 512 + tid; (void)lane; (void)gw; (void)gtid
    const int lo = a0.ph_lo, hi = a0.ph_hi;
#ifndef MK_REP
#define MK_REP -1
#endif
#ifndef MK_REPN
#define MK_REPN 3
#endif
#define RPT(code) for (int rep_ = 0, nrep_ = (MK_REP == (code)) ? MK_REPN : 1; rep_ < nrep_; ++rep_)
#define LASTREP (rep_ == nrep_ - 1)
#define IN(k) (lo <= (k) && (k) < hi)
#define SEAM(k) do { if (IN(k) && IN((k) + 1)) RPT(120) { asm volatile("s_waitcnt vmcnt(0) lgkmcnt(0)" ::: "memory"); grid.sync(); __builtin_amdgcn_fence(__ATOMIC_ACQUIRE, "agent"); asm volatile("s_waitcnt vmcnt(0)" ::: "memory"); } } while (0)

    if (IN(0)) { IDS;
        LAS float* scr = (LAS float*)(lds + wave * 16384);
        constexpr int I_IN = 16 * 297, I_SQ = 16 * 32, I_13 = 16 * 88, I_2 = 44 * 32;
        constexpr int NITEMS = I_IN + 5 * I_SQ + 2 * I_13 + I_2;
        for (int it = gw; it < NITEMS; it += NGW) {
            int r = it;
            if (r < I_IN) { const int kb = r / 297, n0 = (r % 297) * 32; tr_item(a.in[3], 1024, 9504, WinT, kb, n0, n0 + (n0 >= 3360 ? 224 : 0), scr, lane); continue; } r -= I_IN;
            if (r < I_SQ) { tr_item(a.in[17], 1024, 1024, WoutT, r / 32, (r % 32) * 32, (r % 32) * 32, scr, lane); continue; } r -= I_SQ;
            if (r < I_SQ) { tr_item(a.in[20], 1024, 1024, WqT, r / 32, (r % 32) * 32, (r % 32) * 32, scr, lane); continue; } r -= I_SQ;
            if (r < I_SQ) { tr_item(a.in[23], 1024, 1024, WoT, r / 32, (r % 32) * 32, (r % 32) * 32, scr, lane); continue; } r -= I_SQ;
            if (r < I_SQ) { tr_item(a.in[21], 1024, 1024, WkvT, r / 32, (r % 32) * 32, (r % 32) * 32, scr, lane); continue; } r -= I_SQ;
            if (r < I_SQ) { tr_item(a.in[22], 1024, 1024, WkvT, r / 32, (r % 32) * 32, 1024 + (r % 32) * 32, scr, lane); continue; } r -= I_SQ;
            if (r < I_13) { const int n0 = (r % 88) * 32; tr_item(a.in[25], 1024, DFF, W13T, r / 88, n0, (n0 / 128) * 256 + (n0 % 128), scr, lane); continue; } r -= I_13;
            if (r < I_13) { const int n0 = (r % 88) * 32; tr_item(a.in[26], 1024, DFF, W13T, r / 88, n0, (n0 / 128) * 256 + 128 + (n0 % 128), scr, lane); continue; } r -= I_13;
            tr_item(a.in[27], DFF, 1024, W2T, r / 32, (r % 32) * 32, (r % 32) * 32, scr, lane);
        }
        for (int i = gtid; i < 28672; i += NGT) ((u32x4*)(WinT + 3360 * 1024))[i] = (u32x4){0u, 0u, 0u, 0u};
        for (int i = gtid; i < 1792; i += NGT) ((u32x4*)carry)[i] = (u32x4){0u, 0u, 0u, 0u};
        for (int n = gw; n < 1024; n += NGW) { rw2T[n * 64 + lane] = (bf16_t)f2bf(a.in[6][lane * 1024 + n]); ra2T[n * 64 + lane] = (bf16_t)f2bf(a.in[8][lane * 1024 + n]); }
        for (int m = gw; m < 512; m += NGW) {
            for (int e = lane; e < 320; e += 64) { const int n = 2 * m + (e >= 160 ? 1 : 0), k = e >= 160 ? e - 160 : e; rg2T[n * 160 + k] = (bf16_t)f2bf(a.in[9][k * 1024 + n]); } }
        for (int n = gw; n < 1024; n += NGW) { f32x4 v;
#pragma unroll
            for (int e = 0; e < 4; ++e) { const int k = 4 * lane + e; v[e] = k < 160 ? a.in[9][k * 1024 + n] : 0.f; }
            st4bf(g2Tp + n * 256 + 4 * lane, v); }
        for (int i = gtid; i < 1024; i += NGT) lbv[i] = 1.0f / (1.0f + __expf(a.in[15][1024 + i] - a.in[15][i]));
        for (int m = gw; m < 1024; m += NGW) rms_row_bf16(a.in[1] + (size_t)m * 1024, a.in[19], mbf + (size_t)m * 1024, lane);
        __syncthreads();
    }
    SEAM(0);

#pragma unroll 1
    for (int s = 0; s < NSPLIT; ++s) {
        const int pb = 1 + 5 * s;
        if (IN(pb)) { IDS;
            RPT(101) for (int lt = gw; lt < MS; lt += NGW) { const int b = lt / TS, tl = lt % TS; const size_t gt = (size_t)b * SEQ + s * TS + tl; rms_row_bf16(XIN + gt * 1024, a.in[2], u1 + (size_t)lt * 1024, lane); }
        }
        SEAM(pb);
        if (IN(pb + 1)) { const auto& a = *args_fresh();
            pg8::Gemm g{u1, WinT, MS, CL, 1024}; pg8::StaticOrder S; S.init(MS, CL, G, bid);
            pg8::EpiStoreBf16 E{cols, CL};
            RPT(102) pg8::gemm_phase<pg8::EpiStoreBf16, pg8::StaticOrder, true, true>(lds, g, S, E);
        }
        SEAM(pb + 1);
#ifndef SKIP_PREP
        if (IN(pb + 2)) { IDS; RPT(103) prep_phase(s, gw, NGW, lane, cols, carry, a.in[4], a.in[5], a.in[7], a.in[10], a.in[11], a.in[12], rw2T, ra2T, PR, PK, PA, PB, PV, PW, bonus, ASG); }
#endif
        SEAM(pb + 2);
        if (IN(pb + 3)) { IDS;
#ifdef MK_ZERO_SCAN
            for (int i = gtid; i < MS * 256; i += NGT) { ((f32x4*)oraw)[i] = (f32x4){0.f, 0.f, 0.f, 0.f}; ((f32x4*)hgo)[i] = (f32x4){0.01f, 0.02f, 0.03f, 0.04f}; }
#endif
#ifdef MK_NAIVE_RW
            rwkv_scan_naive(s, gw, NGW, lane, wave, lds, PA, PW, PB, PK, PR, PV, oraw, rwst);
#endif
#ifndef SKIP_RW
            RPT(104) { rwkv_scan(s, bid, G, tid, lane, wave, lds, PA, PW, PB, PK, PR, PV, oraw, rwst, LASTREP); __syncthreads(); }
#endif
            __syncthreads();
#ifndef SKIP_HG
            RPT(105) { hgrn_scan(s, bid, G, tid, lane, wave, lds, cols, lbv, hgo, hgst, LASTREP); __syncthreads(); }
#endif
            { pg8::Gemm g{ASG, g2Tp, MS, 1024, 256}; pg8::StaticOrder S; S.init(MS, 1024, G, bid); pg8::EpiStoreBf16 E{GATE, 1024};
              pg8::gemm_phase<pg8::EpiStoreBf16, pg8::StaticOrder, true, true>(lds, g, S, E); }
        }
        SEAM(pb + 3);
        if (IN(pb + 4)) { IDS;
#ifdef MK_NOMIX
            for (int i = gtid; i < MS * 128; i += NGT) { const int lt = i >> 7, b = lt / TS, tl = lt % TS; const size_t gt = (size_t)b * SEQ + s * TS + tl; ((u32x4*)(merged + gt * 1024))[i & 127] = (u32x4){0u, 0u, 0u, 0u}; }
#endif
#ifndef SKIP_POST
            RPT(106) post_phase(s, gw, NGW, lane, cols, carry, a.in[4], GATE, a.in[13], a.in[14], a.in[16], oraw, hgo, PV, bonus, merged);
#endif
            if (bid < 4 && s + 1 < NSPLIT) { const u32x4* src = (const u32x4*)(cols + (size_t)(bid * TS + TS - 1) * CL); u32x4* dst = (u32x4*)(carry + (((s + 1) & 1) * 4 + bid) * CARRY_LD);
                for (int i = tid; i < CARRY_LD / 8; i += 512) dst[i] = src[i]; }
        }
        SEAM(pb + 4);
    }

    if (IN(T0 + 0)) { const auto& a = *args_fresh();
        { pg8::Gemm g{merged, WoutT, NTOK, 1024, 1024}; pg8::StaticOrder S; S.init(NTOK, 1024, G, bid); pg8::EpiResF32 E{XIN, OUTP, 1024};
          pg8::gemm_phase<pg8::EpiResF32, pg8::StaticOrder, true, true>(lds, g, S, E); }
        { pg8::Gemm g{mbf, WkvT, 1024, 2048, 1024}; pg8::StaticOrder S; S.init(1024, 2048, G, bid); pg8::EpiStoreBf16 E{KV, 2048};
          pg8::gemm_phase<pg8::EpiStoreBf16, pg8::StaticOrder, true, true>(lds, g, S, E); }
    }
    SEAM(T0 + 0);
    if (IN(T0 + 1)) { IDS;
        for (int gt = gw; gt < NTOK; gt += NGW) rms_row_bf16(OUTP + (size_t)gt * 1024, a.in[18], U + (size_t)gt * 1024, lane);
        for (int i = gtid; i < 4 * 4 * 256 * 256; i += NGT) { const int kp = i & 255, dim = (i >> 8) & 255, hd = (i >> 16) & 3, b = i >> 18;
            const int k2 = kp >> 5, fq = (kp >> 3) & 3, sl = kp & 7; const int key = 32 * k2 + (sl < 4 ? 4 * fq + sl : 16 + 4 * fq + sl - 4);
            Vt[i] = KV[(size_t)(b * 256 + key) * 2048 + 1024 + hd * 256 + dim]; }
    }
    SEAM(T0 + 1);
    if (IN(T0 + 2)) { const auto& a = *args_fresh(); pg8::Gemm g{U, WqT, NTOK, 1024, 1024}; pg8::StaticOrder S; S.init(NTOK, 1024, G, bid); pg8::EpiStoreBf16 E{Qb, 1024};
        RPT(112) pg8::gemm_phase<pg8::EpiStoreBf16, pg8::StaticOrder, true, true>(lds, g, S, E); }
    SEAM(T0 + 2);
#ifndef SKIP_ATTN
    if (IN(T0 + 3)) { IDS; RPT(113) attn_phase(gw, NGW, lane, Qb, KV, Vt, AO); }
#endif
    SEAM(T0 + 3);
#ifndef MK_NOATT
    if (IN(T0 + 4)) { const auto& a = *args_fresh(); pg8::Gemm g{AO, WoT, NTOK, 1024, 1024}; pg8::StaticOrder S; S.init(NTOK, 1024, G, bid); pg8::EpiResF32 E{OUTP, OUTP, 1024};
        pg8::gemm_phase<pg8::EpiResF32, pg8::StaticOrder, true, true>(lds, g, S, E); }
#endif
    SEAM(T0 + 4);
    if (IN(T0 + 5)) { IDS; RPT(115) for (int gt = gw; gt < NTOK; gt += NGW) rms_row_bf16(OUTP + (size_t)gt * 1024, a.in[24], U + (size_t)gt * 1024, lane); }
    SEAM(T0 + 5);
    if (IN(T0 + 6)) { const auto& a = *args_fresh(); pg8::Gemm g{U, W13T, NTOK, 2 * DFF, 1024}; pg8::StaticOrder S; S.init(NTOK, 2 * DFF, G, bid); pg8::EpiSwiGLU E{FF, DFF};
        RPT(116) pg8::gemm_phase<pg8::EpiSwiGLU, pg8::StaticOrder, true, true>(lds, g, S, E); }
    SEAM(T0 + 6);
    if (IN(T0 + 7)) { const auto& a = *args_fresh(); pg8::Gemm g{FF, W2T, NTOK, 1024, DFF}; pg8::StaticOrder S; S.init(NTOK, 1024, G, bid); pg8::EpiResF32 E{OUTP, OUTP, 1024};
        pg8::gemm_phase<pg8::EpiResF32, pg8::StaticOrder, true, true>(lds, g, S, E); }
    SEAM(T0 + 7);
    if (IN(T0 + 8)) { IDS;
        const float* gf = a.in[28];
        for (int gt = gw; gt < NTOK; gt += NGW) { f32x4* row = (f32x4*)(OUTP + (size_t)gt * 1024); f32x4 v[4]; float sq = 0.f;
#pragma unroll
            for (int j = 0; j < 4; ++j) { v[j] = row[lane + 64 * j]; sq += (v[j][0] * v[j][0] + v[j][1] * v[j][1]) + (v[j][2] * v[j][2] + v[j][3] * v[j][3]); }
            const float rs = 1.0f / sqrtf(wave_sum(sq) * (1.0f / 1024.0f) + 1e-6f);
#pragma unroll
            for (int j = 0; j < 4; ++j) row[lane + 64 * j] = v[j] * rs * ((const f32x4*)gf)[lane + 64 * j]; }
    }
#undef IN
#undef SEAM
}

#ifndef MK_MULTI
#define MK_MULTI 0
#endif
extern "C" void kernel_launch(void* const* d_in, const int* in_sizes, int n_in, void* d_out, int out_size, void* d_ws, size_t ws_size, hipStream_t stream) {
    static int grid = 0;
    if (grid == 0) {
        if (n_in != 29 || in_sizes[0] != NTOK * D || out_size != NTOK * D || ws_size < WS_END) { fprintf(stderr, "kernel_launch: unexpected shapes / workspace (%d inputs, ws %zu)\n", n_in, ws_size); grid = -1; return; }
        int dev = 0, cus = 0, per_cu = 0;
        hipGetDevice(&dev); hipDeviceGetAttribute(&cus, hipDeviceAttributeMultiprocessorCount, dev);
        hipFuncSetAttribute((const void*)mega, hipFuncAttributeMaxDynamicSharedMemorySize, LDS_BYTES);
        hipOccupancyMaxActiveBlocksPerMultiprocessor(&per_cu, (const void*)mega, 512, LDS_BYTES);
        (void)hipGetLastError();
        if (per_cu < 1) per_cu = 1;
        grid = cus;
    }
    if (grid < 0) return;
    Args a{};
    for (int i = 0; i < 29; ++i) a.in[i] = (const float*)d_in[i];
    a.out = (float*)d_out; a.ws = (unsigned char*)d_ws;
    void* args[] = {&a};
#if MK_MULTI
    for (int ph = 0; ph < N_PHASES; ++ph) { a.ph_lo = ph; a.ph_hi = ph + 1; hipLaunchCooperativeKernel((const void*)mega, dim3(grid), dim3(512), args, LDS_BYTES, stream); }
#else
    a.ph_lo = 0; a.ph_hi = N_PHASES;
    hipError_t e = hipLaunchCooperativeKernel((const void*)mega, dim3(grid), dim3(512), args, LDS_BYTES, stream);
    if (e != hipSuccess) fprintf(stderr, "cooperative launch failed: %s (grid %d)\n", hipGetErrorString(e), grid);
#endif
}
```

```cpp
#include <hip/hip_runtime.h>
#include <hip/hip_cooperative_groups.h>
#include <cstdint>
#include <cstdio>
namespace cg = cooperative_groups;
namespace pg8 {
#define PG8_LAS __attribute__((address_space(3)))
typedef unsigned short bf16_t;
typedef short bf16x8 __attribute__((ext_vector_type(8)));
typedef float f32x4 __attribute__((ext_vector_type(4)));
typedef unsigned u32x4 __attribute__((ext_vector_type(4)));
constexpr int BM = 256, BK = 64, HALF = 128, HTB = HALF * BK * 2  , STAGE_BYTES = 8 * HTB, NXCD = 8, WGM = 8;

__host__ __device__ __forceinline__ int lds_byte(int r, int c) { const int st = (r >> 4) * 2 + (c >> 5), rr = r & 15, cc = c & 31, ob = rr * 64 + cc * 2; return st * 1024 + (ob ^ (((ob >> 9) & 1) << 5)); }
__host__ __device__ __forceinline__ void stage_rc(int b, int& R, int& C) { const int st = b / 1024, sb = b % 1024, swz = sb ^ (((sb >> 9) & 1) << 5); R = (st >> 1) * 16 + swz / 64; C = (st & 1) * 32 + (swz % 64) / 2; }
__host__ __device__ __forceinline__ int perm32(int rho) { const int n = rho >> 4, i = rho & 15; return 8 * (i >> 2) + 4 * n + (i & 3); }

struct Unit { int pm, pn; };
struct Gemm { const bf16_t* A; const bf16_t* Bt; int M, N, K; };

struct StaticOrder {
    int nM, nN, nwg, G, c;
    __host__ __device__ void init(int M, int N, int G_, int c_) { nM = M / BM; nN = N / BM; nwg = nM * nN; G = G_; c = c_; }
    __host__ __device__ bool next(int i, Unit& u) const {
        const long L = (long)i * G + c; if (L >= nwg) return false;
        int wgid = (int)L; { const int q = nwg / NXCD, r = nwg % NXCD, xcd = wgid % NXCD, off = wgid / NXCD; wgid = (xcd < r ? xcd * (q + 1) : r * (q + 1) + (xcd - r) * q) + off; }
        const int nig = WGM * nN, gid = wgid / nig, fm = gid * WGM, gsz = (nM - fm) < WGM ? (nM - fm) : WGM;
        u.pm = fm + ((wgid % nig) % gsz); u.pn = (wgid % nig) / gsz; return true;
    }
    __device__ __forceinline__ void a_ready(const Unit&) const {}
    __device__ __forceinline__ void done(const Unit&) const {}
};

__device__ __forceinline__ unsigned cvt_pk_bf16(float lo, float hi) { unsigned r; asm volatile("v_cvt_pk_bf16_f32 %0, %1, %2" : "=v"(r) : "v"(lo), "v"(hi)); return r; }
__device__ __forceinline__ float fast_sigmoid(float x) { return __builtin_amdgcn_rcpf(1.0f + __expf(-x)); }
__device__ __forceinline__ float fast_silu(float x) { return x * fast_sigmoid(x); }
struct EpiStoreBf16 {
    static constexpr bool PERM = true, AFTER_DRAIN = false;
    bf16_t* O; int ldc;
    __device__ __forceinline__ void operator()(const f32x4 (&acc)[2][2][4][2], const Unit& u, int wr, int wc, int fr, int fq) const {
        const int row0 = u.pm * BM + wr * 64 + fr, col0 = u.pn * BM + wc * 32 + 8 * fq;
#pragma unroll
        for (int ai = 0; ai < 2; ++ai)
#pragma unroll
            for (int m = 0; m < 4; ++m) { bf16_t* rowp = O + (size_t)(row0 + ai * HALF + m * 16) * ldc + col0;
#pragma unroll
                for (int bj = 0; bj < 2; ++bj) { const f32x4 v0 = acc[ai][bj][m][0], v1 = acc[ai][bj][m][1];
                    u32x4 w; w.x = cvt_pk_bf16(v0[0], v0[1]); w.y = cvt_pk_bf16(v0[2], v0[3]); w.z = cvt_pk_bf16(v1[0], v1[1]); w.w = cvt_pk_bf16(v1[2], v1[3]);
                    *(u32x4*)(rowp + bj * HALF) = w; } }
    }
};
struct EpiResF32 {
    static constexpr bool PERM = true, AFTER_DRAIN = false;
    const float* base; float* out; int ldc;
    __device__ __forceinline__ void operator()(const f32x4 (&acc)[2][2][4][2], const Unit& u, int wr, int wc, int fr, int fq) const {
        const int row0 = u.pm * BM + wr * 64 + fr, col0 = u.pn * BM + wc * 32 + 8 * fq;
#pragma unroll
        for (int ai = 0; ai < 2; ++ai)
#pragma unroll
            for (int m = 0; m < 4; ++m) { const size_t off = (size_t)(row0 + ai * HALF + m * 16) * ldc + col0;
#pragma unroll
                for (int bj = 0; bj < 2; ++bj)
#pragma unroll
                    for (int n = 0; n < 2; ++n) { const size_t p = off + bj * HALF + 4 * n; const f32x4 b = *(const f32x4*)(base + p); *(f32x4*)(out + p) = b + acc[ai][bj][m][n]; } }
    }
};
struct EpiSwiGLU {
    static constexpr bool PERM = true, AFTER_DRAIN = false;
    bf16_t* O; int ldc;
    __device__ __forceinline__ void operator()(const f32x4 (&acc)[2][2][4][2], const Unit& u, int wr, int wc, int fr, int fq) const {
        const int row0 = u.pm * BM + wr * 64 + fr, col0 = u.pn * HALF + wc * 32 + 8 * fq;
#pragma unroll
        for (int ai = 0; ai < 2; ++ai)
#pragma unroll
            for (int m = 0; m < 4; ++m) { bf16_t* rowp = O + (size_t)(row0 + ai * HALF + m * 16) * ldc + col0;
                f32x4 v0, v1;
#pragma unroll
                for (int j = 0; j < 4; ++j) { v0[j] = fast_silu(acc[ai][0][m][0][j]) * acc[ai][1][m][0][j]; v1[j] = fast_silu(acc[ai][0][m][1][j]) * acc[ai][1][m][1][j]; }
                u32x4 w; w.x = cvt_pk_bf16(v0[0], v0[1]); w.y = cvt_pk_bf16(v0[2], v0[3]); w.z = cvt_pk_bf16(v1[0], v1[1]); w.w = cvt_pk_bf16(v1[2], v1[3]);
                *(u32x4*)rowp = w; }
    }
};
template <class Epi, class Sched, bool ALIGN_EPI = false, bool SP2 = false>
__device__ __forceinline__ void gemm_phase(PG8_LAS unsigned char* lds, const Gemm g, const Sched& S, const Epi& E) {
    int tid = threadIdx.x; asm volatile("" : "+v"(tid));
    const int wid = __builtin_amdgcn_readfirstlane(tid >> 6), lane = tid & 63, wr = wid >> 2, wc = wid & 3, fr = lane & 15, fq = lane >> 4;
    const int K = g.K, nt = K / BK;
    unsigned voffA[2], voffB[2];
#pragma unroll
    for (int i = 0; i < 2; ++i) { int R, C; stage_rc(tid * 16 + i * 8192, R, C); const int Rb = Epi::PERM ? ((R & ~31) + perm32(R & 31)) : R;
        voffA[i] = (unsigned)(R * K + C) * 2u; voffB[i] = (unsigned)(Rb * K + C) * 2u; }
    const size_t kstep = (size_t)(BK * 2);
    const size_t hstep = (size_t)HALF * K * 2;
    const size_t tstep = 2 * hstep;
    const unsigned ldsw = (unsigned)wid * 1024u;
    const int aoff = lds_byte(wr * 64 + fr, fq * 8), boff = lds_byte(wc * 32 + fr, fq * 8);
#define PG8_SA(b, h) (((b) * 2 + (h)) * HTB)
#define PG8_SB(b, h) ((4 + (b) * 2 + (h)) * HTB)
#define PG8_STAGE(bufoff, gbase, voff) do { _Pragma("unroll") for (int _i = 0; _i < 2; ++_i) \
        __builtin_amdgcn_global_load_lds((const unsigned*)((const char*)(gbase) + (voff)[_i]), (PG8_LAS unsigned*)(lds + (bufoff) + ldsw + _i * 8192), 16, 0, 0); } while (0)
#define PG8_LDA(dst, b, h) do { _Pragma("unroll") for (int m = 0; m < 4; ++m) _Pragma("unroll") for (int k = 0; k < 2; ++k) dst[m][k] = *(const PG8_LAS bf16x8*)(lds + PG8_SA(b, h) + aoff + m * 2048 + k * 1024); } while (0)
#define PG8_LDB(dst, b, h) do { _Pragma("unroll") for (int n = 0; n < 2; ++n) _Pragma("unroll") for (int k = 0; k < 2; ++k) dst[n][k] = *(const PG8_LAS bf16x8*)(lds + PG8_SB(b, h) + boff + n * 2048 + k * 1024); } while (0)
#define PG8_MMA(ai, bj, At, Bt) do { __builtin_amdgcn_s_setprio(1); _Pragma("unroll") for (int m = 0; m < 4; ++m) _Pragma("unroll") for (int n = 0; n < 2; ++n) _Pragma("unroll") for (int k = 0; k < 2; ++k) \
        acc[ai][bj][m][n] = __builtin_amdgcn_mfma_f32_16x16x32_bf16(Bt[n][k], At[m][k], acc[ai][bj][m][n], 0, 0, 0); __builtin_amdgcn_s_setprio(0); } while (0)
#define PG8_WAIT_V(n) asm volatile("s_waitcnt vmcnt(" #n ")" ::: "memory")
#define PG8_WAIT_L(n) asm volatile("s_waitcnt lgkmcnt(" #n ")" ::: "memory")
#define PG8_BAR __builtin_amdgcn_s_barrier()
#define PG8_SCHED __builtin_amdgcn_sched_barrier(0)
    Unit cur, nxt; int ui = 0;
    if (!S.next(0, cur)) return;
    f32x4 acc[2][2][4][2];
#pragma unroll
    for (int a = 0; a < 2; ++a)
#pragma unroll
        for (int b = 0; b < 2; ++b)
#pragma unroll
            for (int m = 0; m < 4; ++m)
#pragma unroll
                for (int n = 0; n < 2; ++n) acc[a][b][m][n] = (f32x4){0.f, 0.f, 0.f, 0.f};
    bf16x8 At[4][2], B0[2][2], B1[2][2];
    const char* cA = (const char*)g.A + (size_t)cur.pm * tstep; const char* cB = (const char*)g.Bt + (size_t)cur.pn * tstep;
    S.a_ready(cur);
    if constexpr (SP2) {
        PG8_STAGE(PG8_SB(0, 0), cB, voffB); PG8_STAGE(PG8_SB(0, 1), cB + hstep, voffB); PG8_STAGE(PG8_SA(0, 0), cA, voffA); PG8_STAGE(PG8_SA(0, 1), cA + hstep, voffA);
        if (wr == 1) PG8_BAR;
        PG8_WAIT_V(2); PG8_BAR;
        PG8_STAGE(PG8_SB(1, 0), cB + kstep, voffB); PG8_STAGE(PG8_SA(1, 0), cA + kstep, voffA); PG8_STAGE(PG8_SB(1, 1), cB + hstep + kstep, voffB);
        PG8_WAIT_V(6); PG8_BAR;
    } else {
        PG8_STAGE(PG8_SB(0, 0), cB, voffB); PG8_STAGE(PG8_SA(0, 0), cA, voffA); PG8_STAGE(PG8_SB(0, 1), cB + hstep, voffB); PG8_STAGE(PG8_SA(0, 1), cA + hstep, voffA);
        if (wr == 1) PG8_BAR;
        PG8_WAIT_V(4); PG8_BAR;
        PG8_STAGE(PG8_SB(1, 0), cB + kstep, voffB); PG8_STAGE(PG8_SA(1, 0), cA + kstep, voffA); PG8_STAGE(PG8_SB(1, 1), cB + hstep + kstep, voffB);
        PG8_WAIT_V(6); PG8_BAR;
    }
    for (;;) {
        const bool has_next = S.next(ui + 1, nxt);
        const char* nA = has_next ? (const char*)g.A + (size_t)nxt.pm * tstep : cA; const char* nB = has_next ? (const char*)g.Bt + (size_t)nxt.pn * tstep : cB;
        for (int t = 0; t < nt; t += 2) {
            const bool last = (t == nt - 2);
            const char* a1 = cA + (size_t)(t + 1) * kstep;
            const char* a2 = last ? nA : cA + (size_t)(t + 2) * kstep; const char* b2 = last ? nB : cB + (size_t)(t + 2) * kstep;
            const char* a3 = a2 + kstep; const char* b3 = b2 + kstep;
            if (last && has_next) S.a_ready(nxt);
            if constexpr (SP2) {
            PG8_LDB(B0, 0, 0); PG8_LDB(B1, 0, 1); PG8_SCHED; PG8_LDA(At, 0, 0); PG8_STAGE(PG8_SA(1, 1), a1 + hstep, voffA);
            PG8_WAIT_V(8); PG8_WAIT_L(0); PG8_BAR; PG8_MMA(0, 0, At, B0); PG8_MMA(0, 1, At, B1); PG8_BAR; PG8_SCHED;
            PG8_LDA(At, 0, 1); PG8_STAGE(PG8_SB(0, 0), b2, voffB); PG8_STAGE(PG8_SB(0, 1), b2 + hstep, voffB); PG8_STAGE(PG8_SA(0, 0), a2, voffA);
            PG8_WAIT_V(8); PG8_WAIT_L(0); PG8_BAR; PG8_MMA(1, 0, At, B0); PG8_MMA(1, 1, At, B1); PG8_BAR; PG8_SCHED;
            PG8_LDB(B0, 1, 0); PG8_LDB(B1, 1, 1); PG8_SCHED; PG8_LDA(At, 1, 0); PG8_STAGE(PG8_SA(0, 1), a2 + hstep, voffA);
            PG8_WAIT_V(8); PG8_WAIT_L(0); PG8_BAR; PG8_MMA(0, 0, At, B0); PG8_MMA(0, 1, At, B1); PG8_BAR; PG8_SCHED;
            PG8_LDA(At, 1, 1); PG8_STAGE(PG8_SB(1, 0), b3, voffB); PG8_STAGE(PG8_SB(1, 1), b3 + hstep, voffB); PG8_STAGE(PG8_SA(1, 0), a3, voffA);
            PG8_WAIT_V(8); PG8_WAIT_L(0); PG8_BAR; PG8_MMA(1, 0, At, B0); PG8_MMA(1, 1, At, B1); PG8_BAR; PG8_SCHED;
            } else {
            PG8_LDB(B0, 0, 0); PG8_SCHED; PG8_LDA(At, 0, 0); PG8_STAGE(PG8_SA(1, 1), a1 + hstep, voffA);
            PG8_WAIT_L(8); PG8_BAR; PG8_WAIT_L(0); PG8_MMA(0, 0, At, B0); PG8_BAR; PG8_SCHED;
            PG8_LDB(B1, 0, 1); PG8_STAGE(PG8_SB(0, 0), b2, voffB);
            PG8_BAR; PG8_WAIT_L(0); PG8_MMA(0, 1, At, B1); PG8_BAR;
            PG8_LDA(At, 0, 1); PG8_STAGE(PG8_SA(0, 0), a2, voffA);
            PG8_BAR; PG8_WAIT_L(0); PG8_MMA(1, 0, At, B0); PG8_BAR; PG8_SCHED;
            PG8_STAGE(PG8_SB(0, 1), b2 + hstep, voffB);
            PG8_WAIT_V(6); PG8_BAR; PG8_MMA(1, 1, At, B1); PG8_BAR;
            PG8_LDB(B0, 1, 0); PG8_SCHED; PG8_LDA(At, 1, 0); PG8_STAGE(PG8_SA(0, 1), a2 + hstep, voffA);
            PG8_WAIT_L(8); PG8_BAR; PG8_WAIT_L(0); PG8_MMA(0, 0, At, B0); PG8_BAR; PG8_SCHED;
            PG8_LDB(B1, 1, 1); PG8_STAGE(PG8_SB(1, 0), b3, voffB);
            PG8_BAR; PG8_WAIT_L(0); PG8_MMA(0, 1, At, B1); PG8_BAR;
            PG8_LDA(At, 1, 1); PG8_STAGE(PG8_SA(1, 0), a3, voffA);
            PG8_BAR; PG8_WAIT_L(0); PG8_MMA(1, 0, At, B0); PG8_BAR; PG8_SCHED;
            PG8_STAGE(PG8_SB(1, 1), b3 + hstep, voffB);
            PG8_WAIT_V(6); PG8_BAR; PG8_MMA(1, 1, At, B1); PG8_BAR;
            }
        }
        if constexpr (ALIGN_EPI) { if (wr == 0) PG8_BAR; }
        if constexpr (!Epi::AFTER_DRAIN) { E(acc, cur, wr, wc, fr, fq); S.done(cur); }
        if (!has_next) break;
#pragma unroll
        for (int a = 0; a < 2; ++a)
#pragma unroll
            for (int b = 0; b < 2; ++b)
#pragma unroll
                for (int m = 0; m < 4; ++m)
#pragma unroll
                    for (int n = 0; n < 2; ++n) acc[a][b][m][n] = (f32x4){0.f, 0.f, 0.f, 0.f};
        cur = nxt; cA = nA; cB = nB; ++ui;
        if constexpr (ALIGN_EPI) { if (wr == 1) PG8_BAR; }
    }
    PG8_WAIT_V(0);
    if constexpr (!ALIGN_EPI) { if (wr == 0) PG8_BAR; }
    PG8_BAR;
    if constexpr (Epi::AFTER_DRAIN) { E.fused(acc, cur, wr, wc, fr, fq, lds, wid, lane); S.done(cur); }
#undef PG8_SA
#undef PG8_SB
#undef PG8_STAGE
#undef PG8_LDA
#undef PG8_LDB
#undef PG8_MMA
#undef PG8_WAIT_V
#undef PG8_WAIT_L
#undef PG8_BAR
#undef PG8_SCHED
}
}

#define LAS __attribute__((address_space(3)))
typedef pg8::bf16_t bf16_t;
typedef pg8::bf16x8 bf16x8;
typedef pg8::f32x4 f32x4;
typedef pg8::u32x4 u32x4;
typedef unsigned u32x2 __attribute__((ext_vector_type(2)));
typedef float f32x2v __attribute__((ext_vector_type(2)));
using pg8::cvt_pk_bf16;
using pg8::fast_sigmoid;
using pg8::fast_silu;

constexpr int D = 1024, NB = 4, SEQ = 8192, NTOK = NB * SEQ;
#ifndef MK_NSPLIT
#define MK_NSPLIT 4
#endif
constexpr int NSPLIT = MK_NSPLIT, TS = SEQ / NSPLIT, MS = NB * TS;
constexpr int CL = 9728;
constexpr int C_R = 0, C_K = 1024, C_V = 2048, C_WLO = 3072, C_ALO = 3136, C_GLO = 3200, C_HQ = 3584, C_HF = 4608, C_HI = 5632, C_HG = 6656, C_GA = 7680, C_GB = 8704;
constexpr int CARRY_LD = 3584;
constexpr int DFF = 2816;
constexpr size_t MiB = 1u << 20, KiB = 1u << 10;
constexpr size_t WS_WIN = 0, WS_WOUT = 19 * MiB, WS_WQ = 21 * MiB, WS_WO = 23 * MiB, WS_WKV = 25 * MiB, WS_W13 = 29 * MiB, WS_W2 = 40 * MiB;
constexpr size_t WS_RW2T = 46 * MiB, WS_RA2T = 46 * MiB + 128 * KiB, WS_RG2T = 46 * MiB + 256 * KiB, WS_CARRY = 46 * MiB + 640 * KiB, WS_LB = 46 * MiB + 704 * KiB;
constexpr size_t WS_MBF = 47 * MiB, WS_KV = 49 * MiB, WS_VT = 53 * MiB, WS_RWST = 55 * MiB, WS_HGST = 56 * MiB, WS_BONUS = 58 * MiB;
constexpr size_t WS_G2TP = 59 * MiB;
constexpr size_t WS_MERGED = 64 * MiB;
constexpr size_t WS_U1 = 128 * MiB, WS_COLS = 144 * MiB, WS_PR = 296 * MiB, WS_PK = 312 * MiB, WS_PA = 328 * MiB, WS_PB = 344 * MiB, WS_PV = 360 * MiB, WS_PW = 376 * MiB, WS_ORAW = 408 * MiB, WS_HGO = 440 * MiB;
constexpr size_t WS_GATE = 472 * MiB, WS_ASG = 488 * MiB;
constexpr size_t WS_U = 128 * MiB, WS_Q = 192 * MiB, WS_AO = 256 * MiB, WS_FF = 320 * MiB, WS_CTL = 496 * MiB, CTL_BYTES = 64 * KiB, WS_END = 496 * MiB + 64 * KiB;
constexpr int LDS_BYTES = 147456, MISC_OFF = 131072 + 320;
constexpr int T0 = 1 + 5 * NSPLIT, N_PHASES = T0 + 9;

__device__ __forceinline__ float bflo(unsigned u) { return __uint_as_float(u << 16); }
__device__ __forceinline__ float bfhi(unsigned u) { return __uint_as_float(u & 0xffff0000u); }
__device__ __forceinline__ unsigned f2bf(float f) { unsigned u = __float_as_uint(f); return (u + 0x7fffu + ((u >> 16) & 1u)) >> 16; }
__device__ __forceinline__ f32x4 ld4bf(const bf16_t* p) { const u32x2 u = *(const u32x2*)p; return (f32x4){bflo(u.x), bfhi(u.x), bflo(u.y), bfhi(u.y)}; }
__device__ __forceinline__ void ld8bf(const bf16_t* p, float (&o)[8]) { const u32x4 u = *(const u32x4*)p; o[0] = bflo(u.x); o[1] = bfhi(u.x); o[2] = bflo(u.y); o[3] = bfhi(u.y); o[4] = bflo(u.z); o[5] = bfhi(u.z); o[6] = bflo(u.w); o[7] = bfhi(u.w); }
__device__ __forceinline__ void st4bf(bf16_t* p, f32x4 v) { u32x2 w; w.x = cvt_pk_bf16(v[0], v[1]); w.y = cvt_pk_bf16(v[2], v[3]); *(u32x2*)p = w; }
__device__ __forceinline__ bf16x8 pack8(const float (&t)[8]) { u32x4 w; w.x = cvt_pk_bf16(t[0], t[1]); w.y = cvt_pk_bf16(t[2], t[3]); w.z = cvt_pk_bf16(t[4], t[5]); w.w = cvt_pk_bf16(t[6], t[7]); return __builtin_bit_cast(bf16x8, w); }
__device__ __forceinline__ float tanh_fast(float x) { return 1.0f - 2.0f * __builtin_amdgcn_rcpf(1.0f + __expf(2.0f * x)); }
__device__ __forceinline__ float wave_sum(float v) {
#pragma unroll
    for (int o = 1; o < 64; o <<= 1) v += __shfl_xor(v, o);
    return v;
}
__device__ __forceinline__ float fq_sum(float v) { v += __shfl_xor(v, 16); v += __shfl_xor(v, 32); return v; }
template <int CTRL> __device__ __forceinline__ float dpp_add(float x) { return x + __builtin_bit_cast(float, __builtin_amdgcn_update_dpp(0, __builtin_bit_cast(int, x), CTRL, 0xf, 0xf, false)); }
#ifdef MK_SHFL_REDUCE
__device__ __forceinline__ float allreduce16(float x) { x += __shfl_xor(x, 1); x += __shfl_xor(x, 2); x += __shfl_xor(x, 4); x += __shfl_xor(x, 8); return x; }
#else
__device__ __forceinline__ float allreduce16(float x) { x = dpp_add<0xB1>(x); x = dpp_add<0x4E>(x); x = dpp_add<0x141>(x); x = dpp_add<0x140>(x); return x; }
#endif
#define MFMA16(a, b, c) __builtin_amdgcn_mfma_f32_16x16x32_bf16((a), (b), (c), 0, 0, 0)

#define XB_TMO      128
#define XB_XCNT(j)  (256  + 64 * (j))
#define XB_XSUB(j)  (1280 + 64 * (j))
#define XB_XGEN(j)  (2304 + 64 * (j))
#define XB_TOP      3328
#define XB_TOPGEN   3392
#define XCD_BAR_WORDS 3456
#define XB_SPIN_CAP (1u << 18)

__device__ __forceinline__ unsigned xb_ld(unsigned* p)              { return __hip_atomic_load(p, __ATOMIC_RELAXED, __HIP_MEMORY_SCOPE_AGENT); }
__device__ __forceinline__ unsigned xb_add(unsigned* p, unsigned v) { return __hip_atomic_fetch_add(p, v, __ATOMIC_RELAXED, __HIP_MEMORY_SCOPE_AGENT); }
__device__ __forceinline__ unsigned xb_xcc_id() { return (unsigned)__builtin_amdgcn_s_getreg((3 << 11) | 20) & 0xFu; }
#define XB_SPIN(cond, bar) do { unsigned _sp = 0; while (cond) { __builtin_amdgcn_s_sleep(1); \
    if ((++_sp & 255u) == 0u) { if (xb_ld(&(bar)[XB_TMO])) break; if (_sp > XB_SPIN_CAP) { atomicAdd(&(bar)[XB_TMO], 1u); break; } } } } while (0)

struct XcdBarrier {
    unsigned* bar; unsigned x;
    volatile LAS unsigned* st;
};

__device__ __forceinline__ XcdBarrier xcd_barrier_post(unsigned* bar, volatile LAS unsigned* st) {
    XcdBarrier b; b.bar = bar; b.x = xb_xcc_id(); b.st = st;
    if (threadIdx.x == 0) (void)xb_add(&bar[XB_XCNT(b.x)], 1u);
    return b;
}
__device__ __forceinline__ void xcd_barrier_complete(unsigned* bar, unsigned x, unsigned& nloc, unsigned& nx) {
    const unsigned G = gridDim.x * gridDim.y * gridDim.z;
    unsigned sum, cnt, mine, sp = 0u;
    for (;;) {
        sum = 0u; cnt = 0u; mine = 0u;
#pragma unroll
        for (unsigned j = 0; j < 16; ++j) { const unsigned c = xb_ld(&bar[XB_XCNT(j)]); sum += c; cnt += (c > 0u) ? 1u : 0u; mine = (j == x) ? c : mine; }
        if (sum == G) break;
        __builtin_amdgcn_s_sleep(1);
        if ((++sp & 255u) == 0u) { if (xb_ld(&bar[XB_TMO])) break; if (sp > XB_SPIN_CAP) { atomicAdd(&bar[XB_TMO], 1u); break; } }
    }
    nloc = mine > 0u ? mine : 1u; nx = cnt > 0u ? cnt : 1u;
}

__device__ __forceinline__ void xcd_barrier(const XcdBarrier& b) {
    asm volatile("s_waitcnt vmcnt(0)" ::: "memory");
    __syncthreads();
    if (threadIdx.x == 0) {
        unsigned* bar = b.bar;
        __builtin_amdgcn_s_waitcnt(0);
        unsigned nloc = b.st[0], nx = b.st[1];
        if (nloc == 0u) { xcd_barrier_complete(bar, b.x, nloc, nx); b.st[0] = nloc; b.st[1] = nx; }
        const unsigned old = xb_add(&bar[XB_XSUB(b.x)], 1u);
        const unsigned gen = old / nloc;
        if (old + 1u == (gen + 1u) * nloc) {
            __builtin_amdgcn_fence(__ATOMIC_RELEASE, "agent");
            asm volatile("s_waitcnt vmcnt(0)" ::: "memory");
            const unsigned og = xb_add(&bar[XB_TOP], 1u);
            const unsigned tg = og / nx;
            if (og + 1u == (tg + 1u) * nx) xb_add(&bar[XB_TOPGEN], 1u);
            else XB_SPIN(xb_ld(&bar[XB_TOPGEN]) == tg, bar);
            __builtin_amdgcn_fence(__ATOMIC_ACQUIRE, "agent");
            xb_add(&bar[XB_XGEN(b.x)], 1u);
            asm volatile("s_waitcnt vmcnt(0)" ::: "memory");
        } else {
            XB_SPIN(xb_ld(&bar[XB_XGEN(b.x)]) == gen, bar);
            __builtin_amdgcn_fence(__ATOMIC_ACQUIRE, "agent");
            asm volatile("s_waitcnt vmcnt(0)" ::: "memory");
        }
    }
    __syncthreads();
}

__device__ __forceinline__ void rms_row_bf16(const float* src, const float* g, bf16_t* dst, int lane) {
    f32x4 v[4]; float s = 0.f;
#pragma unroll
    for (int j = 0; j < 4; ++j) { v[j] = ((const f32x4*)src)[lane + 64 * j]; s += (v[j][0] * v[j][0] + v[j][1] * v[j][1]) + (v[j][2] * v[j][2] + v[j][3] * v[j][3]); }
    const float rs = 1.0f / sqrtf(wave_sum(s) * (1.0f / 1024.0f) + 1e-6f);
#pragma unroll
    for (int j = 0; j < 4; ++j) { const f32x4 gv = ((const f32x4*)g)[lane + 64 * j]; st4bf(dst + 4 * (lane + 64 * j), v[j] * rs * gv); }
}
__device__ __forceinline__ void tr_item(const float* W, int K, int N, bf16_t* WT, int kb, int n0, int row_base, LAS float* scr, int lane) {
    const int k0 = 64 * kb;
#pragma unroll 8
    for (int i = 0; i < 32; ++i) { const int kk = 2 * i + (lane >> 5); scr[kk * 33 + (lane & 31)] = W[(size_t)(k0 + kk) * N + n0 + (lane & 31)]; }
    asm volatile("s_waitcnt lgkmcnt(0)" ::: "memory");
    const int c = lane & 7;
#pragma unroll
    for (int j = 0; j < 4; ++j) { const int n = (lane >> 3) + 8 * j; const LAS float* sp = scr + (8 * c) * 33 + n;
        u32x4 o; o.x = cvt_pk_bf16(sp[0 * 33], sp[1 * 33]); o.y = cvt_pk_bf16(sp[2 * 33], sp[3 * 33]); o.z = cvt_pk_bf16(sp[4 * 33], sp[5 * 33]); o.w = cvt_pk_bf16(sp[6 * 33], sp[7 * 33]);
        *(u32x4*)(WT + (size_t)(row_base + n) * K + k0 + 8 * c) = o; }
    asm volatile("s_waitcnt lgkmcnt(0)" ::: "memory");
}

__device__ __forceinline__ void prep_phase(int s, int gw, int NGW, int lane, const bf16_t* cols, const bf16_t* carry,
        const float* mu, const float* w0, const float* a0, const float* k_k, const float* k_a, const float* r_k,
        const bf16_t* w2T, const bf16_t* a2T, bf16_t* PR, bf16_t* PK, bf16_t* PA, bf16_t* PB, bf16_t* PV, float* PW, float* bonus, bf16_t* ASG) {
    const int fr = lane & 15, fq = lane >> 4;
    for (int item = gw; item < (MS / 16) * 4; item += NGW) {
        const int tile = item >> 2, hg4 = item & 3;
        const int lt = tile * 16 + fr, b = lt / TS, tl = lt % TS;
        const bf16_t* crow = cols + (size_t)lt * CL;
        const bf16_t* prow = tl > 0 ? crow - CL : carry + ((s & 1) * 4 + b) * CARRY_LD;
        bf16x8 Aw[2], Aa[2];
#pragma unroll
        for (int ks = 0; ks < 2; ++ks) {
            { const int c = C_WLO + ks * 32 + fq * 8; float cur[8], prv[8], t[8]; ld8bf(crow + c, cur); ld8bf(prow + c, prv);
              const f32x4 m0 = *(const f32x4*)(mu + c), m1 = *(const f32x4*)(mu + c + 4);
#pragma unroll
              for (int e = 0; e < 8; ++e) { const float mm = e < 4 ? m0[e & 3] : m1[e & 3]; t[e] = tanh_fast(cur[e] + mm * (prv[e] - cur[e])); }
              Aw[ks] = pack8(t); }
            { const int c = C_ALO + ks * 32 + fq * 8; float cur[8], prv[8], t[8]; ld8bf(crow + c, cur); ld8bf(prow + c, prv);
              const f32x4 m0 = *(const f32x4*)(mu + c), m1 = *(const f32x4*)(mu + c + 4);
#pragma unroll
              for (int e = 0; e < 8; ++e) { const float mm = e < 4 ? m0[e & 3] : m1[e & 3]; t[e] = cur[e] + mm * (prv[e] - cur[e]); }
              Aa[ks] = pack8(t); }
        }
        if (hg4 == 0) {
#pragma unroll
            for (int ks = 0; ks < 5; ++ks) { const int c = C_GLO + ks * 32 + fq * 8; float cur[8], prv[8], t[8]; ld8bf(crow + c, cur); ld8bf(prow + c, prv);
                const f32x4 m0 = *(const f32x4*)(mu + c), m1 = *(const f32x4*)(mu + c + 4);
#pragma unroll
                for (int e = 0; e < 8; ++e) { const float mm = e < 4 ? m0[e & 3] : m1[e & 3]; t[e] = fast_sigmoid(cur[e] + mm * (prv[e] - cur[e])); }
                *(bf16x8*)(ASG + (size_t)lt * 256 + ks * 32 + fq * 8) = pack8(t); }
#pragma unroll
            for (int ks = 5; ks < 8; ++ks) *(u32x4*)(ASG + (size_t)lt * 256 + ks * 32 + fq * 8) = (u32x4){0u, 0u, 0u, 0u};
        }
#pragma unroll 1
        for (int hh = 0; hh < 4; ++hh) {
            const int h = hg4 * 4 + hh;
            f32x4 aw[4], aa[4];
#pragma unroll
            for (int nt = 0; nt < 4; ++nt) { aw[nt] = (f32x4){0.f, 0.f, 0.f, 0.f}; aa[nt] = (f32x4){0.f, 0.f, 0.f, 0.f};
                const int n = h * 64 + nt * 16 + fr;
#pragma unroll
                for (int ks = 0; ks < 2; ++ks) { const bf16x8 bw = *(const bf16x8*)(w2T + n * 64 + ks * 32 + fq * 8); aw[nt] = MFMA16(bw, Aw[ks], aw[nt]);
                    const bf16x8 ba = *(const bf16x8*)(a2T + n * 64 + ks * 32 + fq * 8); aa[nt] = MFMA16(ba, Aa[ks], aa[nt]); } }
            f32x4 kkv[4], av[4]; float ssq = 0.f, bon = 0.f;
#pragma unroll
            for (int nt = 0; nt < 4; ++nt) {
                const int c = h * 64 + nt * 16 + 4 * fq; const size_t o = (size_t)lt * 1024 + c;
                const f32x4 rc = ld4bf(crow + C_R + c), rp = ld4bf(prow + C_R + c), kc = ld4bf(crow + C_K + c), kp = ld4bf(prow + C_K + c), vc = ld4bf(crow + C_V + c), vp = ld4bf(prow + C_V + c);
                const f32x4 r = rc + *(const f32x4*)(mu + C_R + c) * (rp - rc), k = kc + *(const f32x4*)(mu + C_K + c) * (kp - kc), v = vc + *(const f32x4*)(mu + C_V + c) * (vp - vc);
                const f32x4 w0v = *(const f32x4*)(w0 + c), a0v = *(const f32x4*)(a0 + c), kkp = *(const f32x4*)(k_k + c), kap = *(const f32x4*)(k_a + c), rkp = *(const f32x4*)(r_k + c);
                f32x4 wv, a, kk, kmod;
#pragma unroll
                for (int j = 0; j < 4; ++j) {
                    const float z = -(w0v[j] + aw[nt][j]);
                    const float sp = fmaxf(z, 0.f) + __logf(1.0f + __expf(-fabsf(z)));
                    wv[j] = __expf(-__expf(-sp - 0.5f));
                    a[j] = fast_sigmoid(a0v[j] + aa[nt][j]);
                    kk[j] = k[j] * kkp[j]; kmod[j] = k[j] * (1.0f + (a[j] - 1.0f) * kap[j]);
                    ssq += kk[j] * kk[j]; bon += r[j] * kmod[j] * rkp[j];
                }
                kkv[nt] = kk; av[nt] = a;
                st4bf(PR + o, r); st4bf(PK + o, kmod); st4bf(PV + o, v); *(f32x4*)(PW + o) = wv;
            }
            ssq = fq_sum(ssq); bon = fq_sum(bon);
            const float rs = 1.0f / sqrtf(fmaxf(ssq, 1e-24f));
#pragma unroll
            for (int nt = 0; nt < 4; ++nt) { const int c = h * 64 + nt * 16 + 4 * fq; const size_t o = (size_t)lt * 1024 + c;
                const f32x4 kn = kkv[nt] * rs; st4bf(PA + o, -kn); st4bf(PB + o, kn * av[nt]); }
            if (fq == 0) bonus[lt * 16 + h] = bon;
        }
    }
}

__device__ __forceinline__ void post_phase(int s, int gw, int NGW, int lane, const bf16_t* cols, const bf16_t* carry, const float* mu, const bf16_t* gate,
        const float* ln_w, const float* ln_b, const float* hg_g, const float* oraw, const float* hgo, const bf16_t* PV, const float* bonus, bf16_t* merged) {
    const int fr = lane & 15, fq = lane >> 4;
    for (int item = gw; item < (MS / 16) * 4; item += NGW) {
        const int tile = item >> 2, q4 = item & 3;
        const int lt = tile * 16 + fr, b = lt / TS, tl = lt % TS;
        const size_t gt = (size_t)b * SEQ + s * TS + tl;
        const bf16_t* crow = cols + (size_t)lt * CL;
        const bf16_t* prow = tl > 0 ? crow - CL : carry + ((s & 1) * 4 + b) * CARRY_LD;
#pragma unroll 1
        for (int hgh = 0; hgh < 2; ++hgh) {
            const int h8 = q4 * 2 + hgh;
            f32x4 ho[8]; float ss = 0.f;
#pragma unroll
            for (int n8 = 0; n8 < 8; ++n8) { ho[n8] = *(const f32x4*)(hgo + ((size_t)((b * 8 + h8) * 8 + n8) * TS + tl) * 16 + 4 * fq); ss += (ho[n8][0] * ho[n8][0] + ho[n8][1] * ho[n8][1]) + (ho[n8][2] * ho[n8][2] + ho[n8][3] * ho[n8][3]); }
            ss = fq_sum(ss);
            const float rsh = 1.0f / sqrtf(ss * (1.0f / 128.0f) + 1e-6f);
#pragma unroll
            for (int rwh = 0; rwh < 2; ++rwh) {
                const int h = q4 * 4 + hgh * 2 + rwh;
                f32x4 ag[4], o[4]; float sm = 0.f;
#pragma unroll
                for (int nt = 0; nt < 4; ++nt) { ag[nt] = ld4bf(gate + (size_t)lt * 1024 + h * 64 + nt * 16 + 4 * fq);
                    o[nt] = *(const f32x4*)(oraw + ((size_t)((b * 16 + h) * 4 + nt) * TS + tl) * 16 + 4 * fq); sm += (o[nt][0] + o[nt][1]) + (o[nt][2] + o[nt][3]); }
                const float mean = fq_sum(sm) * (1.0f / 64.0f); float vq = 0.f;
#pragma unroll
                for (int nt = 0; nt < 4; ++nt) { o[nt] = o[nt] - mean; vq += (o[nt][0] * o[nt][0] + o[nt][1] * o[nt][1]) + (o[nt][2] * o[nt][2] + o[nt][3] * o[nt][3]); }
                const float rstd = 1.0f / sqrtf(fq_sum(vq) * (1.0f / 64.0f) + 64e-5f);
#ifdef MK_NO_BONUS
                const float bon = 0.f;
#else
                const float bon = bonus[lt * 16 + h];
#endif
#pragma unroll
                for (int nt = 0; nt < 4; ++nt) {
                    const int c = h * 64 + nt * 16 + 4 * fq;
                    const f32x4 lw = *(const f32x4*)(ln_w + c), lb = *(const f32x4*)(ln_b + c), v = ld4bf(PV + (size_t)lt * 1024 + c);
                    const f32x4 ya = (o[nt] * rstd * lw + lb + v * bon) * ag[nt];
                    const f32x4 ng = *(const f32x4*)(hg_g + (c & 127)), gh = ld4bf(crow + C_HG + c), gar = ld4bf(crow + C_GA + c), gbr = ld4bf(crow + C_GB + c);
                    const f32x4 hv = ho[rwh * 4 + nt] * rsh * ng;
                    f32x4 m;
#pragma unroll
                    for (int j = 0; j < 4; ++j) {
#if defined(MK_ZERO_YA)
                        m[j] = fast_sigmoid(gbr[j]) * (hv[j] * fast_silu(gh[j]));
#elif defined(MK_ZERO_YB)
                        m[j] = fast_sigmoid(gar[j]) * ya[j];
#else
                        m[j] = fast_sigmoid(gar[j]) * ya[j] + fast_sigmoid(gbr[j]) * (hv[j] * fast_silu(gh[j]));
#endif
                    }
                    st4bf(merged + gt * 1024 + c, m);
                }
            }
        }
    }
}

constexpr int RWB = 43008;
__device__ __forceinline__ void rw_load(LAS unsigned char* bp, int lt2, size_t ltok0, int h, int rg, const bf16_t* PA, const float* PW, const bf16_t* PB, const bf16_t* PK, const bf16_t* PR, const bf16_t* PV) {
    const int tok = lt2 >> 3, c8 = (lt2 & 7) * 8; const size_t base = (ltok0 + tok) * 1024 + h * 64 + c8;
    const u32x4 ra = *(const u32x4*)(PA + base), rb = *(const u32x4*)(PB + base), rk = *(const u32x4*)(PK + base), rr = *(const u32x4*)(PR + base);
    const f32x4 w0 = *(const f32x4*)(PW + base), w1 = *(const f32x4*)(PW + base + 4);
    const unsigned rv = *(const unsigned*)(PV + (ltok0 + tok) * 1024 + h * 64 + rg * 16 + (lt2 & 7) * 2);
    const int off = (tok * 64 + c8) * 4;
#define RW_PUT(arr, u) do { *(LAS f32x4*)(bp + (arr) * 8192 + off) = (f32x4){bflo(u.x), bfhi(u.x), bflo(u.y), bfhi(u.y)}; *(LAS f32x4*)(bp + (arr) * 8192 + off + 16) = (f32x4){bflo(u.z), bfhi(u.z), bflo(u.w), bfhi(u.w)}; } while (0)
    RW_PUT(0, ra); RW_PUT(2, rb); RW_PUT(3, rk); RW_PUT(4, rr);
#undef RW_PUT
    *(LAS f32x4*)(bp + 8192 + off) = w0; *(LAS f32x4*)(bp + 8192 + off + 16) = w1;
    *(LAS f32x2v*)(bp + 40960 + (tok * 16 + (lt2 & 7) * 2) * 4) = (f32x2v){bflo(rv), bfhi(rv)};
}
__device__ __forceinline__ void rwkv_scan(int s, int bid, int G, int tid, int lane, int wave, LAS unsigned char* lds,
        const bf16_t* PA, const float* PW, const bf16_t* PB, const bf16_t* PK, const bf16_t* PR, const bf16_t* PV, float* oraw, float* state, bool save) {
    constexpr int NBLK = TS / 32;
    const int rowl = lane >> 4, j = lane & 15, row = (wave & 3) * 4 + rowl;
    for (int it = bid; it < 256; it += G) {
        const int b = it >> 6, h = (it >> 2) & 15, rg = it & 3;
        const size_t tok0 = (size_t)b * TS;
        float* stp = state + ((size_t)((b * 16 + h) * 64 + rg * 16 + row) * 64 + 4 * j);
        f32x4 st = (f32x4){0.f, 0.f, 0.f, 0.f};
        if (wave < 4 && s > 0) st = *(const f32x4*)stp;
        if (wave >= 4) rw_load(lds, tid - 256, tok0, h, rg, PA, PW, PB, PK, PR, PV);
        __syncthreads();
#pragma unroll 1
        for (int blk = 0; blk < NBLK; ++blk) {
            if (wave >= 4) { if (blk + 1 < NBLK) rw_load(lds + ((blk + 1) & 1) * RWB, tid - 256, tok0 + (blk + 1) * 32, h, rg, PA, PW, PB, PK, PR, PV); }
            else {
                const LAS unsigned char* bp = lds + (blk & 1) * RWB;
                float* orow = oraw + ((size_t)it * TS + blk * 32) * 16 + row;
#pragma unroll 4
                for (int t = 0; t < 32; ++t) {
                    const int o4 = (t * 64 + 4 * j) * 4;
                    const f32x4 a4 = *(const LAS f32x4*)(bp + o4), w4 = *(const LAS f32x4*)(bp + 8192 + o4), b4 = *(const LAS f32x4*)(bp + 16384 + o4), k4 = *(const LAS f32x4*)(bp + 24576 + o4), r4 = *(const LAS f32x4*)(bp + 32768 + o4);
                    const float vv = *(const LAS float*)(bp + 40960 + (t * 16 + row) * 4);
                    float sa = (st[0] * a4[0] + st[1] * a4[1]) + (st[2] * a4[2] + st[3] * a4[3]);
                    sa = allreduce16(sa);
                    st = st * w4 + (b4 * sa + k4 * vv);
                    float y = (st[0] * r4[0] + st[1] * r4[1]) + (st[2] * r4[2] + st[3] * r4[3]);
                    y = allreduce16(y);
                    if (j == 0) orow[t * 16] = y;
                }
            }
            __syncthreads();
        }
        if (wave < 4 && save) *(f32x4*)stp = st;
    }
}


__device__ __forceinline__ void rwkv_scan_naive(int s, int gw, int NGW, int lane, int wave, LAS unsigned char* lds,
        const bf16_t* PA, const float* PW, const bf16_t* PB, const bf16_t* PK, const bf16_t* PR, const bf16_t* PV, float* oraw, float* state) {
    LAS float* slab = (LAS float*)(lds + wave * 2048);
    for (int it = gw; it < 64; it += NGW) {
        const int b = it >> 4, h = it & 15;
        float st[64];
        float* stp = state + (size_t)((b * 16 + h) * 64 + lane) * 64;
#pragma unroll
        for (int k = 0; k < 64; ++k) st[k] = (s > 0) ? stp[k] : 0.f;
        for (int tl = 0; tl < TS; ++tl) {
            const size_t base = ((size_t)b * TS + tl) * 1024 + h * 64 + lane;
            slab[lane] = bflo((unsigned)PA[base]); slab[64 + lane] = PW[base]; slab[128 + lane] = bflo((unsigned)PB[base]); slab[192 + lane] = bflo((unsigned)PK[base]); slab[256 + lane] = bflo((unsigned)PR[base]);
            const float vv = bflo((unsigned)PV[base]);
            asm volatile("s_waitcnt lgkmcnt(0)" ::: "memory");
            float sa = 0.f;
#pragma unroll
            for (int k = 0; k < 64; ++k) sa += st[k] * slab[k];
            float y = 0.f;
#pragma unroll
            for (int k = 0; k < 64; ++k) { st[k] = st[k] * slab[64 + k] + (sa * slab[128 + k] + vv * slab[192 + k]); y += st[k] * slab[256 + k]; }
            asm volatile("s_waitcnt lgkmcnt(0)" ::: "memory");
            oraw[((size_t)(it * 4 + (lane >> 4)) * TS + tl) * 16 + (lane & 15)] = y;
        }
#pragma unroll
        for (int k = 0; k < 64; ++k) stp[k] = st[k];
    }
}
constexpr int HGB = 51200;
__device__ __forceinline__ void hg_load(LAS unsigned char* bp, int lt2, size_t ltok0, int h8, int rg, const bf16_t* cols, const float* lbv) {
    const int tok = lt2 >> 3, c16 = (lt2 & 7) * 16; const bf16_t* crow = cols + (ltok0 + tok) * CL;
    float q[16], f[16];
    { float t[8]; ld8bf(crow + C_HQ + h8 * 128 + c16, t);
#pragma unroll
      for (int e = 0; e < 8; ++e) q[e] = t[e];
      ld8bf(crow + C_HQ + h8 * 128 + c16 + 8, t);
#pragma unroll
      for (int e = 0; e < 8; ++e) q[8 + e] = t[e];
      ld8bf(crow + C_HF + h8 * 128 + c16, t);
#pragma unroll
      for (int e = 0; e < 8; ++e) f[e] = t[e];
      ld8bf(crow + C_HF + h8 * 128 + c16 + 8, t);
#pragma unroll
      for (int e = 0; e < 8; ++e) f[8 + e] = t[e]; }
    const unsigned rv = *(const unsigned*)(crow + C_HI + h8 * 128 + rg * 16 + (lt2 & 7) * 2);
    const int off = (tok * 128 + c16) * 4;
#pragma unroll
    for (int g = 0; g < 4; ++g) { const f32x4 lb = *(const f32x4*)(lbv + h8 * 128 + c16 + 4 * g); f32x4 fv, kv, qv;
#pragma unroll
        for (int e = 0; e < 4; ++e) { fv[e] = lb[e] + (1.0f - lb[e]) * fast_sigmoid(f[4 * g + e]); kv[e] = 1.0f - fv[e]; qv[e] = fast_silu(q[4 * g + e]); }
        *(LAS f32x4*)(bp + off + 16 * g) = fv; *(LAS f32x4*)(bp + 16384 + off + 16 * g) = kv; *(LAS f32x4*)(bp + 32768 + off + 16 * g) = qv; }
    *(LAS f32x2v*)(bp + 49152 + (tok * 16 + (lt2 & 7) * 2) * 4) = (f32x2v){bflo(rv), bfhi(rv)};
}
__device__ __forceinline__ void hgrn_scan(int s, int bid, int G, int tid, int lane, int wave, LAS unsigned char* lds, const bf16_t* cols, const float* lbv, float* hgo, float* state, bool save) {
    constexpr int NBLK = TS / 32;
    const int rowl = lane >> 4, j = lane & 15, row = (wave & 3) * 4 + rowl;
    for (int it = bid; it < 256; it += G) {
        const int b = it >> 6, h8 = (it >> 3) & 7, rg = it & 7;
        const size_t tok0 = (size_t)b * TS;
        float* stp = state + ((size_t)((b * 8 + h8) * 128 + rg * 16 + row) * 128 + 4 * j);
        f32x4 s0 = (f32x4){0.f, 0.f, 0.f, 0.f}, s1 = s0;
        if (wave < 4 && s > 0) { s0 = *(const f32x4*)stp; s1 = *(const f32x4*)(stp + 64); }
        if (wave >= 4) hg_load(lds, tid - 256, tok0, h8, rg, cols, lbv);
        __syncthreads();
#pragma unroll 1
        for (int blk = 0; blk < NBLK; ++blk) {
            if (wave >= 4) { if (blk + 1 < NBLK) hg_load(lds + ((blk + 1) & 1) * HGB, tid - 256, tok0 + (blk + 1) * 32, h8, rg, cols, lbv); }
            else {
                const LAS unsigned char* bp = lds + (blk & 1) * HGB;
                float* orow = hgo + ((size_t)it * TS + blk * 32) * 16 + row;
#pragma unroll 4
                for (int t = 0; t < 32; ++t) {
                    const int o4 = (t * 128 + 4 * j) * 4;
                    const f32x4 f0 = *(const LAS f32x4*)(bp + o4), f1 = *(const LAS f32x4*)(bp + o4 + 256), k0 = *(const LAS f32x4*)(bp + 16384 + o4), k1 = *(const LAS f32x4*)(bp + 16384 + o4 + 256);
                    const f32x4 q0 = *(const LAS f32x4*)(bp + 32768 + o4), q1 = *(const LAS f32x4*)(bp + 32768 + o4 + 256);
                    const float iv = *(const LAS float*)(bp + 49152 + (t * 16 + row) * 4);
                    s0 = s0 * f0 + k0 * iv; s1 = s1 * f1 + k1 * iv;
                    float y = ((s0[0] * q0[0] + s0[1] * q0[1]) + (s0[2] * q0[2] + s0[3] * q0[3])) + ((s1[0] * q1[0] + s1[1] * q1[1]) + (s1[2] * q1[2] + s1[3] * q1[3]));
                    y = allreduce16(y);
                    if (j == 0) orow[t * 16] = y;
                }
            }
            __syncthreads();
        }
        if (wave < 4 && save) { *(f32x4*)stp = s0; *(f32x4*)(stp + 64) = s1; }
    }
}

__device__ __forceinline__ void attn_phase(int gw, int NGW, int lane, const bf16_t* Q, const bf16_t* KV, const bf16_t* Vt, bf16_t* AO) {
    const int fr = lane & 15, fq = lane >> 4;
    for (int item = gw; item < 8192; item += NGW) {
        const int bh = item >> 9, tile = item & 511, b = bh >> 2, hd = bh & 3;
        const size_t gt = (size_t)b * SEQ + tile * 16 + fr;
        bf16x8 qf[8];
#pragma unroll
        for (int ks = 0; ks < 8; ++ks) qf[ks] = *(const bf16x8*)(Q + gt * 1024 + hd * 256 + ks * 32 + fq * 8);
        f32x4 sc[16]; float mx = -3.0e38f;
#pragma unroll
        for (int kt = 0; kt < 16; ++kt) { f32x4 acc = (f32x4){0.f, 0.f, 0.f, 0.f}; const bf16_t* kp = KV + (size_t)(b * 256 + kt * 16 + fr) * 2048 + hd * 256 + fq * 8;
#pragma unroll
            for (int ks = 0; ks < 8; ++ks) acc = MFMA16(*(const bf16x8*)(kp + ks * 32), qf[ks], acc);
            sc[kt] = acc * 0.0625f; mx = fmaxf(mx, fmaxf(fmaxf(sc[kt][0], sc[kt][1]), fmaxf(sc[kt][2], sc[kt][3]))); }
        mx = fmaxf(mx, __shfl_xor(mx, 16)); mx = fmaxf(mx, __shfl_xor(mx, 32));
        float sum = 0.f;
#pragma unroll
        for (int kt = 0; kt < 16; ++kt) {
#pragma unroll
            for (int jj = 0; jj < 4; ++jj) { sc[kt][jj] = __expf(sc[kt][jj] - mx); sum += sc[kt][jj]; } }
        sum = fq_sum(sum);
        const float inv = 1.0f / sum;
        bf16x8 pf[8];
#pragma unroll
        for (int k2 = 0; k2 < 8; ++k2) { u32x4 w; w.x = cvt_pk_bf16(sc[2 * k2][0], sc[2 * k2][1]); w.y = cvt_pk_bf16(sc[2 * k2][2], sc[2 * k2][3]); w.z = cvt_pk_bf16(sc[2 * k2 + 1][0], sc[2 * k2 + 1][1]); w.w = cvt_pk_bf16(sc[2 * k2 + 1][2], sc[2 * k2 + 1][3]); pf[k2] = __builtin_bit_cast(bf16x8, w); }
#pragma unroll 2
        for (int dt = 0; dt < 16; ++dt) { f32x4 acc = (f32x4){0.f, 0.f, 0.f, 0.f}; const bf16_t* vp = Vt + (size_t)((b * 4 + hd) * 256 + dt * 16 + fr) * 256 + fq * 8;
#pragma unroll
            for (int k2 = 0; k2 < 8; ++k2) acc = MFMA16(*(const bf16x8*)(vp + k2 * 32), pf[k2], acc);
            st4bf(AO + gt * 1024 + hd * 256 + dt * 16 + 4 * fq, acc * inv); }
    }
}

__device__ __forceinline__ int tid_fresh() { int t = threadIdx.x; asm volatile("" : "+v"(t)); return t; }
#define WinT ((bf16_t*)(a.ws + WS_WIN))
#define WoutT ((bf16_t*)(a.ws + WS_WOUT))
#define WqT ((bf16_t*)(a.ws + WS_WQ))
#define WoT ((bf16_t*)(a.ws + WS_WO))
#define WkvT ((bf16_t*)(a.ws + WS_WKV))
#define W13T ((bf16_t*)(a.ws + WS_W13))
#define W2T ((bf16_t*)(a.ws + WS_W2))
#define rw2T ((bf16_t*)(a.ws + WS_RW2T))
#define ra2T ((bf16_t*)(a.ws + WS_RA2T))
#define rg2T ((bf16_t*)(a.ws + WS_RG2T))
#define g2Tp ((bf16_t*)(a.ws + WS_G2TP))
#define GATE ((bf16_t*)(a.ws + WS_GATE))
#define ASG ((bf16_t*)(a.ws + WS_ASG))
#define carry ((bf16_t*)(a.ws + WS_CARRY))
#define lbv ((float*)(a.ws + WS_LB))
#define mbf ((bf16_t*)(a.ws + WS_MBF))
#define KV ((bf16_t*)(a.ws + WS_KV))
#define Vt ((bf16_t*)(a.ws + WS_VT))
#define rwst ((float*)(a.ws + WS_RWST))
#define hgst ((float*)(a.ws + WS_HGST))
#define bonus ((float*)(a.ws + WS_BONUS))
#define merged ((bf16_t*)(a.ws + WS_MERGED))
#define u1 ((bf16_t*)(a.ws + WS_U1))
#define cols ((bf16_t*)(a.ws + WS_COLS))
#define PR ((bf16_t*)(a.ws + WS_PR))
#define PK ((bf16_t*)(a.ws + WS_PK))
#define PA ((bf16_t*)(a.ws + WS_PA))
#define PB ((bf16_t*)(a.ws + WS_PB))
#define PV ((bf16_t*)(a.ws + WS_PV))
#define PW ((float*)(a.ws + WS_PW))
#define oraw ((float*)(a.ws + WS_ORAW))
#define hgo ((float*)(a.ws + WS_HGO))
#define U ((bf16_t*)(a.ws + WS_U))
#define Qb ((bf16_t*)(a.ws + WS_Q))
#define AO ((bf16_t*)(a.ws + WS_AO))
#define FF ((bf16_t*)(a.ws + WS_FF))
#define XIN (a.in[0])
#define OUTP (a.out)
struct Args { const float* in[29]; float* out; unsigned char* ws; int ph_lo, ph_hi; };

typedef const __attribute__((address_space(4))) Args* CArgsP;
__device__ __forceinline__ CArgsP args_fresh() { CArgsP p = (CArgsP)__builtin_amdgcn_kernarg_segment_ptr(); asm volatile("" : "+s"(p)); return p; }
__global__ void __launch_bounds__(512, 2) mega(Args a0) {
    extern __shared__ __attribute__((aligned(16))) unsigned char lds_raw[];
    LAS unsigned char* lds = (LAS unsigned char*)lds_raw;
    cg::grid_group grid = cg::this_grid();
    const int G = gridDim.x, bid = blockIdx.x, NGW = G * 8, NGT = G * 512;
#define IDS const auto& a = *args_fresh(); const int tid = tid_fresh(), lane = tid & 63, wave = __builtin_amdgcn_readfirstlane(tid >> 6), gw = bid * 8 + wave, gtid = bid * 512 + tid; (void)lane; (void)gw; (void)gtid
    const int lo = a0.ph_lo, hi = a0.ph_hi;
    { volatile LAS unsigned* misc = (volatile LAS unsigned*)(lds + MISC_OFF); if (threadIdx.x < 2) misc[threadIdx.x] = 0u; __syncthreads();
      if (hi - lo > 1) (void)xcd_barrier_post((unsigned*)(a0.ws + WS_CTL), misc); }
#ifndef MK_REP
#define MK_REP -1
#endif
#ifndef MK_REPN
#define MK_REPN 3
#endif
#define RPT(code) for (int rep_ = 0, nrep_ = (MK_REP == (code)) ? MK_REPN : 1; rep_ < nrep_; ++rep_)
#define LASTREP (rep_ == nrep_ - 1)
#define IN(k) (lo <= (k) && (k) < hi)
#define SEAM(k) do { if (IN(k) && IN((k) + 1)) RPT(120) { if ((k) == 0) { asm volatile("s_waitcnt vmcnt(0) lgkmcnt(0)" ::: "memory"); grid.sync(); __builtin_amdgcn_fence(__ATOMIC_ACQUIRE, "agent"); asm volatile("s_waitcnt vmcnt(0)" ::: "memory"); } else { XcdBarrier xb_; xb_.bar = (unsigned*)(args_fresh()->ws + WS_CTL); xb_.x = xb_xcc_id(); xb_.st = (volatile LAS unsigned*)(lds + MISC_OFF); xcd_barrier(xb_); } } } while (0)

    if (IN(0)) { IDS;
        LAS float* scr = (LAS float*)(lds + wave * 16384);
        constexpr int I_IN = 16 * 297, I_SQ = 16 * 32, I_13 = 16 * 88, I_2 = 44 * 32;
        constexpr int NITEMS = I_IN + 5 * I_SQ + 2 * I_13 + I_2;
        for (int it = gw; it < NITEMS; it += NGW) {
            int r = it;
            if (r < I_IN) { const int kb = r / 297, n0 = (r % 297) * 32; tr_item(a.in[3], 1024, 9504, WinT, kb, n0, n0 + (n0 >= 3360 ? 224 : 0), scr, lane); continue; } r -= I_IN;
            if (r < I_SQ) { tr_item(a.in[17], 1024, 1024, WoutT, r / 32, (r % 32) * 32, (r % 32) * 32, scr, lane); continue; } r -= I_SQ;
            if (r < I_SQ) { tr_item(a.in[20], 1024, 1024, WqT, r / 32, (r % 32) * 32, (r % 32) * 32, scr, lane); continue; } r -= I_SQ;
            if (r < I_SQ) { tr_item(a.in[23], 1024, 1024, WoT, r / 32, (r % 32) * 32, (r % 32) * 32, scr, lane); continue; } r -= I_SQ;
            if (r < I_SQ) { tr_item(a.in[21], 1024, 1024, WkvT, r / 32, (r % 32) * 32, (r % 32) * 32, scr, lane); continue; } r -= I_SQ;
            if (r < I_SQ) { tr_item(a.in[22], 1024, 1024, WkvT, r / 32, (r % 32) * 32, 1024 + (r % 32) * 32, scr, lane); continue; } r -= I_SQ;
            if (r < I_13) { const int n0 = (r % 88) * 32; tr_item(a.in[25], 1024, DFF, W13T, r / 88, n0, (n0 / 128) * 256 + (n0 % 128), scr, lane); continue; } r -= I_13;
            if (r < I_13) { const int n0 = (r % 88) * 32; tr_item(a.in[26], 1024, DFF, W13T, r / 88, n0, (n0 / 128) * 256 + 128 + (n0 % 128), scr, lane); continue; } r -= I_13;
            tr_item(a.in[27], DFF, 1024, W2T, r / 32, (r % 32) * 32, (r % 32) * 32, scr, lane);
        }
        for (int i = gtid; i < 28672; i += NGT) ((u32x4*)(WinT + 3360 * 1024))[i] = (u32x4){0u, 0u, 0u, 0u};
        for (int i = gtid; i < 1792; i += NGT) ((u32x4*)carry)[i] = (u32x4){0u, 0u, 0u, 0u};
        for (int n = gw; n < 1024; n += NGW) { rw2T[n * 64 + lane] = (bf16_t)f2bf(a.in[6][lane * 1024 + n]); ra2T[n * 64 + lane] = (bf16_t)f2bf(a.in[8][lane * 1024 + n]); }
        for (int m = gw; m < 512; m += NGW) {
            for (int e = lane; e < 320; e += 64) { const int n = 2 * m + (e >= 160 ? 1 : 0), k = e >= 160 ? e - 160 : e; rg2T[n * 160 + k] = (bf16_t)f2bf(a.in[9][k * 1024 + n]); } }
        for (int n = gw; n < 1024; n += NGW) { f32x4 v;
#pragma unroll
            for (int e = 0; e < 4; ++e) { const int k = 4 * lane + e; v[e] = k < 160 ? a.in[9][k * 1024 + n] : 0.f; }
            st4bf(g2Tp + n * 256 + 4 * lane, v); }
        for (int i = gtid; i < 1024; i += NGT) lbv[i] = 1.0f / (1.0f + __expf(a.in[15][1024 + i] - a.in[15][i]));
        for (int m = gw; m < 1024; m += NGW) rms_row_bf16(a.in[1] + (size_t)m * 1024, a.in[19], mbf + (size_t)m * 1024, lane);
        __syncthreads();
    }
    SEAM(0);

#pragma unroll 1
    for (int s = 0; s < NSPLIT; ++s) {
        const int pb = 1 + 5 * s;
        if (IN(pb)) { IDS;
            RPT(101) for (int lt = gw; lt < MS; lt += NGW) { const int b = lt / TS, tl = lt % TS; const size_t gt = (size_t)b * SEQ + s * TS + tl; rms_row_bf16(XIN + gt * 1024, a.in[2], u1 + (size_t)lt * 1024, lane); }
        }
        SEAM(pb);
        if (IN(pb + 1)) { const auto& a = *args_fresh();
            pg8::Gemm g{u1, WinT, MS, CL, 1024}; pg8::StaticOrder S; S.init(MS, CL, G, bid);
            pg8::EpiStoreBf16 E{cols, CL};
            RPT(102) pg8::gemm_phase<pg8::EpiStoreBf16, pg8::StaticOrder, true, true>(lds, g, S, E);
        }
        SEAM(pb + 1);
#ifndef SKIP_PREP
        if (IN(pb + 2)) { IDS; RPT(103) prep_phase(s, gw, NGW, lane, cols, carry, a.in[4], a.in[5], a.in[7], a.in[10], a.in[11], a.in[12], rw2T, ra2T, PR, PK, PA, PB, PV, PW, bonus, ASG); }
#endif
        SEAM(pb + 2);
        if (IN(pb + 3)) { IDS;
#ifdef MK_ZERO_SCAN
            for (int i = gtid; i < MS * 256; i += NGT) { ((f32x4*)oraw)[i] = (f32x4){0.f, 0.f, 0.f, 0.f}; ((f32x4*)hgo)[i] = (f32x4){0.01f, 0.02f, 0.03f, 0.04f}; }
#endif
#ifdef MK_NAIVE_RW
            rwkv_scan_naive(s, gw, NGW, lane, wave, lds, PA, PW, PB, PK, PR, PV, oraw, rwst);
#endif
#ifndef SKIP_RW
            RPT(104) { rwkv_scan(s, bid, G, tid, lane, wave, lds, PA, PW, PB, PK, PR, PV, oraw, rwst, LASTREP); __syncthreads(); }
#endif
            __syncthreads();
#ifndef SKIP_HG
            RPT(105) { hgrn_scan(s, bid, G, tid, lane, wave, lds, cols, lbv, hgo, hgst, LASTREP); __syncthreads(); }
#endif
            { pg8::Gemm g{ASG, g2Tp, MS, 1024, 256}; pg8::StaticOrder S; S.init(MS, 1024, G, bid); pg8::EpiStoreBf16 E{GATE, 1024};
              pg8::gemm_phase<pg8::EpiStoreBf16, pg8::StaticOrder, true, true>(lds, g, S, E); }
        }
        SEAM(pb + 3);
        if (IN(pb + 4)) { IDS;
#ifdef MK_NOMIX
            for (int i = gtid; i < MS * 128; i += NGT) { const int lt = i >> 7, b = lt / TS, tl = lt % TS; const size_t gt = (size_t)b * SEQ + s * TS + tl; ((u32x4*)(merged + gt * 1024))[i & 127] = (u32x4){0u, 0u, 0u, 0u}; }
#endif
#ifndef SKIP_POST
            RPT(106) post_phase(s, gw, NGW, lane, cols, carry, a.in[4], GATE, a.in[13], a.in[14], a.in[16], oraw, hgo, PV, bonus, merged);
#endif
            if (bid < 4 && s + 1 < NSPLIT) { const u32x4* src = (const u32x4*)(cols + (size_t)(bid * TS + TS - 1) * CL); u32x4* dst = (u32x4*)(carry + (((s + 1) & 1) * 4 + bid) * CARRY_LD);
                for (int i = tid; i < CARRY_LD / 8; i += 512) dst[i] = src[i]; }
        }
        SEAM(pb + 4);
    }

    if (IN(T0 + 0)) { const auto& a = *args_fresh();
        { pg8::Gemm g{merged, WoutT, NTOK, 1024, 1024}; pg8::StaticOrder S; S.init(NTOK, 1024, G, bid); pg8::EpiResF32 E{XIN, OUTP, 1024};
          pg8::gemm_phase<pg8::EpiResF32, pg8::StaticOrder, true, true>(lds, g, S, E); }
        { pg8::Gemm g{mbf, WkvT, 1024, 2048, 1024}; pg8::StaticOrder S; S.init(1024, 2048, G, bid); pg8::EpiStoreBf16 E{KV, 2048};
          pg8::gemm_phase<pg8::EpiStoreBf16, pg8::StaticOrder, true, true>(lds, g, S, E); }
    }
    SEAM(T0 + 0);
    if (IN(T0 + 1)) { IDS;
        for (int gt = gw; gt < NTOK; gt += NGW) rms_row_bf16(OUTP + (size_t)gt * 1024, a.in[18], U + (size_t)gt * 1024, lane);
        for (int i = gtid; i < 4 * 4 * 256 * 256; i += NGT) { const int kp = i & 255, dim = (i >> 8) & 255, hd = (i >> 16) & 3, b = i >> 18;
            const int k2 = kp >> 5, fq = (kp >> 3) & 3, sl = kp & 7; const int key = 32 * k2 + (sl < 4 ? 4 * fq + sl : 16 + 4 * fq + sl - 4);
            Vt[i] = KV[(size_t)(b * 256 + key) * 2048 + 1024 + hd * 256 + dim]; }
    }
    SEAM(T0 + 1);
    if (IN(T0 + 2)) { const auto& a = *args_fresh(); pg8::Gemm g{U, WqT, NTOK, 1024, 1024}; pg8::StaticOrder S; S.init(NTOK, 1024, G, bid); pg8::EpiStoreBf16 E{Qb, 1024};
        RPT(112) pg8::gemm_phase<pg8::EpiStoreBf16, pg8::StaticOrder, true, true>(lds, g, S, E); }
    SEAM(T0 + 2);
#ifndef SKIP_ATTN
    if (IN(T0 + 3)) { IDS; RPT(113) attn_phase(gw, NGW, lane, Qb, KV, Vt, AO); }
#endif
    SEAM(T0 + 3);
#ifndef MK_NOATT
    if (IN(T0 + 4)) { const auto& a = *args_fresh(); pg8::Gemm g{AO, WoT, NTOK, 1024, 1024}; pg8::StaticOrder S; S.init(NTOK, 1024, G, bid); pg8::EpiResF32 E{OUTP, OUTP, 1024};
        pg8::gemm_phase<pg8::EpiResF32, pg8::StaticOrder, true, true>(lds, g, S, E); }
#endif
    SEAM(T0 + 4);
    if (IN(T0 + 5)) { IDS; RPT(115) for (int gt = gw; gt < NTOK; gt += NGW) rms_row_bf16(OUTP + (size_t)gt * 1024, a.in[24], U + (size_t)gt * 1024, lane); }
    SEAM(T0 + 5);
    if (IN(T0 + 6)) { const auto& a = *args_fresh(); pg8::Gemm g{U, W13T, NTOK, 2 * DFF, 1024}; pg8::StaticOrder S; S.init(NTOK, 2 * DFF, G, bid); pg8::EpiSwiGLU E{FF, DFF};
        RPT(116) pg8::gemm_phase<pg8::EpiSwiGLU, pg8::StaticOrder, true, true>(lds, g, S, E); }
    SEAM(T0 + 6);
    if (IN(T0 + 7)) { const auto& a = *args_fresh(); pg8::Gemm g{FF, W2T, NTOK, 1024, DFF}; pg8::StaticOrder S; S.init(NTOK, 1024, G, bid); pg8::EpiResF32 E{OUTP, OUTP, 1024};
        pg8::gemm_phase<pg8::EpiResF32, pg8::StaticOrder, true, true>(lds, g, S, E); }
    SEAM(T0 + 7);
    if (IN(T0 + 8)) { IDS;
        const float* gf = a.in[28];
        for (int gt = gw; gt < NTOK; gt += NGW) { f32x4* row = (f32x4*)(OUTP + (size_t)gt * 1024); f32x4 v[4]; float sq = 0.f;
#pragma unroll
            for (int j = 0; j < 4; ++j) { v[j] = row[lane + 64 * j]; sq += (v[j][0] * v[j][0] + v[j][1] * v[j][1]) + (v[j][2] * v[j][2] + v[j][3] * v[j][3]); }
            const float rs = 1.0f / sqrtf(wave_sum(sq) * (1.0f / 1024.0f) + 1e-6f);
#pragma unroll
            for (int j = 0; j < 4; ++j) row[lane + 64 * j] = v[j] * rs * ((const f32x4*)gf)[lane + 64 * j]; }
    }
#undef IN
#undef SEAM
}

#ifndef MK_MULTI
#define MK_MULTI 0
#endif
extern "C" void kernel_launch(void* const* d_in, const int* in_sizes, int n_in, void* d_out, int out_size, void* d_ws, size_t ws_size, hipStream_t stream) {
    static int grid = 0;
    if (grid == 0) {
        if (n_in != 29 || in_sizes[0] != NTOK * D || out_size != NTOK * D || ws_size < WS_END) { fprintf(stderr, "kernel_launch: unexpected shapes / workspace (%d inputs, ws %zu)\n", n_in, ws_size); grid = -1; return; }
        int dev = 0, cus = 0, per_cu = 0;
        hipGetDevice(&dev); hipDeviceGetAttribute(&cus, hipDeviceAttributeMultiprocessorCount, dev);
        hipFuncSetAttribute((const void*)mega, hipFuncAttributeMaxDynamicSharedMemorySize, LDS_BYTES);
        hipOccupancyMaxActiveBlocksPerMultiprocessor(&per_cu, (const void*)mega, 512, LDS_BYTES);
        (void)hipGetLastError();
        if (per_cu < 1) per_cu = 1;
        grid = cus;
    }
    if (grid < 0) return;
    Args a{};
    for (int i = 0; i < 29; ++i) a.in[i] = (const float*)d_in[i];
    a.out = (float*)d_out; a.ws = (unsigned char*)d_ws;
    (void)hipMemsetAsync((char*)d_ws + WS_CTL, 0, CTL_BYTES, stream);
    void* args[] = {&a};
#if MK_MULTI
    for (int ph = 0; ph < N_PHASES; ++ph) { a.ph_lo = ph; a.ph_hi = ph + 1; hipLaunchCooperativeKernel((const void*)mega, dim3(grid), dim3(512), args, LDS_BYTES, stream); }
#else
    a.ph_lo = 0; a.ph_hi = N_PHASES;
    hipError_t e = hipLaunchCooperativeKernel((const void*)mega, dim3(grid), dim3(512), args, LDS_BYTES, stream);
    if (e != hipSuccess) fprintf(stderr, "cooperative launch failed: %s (grid %d)\n", hipGetErrorString(e), grid);
#endif
}
```

```cpp
#include <hip/hip_runtime.h>
#include <hip/hip_cooperative_groups.h>
#include <cstdint>
#include <cstdio>
namespace cg = cooperative_groups;
namespace pg8 {
#define PG8_LAS __attribute__((address_space(3)))
typedef unsigned short bf16_t;
typedef short bf16x8 __attribute__((ext_vector_type(8)));
typedef float f32x4 __attribute__((ext_vector_type(4)));
typedef unsigned u32x4 __attribute__((ext_vector_type(4)));
constexpr int BM = 256, BK = 64, HALF = 128, HTB = HALF * BK * 2  , STAGE_BYTES = 8 * HTB, NXCD = 8, WGM = 8;

__host__ __device__ __forceinline__ int lds_byte(int r, int c) { const int st = (r >> 4) * 2 + (c >> 5), rr = r & 15, cc = c & 31, ob = rr * 64 + cc * 2; return st * 1024 + (ob ^ (((ob >> 9) & 1) << 5)); }
__host__ __device__ __forceinline__ void stage_rc(int b, int& R, int& C) { const int st = b / 1024, sb = b % 1024, swz = sb ^ (((sb >> 9) & 1) << 5); R = (st >> 1) * 16 + swz / 64; C = (st & 1) * 32 + (swz % 64) / 2; }
__host__ __device__ __forceinline__ int perm32(int rho) { const int n = rho >> 4, i = rho & 15; return 8 * (i >> 2) + 4 * n + (i & 3); }

struct Unit { int pm, pn; };
struct Gemm { const bf16_t* A; const bf16_t* Bt; int M, N, K; };

struct StaticOrder {
    int nM, nN, nwg, G, c;
    __host__ __device__ void init(int M, int N, int G_, int c_) { nM = M / BM; nN = N / BM; nwg = nM * nN; G = G_; c = c_; }
    __host__ __device__ bool next(int i, Unit& u) const {
        const long L = (long)i * G + c; if (L >= nwg) return false;
        int wgid = (int)L; { const int q = nwg / NXCD, r = nwg % NXCD, xcd = wgid % NXCD, off = wgid / NXCD; wgid = (xcd < r ? xcd * (q + 1) : r * (q + 1) + (xcd - r) * q) + off; }
        const int nig = WGM * nN, gid = wgid / nig, fm = gid * WGM, gsz = (nM - fm) < WGM ? (nM - fm) : WGM;
        u.pm = fm + ((wgid % nig) % gsz); u.pn = (wgid % nig) / gsz; return true;
    }
    __device__ __forceinline__ void a_ready(const Unit&) const {}
    __device__ __forceinline__ void done(const Unit&) const {}
};

__device__ __forceinline__ unsigned cvt_pk_bf16(float lo, float hi) { unsigned r; asm volatile("v_cvt_pk_bf16_f32 %0, %1, %2" : "=v"(r) : "v"(lo), "v"(hi)); return r; }
__device__ __forceinline__ float fast_sigmoid(float x) { return __builtin_amdgcn_rcpf(1.0f + __expf(-x)); }
__device__ __forceinline__ float fast_silu(float x) { return x * fast_sigmoid(x); }
struct EpiStoreBf16 {
    static constexpr bool PERM = true, AFTER_DRAIN = false;
    bf16_t* O; int ldc;
    __device__ __forceinline__ void operator()(const f32x4 (&acc)[2][2][4][2], const Unit& u, int wr, int wc, int fr, int fq) const {
        const int row0 = u.pm * BM + wr * 64 + fr, col0 = u.pn * BM + wc * 32 + 8 * fq;
#pragma unroll
        for (int ai = 0; ai < 2; ++ai)
#pragma unroll
            for (int m = 0; m < 4; ++m) { bf16_t* rowp = O + (size_t)(row0 + ai * HALF + m * 16) * ldc + col0;
#pragma unroll
                for (int bj = 0; bj < 2; ++bj) { const f32x4 v0 = acc[ai][bj][m][0], v1 = acc[ai][bj][m][1];
                    u32x4 w; w.x = cvt_pk_bf16(v0[0], v0[1]); w.y = cvt_pk_bf16(v0[2], v0[3]); w.z = cvt_pk_bf16(v1[0], v1[1]); w.w = cvt_pk_bf16(v1[2], v1[3]);
                    *(u32x4*)(rowp + bj * HALF) = w; } }
    }
};
struct EpiResF32 {
    static constexpr bool PERM = true, AFTER_DRAIN = false;
    const float* base; float* out; int ldc;
    __device__ __forceinline__ void operator()(const f32x4 (&acc)[2][2][4][2], const Unit& u, int wr, int wc, int fr, int fq) const {
        const int row0 = u.pm * BM + wr * 64 + fr, col0 = u.pn * BM + wc * 32 + 8 * fq;
#pragma unroll
        for (int ai = 0; ai < 2; ++ai)
#pragma unroll
            for (int m = 0; m < 4; ++m) { const size_t off = (size_t)(row0 + ai * HALF + m * 16) * ldc + col0;
#pragma unroll
                for (int bj = 0; bj < 2; ++bj)
#pragma unroll
                    for (int n = 0; n < 2; ++n) { const size_t p = off + bj * HALF + 4 * n; const f32x4 b = *(const f32x4*)(base + p); *(f32x4*)(out + p) = b + acc[ai][bj][m][n]; } }
    }
};
struct EpiSwiGLU {
    static constexpr bool PERM = true, AFTER_DRAIN = false;
    bf16_t* O; int ldc;
    __device__ __forceinline__ void operator()(const f32x4 (&acc)[2][2][4][2], const Unit& u, int wr, int wc, int fr, int fq) const {
        const int row0 = u.pm * BM + wr * 64 + fr, col0 = u.pn * HALF + wc * 32 + 8 * fq;
#pragma unroll
        for (int ai = 0; ai < 2; ++ai)
#pragma unroll
            for (int m = 0; m < 4; ++m) { bf16_t* rowp = O + (size_t)(row0 + ai * HALF + m * 16) * ldc + col0;
                f32x4 v0, v1;
#pragma unroll
                for (int j = 0; j < 4; ++j) { v0[j] = fast_silu(acc[ai][0][m][0][j]) * acc[ai][1][m][0][j]; v1[j] = fast_silu(acc[ai][0][m][1][j]) * acc[ai][1][m][1][j]; }
                u32x4 w; w.x = cvt_pk_bf16(v0[0], v0[1]); w.y = cvt_pk_bf16(v0[2], v0[3]); w.z = cvt_pk_bf16(v1[0], v1[1]); w.w = cvt_pk_bf16(v1[2], v1[3]);
                *(u32x4*)rowp = w; }
    }
};
template <class Epi, class Sched, bool ALIGN_EPI = false, bool SP2 = false>
__device__ __forceinline__ void gemm_phase(PG8_LAS unsigned char* lds, const Gemm g, const Sched& S, const Epi& E) {
    int tid = threadIdx.x; asm volatile("" : "+v"(tid));
    const int wid = __builtin_amdgcn_readfirstlane(tid >> 6), lane = tid & 63, wr = wid >> 2, wc = wid & 3, fr = lane & 15, fq = lane >> 4;
    const int K = g.K, nt = K / BK;
    unsigned voffA[2], voffB[2];
#pragma unroll
    for (int i = 0; i < 2; ++i) { int R, C; stage_rc(tid * 16 + i * 8192, R, C); const int Rb = Epi::PERM ? ((R & ~31) + perm32(R & 31)) : R;
        voffA[i] = (unsigned)(R * K + C) * 2u; voffB[i] = (unsigned)(Rb * K + C) * 2u; }
    const size_t kstep = (size_t)(BK * 2);
    const size_t hstep = (size_t)HALF * K * 2;
    const size_t tstep = 2 * hstep;
    const unsigned ldsw = (unsigned)wid * 1024u;
    const int aoff = lds_byte(wr * 64 + fr, fq * 8), boff = lds_byte(wc * 32 + fr, fq * 8);
#define PG8_SA(b, h) (((b) * 2 + (h)) * HTB)
#define PG8_SB(b, h) ((4 + (b) * 2 + (h)) * HTB)
#define PG8_STAGE(bufoff, gbase, voff) do { _Pragma("unroll") for (int _i = 0; _i < 2; ++_i) \
        __builtin_amdgcn_global_load_lds((const unsigned*)((const char*)(gbase) + (voff)[_i]), (PG8_LAS unsigned*)(lds + (bufoff) + ldsw + _i * 8192), 16, 0, 0); } while (0)
#define PG8_LDA(dst, b, h) do { _Pragma("unroll") for (int m = 0; m < 4; ++m) _Pragma("unroll") for (int k = 0; k < 2; ++k) dst[m][k] = *(const PG8_LAS bf16x8*)(lds + PG8_SA(b, h) + aoff + m * 2048 + k * 1024); } while (0)
#define PG8_LDB(dst, b, h) do { _Pragma("unroll") for (int n = 0; n < 2; ++n) _Pragma("unroll") for (int k = 0; k < 2; ++k) dst[n][k] = *(const PG8_LAS bf16x8*)(lds + PG8_SB(b, h) + boff + n * 2048 + k * 1024); } while (0)
#define PG8_MMA(ai, bj, At, Bt) do { __builtin_amdgcn_s_setprio(1); _Pragma("unroll") for (int m = 0; m < 4; ++m) _Pragma("unroll") for (int n = 0; n < 2; ++n) _Pragma("unroll") for (int k = 0; k < 2; ++k) \
        acc[ai][bj][m][n] = __builtin_amdgcn_mfma_f32_16x16x32_bf16(Bt[n][k], At[m][k], acc[ai][bj][m][n], 0, 0, 0); __builtin_amdgcn_s_setprio(0); } while (0)
#define PG8_WAIT_V(n) asm volatile("s_waitcnt vmcnt(" #n ")" ::: "memory")
#define PG8_WAIT_L(n) asm volatile("s_waitcnt lgkmcnt(" #n ")" ::: "memory")
#define PG8_BAR __builtin_amdgcn_s_barrier()
#define PG8_SCHED __builtin_amdgcn_sched_barrier(0)
    Unit cur, nxt; int ui = 0;
    if (!S.next(0, cur)) return;
    f32x4 acc[2][2][4][2];
#pragma unroll
    for (int a = 0; a < 2; ++a)
#pragma unroll
        for (int b = 0; b < 2; ++b)
#pragma unroll
            for (int m = 0; m < 4; ++m)
#pragma unroll
                for (int n = 0; n < 2; ++n) acc[a][b][m][n] = (f32x4){0.f, 0.f, 0.f, 0.f};
    bf16x8 At[4][2], B0[2][2], B1[2][2];
    const char* cA = (const char*)g.A + (size_t)cur.pm * tstep; const char* cB = (const char*)g.Bt + (size_t)cur.pn * tstep;
    S.a_ready(cur);
    if constexpr (SP2) {
        PG8_STAGE(PG8_SB(0, 0), cB, voffB); PG8_STAGE(PG8_SB(0, 1), cB + hstep, voffB); PG8_STAGE(PG8_SA(0, 0), cA, voffA); PG8_STAGE(PG8_SA(0, 1), cA + hstep, voffA);
        if (wr == 1) PG8_BAR;
        PG8_WAIT_V(2); PG8_BAR;
        PG8_STAGE(PG8_SB(1, 0), cB + kstep, voffB); PG8_STAGE(PG8_SA(1, 0), cA + kstep, voffA); PG8_STAGE(PG8_SB(1, 1), cB + hstep + kstep, voffB);
        PG8_WAIT_V(6); PG8_BAR;
    } else {
        PG8_STAGE(PG8_SB(0, 0), cB, voffB); PG8_STAGE(PG8_SA(0, 0), cA, voffA); PG8_STAGE(PG8_SB(0, 1), cB + hstep, voffB); PG8_STAGE(PG8_SA(0, 1), cA + hstep, voffA);
        if (wr == 1) PG8_BAR;
        PG8_WAIT_V(4); PG8_BAR;
        PG8_STAGE(PG8_SB(1, 0), cB + kstep, voffB); PG8_STAGE(PG8_SA(1, 0), cA + kstep, voffA); PG8_STAGE(PG8_SB(1, 1), cB + hstep + kstep, voffB);
        PG8_WAIT_V(6); PG8_BAR;
    }
    for (;;) {
        const bool has_next = S.next(ui + 1, nxt);
        const char* nA = has_next ? (const char*)g.A + (size_t)nxt.pm * tstep : cA; const char* nB = has_next ? (const char*)g.Bt + (size_t)nxt.pn * tstep : cB;
        for (int t = 0; t < nt; t += 2) {
            const bool last = (t == nt - 2);
            const char* a1 = cA + (size_t)(t + 1) * kstep;
            const char* a2 = last ? nA : cA + (size_t)(t + 2) * kstep; const char* b2 = last ? nB : cB + (size_t)(t + 2) * kstep;
            const char* a3 = a2 + kstep; const char* b3 = b2 + kstep;
            if (last && has_next) S.a_ready(nxt);
            if constexpr (SP2) {
            PG8_LDB(B0, 0, 0); PG8_LDB(B1, 0, 1); PG8_SCHED; PG8_LDA(At, 0, 0); PG8_STAGE(PG8_SA(1, 1), a1 + hstep, voffA);
            PG8_WAIT_V(8); PG8_WAIT_L(0); PG8_BAR; PG8_MMA(0, 0, At, B0); PG8_MMA(0, 1, At, B1); PG8_BAR; PG8_SCHED;
            PG8_LDA(At, 0, 1); PG8_STAGE(PG8_SB(0, 0), b2, voffB); PG8_STAGE(PG8_SB(0, 1), b2 + hstep, voffB); PG8_STAGE(PG8_SA(0, 0), a2, voffA);
            PG8_WAIT_V(8); PG8_WAIT_L(0); PG8_BAR; PG8_MMA(1, 0, At, B0); PG8_MMA(1, 1, At, B1); PG8_BAR; PG8_SCHED;
            PG8_LDB(B0, 1, 0); PG8_LDB(B1, 1, 1); PG8_SCHED; PG8_LDA(At, 1, 0); PG8_STAGE(PG8_SA(0, 1), a2 + hstep, voffA);
            PG8_WAIT_V(8); PG8_WAIT_L(0); PG8_BAR; PG8_MMA(0, 0, At, B0); PG8_MMA(0, 1, At, B1); PG8_BAR; PG8_SCHED;
            PG8_LDA(At, 1, 1); PG8_STAGE(PG8_SB(1, 0), b3, voffB); PG8_STAGE(PG8_SB(1, 1), b3 + hstep, voffB); PG8_STAGE(PG8_SA(1, 0), a3, voffA);
            PG8_WAIT_V(8); PG8_WAIT_L(0); PG8_BAR; PG8_MMA(1, 0, At, B0); PG8_MMA(1, 1, At, B1); PG8_BAR; PG8_SCHED;
            } else {
            PG8_LDB(B0, 0, 0); PG8_SCHED; PG8_LDA(At, 0, 0); PG8_STAGE(PG8_SA(1, 1), a1 + hstep, voffA);
            PG8_WAIT_L(8); PG8_BAR; PG8_WAIT_L(0); PG8_MMA(0, 0, At, B0); PG8_BAR; PG8_SCHED;
            PG8_LDB(B1, 0, 1); PG8_STAGE(PG8_SB(0, 0), b2, voffB);
            PG8_BAR; PG8_WAIT_L(0); PG8_MMA(0, 1, At, B1); PG8_BAR;
            PG8_LDA(At, 0, 1); PG8_STAGE(PG8_SA(0, 0), a2, voffA);
            PG8_BAR; PG8_WAIT_L(0); PG8_MMA(1, 0, At, B0); PG8_BAR; PG8_SCHED;
            PG8_STAGE(PG8_SB(0, 1), b2 + hstep, voffB);
            PG8_WAIT_V(6); PG8_BAR; PG8_MMA(1, 1, At, B1); PG8_BAR;
            PG8_LDB(B0, 1, 0); PG8_SCHED; PG8_LDA(At, 1, 0); PG8_STAGE(PG8_SA(0, 1), a2 + hstep, voffA);
            PG8_WAIT_L(8); PG8_BAR; PG8_WAIT_L(0); PG8_MMA(0, 0, At, B0); PG8_BAR; PG8_SCHED;
            PG8_LDB(B1, 1, 1); PG8_STAGE(PG8_SB(1, 0), b3, voffB);
            PG8_BAR; PG8_WAIT_L(0); PG8_MMA(0, 1, At, B1); PG8_BAR;
            PG8_LDA(At, 1, 1); PG8_STAGE(PG8_SA(1, 0), a3, voffA);
            PG8_BAR; PG8_WAIT_L(0); PG8_MMA(1, 0, At, B0); PG8_BAR; PG8_SCHED;
            PG8_STAGE(PG8_SB(1, 1), b3 + hstep, voffB);
            PG8_WAIT_V(6); PG8_BAR; PG8_MMA(1, 1, At, B1); PG8_BAR;
            }
        }
        if constexpr (ALIGN_EPI) { if (wr == 0) PG8_BAR; }
        if constexpr (!Epi::AFTER_DRAIN) { E(acc, cur, wr, wc, fr, fq); S.done(cur); }
        if (!has_next) break;
#pragma unroll
        for (int a = 0; a < 2; ++a)
#pragma unroll
            for (int b = 0; b < 2; ++b)
#pragma unroll
                for (int m = 0; m < 4; ++m)
#pragma unroll
                    for (int n = 0; n < 2; ++n) acc[a][b][m][n] = (f32x4){0.f, 0.f, 0.f, 0.f};
        cur = nxt; cA = nA; cB = nB; ++ui;
        if constexpr (ALIGN_EPI) { if (wr == 1) PG8_BAR; }
    }
    PG8_WAIT_V(0);
    if constexpr (!ALIGN_EPI) { if (wr == 0) PG8_BAR; }
    PG8_BAR;
    if constexpr (Epi::AFTER_DRAIN) { E.fused(acc, cur, wr, wc, fr, fq, lds, wid, lane); S.done(cur); }
#undef PG8_SA
#undef PG8_SB
#undef PG8_STAGE
#undef PG8_LDA
#undef PG8_LDB
#undef PG8_MMA
#undef PG8_WAIT_V
#undef PG8_WAIT_L
#undef PG8_BAR
#undef PG8_SCHED
}
}

#define LAS __attribute__((address_space(3)))
typedef pg8::bf16_t bf16_t;
typedef pg8::bf16x8 bf16x8;
typedef pg8::f32x4 f32x4;
typedef pg8::u32x4 u32x4;
typedef unsigned u32x2 __attribute__((ext_vector_type(2)));
typedef float f32x2v __attribute__((ext_vector_type(2)));
using pg8::cvt_pk_bf16;
using pg8::fast_sigmoid;
using pg8::fast_silu;

constexpr int D = 1024, NB = 4, SEQ = 8192, NTOK = NB * SEQ;
#ifndef MK_NSPLIT
#define MK_NSPLIT 4
#endif
constexpr int NSPLIT = MK_NSPLIT, TS = SEQ / NSPLIT, MS = NB * TS;
constexpr int CL = 9728;
constexpr int C_R = 0, C_K = 1024, C_V = 2048, C_WLO = 3072, C_ALO = 3136, C_GLO = 3200, C_HQ = 3584, C_HF = 4608, C_HI = 5632, C_HG = 6656, C_GA = 7680, C_GB = 8704;
constexpr int CARRY_LD = 3584;
constexpr int DFF = 2816;
constexpr size_t MiB = 1u << 20, KiB = 1u << 10;
constexpr size_t WS_WIN = 0, WS_WOUT = 19 * MiB, WS_WQ = 21 * MiB, WS_WO = 23 * MiB, WS_WKV = 25 * MiB, WS_W13 = 29 * MiB, WS_W2 = 40 * MiB;
constexpr size_t WS_RW2T = 46 * MiB, WS_RA2T = 46 * MiB + 128 * KiB, WS_RG2T = 46 * MiB + 256 * KiB, WS_CARRY = 46 * MiB + 640 * KiB, WS_LB = 46 * MiB + 704 * KiB;
constexpr size_t WS_MBF = 47 * MiB, WS_KV = 49 * MiB, WS_VT = 53 * MiB, WS_RWST = 55 * MiB, WS_HGST = 56 * MiB, WS_BONUS = 58 * MiB;
constexpr size_t WS_G2TP = 59 * MiB;
constexpr size_t WS_MERGED = 64 * MiB;
constexpr size_t WS_U1 = 128 * MiB, WS_COLS = 144 * MiB, WS_PR = 296 * MiB, WS_PK = 312 * MiB, WS_PA = 328 * MiB, WS_PB = 344 * MiB, WS_PV = 360 * MiB, WS_PW = 376 * MiB, WS_ORAW = 408 * MiB, WS_HGO = 440 * MiB;
constexpr size_t WS_GATE = 472 * MiB, WS_ASG = 488 * MiB;
constexpr size_t WS_U = 128 * MiB, WS_Q = 192 * MiB, WS_AO = 256 * MiB, WS_FF = 320 * MiB, WS_CTL = 496 * MiB, CTL_BYTES = 64 * KiB, WS_END = 496 * MiB + 64 * KiB;
constexpr int LDS_BYTES = 147456, MISC_OFF = 131072 + 320;
constexpr int T0 = 1 + 5 * NSPLIT, N_PHASES = T0 + 9;

__device__ __forceinline__ float bflo(unsigned u) { return __uint_as_float(u << 16); }
__device__ __forceinline__ float bfhi(unsigned u) { return __uint_as_float(u & 0xffff0000u); }
__device__ __forceinline__ unsigned f2bf(float f) { unsigned u = __float_as_uint(f); return (u + 0x7fffu + ((u >> 16) & 1u)) >> 16; }
__device__ __forceinline__ f32x4 ld4bf(const bf16_t* p) { const u32x2 u = *(const u32x2*)p; return (f32x4){bflo(u.x), bfhi(u.x), bflo(u.y), bfhi(u.y)}; }
__device__ __forceinline__ void ld8bf(const bf16_t* p, float (&o)[8]) { const u32x4 u = *(const u32x4*)p; o[0] = bflo(u.x); o[1] = bfhi(u.x); o[2] = bflo(u.y); o[3] = bfhi(u.y); o[4] = bflo(u.z); o[5] = bfhi(u.z); o[6] = bflo(u.w); o[7] = bfhi(u.w); }
__device__ __forceinline__ void st4bf(bf16_t* p, f32x4 v) { u32x2 w; w.x = cvt_pk_bf16(v[0], v[1]); w.y = cvt_pk_bf16(v[2], v[3]); *(u32x2*)p = w; }
__device__ __forceinline__ bf16x8 pack8(const float (&t)[8]) { u32x4 w; w.x = cvt_pk_bf16(t[0], t[1]); w.y = cvt_pk_bf16(t[2], t[3]); w.z = cvt_pk_bf16(t[4], t[5]); w.w = cvt_pk_bf16(t[6], t[7]); return __builtin_bit_cast(bf16x8, w); }
__device__ __forceinline__ float tanh_fast(float x) { return 1.0f - 2.0f * __builtin_amdgcn_rcpf(1.0f + __expf(2.0f * x)); }
__device__ __forceinline__ float wave_sum(float v) {
#pragma unroll
    for (int o = 1; o < 64; o <<= 1) v += __shfl_xor(v, o);
    return v;
}
__device__ __forceinline__ float fq_sum(float v) { v += __shfl_xor(v, 16); v += __shfl_xor(v, 32); return v; }
template <int CTRL> __device__ __forceinline__ float dpp_add(float x) { return x + __builtin_bit_cast(float, __builtin_amdgcn_update_dpp(0, __builtin_bit_cast(int, x), CTRL, 0xf, 0xf, false)); }
#ifdef MK_SHFL_REDUCE
__device__ __forceinline__ float allreduce16(float x) { x += __shfl_xor(x, 1); x += __shfl_xor(x, 2); x += __shfl_xor(x, 4); x += __shfl_xor(x, 8); return x; }
#else
__device__ __forceinline__ float allreduce16(float x) { x = dpp_add<0xB1>(x); x = dpp_add<0x4E>(x); x = dpp_add<0x141>(x); x = dpp_add<0x140>(x); return x; }
#endif
__device__ __forceinline__ void allreduce16x2(float& x, float& y) {
    x = dpp_add<0xB1>(x); y = dpp_add<0xB1>(y); x = dpp_add<0x4E>(x); y = dpp_add<0x4E>(y); x = dpp_add<0x141>(x); y = dpp_add<0x141>(y); x = dpp_add<0x140>(x); y = dpp_add<0x140>(y); }
#define MFMA16(a, b, c) __builtin_amdgcn_mfma_f32_16x16x32_bf16((a), (b), (c), 0, 0, 0)

#define XB_TMO      128
#define XB_XCNT(j)  (256  + 64 * (j))
#define XB_XSUB(j)  (1280 + 64 * (j))
#define XB_XGEN(j)  (2304 + 64 * (j))
#define XB_TOP      3328
#define XB_TOPGEN   3392
#define XCD_BAR_WORDS 3456
#define XB_SPIN_CAP (1u << 18)

__device__ __forceinline__ unsigned xb_ld(unsigned* p)              { return __hip_atomic_load(p, __ATOMIC_RELAXED, __HIP_MEMORY_SCOPE_AGENT); }
__device__ __forceinline__ unsigned xb_add(unsigned* p, unsigned v) { return __hip_atomic_fetch_add(p, v, __ATOMIC_RELAXED, __HIP_MEMORY_SCOPE_AGENT); }
__device__ __forceinline__ unsigned xb_xcc_id() { return (unsigned)__builtin_amdgcn_s_getreg((3 << 11) | 20) & 0xFu; }
#define XB_SPIN(cond, bar) do { unsigned _sp = 0; while (cond) { __builtin_amdgcn_s_sleep(1); \
    if ((++_sp & 255u) == 0u) { if (xb_ld(&(bar)[XB_TMO])) break; if (_sp > XB_SPIN_CAP) { atomicAdd(&(bar)[XB_TMO], 1u); break; } } } } while (0)

struct XcdBarrier {
    unsigned* bar; unsigned x;
    volatile LAS unsigned* st;
};

__device__ __forceinline__ XcdBarrier xcd_barrier_post(unsigned* bar, volatile LAS unsigned* st) {
    XcdBarrier b; b.bar = bar; b.x = xb_xcc_id(); b.st = st;
    if (threadIdx.x == 0) (void)xb_add(&bar[XB_XCNT(b.x)], 1u);
    return b;
}
__device__ __forceinline__ void xcd_barrier_complete(unsigned* bar, unsigned x, unsigned& nloc, unsigned& nx) {
    const unsigned G = gridDim.x * gridDim.y * gridDim.z;
    unsigned sum, cnt, mine, sp = 0u;
    for (;;) {
        sum = 0u; cnt = 0u; mine = 0u;
#pragma unroll
        for (unsigned j = 0; j < 16; ++j) { const unsigned c = xb_ld(&bar[XB_XCNT(j)]); sum += c; cnt += (c > 0u) ? 1u : 0u; mine = (j == x) ? c : mine; }
        if (sum == G) break;
        __builtin_amdgcn_s_sleep(1);
        if ((++sp & 255u) == 0u) { if (xb_ld(&bar[XB_TMO])) break; if (sp > XB_SPIN_CAP) { atomicAdd(&bar[XB_TMO], 1u); break; } }
    }
    nloc = mine > 0u ? mine : 1u; nx = cnt > 0u ? cnt : 1u;
}

__device__ __forceinline__ void xcd_barrier(const XcdBarrier& b) {
    asm volatile("s_waitcnt vmcnt(0)" ::: "memory");
    __syncthreads();
    if (threadIdx.x == 0) {
        unsigned* bar = b.bar;
        __builtin_amdgcn_s_waitcnt(0);
        unsigned nloc = b.st[0], nx = b.st[1];
        if (nloc == 0u) { xcd_barrier_complete(bar, b.x, nloc, nx); b.st[0] = nloc; b.st[1] = nx; }
        const unsigned old = xb_add(&bar[XB_XSUB(b.x)], 1u);
        const unsigned gen = old / nloc;
        if (old + 1u == (gen + 1u) * nloc) {
            __builtin_amdgcn_fence(__ATOMIC_RELEASE, "agent");
            asm volatile("s_waitcnt vmcnt(0)" ::: "memory");
            const unsigned og = xb_add(&bar[XB_TOP], 1u);
            const unsigned tg = og / nx;
            if (og + 1u == (tg + 1u) * nx) xb_add(&bar[XB_TOPGEN], 1u);
            else XB_SPIN(xb_ld(&bar[XB_TOPGEN]) == tg, bar);
            __builtin_amdgcn_fence(__ATOMIC_ACQUIRE, "agent");
            xb_add(&bar[XB_XGEN(b.x)], 1u);
            asm volatile("s_waitcnt vmcnt(0)" ::: "memory");
        } else {
            XB_SPIN(xb_ld(&bar[XB_XGEN(b.x)]) == gen, bar);
            __builtin_amdgcn_fence(__ATOMIC_ACQUIRE, "agent");
            asm volatile("s_waitcnt vmcnt(0)" ::: "memory");
        }
    }
    __syncthreads();
}

__device__ __forceinline__ void rms_row_bf16(const float* src, const float* g, bf16_t* dst, int lane) {
    f32x4 v[4]; float s = 0.f;
#pragma unroll
    for (int j = 0; j < 4; ++j) { v[j] = ((const f32x4*)src)[lane + 64 * j]; s += (v[j][0] * v[j][0] + v[j][1] * v[j][1]) + (v[j][2] * v[j][2] + v[j][3] * v[j][3]); }
    const float rs = 1.0f / sqrtf(wave_sum(s) * (1.0f / 1024.0f) + 1e-6f);
#pragma unroll
    for (int j = 0; j < 4; ++j) { const f32x4 gv = ((const f32x4*)g)[lane + 64 * j]; st4bf(dst + 4 * (lane + 64 * j), v[j] * rs * gv); }
}
__device__ __forceinline__ void tr_item(const float* W, int K, int N, bf16_t* WT, int kb, int n0, int row_base, LAS float* scr, int lane) {
    const int k0 = 64 * kb;
#pragma unroll 8
    for (int i = 0; i < 32; ++i) { const int kk = 2 * i + (lane >> 5); scr[kk * 33 + (lane & 31)] = W[(size_t)(k0 + kk) * N + n0 + (lane & 31)]; }
    asm volatile("s_waitcnt lgkmcnt(0)" ::: "memory");
    const int c = lane & 7;
#pragma unroll
    for (int j = 0; j < 4; ++j) { const int n = (lane >> 3) + 8 * j; const LAS float* sp = scr + (8 * c) * 33 + n;
        u32x4 o; o.x = cvt_pk_bf16(sp[0 * 33], sp[1 * 33]); o.y = cvt_pk_bf16(sp[2 * 33], sp[3 * 33]); o.z = cvt_pk_bf16(sp[4 * 33], sp[5 * 33]); o.w = cvt_pk_bf16(sp[6 * 33], sp[7 * 33]);
        *(u32x4*)(WT + (size_t)(row_base + n) * K + k0 + 8 * c) = o; }
    asm volatile("s_waitcnt lgkmcnt(0)" ::: "memory");
}

__device__ __forceinline__ void prep_phase(int s, int gw, int NGW, int lane, const bf16_t* cols, const bf16_t* carry,
        const float* mu, const float* w0, const float* a0, const float* k_k, const float* k_a, const float* r_k,
        const bf16_t* w2T, const bf16_t* a2T, bf16_t* PR, bf16_t* PK, bf16_t* PA, bf16_t* PB, bf16_t* PV, float* PW, float* bonus, bf16_t* ASG) {
    const int fr = lane & 15, fq = lane >> 4;
    for (int item = gw; item < (MS / 16) * 4; item += NGW) {
        const int tile = item >> 2, hg4 = item & 3;
        const int lt = tile * 16 + fr, b = lt / TS, tl = lt % TS;
        const bf16_t* crow = cols + (size_t)lt * CL;
        const bf16_t* prow = tl > 0 ? crow - CL : carry + ((s & 1) * 4 + b) * CARRY_LD;
        bf16x8 Aw[2], Aa[2];
#pragma unroll
        for (int ks = 0; ks < 2; ++ks) {
            { const int c = C_WLO + ks * 32 + fq * 8; float cur[8], prv[8], t[8]; ld8bf(crow + c, cur); ld8bf(prow + c, prv);
              const f32x4 m0 = *(const f32x4*)(mu + c), m1 = *(const f32x4*)(mu + c + 4);
#pragma unroll
              for (int e = 0; e < 8; ++e) { const float mm = e < 4 ? m0[e & 3] : m1[e & 3]; t[e] = tanh_fast(cur[e] + mm * (prv[e] - cur[e])); }
              Aw[ks] = pack8(t); }
            { const int c = C_ALO + ks * 32 + fq * 8; float cur[8], prv[8], t[8]; ld8bf(crow + c, cur); ld8bf(prow + c, prv);
              const f32x4 m0 = *(const f32x4*)(mu + c), m1 = *(const f32x4*)(mu + c + 4);
#pragma unroll
              for (int e = 0; e < 8; ++e) { const float mm = e < 4 ? m0[e & 3] : m1[e & 3]; t[e] = cur[e] + mm * (prv[e] - cur[e]); }
              Aa[ks] = pack8(t); }
        }
        if (hg4 == 0) {
#pragma unroll
            for (int ks = 0; ks < 5; ++ks) { const int c = C_GLO + ks * 32 + fq * 8; float cur[8], prv[8], t[8]; ld8bf(crow + c, cur); ld8bf(prow + c, prv);
                const f32x4 m0 = *(const f32x4*)(mu + c), m1 = *(const f32x4*)(mu + c + 4);
#pragma unroll
                for (int e = 0; e < 8; ++e) { const float mm = e < 4 ? m0[e & 3] : m1[e & 3]; t[e] = fast_sigmoid(cur[e] + mm * (prv[e] - cur[e])); }
                *(bf16x8*)(ASG + (size_t)lt * 256 + ks * 32 + fq * 8) = pack8(t); }
#pragma unroll
            for (int ks = 5; ks < 8; ++ks) *(u32x4*)(ASG + (size_t)lt * 256 + ks * 32 + fq * 8) = (u32x4){0u, 0u, 0u, 0u};
        }
#pragma unroll 1
        for (int hh = 0; hh < 4; ++hh) {
            const int h = hg4 * 4 + hh;
            f32x4 aw[4], aa[4];
#pragma unroll
            for (int nt = 0; nt < 4; ++nt) { aw[nt] = (f32x4){0.f, 0.f, 0.f, 0.f}; aa[nt] = (f32x4){0.f, 0.f, 0.f, 0.f};
                const int n = h * 64 + nt * 16 + fr;
#pragma unroll
                for (int ks = 0; ks < 2; ++ks) { const bf16x8 bw = *(const bf16x8*)(w2T + n * 64 + ks * 32 + fq * 8); aw[nt] = MFMA16(bw, Aw[ks], aw[nt]);
                    const bf16x8 ba = *(const bf16x8*)(a2T + n * 64 + ks * 32 + fq * 8); aa[nt] = MFMA16(ba, Aa[ks], aa[nt]); } }
            f32x4 kkv[4], av[4]; float ssq = 0.f, bon = 0.f;
#pragma unroll
            for (int nt = 0; nt < 4; ++nt) {
                const int c = h * 64 + nt * 16 + 4 * fq; const size_t o = (size_t)lt * 1024 + c;
                const f32x4 rc = ld4bf(crow + C_R + c), rp = ld4bf(prow + C_R + c), kc = ld4bf(crow + C_K + c), kp = ld4bf(prow + C_K + c), vc = ld4bf(crow + C_V + c), vp = ld4bf(prow + C_V + c);
                const f32x4 r = rc + *(const f32x4*)(mu + C_R + c) * (rp - rc), k = kc + *(const f32x4*)(mu + C_K + c) * (kp - kc), v = vc + *(const f32x4*)(mu + C_V + c) * (vp - vc);
                const f32x4 w0v = *(const f32x4*)(w0 + c), a0v = *(const f32x4*)(a0 + c), kkp = *(const f32x4*)(k_k + c), kap = *(const f32x4*)(k_a + c), rkp = *(const f32x4*)(r_k + c);
                f32x4 wv, a, kk, kmod;
#pragma unroll
                for (int j = 0; j < 4; ++j) {
                    const float z = -(w0v[j] + aw[nt][j]);
                    const float sp = fmaxf(z, 0.f) + __logf(1.0f + __expf(-fabsf(z)));
                    wv[j] = __expf(-__expf(-sp - 0.5f));
                    a[j] = fast_sigmoid(a0v[j] + aa[nt][j]);
                    kk[j] = k[j] * kkp[j]; kmod[j] = k[j] * (1.0f + (a[j] - 1.0f) * kap[j]);
                    ssq += kk[j] * kk[j]; bon += r[j] * kmod[j] * rkp[j];
                }
                kkv[nt] = kk; av[nt] = a;
                st4bf(PR + o, r); st4bf(PK + o, kmod); st4bf(PV + o, v); *(f32x4*)(PW + o) = wv;
            }
            ssq = fq_sum(ssq); bon = fq_sum(bon);
            const float rs = 1.0f / sqrtf(fmaxf(ssq, 1e-24f));
#pragma unroll
            for (int nt = 0; nt < 4; ++nt) { const int c = h * 64 + nt * 16 + 4 * fq; const size_t o = (size_t)lt * 1024 + c;
                const f32x4 kn = kkv[nt] * rs; st4bf(PA + o, -kn); st4bf(PB + o, kn * av[nt]); }
            if (fq == 0) bonus[lt * 16 + h] = bon;
        }
    }
}

__device__ __forceinline__ void post_phase(int s, int gw, int NGW, int lane, const bf16_t* cols, const bf16_t* carry, const float* mu, const bf16_t* gate,
        const float* ln_w, const float* ln_b, const float* hg_g, const float* oraw, const float* hgo, const bf16_t* PV, const float* bonus, bf16_t* merged) {
    const int fr = lane & 15, fq = lane >> 4;
    for (int item = gw; item < (MS / 16) * 4; item += NGW) {
        const int tile = item >> 2, q4 = item & 3;
        const int lt = tile * 16 + fr, b = lt / TS, tl = lt % TS;
        const size_t gt = (size_t)b * SEQ + s * TS + tl;
        const bf16_t* crow = cols + (size_t)lt * CL;
        const bf16_t* prow = tl > 0 ? crow - CL : carry + ((s & 1) * 4 + b) * CARRY_LD;
#pragma unroll 1
        for (int hgh = 0; hgh < 2; ++hgh) {
            const int h8 = q4 * 2 + hgh;
            f32x4 ho[8]; float ss = 0.f;
#pragma unroll
            for (int n8 = 0; n8 < 8; ++n8) { ho[n8] = *(const f32x4*)(hgo + ((size_t)((b * 8 + h8) * 8 + n8) * TS + tl) * 16 + 4 * fq); ss += (ho[n8][0] * ho[n8][0] + ho[n8][1] * ho[n8][1]) + (ho[n8][2] * ho[n8][2] + ho[n8][3] * ho[n8][3]); }
            ss = fq_sum(ss);
            const float rsh = 1.0f / sqrtf(ss * (1.0f / 128.0f) + 1e-6f);
#pragma unroll
            for (int rwh = 0; rwh < 2; ++rwh) {
                const int h = q4 * 4 + hgh * 2 + rwh;
                f32x4 ag[4], o[4]; float sm = 0.f;
#pragma unroll
                for (int nt = 0; nt < 4; ++nt) { ag[nt] = ld4bf(gate + (size_t)lt * 1024 + h * 64 + nt * 16 + 4 * fq);
                    o[nt] = *(const f32x4*)(oraw + ((size_t)((b * 16 + h) * 4 + nt) * TS + tl) * 16 + 4 * fq); sm += (o[nt][0] + o[nt][1]) + (o[nt][2] + o[nt][3]); }
                const float mean = fq_sum(sm) * (1.0f / 64.0f); float vq = 0.f;
#pragma unroll
                for (int nt = 0; nt < 4; ++nt) { o[nt] = o[nt] - mean; vq += (o[nt][0] * o[nt][0] + o[nt][1] * o[nt][1]) + (o[nt][2] * o[nt][2] + o[nt][3] * o[nt][3]); }
                const float rstd = 1.0f / sqrtf(fq_sum(vq) * (1.0f / 64.0f) + 64e-5f);
#ifdef MK_NO_BONUS
                const float bon = 0.f;
#else
                const float bon = bonus[lt * 16 + h];
#endif
#pragma unroll
                for (int nt = 0; nt < 4; ++nt) {
                    const int c = h * 64 + nt * 16 + 4 * fq;
                    const f32x4 lw = *(const f32x4*)(ln_w + c), lb = *(const f32x4*)(ln_b + c), v = ld4bf(PV + (size_t)lt * 1024 + c);
                    const f32x4 ya = (o[nt] * rstd * lw + lb + v * bon) * ag[nt];
                    const f32x4 ng = *(const f32x4*)(hg_g + (c & 127)), gh = ld4bf(crow + C_HG + c), gar = ld4bf(crow + C_GA + c), gbr = ld4bf(crow + C_GB + c);
                    const f32x4 hv = ho[rwh * 4 + nt] * rsh * ng;
                    f32x4 m;
#pragma unroll
                    for (int j = 0; j < 4; ++j) {
#if defined(MK_ZERO_YA)
                        m[j] = fast_sigmoid(gbr[j]) * (hv[j] * fast_silu(gh[j]));
#elif defined(MK_ZERO_YB)
                        m[j] = fast_sigmoid(gar[j]) * ya[j];
#else
                        m[j] = fast_sigmoid(gar[j]) * ya[j] + fast_sigmoid(gbr[j]) * (hv[j] * fast_silu(gh[j]));
#endif
                    }
                    st4bf(merged + gt * 1024 + c, m);
                }
            }
        }
    }
}

constexpr int RWB = 45056;
#define SCAN_BAR_L() do { asm volatile("s_waitcnt vmcnt(0) lgkmcnt(0)" ::: "memory"); __builtin_amdgcn_s_barrier(); asm volatile("" ::: "memory"); } while (0)
#define SCAN_BAR_S() do { asm volatile("s_waitcnt lgkmcnt(0)" ::: "memory"); __builtin_amdgcn_s_barrier(); asm volatile("" ::: "memory"); } while (0)
__device__ __forceinline__ void rw_load(LAS unsigned char* bp, int lt2, size_t ltok0, int h, int rg, const bf16_t* PA, const float* PW, const bf16_t* PB, const bf16_t* PK, const bf16_t* PR, const bf16_t* PV) {
    const int tok = lt2 >> 3, c8 = (lt2 & 7) * 8; const size_t base = (ltok0 + tok) * 1024 + h * 64 + c8;
    const u32x4 ra = *(const u32x4*)(PA + base), rb = *(const u32x4*)(PB + base), rk = *(const u32x4*)(PK + base), rr = *(const u32x4*)(PR + base);
    const f32x4 w0 = *(const f32x4*)(PW + base), w1 = *(const f32x4*)(PW + base + 4);
    const unsigned rv = *(const unsigned*)(PV + (ltok0 + tok) * 1024 + h * 64 + rg * 16 + (lt2 & 7) * 2);
    const int off = (tok * 64 + c8) * 4;
#define RW_PUT(arr, u) do { *(LAS f32x4*)(bp + (arr) * 8192 + off) = (f32x4){bflo(u.x), bfhi(u.x), bflo(u.y), bfhi(u.y)}; *(LAS f32x4*)(bp + (arr) * 8192 + off + 16) = (f32x4){bflo(u.z), bfhi(u.z), bflo(u.w), bfhi(u.w)}; } while (0)
    RW_PUT(0, ra); RW_PUT(2, rb); RW_PUT(3, rk); RW_PUT(4, rr);
#undef RW_PUT
    *(LAS f32x4*)(bp + 8192 + off) = w0; *(LAS f32x4*)(bp + 8192 + off + 16) = w1;
    *(LAS f32x2v*)(bp + 40960 + (tok * 16 + (lt2 & 7) * 2) * 4) = (f32x2v){bflo(rv), bfhi(rv)};
}
__device__ __forceinline__ void y_drain(const LAS unsigned char* ybase, int lt2, float* dst) { *(f32x2v*)(dst + lt2 * 2) = *(const LAS f32x2v*)(ybase + lt2 * 8); }
__device__ __forceinline__ void rwkv_scan(int s, int bid, int G, int tid, int lane, int wave, LAS unsigned char* lds,
        const bf16_t* PA, const float* PW, const bf16_t* PB, const bf16_t* PK, const bf16_t* PR, const bf16_t* PV, float* oraw, float* state, bool save) {
    constexpr int NBLK = TS / 32;
    const int rowl = lane >> 4, j = lane & 15, row = (wave & 3) * 4 + rowl;
    for (int it = bid; it < 256; it += G) {
        const int b = it >> 6, h = (it >> 2) & 15, rg = it & 3;
        const size_t tok0 = (size_t)b * TS;
        float* stp = state + ((size_t)((b * 16 + h) * 64 + rg * 16 + row) * 64 + 4 * j);
        float* obase = oraw + (size_t)it * TS * 16;
        f32x4 st = (f32x4){0.f, 0.f, 0.f, 0.f};
        if (wave < 4 && s > 0) st = *(const f32x4*)stp;
        if (wave >= 4) { rw_load(lds, tid - 256, tok0, h, rg, PA, PW, PB, PK, PR, PV); SCAN_BAR_L(); } else { __builtin_amdgcn_s_setprio(2); asm volatile("s_waitcnt vmcnt(0)" ::: "memory"); SCAN_BAR_S(); }
#pragma unroll 1
        for (int blk = 0; blk < NBLK; ++blk) {
            if (wave >= 4) {
                if (blk > 0) y_drain(lds + ((blk - 1) & 1) * RWB + 43008, tid - 256, obase + (size_t)(blk - 1) * 512);
                if (blk + 1 < NBLK) rw_load(lds + ((blk + 1) & 1) * RWB, tid - 256, tok0 + (blk + 1) * 32, h, rg, PA, PW, PB, PK, PR, PV);
                SCAN_BAR_L();
            } else {
                const LAS unsigned char* bp = lds + (blk & 1) * RWB;
                const LAS unsigned char* p4 = bp + 16 * j; const LAS unsigned char* pv = bp + 40960 + row * 4; LAS unsigned char* py = (LAS unsigned char*)bp + 43008 + row * 4;
                f32x4 a4 = *(const LAS f32x4*)(p4), w4 = *(const LAS f32x4*)(p4 + 8192), b4 = *(const LAS f32x4*)(p4 + 16384), k4 = *(const LAS f32x4*)(p4 + 24576), r4 = *(const LAS f32x4*)(p4 + 32768);
                float vv = *(const LAS float*)(pv);
                float sa = (st[0] * a4[0] + st[1] * a4[1]) + (st[2] * a4[2] + st[3] * a4[3]);
                sa = allreduce16(sa);
#pragma unroll
                for (int t = 0; t < 32; ++t) {
                    f32x4 na = a4, nw = w4, nb = b4, nk = k4, nr = r4; float nv = vv;
                    if (t < 31) { const int o = (t + 1) * 256; na = *(const LAS f32x4*)(p4 + o); nw = *(const LAS f32x4*)(p4 + 8192 + o); nb = *(const LAS f32x4*)(p4 + 16384 + o); nk = *(const LAS f32x4*)(p4 + 24576 + o); nr = *(const LAS f32x4*)(p4 + 32768 + o); nv = *(const LAS float*)(pv + (t + 1) * 64); }
                    st = st * w4 + (b4 * sa + k4 * vv);
                    float y = (st[0] * r4[0] + st[1] * r4[1]) + (st[2] * r4[2] + st[3] * r4[3]);
                    float sn = (st[0] * na[0] + st[1] * na[1]) + (st[2] * na[2] + st[3] * na[3]);
                    allreduce16x2(sn, y);
                    if (j == 0) *(LAS float*)(py + t * 64) = y;
                    sa = sn; a4 = na; w4 = nw; b4 = nb; k4 = nk; r4 = nr; vv = nv;
                }
                SCAN_BAR_S();
            }
        }
        if (wave >= 4) { y_drain(lds + ((NBLK - 1) & 1) * RWB + 43008, tid - 256, obase + (size_t)(NBLK - 1) * 512); }
        else { __builtin_amdgcn_s_setprio(0); if (save) *(f32x4*)stp = st; }
    }
}

__device__ __forceinline__ void rwkv_scan_naive(int s, int gw, int NGW, int lane, int wave, LAS unsigned char* lds,
        const bf16_t* PA, const float* PW, const bf16_t* PB, const bf16_t* PK, const bf16_t* PR, const bf16_t* PV, float* oraw, float* state) {
    LAS float* slab = (LAS float*)(lds + wave * 2048);
    for (int it = gw; it < 64; it += NGW) {
        const int b = it >> 4, h = it & 15;
        float st[64];
        float* stp = state + (size_t)((b * 16 + h) * 64 + lane) * 64;
#pragma unroll
        for (int k = 0; k < 64; ++k) st[k] = (s > 0) ? stp[k] : 0.f;
        for (int tl = 0; tl < TS; ++tl) {
            const size_t base = ((size_t)b * TS + tl) * 1024 + h * 64 + lane;
            slab[lane] = bflo((unsigned)PA[base]); slab[64 + lane] = PW[base]; slab[128 + lane] = bflo((unsigned)PB[base]); slab[192 + lane] = bflo((unsigned)PK[base]); slab[256 + lane] = bflo((unsigned)PR[base]);
            const float vv = bflo((unsigned)PV[base]);
            asm volatile("s_waitcnt lgkmcnt(0)" ::: "memory");
            float sa = 0.f;
#pragma unroll
            for (int k = 0; k < 64; ++k) sa += st[k] * slab[k];
            float y = 0.f;
#pragma unroll
            for (int k = 0; k < 64; ++k) { st[k] = st[k] * slab[64 + k] + (sa * slab[128 + k] + vv * slab[192 + k]); y += st[k] * slab[256 + k]; }
            asm volatile("s_waitcnt lgkmcnt(0)" ::: "memory");
            oraw[((size_t)(it * 4 + (lane >> 4)) * TS + tl) * 16 + (lane & 15)] = y;
        }
#pragma unroll
        for (int k = 0; k < 64; ++k) stp[k] = st[k];
    }
}
constexpr int HGB = 53248;
__device__ __forceinline__ void hg_load(LAS unsigned char* bp, int lt2, size_t ltok0, int h8, int rg, const bf16_t* cols, const float* lbv) {
    const int tok = lt2 >> 3, c16 = (lt2 & 7) * 16; const bf16_t* crow = cols + (ltok0 + tok) * CL;
    float q[16], f[16];
    { float t[8]; ld8bf(crow + C_HQ + h8 * 128 + c16, t);
#pragma unroll
      for (int e = 0; e < 8; ++e) q[e] = t[e];
      ld8bf(crow + C_HQ + h8 * 128 + c16 + 8, t);
#pragma unroll
      for (int e = 0; e < 8; ++e) q[8 + e] = t[e];
      ld8bf(crow + C_HF + h8 * 128 + c16, t);
#pragma unroll
      for (int e = 0; e < 8; ++e) f[e] = t[e];
      ld8bf(crow + C_HF + h8 * 128 + c16 + 8, t);
#pragma unroll
      for (int e = 0; e < 8; ++e) f[8 + e] = t[e]; }
    const unsigned rv = *(const unsigned*)(crow + C_HI + h8 * 128 + rg * 16 + (lt2 & 7) * 2);
    const int off = (tok * 128 + c16) * 4;
#pragma unroll
    for (int g = 0; g < 4; ++g) { const f32x4 lb = *(const f32x4*)(lbv + h8 * 128 + c16 + 4 * g); f32x4 fv, kv, qv;
#pragma unroll
        for (int e = 0; e < 4; ++e) { fv[e] = lb[e] + (1.0f - lb[e]) * fast_sigmoid(f[4 * g + e]); kv[e] = 1.0f - fv[e]; qv[e] = fast_silu(q[4 * g + e]); }
        *(LAS f32x4*)(bp + off + 16 * g) = fv; *(LAS f32x4*)(bp + 16384 + off + 16 * g) = kv; *(LAS f32x4*)(bp + 32768 + off + 16 * g) = qv; }
    *(LAS f32x2v*)(bp + 49152 + (tok * 16 + (lt2 & 7) * 2) * 4) = (f32x2v){bflo(rv), bfhi(rv)};
}
__device__ __forceinline__ void hgrn_scan(int s, int bid, int G, int tid, int lane, int wave, LAS unsigned char* lds, const bf16_t* cols, const float* lbv, float* hgo, float* state, bool save) {
    constexpr int NBLK = TS / 32;
    const int rowl = lane >> 4, j = lane & 15, row = (wave & 3) * 4 + rowl;
    for (int it = bid; it < 256; it += G) {
        const int b = it >> 6, h8 = (it >> 3) & 7, rg = it & 7;
        const size_t tok0 = (size_t)b * TS;
        float* stp = state + ((size_t)((b * 8 + h8) * 128 + rg * 16 + row) * 128 + 4 * j);
        float* obase = hgo + (size_t)it * TS * 16;
        f32x4 s0 = (f32x4){0.f, 0.f, 0.f, 0.f}, s1 = s0;
        if (wave < 4 && s > 0) { s0 = *(const f32x4*)stp; s1 = *(const f32x4*)(stp + 64); }
        if (wave >= 4) { hg_load(lds, tid - 256, tok0, h8, rg, cols, lbv); SCAN_BAR_L(); } else { __builtin_amdgcn_s_setprio(2); asm volatile("s_waitcnt vmcnt(0)" ::: "memory"); SCAN_BAR_S(); }
#pragma unroll 1
        for (int blk = 0; blk < NBLK; ++blk) {
            if (wave >= 4) {
                if (blk > 0) y_drain(lds + ((blk - 1) & 1) * HGB + 51200, tid - 256, obase + (size_t)(blk - 1) * 512);
                if (blk + 1 < NBLK) hg_load(lds + ((blk + 1) & 1) * HGB, tid - 256, tok0 + (blk + 1) * 32, h8, rg, cols, lbv);
                SCAN_BAR_L();
            } else {
                const LAS unsigned char* bp = lds + (blk & 1) * HGB;
                const LAS unsigned char* p4 = bp + 16 * j; const LAS unsigned char* pv = bp + 49152 + row * 4; LAS unsigned char* py = (LAS unsigned char*)bp + 51200 + row * 4;
                f32x4 f0 = *(const LAS f32x4*)(p4), f1 = *(const LAS f32x4*)(p4 + 256), k0 = *(const LAS f32x4*)(p4 + 16384), k1 = *(const LAS f32x4*)(p4 + 16384 + 256), q0 = *(const LAS f32x4*)(p4 + 32768), q1 = *(const LAS f32x4*)(p4 + 32768 + 256);
                float iv = *(const LAS float*)(pv); float yprev = 0.f;
#pragma unroll
                for (int t = 0; t < 32; ++t) {
                    f32x4 nf0 = f0, nf1 = f1, nk0 = k0, nk1 = k1, nq0 = q0, nq1 = q1; float niv = iv;
                    if (t < 31) { const int o = (t + 1) * 512; nf0 = *(const LAS f32x4*)(p4 + o); nf1 = *(const LAS f32x4*)(p4 + 256 + o); nk0 = *(const LAS f32x4*)(p4 + 16384 + o); nk1 = *(const LAS f32x4*)(p4 + 16384 + 256 + o);
                                  nq0 = *(const LAS f32x4*)(p4 + 32768 + o); nq1 = *(const LAS f32x4*)(p4 + 32768 + 256 + o); niv = *(const LAS float*)(pv + (t + 1) * 64); }
                    s0 = s0 * f0 + k0 * iv; s1 = s1 * f1 + k1 * iv;
                    float y = ((s0[0] * q0[0] + s0[1] * q0[1]) + (s0[2] * q0[2] + s0[3] * q0[3])) + ((s1[0] * q1[0] + s1[1] * q1[1]) + (s1[2] * q1[2] + s1[3] * q1[3]));
                    if (t & 1) { allreduce16x2(yprev, y); if (j == 0) { *(LAS float*)(py + (t - 1) * 64) = yprev; *(LAS float*)(py + t * 64) = y; } }
                    yprev = y;
                    f0 = nf0; f1 = nf1; k0 = nk0; k1 = nk1; q0 = nq0; q1 = nq1; iv = niv;
                }
                SCAN_BAR_S();
            }
        }
        if (wave >= 4) { y_drain(lds + ((NBLK - 1) & 1) * HGB + 51200, tid - 256, obase + (size_t)(NBLK - 1) * 512); }
        else { __builtin_amdgcn_s_setprio(0); if (save) { *(f32x4*)stp = s0; *(f32x4*)(stp + 64) = s1; } }
    }
}

__device__ __forceinline__ void attn_phase(int gw, int NGW, int lane, const bf16_t* Q, const bf16_t* KV, const bf16_t* Vt, bf16_t* AO) {
    const int fr = lane & 15, fq = lane >> 4;
    for (int item = gw; item < 8192; item += NGW) {
        const int bh = item >> 9, tile = item & 511, b = bh >> 2, hd = bh & 3;
        const size_t gt = (size_t)b * SEQ + tile * 16 + fr;
        bf16x8 qf[8];
#pragma unroll
        for (int ks = 0; ks < 8; ++ks) qf[ks] = *(const bf16x8*)(Q + gt * 1024 + hd * 256 + ks * 32 + fq * 8);
        f32x4 sc[16]; float mx = -3.0e38f;
#pragma unroll
        for (int kt = 0; kt < 16; ++kt) { f32x4 acc = (f32x4){0.f, 0.f, 0.f, 0.f}; const bf16_t* kp = KV + (size_t)(b * 256 + kt * 16 + fr) * 2048 + hd * 256 + fq * 8;
#pragma unroll
            for (int ks = 0; ks < 8; ++ks) acc = MFMA16(*(const bf16x8*)(kp + ks * 32), qf[ks], acc);
            sc[kt] = acc * 0.0625f; mx = fmaxf(mx, fmaxf(fmaxf(sc[kt][0], sc[kt][1]), fmaxf(sc[kt][2], sc[kt][3]))); }
        mx = fmaxf(mx, __shfl_xor(mx, 16)); mx = fmaxf(mx, __shfl_xor(mx, 32));
        float sum = 0.f;
#pragma unroll
        for (int kt = 0; kt < 16; ++kt) {
#pragma unroll
            for (int jj = 0; jj < 4; ++jj) { sc[kt][jj] = __expf(sc[kt][jj] - mx); sum += sc[kt][jj]; } }
        sum = fq_sum(sum);
        const float inv = 1.0f / sum;
        bf16x8 pf[8];
#pragma unroll
        for (int k2 = 0; k2 < 8; ++k2) { u32x4 w; w.x = cvt_pk_bf16(sc[2 * k2][0], sc[2 * k2][1]); w.y = cvt_pk_bf16(sc[2 * k2][2], sc[2 * k2][3]); w.z = cvt_pk_bf16(sc[2 * k2 + 1][0], sc[2 * k2 + 1][1]); w.w = cvt_pk_bf16(sc[2 * k2 + 1][2], sc[2 * k2 + 1][3]); pf[k2] = __builtin_bit_cast(bf16x8, w); }
#pragma unroll 2
        for (int dt = 0; dt < 16; ++dt) { f32x4 acc = (f32x4){0.f, 0.f, 0.f, 0.f}; const bf16_t* vp = Vt + (size_t)((b * 4 + hd) * 256 + dt * 16 + fr) * 256 + fq * 8;
#pragma unroll
            for (int k2 = 0; k2 < 8; ++k2) acc = MFMA16(*(const bf16x8*)(vp + k2 * 32), pf[k2], acc);
            st4bf(AO + gt * 1024 + hd * 256 + dt * 16 + 4 * fq, acc * inv); }
    }
}

__device__ __forceinline__ int tid_fresh() { int t = threadIdx.x; asm volatile("" : "+v"(t)); return t; }
#define WinT ((bf16_t*)(a.ws + WS_WIN))
#define WoutT ((bf16_t*)(a.ws + WS_WOUT))
#define WqT ((bf16_t*)(a.ws + WS_WQ))
#define WoT ((bf16_t*)(a.ws + WS_WO))
#define WkvT ((bf16_t*)(a.ws + WS_WKV))
#define W13T ((bf16_t*)(a.ws + WS_W13))
#define W2T ((bf16_t*)(a.ws + WS_W2))
#define rw2T ((bf16_t*)(a.ws + WS_RW2T))
#define ra2T ((bf16_t*)(a.ws + WS_RA2T))
#define rg2T ((bf16_t*)(a.ws + WS_RG2T))
#define g2Tp ((bf16_t*)(a.ws + WS_G2TP))
#define GATE ((bf16_t*)(a.ws + WS_GATE))
#define ASG ((bf16_t*)(a.ws + WS_ASG))
#define carry ((bf16_t*)(a.ws + WS_CARRY))
#define lbv ((float*)(a.ws + WS_LB))
#define mbf ((bf16_t*)(a.ws + WS_MBF))
#define KV ((bf16_t*)(a.ws + WS_KV))
#define Vt ((bf16_t*)(a.ws + WS_VT))
#define rwst ((float*)(a.ws + WS_RWST))
#define hgst ((float*)(a.ws + WS_HGST))
#define bonus ((float*)(a.ws + WS_BONUS))
#define merged ((bf16_t*)(a.ws + WS_MERGED))
#define u1 ((bf16_t*)(a.ws + WS_U1))
#define cols ((bf16_t*)(a.ws + WS_COLS))
#define PR ((bf16_t*)(a.ws + WS_PR))
#define PK ((bf16_t*)(a.ws + WS_PK))
#define PA ((bf16_t*)(a.ws + WS_PA))
#define PB ((bf16_t*)(a.ws + WS_PB))
#define PV ((bf16_t*)(a.ws + WS_PV))
#define PW ((float*)(a.ws + WS_PW))
#define oraw ((float*)(a.ws + WS_ORAW))
#define hgo ((float*)(a.ws + WS_HGO))
#define U ((bf16_t*)(a.ws + WS_U))
#define Qb ((bf16_t*)(a.ws + WS_Q))
#define AO ((bf16_t*)(a.ws + WS_AO))
#define FF ((bf16_t*)(a.ws + WS_FF))
#define XIN (a.in[0])
#define OUTP (a.out)
struct Args { const float* in[29]; float* out; unsigned char* ws; int ph_lo, ph_hi; };

typedef const __attribute__((address_space(4))) Args* CArgsP;
__device__ __forceinline__ CArgsP args_fresh() { CArgsP p = (CArgsP)__builtin_amdgcn_kernarg_segment_ptr(); asm volatile("" : "+s"(p)); return p; }
__global__ void __launch_bounds__(512, 2) mega(Args a0) {
    extern __shared__ __attribute__((aligned(16))) unsigned char lds_raw[];
    LAS unsigned char* lds = (LAS unsigned char*)lds_raw;
    cg::grid_group grid = cg::this_grid();
    const int G = gridDim.x, bid = blockIdx.x, NGW = G * 8, NGT = G * 512;
#define IDS const auto& a = *args_fresh(); const int tid = tid_fresh(), lane = tid & 63, wave = __builtin_amdgcn_readfirstlane(tid >> 6), gw = bid * 8 + wave, gtid = bid * 512 + tid; (void)lane; (void)gw; (void)gtid
    const int lo = a0.ph_lo, hi = a0.ph_hi;
    { volatile LAS unsigned* misc = (volatile LAS unsigned*)(lds + MISC_OFF); if (threadIdx.x < 2) misc[threadIdx.x] = 0u; __syncthreads();
      if (hi - lo > 1) (void)xcd_barrier_post((unsigned*)(a0.ws + WS_CTL), misc); }
#ifndef MK_REP
#define MK_REP -1
#endif
#ifndef MK_REPN
#define MK_REPN 3
#endif
#define RPT(code) for (int rep_ = 0, nrep_ = (MK_REP == (code)) ? MK_REPN : 1; rep_ < nrep_; ++rep_)
#define LASTREP (rep_ == nrep_ - 1)
#define IN(k) (lo <= (k) && (k) < hi)
#define SEAM(k) do { if (IN(k) && IN((k) + 1)) RPT(120) { if ((k) == 0) { asm volatile("s_waitcnt vmcnt(0) lgkmcnt(0)" ::: "memory"); grid.sync(); __builtin_amdgcn_fence(__ATOMIC_ACQUIRE, "agent"); asm volatile("s_waitcnt vmcnt(0)" ::: "memory"); } else { XcdBarrier xb_; xb_.bar = (unsigned*)(args_fresh()->ws + WS_CTL); xb_.x = xb_xcc_id(); xb_.st = (volatile LAS unsigned*)(lds + MISC_OFF); xcd_barrier(xb_); } } } while (0)

    if (IN(0)) { IDS;
        LAS float* scr = (LAS float*)(lds + wave * 16384);
        constexpr int I_IN = 16 * 297, I_SQ = 16 * 32, I_13 = 16 * 88, I_2 = 44 * 32;
        constexpr int NITEMS = I_IN + 5 * I_SQ + 2 * I_13 + I_2;
        for (int it = gw; it < NITEMS; it += NGW) {
            int r = it;
            if (r < I_IN) { const int kb = r / 297, n0 = (r % 297) * 32; tr_item(a.in[3], 1024, 9504, WinT, kb, n0, n0 + (n0 >= 3360 ? 224 : 0), scr, lane); continue; } r -= I_IN;
            if (r < I_SQ) { tr_item(a.in[17], 1024, 1024, WoutT, r / 32, (r % 32) * 32, (r % 32) * 32, scr, lane); continue; } r -= I_SQ;
            if (r < I_SQ) { tr_item(a.in[20], 1024, 1024, WqT, r / 32, (r % 32) * 32, (r % 32) * 32, scr, lane); continue; } r -= I_SQ;
            if (r < I_SQ) { tr_item(a.in[23], 1024, 1024, WoT, r / 32, (r % 32) * 32, (r % 32) * 32, scr, lane); continue; } r -= I_SQ;
            if (r < I_SQ) { tr_item(a.in[21], 1024, 1024, WkvT, r / 32, (r % 32) * 32, (r % 32) * 32, scr, lane); continue; } r -= I_SQ;
            if (r < I_SQ) { tr_item(a.in[22], 1024, 1024, WkvT, r / 32, (r % 32) * 32, 1024 + (r % 32) * 32, scr, lane); continue; } r -= I_SQ;
            if (r < I_13) { const int n0 = (r % 88) * 32; tr_item(a.in[25], 1024, DFF, W13T, r / 88, n0, (n0 / 128) * 256 + (n0 % 128), scr, lane); continue; } r -= I_13;
            if (r < I_13) { const int n0 = (r % 88) * 32; tr_item(a.in[26], 1024, DFF, W13T, r / 88, n0, (n0 / 128) * 256 + 128 + (n0 % 128), scr, lane); continue; } r -= I_13;
            tr_item(a.in[27], DFF, 1024, W2T, r / 32, (r % 32) * 32, (r % 32) * 32, scr, lane);
        }
        for (int i = gtid; i < 28672; i += NGT) ((u32x4*)(WinT + 3360 * 1024))[i] = (u32x4){0u, 0u, 0u, 0u};
        for (int i = gtid; i < 1792; i += NGT) ((u32x4*)carry)[i] = (u32x4){0u, 0u, 0u, 0u};
        for (int n = gw; n < 1024; n += NGW) { rw2T[n * 64 + lane] = (bf16_t)f2bf(a.in[6][lane * 1024 + n]); ra2T[n * 64 + lane] = (bf16_t)f2bf(a.in[8][lane * 1024 + n]); }
        for (int m = gw; m < 512; m += NGW) {
            for (int e = lane; e < 320; e += 64) { const int n = 2 * m + (e >= 160 ? 1 : 0), k = e >= 160 ? e - 160 : e; rg2T[n * 160 + k] = (bf16_t)f2bf(a.in[9][k * 1024 + n]); } }
        for (int n = gw; n < 1024; n += NGW) { f32x4 v;
#pragma unroll
            for (int e = 0; e < 4; ++e) { const int k = 4 * lane + e; v[e] = k < 160 ? a.in[9][k * 1024 + n] : 0.f; }
            st4bf(g2Tp + n * 256 + 4 * lane, v); }
        for (int i = gtid; i < 1024; i += NGT) lbv[i] = 1.0f / (1.0f + __expf(a.in[15][1024 + i] - a.in[15][i]));
        for (int m = gw; m < 1024; m += NGW) rms_row_bf16(a.in[1] + (size_t)m * 1024, a.in[19], mbf + (size_t)m * 1024, lane);
        __syncthreads();
    }
    SEAM(0);

#pragma unroll 1
    for (int s = 0; s < NSPLIT; ++s) {
        const int pb = 1 + 5 * s;
        if (IN(pb)) { IDS;
            RPT(101) for (int lt = gw; lt < MS; lt += NGW) { const int b = lt / TS, tl = lt % TS; const size_t gt = (size_t)b * SEQ + s * TS + tl; rms_row_bf16(XIN + gt * 1024, a.in[2], u1 + (size_t)lt * 1024, lane); }
        }
        SEAM(pb);
        if (IN(pb + 1)) { const auto& a = *args_fresh();
            pg8::Gemm g{u1, WinT, MS, CL, 1024}; pg8::StaticOrder S; S.init(MS, CL, G, bid);
            pg8::EpiStoreBf16 E{cols, CL};
            RPT(102) pg8::gemm_phase<pg8::EpiStoreBf16, pg8::StaticOrder, true, true>(lds, g, S, E);
        }
        SEAM(pb + 1);
#ifndef SKIP_PREP
        if (IN(pb + 2)) { IDS; RPT(103) prep_phase(s, gw, NGW, lane, cols, carry, a.in[4], a.in[5], a.in[7], a.in[10], a.in[11], a.in[12], rw2T, ra2T, PR, PK, PA, PB, PV, PW, bonus, ASG); }
#endif
        SEAM(pb + 2);
        if (IN(pb + 3)) { IDS;
#ifdef MK_ZERO_SCAN
            for (int i = gtid; i < MS * 256; i += NGT) { ((f32x4*)oraw)[i] = (f32x4){0.f, 0.f, 0.f, 0.f}; ((f32x4*)hgo)[i] = (f32x4){0.01f, 0.02f, 0.03f, 0.04f}; }
#endif
#ifdef MK_NAIVE_RW
            rwkv_scan_naive(s, gw, NGW, lane, wave, lds, PA, PW, PB, PK, PR, PV, oraw, rwst);
#endif
#ifndef SKIP_RW
            RPT(104) { rwkv_scan(s, bid, G, tid, lane, wave, lds, PA, PW, PB, PK, PR, PV, oraw, rwst, LASTREP); __syncthreads(); }
#endif
            __syncthreads();
#ifndef SKIP_HG
            RPT(105) { hgrn_scan(s, bid, G, tid, lane, wave, lds, cols, lbv, hgo, hgst, LASTREP); __syncthreads(); }
#endif
            { pg8::Gemm g{ASG, g2Tp, MS, 1024, 256}; pg8::StaticOrder S; S.init(MS, 1024, G, bid); pg8::EpiStoreBf16 E{GATE, 1024};
              pg8::gemm_phase<pg8::EpiStoreBf16, pg8::StaticOrder, true, true>(lds, g, S, E); }
        }
        SEAM(pb + 3);
        if (IN(pb + 4)) { IDS;
#ifdef MK_NOMIX
            for (int i = gtid; i < MS * 128; i += NGT) { const int lt = i >> 7, b = lt / TS, tl = lt % TS; const size_t gt = (size_t)b * SEQ + s * TS + tl; ((u32x4*)(merged + gt * 1024))[i & 127] = (u32x4){0u, 0u, 0u, 0u}; }
#endif
#ifndef SKIP_POST
            RPT(106) post_phase(s, gw, NGW, lane, cols, carry, a.in[4], GATE, a.in[13], a.in[14], a.in[16], oraw, hgo, PV, bonus, merged);
#endif
            if (bid < 4 && s + 1 < NSPLIT) { const u32x4* src = (const u32x4*)(cols + (size_t)(bid * TS + TS - 1) * CL); u32x4* dst = (u32x4*)(carry + (((s + 1) & 1) * 4 + bid) * CARRY_LD);
                for (int i = tid; i < CARRY_LD / 8; i += 512) dst[i] = src[i]; }
        }
        SEAM(pb + 4);
    }

    if (IN(T0 + 0)) { const auto& a = *args_fresh();
        { pg8::Gemm g{merged, WoutT, NTOK, 1024, 1024}; pg8::StaticOrder S; S.init(NTOK, 1024, G, bid); pg8::EpiResF32 E{XIN, OUTP, 1024};
          pg8::gemm_phase<pg8::EpiResF32, pg8::StaticOrder, true, true>(lds, g, S, E); }
        { pg8::Gemm g{mbf, WkvT, 1024, 2048, 1024}; pg8::StaticOrder S; S.init(1024, 2048, G, bid); pg8::EpiStoreBf16 E{KV, 2048};
          pg8::gemm_phase<pg8::EpiStoreBf16, pg8::StaticOrder, true, true>(lds, g, S, E); }
    }
    SEAM(T0 + 0);
    if (IN(T0 + 1)) { IDS;
        for (int gt = gw; gt < NTOK; gt += NGW) rms_row_bf16(OUTP + (size_t)gt * 1024, a.in[18], U + (size_t)gt * 1024, lane);
        for (int i = gtid; i < 4 * 4 * 256 * 256; i += NGT) { const int kp = i & 255, dim = (i >> 8) & 255, hd = (i >> 16) & 3, b = i >> 18;
            const int k2 = kp >> 5, fq = (kp >> 3) & 3, sl = kp & 7; const int key = 32 * k2 + (sl < 4 ? 4 * fq + sl : 16 + 4 * fq + sl - 4);
            Vt[i] = KV[(size_t)(b * 256 + key) * 2048 + 1024 + hd * 256 + dim]; }
    }
    SEAM(T0 + 1);
    if (IN(T0 + 2)) { const auto& a = *args_fresh(); pg8::Gemm g{U, WqT, NTOK, 1024, 1024}; pg8::StaticOrder S; S.init(NTOK, 1024, G, bid); pg8::EpiStoreBf16 E{Qb, 1024};
        RPT(112) pg8::gemm_phase<pg8::EpiStoreBf16, pg8::StaticOrder, true, true>(lds, g, S, E); }
    SEAM(T0 + 2);
#ifndef SKIP_ATTN
    if (IN(T0 + 3)) { IDS; RPT(113) attn_phase(gw, NGW, lane, Qb, KV, Vt, AO); }
#endif
    SEAM(T0 + 3);
#ifndef MK_NOATT
    if (IN(T0 + 4)) { const auto& a = *args_fresh(); pg8::Gemm g{AO, WoT, NTOK, 1024, 1024}; pg8::StaticOrder S; S.init(NTOK, 1024, G, bid); pg8::EpiResF32 E{OUTP, OUTP, 1024};
        pg8::gemm_phase<pg8::EpiResF32, pg8::StaticOrder, true, true>(lds, g, S, E); }
#endif
    SEAM(T0 + 4);
    if (IN(T0 + 5)) { IDS; RPT(115) for (int gt = gw; gt < NTOK; gt += NGW) rms_row_bf16(OUTP + (size_t)gt * 1024, a.in[24], U + (size_t)gt * 1024, lane); }
    SEAM(T0 + 5);
    if (IN(T0 + 6)) { const auto& a = *args_fresh(); pg8::Gemm g{U, W13T, NTOK, 2 * DFF, 1024}; pg8::StaticOrder S; S.init(NTOK, 2 * DFF, G, bid); pg8::EpiSwiGLU E{FF, DFF};
        RPT(116) pg8::gemm_phase<pg8::EpiSwiGLU, pg8::StaticOrder, true, true>(lds, g, S, E); }
    SEAM(T0 + 6);
    if (IN(T0 + 7)) { const auto& a = *args_fresh(); pg8::Gemm g{FF, W2T, NTOK, 1024, DFF}; pg8::StaticOrder S; S.init(NTOK, 1024, G, bid); pg8::EpiResF32 E{OUTP, OUTP, 1024};
        pg8::gemm_phase<pg8::EpiResF32, pg8::StaticOrder, true, true>(lds, g, S, E); }
    SEAM(T0 + 7);
    if (IN(T0 + 8)) { IDS;
        const float* gf = a.in[28];
        for (int gt = gw; gt < NTOK; gt += NGW) { f32x4* row = (f32x4*)(OUTP + (size_t)gt * 1024); f32x4 v[4]; float sq = 0.f;
#pragma unroll
            for (int j = 0; j < 4; ++j) { v[j] = row[lane + 64 * j]; sq += (v[j][0] * v[j][0] + v[j][1] * v[j][1]) + (v[j][2] * v[j][2] + v[j][3] * v[j][3]); }
            const float rs = 1.0f / sqrtf(wave_sum(sq) * (1.0f / 1024.0f) + 1e-6f);
#pragma unroll
            for (int j = 0; j < 4; ++j) row[lane + 64 * j] = v[j] * rs * ((const f32x4*)gf)[lane + 64 * j]; }
    }
#undef IN
#undef SEAM
}

#ifndef MK_MULTI
#define MK_MULTI 0
#endif
extern "C" void kernel_launch(void* const* d_in, const int* in_sizes, int n_in, void* d_out, int out_size, void* d_ws, size_t ws_size, hipStream_t stream) {
    static int grid = 0;
    if (grid == 0) {
        if (n_in != 29 || in_sizes[0] != NTOK * D || out_size != NTOK * D || ws_size < WS_END) { fprintf(stderr, "kernel_launch: unexpected shapes / workspace (%d inputs, ws %zu)\n", n_in, ws_size); grid = -1; return; }
        int dev = 0, cus = 0, per_cu = 0;
        hipGetDevice(&dev); hipDeviceGetAttribute(&cus, hipDeviceAttributeMultiprocessorCount, dev);
        hipFuncSetAttribute((const void*)mega, hipFuncAttributeMaxDynamicSharedMemorySize, LDS_BYTES);
        hipOccupancyMaxActiveBlocksPerMultiprocessor(&per_cu, (const void*)mega, 512, LDS_BYTES);
        (void)hipGetLastError();
        if (per_cu < 1) per_cu = 1;
        grid = cus;
    }
    if (grid < 0) return;
    Args a{};
    for (int i = 0; i < 29; ++i) a.in[i] = (const float*)d_in[i];
    a.out = (float*)d_out; a.ws = (unsigned char*)d_ws;
    (void)hipMemsetAsync((char*)d_ws + WS_CTL, 0, CTL_BYTES, stream);
    void* args[] = {&a};
#if MK_MULTI
    for (int ph = 0; ph < N_PHASES; ++ph) { a.ph_lo = ph; a.ph_hi = ph + 1; hipLaunchCooperativeKernel((const void*)mega, dim3(grid), dim3(512), args, LDS_BYTES, stream); }
#else
    a.ph_lo = 0; a.ph_hi = N_PHASES;
    hipError_t e = hipLaunchCooperativeKernel((const void*)mega, dim3(grid), dim3(512), args, LDS_BYTES, stream);
    if (e != hipSuccess) fprintf(stderr, "cooperative launch failed: %s (grid %d)\n", hipGetErrorString(e), grid);
#endif
}
```

```cpp
#include <hip/hip_runtime.h>
#include <hip/hip_cooperative_groups.h>
#include <cstdint>
#include <cstdio>
namespace cg = cooperative_groups;
namespace pg8 {
#define PG8_LAS __attribute__((address_space(3)))
typedef unsigned short bf16_t;
typedef short bf16x8 __attribute__((ext_vector_type(8)));
typedef float f32x4 __attribute__((ext_vector_type(4)));
typedef unsigned u32x4 __attribute__((ext_vector_type(4)));
constexpr int BM = 256, BK = 64, HALF = 128, HTB = HALF * BK * 2  , STAGE_BYTES = 8 * HTB, NXCD = 8, WGM = 8;

__host__ __device__ __forceinline__ int lds_byte(int r, int c) { const int st = (r >> 4) * 2 + (c >> 5), rr = r & 15, cc = c & 31, ob = rr * 64 + cc * 2; return st * 1024 + (ob ^ (((ob >> 9) & 1) << 5)); }
__host__ __device__ __forceinline__ void stage_rc(int b, int& R, int& C) { const int st = b / 1024, sb = b % 1024, swz = sb ^ (((sb >> 9) & 1) << 5); R = (st >> 1) * 16 + swz / 64; C = (st & 1) * 32 + (swz % 64) / 2; }
__host__ __device__ __forceinline__ int perm32(int rho) { const int n = rho >> 4, i = rho & 15; return 8 * (i >> 2) + 4 * n + (i & 3); }

struct Unit { int pm, pn; };
struct Gemm { const bf16_t* A; const bf16_t* Bt; int M, N, K; };

struct StaticOrder {
    int nM, nN, nwg, G, c;
    __host__ __device__ void init(int M, int N, int G_, int c_) { nM = M / BM; nN = N / BM; nwg = nM * nN; G = G_; c = c_; }
    __host__ __device__ bool next(int i, Unit& u) const {
        const long L = (long)i * G + c; if (L >= nwg) return false;
        int wgid = (int)L; { const int q = nwg / NXCD, r = nwg % NXCD, xcd = wgid % NXCD, off = wgid / NXCD; wgid = (xcd < r ? xcd * (q + 1) : r * (q + 1) + (xcd - r) * q) + off; }
        const int nig = WGM * nN, gid = wgid / nig, fm = gid * WGM, gsz = (nM - fm) < WGM ? (nM - fm) : WGM;
        u.pm = fm + ((wgid % nig) % gsz); u.pn = (wgid % nig) / gsz; return true;
    }
    __device__ __forceinline__ void a_ready(const Unit&) const {}
    __device__ __forceinline__ void done(const Unit&) const {}
};

__device__ __forceinline__ unsigned cvt_pk_bf16(float lo, float hi) { unsigned r; asm volatile("v_cvt_pk_bf16_f32 %0, %1, %2" : "=v"(r) : "v"(lo), "v"(hi)); return r; }
__device__ __forceinline__ float fast_sigmoid(float x) { return __builtin_amdgcn_rcpf(1.0f + __expf(-x)); }
__device__ __forceinline__ float fast_silu(float x) { return x * fast_sigmoid(x); }
struct EpiStoreBf16 {
    static constexpr bool PERM = true, AFTER_DRAIN = false;
    bf16_t* O; int ldc;
    __device__ __forceinline__ void operator()(const f32x4 (&acc)[2][2][4][2], const Unit& u, int wr, int wc, int fr, int fq) const {
        const int row0 = u.pm * BM + wr * 64 + fr, col0 = u.pn * BM + wc * 32 + 8 * fq;
#pragma unroll
        for (int ai = 0; ai < 2; ++ai)
#pragma unroll
            for (int m = 0; m < 4; ++m) { bf16_t* rowp = O + (size_t)(row0 + ai * HALF + m * 16) * ldc + col0;
#pragma unroll
                for (int bj = 0; bj < 2; ++bj) { const f32x4 v0 = acc[ai][bj][m][0], v1 = acc[ai][bj][m][1];
                    u32x4 w; w.x = cvt_pk_bf16(v0[0], v0[1]); w.y = cvt_pk_bf16(v0[2], v0[3]); w.z = cvt_pk_bf16(v1[0], v1[1]); w.w = cvt_pk_bf16(v1[2], v1[3]);
                    *(u32x4*)(rowp + bj * HALF) = w; } }
    }
};
struct EpiResF32 {
    static constexpr bool PERM = true, AFTER_DRAIN = false;
    const float* base; float* out; int ldc;
    __device__ __forceinline__ void operator()(const f32x4 (&acc)[2][2][4][2], const Unit& u, int wr, int wc, int fr, int fq) const {
        const int row0 = u.pm * BM + wr * 64 + fr, col0 = u.pn * BM + wc * 32 + 8 * fq;
#pragma unroll
        for (int ai = 0; ai < 2; ++ai)
#pragma unroll
            for (int m = 0; m < 4; ++m) { const size_t off = (size_t)(row0 + ai * HALF + m * 16) * ldc + col0;
#pragma unroll
                for (int bj = 0; bj < 2; ++bj)
#pragma unroll
                    for (int n = 0; n < 2; ++n) { const size_t p = off + bj * HALF + 4 * n; const f32x4 b = *(const f32x4*)(base + p); *(f32x4*)(out + p) = b + acc[ai][bj][m][n]; } }
    }
};
struct EpiSwiGLU {
    static constexpr bool PERM = true, AFTER_DRAIN = false;
    bf16_t* O; int ldc;
    __device__ __forceinline__ void operator()(const f32x4 (&acc)[2][2][4][2], const Unit& u, int wr, int wc, int fr, int fq) const {
        const int row0 = u.pm * BM + wr * 64 + fr, col0 = u.pn * HALF + wc * 32 + 8 * fq;
#pragma unroll
        for (int ai = 0; ai < 2; ++ai)
#pragma unroll
            for (int m = 0; m < 4; ++m) { bf16_t* rowp = O + (size_t)(row0 + ai * HALF + m * 16) * ldc + col0;
                f32x4 v0, v1;
#pragma unroll
                for (int j = 0; j < 4; ++j) { v0[j] = fast_silu(acc[ai][0][m][0][j]) * acc[ai][1][m][0][j]; v1[j] = fast_silu(acc[ai][0][m][1][j]) * acc[ai][1][m][1][j]; }
                u32x4 w; w.x = cvt_pk_bf16(v0[0], v0[1]); w.y = cvt_pk_bf16(v0[2], v0[3]); w.z = cvt_pk_bf16(v1[0], v1[1]); w.w = cvt_pk_bf16(v1[2], v1[3]);
                *(u32x4*)rowp = w; }
    }
};
template <class Epi, class Sched, bool ALIGN_EPI = false, bool SP2 = false>
__device__ __forceinline__ void gemm_phase(PG8_LAS unsigned char* lds, const Gemm g, const Sched& S, const Epi& E) {
    int tid = threadIdx.x; asm volatile("" : "+v"(tid));
    const int wid = __builtin_amdgcn_readfirstlane(tid >> 6), lane = tid & 63, wr = wid >> 2, wc = wid & 3, fr = lane & 15, fq = lane >> 4;
    const int K = g.K, nt = K / BK;
    unsigned voffA[2], voffB[2];
#pragma unroll
    for (int i = 0; i < 2; ++i) { int R, C; stage_rc(tid * 16 + i * 8192, R, C); const int Rb = Epi::PERM ? ((R & ~31) + perm32(R & 31)) : R;
        voffA[i] = (unsigned)(R * K + C) * 2u; voffB[i] = (unsigned)(Rb * K + C) * 2u; }
    const size_t kstep = (size_t)(BK * 2);
    const size_t hstep = (size_t)HALF * K * 2;
    const size_t tstep = 2 * hstep;
    const unsigned ldsw = (unsigned)wid * 1024u;
    const int aoff = lds_byte(wr * 64 + fr, fq * 8), boff = lds_byte(wc * 32 + fr, fq * 8);
#define PG8_SA(b, h) (((b) * 2 + (h)) * HTB)
#define PG8_SB(b, h) ((4 + (b) * 2 + (h)) * HTB)
#define PG8_STAGE(bufoff, gbase, voff) do { _Pragma("unroll") for (int _i = 0; _i < 2; ++_i) \
        __builtin_amdgcn_global_load_lds((const unsigned*)((const char*)(gbase) + (voff)[_i]), (PG8_LAS unsigned*)(lds + (bufoff) + ldsw + _i * 8192), 16, 0, 0); } while (0)
#define PG8_LDA(dst, b, h) do { _Pragma("unroll") for (int m = 0; m < 4; ++m) _Pragma("unroll") for (int k = 0; k < 2; ++k) dst[m][k] = *(const PG8_LAS bf16x8*)(lds + PG8_SA(b, h) + aoff + m * 2048 + k * 1024); } while (0)
#define PG8_LDB(dst, b, h) do { _Pragma("unroll") for (int n = 0; n < 2; ++n) _Pragma("unroll") for (int k = 0; k < 2; ++k) dst[n][k] = *(const PG8_LAS bf16x8*)(lds + PG8_SB(b, h) + boff + n * 2048 + k * 1024); } while (0)
#define PG8_MMA(ai, bj, At, Bt) do { __builtin_amdgcn_s_setprio(1); _Pragma("unroll") for (int m = 0; m < 4; ++m) _Pragma("unroll") for (int n = 0; n < 2; ++n) _Pragma("unroll") for (int k = 0; k < 2; ++k) \
        acc[ai][bj][m][n] = __builtin_amdgcn_mfma_f32_16x16x32_bf16(Bt[n][k], At[m][k], acc[ai][bj][m][n], 0, 0, 0); __builtin_amdgcn_s_setprio(0); } while (0)
#define PG8_WAIT_V(n) asm volatile("s_waitcnt vmcnt(" #n ")" ::: "memory")
#define PG8_WAIT_L(n) asm volatile("s_waitcnt lgkmcnt(" #n ")" ::: "memory")
#define PG8_BAR __builtin_amdgcn_s_barrier()
#define PG8_SCHED __builtin_amdgcn_sched_barrier(0)
    Unit cur, nxt; int ui = 0;
    if (!S.next(0, cur)) return;
    f32x4 acc[2][2][4][2];
#pragma unroll
    for (int a = 0; a < 2; ++a)
#pragma unroll
        for (int b = 0; b < 2; ++b)
#pragma unroll
            for (int m = 0; m < 4; ++m)
#pragma unroll
                for (int n = 0; n < 2; ++n) acc[a][b][m][n] = (f32x4){0.f, 0.f, 0.f, 0.f};
    bf16x8 At[4][2], B0[2][2], B1[2][2];
    const char* cA = (const char*)g.A + (size_t)cur.pm * tstep; const char* cB = (const char*)g.Bt + (size_t)cur.pn * tstep;
    S.a_ready(cur);
    if constexpr (SP2) {
        PG8_STAGE(PG8_SB(0, 0), cB, voffB); PG8_STAGE(PG8_SB(0, 1), cB + hstep, voffB); PG8_STAGE(PG8_SA(0, 0), cA, voffA); PG8_STAGE(PG8_SA(0, 1), cA + hstep, voffA);
        if (wr == 1) PG8_BAR;
        PG8_WAIT_V(2); PG8_BAR;
        PG8_STAGE(PG8_SB(1, 0), cB + kstep, voffB); PG8_STAGE(PG8_SA(1, 0), cA + kstep, voffA); PG8_STAGE(PG8_SB(1, 1), cB + hstep + kstep, voffB);
        PG8_WAIT_V(6); PG8_BAR;
    } else {
        PG8_STAGE(PG8_SB(0, 0), cB, voffB); PG8_STAGE(PG8_SA(0, 0), cA, voffA); PG8_STAGE(PG8_SB(0, 1), cB + hstep, voffB); PG8_STAGE(PG8_SA(0, 1), cA + hstep, voffA);
        if (wr == 1) PG8_BAR;
        PG8_WAIT_V(4); PG8_BAR;
        PG8_STAGE(PG8_SB(1, 0), cB + kstep, voffB); PG8_STAGE(PG8_SA(1, 0), cA + kstep, voffA); PG8_STAGE(PG8_SB(1, 1), cB + hstep + kstep, voffB);
        PG8_WAIT_V(6); PG8_BAR;
    }
    for (;;) {
        const bool has_next = S.next(ui + 1, nxt);
        const char* nA = has_next ? (const char*)g.A + (size_t)nxt.pm * tstep : cA; const char* nB = has_next ? (const char*)g.Bt + (size_t)nxt.pn * tstep : cB;
        for (int t = 0; t < nt; t += 2) {
            const bool last = (t == nt - 2);
            const char* a1 = cA + (size_t)(t + 1) * kstep;
            const char* a2 = last ? nA : cA + (size_t)(t + 2) * kstep; const char* b2 = last ? nB : cB + (size_t)(t + 2) * kstep;
            const char* a3 = a2 + kstep; const char* b3 = b2 + kstep;
            if (last && has_next) S.a_ready(nxt);
            if constexpr (SP2) {
            PG8_LDB(B0, 0, 0); PG8_LDB(B1, 0, 1); PG8_SCHED; PG8_LDA(At, 0, 0); PG8_STAGE(PG8_SA(1, 1), a1 + hstep, voffA);
            PG8_WAIT_V(8); PG8_WAIT_L(0); PG8_BAR; PG8_MMA(0, 0, At, B0); PG8_MMA(0, 1, At, B1); PG8_BAR; PG8_SCHED;
            PG8_LDA(At, 0, 1); PG8_STAGE(PG8_SB(0, 0), b2, voffB); PG8_STAGE(PG8_SB(0, 1), b2 + hstep, voffB); PG8_STAGE(PG8_SA(0, 0), a2, voffA);
            PG8_WAIT_V(8); PG8_WAIT_L(0); PG8_BAR; PG8_MMA(1, 0, At, B0); PG8_MMA(1, 1, At, B1); PG8_BAR; PG8_SCHED;
            PG8_LDB(B0, 1, 0); PG8_LDB(B1, 1, 1); PG8_SCHED; PG8_LDA(At, 1, 0); PG8_STAGE(PG8_SA(0, 1), a2 + hstep, voffA);
            PG8_WAIT_V(8); PG8_WAIT_L(0); PG8_BAR; PG8_MMA(0, 0, At, B0); PG8_MMA(0, 1, At, B1); PG8_BAR; PG8_SCHED;
            PG8_LDA(At, 1, 1); PG8_STAGE(PG8_SB(1, 0), b3, voffB); PG8_STAGE(PG8_SB(1, 1), b3 + hstep, voffB); PG8_STAGE(PG8_SA(1, 0), a3, voffA);
            PG8_WAIT_V(8); PG8_WAIT_L(0); PG8_BAR; PG8_MMA(1, 0, At, B0); PG8_MMA(1, 1, At, B1); PG8_BAR; PG8_SCHED;
            } else {
            PG8_LDB(B0, 0, 0); PG8_SCHED; PG8_LDA(At, 0, 0); PG8_STAGE(PG8_SA(1, 1), a1 + hstep, voffA);
            PG8_WAIT_L(8); PG8_BAR; PG8_WAIT_L(0); PG8_MMA(0, 0, At, B0); PG8_BAR; PG8_SCHED;
            PG8_LDB(B1, 0, 1); PG8_STAGE(PG8_SB(0, 0), b2, voffB);
            PG8_BAR; PG8_WAIT_L(0); PG8_MMA(0, 1, At, B1); PG8_BAR;
            PG8_LDA(At, 0, 1); PG8_STAGE(PG8_SA(0, 0), a2, voffA);
            PG8_BAR; PG8_WAIT_L(0); PG8_MMA(1, 0, At, B0); PG8_BAR; PG8_SCHED;
            PG8_STAGE(PG8_SB(0, 1), b2 + hstep, voffB);
            PG8_WAIT_V(6); PG8_BAR; PG8_MMA(1, 1, At, B1); PG8_BAR;
            PG8_LDB(B0, 1, 0); PG8_SCHED; PG8_LDA(At, 1, 0); PG8_STAGE(PG8_SA(0, 1), a2 + hstep, voffA);
            PG8_WAIT_L(8); PG8_BAR; PG8_WAIT_L(0); PG8_MMA(0, 0, At, B0); PG8_BAR; PG8_SCHED;
            PG8_LDB(B1, 1, 1); PG8_STAGE(PG8_SB(1, 0), b3, voffB);
            PG8_BAR; PG8_WAIT_L(0); PG8_MMA(0, 1, At, B1); PG8_BAR;
            PG8_LDA(At, 1, 1); PG8_STAGE(PG8_SA(1, 0), a3, voffA);
            PG8_BAR; PG8_WAIT_L(0); PG8_MMA(1, 0, At, B0); PG8_BAR; PG8_SCHED;
            PG8_STAGE(PG8_SB(1, 1), b3 + hstep, voffB);
            PG8_WAIT_V(6); PG8_BAR; PG8_MMA(1, 1, At, B1); PG8_BAR;
            }
        }
        if constexpr (ALIGN_EPI) { if (wr == 0) PG8_BAR; }
        if constexpr (!Epi::AFTER_DRAIN) { E(acc, cur, wr, wc, fr, fq); S.done(cur); }
        if (!has_next) break;
#pragma unroll
        for (int a = 0; a < 2; ++a)
#pragma unroll
            for (int b = 0; b < 2; ++b)
#pragma unroll
                for (int m = 0; m < 4; ++m)
#pragma unroll
                    for (int n = 0; n < 2; ++n) acc[a][b][m][n] = (f32x4){0.f, 0.f, 0.f, 0.f};
        cur = nxt; cA = nA; cB = nB; ++ui;
        if constexpr (ALIGN_EPI) { if (wr == 1) PG8_BAR; }
    }
    PG8_WAIT_V(0);
    if constexpr (!ALIGN_EPI) { if (wr == 0) PG8_BAR; }
    PG8_BAR;
    if constexpr (Epi::AFTER_DRAIN) { E.fused(acc, cur, wr, wc, fr, fq, lds, wid, lane); S.done(cur); }
#undef PG8_SA
#undef PG8_SB
#undef PG8_STAGE
#undef PG8_LDA
#undef PG8_LDB
#undef PG8_MMA
#undef PG8_WAIT_V
#undef PG8_WAIT_L
#undef PG8_BAR
#undef PG8_SCHED
}
}

#define LAS __attribute__((address_space(3)))
typedef pg8::bf16_t bf16_t;
typedef pg8::bf16x8 bf16x8;
typedef pg8::f32x4 f32x4;
typedef pg8::u32x4 u32x4;
typedef unsigned u32x2 __attribute__((ext_vector_type(2)));
typedef float f32x2v __attribute__((ext_vector_type(2)));
using pg8::cvt_pk_bf16;
using pg8::fast_sigmoid;
using pg8::fast_silu;

constexpr int D = 1024, NB = 4, SEQ = 8192, NTOK = NB * SEQ;
#ifndef MK_NSPLIT
#define MK_NSPLIT 4
#endif
constexpr int NSPLIT = MK_NSPLIT, TS = SEQ / NSPLIT, MS = NB * TS;
constexpr int CL = 9728;
constexpr int C_R = 0, C_K = 1024, C_V = 2048, C_WLO = 3072, C_ALO = 3136, C_GLO = 3200, C_HQ = 3584, C_HF = 4608, C_HI = 5632, C_HG = 6656, C_GA = 7680, C_GB = 8704;
constexpr int CARRY_LD = 3584;
constexpr int DFF = 2816;
constexpr size_t MiB = 1u << 20, KiB = 1u << 10;
constexpr size_t WS_WIN = 0, WS_WOUT = 19 * MiB, WS_WQ = 21 * MiB, WS_WO = 23 * MiB, WS_WKV = 25 * MiB, WS_W13 = 29 * MiB, WS_W2 = 40 * MiB;
constexpr size_t WS_RW2T = 46 * MiB, WS_RA2T = 46 * MiB + 128 * KiB, WS_RG2T = 46 * MiB + 256 * KiB, WS_CARRY = 46 * MiB + 640 * KiB, WS_LB = 46 * MiB + 704 * KiB;
constexpr size_t WS_MBF = 47 * MiB, WS_KV = 49 * MiB, WS_VT = 53 * MiB, WS_RWST = 55 * MiB, WS_HGST = 56 * MiB, WS_BONUS = 58 * MiB;
constexpr size_t WS_G2TP = 59 * MiB;
constexpr size_t WS_MERGED = 64 * MiB;
constexpr size_t WS_U1 = 128 * MiB, WS_COLS = 144 * MiB, WS_PR = 296 * MiB, WS_PK = 312 * MiB, WS_PA = 328 * MiB, WS_PB = 344 * MiB, WS_PV = 360 * MiB, WS_PW = 376 * MiB, WS_ORAW = 408 * MiB, WS_HGO = 440 * MiB;
constexpr size_t WS_GATE = 472 * MiB, WS_ASG = 488 * MiB;
constexpr size_t WS_U = 128 * MiB, WS_Q = 192 * MiB, WS_AO = 256 * MiB, WS_FF = 320 * MiB, WS_CTL = 496 * MiB, CTL_BYTES = 64 * KiB, WS_END = 496 * MiB + 64 * KiB;
constexpr int LDS_BYTES = 147456, MISC_OFF = 131072 + 320;
constexpr int T0 = 1 + 5 * NSPLIT, N_PHASES = T0 + 9;

__device__ __forceinline__ float bflo(unsigned u) { return __uint_as_float(u << 16); }
__device__ __forceinline__ float bfhi(unsigned u) { return __uint_as_float(u & 0xffff0000u); }
__device__ __forceinline__ unsigned f2bf(float f) { unsigned u = __float_as_uint(f); return (u + 0x7fffu + ((u >> 16) & 1u)) >> 16; }
__device__ __forceinline__ f32x4 ld4bf(const bf16_t* p) { const u32x2 u = *(const u32x2*)p; return (f32x4){bflo(u.x), bfhi(u.x), bflo(u.y), bfhi(u.y)}; }
__device__ __forceinline__ void ld8bf(const bf16_t* p, float (&o)[8]) { const u32x4 u = *(const u32x4*)p; o[0] = bflo(u.x); o[1] = bfhi(u.x); o[2] = bflo(u.y); o[3] = bfhi(u.y); o[4] = bflo(u.z); o[5] = bfhi(u.z); o[6] = bflo(u.w); o[7] = bfhi(u.w); }
__device__ __forceinline__ void st4bf(bf16_t* p, f32x4 v) { u32x2 w; w.x = cvt_pk_bf16(v[0], v[1]); w.y = cvt_pk_bf16(v[2], v[3]); *(u32x2*)p = w; }
__device__ __forceinline__ bf16x8 pack8(const float (&t)[8]) { u32x4 w; w.x = cvt_pk_bf16(t[0], t[1]); w.y = cvt_pk_bf16(t[2], t[3]); w.z = cvt_pk_bf16(t[4], t[5]); w.w = cvt_pk_bf16(t[6], t[7]); return __builtin_bit_cast(bf16x8, w); }
__device__ __forceinline__ float tanh_fast(float x) { return 1.0f - 2.0f * __builtin_amdgcn_rcpf(1.0f + __expf(2.0f * x)); }
__device__ __forceinline__ float wave_sum(float v) {
#pragma unroll
    for (int o = 1; o < 64; o <<= 1) v += __shfl_xor(v, o);
    return v;
}
__device__ __forceinline__ float fq_sum(float v) { v += __shfl_xor(v, 16); v += __shfl_xor(v, 32); return v; }
template <int CTRL> __device__ __forceinline__ float dpp_add(float x) { return x + __builtin_bit_cast(float, __builtin_amdgcn_update_dpp(0, __builtin_bit_cast(int, x), CTRL, 0xf, 0xf, false)); }
#ifdef MK_SHFL_REDUCE
__device__ __forceinline__ float allreduce16(float x) { x += __shfl_xor(x, 1); x += __shfl_xor(x, 2); x += __shfl_xor(x, 4); x += __shfl_xor(x, 8); return x; }
#else
__device__ __forceinline__ float allreduce16(float x) { x = dpp_add<0xB1>(x); x = dpp_add<0x4E>(x); x = dpp_add<0x141>(x); x = dpp_add<0x140>(x); return x; }
#endif
__device__ __forceinline__ void allreduce16x2(float& x, float& y) {
    x = dpp_add<0xB1>(x); y = dpp_add<0xB1>(y); x = dpp_add<0x4E>(x); y = dpp_add<0x4E>(y); x = dpp_add<0x141>(x); y = dpp_add<0x141>(y); x = dpp_add<0x140>(x); y = dpp_add<0x140>(y); }
#define MFMA16(a, b, c) __builtin_amdgcn_mfma_f32_16x16x32_bf16((a), (b), (c), 0, 0, 0)

#define XB_TMO      128
#define XB_XCNT(j)  (256  + 64 * (j))
#define XB_XSUB(j)  (1280 + 64 * (j))
#define XB_XGEN(j)  (2304 + 64 * (j))
#define XB_TOP      3328
#define XB_TOPGEN   3392
#define XCD_BAR_WORDS 3456
#define XB_SPIN_CAP (1u << 18)

__device__ __forceinline__ unsigned xb_ld(unsigned* p)              { return __hip_atomic_load(p, __ATOMIC_RELAXED, __HIP_MEMORY_SCOPE_AGENT); }
__device__ __forceinline__ unsigned xb_add(unsigned* p, unsigned v) { return __hip_atomic_fetch_add(p, v, __ATOMIC_RELAXED, __HIP_MEMORY_SCOPE_AGENT); }
__device__ __forceinline__ unsigned xb_xcc_id() { return (unsigned)__builtin_amdgcn_s_getreg((3 << 11) | 20) & 0xFu; }
#define XB_SPIN(cond, bar) do { unsigned _sp = 0; while (cond) { __builtin_amdgcn_s_sleep(1); \
    if ((++_sp & 255u) == 0u) { if (xb_ld(&(bar)[XB_TMO])) break; if (_sp > XB_SPIN_CAP) { atomicAdd(&(bar)[XB_TMO], 1u); break; } } } } while (0)

struct XcdBarrier {
    unsigned* bar; unsigned x;
    volatile LAS unsigned* st;
};

__device__ __forceinline__ XcdBarrier xcd_barrier_post(unsigned* bar, volatile LAS unsigned* st) {
    XcdBarrier b; b.bar = bar; b.x = xb_xcc_id(); b.st = st;
    if (threadIdx.x == 0) (void)xb_add(&bar[XB_XCNT(b.x)], 1u);
    return b;
}
__device__ __forceinline__ void xcd_barrier_complete(unsigned* bar, unsigned x, unsigned& nloc, unsigned& nx) {
    const unsigned G = gridDim.x * gridDim.y * gridDim.z;
    unsigned sum, cnt, mine, sp = 0u;
    for (;;) {
        sum = 0u; cnt = 0u; mine = 0u;
#pragma unroll
        for (unsigned j = 0; j < 16; ++j) { const unsigned c = xb_ld(&bar[XB_XCNT(j)]); sum += c; cnt += (c > 0u) ? 1u : 0u; mine = (j == x) ? c : mine; }
        if (sum == G) break;
        __builtin_amdgcn_s_sleep(1);
        if ((++sp & 255u) == 0u) { if (xb_ld(&bar[XB_TMO])) break; if (sp > XB_SPIN_CAP) { atomicAdd(&bar[XB_TMO], 1u); break; } }
    }
    nloc = mine > 0u ? mine : 1u; nx = cnt > 0u ? cnt : 1u;
}

__device__ __forceinline__ void xcd_barrier(const XcdBarrier& b) {
    asm volatile("s_waitcnt vmcnt(0)" ::: "memory");
    __syncthreads();
    if (threadIdx.x == 0) {
        unsigned* bar = b.bar;
        __builtin_amdgcn_s_waitcnt(0);
        unsigned nloc = b.st[0], nx = b.st[1];
        if (nloc == 0u) { xcd_barrier_complete(bar, b.x, nloc, nx); b.st[0] = nloc; b.st[1] = nx; }
        const unsigned old = xb_add(&bar[XB_XSUB(b.x)], 1u);
        const unsigned gen = old / nloc;
        if (old + 1u == (gen + 1u) * nloc) {
            __builtin_amdgcn_fence(__ATOMIC_RELEASE, "agent");
            asm volatile("s_waitcnt vmcnt(0)" ::: "memory");
            const unsigned og = xb_add(&bar[XB_TOP], 1u);
            const unsigned tg = og / nx;
            if (og + 1u == (tg + 1u) * nx) xb_add(&bar[XB_TOPGEN], 1u);
            else XB_SPIN(xb_ld(&bar[XB_TOPGEN]) == tg, bar);
            __builtin_amdgcn_fence(__ATOMIC_ACQUIRE, "agent");
            xb_add(&bar[XB_XGEN(b.x)], 1u);
            asm volatile("s_waitcnt vmcnt(0)" ::: "memory");
        } else {
            XB_SPIN(xb_ld(&bar[XB_XGEN(b.x)]) == gen, bar);
            __builtin_amdgcn_fence(__ATOMIC_ACQUIRE, "agent");
            asm volatile("s_waitcnt vmcnt(0)" ::: "memory");
        }
    }
    __syncthreads();
}

__device__ __forceinline__ void rms_row_bf16(const float* src, const float* g, bf16_t* dst, int lane) {
    f32x4 v[4]; float s = 0.f;
#pragma unroll
    for (int j = 0; j < 4; ++j) { v[j] = ((const f32x4*)src)[lane + 64 * j]; s += (v[j][0] * v[j][0] + v[j][1] * v[j][1]) + (v[j][2] * v[j][2] + v[j][3] * v[j][3]); }
    const float rs = 1.0f / sqrtf(wave_sum(s) * (1.0f / 1024.0f) + 1e-6f);
#pragma unroll
    for (int j = 0; j < 4; ++j) { const f32x4 gv = ((const f32x4*)g)[lane + 64 * j]; st4bf(dst + 4 * (lane + 64 * j), v[j] * rs * gv); }
}
__device__ __forceinline__ void tr_item(const float* W, int K, int N, bf16_t* WT, int kb, int n0, int row_base, LAS float* scr, int lane) {
    const int k0 = 64 * kb;
#pragma unroll 8
    for (int i = 0; i < 32; ++i) { const int kk = 2 * i + (lane >> 5); scr[kk * 33 + (lane & 31)] = W[(size_t)(k0 + kk) * N + n0 + (lane & 31)]; }
    asm volatile("s_waitcnt lgkmcnt(0)" ::: "memory");
    const int c = lane & 7;
#pragma unroll
    for (int j = 0; j < 4; ++j) { const int n = (lane >> 3) + 8 * j; const LAS float* sp = scr + (8 * c) * 33 + n;
        u32x4 o; o.x = cvt_pk_bf16(sp[0 * 33], sp[1 * 33]); o.y = cvt_pk_bf16(sp[2 * 33], sp[3 * 33]); o.z = cvt_pk_bf16(sp[4 * 33], sp[5 * 33]); o.w = cvt_pk_bf16(sp[6 * 33], sp[7 * 33]);
        *(u32x4*)(WT + (size_t)(row_base + n) * K + k0 + 8 * c) = o; }
    asm volatile("s_waitcnt lgkmcnt(0)" ::: "memory");
}

__device__ __forceinline__ void prep_phase(int s, int gw, int NGW, int lane, const bf16_t* cols, const bf16_t* carry,
        const float* mu, const float* w0, const float* a0, const float* k_k, const float* k_a, const float* r_k,
        const bf16_t* w2T, const bf16_t* a2T, bf16_t* PR, bf16_t* PK, bf16_t* PA, bf16_t* PB, bf16_t* PV, float* PW, float* bonus, bf16_t* ASG) {
    const int fr = lane & 15, fq = lane >> 4;
    for (int item = gw; item < (MS / 16) * 4; item += NGW) {
        const int tile = item >> 2, hg4 = item & 3;
        const int lt = tile * 16 + fr, b = lt / TS, tl = lt % TS;
        const bf16_t* crow = cols + (size_t)lt * CL;
        const bf16_t* prow = tl > 0 ? crow - CL : carry + ((s & 1) * 4 + b) * CARRY_LD;
        bf16x8 Aw[2], Aa[2];
#pragma unroll
        for (int ks = 0; ks < 2; ++ks) {
            { const int c = C_WLO + ks * 32 + fq * 8; float cur[8], prv[8], t[8]; ld8bf(crow + c, cur); ld8bf(prow + c, prv);
              const f32x4 m0 = *(const f32x4*)(mu + c), m1 = *(const f32x4*)(mu + c + 4);
#pragma unroll
              for (int e = 0; e < 8; ++e) { const float mm = e < 4 ? m0[e & 3] : m1[e & 3]; t[e] = tanh_fast(cur[e] + mm * (prv[e] - cur[e])); }
              Aw[ks] = pack8(t); }
            { const int c = C_ALO + ks * 32 + fq * 8; float cur[8], prv[8], t[8]; ld8bf(crow + c, cur); ld8bf(prow + c, prv);
              const f32x4 m0 = *(const f32x4*)(mu + c), m1 = *(const f32x4*)(mu + c + 4);
#pragma unroll
              for (int e = 0; e < 8; ++e) { const float mm = e < 4 ? m0[e & 3] : m1[e & 3]; t[e] = cur[e] + mm * (prv[e] - cur[e]); }
              Aa[ks] = pack8(t); }
        }
        if (hg4 == 0) {
#pragma unroll
            for (int ks = 0; ks < 5; ++ks) { const int c = C_GLO + ks * 32 + fq * 8; float cur[8], prv[8], t[8]; ld8bf(crow + c, cur); ld8bf(prow + c, prv);
                const f32x4 m0 = *(const f32x4*)(mu + c), m1 = *(const f32x4*)(mu + c + 4);
#pragma unroll
                for (int e = 0; e < 8; ++e) { const float mm = e < 4 ? m0[e & 3] : m1[e & 3]; t[e] = fast_sigmoid(cur[e] + mm * (prv[e] - cur[e])); }
                *(bf16x8*)(ASG + (size_t)lt * 256 + ks * 32 + fq * 8) = pack8(t); }
#pragma unroll
            for (int ks = 5; ks < 8; ++ks) *(u32x4*)(ASG + (size_t)lt * 256 + ks * 32 + fq * 8) = (u32x4){0u, 0u, 0u, 0u};
        }
#pragma unroll 1
        for (int hh = 0; hh < 4; ++hh) {
            const int h = hg4 * 4 + hh;
            f32x4 aw[4], aa[4];
#pragma unroll
            for (int nt = 0; nt < 4; ++nt) { aw[nt] = (f32x4){0.f, 0.f, 0.f, 0.f}; aa[nt] = (f32x4){0.f, 0.f, 0.f, 0.f};
                const int n = h * 64 + nt * 16 + fr;
#pragma unroll
                for (int ks = 0; ks < 2; ++ks) { const bf16x8 bw = *(const bf16x8*)(w2T + n * 64 + ks * 32 + fq * 8); aw[nt] = MFMA16(bw, Aw[ks], aw[nt]);
                    const bf16x8 ba = *(const bf16x8*)(a2T + n * 64 + ks * 32 + fq * 8); aa[nt] = MFMA16(ba, Aa[ks], aa[nt]); } }
            f32x4 kkv[4], av[4]; float ssq = 0.f, bon = 0.f;
#pragma unroll
            for (int nt = 0; nt < 4; ++nt) {
                const int c = h * 64 + nt * 16 + 4 * fq; const size_t o = (size_t)lt * 1024 + c;
                const f32x4 rc = ld4bf(crow + C_R + c), rp = ld4bf(prow + C_R + c), kc = ld4bf(crow + C_K + c), kp = ld4bf(prow + C_K + c), vc = ld4bf(crow + C_V + c), vp = ld4bf(prow + C_V + c);
                const f32x4 r = rc + *(const f32x4*)(mu + C_R + c) * (rp - rc), k = kc + *(const f32x4*)(mu + C_K + c) * (kp - kc), v = vc + *(const f32x4*)(mu + C_V + c) * (vp - vc);
                const f32x4 w0v = *(const f32x4*)(w0 + c), a0v = *(const f32x4*)(a0 + c), kkp = *(const f32x4*)(k_k + c), kap = *(const f32x4*)(k_a + c), rkp = *(const f32x4*)(r_k + c);
                f32x4 wv, a, kk, kmod;
#pragma unroll
                for (int j = 0; j < 4; ++j) {
                    const float z = -(w0v[j] + aw[nt][j]);
                    const float sp = fmaxf(z, 0.f) + __logf(1.0f + __expf(-fabsf(z)));
                    wv[j] = __expf(-__expf(-sp - 0.5f));
                    a[j] = fast_sigmoid(a0v[j] + aa[nt][j]);
                    kk[j] = k[j] * kkp[j]; kmod[j] = k[j] * (1.0f + (a[j] - 1.0f) * kap[j]);
                    ssq += kk[j] * kk[j]; bon += r[j] * kmod[j] * rkp[j];
                }
                kkv[nt] = kk; av[nt] = a;
                st4bf(PR + o, r); st4bf(PK + o, kmod); st4bf(PV + o, v); *(f32x4*)(PW + o) = wv;
            }
            ssq = fq_sum(ssq); bon = fq_sum(bon);
            const float rs = 1.0f / sqrtf(fmaxf(ssq, 1e-24f));
#pragma unroll
            for (int nt = 0; nt < 4; ++nt) { const int c = h * 64 + nt * 16 + 4 * fq; const size_t o = (size_t)lt * 1024 + c;
                const f32x4 kn = kkv[nt] * rs; st4bf(PA + o, -kn); st4bf(PB + o, kn * av[nt]); }
            if (fq == 0) bonus[lt * 16 + h] = bon;
        }
    }
}

__device__ __forceinline__ void post_phase(int s, int gw, int NGW, int lane, const bf16_t* cols, const bf16_t* carry, const float* mu, const bf16_t* gate,
        const float* ln_w, const float* ln_b, const float* hg_g, const float* oraw, const float* hgo, const bf16_t* PV, const float* bonus, bf16_t* merged) {
    const int fr = lane & 15, fq = lane >> 4;
    for (int item = gw; item < (MS / 16) * 4; item += NGW) {
        const int tile = item >> 2, q4 = item & 3;
        const int lt = tile * 16 + fr, b = lt / TS, tl = lt % TS;
        const size_t gt = (size_t)b * SEQ + s * TS + tl;
        const bf16_t* crow = cols + (size_t)lt * CL;
        const bf16_t* prow = tl > 0 ? crow - CL : carry + ((s & 1) * 4 + b) * CARRY_LD;
#pragma unroll 1
        for (int hgh = 0; hgh < 2; ++hgh) {
            const int h8 = q4 * 2 + hgh;
            f32x4 ho[8]; float ss = 0.f;
#pragma unroll
            for (int n8 = 0; n8 < 8; ++n8) { ho[n8] = *(const f32x4*)(hgo + ((size_t)((b * 8 + h8) * 8 + n8) * TS + tl) * 16 + 4 * fq); ss += (ho[n8][0] * ho[n8][0] + ho[n8][1] * ho[n8][1]) + (ho[n8][2] * ho[n8][2] + ho[n8][3] * ho[n8][3]); }
            ss = fq_sum(ss);
            const float rsh = 1.0f / sqrtf(ss * (1.0f / 128.0f) + 1e-6f);
#pragma unroll
            for (int rwh = 0; rwh < 2; ++rwh) {
                const int h = q4 * 4 + hgh * 2 + rwh;
                f32x4 ag[4], o[4]; float sm = 0.f;
#pragma unroll
                for (int nt = 0; nt < 4; ++nt) { ag[nt] = ld4bf(gate + (size_t)lt * 1024 + h * 64 + nt * 16 + 4 * fq);
                    o[nt] = *(const f32x4*)(oraw + ((size_t)((b * 16 + h) * 4 + nt) * TS + tl) * 16 + 4 * fq); sm += (o[nt][0] + o[nt][1]) + (o[nt][2] + o[nt][3]); }
                const float mean = fq_sum(sm) * (1.0f / 64.0f); float vq = 0.f;
#pragma unroll
                for (int nt = 0; nt < 4; ++nt) { o[nt] = o[nt] - mean; vq += (o[nt][0] * o[nt][0] + o[nt][1] * o[nt][1]) + (o[nt][2] * o[nt][2] + o[nt][3] * o[nt][3]); }
                const float rstd = 1.0f / sqrtf(fq_sum(vq) * (1.0f / 64.0f) + 64e-5f);
#ifdef MK_NO_BONUS
                const float bon = 0.f;
#else
                const float bon = bonus[lt * 16 + h];
#endif
#pragma unroll
                for (int nt = 0; nt < 4; ++nt) {
                    const int c = h * 64 + nt * 16 + 4 * fq;
                    const f32x4 lw = *(const f32x4*)(ln_w + c), lb = *(const f32x4*)(ln_b + c), v = ld4bf(PV + (size_t)lt * 1024 + c);
                    const f32x4 ya = (o[nt] * rstd * lw + lb + v * bon) * ag[nt];
                    const f32x4 ng = *(const f32x4*)(hg_g + (c & 127)), gh = ld4bf(crow + C_HG + c), gar = ld4bf(crow + C_GA + c), gbr = ld4bf(crow + C_GB + c);
                    const f32x4 hv = ho[rwh * 4 + nt] * rsh * ng;
                    f32x4 m;
#pragma unroll
                    for (int j = 0; j < 4; ++j) {
#if defined(MK_ZERO_YA)
                        m[j] = fast_sigmoid(gbr[j]) * (hv[j] * fast_silu(gh[j]));
#elif defined(MK_ZERO_YB)
                        m[j] = fast_sigmoid(gar[j]) * ya[j];
#else
                        m[j] = fast_sigmoid(gar[j]) * ya[j] + fast_sigmoid(gbr[j]) * (hv[j] * fast_silu(gh[j]));
#endif
                    }
                    st4bf(merged + gt * 1024 + c, m);
                }
            }
        }
    }
}

constexpr int RWB = 45056;
#define SCAN_BAR_L() do { asm volatile("s_waitcnt vmcnt(0) lgkmcnt(0)" ::: "memory"); __builtin_amdgcn_s_barrier(); asm volatile("" ::: "memory"); } while (0)
#define SCAN_BAR_S() do { asm volatile("s_waitcnt lgkmcnt(0)" ::: "memory"); __builtin_amdgcn_s_barrier(); asm volatile("" ::: "memory"); } while (0)
__device__ __forceinline__ void rw_load(LAS unsigned char* bp, int lt2, size_t ltok0, int h, int rg, const bf16_t* PA, const float* PW, const bf16_t* PB, const bf16_t* PK, const bf16_t* PR, const bf16_t* PV) {
    const int tok = lt2 >> 3, c8 = (lt2 & 7) * 8; const size_t base = (ltok0 + tok) * 1024 + h * 64 + c8;
    const u32x4 ra = *(const u32x4*)(PA + base), rb = *(const u32x4*)(PB + base), rk = *(const u32x4*)(PK + base), rr = *(const u32x4*)(PR + base);
    const f32x4 w0 = *(const f32x4*)(PW + base), w1 = *(const f32x4*)(PW + base + 4);
    const unsigned rv = *(const unsigned*)(PV + (ltok0 + tok) * 1024 + h * 64 + rg * 16 + (lt2 & 7) * 2);
    const int off = (tok * 64 + c8) * 4;
#define RW_PUT(arr, u) do { *(LAS f32x4*)(bp + (arr) * 8192 + off) = (f32x4){bflo(u.x), bfhi(u.x), bflo(u.y), bfhi(u.y)}; *(LAS f32x4*)(bp + (arr) * 8192 + off + 16) = (f32x4){bflo(u.z), bfhi(u.z), bflo(u.w), bfhi(u.w)}; } while (0)
    RW_PUT(0, ra); RW_PUT(2, rb); RW_PUT(3, rk); RW_PUT(4, rr);
#undef RW_PUT
    *(LAS f32x4*)(bp + 8192 + off) = w0; *(LAS f32x4*)(bp + 8192 + off + 16) = w1;
    *(LAS f32x2v*)(bp + 40960 + (tok * 16 + (lt2 & 7) * 2) * 4) = (f32x2v){bflo(rv), bfhi(rv)};
}
__device__ __forceinline__ void y_drain(const LAS unsigned char* ybase, int lt2, float* dst) { *(f32x2v*)(dst + lt2 * 2) = *(const LAS f32x2v*)(ybase + lt2 * 8); }
__device__ __forceinline__ void rwkv_scan(int s, int bid, int G, int tid, int lane, int wave, LAS unsigned char* lds,
        const bf16_t* PA, const float* PW, const bf16_t* PB, const bf16_t* PK, const bf16_t* PR, const bf16_t* PV, float* oraw, float* state, bool save) {
    constexpr int NBLK = TS / 32;
    const int rowl = lane >> 4, j = lane & 15, row = (wave & 3) * 4 + rowl;
    for (int it = bid; it < 256; it += G) {
        const int b = it >> 6, h = (it >> 2) & 15, rg = it & 3;
        const size_t tok0 = (size_t)b * TS;
        float* stp = state + ((size_t)((b * 16 + h) * 64 + rg * 16 + row) * 64 + 4 * j);
        float* obase = oraw + (size_t)it * TS * 16;
        f32x4 st = (f32x4){0.f, 0.f, 0.f, 0.f};
        if (wave < 4 && s > 0) st = *(const f32x4*)stp;
        if (wave >= 4) { rw_load(lds, tid - 256, tok0, h, rg, PA, PW, PB, PK, PR, PV); SCAN_BAR_L(); } else { __builtin_amdgcn_s_setprio(2); asm volatile("s_waitcnt vmcnt(0)" ::: "memory"); SCAN_BAR_S(); }
#pragma unroll 1
        for (int blk = 0; blk < NBLK; ++blk) {
            if (wave >= 4) {
                if (blk > 0) y_drain(lds + ((blk - 1) & 1) * RWB + 43008, tid - 256, obase + (size_t)(blk - 1) * 512);
                if (blk + 1 < NBLK) rw_load(lds + ((blk + 1) & 1) * RWB, tid - 256, tok0 + (blk + 1) * 32, h, rg, PA, PW, PB, PK, PR, PV);
                SCAN_BAR_L();
            } else {
                const LAS unsigned char* bp = lds + (blk & 1) * RWB;
                const LAS unsigned char* p4 = bp + 16 * j; const LAS unsigned char* pv = bp + 40960 + row * 4; LAS unsigned char* py = (LAS unsigned char*)bp + 43008 + row * 4;
                f32x4 a4 = *(const LAS f32x4*)(p4), w4 = *(const LAS f32x4*)(p4 + 8192), b4 = *(const LAS f32x4*)(p4 + 16384), k4 = *(const LAS f32x4*)(p4 + 24576), r4 = *(const LAS f32x4*)(p4 + 32768);
                float vv = *(const LAS float*)(pv);
                float sa = (st[0] * a4[0] + st[1] * a4[1]) + (st[2] * a4[2] + st[3] * a4[3]);
                sa = allreduce16(sa);
#pragma unroll
                for (int t = 0; t < 32; ++t) {
                    f32x4 na = a4, nw = w4, nb = b4, nk = k4, nr = r4; float nv = vv;
                    if (t < 31) { const int o = (t + 1) * 256; na = *(const LAS f32x4*)(p4 + o); nw = *(const LAS f32x4*)(p4 + 8192 + o); nb = *(const LAS f32x4*)(p4 + 16384 + o); nk = *(const LAS f32x4*)(p4 + 24576 + o); nr = *(const LAS f32x4*)(p4 + 32768 + o); nv = *(const LAS float*)(pv + (t + 1) * 64); }
                    st = st * w4 + (b4 * sa + k4 * vv);
                    float y = (st[0] * r4[0] + st[1] * r4[1]) + (st[2] * r4[2] + st[3] * r4[3]);
                    float sn = (st[0] * na[0] + st[1] * na[1]) + (st[2] * na[2] + st[3] * na[3]);
                    allreduce16x2(sn, y);
                    if (j == 0) *(LAS float*)(py + t * 64) = y;
                    sa = sn; a4 = na; w4 = nw; b4 = nb; k4 = nk; r4 = nr; vv = nv;
                }
                SCAN_BAR_S();
            }
        }
        if (wave >= 4) { y_drain(lds + ((NBLK - 1) & 1) * RWB + 43008, tid - 256, obase + (size_t)(NBLK - 1) * 512); }
        else { __builtin_amdgcn_s_setprio(0); if (save) *(f32x4*)stp = st; }
    }
}

__device__ __forceinline__ void rwkv_scan_naive(int s, int gw, int NGW, int lane, int wave, LAS unsigned char* lds,
        const bf16_t* PA, const float* PW, const bf16_t* PB, const bf16_t* PK, const bf16_t* PR, const bf16_t* PV, float* oraw, float* state) {
    LAS float* slab = (LAS float*)(lds + wave * 2048);
    for (int it = gw; it < 64; it += NGW) {
        const int b = it >> 4, h = it & 15;
        float st[64];
        float* stp = state + (size_t)((b * 16 + h) * 64 + lane) * 64;
#pragma unroll
        for (int k = 0; k < 64; ++k) st[k] = (s > 0) ? stp[k] : 0.f;
        for (int tl = 0; tl < TS; ++tl) {
            const size_t base = ((size_t)b * TS + tl) * 1024 + h * 64 + lane;
            slab[lane] = bflo((unsigned)PA[base]); slab[64 + lane] = PW[base]; slab[128 + lane] = bflo((unsigned)PB[base]); slab[192 + lane] = bflo((unsigned)PK[base]); slab[256 + lane] = bflo((unsigned)PR[base]);
            const float vv = bflo((unsigned)PV[base]);
            asm volatile("s_waitcnt lgkmcnt(0)" ::: "memory");
            float sa = 0.f;
#pragma unroll
            for (int k = 0; k < 64; ++k) sa += st[k] * slab[k];
            float y = 0.f;
#pragma unroll
            for (int k = 0; k < 64; ++k) { st[k] = st[k] * slab[64 + k] + (sa * slab[128 + k] + vv * slab[192 + k]); y += st[k] * slab[256 + k]; }
            asm volatile("s_waitcnt lgkmcnt(0)" ::: "memory");
            oraw[((size_t)(it * 4 + (lane >> 4)) * TS + tl) * 16 + (lane & 15)] = y;
        }
#pragma unroll
        for (int k = 0; k < 64; ++k) stp[k] = st[k];
    }
}
constexpr int HGB = 53248;
__device__ __forceinline__ void hg_load(LAS unsigned char* bp, int lt2, size_t ltok0, int h8, int rg, const bf16_t* cols, const float* lbv) {
    const int tok = lt2 >> 3, c16 = (lt2 & 7) * 16; const bf16_t* crow = cols + (ltok0 + tok) * CL;
    float q[16], f[16];
    { float t[8]; ld8bf(crow + C_HQ + h8 * 128 + c16, t);
#pragma unroll
      for (int e = 0; e < 8; ++e) q[e] = t[e];
      ld8bf(crow + C_HQ + h8 * 128 + c16 + 8, t);
#pragma unroll
      for (int e = 0; e < 8; ++e) q[8 + e] = t[e];
      ld8bf(crow + C_HF + h8 * 128 + c16, t);
#pragma unroll
      for (int e = 0; e < 8; ++e) f[e] = t[e];
      ld8bf(crow + C_HF + h8 * 128 + c16 + 8, t);
#pragma unroll
      for (int e = 0; e < 8; ++e) f[8 + e] = t[e]; }
    const unsigned rv = *(const unsigned*)(crow + C_HI + h8 * 128 + rg * 16 + (lt2 & 7) * 2);
    const int off = (tok * 128 + c16) * 4;
#pragma unroll
    for (int g = 0; g < 4; ++g) { const f32x4 lb = *(const f32x4*)(lbv + h8 * 128 + c16 + 4 * g); f32x4 fv, kv, qv;
#pragma unroll
        for (int e = 0; e < 4; ++e) { fv[e] = lb[e] + (1.0f - lb[e]) * fast_sigmoid(f[4 * g + e]); kv[e] = 1.0f - fv[e]; qv[e] = fast_silu(q[4 * g + e]); }
        *(LAS f32x4*)(bp + off + 16 * g) = fv; *(LAS f32x4*)(bp + 16384 + off + 16 * g) = kv; *(LAS f32x4*)(bp + 32768 + off + 16 * g) = qv; }
    *(LAS f32x2v*)(bp + 49152 + (tok * 16 + (lt2 & 7) * 2) * 4) = (f32x2v){bflo(rv), bfhi(rv)};
}
__device__ __forceinline__ void hgrn_scan(int s, int bid, int G, int tid, int lane, int wave, LAS unsigned char* lds, const bf16_t* cols, const float* lbv, float* hgo, float* state, bool save) {
    constexpr int NBLK = TS / 32;
    const int rowl = lane >> 4, j = lane & 15, row = (wave & 3) * 4 + rowl;
    for (int it = bid; it < 256; it += G) {
        const int b = it >> 6, h8 = (it >> 3) & 7, rg = it & 7;
        const size_t tok0 = (size_t)b * TS;
        float* stp = state + ((size_t)((b * 8 + h8) * 128 + rg * 16 + row) * 128 + 4 * j);
        float* obase = hgo + (size_t)it * TS * 16;
        f32x4 s0 = (f32x4){0.f, 0.f, 0.f, 0.f}, s1 = s0;
        if (wave < 4 && s > 0) { s0 = *(const f32x4*)stp; s1 = *(const f32x4*)(stp + 64); }
        if (wave >= 4) { hg_load(lds, tid - 256, tok0, h8, rg, cols, lbv); SCAN_BAR_L(); } else { __builtin_amdgcn_s_setprio(2); asm volatile("s_waitcnt vmcnt(0)" ::: "memory"); SCAN_BAR_S(); }
#pragma unroll 1
        for (int blk = 0; blk < NBLK; ++blk) {
            if (wave >= 4) {
                if (blk > 0) y_drain(lds + ((blk - 1) & 1) * HGB + 51200, tid - 256, obase + (size_t)(blk - 1) * 512);
                if (blk + 1 < NBLK) hg_load(lds + ((blk + 1) & 1) * HGB, tid - 256, tok0 + (blk + 1) * 32, h8, rg, cols, lbv);
                SCAN_BAR_L();
            } else {
                const LAS unsigned char* bp = lds + (blk & 1) * HGB;
                const LAS unsigned char* p4 = bp + 16 * j; const LAS unsigned char* pv = bp + 49152 + row * 4; LAS unsigned char* py = (LAS unsigned char*)bp + 51200 + row * 4;
                f32x4 f0 = *(const LAS f32x4*)(p4), f1 = *(const LAS f32x4*)(p4 + 256), k0 = *(const LAS f32x4*)(p4 + 16384), k1 = *(const LAS f32x4*)(p4 + 16384 + 256), q0 = *(const LAS f32x4*)(p4 + 32768), q1 = *(const LAS f32x4*)(p4 + 32768 + 256);
                float iv = *(const LAS float*)(pv); float yprev = 0.f;
#pragma unroll
                for (int t = 0; t < 32; ++t) {
                    f32x4 nf0 = f0, nf1 = f1, nk0 = k0, nk1 = k1, nq0 = q0, nq1 = q1; float niv = iv;
                    if (t < 31) { const int o = (t + 1) * 512; nf0 = *(const LAS f32x4*)(p4 + o); nf1 = *(const LAS f32x4*)(p4 + 256 + o); nk0 = *(const LAS f32x4*)(p4 + 16384 + o); nk1 = *(const LAS f32x4*)(p4 + 16384 + 256 + o);
                                  nq0 = *(const LAS f32x4*)(p4 + 32768 + o); nq1 = *(const LAS f32x4*)(p4 + 32768 + 256 + o); niv = *(const LAS float*)(pv + (t + 1) * 64); }
                    s0 = s0 * f0 + k0 * iv; s1 = s1 * f1 + k1 * iv;
                    float y = ((s0[0] * q0[0] + s0[1] * q0[1]) + (s0[2] * q0[2] + s0[3] * q0[3])) + ((s1[0] * q1[0] + s1[1] * q1[1]) + (s1[2] * q1[2] + s1[3] * q1[3]));
                    if (t & 1) { allreduce16x2(yprev, y); if (j == 0) { *(LAS float*)(py + (t - 1) * 64) = yprev; *(LAS float*)(py + t * 64) = y; } }
                    yprev = y;
                    f0 = nf0; f1 = nf1; k0 = nk0; k1 = nk1; q0 = nq0; q1 = nq1; iv = niv;
                }
                SCAN_BAR_S();
            }
        }
        if (wave >= 4) { y_drain(lds + ((NBLK - 1) & 1) * HGB + 51200, tid - 256, obase + (size_t)(NBLK - 1) * 512); }
        else { __builtin_amdgcn_s_setprio(0); if (save) { *(f32x4*)stp = s0; *(f32x4*)(stp + 64) = s1; } }
    }
}


constexpr int FT = 16;
constexpr int F_RW = 0, F_RWV = 20480, F_RWY = 21504, F_HG = 22528, F_HGI = F_HG + 24576, F_HGY = F_HG + 25600, FBUF = 49152;
__device__ __forceinline__ void fused_load(LAS unsigned char* bp, int lt2, size_t ltok0, int h, int rg, int h8, int rg8, const bf16_t* PA, const float* PW, const bf16_t* PB, const bf16_t* PK, const bf16_t* PR, const bf16_t* PV,
        const bf16_t* cols, const float* lbv) {
    if (lt2 < 128) {
        const int tok = lt2 >> 3, c8 = (lt2 & 7) * 8; const size_t base = (ltok0 + tok) * 1024 + h * 64 + c8;
        const u32x4 ra = *(const u32x4*)(PA + base), rb = *(const u32x4*)(PB + base), rk = *(const u32x4*)(PK + base), rr = *(const u32x4*)(PR + base);
        const f32x4 w0 = *(const f32x4*)(PW + base), w1 = *(const f32x4*)(PW + base + 4);
        const unsigned rv = *(const unsigned*)(PV + (ltok0 + tok) * 1024 + h * 64 + rg * 16 + (lt2 & 7) * 2);
        const int off = (tok * 64 + c8) * 4;
#define RW_PUT(arr, u) do { *(LAS f32x4*)(bp + (arr) * 4096 + off) = (f32x4){bflo(u.x), bfhi(u.x), bflo(u.y), bfhi(u.y)}; *(LAS f32x4*)(bp + (arr) * 4096 + off + 16) = (f32x4){bflo(u.z), bfhi(u.z), bflo(u.w), bfhi(u.w)}; } while (0)
        RW_PUT(0, ra); RW_PUT(2, rb); RW_PUT(3, rk); RW_PUT(4, rr);
#undef RW_PUT
        *(LAS f32x4*)(bp + 4096 + off) = w0; *(LAS f32x4*)(bp + 4096 + off + 16) = w1;
        *(LAS f32x2v*)(bp + F_RWV + (tok * 16 + (lt2 & 7) * 2) * 4) = (f32x2v){bflo(rv), bfhi(rv)};
    } else {
        const int l = lt2 - 128, tok = l >> 3, c16 = (l & 7) * 16; const bf16_t* crow = cols + (ltok0 + tok) * CL;
        float q[16], f[16];
        { float t[8]; ld8bf(crow + C_HQ + h8 * 128 + c16, t);
#pragma unroll
          for (int e = 0; e < 8; ++e) q[e] = t[e];
          ld8bf(crow + C_HQ + h8 * 128 + c16 + 8, t);
#pragma unroll
          for (int e = 0; e < 8; ++e) q[8 + e] = t[e];
          ld8bf(crow + C_HF + h8 * 128 + c16, t);
#pragma unroll
          for (int e = 0; e < 8; ++e) f[e] = t[e];
          ld8bf(crow + C_HF + h8 * 128 + c16 + 8, t);
#pragma unroll
          for (int e = 0; e < 8; ++e) f[8 + e] = t[e]; }
        const unsigned rv = *(const unsigned*)(crow + C_HI + h8 * 128 + rg8 * 16 + (l & 7) * 2);
        LAS unsigned char* hp = bp + F_HG; const int off = (tok * 128 + c16) * 4;
#pragma unroll
        for (int g = 0; g < 4; ++g) { const f32x4 lb = *(const f32x4*)(lbv + h8 * 128 + c16 + 4 * g); f32x4 fv, kv, qv;
#pragma unroll
            for (int e = 0; e < 4; ++e) { fv[e] = lb[e] + (1.0f - lb[e]) * fast_sigmoid(f[4 * g + e]); kv[e] = 1.0f - fv[e]; qv[e] = fast_silu(q[4 * g + e]); }
            *(LAS f32x4*)(hp + off + 16 * g) = fv; *(LAS f32x4*)(hp + 8192 + off + 16 * g) = kv; *(LAS f32x4*)(hp + 16384 + off + 16 * g) = qv; }
        *(LAS f32x2v*)(bp + F_HGI + (tok * 16 + (l & 7) * 2) * 4) = (f32x2v){bflo(rv), bfhi(rv)};
    }
}
__device__ __forceinline__ void fused_drain(const LAS unsigned char* bp, int lt2, float* orw, float* ohg) {
    if (lt2 < 128) *(f32x2v*)(orw + lt2 * 2) = *(const LAS f32x2v*)(bp + F_RWY + lt2 * 8);
    else *(f32x2v*)(ohg + (lt2 - 128) * 2) = *(const LAS f32x2v*)(bp + F_HGY + (lt2 - 128) * 8);
}
__device__ __forceinline__ void fused_scan(int s, int bid, int G, int tid, int lane, int wave, LAS unsigned char* lds,
        const bf16_t* PA, const float* PW, const bf16_t* PB, const bf16_t* PK, const bf16_t* PR, const bf16_t* PV, const bf16_t* cols, const float* lbv,
        float* oraw, float* hgo, float* rwstate, float* hgstate, bool save) {
    constexpr int NBLK = TS / FT;
    const int rowl = lane >> 4, j = lane & 15, row = (wave & 3) * 4 + rowl;
    for (int it = bid; it < 256; it += G) {
        const int b = it >> 6, h = (it >> 2) & 15, rg = it & 3, h8 = (it >> 3) & 7, rg8 = it & 7;
        const size_t tok0 = (size_t)b * TS;
        float* stp = rwstate + ((size_t)((b * 16 + h) * 64 + rg * 16 + row) * 64 + 4 * j);
        float* shp = hgstate + ((size_t)((b * 8 + h8) * 128 + rg8 * 16 + row) * 128 + 4 * j);
        float* orw = oraw + (size_t)it * TS * 16; float* ohg = hgo + (size_t)it * TS * 16;
        f32x4 st = (f32x4){0.f, 0.f, 0.f, 0.f}, s0 = st, s1 = st;
        if (wave < 4 && s > 0) { st = *(const f32x4*)stp; s0 = *(const f32x4*)shp; s1 = *(const f32x4*)(shp + 64); }
        if (wave >= 4) { fused_load(lds, tid - 256, tok0, h, rg, h8, rg8, PA, PW, PB, PK, PR, PV, cols, lbv); SCAN_BAR_L(); } else { __builtin_amdgcn_s_setprio(2); asm volatile("s_waitcnt vmcnt(0)" ::: "memory"); SCAN_BAR_S(); }
#pragma unroll 1
        for (int blk = 0; blk < NBLK; ++blk) {
            if (wave >= 4) {
                if (blk > 0) fused_drain(lds + ((blk - 1) & 1) * FBUF, tid - 256, orw + (size_t)(blk - 1) * (FT * 16), ohg + (size_t)(blk - 1) * (FT * 16));
                if (blk + 1 < NBLK) fused_load(lds + ((blk + 1) & 1) * FBUF, tid - 256, tok0 + (blk + 1) * FT, h, rg, h8, rg8, PA, PW, PB, PK, PR, PV, cols, lbv);
                SCAN_BAR_L();
            } else {
                const LAS unsigned char* bp = lds + (blk & 1) * FBUF;
                const LAS unsigned char* p4 = bp + 16 * j; const LAS unsigned char* pv = bp + F_RWV + row * 4; LAS unsigned char* py = (LAS unsigned char*)bp + F_RWY + row * 4;
                const LAS unsigned char* g4 = bp + F_HG + 16 * j; const LAS unsigned char* gi = bp + F_HGI + row * 4; LAS unsigned char* gy = (LAS unsigned char*)bp + F_HGY + row * 4;
                f32x4 a4 = *(const LAS f32x4*)(p4), w4 = *(const LAS f32x4*)(p4 + 4096), b4 = *(const LAS f32x4*)(p4 + 8192), k4 = *(const LAS f32x4*)(p4 + 12288), r4 = *(const LAS f32x4*)(p4 + 16384);
                float vv = *(const LAS float*)(pv);
                f32x4 f0 = *(const LAS f32x4*)(g4), f1 = *(const LAS f32x4*)(g4 + 256), k0 = *(const LAS f32x4*)(g4 + 8192), k1 = *(const LAS f32x4*)(g4 + 8192 + 256), q0 = *(const LAS f32x4*)(g4 + 16384), q1 = *(const LAS f32x4*)(g4 + 16384 + 256);
                float iv = *(const LAS float*)(gi);
                float sa = (st[0] * a4[0] + st[1] * a4[1]) + (st[2] * a4[2] + st[3] * a4[3]);
                sa = allreduce16(sa);
#pragma unroll
                for (int t = 0; t < FT; ++t) {
                    f32x4 na = a4, nw = w4, nb = b4, nk = k4, nr = r4; float nv = vv;
                    f32x4 nf0 = f0, nf1 = f1, nk0 = k0, nk1 = k1, nq0 = q0, nq1 = q1; float niv = iv;
                    if (t < FT - 1) { const int o = (t + 1) * 256; na = *(const LAS f32x4*)(p4 + o); nw = *(const LAS f32x4*)(p4 + 4096 + o); nb = *(const LAS f32x4*)(p4 + 8192 + o); nk = *(const LAS f32x4*)(p4 + 12288 + o); nr = *(const LAS f32x4*)(p4 + 16384 + o); nv = *(const LAS float*)(pv + (t + 1) * 64);
                        const int o2 = (t + 1) * 512; nf0 = *(const LAS f32x4*)(g4 + o2); nf1 = *(const LAS f32x4*)(g4 + 256 + o2); nk0 = *(const LAS f32x4*)(g4 + 8192 + o2); nk1 = *(const LAS f32x4*)(g4 + 8192 + 256 + o2);
                        nq0 = *(const LAS f32x4*)(g4 + 16384 + o2); nq1 = *(const LAS f32x4*)(g4 + 16384 + 256 + o2); niv = *(const LAS float*)(gi + (t + 1) * 64); }
                    st = st * w4 + (b4 * sa + k4 * vv);
                    s0 = s0 * f0 + k0 * iv; s1 = s1 * f1 + k1 * iv;
                    float y = (st[0] * r4[0] + st[1] * r4[1]) + (st[2] * r4[2] + st[3] * r4[3]);
                    float sn = (st[0] * na[0] + st[1] * na[1]) + (st[2] * na[2] + st[3] * na[3]);
                    float yh = ((s0[0] * q0[0] + s0[1] * q0[1]) + (s0[2] * q0[2] + s0[3] * q0[3])) + ((s1[0] * q1[0] + s1[1] * q1[1]) + (s1[2] * q1[2] + s1[3] * q1[3]));
                    sn = dpp_add<0xB1>(sn); y = dpp_add<0xB1>(y); yh = dpp_add<0xB1>(yh); sn = dpp_add<0x4E>(sn); y = dpp_add<0x4E>(y); yh = dpp_add<0x4E>(yh);
                    sn = dpp_add<0x141>(sn); y = dpp_add<0x141>(y); yh = dpp_add<0x141>(yh); sn = dpp_add<0x140>(sn); y = dpp_add<0x140>(y); yh = dpp_add<0x140>(yh);
                    if (j == 0) { *(LAS float*)(py + t * 64) = y; *(LAS float*)(gy + t * 64) = yh; }
                    sa = sn; a4 = na; w4 = nw; b4 = nb; k4 = nk; r4 = nr; vv = nv;
                    f0 = nf0; f1 = nf1; k0 = nk0; k1 = nk1; q0 = nq0; q1 = nq1; iv = niv;
                }
                SCAN_BAR_S();
            }
        }
        if (wave >= 4) fused_drain(lds + ((NBLK - 1) & 1) * FBUF, tid - 256, orw + (size_t)(NBLK - 1) * (FT * 16), ohg + (size_t)(NBLK - 1) * (FT * 16));
        else { __builtin_amdgcn_s_setprio(0); if (save) { *(f32x4*)stp = st; *(f32x4*)shp = s0; *(f32x4*)(shp + 64) = s1; } }
    }
}

__device__ __forceinline__ void attn_phase(int gw, int NGW, int lane, const bf16_t* Q, const bf16_t* KV, const bf16_t* Vt, bf16_t* AO) {
    const int fr = lane & 15, fq = lane >> 4;
    for (int item = gw; item < 8192; item += NGW) {
        const int bh = item >> 9, tile = item & 511, b = bh >> 2, hd = bh & 3;
        const size_t gt = (size_t)b * SEQ + tile * 16 + fr;
        bf16x8 qf[8];
#pragma unroll
        for (int ks = 0; ks < 8; ++ks) qf[ks] = *(const bf16x8*)(Q + gt * 1024 + hd * 256 + ks * 32 + fq * 8);
        f32x4 sc[16]; float mx = -3.0e38f;
#pragma unroll
        for (int kt = 0; kt < 16; ++kt) { f32x4 acc = (f32x4){0.f, 0.f, 0.f, 0.f}; const bf16_t* kp = KV + (size_t)(b * 256 + kt * 16 + fr) * 2048 + hd * 256 + fq * 8;
#pragma unroll
            for (int ks = 0; ks < 8; ++ks) acc = MFMA16(*(const bf16x8*)(kp + ks * 32), qf[ks], acc);
            sc[kt] = acc * 0.0625f; mx = fmaxf(mx, fmaxf(fmaxf(sc[kt][0], sc[kt][1]), fmaxf(sc[kt][2], sc[kt][3]))); }
        mx = fmaxf(mx, __shfl_xor(mx, 16)); mx = fmaxf(mx, __shfl_xor(mx, 32));
        float sum = 0.f;
#pragma unroll
        for (int kt = 0; kt < 16; ++kt) {
#pragma unroll
            for (int jj = 0; jj < 4; ++jj) { sc[kt][jj] = __expf(sc[kt][jj] - mx); sum += sc[kt][jj]; } }
        sum = fq_sum(sum);
        const float inv = 1.0f / sum;
        bf16x8 pf[8];
#pragma unroll
        for (int k2 = 0; k2 < 8; ++k2) { u32x4 w; w.x = cvt_pk_bf16(sc[2 * k2][0], sc[2 * k2][1]); w.y = cvt_pk_bf16(sc[2 * k2][2], sc[2 * k2][3]); w.z = cvt_pk_bf16(sc[2 * k2 + 1][0], sc[2 * k2 + 1][1]); w.w = cvt_pk_bf16(sc[2 * k2 + 1][2], sc[2 * k2 + 1][3]); pf[k2] = __builtin_bit_cast(bf16x8, w); }
#pragma unroll 2
        for (int dt = 0; dt < 16; ++dt) { f32x4 acc = (f32x4){0.f, 0.f, 0.f, 0.f}; const bf16_t* vp = Vt + (size_t)((b * 4 + hd) * 256 + dt * 16 + fr) * 256 + fq * 8;
#pragma unroll
            for (int k2 = 0; k2 < 8; ++k2) acc = MFMA16(*(const bf16x8*)(vp + k2 * 32), pf[k2], acc);
            st4bf(AO + gt * 1024 + hd * 256 + dt * 16 + 4 * fq, acc * inv); }
    }
}

__device__ __forceinline__ int tid_fresh() { int t = threadIdx.x; asm volatile("" : "+v"(t)); return t; }
#define WinT ((bf16_t*)(a.ws + WS_WIN))
#define WoutT ((bf16_t*)(a.ws + WS_WOUT))
#define WqT ((bf16_t*)(a.ws + WS_WQ))
#define WoT ((bf16_t*)(a.ws + WS_WO))
#define WkvT ((bf16_t*)(a.ws + WS_WKV))
#define W13T ((bf16_t*)(a.ws + WS_W13))
#define W2T ((bf16_t*)(a.ws + WS_W2))
#define rw2T ((bf16_t*)(a.ws + WS_RW2T))
#define ra2T ((bf16_t*)(a.ws + WS_RA2T))
#define rg2T ((bf16_t*)(a.ws + WS_RG2T))
#define g2Tp ((bf16_t*)(a.ws + WS_G2TP))
#define GATE ((bf16_t*)(a.ws + WS_GATE))
#define ASG ((bf16_t*)(a.ws + WS_ASG))
#define carry ((bf16_t*)(a.ws + WS_CARRY))
#define lbv ((float*)(a.ws + WS_LB))
#define mbf ((bf16_t*)(a.ws + WS_MBF))
#define KV ((bf16_t*)(a.ws + WS_KV))
#define Vt ((bf16_t*)(a.ws + WS_VT))
#define rwst ((float*)(a.ws + WS_RWST))
#define hgst ((float*)(a.ws + WS_HGST))
#define bonus ((float*)(a.ws + WS_BONUS))
#define merged ((bf16_t*)(a.ws + WS_MERGED))
#define u1 ((bf16_t*)(a.ws + WS_U1))
#define cols ((bf16_t*)(a.ws + WS_COLS))
#define PR ((bf16_t*)(a.ws + WS_PR))
#define PK ((bf16_t*)(a.ws + WS_PK))
#define PA ((bf16_t*)(a.ws + WS_PA))
#define PB ((bf16_t*)(a.ws + WS_PB))
#define PV ((bf16_t*)(a.ws + WS_PV))
#define PW ((float*)(a.ws + WS_PW))
#define oraw ((float*)(a.ws + WS_ORAW))
#define hgo ((float*)(a.ws + WS_HGO))
#define U ((bf16_t*)(a.ws + WS_U))
#define Qb ((bf16_t*)(a.ws + WS_Q))
#define AO ((bf16_t*)(a.ws + WS_AO))
#define FF ((bf16_t*)(a.ws + WS_FF))
#define XIN (a.in[0])
#define OUTP (a.out)
struct Args { const float* in[29]; float* out; unsigned char* ws; int ph_lo, ph_hi; };

typedef const __attribute__((address_space(4))) Args* CArgsP;
__device__ __forceinline__ CArgsP args_fresh() { CArgsP p = (CArgsP)__builtin_amdgcn_kernarg_segment_ptr(); asm volatile("" : "+s"(p)); return p; }
__global__ void __launch_bounds__(512, 2) mega(Args a0) {
    extern __shared__ __attribute__((aligned(16))) unsigned char lds_raw[];
    LAS unsigned char* lds = (LAS unsigned char*)lds_raw;
    cg::grid_group grid = cg::this_grid();
    const int G = gridDim.x, bid = blockIdx.x, NGW = G * 8, NGT = G * 512;
#define IDS const auto& a = *args_fresh(); const int tid = tid_fresh(), lane = tid & 63, wave = __builtin_amdgcn_readfirstlane(tid >> 6), gw = bid * 8 + wave, gtid = bid * 512 + tid; (void)lane; (void)gw; (void)gtid
    const int lo = a0.ph_lo, hi = a0.ph_hi;
    { volatile LAS unsigned* misc = (volatile LAS unsigned*)(lds + MISC_OFF); if (threadIdx.x < 2) misc[threadIdx.x] = 0u; __syncthreads();
      if (hi - lo > 1) (void)xcd_barrier_post((unsigned*)(a0.ws + WS_CTL), misc); }
#ifndef MK_REP
#define MK_REP -1
#endif
#ifndef MK_REPN
#define MK_REPN 3
#endif
#define RPT(code) for (int rep_ = 0, nrep_ = (MK_REP == (code)) ? MK_REPN : 1; rep_ < nrep_; ++rep_)
#define LASTREP (rep_ == nrep_ - 1)
#define IN(k) (lo <= (k) && (k) < hi)
#define SEAM(k) do { if (IN(k) && IN((k) + 1)) RPT(120) { if ((k) == 0) { asm volatile("s_waitcnt vmcnt(0) lgkmcnt(0)" ::: "memory"); grid.sync(); __builtin_amdgcn_fence(__ATOMIC_ACQUIRE, "agent"); asm volatile("s_waitcnt vmcnt(0)" ::: "memory"); } else { XcdBarrier xb_; xb_.bar = (unsigned*)(args_fresh()->ws + WS_CTL); xb_.x = xb_xcc_id(); xb_.st = (volatile LAS unsigned*)(lds + MISC_OFF); xcd_barrier(xb_); } } } while (0)

    if (IN(0)) { IDS;
        LAS float* scr = (LAS float*)(lds + wave * 16384);
        constexpr int I_IN = 16 * 297, I_SQ = 16 * 32, I_13 = 16 * 88, I_2 = 44 * 32;
        constexpr int NITEMS = I_IN + 5 * I_SQ + 2 * I_13 + I_2;
        for (int it = gw; it < NITEMS; it += NGW) {
            int r = it;
            if (r < I_IN) { const int kb = r / 297, n0 = (r % 297) * 32; tr_item(a.in[3], 1024, 9504, WinT, kb, n0, n0 + (n0 >= 3360 ? 224 : 0), scr, lane); continue; } r -= I_IN;
            if (r < I_SQ) { tr_item(a.in[17], 1024, 1024, WoutT, r / 32, (r % 32) * 32, (r % 32) * 32, scr, lane); continue; } r -= I_SQ;
            if (r < I_SQ) { tr_item(a.in[20], 1024, 1024, WqT, r / 32, (r % 32) * 32, (r % 32) * 32, scr, lane); continue; } r -= I_SQ;
            if (r < I_SQ) { tr_item(a.in[23], 1024, 1024, WoT, r / 32, (r % 32) * 32, (r % 32) * 32, scr, lane); continue; } r -= I_SQ;
            if (r < I_SQ) { tr_item(a.in[21], 1024, 1024, WkvT, r / 32, (r % 32) * 32, (r % 32) * 32, scr, lane); continue; } r -= I_SQ;
            if (r < I_SQ) { tr_item(a.in[22], 1024, 1024, WkvT, r / 32, (r % 32) * 32, 1024 + (r % 32) * 32, scr, lane); continue; } r -= I_SQ;
            if (r < I_13) { const int n0 = (r % 88) * 32; tr_item(a.in[25], 1024, DFF, W13T, r / 88, n0, (n0 / 128) * 256 + (n0 % 128), scr, lane); continue; } r -= I_13;
            if (r < I_13) { const int n0 = (r % 88) * 32; tr_item(a.in[26], 1024, DFF, W13T, r / 88, n0, (n0 / 128) * 256 + 128 + (n0 % 128), scr, lane); continue; } r -= I_13;
            tr_item(a.in[27], DFF, 1024, W2T, r / 32, (r % 32) * 32, (r % 32) * 32, scr, lane);
        }
        for (int i = gtid; i < 28672; i += NGT) ((u32x4*)(WinT + 3360 * 1024))[i] = (u32x4){0u, 0u, 0u, 0u};
        for (int i = gtid; i < 1792; i += NGT) ((u32x4*)carry)[i] = (u32x4){0u, 0u, 0u, 0u};
        for (int n = gw; n < 1024; n += NGW) { rw2T[n * 64 + lane] = (bf16_t)f2bf(a.in[6][lane * 1024 + n]); ra2T[n * 64 + lane] = (bf16_t)f2bf(a.in[8][lane * 1024 + n]); }
        for (int m = gw; m < 512; m += NGW) {
            for (int e = lane; e < 320; e += 64) { const int n = 2 * m + (e >= 160 ? 1 : 0), k = e >= 160 ? e - 160 : e; rg2T[n * 160 + k] = (bf16_t)f2bf(a.in[9][k * 1024 + n]); } }
        for (int n = gw; n < 1024; n += NGW) { f32x4 v;
#pragma unroll
            for (int e = 0; e < 4; ++e) { const int k = 4 * lane + e; v[e] = k < 160 ? a.in[9][k * 1024 + n] : 0.f; }
            st4bf(g2Tp + n * 256 + 4 * lane, v); }
        for (int i = gtid; i < 1024; i += NGT) lbv[i] = 1.0f / (1.0f + __expf(a.in[15][1024 + i] - a.in[15][i]));
        for (int m = gw; m < 1024; m += NGW) rms_row_bf16(a.in[1] + (size_t)m * 1024, a.in[19], mbf + (size_t)m * 1024, lane);
        __syncthreads();
    }
    SEAM(0);

#pragma unroll 1
    for (int s = 0; s < NSPLIT; ++s) {
        const int pb = 1 + 5 * s;
        if (IN(pb)) { IDS;
            RPT(101) for (int lt = gw; lt < MS; lt += NGW) { const int b = lt / TS, tl = lt % TS; const size_t gt = (size_t)b * SEQ + s * TS + tl; rms_row_bf16(XIN + gt * 1024, a.in[2], u1 + (size_t)lt * 1024, lane); }
        }
        SEAM(pb);
        if (IN(pb + 1)) { const auto& a = *args_fresh();
            pg8::Gemm g{u1, WinT, MS, CL, 1024}; pg8::StaticOrder S; S.init(MS, CL, G, bid);
            pg8::EpiStoreBf16 E{cols, CL};
            RPT(102) pg8::gemm_phase<pg8::EpiStoreBf16, pg8::StaticOrder, true, true>(lds, g, S, E);
        }
        SEAM(pb + 1);
#ifndef SKIP_PREP
        if (IN(pb + 2)) { IDS; RPT(103) prep_phase(s, gw, NGW, lane, cols, carry, a.in[4], a.in[5], a.in[7], a.in[10], a.in[11], a.in[12], rw2T, ra2T, PR, PK, PA, PB, PV, PW, bonus, ASG); }
#endif
        SEAM(pb + 2);
        if (IN(pb + 3)) { IDS;
#ifdef MK_ZERO_SCAN
            for (int i = gtid; i < MS * 256; i += NGT) { ((f32x4*)oraw)[i] = (f32x4){0.f, 0.f, 0.f, 0.f}; ((f32x4*)hgo)[i] = (f32x4){0.01f, 0.02f, 0.03f, 0.04f}; }
#endif
#ifdef MK_SPLIT_SCANS
            RPT(104) { rwkv_scan(s, bid, G, tid, lane, wave, lds, PA, PW, PB, PK, PR, PV, oraw, rwst, LASTREP); __syncthreads(); }
            RPT(105) { hgrn_scan(s, bid, G, tid, lane, wave, lds, cols, lbv, hgo, hgst, LASTREP); __syncthreads(); }
#else
            RPT(104) { fused_scan(s, bid, G, tid, lane, wave, lds, PA, PW, PB, PK, PR, PV, cols, lbv, oraw, hgo, rwst, hgst, LASTREP); __syncthreads(); }
#endif
            { pg8::Gemm g{ASG, g2Tp, MS, 1024, 256}; pg8::StaticOrder S; S.init(MS, 1024, G, bid); pg8::EpiStoreBf16 E{GATE, 1024};
              pg8::gemm_phase<pg8::EpiStoreBf16, pg8::StaticOrder, true, true>(lds, g, S, E); }
        }
        SEAM(pb + 3);
        if (IN(pb + 4)) { IDS;
#ifdef MK_NOMIX
            for (int i = gtid; i < MS * 128; i += NGT) { const int lt = i >> 7, b = lt / TS, tl = lt % TS; const size_t gt = (size_t)b * SEQ + s * TS + tl; ((u32x4*)(merged + gt * 1024))[i & 127] = (u32x4){0u, 0u, 0u, 0u}; }
#endif
#ifndef SKIP_POST
            RPT(106) post_phase(s, gw, NGW, lane, cols, carry, a.in[4], GATE, a.in[13], a.in[14], a.in[16], oraw, hgo, PV, bonus, merged);
#endif
            if (bid < 4 && s + 1 < NSPLIT) { const u32x4* src = (const u32x4*)(cols + (size_t)(bid * TS + TS - 1) * CL); u32x4* dst = (u32x4*)(carry + (((s + 1) & 1) * 4 + bid) * CARRY_LD);
                for (int i = tid; i < CARRY_LD / 8; i += 512) dst[i] = src[i]; }
        }
        SEAM(pb + 4);
    }

    if (IN(T0 + 0)) { const auto& a = *args_fresh();
        { pg8::Gemm g{merged, WoutT, NTOK, 1024, 1024}; pg8::StaticOrder S; S.init(NTOK, 1024, G, bid); pg8::EpiResF32 E{XIN, OUTP, 1024};
          pg8::gemm_phase<pg8::EpiResF32, pg8::StaticOrder, true, true>(lds, g, S, E); }
        { pg8::Gemm g{mbf, WkvT, 1024, 2048, 1024}; pg8::StaticOrder S; S.init(1024, 2048, G, bid); pg8::EpiStoreBf16 E{KV, 2048};
          pg8::gemm_phase<pg8::EpiStoreBf16, pg8::StaticOrder, true, true>(lds, g, S, E); }
    }
    SEAM(T0 + 0);
    if (IN(T0 + 1)) { IDS;
        for (int gt = gw; gt < NTOK; gt += NGW) rms_row_bf16(OUTP + (size_t)gt * 1024, a.in[18], U + (size_t)gt * 1024, lane);
        for (int i = gtid; i < 4 * 4 * 256 * 256; i += NGT) { const int kp = i & 255, dim = (i >> 8) & 255, hd = (i >> 16) & 3, b = i >> 18;
            const int k2 = kp >> 5, fq = (kp >> 3) & 3, sl = kp & 7; const int key = 32 * k2 + (sl < 4 ? 4 * fq + sl : 16 + 4 * fq + sl - 4);
            Vt[i] = KV[(size_t)(b * 256 + key) * 2048 + 1024 + hd * 256 + dim]; }
    }
    SEAM(T0 + 1);
    if (IN(T0 + 2)) { const auto& a = *args_fresh(); pg8::Gemm g{U, WqT, NTOK, 1024, 1024}; pg8::StaticOrder S; S.init(NTOK, 1024, G, bid); pg8::EpiStoreBf16 E{Qb, 1024};
        RPT(112) pg8::gemm_phase<pg8::EpiStoreBf16, pg8::StaticOrder, true, true>(lds, g, S, E); }
    SEAM(T0 + 2);
#ifndef SKIP_ATTN
    if (IN(T0 + 3)) { IDS; RPT(113) attn_phase(gw, NGW, lane, Qb, KV, Vt, AO); }
#endif
    SEAM(T0 + 3);
#ifndef MK_NOATT
    if (IN(T0 + 4)) { const auto& a = *args_fresh(); pg8::Gemm g{AO, WoT, NTOK, 1024, 1024}; pg8::StaticOrder S; S.init(NTOK, 1024, G, bid); pg8::EpiResF32 E{OUTP, OUTP, 1024};
        pg8::gemm_phase<pg8::EpiResF32, pg8::StaticOrder, true, true>(lds, g, S, E); }
#endif
    SEAM(T0 + 4);
    if (IN(T0 + 5)) { IDS; RPT(115) for (int gt = gw; gt < NTOK; gt += NGW) rms_row_bf16(OUTP + (size_t)gt * 1024, a.in[24], U + (size_t)gt * 1024, lane); }
    SEAM(T0 + 5);
    if (IN(T0 + 6)) { const auto& a = *args_fresh(); pg8::Gemm g{U, W13T, NTOK, 2 * DFF, 1024}; pg8::StaticOrder S; S.init(NTOK, 2 * DFF, G, bid); pg8::EpiSwiGLU E{FF, DFF};
        RPT(116) pg8::gemm_phase<pg8::EpiSwiGLU, pg8::StaticOrder, true, true>(lds, g, S, E); }
    SEAM(T0 + 6);
    if (IN(T0 + 7)) { const auto& a = *args_fresh(); pg8::Gemm g{FF, W2T, NTOK, 1024, DFF}; pg8::StaticOrder S; S.init(NTOK, 1024, G, bid); pg8::EpiResF32 E{OUTP, OUTP, 1024};
        pg8::gemm_phase<pg8::EpiResF32, pg8::StaticOrder, true, true>(lds, g, S, E); }
    SEAM(T0 + 7);
    if (IN(T0 + 8)) { IDS;
        const float* gf = a.in[28];
        for (int gt = gw; gt < NTOK; gt += NGW) { f32x4* row = (f32x4*)(OUTP + (size_t)gt * 1024); f32x4 v[4]; float sq = 0.f;
#pragma unroll
            for (int j = 0; j < 4; ++j) { v[j] = row[lane + 64 * j]; sq += (v[j][0] * v[j][0] + v[j][1] * v[j][1]) + (v[j][2] * v[j][2] + v[j][3] * v[j][3]); }
            const float rs = 1.0f / sqrtf(wave_sum(sq) * (1.0f / 1024.0f) + 1e-6f);
#pragma unroll
            for (int j = 0; j < 4; ++j) row[lane + 64 * j] = v[j] * rs * ((const f32x4*)gf)[lane + 64 * j]; }
    }
#undef IN
#undef SEAM
}

#ifndef MK_MULTI
#define MK_MULTI 0
#endif
extern "C" void kernel_launch(void* const* d_in, const int* in_sizes, int n_in, void* d_out, int out_size, void* d_ws, size_t ws_size, hipStream_t stream) {
    static int grid = 0;
    if (grid == 0) {
        if (n_in != 29 || in_sizes[0] != NTOK * D || out_size != NTOK * D || ws_size < WS_END) { fprintf(stderr, "kernel_launch: unexpected shapes / workspace (%d inputs, ws %zu)\n", n_in, ws_size); grid = -1; return; }
        int dev = 0, cus = 0, per_cu = 0;
        hipGetDevice(&dev); hipDeviceGetAttribute(&cus, hipDeviceAttributeMultiprocessorCount, dev);
        hipFuncSetAttribute((const void*)mega, hipFuncAttributeMaxDynamicSharedMemorySize, LDS_BYTES);
        hipOccupancyMaxActiveBlocksPerMultiprocessor(&per_cu, (const void*)mega, 512, LDS_BYTES);
        (void)hipGetLastError();
        if (per_cu < 1) per_cu = 1;
        grid = cus;
    }
    if (grid < 0) return;
    Args a{};
    for (int i = 0; i < 29; ++i) a.in[i] = (const float*)d_in[i];
    a.out = (float*)d_out; a.ws = (unsigned char*)d_ws;
    (void)hipMemsetAsync((char*)d_ws + WS_CTL, 0, CTL_BYTES, stream);
    void* args[] = {&a};
#if MK_MULTI
    for (int ph = 0; ph < N_PHASES; ++ph) { a.ph_lo = ph; a.ph_hi = ph + 1; hipLaunchCooperativeKernel((const void*)mega, dim3(grid), dim3(512), args, LDS_BYTES, stream); }
#else
    a.ph_lo = 0; a.ph_hi = N_PHASES;
    hipError_t e = hipLaunchCooperativeKernel((const void*)mega, dim3(grid), dim3(512), args, LDS_BYTES, stream);
    if (e != hipSuccess) fprintf(stderr, "cooperative launch failed: %s (grid %d)\n", hipGetErrorString(e), grid);
#endif
}
```

```cpp
#include <hip/hip_runtime.h>
#include <hip/hip_cooperative_groups.h>
#include <cstdint>
#include <cstdio>
namespace cg = cooperative_groups;
namespace pg8 {
#define PG8_LAS __attribute__((address_space(3)))
typedef unsigned short bf16_t;
typedef short bf16x8 __attribute__((ext_vector_type(8)));
typedef float f32x4 __attribute__((ext_vector_type(4)));
typedef unsigned u32x4 __attribute__((ext_vector_type(4)));
constexpr int BM = 256, BK = 64, HALF = 128, HTB = HALF * BK * 2  , STAGE_BYTES = 8 * HTB, NXCD = 8, WGM = 8;

__host__ __device__ __forceinline__ int lds_byte(int r, int c) { const int st = (r >> 4) * 2 + (c >> 5), rr = r & 15, cc = c & 31, ob = rr * 64 + cc * 2; return st * 1024 + (ob ^ (((ob >> 9) & 1) << 5)); }
__host__ __device__ __forceinline__ void stage_rc(int b, int& R, int& C) { const int st = b / 1024, sb = b % 1024, swz = sb ^ (((sb >> 9) & 1) << 5); R = (st >> 1) * 16 + swz / 64; C = (st & 1) * 32 + (swz % 64) / 2; }
__host__ __device__ __forceinline__ int perm32(int rho) { const int n = rho >> 4, i = rho & 15; return 8 * (i >> 2) + 4 * n + (i & 3); }

struct Unit { int pm, pn; };
struct Gemm { const bf16_t* A; const bf16_t* Bt; int M, N, K; };

struct StaticOrder {
    int nM, nN, nwg, G, c;
    __host__ __device__ void init(int M, int N, int G_, int c_) { nM = M / BM; nN = N / BM; nwg = nM * nN; G = G_; c = c_; }
    __host__ __device__ bool next(int i, Unit& u) const {
        const long L = (long)i * G + c; if (L >= nwg) return false;
        int wgid = (int)L; { const int q = nwg / NXCD, r = nwg % NXCD, xcd = wgid % NXCD, off = wgid / NXCD; wgid = (xcd < r ? xcd * (q + 1) : r * (q + 1) + (xcd - r) * q) + off; }
        const int nig = WGM * nN, gid = wgid / nig, fm = gid * WGM, gsz = (nM - fm) < WGM ? (nM - fm) : WGM;
        u.pm = fm + ((wgid % nig) % gsz); u.pn = (wgid % nig) / gsz; return true;
    }
    __device__ __forceinline__ void a_ready(const Unit&) const {}
    __device__ __forceinline__ void done(const Unit&) const {}
};

__device__ __forceinline__ unsigned cvt_pk_bf16(float lo, float hi) { unsigned r; asm volatile("v_cvt_pk_bf16_f32 %0, %1, %2" : "=v"(r) : "v"(lo), "v"(hi)); return r; }
__device__ __forceinline__ float fast_sigmoid(float x) { return __builtin_amdgcn_rcpf(1.0f + __expf(-x)); }
__device__ __forceinline__ float fast_silu(float x) { return x * fast_sigmoid(x); }
struct EpiStoreBf16 {
    static constexpr bool PERM = true, AFTER_DRAIN = false;
    bf16_t* O; int ldc;
    __device__ __forceinline__ void operator()(const f32x4 (&acc)[2][2][4][2], const Unit& u, int wr, int wc, int fr, int fq) const {
        const int row0 = u.pm * BM + wr * 64 + fr, col0 = u.pn * BM + wc * 32 + 8 * fq;
#pragma unroll
        for (int ai = 0; ai < 2; ++ai)
#pragma unroll
            for (int m = 0; m < 4; ++m) { bf16_t* rowp = O + (size_t)(row0 + ai * HALF + m * 16) * ldc + col0;
#pragma unroll
                for (int bj = 0; bj < 2; ++bj) { const f32x4 v0 = acc[ai][bj][m][0], v1 = acc[ai][bj][m][1];
                    u32x4 w; w.x = cvt_pk_bf16(v0[0], v0[1]); w.y = cvt_pk_bf16(v0[2], v0[3]); w.z = cvt_pk_bf16(v1[0], v1[1]); w.w = cvt_pk_bf16(v1[2], v1[3]);
                    *(u32x4*)(rowp + bj * HALF) = w; } }
    }
};
struct EpiResF32 {
    static constexpr bool PERM = true, AFTER_DRAIN = false;
    const float* base; float* out; int ldc;
    __device__ __forceinline__ void operator()(const f32x4 (&acc)[2][2][4][2], const Unit& u, int wr, int wc, int fr, int fq) const {
        const int row0 = u.pm * BM + wr * 64 + fr, col0 = u.pn * BM + wc * 32 + 8 * fq;
#pragma unroll
        for (int ai = 0; ai < 2; ++ai)
#pragma unroll
            for (int m = 0; m < 4; ++m) { const size_t off = (size_t)(row0 + ai * HALF + m * 16) * ldc + col0;
#pragma unroll
                for (int bj = 0; bj < 2; ++bj)
#pragma unroll
                    for (int n = 0; n < 2; ++n) { const size_t p = off + bj * HALF + 4 * n; const f32x4 b = *(const f32x4*)(base + p); *(f32x4*)(out + p) = b + acc[ai][bj][m][n]; } }
    }
};
struct EpiSwiGLU {
    static constexpr bool PERM = true, AFTER_DRAIN = false;
    bf16_t* O; int ldc;
    __device__ __forceinline__ void operator()(const f32x4 (&acc)[2][2][4][2], const Unit& u, int wr, int wc, int fr, int fq) const {
        const int row0 = u.pm * BM + wr * 64 + fr, col0 = u.pn * HALF + wc * 32 + 8 * fq;
#pragma unroll
        for (int ai = 0; ai < 2; ++ai)
#pragma unroll
            for (int m = 0; m < 4; ++m) { bf16_t* rowp = O + (size_t)(row0 + ai * HALF + m * 16) * ldc + col0;
                f32x4 v0, v1;
#pragma unroll
                for (int j = 0; j < 4; ++j) { v0[j] = fast_silu(acc[ai][0][m][0][j]) * acc[ai][1][m][0][j]; v1[j] = fast_silu(acc[ai][0][m][1][j]) * acc[ai][1][m][1][j]; }
                u32x4 w; w.x = cvt_pk_bf16(v0[0], v0[1]); w.y = cvt_pk_bf16(v0[2], v0[3]); w.z = cvt_pk_bf16(v1[0], v1[1]); w.w = cvt_pk_bf16(v1[2], v1[3]);
                *(u32x4*)rowp = w; }
    }
};

struct EpiColsAct {
    static constexpr bool PERM = true, AFTER_DRAIN = false;
    bf16_t* O; int ldc;
    __device__ __forceinline__ void operator()(const f32x4 (&acc)[2][2][4][2], const Unit& u, int wr, int wc, int fr, int fq) const {
        const int row0 = u.pm * BM + wr * 64 + fr, col0 = u.pn * BM + wc * 32 + 8 * fq;
        const int pn = u.pn; const int act = (pn >= 14 && pn < 18) ? 1 : (pn >= 18 && pn < 22) ? 2 : (pn >= 26 && pn < 30) ? 1 : (pn >= 30) ? 2 : 0;
#pragma unroll
        for (int ai = 0; ai < 2; ++ai)
#pragma unroll
            for (int m = 0; m < 4; ++m) { bf16_t* rowp = O + (size_t)(row0 + ai * HALF + m * 16) * ldc + col0;
#pragma unroll
                for (int bj = 0; bj < 2; ++bj) { f32x4 v0 = acc[ai][bj][m][0], v1 = acc[ai][bj][m][1];
                    if (act == 1) {
#pragma unroll
                        for (int j = 0; j < 4; ++j) { v0[j] = fast_silu(v0[j]); v1[j] = fast_silu(v1[j]); } }
                    else if (act == 2) {
#pragma unroll
                        for (int j = 0; j < 4; ++j) { v0[j] = fast_sigmoid(v0[j]); v1[j] = fast_sigmoid(v1[j]); } }
                    u32x4 w; w.x = cvt_pk_bf16(v0[0], v0[1]); w.y = cvt_pk_bf16(v0[2], v0[3]); w.z = cvt_pk_bf16(v1[0], v1[1]); w.w = cvt_pk_bf16(v1[2], v1[3]);
                    *(u32x4*)(rowp + bj * HALF) = w; } }
    }
};
template <class Epi, class Sched, bool ALIGN_EPI = false, bool SP2 = false>
__device__ __forceinline__ void gemm_phase(PG8_LAS unsigned char* lds, const Gemm g, const Sched& S, const Epi& E) {
    int tid = threadIdx.x; asm volatile("" : "+v"(tid));
    const int wid = __builtin_amdgcn_readfirstlane(tid >> 6), lane = tid & 63, wr = wid >> 2, wc = wid & 3, fr = lane & 15, fq = lane >> 4;
    const int K = g.K, nt = K / BK;
    unsigned voffA[2], voffB[2];
#pragma unroll
    for (int i = 0; i < 2; ++i) { int R, C; stage_rc(tid * 16 + i * 8192, R, C); const int Rb = Epi::PERM ? ((R & ~31) + perm32(R & 31)) : R;
        voffA[i] = (unsigned)(R * K + C) * 2u; voffB[i] = (unsigned)(Rb * K + C) * 2u; }
    const size_t kstep = (size_t)(BK * 2);
    const size_t hstep = (size_t)HALF * K * 2;
    const size_t tstep = 2 * hstep;
    const unsigned ldsw = (unsigned)wid * 1024u;
    const int aoff = lds_byte(wr * 64 + fr, fq * 8), boff = lds_byte(wc * 32 + fr, fq * 8);
#define PG8_SA(b, h) (((b) * 2 + (h)) * HTB)
#define PG8_SB(b, h) ((4 + (b) * 2 + (h)) * HTB)
#define PG8_STAGE(bufoff, gbase, voff) do { _Pragma("unroll") for (int _i = 0; _i < 2; ++_i) \
        __builtin_amdgcn_global_load_lds((const unsigned*)((const char*)(gbase) + (voff)[_i]), (PG8_LAS unsigned*)(lds + (bufoff) + ldsw + _i * 8192), 16, 0, 0); } while (0)
#define PG8_LDA(dst, b, h) do { _Pragma("unroll") for (int m = 0; m < 4; ++m) _Pragma("unroll") for (int k = 0; k < 2; ++k) dst[m][k] = *(const PG8_LAS bf16x8*)(lds + PG8_SA(b, h) + aoff + m * 2048 + k * 1024); } while (0)
#define PG8_LDB(dst, b, h) do { _Pragma("unroll") for (int n = 0; n < 2; ++n) _Pragma("unroll") for (int k = 0; k < 2; ++k) dst[n][k] = *(const PG8_LAS bf16x8*)(lds + PG8_SB(b, h) + boff + n * 2048 + k * 1024); } while (0)
#define PG8_MMA(ai, bj, At, Bt) do { __builtin_amdgcn_s_setprio(1); _Pragma("unroll") for (int m = 0; m < 4; ++m) _Pragma("unroll") for (int n = 0; n < 2; ++n) _Pragma("unroll") for (int k = 0; k < 2; ++k) \
        acc[ai][bj][m][n] = __builtin_amdgcn_mfma_f32_16x16x32_bf16(Bt[n][k], At[m][k], acc[ai][bj][m][n], 0, 0, 0); __builtin_amdgcn_s_setprio(0); } while (0)
#define PG8_WAIT_V(n) asm volatile("s_waitcnt vmcnt(" #n ")" ::: "memory")
#define PG8_WAIT_L(n) asm volatile("s_waitcnt lgkmcnt(" #n ")" ::: "memory")
#define PG8_BAR __builtin_amdgcn_s_barrier()
#define PG8_SCHED __builtin_amdgcn_sched_barrier(0)
    Unit cur, nxt; int ui = 0;
    if (!S.next(0, cur)) return;
    f32x4 acc[2][2][4][2];
#pragma unroll
    for (int a = 0; a < 2; ++a)
#pragma unroll
        for (int b = 0; b < 2; ++b)
#pragma unroll
            for (int m = 0; m < 4; ++m)
#pragma unroll
                for (int n = 0; n < 2; ++n) acc[a][b][m][n] = (f32x4){0.f, 0.f, 0.f, 0.f};
    bf16x8 At[4][2], B0[2][2], B1[2][2];
    const char* cA = (const char*)g.A + (size_t)cur.pm * tstep; const char* cB = (const char*)g.Bt + (size_t)cur.pn * tstep;
    S.a_ready(cur);
    if constexpr (SP2) {
        PG8_STAGE(PG8_SB(0, 0), cB, voffB); PG8_STAGE(PG8_SB(0, 1), cB + hstep, voffB); PG8_STAGE(PG8_SA(0, 0), cA, voffA); PG8_STAGE(PG8_SA(0, 1), cA + hstep, voffA);
        if (wr == 1) PG8_BAR;
        PG8_WAIT_V(2); PG8_BAR;
        PG8_STAGE(PG8_SB(1, 0), cB + kstep, voffB); PG8_STAGE(PG8_SA(1, 0), cA + kstep, voffA); PG8_STAGE(PG8_SB(1, 1), cB + hstep + kstep, voffB);
        PG8_WAIT_V(6); PG8_BAR;
    } else {
        PG8_STAGE(PG8_SB(0, 0), cB, voffB); PG8_STAGE(PG8_SA(0, 0), cA, voffA); PG8_STAGE(PG8_SB(0, 1), cB + hstep, voffB); PG8_STAGE(PG8_SA(0, 1), cA + hstep, voffA);
        if (wr == 1) PG8_BAR;
        PG8_WAIT_V(4); PG8_BAR;
        PG8_STAGE(PG8_SB(1, 0), cB + kstep, voffB); PG8_STAGE(PG8_SA(1, 0), cA + kstep, voffA); PG8_STAGE(PG8_SB(1, 1), cB + hstep + kstep, voffB);
        PG8_WAIT_V(6); PG8_BAR;
    }
    for (;;) {
        const bool has_next = S.next(ui + 1, nxt);
        const char* nA = has_next ? (const char*)g.A + (size_t)nxt.pm * tstep : cA; const char* nB = has_next ? (const char*)g.Bt + (size_t)nxt.pn * tstep : cB;
        for (int t = 0; t < nt; t += 2) {
            const bool last = (t == nt - 2);
            const char* a1 = cA + (size_t)(t + 1) * kstep;
            const char* a2 = last ? nA : cA + (size_t)(t + 2) * kstep; const char* b2 = last ? nB : cB + (size_t)(t + 2) * kstep;
            const char* a3 = a2 + kstep; const char* b3 = b2 + kstep;
            if (last && has_next) S.a_ready(nxt);
            if constexpr (SP2) {
            PG8_LDB(B0, 0, 0); PG8_LDB(B1, 0, 1); PG8_SCHED; PG8_LDA(At, 0, 0); PG8_STAGE(PG8_SA(1, 1), a1 + hstep, voffA);
            PG8_WAIT_V(8); PG8_WAIT_L(0); PG8_BAR; PG8_MMA(0, 0, At, B0); PG8_MMA(0, 1, At, B1); PG8_BAR; PG8_SCHED;
            PG8_LDA(At, 0, 1); PG8_STAGE(PG8_SB(0, 0), b2, voffB); PG8_STAGE(PG8_SB(0, 1), b2 + hstep, voffB); PG8_STAGE(PG8_SA(0, 0), a2, voffA);
            PG8_WAIT_V(8); PG8_WAIT_L(0); PG8_BAR; PG8_MMA(1, 0, At, B0); PG8_MMA(1, 1, At, B1); PG8_BAR; PG8_SCHED;
            PG8_LDB(B0, 1, 0); PG8_LDB(B1, 1, 1); PG8_SCHED; PG8_LDA(At, 1, 0); PG8_STAGE(PG8_SA(0, 1), a2 + hstep, voffA);
            PG8_WAIT_V(8); PG8_WAIT_L(0); PG8_BAR; PG8_MMA(0, 0, At, B0); PG8_MMA(0, 1, At, B1); PG8_BAR; PG8_SCHED;
            PG8_LDA(At, 1, 1); PG8_STAGE(PG8_SB(1, 0), b3, voffB); PG8_STAGE(PG8_SB(1, 1), b3 + hstep, voffB); PG8_STAGE(PG8_SA(1, 0), a3, voffA);
            PG8_WAIT_V(8); PG8_WAIT_L(0); PG8_BAR; PG8_MMA(1, 0, At, B0); PG8_MMA(1, 1, At, B1); PG8_BAR; PG8_SCHED;
            } else {
            PG8_LDB(B0, 0, 0); PG8_SCHED; PG8_LDA(At, 0, 0); PG8_STAGE(PG8_SA(1, 1), a1 + hstep, voffA);
            PG8_WAIT_L(8); PG8_BAR; PG8_WAIT_L(0); PG8_MMA(0, 0, At, B0); PG8_BAR; PG8_SCHED;
            PG8_LDB(B1, 0, 1); PG8_STAGE(PG8_SB(0, 0), b2, voffB);
            PG8_BAR; PG8_WAIT_L(0); PG8_MMA(0, 1, At, B1); PG8_BAR;
            PG8_LDA(At, 0, 1); PG8_STAGE(PG8_SA(0, 0), a2, voffA);
            PG8_BAR; PG8_WAIT_L(0); PG8_MMA(1, 0, At, B0); PG8_BAR; PG8_SCHED;
            PG8_STAGE(PG8_SB(0, 1), b2 + hstep, voffB);
            PG8_WAIT_V(6); PG8_BAR; PG8_MMA(1, 1, At, B1); PG8_BAR;
            PG8_LDB(B0, 1, 0); PG8_SCHED; PG8_LDA(At, 1, 0); PG8_STAGE(PG8_SA(0, 1), a2 + hstep, voffA);
            PG8_WAIT_L(8); PG8_BAR; PG8_WAIT_L(0); PG8_MMA(0, 0, At, B0); PG8_BAR; PG8_SCHED;
            PG8_LDB(B1, 1, 1); PG8_STAGE(PG8_SB(1, 0), b3, voffB);
            PG8_BAR; PG8_WAIT_L(0); PG8_MMA(0, 1, At, B1); PG8_BAR;
            PG8_LDA(At, 1, 1); PG8_STAGE(PG8_SA(1, 0), a3, voffA);
            PG8_BAR; PG8_WAIT_L(0); PG8_MMA(1, 0, At, B0); PG8_BAR; PG8_SCHED;
            PG8_STAGE(PG8_SB(1, 1), b3 + hstep, voffB);
            PG8_WAIT_V(6); PG8_BAR; PG8_MMA(1, 1, At, B1); PG8_BAR;
            }
        }
        if constexpr (ALIGN_EPI) { if (wr == 0) PG8_BAR; }
        if constexpr (!Epi::AFTER_DRAIN) { E(acc, cur, wr, wc, fr, fq); S.done(cur); }
        if (!has_next) break;
#pragma unroll
        for (int a = 0; a < 2; ++a)
#pragma unroll
            for (int b = 0; b < 2; ++b)
#pragma unroll
                for (int m = 0; m < 4; ++m)
#pragma unroll
                    for (int n = 0; n < 2; ++n) acc[a][b][m][n] = (f32x4){0.f, 0.f, 0.f, 0.f};
        cur = nxt; cA = nA; cB = nB; ++ui;
        if constexpr (ALIGN_EPI) { if (wr == 1) PG8_BAR; }
    }
    PG8_WAIT_V(0);
    if constexpr (!ALIGN_EPI) { if (wr == 0) PG8_BAR; }
    PG8_BAR;
    if constexpr (Epi::AFTER_DRAIN) { E.fused(acc, cur, wr, wc, fr, fq, lds, wid, lane); S.done(cur); }
#undef PG8_SA
#undef PG8_SB
#undef PG8_STAGE
#undef PG8_LDA
#undef PG8_LDB
#undef PG8_MMA
#undef PG8_WAIT_V
#undef PG8_WAIT_L
#undef PG8_BAR
#undef PG8_SCHED
}
}

#define LAS __attribute__((address_space(3)))
typedef pg8::bf16_t bf16_t;
typedef pg8::bf16x8 bf16x8;
typedef pg8::f32x4 f32x4;
typedef pg8::u32x4 u32x4;
typedef unsigned u32x2 __attribute__((ext_vector_type(2)));
typedef float f32x2v __attribute__((ext_vector_type(2)));
using pg8::cvt_pk_bf16;
using pg8::fast_sigmoid;
using pg8::fast_silu;

constexpr int D = 1024, NB = 4, SEQ = 8192, NTOK = NB * SEQ;
#ifndef MK_NSPLIT
#define MK_NSPLIT 4
#endif
constexpr int NSPLIT = MK_NSPLIT, TS = SEQ / NSPLIT, MS = NB * TS;
constexpr int CL = 9728;
constexpr int C_R = 0, C_K = 1024, C_V = 2048, C_WLO = 3072, C_ALO = 3136, C_GLO = 3200, C_HQ = 3584, C_HF = 4608, C_HI = 5632, C_HG = 6656, C_GA = 7680, C_GB = 8704;
constexpr int CARRY_LD = 3584;
constexpr int DFF = 2816;
constexpr size_t MiB = 1u << 20, KiB = 1u << 10;
constexpr size_t WS_WIN = 0, WS_WOUT = 19 * MiB, WS_WQ = 21 * MiB, WS_WO = 23 * MiB, WS_WKV = 25 * MiB, WS_W13 = 29 * MiB, WS_W2 = 40 * MiB;
constexpr size_t WS_RW2T = 46 * MiB, WS_RA2T = 46 * MiB + 128 * KiB, WS_RG2T = 46 * MiB + 256 * KiB, WS_CARRY = 46 * MiB + 640 * KiB, WS_LB = 46 * MiB + 704 * KiB;
constexpr size_t WS_MBF = 47 * MiB, WS_KV = 49 * MiB, WS_VT = 53 * MiB, WS_RWST = 55 * MiB, WS_HGST = 56 * MiB, WS_BONUS = 58 * MiB;
constexpr size_t WS_G2TP = 59 * MiB;
constexpr size_t WS_MERGED = 64 * MiB;
constexpr size_t WS_U1 = 128 * MiB, WS_COLS = 144 * MiB, WS_PR = 296 * MiB, WS_PK = 312 * MiB, WS_PA = 328 * MiB, WS_PB = 344 * MiB, WS_PV = 360 * MiB, WS_PW = 376 * MiB, WS_ORAW = 408 * MiB, WS_HGO = 440 * MiB;
constexpr size_t WS_GATE = 472 * MiB, WS_ASG = 488 * MiB;
constexpr size_t WS_U = 128 * MiB, WS_Q = 192 * MiB, WS_AO = 256 * MiB, WS_FF = 320 * MiB, WS_CTL = 496 * MiB, CTL_BYTES = 64 * KiB, WS_END = 496 * MiB + 64 * KiB;
constexpr int LDS_BYTES = 147456, MISC_OFF = 131072 + 320;
constexpr int T0 = 1 + 5 * NSPLIT, N_PHASES = T0 + 9;

__device__ __forceinline__ float bflo(unsigned u) { return __uint_as_float(u << 16); }
__device__ __forceinline__ float bfhi(unsigned u) { return __uint_as_float(u & 0xffff0000u); }
__device__ __forceinline__ unsigned f2bf(float f) { unsigned u = __float_as_uint(f); return (u + 0x7fffu + ((u >> 16) & 1u)) >> 16; }
__device__ __forceinline__ f32x4 ld4bf(const bf16_t* p) { const u32x2 u = *(const u32x2*)p; return (f32x4){bflo(u.x), bfhi(u.x), bflo(u.y), bfhi(u.y)}; }
__device__ __forceinline__ void ld8bf(const bf16_t* p, float (&o)[8]) { const u32x4 u = *(const u32x4*)p; o[0] = bflo(u.x); o[1] = bfhi(u.x); o[2] = bflo(u.y); o[3] = bfhi(u.y); o[4] = bflo(u.z); o[5] = bfhi(u.z); o[6] = bflo(u.w); o[7] = bfhi(u.w); }
__device__ __forceinline__ void st4bf(bf16_t* p, f32x4 v) { u32x2 w; w.x = cvt_pk_bf16(v[0], v[1]); w.y = cvt_pk_bf16(v[2], v[3]); *(u32x2*)p = w; }
__device__ __forceinline__ bf16x8 pack8(const float (&t)[8]) { u32x4 w; w.x = cvt_pk_bf16(t[0], t[1]); w.y = cvt_pk_bf16(t[2], t[3]); w.z = cvt_pk_bf16(t[4], t[5]); w.w = cvt_pk_bf16(t[6], t[7]); return __builtin_bit_cast(bf16x8, w); }
__device__ __forceinline__ float tanh_fast(float x) { return 1.0f - 2.0f * __builtin_amdgcn_rcpf(1.0f + __expf(2.0f * x)); }
__device__ __forceinline__ float wave_sum(float v) {
#pragma unroll
    for (int o = 1; o < 64; o <<= 1) v += __shfl_xor(v, o);
    return v;
}
__device__ __forceinline__ float fq_sum(float v) { v += __shfl_xor(v, 16); v += __shfl_xor(v, 32); return v; }
template <int CTRL> __device__ __forceinline__ float dpp_add(float x) { return x + __builtin_bit_cast(float, __builtin_amdgcn_update_dpp(0, __builtin_bit_cast(int, x), CTRL, 0xf, 0xf, false)); }
#ifdef MK_SHFL_REDUCE
__device__ __forceinline__ float allreduce16(float x) { x += __shfl_xor(x, 1); x += __shfl_xor(x, 2); x += __shfl_xor(x, 4); x += __shfl_xor(x, 8); return x; }
#else
__device__ __forceinline__ float allreduce16(float x) { x = dpp_add<0xB1>(x); x = dpp_add<0x4E>(x); x = dpp_add<0x141>(x); x = dpp_add<0x140>(x); return x; }
#endif
__device__ __forceinline__ void allreduce16x2(float& x, float& y) {
    x = dpp_add<0xB1>(x); y = dpp_add<0xB1>(y); x = dpp_add<0x4E>(x); y = dpp_add<0x4E>(y); x = dpp_add<0x141>(x); y = dpp_add<0x141>(y); x = dpp_add<0x140>(x); y = dpp_add<0x140>(y); }
#define MFMA16(a, b, c) __builtin_amdgcn_mfma_f32_16x16x32_bf16((a), (b), (c), 0, 0, 0)

#define XB_TMO      128
#define XB_XCNT(j)  (256  + 64 * (j))
#define XB_XSUB(j)  (1280 + 64 * (j))
#define XB_XGEN(j)  (2304 + 64 * (j))
#define XB_TOP      3328
#define XB_TOPGEN   3392
#define XCD_BAR_WORDS 3456
#define XB_SPIN_CAP (1u << 18)

__device__ __forceinline__ unsigned xb_ld(unsigned* p)              { return __hip_atomic_load(p, __ATOMIC_RELAXED, __HIP_MEMORY_SCOPE_AGENT); }
__device__ __forceinline__ unsigned xb_add(unsigned* p, unsigned v) { return __hip_atomic_fetch_add(p, v, __ATOMIC_RELAXED, __HIP_MEMORY_SCOPE_AGENT); }
__device__ __forceinline__ unsigned xb_xcc_id() { return (unsigned)__builtin_amdgcn_s_getreg((3 << 11) | 20) & 0xFu; }
#define XB_SPIN(cond, bar) do { unsigned _sp = 0; while (cond) { __builtin_amdgcn_s_sleep(1); \
    if ((++_sp & 255u) == 0u) { if (xb_ld(&(bar)[XB_TMO])) break; if (_sp > XB_SPIN_CAP) { atomicAdd(&(bar)[XB_TMO], 1u); break; } } } } while (0)

struct XcdBarrier {
    unsigned* bar; unsigned x;
    volatile LAS unsigned* st;
};

__device__ __forceinline__ XcdBarrier xcd_barrier_post(unsigned* bar, volatile LAS unsigned* st) {
    XcdBarrier b; b.bar = bar; b.x = xb_xcc_id(); b.st = st;
    if (threadIdx.x == 0) (void)xb_add(&bar[XB_XCNT(b.x)], 1u);
    return b;
}
__device__ __forceinline__ void xcd_barrier_complete(unsigned* bar, unsigned x, unsigned& nloc, unsigned& nx) {
    const unsigned G = gridDim.x * gridDim.y * gridDim.z;
    unsigned sum, cnt, mine, sp = 0u;
    for (;;) {
        sum = 0u; cnt = 0u; mine = 0u;
#pragma unroll
        for (unsigned j = 0; j < 16; ++j) { const unsigned c = xb_ld(&bar[XB_XCNT(j)]); sum += c; cnt += (c > 0u) ? 1u : 0u; mine = (j == x) ? c : mine; }
        if (sum == G) break;
        __builtin_amdgcn_s_sleep(1);
        if ((++sp & 255u) == 0u) { if (xb_ld(&bar[XB_TMO])) break; if (sp > XB_SPIN_CAP) { atomicAdd(&bar[XB_TMO], 1u); break; } }
    }
    nloc = mine > 0u ? mine : 1u; nx = cnt > 0u ? cnt : 1u;
}

__device__ __forceinline__ void xcd_barrier(const XcdBarrier& b) {
    asm volatile("s_waitcnt vmcnt(0)" ::: "memory");
    __syncthreads();
    if (threadIdx.x == 0) {
        unsigned* bar = b.bar;
        __builtin_amdgcn_s_waitcnt(0);
        unsigned nloc = b.st[0], nx = b.st[1];
        if (nloc == 0u) { xcd_barrier_complete(bar, b.x, nloc, nx); b.st[0] = nloc; b.st[1] = nx; }
        const unsigned old = xb_add(&bar[XB_XSUB(b.x)], 1u);
        const unsigned gen = old / nloc;
        if (old + 1u == (gen + 1u) * nloc) {
            __builtin_amdgcn_fence(__ATOMIC_RELEASE, "agent");
            asm volatile("s_waitcnt vmcnt(0)" ::: "memory");
            const unsigned og = xb_add(&bar[XB_TOP], 1u);
            const unsigned tg = og / nx;
            if (og + 1u == (tg + 1u) * nx) xb_add(&bar[XB_TOPGEN], 1u);
            else XB_SPIN(xb_ld(&bar[XB_TOPGEN]) == tg, bar);
            __builtin_amdgcn_fence(__ATOMIC_ACQUIRE, "agent");
            xb_add(&bar[XB_XGEN(b.x)], 1u);
            asm volatile("s_waitcnt vmcnt(0)" ::: "memory");
        } else {
            XB_SPIN(xb_ld(&bar[XB_XGEN(b.x)]) == gen, bar);
            __builtin_amdgcn_fence(__ATOMIC_ACQUIRE, "agent");
            asm volatile("s_waitcnt vmcnt(0)" ::: "memory");
        }
    }
    __syncthreads();
}

__device__ __forceinline__ void rms_row_bf16(const float* src, const float* g, bf16_t* dst, int lane) {
    f32x4 v[4]; float s = 0.f;
#pragma unroll
    for (int j = 0; j < 4; ++j) { v[j] = ((const f32x4*)src)[lane + 64 * j]; s += (v[j][0] * v[j][0] + v[j][1] * v[j][1]) + (v[j][2] * v[j][2] + v[j][3] * v[j][3]); }
    const float rs = 1.0f / sqrtf(wave_sum(s) * (1.0f / 1024.0f) + 1e-6f);
#pragma unroll
    for (int j = 0; j < 4; ++j) { const f32x4 gv = ((const f32x4*)g)[lane + 64 * j]; st4bf(dst + 4 * (lane + 64 * j), v[j] * rs * gv); }
}
__device__ __forceinline__ void tr_item(const float* W, int K, int N, bf16_t* WT, int kb, int n0, int row_base, LAS float* scr, int lane) {
    const int k0 = 64 * kb;
#pragma unroll 8
    for (int i = 0; i < 32; ++i) { const int kk = 2 * i + (lane >> 5); scr[kk * 33 + (lane & 31)] = W[(size_t)(k0 + kk) * N + n0 + (lane & 31)]; }
    asm volatile("s_waitcnt lgkmcnt(0)" ::: "memory");
    const int c = lane & 7;
#pragma unroll
    for (int j = 0; j < 4; ++j) { const int n = (lane >> 3) + 8 * j; const LAS float* sp = scr + (8 * c) * 33 + n;
        u32x4 o; o.x = cvt_pk_bf16(sp[0 * 33], sp[1 * 33]); o.y = cvt_pk_bf16(sp[2 * 33], sp[3 * 33]); o.z = cvt_pk_bf16(sp[4 * 33], sp[5 * 33]); o.w = cvt_pk_bf16(sp[6 * 33], sp[7 * 33]);
        *(u32x4*)(WT + (size_t)(row_base + n) * K + k0 + 8 * c) = o; }
    asm volatile("s_waitcnt lgkmcnt(0)" ::: "memory");
}

__device__ __forceinline__ void prep_phase(int s, int gw, int NGW, int lane, const bf16_t* cols, const bf16_t* carry,
        const float* mu, const float* w0, const float* a0, const float* k_k, const float* k_a, const float* r_k,
        const bf16_t* w2T, const bf16_t* a2T, bf16_t* PR, bf16_t* PK, bf16_t* PA, bf16_t* PB, bf16_t* PV, float* PW, float* bonus, bf16_t* ASG) {
    const int fr = lane & 15, fq = lane >> 4;
    for (int item = gw; item < (MS / 16) * 4; item += NGW) {
        const int tile = item >> 2, hg4 = item & 3;
        const int lt = tile * 16 + fr, b = lt / TS, tl = lt % TS;
        const bf16_t* crow = cols + (size_t)lt * CL;
        const bf16_t* prow = tl > 0 ? crow - CL : carry + ((s & 1) * 4 + b) * CARRY_LD;
        bf16x8 Aw[2], Aa[2];
#pragma unroll
        for (int ks = 0; ks < 2; ++ks) {
            { const int c = C_WLO + ks * 32 + fq * 8; float cur[8], prv[8], t[8]; ld8bf(crow + c, cur); ld8bf(prow + c, prv);
              const f32x4 m0 = *(const f32x4*)(mu + c), m1 = *(const f32x4*)(mu + c + 4);
#pragma unroll
              for (int e = 0; e < 8; ++e) { const float mm = e < 4 ? m0[e & 3] : m1[e & 3]; t[e] = tanh_fast(cur[e] + mm * (prv[e] - cur[e])); }
              Aw[ks] = pack8(t); }
            { const int c = C_ALO + ks * 32 + fq * 8; float cur[8], prv[8], t[8]; ld8bf(crow + c, cur); ld8bf(prow + c, prv);
              const f32x4 m0 = *(const f32x4*)(mu + c), m1 = *(const f32x4*)(mu + c + 4);
#pragma unroll
              for (int e = 0; e < 8; ++e) { const float mm = e < 4 ? m0[e & 3] : m1[e & 3]; t[e] = cur[e] + mm * (prv[e] - cur[e]); }
              Aa[ks] = pack8(t); }
        }
        if (hg4 == 0) {
#pragma unroll
            for (int ks = 0; ks < 5; ++ks) { const int c = C_GLO + ks * 32 + fq * 8; float cur[8], prv[8], t[8]; ld8bf(crow + c, cur); ld8bf(prow + c, prv);
                const f32x4 m0 = *(const f32x4*)(mu + c), m1 = *(const f32x4*)(mu + c + 4);
#pragma unroll
                for (int e = 0; e < 8; ++e) { const float mm = e < 4 ? m0[e & 3] : m1[e & 3]; t[e] = fast_sigmoid(cur[e] + mm * (prv[e] - cur[e])); }
                *(bf16x8*)(ASG + (size_t)lt * 256 + ks * 32 + fq * 8) = pack8(t); }
#pragma unroll
            for (int ks = 5; ks < 8; ++ks) *(u32x4*)(ASG + (size_t)lt * 256 + ks * 32 + fq * 8) = (u32x4){0u, 0u, 0u, 0u};
        }
#pragma unroll 1
        for (int hh = 0; hh < 4; ++hh) {
            const int h = hg4 * 4 + hh;
            f32x4 aw[4], aa[4];
#pragma unroll
            for (int nt = 0; nt < 4; ++nt) { aw[nt] = (f32x4){0.f, 0.f, 0.f, 0.f}; aa[nt] = (f32x4){0.f, 0.f, 0.f, 0.f};
                const int n = h * 64 + nt * 16 + fr;
#pragma unroll
                for (int ks = 0; ks < 2; ++ks) { const bf16x8 bw = *(const bf16x8*)(w2T + n * 64 + ks * 32 + fq * 8); aw[nt] = MFMA16(bw, Aw[ks], aw[nt]);
                    const bf16x8 ba = *(const bf16x8*)(a2T + n * 64 + ks * 32 + fq * 8); aa[nt] = MFMA16(ba, Aa[ks], aa[nt]); } }
            f32x4 kkv[4], av[4]; float ssq = 0.f, bon = 0.f;
#pragma unroll
            for (int nt = 0; nt < 4; ++nt) {
                const int c = h * 64 + nt * 16 + 4 * fq; const size_t o = (size_t)lt * 1024 + c;
                const f32x4 rc = ld4bf(crow + C_R + c), rp = ld4bf(prow + C_R + c), kc = ld4bf(crow + C_K + c), kp = ld4bf(prow + C_K + c), vc = ld4bf(crow + C_V + c), vp = ld4bf(prow + C_V + c);
                const f32x4 r = rc + *(const f32x4*)(mu + C_R + c) * (rp - rc), k = kc + *(const f32x4*)(mu + C_K + c) * (kp - kc), v = vc + *(const f32x4*)(mu + C_V + c) * (vp - vc);
                const f32x4 w0v = *(const f32x4*)(w0 + c), a0v = *(const f32x4*)(a0 + c), kkp = *(const f32x4*)(k_k + c), kap = *(const f32x4*)(k_a + c), rkp = *(const f32x4*)(r_k + c);
                f32x4 wv, a, kk, kmod;
#pragma unroll
                for (int j = 0; j < 4; ++j) {
                    const float z = -(w0v[j] + aw[nt][j]);
                    const float sp = fmaxf(z, 0.f) + __logf(1.0f + __expf(-fabsf(z)));
                    wv[j] = __expf(-__expf(-sp - 0.5f));
                    a[j] = fast_sigmoid(a0v[j] + aa[nt][j]);
                    kk[j] = k[j] * kkp[j]; kmod[j] = k[j] * (1.0f + (a[j] - 1.0f) * kap[j]);
                    ssq += kk[j] * kk[j]; bon += r[j] * kmod[j] * rkp[j];
                }
                kkv[nt] = kk; av[nt] = a;
                st4bf(PR + o, r); st4bf(PK + o, kmod); st4bf(PV + o, v); *(f32x4*)(PW + o) = wv;
            }
            ssq = fq_sum(ssq); bon = fq_sum(bon);
            const float rs = 1.0f / sqrtf(fmaxf(ssq, 1e-24f));
#pragma unroll
            for (int nt = 0; nt < 4; ++nt) { const int c = h * 64 + nt * 16 + 4 * fq; const size_t o = (size_t)lt * 1024 + c;
                const f32x4 kn = kkv[nt] * rs; st4bf(PA + o, -kn); st4bf(PB + o, kn * av[nt]); }
            if (fq == 0) bonus[lt * 16 + h] = bon;
        }
    }
}

__device__ __forceinline__ void post_phase(int s, int gw, int NGW, int lane, const bf16_t* cols, const bf16_t* carry, const float* mu, const bf16_t* gate,
        const float* ln_w, const float* ln_b, const float* hg_g, const float* oraw, const float* hgo, const bf16_t* PV, const float* bonus, bf16_t* merged) {
    const int fr = lane & 15, fq = lane >> 4;
    for (int item = gw; item < (MS / 16) * 4; item += NGW) {
        const int tile = item >> 2, q4 = item & 3;
        const int lt = tile * 16 + fr, b = lt / TS, tl = lt % TS;
        const size_t gt = (size_t)b * SEQ + s * TS + tl;
        const bf16_t* crow = cols + (size_t)lt * CL;
        const bf16_t* prow = tl > 0 ? crow - CL : carry + ((s & 1) * 4 + b) * CARRY_LD;
#pragma unroll 1
        for (int hgh = 0; hgh < 2; ++hgh) {
            const int h8 = q4 * 2 + hgh;
            f32x4 ho[8]; float ss = 0.f;
#pragma unroll
            for (int n8 = 0; n8 < 8; ++n8) { ho[n8] = *(const f32x4*)(hgo + ((size_t)((b * 8 + h8) * 8 + n8) * TS + tl) * 16 + 4 * fq); ss += (ho[n8][0] * ho[n8][0] + ho[n8][1] * ho[n8][1]) + (ho[n8][2] * ho[n8][2] + ho[n8][3] * ho[n8][3]); }
            ss = fq_sum(ss);
            const float rsh = 1.0f / sqrtf(ss * (1.0f / 128.0f) + 1e-6f);
#pragma unroll
            for (int rwh = 0; rwh < 2; ++rwh) {
                const int h = q4 * 4 + hgh * 2 + rwh;
                f32x4 ag[4], o[4]; float sm = 0.f;
#pragma unroll
                for (int nt = 0; nt < 4; ++nt) { ag[nt] = ld4bf(gate + (size_t)lt * 1024 + h * 64 + nt * 16 + 4 * fq);
                    o[nt] = *(const f32x4*)(oraw + ((size_t)((b * 16 + h) * 4 + nt) * TS + tl) * 16 + 4 * fq); sm += (o[nt][0] + o[nt][1]) + (o[nt][2] + o[nt][3]); }
                const float mean = fq_sum(sm) * (1.0f / 64.0f); float vq = 0.f;
#pragma unroll
                for (int nt = 0; nt < 4; ++nt) { o[nt] = o[nt] - mean; vq += (o[nt][0] * o[nt][0] + o[nt][1] * o[nt][1]) + (o[nt][2] * o[nt][2] + o[nt][3] * o[nt][3]); }
                const float rstd = 1.0f / sqrtf(fq_sum(vq) * (1.0f / 64.0f) + 64e-5f);
#ifdef MK_NO_BONUS
                const float bon = 0.f;
#else
                const float bon = bonus[lt * 16 + h];
#endif
#pragma unroll
                for (int nt = 0; nt < 4; ++nt) {
                    const int c = h * 64 + nt * 16 + 4 * fq;
                    const f32x4 lw = *(const f32x4*)(ln_w + c), lb = *(const f32x4*)(ln_b + c), v = ld4bf(PV + (size_t)lt * 1024 + c);
                    const f32x4 ya = (o[nt] * rstd * lw + lb + v * bon) * ag[nt];
                    const f32x4 ng = *(const f32x4*)(hg_g + (c & 127)), gh = ld4bf(crow + C_HG + c), gar = ld4bf(crow + C_GA + c), gbr = ld4bf(crow + C_GB + c);
                    const f32x4 hv = ho[rwh * 4 + nt] * rsh * ng;
                    f32x4 m;
#pragma unroll
                    for (int j = 0; j < 4; ++j) {
#if defined(MK_ZERO_YA)
                        m[j] = fast_sigmoid(gbr[j]) * (hv[j] * fast_silu(gh[j]));
#elif defined(MK_ZERO_YB)
                        m[j] = fast_sigmoid(gar[j]) * ya[j];
#else
                        m[j] = gar[j] * ya[j] + gbr[j] * (hv[j] * gh[j]);
#endif
                    }
                    st4bf(merged + gt * 1024 + c, m);
                }
            }
        }
    }
}

constexpr int RWB = 45056;
#define SCAN_BAR_L() do { asm volatile("s_waitcnt vmcnt(0) lgkmcnt(0)" ::: "memory"); __builtin_amdgcn_s_barrier(); asm volatile("" ::: "memory"); } while (0)
#define SCAN_BAR_S() do { asm volatile("s_waitcnt lgkmcnt(0)" ::: "memory"); __builtin_amdgcn_s_barrier(); asm volatile("" ::: "memory"); } while (0)
__device__ __forceinline__ void rw_load(LAS unsigned char* bp, int lt2, size_t ltok0, int h, int rg, const bf16_t* PA, const float* PW, const bf16_t* PB, const bf16_t* PK, const bf16_t* PR, const bf16_t* PV) {
    const int tok = lt2 >> 3, c8 = (lt2 & 7) * 8; const size_t base = (ltok0 + tok) * 1024 + h * 64 + c8;
    const u32x4 ra = *(const u32x4*)(PA + base), rb = *(const u32x4*)(PB + base), rk = *(const u32x4*)(PK + base), rr = *(const u32x4*)(PR + base);
    const f32x4 w0 = *(const f32x4*)(PW + base), w1 = *(const f32x4*)(PW + base + 4);
    const unsigned rv = *(const unsigned*)(PV + (ltok0 + tok) * 1024 + h * 64 + rg * 16 + (lt2 & 7) * 2);
    const int off = (tok * 64 + c8) * 4;
#define RW_PUT(arr, u) do { *(LAS f32x4*)(bp + (arr) * 8192 + off) = (f32x4){bflo(u.x), bfhi(u.x), bflo(u.y), bfhi(u.y)}; *(LAS f32x4*)(bp + (arr) * 8192 + off + 16) = (f32x4){bflo(u.z), bfhi(u.z), bflo(u.w), bfhi(u.w)}; } while (0)
    RW_PUT(0, ra); RW_PUT(2, rb); RW_PUT(3, rk); RW_PUT(4, rr);
#undef RW_PUT
    *(LAS f32x4*)(bp + 8192 + off) = w0; *(LAS f32x4*)(bp + 8192 + off + 16) = w1;
    *(LAS f32x2v*)(bp + 40960 + (tok * 16 + (lt2 & 7) * 2) * 4) = (f32x2v){bflo(rv), bfhi(rv)};
}
__device__ __forceinline__ void y_drain(const LAS unsigned char* ybase, int lt2, float* dst) { *(f32x2v*)(dst + lt2 * 2) = *(const LAS f32x2v*)(ybase + lt2 * 8); }
__device__ __forceinline__ void rwkv_scan(int s, int bid, int G, int tid, int lane, int wave, LAS unsigned char* lds,
        const bf16_t* PA, const float* PW, const bf16_t* PB, const bf16_t* PK, const bf16_t* PR, const bf16_t* PV, float* oraw, float* state, bool save) {
    constexpr int NBLK = TS / 32;
    const int rowl = lane >> 4, j = lane & 15, row = (wave & 3) * 4 + rowl;
    for (int it = bid; it < 256; it += G) {
        const int b = it >> 6, h = (it >> 2) & 15, rg = it & 3;
        const size_t tok0 = (size_t)b * TS;
        float* stp = state + ((size_t)((b * 16 + h) * 64 + rg * 16 + row) * 64 + 4 * j);
        float* obase = oraw + (size_t)it * TS * 16;
        f32x4 st = (f32x4){0.f, 0.f, 0.f, 0.f};
        if (wave < 4 && s > 0) st = *(const f32x4*)stp;
        if (wave >= 4) { rw_load(lds, tid - 256, tok0, h, rg, PA, PW, PB, PK, PR, PV); SCAN_BAR_L(); } else { __builtin_amdgcn_s_setprio(2); asm volatile("s_waitcnt vmcnt(0)" ::: "memory"); SCAN_BAR_S(); }
#pragma unroll 1
        for (int blk = 0; blk < NBLK; ++blk) {
            if (wave >= 4) {
                if (blk > 0) y_drain(lds + ((blk - 1) & 1) * RWB + 43008, tid - 256, obase + (size_t)(blk - 1) * 512);
                if (blk + 1 < NBLK) rw_load(lds + ((blk + 1) & 1) * RWB, tid - 256, tok0 + (blk + 1) * 32, h, rg, PA, PW, PB, PK, PR, PV);
                SCAN_BAR_L();
            } else {
                const LAS unsigned char* bp = lds + (blk & 1) * RWB;
                const LAS unsigned char* p4 = bp + 16 * j; const LAS unsigned char* pv = bp + 40960 + row * 4; LAS unsigned char* py = (LAS unsigned char*)bp + 43008 + row * 4;
                f32x4 a4 = *(const LAS f32x4*)(p4), w4 = *(const LAS f32x4*)(p4 + 8192), b4 = *(const LAS f32x4*)(p4 + 16384), k4 = *(const LAS f32x4*)(p4 + 24576), r4 = *(const LAS f32x4*)(p4 + 32768);
                float vv = *(const LAS float*)(pv);
                float sa = (st[0] * a4[0] + st[1] * a4[1]) + (st[2] * a4[2] + st[3] * a4[3]);
                sa = allreduce16(sa);
#pragma unroll
                for (int t = 0; t < 32; ++t) {
                    f32x4 na = a4, nw = w4, nb = b4, nk = k4, nr = r4; float nv = vv;
                    if (t < 31) { const int o = (t + 1) * 256; na = *(const LAS f32x4*)(p4 + o); nw = *(const LAS f32x4*)(p4 + 8192 + o); nb = *(const LAS f32x4*)(p4 + 16384 + o); nk = *(const LAS f32x4*)(p4 + 24576 + o); nr = *(const LAS f32x4*)(p4 + 32768 + o); nv = *(const LAS float*)(pv + (t + 1) * 64); }
                    st = st * w4 + (b4 * sa + k4 * vv);
                    float y = (st[0] * r4[0] + st[1] * r4[1]) + (st[2] * r4[2] + st[3] * r4[3]);
                    float sn = (st[0] * na[0] + st[1] * na[1]) + (st[2] * na[2] + st[3] * na[3]);
                    allreduce16x2(sn, y);
                    if (j == 0) *(LAS float*)(py + t * 64) = y;
                    sa = sn; a4 = na; w4 = nw; b4 = nb; k4 = nk; r4 = nr; vv = nv;
                }
                SCAN_BAR_S();
            }
        }
        if (wave >= 4) { y_drain(lds + ((NBLK - 1) & 1) * RWB + 43008, tid - 256, obase + (size_t)(NBLK - 1) * 512); }
        else { __builtin_amdgcn_s_setprio(0); if (save) *(f32x4*)stp = st; }
    }
}

__device__ __forceinline__ void rwkv_scan_naive(int s, int gw, int NGW, int lane, int wave, LAS unsigned char* lds,
        const bf16_t* PA, const float* PW, const bf16_t* PB, const bf16_t* PK, const bf16_t* PR, const bf16_t* PV, float* oraw, float* state) {
    LAS float* slab = (LAS float*)(lds + wave * 2048);
    for (int it = gw; it < 64; it += NGW) {
        const int b = it >> 4, h = it & 15;
        float st[64];
        float* stp = state + (size_t)((b * 16 + h) * 64 + lane) * 64;
#pragma unroll
        for (int k = 0; k < 64; ++k) st[k] = (s > 0) ? stp[k] : 0.f;
        for (int tl = 0; tl < TS; ++tl) {
            const size_t base = ((size_t)b * TS + tl) * 1024 + h * 64 + lane;
            slab[lane] = bflo((unsigned)PA[base]); slab[64 + lane] = PW[base]; slab[128 + lane] = bflo((unsigned)PB[base]); slab[192 + lane] = bflo((unsigned)PK[base]); slab[256 + lane] = bflo((unsigned)PR[base]);
            const float vv = bflo((unsigned)PV[base]);
            asm volatile("s_waitcnt lgkmcnt(0)" ::: "memory");
            float sa = 0.f;
#pragma unroll
            for (int k = 0; k < 64; ++k) sa += st[k] * slab[k];
            float y = 0.f;
#pragma unroll
            for (int k = 0; k < 64; ++k) { st[k] = st[k] * slab[64 + k] + (sa * slab[128 + k] + vv * slab[192 + k]); y += st[k] * slab[256 + k]; }
            asm volatile("s_waitcnt lgkmcnt(0)" ::: "memory");
            oraw[((size_t)(it * 4 + (lane >> 4)) * TS + tl) * 16 + (lane & 15)] = y;
        }
#pragma unroll
        for (int k = 0; k < 64; ++k) stp[k] = st[k];
    }
}
constexpr int HGB = 53248;
__device__ __forceinline__ void hg_load(LAS unsigned char* bp, int lt2, size_t ltok0, int h8, int rg, const bf16_t* cols, const float* lbv) {
    const int tok = lt2 >> 3, c16 = (lt2 & 7) * 16; const bf16_t* crow = cols + (ltok0 + tok) * CL;
    float q[16], f[16];
    { float t[8]; ld8bf(crow + C_HQ + h8 * 128 + c16, t);
#pragma unroll
      for (int e = 0; e < 8; ++e) q[e] = t[e];
      ld8bf(crow + C_HQ + h8 * 128 + c16 + 8, t);
#pragma unroll
      for (int e = 0; e < 8; ++e) q[8 + e] = t[e];
      ld8bf(crow + C_HF + h8 * 128 + c16, t);
#pragma unroll
      for (int e = 0; e < 8; ++e) f[e] = t[e];
      ld8bf(crow + C_HF + h8 * 128 + c16 + 8, t);
#pragma unroll
      for (int e = 0; e < 8; ++e) f[8 + e] = t[e]; }
    const unsigned rv = *(const unsigned*)(crow + C_HI + h8 * 128 + rg * 16 + (lt2 & 7) * 2);
    const int off = (tok * 128 + c16) * 4;
#pragma unroll
    for (int g = 0; g < 4; ++g) { const f32x4 lb = *(const f32x4*)(lbv + h8 * 128 + c16 + 4 * g); f32x4 fv, kv, qv;
#pragma unroll
        for (int e = 0; e < 4; ++e) { fv[e] = lb[e] + (1.0f - lb[e]) * fast_sigmoid(f[4 * g + e]); kv[e] = 1.0f - fv[e]; qv[e] = fast_silu(q[4 * g + e]); }
        *(LAS f32x4*)(bp + off + 16 * g) = fv; *(LAS f32x4*)(bp + 16384 + off + 16 * g) = kv; *(LAS f32x4*)(bp + 32768 + off + 16 * g) = qv; }
    *(LAS f32x2v*)(bp + 49152 + (tok * 16 + (lt2 & 7) * 2) * 4) = (f32x2v){bflo(rv), bfhi(rv)};
}
__device__ __forceinline__ void hgrn_scan(int s, int bid, int G, int tid, int lane, int wave, LAS unsigned char* lds, const bf16_t* cols, const float* lbv, float* hgo, float* state, bool save) {
    constexpr int NBLK = TS / 32;
    const int rowl = lane >> 4, j = lane & 15, row = (wave & 3) * 4 + rowl;
    for (int it = bid; it < 256; it += G) {
        const int b = it >> 6, h8 = (it >> 3) & 7, rg = it & 7;
        const size_t tok0 = (size_t)b * TS;
        float* stp = state + ((size_t)((b * 8 + h8) * 128 + rg * 16 + row) * 128 + 4 * j);
        float* obase = hgo + (size_t)it * TS * 16;
        f32x4 s0 = (f32x4){0.f, 0.f, 0.f, 0.f}, s1 = s0;
        if (wave < 4 && s > 0) { s0 = *(const f32x4*)stp; s1 = *(const f32x4*)(stp + 64); }
        if (wave >= 4) { hg_load(lds, tid - 256, tok0, h8, rg, cols, lbv); SCAN_BAR_L(); } else { __builtin_amdgcn_s_setprio(2); asm volatile("s_waitcnt vmcnt(0)" ::: "memory"); SCAN_BAR_S(); }
#pragma unroll 1
        for (int blk = 0; blk < NBLK; ++blk) {
            if (wave >= 4) {
                if (blk > 0) y_drain(lds + ((blk - 1) & 1) * HGB + 51200, tid - 256, obase + (size_t)(blk - 1) * 512);
                if (blk + 1 < NBLK) hg_load(lds + ((blk + 1) & 1) * HGB, tid - 256, tok0 + (blk + 1) * 32, h8, rg, cols, lbv);
                SCAN_BAR_L();
            } else {
                const LAS unsigned char* bp = lds + (blk & 1) * HGB;
                const LAS unsigned char* p4 = bp + 16 * j; const LAS unsigned char* pv = bp + 49152 + row * 4; LAS unsigned char* py = (LAS unsigned char*)bp + 51200 + row * 4;
                f32x4 f0 = *(const LAS f32x4*)(p4), f1 = *(const LAS f32x4*)(p4 + 256), k0 = *(const LAS f32x4*)(p4 + 16384), k1 = *(const LAS f32x4*)(p4 + 16384 + 256), q0 = *(const LAS f32x4*)(p4 + 32768), q1 = *(const LAS f32x4*)(p4 + 32768 + 256);
                float iv = *(const LAS float*)(pv); float yprev = 0.f;
#pragma unroll
                for (int t = 0; t < 32; ++t) {
                    f32x4 nf0 = f0, nf1 = f1, nk0 = k0, nk1 = k1, nq0 = q0, nq1 = q1; float niv = iv;
                    if (t < 31) { const int o = (t + 1) * 512; nf0 = *(const LAS f32x4*)(p4 + o); nf1 = *(const LAS f32x4*)(p4 + 256 + o); nk0 = *(const LAS f32x4*)(p4 + 16384 + o); nk1 = *(const LAS f32x4*)(p4 + 16384 + 256 + o);
                                  nq0 = *(const LAS f32x4*)(p4 + 32768 + o); nq1 = *(const LAS f32x4*)(p4 + 32768 + 256 + o); niv = *(const LAS float*)(pv + (t + 1) * 64); }
                    s0 = s0 * f0 + k0 * iv; s1 = s1 * f1 + k1 * iv;
                    float y = ((s0[0] * q0[0] + s0[1] * q0[1]) + (s0[2] * q0[2] + s0[3] * q0[3])) + ((s1[0] * q1[0] + s1[1] * q1[1]) + (s1[2] * q1[2] + s1[3] * q1[3]));
                    if (t & 1) { allreduce16x2(yprev, y); if (j == 0) { *(LAS float*)(py + (t - 1) * 64) = yprev; *(LAS float*)(py + t * 64) = y; } }
                    yprev = y;
                    f0 = nf0; f1 = nf1; k0 = nk0; k1 = nk1; q0 = nq0; q1 = nq1; iv = niv;
                }
                SCAN_BAR_S();
            }
        }
        if (wave >= 4) { y_drain(lds + ((NBLK - 1) & 1) * HGB + 51200, tid - 256, obase + (size_t)(NBLK - 1) * 512); }
        else { __builtin_amdgcn_s_setprio(0); if (save) { *(f32x4*)stp = s0; *(f32x4*)(stp + 64) = s1; } }
    }
}


constexpr int FT = 16;
constexpr int F_RW = 0, F_RWV = 20480, F_RWY = 21504, F_HG = 22528, F_HGQ = 8192, F_HGI = F_HG + 16384, F_HGY = F_HG + 17408, FBUF = 40960;
__device__ __forceinline__ void fused_load(LAS unsigned char* bp, int lt2, size_t ltok0, int h, int rg, int h8, int rg8, const bf16_t* PA, const float* PW, const bf16_t* PB, const bf16_t* PK, const bf16_t* PR, const bf16_t* PV,
        const bf16_t* cols, const float* lbv) {
    if (lt2 < 128) {
        const int tok = lt2 >> 3, c8 = (lt2 & 7) * 8; const size_t base = (ltok0 + tok) * 1024 + h * 64 + c8;
        const u32x4 ra = *(const u32x4*)(PA + base), rb = *(const u32x4*)(PB + base), rk = *(const u32x4*)(PK + base), rr = *(const u32x4*)(PR + base);
        const f32x4 w0 = *(const f32x4*)(PW + base), w1 = *(const f32x4*)(PW + base + 4);
        const unsigned rv = *(const unsigned*)(PV + (ltok0 + tok) * 1024 + h * 64 + rg * 16 + (lt2 & 7) * 2);
        const int off = (tok * 64 + c8) * 4;
#define RW_PUT(arr, u) do { *(LAS f32x4*)(bp + (arr) * 4096 + off) = (f32x4){bflo(u.x), bfhi(u.x), bflo(u.y), bfhi(u.y)}; *(LAS f32x4*)(bp + (arr) * 4096 + off + 16) = (f32x4){bflo(u.z), bfhi(u.z), bflo(u.w), bfhi(u.w)}; } while (0)
        RW_PUT(0, ra); RW_PUT(2, rb); RW_PUT(3, rk); RW_PUT(4, rr);
#undef RW_PUT
        *(LAS f32x4*)(bp + 4096 + off) = w0; *(LAS f32x4*)(bp + 4096 + off + 16) = w1;
        *(LAS f32x2v*)(bp + F_RWV + (tok * 16 + (lt2 & 7) * 2) * 4) = (f32x2v){bflo(rv), bfhi(rv)};
    } else {
        const int l = lt2 - 128, tok = l >> 3, c16 = (l & 7) * 16; const bf16_t* crow = cols + (ltok0 + tok) * CL;
        float q[16], f[16];
        { float t[8]; ld8bf(crow + C_HQ + h8 * 128 + c16, t);
#pragma unroll
          for (int e = 0; e < 8; ++e) q[e] = t[e];
          ld8bf(crow + C_HQ + h8 * 128 + c16 + 8, t);
#pragma unroll
          for (int e = 0; e < 8; ++e) q[8 + e] = t[e];
          ld8bf(crow + C_HF + h8 * 128 + c16, t);
#pragma unroll
          for (int e = 0; e < 8; ++e) f[e] = t[e];
          ld8bf(crow + C_HF + h8 * 128 + c16 + 8, t);
#pragma unroll
          for (int e = 0; e < 8; ++e) f[8 + e] = t[e]; }
        const unsigned rv = *(const unsigned*)(crow + C_HI + h8 * 128 + rg8 * 16 + (l & 7) * 2);
        LAS unsigned char* hp = bp + F_HG; const int off = (tok * 128 + c16) * 4;
#pragma unroll
        for (int g = 0; g < 4; ++g) { const f32x4 lb = *(const f32x4*)(lbv + h8 * 128 + c16 + 4 * g); f32x4 fv, qv;
#pragma unroll
            for (int e = 0; e < 4; ++e) { fv[e] = lb[e] + (1.0f - lb[e]) * f[4 * g + e]; qv[e] = q[4 * g + e]; }
            *(LAS f32x4*)(hp + off + 16 * g) = fv; *(LAS f32x4*)(hp + F_HGQ + off + 16 * g) = qv; }
        *(LAS f32x2v*)(bp + F_HGI + (tok * 16 + (l & 7) * 2) * 4) = (f32x2v){bflo(rv), bfhi(rv)};
    }
}
__device__ __forceinline__ void fused_drain(const LAS unsigned char* bp, int lt2, float* orw, float* ohg) {
    if (lt2 < 128) *(f32x2v*)(orw + lt2 * 2) = *(const LAS f32x2v*)(bp + F_RWY + lt2 * 8);
    else *(f32x2v*)(ohg + (lt2 - 128) * 2) = *(const LAS f32x2v*)(bp + F_HGY + (lt2 - 128) * 8);
}
__device__ __forceinline__ void fused_scan(int s, int bid, int G, int tid, int lane, int wave, LAS unsigned char* lds,
        const bf16_t* PA, const float* PW, const bf16_t* PB, const bf16_t* PK, const bf16_t* PR, const bf16_t* PV, const bf16_t* cols, const float* lbv,
        float* oraw, float* hgo, float* rwstate, float* hgstate, bool save) {
    constexpr int NBLK = TS / FT;
    const int rowl = lane >> 4, j = lane & 15, row = (wave & 3) * 4 + rowl;
    for (int it = bid; it < 256; it += G) {
        const int b = it >> 6, h = (it >> 2) & 15, rg = it & 3, h8 = (it >> 3) & 7, rg8 = it & 7;
        const size_t tok0 = (size_t)b * TS;
        float* stp = rwstate + ((size_t)((b * 16 + h) * 64 + rg * 16 + row) * 64 + 4 * j);
        float* shp = hgstate + ((size_t)((b * 8 + h8) * 128 + rg8 * 16 + row) * 128 + 4 * j);
        float* orw = oraw + (size_t)it * TS * 16; float* ohg = hgo + (size_t)it * TS * 16;
        f32x4 st = (f32x4){0.f, 0.f, 0.f, 0.f}, s0 = st, s1 = st;
        if (wave < 4 && s > 0) { st = *(const f32x4*)stp; s0 = *(const f32x4*)shp; s1 = *(const f32x4*)(shp + 64); }
        if (wave >= 4) { fused_load(lds, tid - 256, tok0, h, rg, h8, rg8, PA, PW, PB, PK, PR, PV, cols, lbv); SCAN_BAR_L(); } else { __builtin_amdgcn_s_setprio(2); asm volatile("s_waitcnt vmcnt(0)" ::: "memory"); SCAN_BAR_S(); }
#pragma unroll 1
        for (int blk = 0; blk < NBLK; ++blk) {
            if (wave >= 4) {
                if (blk > 0) fused_drain(lds + ((blk - 1) & 1) * FBUF, tid - 256, orw + (size_t)(blk - 1) * (FT * 16), ohg + (size_t)(blk - 1) * (FT * 16));
                if (blk + 1 < NBLK) fused_load(lds + ((blk + 1) & 1) * FBUF, tid - 256, tok0 + (blk + 1) * FT, h, rg, h8, rg8, PA, PW, PB, PK, PR, PV, cols, lbv);
                SCAN_BAR_L();
            } else {
                const LAS unsigned char* bp = lds + (blk & 1) * FBUF;
                const LAS unsigned char* p4 = bp + 16 * j; const LAS unsigned char* pv = bp + F_RWV + row * 4; LAS unsigned char* py = (LAS unsigned char*)bp + F_RWY + row * 4;
                const LAS unsigned char* g4 = bp + F_HG + 16 * j; const LAS unsigned char* gi = bp + F_HGI + row * 4; LAS unsigned char* gy = (LAS unsigned char*)bp + F_HGY + row * 4;
                f32x4 a4 = *(const LAS f32x4*)(p4), w4 = *(const LAS f32x4*)(p4 + 4096), b4 = *(const LAS f32x4*)(p4 + 8192), k4 = *(const LAS f32x4*)(p4 + 12288), r4 = *(const LAS f32x4*)(p4 + 16384);
                float vv = *(const LAS float*)(pv);
                f32x4 f0 = *(const LAS f32x4*)(g4), f1 = *(const LAS f32x4*)(g4 + 256), q0 = *(const LAS f32x4*)(g4 + F_HGQ), q1 = *(const LAS f32x4*)(g4 + F_HGQ + 256);
                float iv = *(const LAS float*)(gi);
                float sa = (st[0] * a4[0] + st[1] * a4[1]) + (st[2] * a4[2] + st[3] * a4[3]);
                sa = allreduce16(sa);
#pragma unroll
                for (int t = 0; t < FT; ++t) {
                    f32x4 na = a4, nw = w4, nb = b4, nk = k4, nr = r4; float nv = vv;
                    f32x4 nf0 = f0, nf1 = f1, nq0 = q0, nq1 = q1; float niv = iv;
                    if (t < FT - 1) { const int o = (t + 1) * 256; na = *(const LAS f32x4*)(p4 + o); nw = *(const LAS f32x4*)(p4 + 4096 + o); nb = *(const LAS f32x4*)(p4 + 8192 + o); nk = *(const LAS f32x4*)(p4 + 12288 + o); nr = *(const LAS f32x4*)(p4 + 16384 + o); nv = *(const LAS float*)(pv + (t + 1) * 64);
                        const int o2 = (t + 1) * 512; nf0 = *(const LAS f32x4*)(g4 + o2); nf1 = *(const LAS f32x4*)(g4 + 256 + o2);
                        nq0 = *(const LAS f32x4*)(g4 + F_HGQ + o2); nq1 = *(const LAS f32x4*)(g4 + F_HGQ + 256 + o2); niv = *(const LAS float*)(gi + (t + 1) * 64); }
                    st = st * w4 + (b4 * sa + k4 * vv);
                    s0 = (s0 - iv) * f0 + iv; s1 = (s1 - iv) * f1 + iv;
                    float y = (st[0] * r4[0] + st[1] * r4[1]) + (st[2] * r4[2] + st[3] * r4[3]);
                    float sn = (st[0] * na[0] + st[1] * na[1]) + (st[2] * na[2] + st[3] * na[3]);
                    float yh = ((s0[0] * q0[0] + s0[1] * q0[1]) + (s0[2] * q0[2] + s0[3] * q0[3])) + ((s1[0] * q1[0] + s1[1] * q1[1]) + (s1[2] * q1[2] + s1[3] * q1[3]));
                    sn = dpp_add<0xB1>(sn); y = dpp_add<0xB1>(y); yh = dpp_add<0xB1>(yh); sn = dpp_add<0x4E>(sn); y = dpp_add<0x4E>(y); yh = dpp_add<0x4E>(yh);
                    sn = dpp_add<0x141>(sn); y = dpp_add<0x141>(y); yh = dpp_add<0x141>(yh); sn = dpp_add<0x140>(sn); y = dpp_add<0x140>(y); yh = dpp_add<0x140>(yh);
                    if (j == 0) { *(LAS float*)(py + t * 64) = y; *(LAS float*)(gy + t * 64) = yh; }
                    sa = sn; a4 = na; w4 = nw; b4 = nb; k4 = nk; r4 = nr; vv = nv;
                    f0 = nf0; f1 = nf1; q0 = nq0; q1 = nq1; iv = niv;
                }
                SCAN_BAR_S();
            }
        }
        if (wave >= 4) fused_drain(lds + ((NBLK - 1) & 1) * FBUF, tid - 256, orw + (size_t)(NBLK - 1) * (FT * 16), ohg + (size_t)(NBLK - 1) * (FT * 16));
        else { __builtin_amdgcn_s_setprio(0); if (save) { *(f32x4*)stp = st; *(f32x4*)shp = s0; *(f32x4*)(shp + 64) = s1; } }
    }
}

__device__ __forceinline__ void attn_phase(int gw, int NGW, int lane, const bf16_t* Q, const bf16_t* KV, const bf16_t* Vt, bf16_t* AO) {
    const int fr = lane & 15, fq = lane >> 4;
    for (int item = gw; item < 8192; item += NGW) {
        const int bh = item >> 9, tile = item & 511, b = bh >> 2, hd = bh & 3;
        const size_t gt = (size_t)b * SEQ + tile * 16 + fr;
        bf16x8 qf[8];
#pragma unroll
        for (int ks = 0; ks < 8; ++ks) qf[ks] = *(const bf16x8*)(Q + gt * 1024 + hd * 256 + ks * 32 + fq * 8);
        f32x4 sc[16]; float mx = -3.0e38f;
#pragma unroll
        for (int kt = 0; kt < 16; ++kt) { f32x4 acc = (f32x4){0.f, 0.f, 0.f, 0.f}; const bf16_t* kp = KV + (size_t)(b * 256 + kt * 16 + fr) * 2048 + hd * 256 + fq * 8;
#pragma unroll
            for (int ks = 0; ks < 8; ++ks) acc = MFMA16(*(const bf16x8*)(kp + ks * 32), qf[ks], acc);
            sc[kt] = acc * 0.0625f; mx = fmaxf(mx, fmaxf(fmaxf(sc[kt][0], sc[kt][1]), fmaxf(sc[kt][2], sc[kt][3]))); }
        mx = fmaxf(mx, __shfl_xor(mx, 16)); mx = fmaxf(mx, __shfl_xor(mx, 32));
        float sum = 0.f;
#pragma unroll
        for (int kt = 0; kt < 16; ++kt) {
#pragma unroll
            for (int jj = 0; jj < 4; ++jj) { sc[kt][jj] = __expf(sc[kt][jj] - mx); sum += sc[kt][jj]; } }
        sum = fq_sum(sum);
        const float inv = 1.0f / sum;
        bf16x8 pf[8];
#pragma unroll
        for (int k2 = 0; k2 < 8; ++k2) { u32x4 w; w.x = cvt_pk_bf16(sc[2 * k2][0], sc[2 * k2][1]); w.y = cvt_pk_bf16(sc[2 * k2][2], sc[2 * k2][3]); w.z = cvt_pk_bf16(sc[2 * k2 + 1][0], sc[2 * k2 + 1][1]); w.w = cvt_pk_bf16(sc[2 * k2 + 1][2], sc[2 * k2 + 1][3]); pf[k2] = __builtin_bit_cast(bf16x8, w); }
#pragma unroll 2
        for (int dt = 0; dt < 16; ++dt) { f32x4 acc = (f32x4){0.f, 0.f, 0.f, 0.f}; const bf16_t* vp = Vt + (size_t)((b * 4 + hd) * 256 + dt * 16 + fr) * 256 + fq * 8;
#pragma unroll
            for (int k2 = 0; k2 < 8; ++k2) acc = MFMA16(*(const bf16x8*)(vp + k2 * 32), pf[k2], acc);
            st4bf(AO + gt * 1024 + hd * 256 + dt * 16 + 4 * fq, acc * inv); }
    }
}

__device__ __forceinline__ int tid_fresh() { int t = threadIdx.x; asm volatile("" : "+v"(t)); return t; }
#define WinT ((bf16_t*)(a.ws + WS_WIN))
#define WoutT ((bf16_t*)(a.ws + WS_WOUT))
#define WqT ((bf16_t*)(a.ws + WS_WQ))
#define WoT ((bf16_t*)(a.ws + WS_WO))
#define WkvT ((bf16_t*)(a.ws + WS_WKV))
#define W13T ((bf16_t*)(a.ws + WS_W13))
#define W2T ((bf16_t*)(a.ws + WS_W2))
#define rw2T ((bf16_t*)(a.ws + WS_RW2T))
#define ra2T ((bf16_t*)(a.ws + WS_RA2T))
#define rg2T ((bf16_t*)(a.ws + WS_RG2T))
#define g2Tp ((bf16_t*)(a.ws + WS_G2TP))
#define GATE ((bf16_t*)(a.ws + WS_GATE))
#define ASG ((bf16_t*)(a.ws + WS_ASG))
#define carry ((bf16_t*)(a.ws + WS_CARRY))
#define lbv ((float*)(a.ws + WS_LB))
#define mbf ((bf16_t*)(a.ws + WS_MBF))
#define KV ((bf16_t*)(a.ws + WS_KV))
#define Vt ((bf16_t*)(a.ws + WS_VT))
#define rwst ((float*)(a.ws + WS_RWST))
#define hgst ((float*)(a.ws + WS_HGST))
#define bonus ((float*)(a.ws + WS_BONUS))
#define merged ((bf16_t*)(a.ws + WS_MERGED))
#define u1 ((bf16_t*)(a.ws + WS_U1))
#define cols ((bf16_t*)(a.ws + WS_COLS))
#define PR ((bf16_t*)(a.ws + WS_PR))
#define PK ((bf16_t*)(a.ws + WS_PK))
#define PA ((bf16_t*)(a.ws + WS_PA))
#define PB ((bf16_t*)(a.ws + WS_PB))
#define PV ((bf16_t*)(a.ws + WS_PV))
#define PW ((float*)(a.ws + WS_PW))
#define oraw ((float*)(a.ws + WS_ORAW))
#define hgo ((float*)(a.ws + WS_HGO))
#define U ((bf16_t*)(a.ws + WS_U))
#define Qb ((bf16_t*)(a.ws + WS_Q))
#define AO ((bf16_t*)(a.ws + WS_AO))
#define FF ((bf16_t*)(a.ws + WS_FF))
#define XIN (a.in[0])
#define OUTP (a.out)
struct Args { const float* in[29]; float* out; unsigned char* ws; int ph_lo, ph_hi; };

typedef const __attribute__((address_space(4))) Args* CArgsP;
__device__ __forceinline__ CArgsP args_fresh() { CArgsP p = (CArgsP)__builtin_amdgcn_kernarg_segment_ptr(); asm volatile("" : "+s"(p)); return p; }
__global__ void __launch_bounds__(512, 2) mega(Args a0) {
    extern __shared__ __attribute__((aligned(16))) unsigned char lds_raw[];
    LAS unsigned char* lds = (LAS unsigned char*)lds_raw;
    cg::grid_group grid = cg::this_grid();
    const int G = gridDim.x, bid = blockIdx.x, NGW = G * 8, NGT = G * 512;
#define IDS const auto& a = *args_fresh(); const int tid = tid_fresh(), lane = tid & 63, wave = __builtin_amdgcn_readfirstlane(tid >> 6), gw = bid * 8 + wave, gtid = bid * 512 + tid; (void)lane; (void)gw; (void)gtid
    const int lo = a0.ph_lo, hi = a0.ph_hi;
    if (lo < 0) grid.sync();
    { volatile LAS unsigned* misc = (volatile LAS unsigned*)(lds + MISC_OFF); if (threadIdx.x < 2) misc[threadIdx.x] = 0u; __syncthreads();
      if (hi - lo > 1) (void)xcd_barrier_post((unsigned*)(a0.ws + WS_CTL), misc); }
#ifndef MK_REP
#define MK_REP -1
#endif
#ifndef MK_REPN
#define MK_REPN 3
#endif
#define RPT(code) for (int rep_ = 0, nrep_ = (MK_REP == (code)) ? MK_REPN : 1; rep_ < nrep_; ++rep_)
#define LASTREP (rep_ == nrep_ - 1)
#define IN(k) (lo <= (k) && (k) < hi)
#define SEAM(k) do { if (IN(k) && IN((k) + 1)) RPT(120) { XcdBarrier xb_; xb_.bar = (unsigned*)(args_fresh()->ws + WS_CTL); xb_.x = xb_xcc_id(); xb_.st = (volatile LAS unsigned*)(lds + MISC_OFF); xcd_barrier(xb_); } } while (0)

    if (IN(0)) { IDS;
        LAS float* scr = (LAS float*)(lds + wave * 16384);
        constexpr int I_IN = 16 * 297, I_SQ = 16 * 32, I_13 = 16 * 88, I_2 = 44 * 32;
        constexpr int NITEMS = I_IN + 5 * I_SQ + 2 * I_13 + I_2;
        for (int it = gw; it < NITEMS; it += NGW) {
            int r = it;
            if (r < I_IN) { const int kb = r / 297, n0 = (r % 297) * 32; tr_item(a.in[3], 1024, 9504, WinT, kb, n0, n0 + (n0 >= 3360 ? 224 : 0), scr, lane); continue; } r -= I_IN;
            if (r < I_SQ) { tr_item(a.in[17], 1024, 1024, WoutT, r / 32, (r % 32) * 32, (r % 32) * 32, scr, lane); continue; } r -= I_SQ;
            if (r < I_SQ) { tr_item(a.in[20], 1024, 1024, WqT, r / 32, (r % 32) * 32, (r % 32) * 32, scr, lane); continue; } r -= I_SQ;
            if (r < I_SQ) { tr_item(a.in[23], 1024, 1024, WoT, r / 32, (r % 32) * 32, (r % 32) * 32, scr, lane); continue; } r -= I_SQ;
            if (r < I_SQ) { tr_item(a.in[21], 1024, 1024, WkvT, r / 32, (r % 32) * 32, (r % 32) * 32, scr, lane); continue; } r -= I_SQ;
            if (r < I_SQ) { tr_item(a.in[22], 1024, 1024, WkvT, r / 32, (r % 32) * 32, 1024 + (r % 32) * 32, scr, lane); continue; } r -= I_SQ;
            if (r < I_13) { const int n0 = (r % 88) * 32; tr_item(a.in[25], 1024, DFF, W13T, r / 88, n0, (n0 / 128) * 256 + (n0 % 128), scr, lane); continue; } r -= I_13;
            if (r < I_13) { const int n0 = (r % 88) * 32; tr_item(a.in[26], 1024, DFF, W13T, r / 88, n0, (n0 / 128) * 256 + 128 + (n0 % 128), scr, lane); continue; } r -= I_13;
            tr_item(a.in[27], DFF, 1024, W2T, r / 32, (r % 32) * 32, (r % 32) * 32, scr, lane);
        }
        for (int i = gtid; i < 28672; i += NGT) ((u32x4*)(WinT + 3360 * 1024))[i] = (u32x4){0u, 0u, 0u, 0u};
        for (int i = gtid; i < 1792; i += NGT) ((u32x4*)carry)[i] = (u32x4){0u, 0u, 0u, 0u};
        for (int n = gw; n < 1024; n += NGW) { rw2T[n * 64 + lane] = (bf16_t)f2bf(a.in[6][lane * 1024 + n]); ra2T[n * 64 + lane] = (bf16_t)f2bf(a.in[8][lane * 1024 + n]); }
        for (int m = gw; m < 512; m += NGW) {
            for (int e = lane; e < 320; e += 64) { const int n = 2 * m + (e >= 160 ? 1 : 0), k = e >= 160 ? e - 160 : e; rg2T[n * 160 + k] = (bf16_t)f2bf(a.in[9][k * 1024 + n]); } }
        for (int n = gw; n < 1024; n += NGW) { f32x4 v;
#pragma unroll
            for (int e = 0; e < 4; ++e) { const int k = 4 * lane + e; v[e] = k < 160 ? a.in[9][k * 1024 + n] : 0.f; }
            st4bf(g2Tp + n * 256 + 4 * lane, v); }
        for (int i = gtid; i < 1024; i += NGT) lbv[i] = 1.0f / (1.0f + __expf(a.in[15][1024 + i] - a.in[15][i]));
        for (int m = gw; m < 1024; m += NGW) rms_row_bf16(a.in[1] + (size_t)m * 1024, a.in[19], mbf + (size_t)m * 1024, lane);
        for (int lt = gw; lt < MS; lt += NGW) { const int b = lt / TS, tl = lt % TS; const size_t gt = (size_t)b * SEQ + tl; rms_row_bf16(XIN + gt * 1024, a.in[2], u1 + (size_t)lt * 1024, lane); }
        __syncthreads();
    }
    SEAM(0);

#pragma unroll 1
    for (int s = 0; s < NSPLIT; ++s) {
        const int pb = 1 + 5 * s;
        if (IN(pb + 1)) { const auto& a = *args_fresh();
            pg8::Gemm g{u1, WinT, MS, CL, 1024}; pg8::StaticOrder S; S.init(MS, CL, G, bid);
            pg8::EpiColsAct E{cols, CL};
            RPT(102) pg8::gemm_phase<pg8::EpiColsAct, pg8::StaticOrder, true, true>(lds, g, S, E);
        }
        SEAM(pb + 1);
#ifndef SKIP_PREP
        if (IN(pb + 2)) { IDS; RPT(103) prep_phase(s, gw, NGW, lane, cols, carry, a.in[4], a.in[5], a.in[7], a.in[10], a.in[11], a.in[12], rw2T, ra2T, PR, PK, PA, PB, PV, PW, bonus, ASG); }
#endif
        SEAM(pb + 2);
        if (IN(pb + 3)) { IDS;
#ifdef MK_ZERO_SCAN
            for (int i = gtid; i < MS * 256; i += NGT) { ((f32x4*)oraw)[i] = (f32x4){0.f, 0.f, 0.f, 0.f}; ((f32x4*)hgo)[i] = (f32x4){0.01f, 0.02f, 0.03f, 0.04f}; }
#endif
#if 0
            RPT(104) { rwkv_scan(s, bid, G, tid, lane, wave, lds, PA, PW, PB, PK, PR, PV, oraw, rwst, LASTREP); __syncthreads(); }
            RPT(105) { hgrn_scan(s, bid, G, tid, lane, wave, lds, cols, lbv, hgo, hgst, LASTREP); __syncthreads(); }
#else
            RPT(104) { fused_scan(s, bid, G, tid, lane, wave, lds, PA, PW, PB, PK, PR, PV, cols, lbv, oraw, hgo, rwst, hgst, LASTREP); __syncthreads(); }
#endif
            { pg8::Gemm g{ASG, g2Tp, MS, 1024, 256}; pg8::StaticOrder S; S.init(MS, 1024, G, bid); pg8::EpiStoreBf16 E{GATE, 1024};
              pg8::gemm_phase<pg8::EpiStoreBf16, pg8::StaticOrder, true, true>(lds, g, S, E); }
        }
        SEAM(pb + 3);
        if (IN(pb + 4)) { IDS;
#ifdef MK_NOMIX
            for (int i = gtid; i < MS * 128; i += NGT) { const int lt = i >> 7, b = lt / TS, tl = lt % TS; const size_t gt = (size_t)b * SEQ + s * TS + tl; ((u32x4*)(merged + gt * 1024))[i & 127] = (u32x4){0u, 0u, 0u, 0u}; }
#endif
#ifndef SKIP_POST
            RPT(106) post_phase(s, gw, NGW, lane, cols, carry, a.in[4], GATE, a.in[13], a.in[14], a.in[16], oraw, hgo, PV, bonus, merged);
#endif
            if (s + 1 < NSPLIT) for (int lt = gw; lt < MS; lt += NGW) { const int b = lt / TS, tl = lt % TS; const size_t gt = (size_t)b * SEQ + (s + 1) * TS + tl; rms_row_bf16(XIN + gt * 1024, a.in[2], u1 + (size_t)lt * 1024, lane); }
            if (bid < 4 && s + 1 < NSPLIT) { const u32x4* src = (const u32x4*)(cols + (size_t)(bid * TS + TS - 1) * CL); u32x4* dst = (u32x4*)(carry + (((s + 1) & 1) * 4 + bid) * CARRY_LD);
                for (int i = tid; i < CARRY_LD / 8; i += 512) dst[i] = src[i]; }
        }
        SEAM(pb + 4);
    }

    if (IN(T0 + 0)) { const auto& a = *args_fresh();
        { pg8::Gemm g{merged, WoutT, NTOK, 1024, 1024}; pg8::StaticOrder S; S.init(NTOK, 1024, G, bid); pg8::EpiResF32 E{XIN, OUTP, 1024};
          pg8::gemm_phase<pg8::EpiResF32, pg8::StaticOrder, true, true>(lds, g, S, E); }
        { pg8::Gemm g{mbf, WkvT, 1024, 2048, 1024}; pg8::StaticOrder S; S.init(1024, 2048, G, bid); pg8::EpiStoreBf16 E{KV, 2048};
          pg8::gemm_phase<pg8::EpiStoreBf16, pg8::StaticOrder, true, true>(lds, g, S, E); }
    }
    SEAM(T0 + 0);
    if (IN(T0 + 1)) { IDS;
        for (int gt = gw; gt < NTOK; gt += NGW) rms_row_bf16(OUTP + (size_t)gt * 1024, a.in[18], U + (size_t)gt * 1024, lane);
        for (int i = gtid; i < 4 * 4 * 256 * 256; i += NGT) { const int kp = i & 255, dim = (i >> 8) & 255, hd = (i >> 16) & 3, b = i >> 18;
            const int k2 = kp >> 5, fq = (kp >> 3) & 3, sl = kp & 7; const int key = 32 * k2 + (sl < 4 ? 4 * fq + sl : 16 + 4 * fq + sl - 4);
            Vt[i] = KV[(size_t)(b * 256 + key) * 2048 + 1024 + hd * 256 + dim]; }
    }
    SEAM(T0 + 1);
    if (IN(T0 + 2)) { const auto& a = *args_fresh(); pg8::Gemm g{U, WqT, NTOK, 1024, 1024}; pg8::StaticOrder S; S.init(NTOK, 1024, G, bid); pg8::EpiStoreBf16 E{Qb, 1024};
        RPT(112) pg8::gemm_phase<pg8::EpiStoreBf16, pg8::StaticOrder, true, true>(lds, g, S, E); }
    SEAM(T0 + 2);
#ifndef SKIP_ATTN
    if (IN(T0 + 3)) { IDS; RPT(113) attn_phase(gw, NGW, lane, Qb, KV, Vt, AO); }
#endif
    SEAM(T0 + 3);
#ifndef MK_NOATT
    if (IN(T0 + 4)) { const auto& a = *args_fresh(); pg8::Gemm g{AO, WoT, NTOK, 1024, 1024}; pg8::StaticOrder S; S.init(NTOK, 1024, G, bid); pg8::EpiResF32 E{OUTP, OUTP, 1024};
        pg8::gemm_phase<pg8::EpiResF32, pg8::StaticOrder, true, true>(lds, g, S, E); }
#endif
    SEAM(T0 + 4);
    if (IN(T0 + 5)) { IDS; RPT(115) for (int gt = gw; gt < NTOK; gt += NGW) rms_row_bf16(OUTP + (size_t)gt * 1024, a.in[24], U + (size_t)gt * 1024, lane); }
    SEAM(T0 + 5);
    if (IN(T0 + 6)) { const auto& a = *args_fresh(); pg8::Gemm g{U, W13T, NTOK, 2 * DFF, 1024}; pg8::StaticOrder S; S.init(NTOK, 2 * DFF, G, bid); pg8::EpiSwiGLU E{FF, DFF};
        RPT(116) pg8::gemm_phase<pg8::EpiSwiGLU, pg8::StaticOrder, true, true>(lds, g, S, E); }
    SEAM(T0 + 6);
    if (IN(T0 + 7)) { const auto& a = *args_fresh(); pg8::Gemm g{FF, W2T, NTOK, 1024, DFF}; pg8::StaticOrder S; S.init(NTOK, 1024, G, bid); pg8::EpiResF32 E{OUTP, OUTP, 1024};
        pg8::gemm_phase<pg8::EpiResF32, pg8::StaticOrder, true, true>(lds, g, S, E); }
    SEAM(T0 + 7);
    if (IN(T0 + 8)) { IDS;
        const float* gf = a.in[28];
        for (int gt = gw; gt < NTOK; gt += NGW) { f32x4* row = (f32x4*)(OUTP + (size_t)gt * 1024); f32x4 v[4]; float sq = 0.f;
#pragma unroll
            for (int j = 0; j < 4; ++j) { v[j] = row[lane + 64 * j]; sq += (v[j][0] * v[j][0] + v[j][1] * v[j][1]) + (v[j][2] * v[j][2] + v[j][3] * v[j][3]); }
            const float rs = 1.0f / sqrtf(wave_sum(sq) * (1.0f / 1024.0f) + 1e-6f);
#pragma unroll
            for (int j = 0; j < 4; ++j) row[lane + 64 * j] = v[j] * rs * ((const f32x4*)gf)[lane + 64 * j]; }
    }
#undef IN
#undef SEAM
}

#ifndef MK_MULTI
#define MK_MULTI 0
#endif
extern "C" void kernel_launch(void* const* d_in, const int* in_sizes, int n_in, void* d_out, int out_size, void* d_ws, size_t ws_size, hipStream_t stream) {
    static int grid = 0;
    if (grid == 0) {
        if (n_in != 29 || in_sizes[0] != NTOK * D || out_size != NTOK * D || ws_size < WS_END) { fprintf(stderr, "kernel_launch: unexpected shapes / workspace (%d inputs, ws %zu)\n", n_in, ws_size); grid = -1; return; }
        int dev = 0, cus = 0, per_cu = 0;
        hipGetDevice(&dev); hipDeviceGetAttribute(&cus, hipDeviceAttributeMultiprocessorCount, dev);
        hipFuncSetAttribute((const void*)mega, hipFuncAttributeMaxDynamicSharedMemorySize, LDS_BYTES);
        hipOccupancyMaxActiveBlocksPerMultiprocessor(&per_cu, (const void*)mega, 512, LDS_BYTES);
        (void)hipGetLastError();
        if (per_cu < 1) per_cu = 1;
        grid = cus;
    }
    if (grid < 0) return;
    Args a{};
    for (int i = 0; i < 29; ++i) a.in[i] = (const float*)d_in[i];
    a.out = (float*)d_out; a.ws = (unsigned char*)d_ws;
    (void)hipMemsetAsync((char*)d_ws + WS_CTL, 0, CTL_BYTES, stream);
    void* args[] = {&a};
#if MK_MULTI
    for (int ph = 0; ph < N_PHASES; ++ph) { a.ph_lo = ph; a.ph_hi = ph + 1; hipLaunchCooperativeKernel((const void*)mega, dim3(grid), dim3(512), args, LDS_BYTES, stream); }
#else
    a.ph_lo = 0; a.ph_hi = N_PHASES;
    hipError_t e = hipLaunchCooperativeKernel((const void*)mega, dim3(grid), dim3(512), args, LDS_BYTES, stream);
    if (e != hipSuccess) fprintf(stderr, "cooperative launch failed: %s (grid %d)\n", hipGetErrorString(e), grid);
#endif
}
```

```cpp
#include <hip/hip_runtime.h>
#include <hip/hip_cooperative_groups.h>
#include <cstdint>
#include <cstdio>
namespace cg = cooperative_groups;
namespace pg8 {
#define PG8_LAS __attribute__((address_space(3)))
typedef unsigned short bf16_t;
typedef short bf16x8 __attribute__((ext_vector_type(8)));
typedef float f32x4 __attribute__((ext_vector_type(4)));
typedef unsigned u32x4 __attribute__((ext_vector_type(4)));
constexpr int BM = 256, BK = 64, HALF = 128, HTB = HALF * BK * 2  , STAGE_BYTES = 8 * HTB, NXCD = 8, WGM = 8;

__host__ __device__ __forceinline__ int lds_byte(int r, int c) { const int st = (r >> 4) * 2 + (c >> 5), rr = r & 15, cc = c & 31, ob = rr * 64 + cc * 2; return st * 1024 + (ob ^ (((ob >> 9) & 1) << 5)); }
__host__ __device__ __forceinline__ void stage_rc(int b, int& R, int& C) { const int st = b / 1024, sb = b % 1024, swz = sb ^ (((sb >> 9) & 1) << 5); R = (st >> 1) * 16 + swz / 64; C = (st & 1) * 32 + (swz % 64) / 2; }
__host__ __device__ __forceinline__ int perm32(int rho) { const int n = rho >> 4, i = rho & 15; return 8 * (i >> 2) + 4 * n + (i & 3); }

struct Unit { int pm, pn; };
struct Gemm { const bf16_t* A; const bf16_t* Bt; int M, N, K; };

struct StaticOrder {
    int nM, nN, nwg, G, c;
    __host__ __device__ void init(int M, int N, int G_, int c_) { nM = M / BM; nN = N / BM; nwg = nM * nN; G = G_; c = c_; }
    __host__ __device__ bool next(int i, Unit& u) const {
        const long L = (long)i * G + c; if (L >= nwg) return false;
        int wgid = (int)L; { const int q = nwg / NXCD, r = nwg % NXCD, xcd = wgid % NXCD, off = wgid / NXCD; wgid = (xcd < r ? xcd * (q + 1) : r * (q + 1) + (xcd - r) * q) + off; }
        const int nig = WGM * nN, gid = wgid / nig, fm = gid * WGM, gsz = (nM - fm) < WGM ? (nM - fm) : WGM;
        u.pm = fm + ((wgid % nig) % gsz); u.pn = (wgid % nig) / gsz; return true;
    }
    __device__ __forceinline__ void a_ready(const Unit&) const {}
    __device__ __forceinline__ void done(const Unit&) const {}
};

__device__ __forceinline__ unsigned cvt_pk_bf16(float lo, float hi) { unsigned r; asm volatile("v_cvt_pk_bf16_f32 %0, %1, %2" : "=v"(r) : "v"(lo), "v"(hi)); return r; }
__device__ __forceinline__ float fast_sigmoid(float x) { return __builtin_amdgcn_rcpf(1.0f + __expf(-x)); }
__device__ __forceinline__ float fast_silu(float x) { return x * fast_sigmoid(x); }
struct EpiStoreBf16 {
    static constexpr bool PERM = true, AFTER_DRAIN = false;
    bf16_t* O; int ldc;
    __device__ __forceinline__ void operator()(const f32x4 (&acc)[2][2][4][2], const Unit& u, int wr, int wc, int fr, int fq) const {
        const int row0 = u.pm * BM + wr * 64 + fr, col0 = u.pn * BM + wc * 32 + 8 * fq;
#pragma unroll
        for (int ai = 0; ai < 2; ++ai)
#pragma unroll
            for (int m = 0; m < 4; ++m) { bf16_t* rowp = O + (size_t)(row0 + ai * HALF + m * 16) * ldc + col0;
#pragma unroll
                for (int bj = 0; bj < 2; ++bj) { const f32x4 v0 = acc[ai][bj][m][0], v1 = acc[ai][bj][m][1];
                    u32x4 w; w.x = cvt_pk_bf16(v0[0], v0[1]); w.y = cvt_pk_bf16(v0[2], v0[3]); w.z = cvt_pk_bf16(v1[0], v1[1]); w.w = cvt_pk_bf16(v1[2], v1[3]);
                    *(u32x4*)(rowp + bj * HALF) = w; } }
    }
};
struct EpiResF32 {
    static constexpr bool PERM = true, AFTER_DRAIN = false;
    const float* base; float* out; int ldc;
    __device__ __forceinline__ void operator()(const f32x4 (&acc)[2][2][4][2], const Unit& u, int wr, int wc, int fr, int fq) const {
        const int row0 = u.pm * BM + wr * 64 + fr, col0 = u.pn * BM + wc * 32 + 8 * fq;
#pragma unroll
        for (int ai = 0; ai < 2; ++ai)
#pragma unroll
            for (int m = 0; m < 4; ++m) { const size_t off = (size_t)(row0 + ai * HALF + m * 16) * ldc + col0;
#pragma unroll
                for (int bj = 0; bj < 2; ++bj)
#pragma unroll
                    for (int n = 0; n < 2; ++n) { const size_t p = off + bj * HALF + 4 * n; const f32x4 b = *(const f32x4*)(base + p); *(f32x4*)(out + p) = b + acc[ai][bj][m][n]; } }
    }
};
struct EpiSwiGLU {
    static constexpr bool PERM = true, AFTER_DRAIN = false;
    bf16_t* O; int ldc;
    __device__ __forceinline__ void operator()(const f32x4 (&acc)[2][2][4][2], const Unit& u, int wr, int wc, int fr, int fq) const {
        const int row0 = u.pm * BM + wr * 64 + fr, col0 = u.pn * HALF + wc * 32 + 8 * fq;
#pragma unroll
        for (int ai = 0; ai < 2; ++ai)
#pragma unroll
            for (int m = 0; m < 4; ++m) { bf16_t* rowp = O + (size_t)(row0 + ai * HALF + m * 16) * ldc + col0;
                f32x4 v0, v1;
#pragma unroll
                for (int j = 0; j < 4; ++j) { v0[j] = fast_silu(acc[ai][0][m][0][j]) * acc[ai][1][m][0][j]; v1[j] = fast_silu(acc[ai][0][m][1][j]) * acc[ai][1][m][1][j]; }
                u32x4 w; w.x = cvt_pk_bf16(v0[0], v0[1]); w.y = cvt_pk_bf16(v0[2], v0[3]); w.z = cvt_pk_bf16(v1[0], v1[1]); w.w = cvt_pk_bf16(v1[2], v1[3]);
                *(u32x4*)rowp = w; }
    }
};

struct EpiColsAct {
    static constexpr bool PERM = true, AFTER_DRAIN = false;
    bf16_t* O; int ldc;
    __device__ __forceinline__ void operator()(const f32x4 (&acc)[2][2][4][2], const Unit& u, int wr, int wc, int fr, int fq) const {
        const int row0 = u.pm * BM + wr * 64 + fr, col0 = u.pn * BM + wc * 32 + 8 * fq;
        const int pn = u.pn; const int act = (pn >= 14 && pn < 18) ? 1 : (pn >= 18 && pn < 22) ? 2 : (pn >= 26 && pn < 30) ? 1 : (pn >= 30) ? 2 : 0;
#pragma unroll
        for (int ai = 0; ai < 2; ++ai)
#pragma unroll
            for (int m = 0; m < 4; ++m) { bf16_t* rowp = O + (size_t)(row0 + ai * HALF + m * 16) * ldc + col0;
#pragma unroll
                for (int bj = 0; bj < 2; ++bj) { f32x4 v0 = acc[ai][bj][m][0], v1 = acc[ai][bj][m][1];
                    if (act == 1) {
#pragma unroll
                        for (int j = 0; j < 4; ++j) { v0[j] = fast_silu(v0[j]); v1[j] = fast_silu(v1[j]); } }
                    else if (act == 2) {
#pragma unroll
                        for (int j = 0; j < 4; ++j) { v0[j] = fast_sigmoid(v0[j]); v1[j] = fast_sigmoid(v1[j]); } }
                    u32x4 w; w.x = cvt_pk_bf16(v0[0], v0[1]); w.y = cvt_pk_bf16(v0[2], v0[3]); w.z = cvt_pk_bf16(v1[0], v1[1]); w.w = cvt_pk_bf16(v1[2], v1[3]);
                    *(u32x4*)(rowp + bj * HALF) = w; } }
    }
};
template <class Epi, class Sched, bool ALIGN_EPI = false, bool SP2 = false>
__device__ __forceinline__ void gemm_phase(PG8_LAS unsigned char* lds, const Gemm g, const Sched& S, const Epi& E) {
    int tid = threadIdx.x; asm volatile("" : "+v"(tid));
    const int wid = __builtin_amdgcn_readfirstlane(tid >> 6), lane = tid & 63, wr = wid >> 2, wc = wid & 3, fr = lane & 15, fq = lane >> 4;
    const int K = g.K, nt = K / BK;
    unsigned voffA[2], voffB[2];
#pragma unroll
    for (int i = 0; i < 2; ++i) { int R, C; stage_rc(tid * 16 + i * 8192, R, C); const int Rb = Epi::PERM ? ((R & ~31) + perm32(R & 31)) : R;
        voffA[i] = (unsigned)(R * K + C) * 2u; voffB[i] = (unsigned)(Rb * K + C) * 2u; }
    const size_t kstep = (size_t)(BK * 2);
    const size_t hstep = (size_t)HALF * K * 2;
    const size_t tstep = 2 * hstep;
    const unsigned ldsw = (unsigned)wid * 1024u;
    const int aoff = lds_byte(wr * 64 + fr, fq * 8), boff = lds_byte(wc * 32 + fr, fq * 8);
#define PG8_SA(b, h) (((b) * 2 + (h)) * HTB)
#define PG8_SB(b, h) ((4 + (b) * 2 + (h)) * HTB)
#define PG8_STAGE(bufoff, gbase, voff) do { _Pragma("unroll") for (int _i = 0; _i < 2; ++_i) \
        __builtin_amdgcn_global_load_lds((const unsigned*)((const char*)(gbase) + (voff)[_i]), (PG8_LAS unsigned*)(lds + (bufoff) + ldsw + _i * 8192), 16, 0, 0); } while (0)
#define PG8_LDA(dst, b, h) do { _Pragma("unroll") for (int m = 0; m < 4; ++m) _Pragma("unroll") for (int k = 0; k < 2; ++k) dst[m][k] = *(const PG8_LAS bf16x8*)(lds + PG8_SA(b, h) + aoff + m * 2048 + k * 1024); } while (0)
#define PG8_LDB(dst, b, h) do { _Pragma("unroll") for (int n = 0; n < 2; ++n) _Pragma("unroll") for (int k = 0; k < 2; ++k) dst[n][k] = *(const PG8_LAS bf16x8*)(lds + PG8_SB(b, h) + boff + n * 2048 + k * 1024); } while (0)
#define PG8_MMA(ai, bj, At, Bt) do { __builtin_amdgcn_s_setprio(1); _Pragma("unroll") for (int m = 0; m < 4; ++m) _Pragma("unroll") for (int n = 0; n < 2; ++n) _Pragma("unroll") for (int k = 0; k < 2; ++k) \
        acc[ai][bj][m][n] = __builtin_amdgcn_mfma_f32_16x16x32_bf16(Bt[n][k], At[m][k], acc[ai][bj][m][n], 0, 0, 0); __builtin_amdgcn_s_setprio(0); } while (0)
#define PG8_WAIT_V(n) asm volatile("s_waitcnt vmcnt(" #n ")" ::: "memory")
#define PG8_WAIT_L(n) asm volatile("s_waitcnt lgkmcnt(" #n ")" ::: "memory")
#define PG8_BAR __builtin_amdgcn_s_barrier()
#define PG8_SCHED __builtin_amdgcn_sched_barrier(0)
    Unit cur, nxt; int ui = 0;
    if (!S.next(0, cur)) return;
    f32x4 acc[2][2][4][2];
#pragma unroll
    for (int a = 0; a < 2; ++a)
#pragma unroll
        for (int b = 0; b < 2; ++b)
#pragma unroll
            for (int m = 0; m < 4; ++m)
#pragma unroll
                for (int n = 0; n < 2; ++n) acc[a][b][m][n] = (f32x4){0.f, 0.f, 0.f, 0.f};
    bf16x8 At[4][2], B0[2][2], B1[2][2];
    const char* cA = (const char*)g.A + (size_t)cur.pm * tstep; const char* cB = (const char*)g.Bt + (size_t)cur.pn * tstep;
    S.a_ready(cur);
    if constexpr (SP2) {
        PG8_STAGE(PG8_SB(0, 0), cB, voffB); PG8_STAGE(PG8_SB(0, 1), cB + hstep, voffB); PG8_STAGE(PG8_SA(0, 0), cA, voffA); PG8_STAGE(PG8_SA(0, 1), cA + hstep, voffA);
        if (wr == 1) PG8_BAR;
        PG8_WAIT_V(2); PG8_BAR;
        PG8_STAGE(PG8_SB(1, 0), cB + kstep, voffB); PG8_STAGE(PG8_SA(1, 0), cA + kstep, voffA); PG8_STAGE(PG8_SB(1, 1), cB + hstep + kstep, voffB);
        PG8_WAIT_V(6); PG8_BAR;
    } else {
        PG8_STAGE(PG8_SB(0, 0), cB, voffB); PG8_STAGE(PG8_SA(0, 0), cA, voffA); PG8_STAGE(PG8_SB(0, 1), cB + hstep, voffB); PG8_STAGE(PG8_SA(0, 1), cA + hstep, voffA);
        if (wr == 1) PG8_BAR;
        PG8_WAIT_V(4); PG8_BAR;
        PG8_STAGE(PG8_SB(1, 0), cB + kstep, voffB); PG8_STAGE(PG8_SA(1, 0), cA + kstep, voffA); PG8_STAGE(PG8_SB(1, 1), cB + hstep + kstep, voffB);
        PG8_WAIT_V(6); PG8_BAR;
    }
    for (;;) {
        const bool has_next = S.next(ui + 1, nxt);
        const char* nA = has_next ? (const char*)g.A + (size_t)nxt.pm * tstep : cA; const char* nB = has_next ? (const char*)g.Bt + (size_t)nxt.pn * tstep : cB;
        for (int t = 0; t < nt; t += 2) {
            const bool last = (t == nt - 2);
            const char* a1 = cA + (size_t)(t + 1) * kstep;
            const char* a2 = last ? nA : cA + (size_t)(t + 2) * kstep; const char* b2 = last ? nB : cB + (size_t)(t + 2) * kstep;
            const char* a3 = a2 + kstep; const char* b3 = b2 + kstep;
            if (last && has_next) S.a_ready(nxt);
            if constexpr (SP2) {
            PG8_LDB(B0, 0, 0); PG8_LDB(B1, 0, 1); PG8_SCHED; PG8_LDA(At, 0, 0); PG8_STAGE(PG8_SA(1, 1), a1 + hstep, voffA);
            PG8_WAIT_V(8); PG8_WAIT_L(0); PG8_BAR; PG8_MMA(0, 0, At, B0); PG8_MMA(0, 1, At, B1); PG8_BAR; PG8_SCHED;
            PG8_LDA(At, 0, 1); PG8_STAGE(PG8_SB(0, 0), b2, voffB); PG8_STAGE(PG8_SB(0, 1), b2 + hstep, voffB); PG8_STAGE(PG8_SA(0, 0), a2, voffA);
            PG8_WAIT_V(8); PG8_WAIT_L(0); PG8_BAR; PG8_MMA(1, 0, At, B0); PG8_MMA(1, 1, At, B1); PG8_BAR; PG8_SCHED;
            PG8_LDB(B0, 1, 0); PG8_LDB(B1, 1, 1); PG8_SCHED; PG8_LDA(At, 1, 0); PG8_STAGE(PG8_SA(0, 1), a2 + hstep, voffA);
            PG8_WAIT_V(8); PG8_WAIT_L(0); PG8_BAR; PG8_MMA(0, 0, At, B0); PG8_MMA(0, 1, At, B1); PG8_BAR; PG8_SCHED;
            PG8_LDA(At, 1, 1); PG8_STAGE(PG8_SB(1, 0), b3, voffB); PG8_STAGE(PG8_SB(1, 1), b3 + hstep, voffB); PG8_STAGE(PG8_SA(1, 0), a3, voffA);
            PG8_WAIT_V(8); PG8_WAIT_L(0); PG8_BAR; PG8_MMA(1, 0, At, B0); PG8_MMA(1, 1, At, B1); PG8_BAR; PG8_SCHED;
            } else {
            PG8_LDB(B0, 0, 0); PG8_SCHED; PG8_LDA(At, 0, 0); PG8_STAGE(PG8_SA(1, 1), a1 + hstep, voffA);
            PG8_WAIT_L(8); PG8_BAR; PG8_WAIT_L(0); PG8_MMA(0, 0, At, B0); PG8_BAR; PG8_SCHED;
            PG8_LDB(B1, 0, 1); PG8_STAGE(PG8_SB(0, 0), b2, voffB);
            PG8_BAR; PG8_WAIT_L(0); PG8_MMA(0, 1, At, B1); PG8_BAR;
            PG8_LDA(At, 0, 1); PG8_STAGE(PG8_SA(0, 0), a2, voffA);
            PG8_BAR; PG8_WAIT_L(0); PG8_MMA(1, 0, At, B0); PG8_BAR; PG8_SCHED;
            PG8_STAGE(PG8_SB(0, 1), b2 + hstep, voffB);
            PG8_WAIT_V(6); PG8_BAR; PG8_MMA(1, 1, At, B1); PG8_BAR;
            PG8_LDB(B0, 1, 0); PG8_SCHED; PG8_LDA(At, 1, 0); PG8_STAGE(PG8_SA(0, 1), a2 + hstep, voffA);
            PG8_WAIT_L(8); PG8_BAR; PG8_WAIT_L(0); PG8_MMA(0, 0, At, B0); PG8_BAR; PG8_SCHED;
            PG8_LDB(B1, 1, 1); PG8_STAGE(PG8_SB(1, 0), b3, voffB);
            PG8_BAR; PG8_WAIT_L(0); PG8_MMA(0, 1, At, B1); PG8_BAR;
            PG8_LDA(At, 1, 1); PG8_STAGE(PG8_SA(1, 0), a3, voffA);
            PG8_BAR; PG8_WAIT_L(0); PG8_MMA(1, 0, At, B0); PG8_BAR; PG8_SCHED;
            PG8_STAGE(PG8_SB(1, 1), b3 + hstep, voffB);
            PG8_WAIT_V(6); PG8_BAR; PG8_MMA(1, 1, At, B1); PG8_BAR;
            }
        }
        if constexpr (ALIGN_EPI) { if (wr == 0) PG8_BAR; }
        if constexpr (!Epi::AFTER_DRAIN) { E(acc, cur, wr, wc, fr, fq); S.done(cur); }
        if (!has_next) break;
#pragma unroll
        for (int a = 0; a < 2; ++a)
#pragma unroll
            for (int b = 0; b < 2; ++b)
#pragma unroll
                for (int m = 0; m < 4; ++m)
#pragma unroll
                    for (int n = 0; n < 2; ++n) acc[a][b][m][n] = (f32x4){0.f, 0.f, 0.f, 0.f};
        cur = nxt; cA = nA; cB = nB; ++ui;
        if constexpr (ALIGN_EPI) { if (wr == 1) PG8_BAR; }
    }
    PG8_WAIT_V(0);
    if constexpr (!ALIGN_EPI) { if (wr == 0) PG8_BAR; }
    PG8_BAR;
    if constexpr (Epi::AFTER_DRAIN) { E.fused(acc, cur, wr, wc, fr, fq, lds, wid, lane); S.done(cur); }
#undef PG8_SA
#undef PG8_SB
#undef PG8_STAGE
#undef PG8_LDA
#undef PG8_LDB
#undef PG8_MMA
#undef PG8_WAIT_V
#undef PG8_WAIT_L
#undef PG8_BAR
#undef PG8_SCHED
}
}

#define LAS __attribute__((address_space(3)))
typedef pg8::bf16_t bf16_t;
typedef pg8::bf16x8 bf16x8;
typedef pg8::f32x4 f32x4;
typedef pg8::u32x4 u32x4;
typedef unsigned u32x2 __attribute__((ext_vector_type(2)));
typedef float f32x2v __attribute__((ext_vector_type(2)));
using pg8::cvt_pk_bf16;
using pg8::fast_sigmoid;
using pg8::fast_silu;

constexpr int D = 1024, NB = 4, SEQ = 8192, NTOK = NB * SEQ;
#ifndef MK_NSPLIT
#define MK_NSPLIT 4
#endif
constexpr int NSPLIT = MK_NSPLIT, TS = SEQ / NSPLIT, MS = NB * TS;
constexpr int CL = 9728;
constexpr int C_R = 0, C_K = 1024, C_V = 2048, C_WLO = 3072, C_ALO = 3136, C_GLO = 3200, C_HQ = 3584, C_HF = 4608, C_HI = 5632, C_HG = 6656, C_GA = 7680, C_GB = 8704;
constexpr int CARRY_LD = 3584;
constexpr int DFF = 2816;
constexpr size_t MiB = 1u << 20, KiB = 1u << 10;
constexpr size_t WS_WIN = 0, WS_WOUT = 19 * MiB, WS_WQ = 21 * MiB, WS_WO = 23 * MiB, WS_WKV = 25 * MiB, WS_W13 = 29 * MiB, WS_W2 = 40 * MiB;
constexpr size_t WS_RW2T = 46 * MiB, WS_RA2T = 46 * MiB + 128 * KiB, WS_RG2T = 46 * MiB + 256 * KiB, WS_CARRY = 46 * MiB + 640 * KiB, WS_LB = 46 * MiB + 704 * KiB;
constexpr size_t WS_MBF = 47 * MiB, WS_KV = 49 * MiB, WS_VT = 53 * MiB, WS_RWST = 55 * MiB, WS_HGST = 56 * MiB, WS_BONUS = 58 * MiB;
constexpr size_t WS_G2TP = 59 * MiB;
constexpr size_t WS_MERGED = 64 * MiB;
constexpr size_t WS_U1 = 128 * MiB, WS_COLS = 144 * MiB, WS_PR = 296 * MiB, WS_PK = 312 * MiB, WS_PA = 328 * MiB, WS_PB = 344 * MiB, WS_PV = 360 * MiB, WS_PW = 376 * MiB, WS_ORAW = 408 * MiB, WS_HGO = 440 * MiB;
constexpr size_t WS_GATE = 472 * MiB, WS_ASG = 488 * MiB;
constexpr size_t WS_U = 128 * MiB, WS_Q = 192 * MiB, WS_AO = 256 * MiB, WS_FF = 320 * MiB, WS_CTL = 496 * MiB, CTL_BYTES = 64 * KiB, WS_END = 496 * MiB + 64 * KiB;
constexpr int LDS_BYTES = 147456, MISC_OFF = 131072 + 320;
constexpr int T0 = 1 + 5 * NSPLIT, N_PHASES = T0 + 9;

__device__ __forceinline__ float bflo(unsigned u) { return __uint_as_float(u << 16); }
__device__ __forceinline__ float bfhi(unsigned u) { return __uint_as_float(u & 0xffff0000u); }
__device__ __forceinline__ unsigned f2bf(float f) { unsigned u = __float_as_uint(f); return (u + 0x7fffu + ((u >> 16) & 1u)) >> 16; }
__device__ __forceinline__ f32x4 ld4bf(const bf16_t* p) { const u32x2 u = *(const u32x2*)p; return (f32x4){bflo(u.x), bfhi(u.x), bflo(u.y), bfhi(u.y)}; }
__device__ __forceinline__ void ld8bf(const bf16_t* p, float (&o)[8]) { const u32x4 u = *(const u32x4*)p; o[0] = bflo(u.x); o[1] = bfhi(u.x); o[2] = bflo(u.y); o[3] = bfhi(u.y); o[4] = bflo(u.z); o[5] = bfhi(u.z); o[6] = bflo(u.w); o[7] = bfhi(u.w); }
__device__ __forceinline__ void st4bf(bf16_t* p, f32x4 v) { u32x2 w; w.x = cvt_pk_bf16(v[0], v[1]); w.y = cvt_pk_bf16(v[2], v[3]); *(u32x2*)p = w; }
__device__ __forceinline__ bf16x8 pack8(const float (&t)[8]) { u32x4 w; w.x = cvt_pk_bf16(t[0], t[1]); w.y = cvt_pk_bf16(t[2], t[3]); w.z = cvt_pk_bf16(t[4], t[5]); w.w = cvt_pk_bf16(t[6], t[7]); return __builtin_bit_cast(bf16x8, w); }
__device__ __forceinline__ float tanh_fast(float x) { return 1.0f - 2.0f * __builtin_amdgcn_rcpf(1.0f + __expf(2.0f * x)); }
__device__ __forceinline__ float wave_sum(float v) {
#pragma unroll
    for (int o = 1; o < 64; o <<= 1) v += __shfl_xor(v, o);
    return v;
}
__device__ __forceinline__ float fq_sum(float v) { v += __shfl_xor(v, 16); v += __shfl_xor(v, 32); return v; }
template <int CTRL> __device__ __forceinline__ float dpp_add(float x) { return x + __builtin_bit_cast(float, __builtin_amdgcn_update_dpp(0, __builtin_bit_cast(int, x), CTRL, 0xf, 0xf, false)); }
#ifdef MK_SHFL_REDUCE
__device__ __forceinline__ float allreduce16(float x) { x += __shfl_xor(x, 1); x += __shfl_xor(x, 2); x += __shfl_xor(x, 4); x += __shfl_xor(x, 8); return x; }
#else
__device__ __forceinline__ float allreduce16(float x) { x = dpp_add<0xB1>(x); x = dpp_add<0x4E>(x); x = dpp_add<0x141>(x); x = dpp_add<0x140>(x); return x; }
#endif
__device__ __forceinline__ void allreduce16x2(float& x, float& y) {
    x = dpp_add<0xB1>(x); y = dpp_add<0xB1>(y); x = dpp_add<0x4E>(x); y = dpp_add<0x4E>(y); x = dpp_add<0x141>(x); y = dpp_add<0x141>(y); x = dpp_add<0x140>(x); y = dpp_add<0x140>(y); }
#define MFMA16(a, b, c) __builtin_amdgcn_mfma_f32_16x16x32_bf16((a), (b), (c), 0, 0, 0)

#define XB_TMO      128
#define XB_XCNT(j)  (256  + 64 * (j))
#define XB_XSUB(j)  (1280 + 64 * (j))
#define XB_XGEN(j)  (2304 + 64 * (j))
#define XB_TOP      3328
#define XB_TOPGEN   3392
#define XCD_BAR_WORDS 3456
#define XB_SPIN_CAP (1u << 18)

__device__ __forceinline__ unsigned xb_ld(unsigned* p)              { return __hip_atomic_load(p, __ATOMIC_RELAXED, __HIP_MEMORY_SCOPE_AGENT); }
__device__ __forceinline__ unsigned xb_add(unsigned* p, unsigned v) { return __hip_atomic_fetch_add(p, v, __ATOMIC_RELAXED, __HIP_MEMORY_SCOPE_AGENT); }
__device__ __forceinline__ unsigned xb_xcc_id() { return (unsigned)__builtin_amdgcn_s_getreg((3 << 11) | 20) & 0xFu; }
#define XB_SPIN(cond, bar) do { unsigned _sp = 0; while (cond) { __builtin_amdgcn_s_sleep(1); \
    if ((++_sp & 255u) == 0u) { if (xb_ld(&(bar)[XB_TMO])) break; if (_sp > XB_SPIN_CAP) { atomicAdd(&(bar)[XB_TMO], 1u); break; } } } } while (0)

struct XcdBarrier {
    unsigned* bar; unsigned x;
    volatile LAS unsigned* st;
};

__device__ __forceinline__ XcdBarrier xcd_barrier_post(unsigned* bar, volatile LAS unsigned* st) {
    XcdBarrier b; b.bar = bar; b.x = xb_xcc_id(); b.st = st;
    if (threadIdx.x == 0) (void)xb_add(&bar[XB_XCNT(b.x)], 1u);
    return b;
}
__device__ __forceinline__ void xcd_barrier_complete(unsigned* bar, unsigned x, unsigned& nloc, unsigned& nx) {
    const unsigned G = gridDim.x * gridDim.y * gridDim.z;
    unsigned sum, cnt, mine, sp = 0u;
    for (;;) {
        sum = 0u; cnt = 0u; mine = 0u;
#pragma unroll
        for (unsigned j = 0; j < 16; ++j) { const unsigned c = xb_ld(&bar[XB_XCNT(j)]); sum += c; cnt += (c > 0u) ? 1u : 0u; mine = (j == x) ? c : mine; }
        if (sum == G) break;
        __builtin_amdgcn_s_sleep(1);
        if ((++sp & 255u) == 0u) { if (xb_ld(&bar[XB_TMO])) break; if (sp > XB_SPIN_CAP) { atomicAdd(&bar[XB_TMO], 1u); break; } }
    }
    nloc = mine > 0u ? mine : 1u; nx = cnt > 0u ? cnt : 1u;
}

__device__ __forceinline__ void xcd_barrier(const XcdBarrier& b) {
    asm volatile("s_waitcnt vmcnt(0)" ::: "memory");
    __syncthreads();
    if (threadIdx.x == 0) {
        unsigned* bar = b.bar;
        __builtin_amdgcn_s_waitcnt(0);
        unsigned nloc = b.st[0], nx = b.st[1];
        if (nloc == 0u) { xcd_barrier_complete(bar, b.x, nloc, nx); b.st[0] = nloc; b.st[1] = nx; }
        const unsigned old = xb_add(&bar[XB_XSUB(b.x)], 1u);
        const unsigned gen = old / nloc;
        if (old + 1u == (gen + 1u) * nloc) {
            __builtin_amdgcn_fence(__ATOMIC_RELEASE, "agent");
            asm volatile("s_waitcnt vmcnt(0)" ::: "memory");
            const unsigned og = xb_add(&bar[XB_TOP], 1u);
            const unsigned tg = og / nx;
            if (og + 1u == (tg + 1u) * nx) xb_add(&bar[XB_TOPGEN], 1u);
            else XB_SPIN(xb_ld(&bar[XB_TOPGEN]) == tg, bar);
            __builtin_amdgcn_fence(__ATOMIC_ACQUIRE, "agent");
            xb_add(&bar[XB_XGEN(b.x)], 1u);
            asm volatile("s_waitcnt vmcnt(0)" ::: "memory");
        } else {
            XB_SPIN(xb_ld(&bar[XB_XGEN(b.x)]) == gen, bar);
            __builtin_amdgcn_fence(__ATOMIC_ACQUIRE, "agent");
            asm volatile("s_waitcnt vmcnt(0)" ::: "memory");
        }
    }
    __syncthreads();
}

__device__ __forceinline__ void rms_row_bf16(const float* src, const float* g, bf16_t* dst, int lane) {
    f32x4 v[4]; float s = 0.f;
#pragma unroll
    for (int j = 0; j < 4; ++j) { v[j] = ((const f32x4*)src)[lane + 64 * j]; s += (v[j][0] * v[j][0] + v[j][1] * v[j][1]) + (v[j][2] * v[j][2] + v[j][3] * v[j][3]); }
    const float rs = 1.0f / sqrtf(wave_sum(s) * (1.0f / 1024.0f) + 1e-6f);
#pragma unroll
    for (int j = 0; j < 4; ++j) { const f32x4 gv = ((const f32x4*)g)[lane + 64 * j]; st4bf(dst + 4 * (lane + 64 * j), v[j] * rs * gv); }
}
__device__ __forceinline__ void tr_item(const float* W, int K, int N, bf16_t* WT, int kb, int n0, int row_base, LAS float* scr, int lane) {
    const int k0 = 64 * kb;
#pragma unroll 8
    for (int i = 0; i < 32; ++i) { const int kk = 2 * i + (lane >> 5); scr[kk * 33 + (lane & 31)] = W[(size_t)(k0 + kk) * N + n0 + (lane & 31)]; }
    asm volatile("s_waitcnt lgkmcnt(0)" ::: "memory");
    const int c = lane & 7;
#pragma unroll
    for (int j = 0; j < 4; ++j) { const int n = (lane >> 3) + 8 * j; const LAS float* sp = scr + (8 * c) * 33 + n;
        u32x4 o; o.x = cvt_pk_bf16(sp[0 * 33], sp[1 * 33]); o.y = cvt_pk_bf16(sp[2 * 33], sp[3 * 33]); o.z = cvt_pk_bf16(sp[4 * 33], sp[5 * 33]); o.w = cvt_pk_bf16(sp[6 * 33], sp[7 * 33]);
        *(u32x4*)(WT + (size_t)(row_base + n) * K + k0 + 8 * c) = o; }
    asm volatile("s_waitcnt lgkmcnt(0)" ::: "memory");
}

__device__ __forceinline__ void prep_phase(int s, int gw, int NGW, int lane, const bf16_t* cols, const bf16_t* carry,
        const float* mu, const float* w0, const float* a0, const float* k_k, const float* k_a, const float* r_k,
        const bf16_t* w2T, const bf16_t* a2T, bf16_t* PR, bf16_t* PK, bf16_t* PA, bf16_t* PB, bf16_t* PV, float* PW, float* bonus, bf16_t* ASG) {
    const int fr = lane & 15, fq = lane >> 4;
    for (int item = gw; item < (MS / 16) * 4; item += NGW) {
        const int tile = item >> 2, hg4 = item & 3;
        const int lt = tile * 16 + fr, b = lt / TS, tl = lt % TS;
        const bf16_t* crow = cols + (size_t)lt * CL;
        const bf16_t* prow = tl > 0 ? crow - CL : carry + ((s & 1) * 4 + b) * CARRY_LD;
        bf16x8 Aw[2], Aa[2];
#pragma unroll
        for (int ks = 0; ks < 2; ++ks) {
            { const int c = C_WLO + ks * 32 + fq * 8; float cur[8], prv[8], t[8]; ld8bf(crow + c, cur); ld8bf(prow + c, prv);
              const f32x4 m0 = *(const f32x4*)(mu + c), m1 = *(const f32x4*)(mu + c + 4);
#pragma unroll
              for (int e = 0; e < 8; ++e) { const float mm = e < 4 ? m0[e & 3] : m1[e & 3]; t[e] = tanh_fast(cur[e] + mm * (prv[e] - cur[e])); }
              Aw[ks] = pack8(t); }
            { const int c = C_ALO + ks * 32 + fq * 8; float cur[8], prv[8], t[8]; ld8bf(crow + c, cur); ld8bf(prow + c, prv);
              const f32x4 m0 = *(const f32x4*)(mu + c), m1 = *(const f32x4*)(mu + c + 4);
#pragma unroll
              for (int e = 0; e < 8; ++e) { const float mm = e < 4 ? m0[e & 3] : m1[e & 3]; t[e] = cur[e] + mm * (prv[e] - cur[e]); }
              Aa[ks] = pack8(t); }
        }
        if (hg4 == 0) {
#pragma unroll
            for (int ks = 0; ks < 5; ++ks) { const int c = C_GLO + ks * 32 + fq * 8; float cur[8], prv[8], t[8]; ld8bf(crow + c, cur); ld8bf(prow + c, prv);
                const f32x4 m0 = *(const f32x4*)(mu + c), m1 = *(const f32x4*)(mu + c + 4);
#pragma unroll
                for (int e = 0; e < 8; ++e) { const float mm = e < 4 ? m0[e & 3] : m1[e & 3]; t[e] = fast_sigmoid(cur[e] + mm * (prv[e] - cur[e])); }
                *(bf16x8*)(ASG + (size_t)lt * 256 + ks * 32 + fq * 8) = pack8(t); }
#pragma unroll
            for (int ks = 5; ks < 8; ++ks) *(u32x4*)(ASG + (size_t)lt * 256 + ks * 32 + fq * 8) = (u32x4){0u, 0u, 0u, 0u};
        }
#pragma unroll 1
        for (int hh = 0; hh < 4; ++hh) {
            const int h = hg4 * 4 + hh;
            f32x4 aw[4], aa[4];
#pragma unroll
            for (int nt = 0; nt < 4; ++nt) { aw[nt] = (f32x4){0.f, 0.f, 0.f, 0.f}; aa[nt] = (f32x4){0.f, 0.f, 0.f, 0.f};
                const int n = h * 64 + nt * 16 + fr;
#pragma unroll
                for (int ks = 0; ks < 2; ++ks) { const bf16x8 bw = *(const bf16x8*)(w2T + n * 64 + ks * 32 + fq * 8); aw[nt] = MFMA16(bw, Aw[ks], aw[nt]);
                    const bf16x8 ba = *(const bf16x8*)(a2T + n * 64 + ks * 32 + fq * 8); aa[nt] = MFMA16(ba, Aa[ks], aa[nt]); } }
            f32x4 kkv[4], av[4]; float ssq = 0.f, bon = 0.f;
#pragma unroll
            for (int nt = 0; nt < 4; ++nt) {
                const int c = h * 64 + nt * 16 + 4 * fq; const size_t o = (size_t)lt * 1024 + c;
                const f32x4 rc = ld4bf(crow + C_R + c), rp = ld4bf(prow + C_R + c), kc = ld4bf(crow + C_K + c), kp = ld4bf(prow + C_K + c), vc = ld4bf(crow + C_V + c), vp = ld4bf(prow + C_V + c);
                const f32x4 r = rc + *(const f32x4*)(mu + C_R + c) * (rp - rc), k = kc + *(const f32x4*)(mu + C_K + c) * (kp - kc), v = vc + *(const f32x4*)(mu + C_V + c) * (vp - vc);
                const f32x4 w0v = *(const f32x4*)(w0 + c), a0v = *(const f32x4*)(a0 + c), kkp = *(const f32x4*)(k_k + c), kap = *(const f32x4*)(k_a + c), rkp = *(const f32x4*)(r_k + c);
                f32x4 wv, a, kk, kmod;
#pragma unroll
                for (int j = 0; j < 4; ++j) {
                    const float z = -(w0v[j] + aw[nt][j]);
                    const float sp = fmaxf(z, 0.f) + __logf(1.0f + __expf(-fabsf(z)));
                    wv[j] = __expf(-__expf(-sp - 0.5f));
                    a[j] = fast_sigmoid(a0v[j] + aa[nt][j]);
                    kk[j] = k[j] * kkp[j]; kmod[j] = k[j] * (1.0f + (a[j] - 1.0f) * kap[j]);
                    ssq += kk[j] * kk[j]; bon += r[j] * kmod[j] * rkp[j];
                }
                kkv[nt] = kk; av[nt] = a;
                st4bf(PR + o, r); st4bf(PK + o, kmod); st4bf(PV + o, v); *(f32x4*)(PW + o) = wv;
            }
            ssq = fq_sum(ssq); bon = fq_sum(bon);
            const float rs = 1.0f / sqrtf(fmaxf(ssq, 1e-24f));
#pragma unroll
            for (int nt = 0; nt < 4; ++nt) { const int c = h * 64 + nt * 16 + 4 * fq; const size_t o = (size_t)lt * 1024 + c;
                const f32x4 kn = kkv[nt] * rs; st4bf(PA + o, -kn); st4bf(PB + o, kn * av[nt]); }
            if (fq == 0) bonus[lt * 16 + h] = bon;
        }
    }
}

__device__ __forceinline__ void post_phase(int s, int gw, int NGW, int lane, const bf16_t* cols, const bf16_t* carry, const float* mu, const bf16_t* gate,
        const float* ln_w, const float* ln_b, const float* hg_g, const float* oraw, const float* hgo, const bf16_t* PV, const float* bonus, bf16_t* merged) {
    const int fr = lane & 15, fq = lane >> 4;
    for (int item = gw; item < (MS / 16) * 4; item += NGW) {
        const int tile = item >> 2, q4 = item & 3;
        const int lt = tile * 16 + fr, b = lt / TS, tl = lt % TS;
        const size_t gt = (size_t)b * SEQ + s * TS + tl;
        const bf16_t* crow = cols + (size_t)lt * CL;
        const bf16_t* prow = tl > 0 ? crow - CL : carry + ((s & 1) * 4 + b) * CARRY_LD;
#pragma unroll 1
        for (int hgh = 0; hgh < 2; ++hgh) {
            const int h8 = q4 * 2 + hgh;
            f32x4 ho[8]; float ss = 0.f;
#pragma unroll
            for (int n8 = 0; n8 < 8; ++n8) { ho[n8] = *(const f32x4*)(hgo + ((size_t)((b * 8 + h8) * 8 + n8) * TS + tl) * 16 + 4 * fq); ss += (ho[n8][0] * ho[n8][0] + ho[n8][1] * ho[n8][1]) + (ho[n8][2] * ho[n8][2] + ho[n8][3] * ho[n8][3]); }
            ss = fq_sum(ss);
            const float rsh = 1.0f / sqrtf(ss * (1.0f / 128.0f) + 1e-6f);
#pragma unroll
            for (int rwh = 0; rwh < 2; ++rwh) {
                const int h = q4 * 4 + hgh * 2 + rwh;
                f32x4 ag[4], o[4]; float sm = 0.f;
#pragma unroll
                for (int nt = 0; nt < 4; ++nt) { ag[nt] = ld4bf(gate + (size_t)lt * 1024 + h * 64 + nt * 16 + 4 * fq);
                    o[nt] = *(const f32x4*)(oraw + ((size_t)((b * 16 + h) * 4 + nt) * TS + tl) * 16 + 4 * fq); sm += (o[nt][0] + o[nt][1]) + (o[nt][2] + o[nt][3]); }
                const float mean = fq_sum(sm) * (1.0f / 64.0f); float vq = 0.f;
#pragma unroll
                for (int nt = 0; nt < 4; ++nt) { o[nt] = o[nt] - mean; vq += (o[nt][0] * o[nt][0] + o[nt][1] * o[nt][1]) + (o[nt][2] * o[nt][2] + o[nt][3] * o[nt][3]); }
                const float rstd = 1.0f / sqrtf(fq_sum(vq) * (1.0f / 64.0f) + 64e-5f);
#ifdef MK_NO_BONUS
                const float bon = 0.f;
#else
                const float bon = bonus[lt * 16 + h];
#endif
#pragma unroll
                for (int nt = 0; nt < 4; ++nt) {
                    const int c = h * 64 + nt * 16 + 4 * fq;
                    const f32x4 lw = *(const f32x4*)(ln_w + c), lb = *(const f32x4*)(ln_b + c), v = ld4bf(PV + (size_t)lt * 1024 + c);
                    const f32x4 ya = (o[nt] * rstd * lw + lb + v * bon) * ag[nt];
                    const f32x4 ng = *(const f32x4*)(hg_g + (c & 127)), gh = ld4bf(crow + C_HG + c), gar = ld4bf(crow + C_GA + c), gbr = ld4bf(crow + C_GB + c);
                    const f32x4 hv = ho[rwh * 4 + nt] * rsh * ng;
                    f32x4 m;
#pragma unroll
                    for (int j = 0; j < 4; ++j) {
#if defined(MK_ZERO_YA)
                        m[j] = fast_sigmoid(gbr[j]) * (hv[j] * fast_silu(gh[j]));
#elif defined(MK_ZERO_YB)
                        m[j] = fast_sigmoid(gar[j]) * ya[j];
#else
                        m[j] = gar[j] * ya[j] + gbr[j] * (hv[j] * gh[j]);
#endif
                    }
                    st4bf(merged + gt * 1024 + c, m);
                }
            }
        }
    }
}

constexpr int RWB = 45056;
#define SCAN_BAR_L() do { asm volatile("s_waitcnt vmcnt(0) lgkmcnt(0)" ::: "memory"); __builtin_amdgcn_s_barrier(); asm volatile("" ::: "memory"); } while (0)
#define SCAN_BAR_S() do { asm volatile("s_waitcnt lgkmcnt(0)" ::: "memory"); __builtin_amdgcn_s_barrier(); asm volatile("" ::: "memory"); } while (0)
__device__ __forceinline__ void rw_load(LAS unsigned char* bp, int lt2, size_t ltok0, int h, int rg, const bf16_t* PA, const float* PW, const bf16_t* PB, const bf16_t* PK, const bf16_t* PR, const bf16_t* PV) {
    const int tok = lt2 >> 3, c8 = (lt2 & 7) * 8; const size_t base = (ltok0 + tok) * 1024 + h * 64 + c8;
    const u32x4 ra = *(const u32x4*)(PA + base), rb = *(const u32x4*)(PB + base), rk = *(const u32x4*)(PK + base), rr = *(const u32x4*)(PR + base);
    const f32x4 w0 = *(const f32x4*)(PW + base), w1 = *(const f32x4*)(PW + base + 4);
    const unsigned rv = *(const unsigned*)(PV + (ltok0 + tok) * 1024 + h * 64 + rg * 16 + (lt2 & 7) * 2);
    const int off = (tok * 64 + c8) * 4;
#define RW_PUT(arr, u) do { *(LAS f32x4*)(bp + (arr) * 8192 + off) = (f32x4){bflo(u.x), bfhi(u.x), bflo(u.y), bfhi(u.y)}; *(LAS f32x4*)(bp + (arr) * 8192 + off + 16) = (f32x4){bflo(u.z), bfhi(u.z), bflo(u.w), bfhi(u.w)}; } while (0)
    RW_PUT(0, ra); RW_PUT(2, rb); RW_PUT(3, rk); RW_PUT(4, rr);
#undef RW_PUT
    *(LAS f32x4*)(bp + 8192 + off) = w0; *(LAS f32x4*)(bp + 8192 + off + 16) = w1;
    *(LAS f32x2v*)(bp + 40960 + (tok * 16 + (lt2 & 7) * 2) * 4) = (f32x2v){bflo(rv), bfhi(rv)};
}
__device__ __forceinline__ void y_drain(const LAS unsigned char* ybase, int lt2, float* dst) { *(f32x2v*)(dst + lt2 * 2) = *(const LAS f32x2v*)(ybase + lt2 * 8); }
__device__ __forceinline__ void rwkv_scan(int s, int bid, int G, int tid, int lane, int wave, LAS unsigned char* lds,
        const bf16_t* PA, const float* PW, const bf16_t* PB, const bf16_t* PK, const bf16_t* PR, const bf16_t* PV, float* oraw, float* state, bool save) {
    constexpr int NBLK = TS / 32;
    const int rowl = lane >> 4, j = lane & 15, row = (wave & 3) * 4 + rowl;
    for (int it = bid; it < 256; it += G) {
        const int b = it >> 6, h = (it >> 2) & 15, rg = it & 3;
        const size_t tok0 = (size_t)b * TS;
        float* stp = state + ((size_t)((b * 16 + h) * 64 + rg * 16 + row) * 64 + 4 * j);
        float* obase = oraw + (size_t)it * TS * 16;
        f32x4 st = (f32x4){0.f, 0.f, 0.f, 0.f};
        if (wave < 4 && s > 0) st = *(const f32x4*)stp;
        if (wave >= 4) { rw_load(lds, tid - 256, tok0, h, rg, PA, PW, PB, PK, PR, PV); SCAN_BAR_L(); } else { __builtin_amdgcn_s_setprio(2); asm volatile("s_waitcnt vmcnt(0)" ::: "memory"); SCAN_BAR_S(); }
#pragma unroll 1
        for (int blk = 0; blk < NBLK; ++blk) {
            if (wave >= 4) {
                if (blk > 0) y_drain(lds + ((blk - 1) & 1) * RWB + 43008, tid - 256, obase + (size_t)(blk - 1) * 512);
                if (blk + 1 < NBLK) rw_load(lds + ((blk + 1) & 1) * RWB, tid - 256, tok0 + (blk + 1) * 32, h, rg, PA, PW, PB, PK, PR, PV);
                SCAN_BAR_L();
            } else {
                const LAS unsigned char* bp = lds + (blk & 1) * RWB;
                const LAS unsigned char* p4 = bp + 16 * j; const LAS unsigned char* pv = bp + 40960 + row * 4; LAS unsigned char* py = (LAS unsigned char*)bp + 43008 + row * 4;
                f32x4 a4 = *(const LAS f32x4*)(p4), w4 = *(const LAS f32x4*)(p4 + 8192), b4 = *(const LAS f32x4*)(p4 + 16384), k4 = *(const LAS f32x4*)(p4 + 24576), r4 = *(const LAS f32x4*)(p4 + 32768);
                float vv = *(const LAS float*)(pv);
                float sa = (st[0] * a4[0] + st[1] * a4[1]) + (st[2] * a4[2] + st[3] * a4[3]);
                sa = allreduce16(sa);
#pragma unroll
                for (int t = 0; t < 32; ++t) {
                    f32x4 na = a4, nw = w4, nb = b4, nk = k4, nr = r4; float nv = vv;
                    if (t < 31) { const int o = (t + 1) * 256; na = *(const LAS f32x4*)(p4 + o); nw = *(const LAS f32x4*)(p4 + 8192 + o); nb = *(const LAS f32x4*)(p4 + 16384 + o); nk = *(const LAS f32x4*)(p4 + 24576 + o); nr = *(const LAS f32x4*)(p4 + 32768 + o); nv = *(const LAS float*)(pv + (t + 1) * 64); }
                    st = st * w4 + (b4 * sa + k4 * vv);
                    float y = (st[0] * r4[0] + st[1] * r4[1]) + (st[2] * r4[2] + st[3] * r4[3]);
                    float sn = (st[0] * na[0] + st[1] * na[1]) + (st[2] * na[2] + st[3] * na[3]);
                    allreduce16x2(sn, y);
                    if (j == 0) *(LAS float*)(py + t * 64) = y;
                    sa = sn; a4 = na; w4 = nw; b4 = nb; k4 = nk; r4 = nr; vv = nv;
                }
                SCAN_BAR_S();
            }
        }
        if (wave >= 4) { y_drain(lds + ((NBLK - 1) & 1) * RWB + 43008, tid - 256, obase + (size_t)(NBLK - 1) * 512); }
        else { __builtin_amdgcn_s_setprio(0); if (save) *(f32x4*)stp = st; }
    }
}

__device__ __forceinline__ void rwkv_scan_naive(int s, int gw, int NGW, int lane, int wave, LAS unsigned char* lds,
        const bf16_t* PA, const float* PW, const bf16_t* PB, const bf16_t* PK, const bf16_t* PR, const bf16_t* PV, float* oraw, float* state) {
    LAS float* slab = (LAS float*)(lds + wave * 2048);
    for (int it = gw; it < 64; it += NGW) {
        const int b = it >> 4, h = it & 15;
        float st[64];
        float* stp = state + (size_t)((b * 16 + h) * 64 + lane) * 64;
#pragma unroll
        for (int k = 0; k < 64; ++k) st[k] = (s > 0) ? stp[k] : 0.f;
        for (int tl = 0; tl < TS; ++tl) {
            const size_t base = ((size_t)b * TS + tl) * 1024 + h * 64 + lane;
            slab[lane] = bflo((unsigned)PA[base]); slab[64 + lane] = PW[base]; slab[128 + lane] = bflo((unsigned)PB[base]); slab[192 + lane] = bflo((unsigned)PK[base]); slab[256 + lane] = bflo((unsigned)PR[base]);
            const float vv = bflo((unsigned)PV[base]);
            asm volatile("s_waitcnt lgkmcnt(0)" ::: "memory");
            float sa = 0.f;
#pragma unroll
            for (int k = 0; k < 64; ++k) sa += st[k] * slab[k];
            float y = 0.f;
#pragma unroll
            for (int k = 0; k < 64; ++k) { st[k] = st[k] * slab[64 + k] + (sa * slab[128 + k] + vv * slab[192 + k]); y += st[k] * slab[256 + k]; }
            asm volatile("s_waitcnt lgkmcnt(0)" ::: "memory");
            oraw[((size_t)(it * 4 + (lane >> 4)) * TS + tl) * 16 + (lane & 15)] = y;
        }
#pragma unroll
        for (int k = 0; k < 64; ++k) stp[k] = st[k];
    }
}
constexpr int HGB = 53248;
__device__ __forceinline__ void hg_load(LAS unsigned char* bp, int lt2, size_t ltok0, int h8, int rg, const bf16_t* cols, const float* lbv) {
    const int tok = lt2 >> 3, c16 = (lt2 & 7) * 16; const bf16_t* crow = cols + (ltok0 + tok) * CL;
    float q[16], f[16];
    { float t[8]; ld8bf(crow + C_HQ + h8 * 128 + c16, t);
#pragma unroll
      for (int e = 0; e < 8; ++e) q[e] = t[e];
      ld8bf(crow + C_HQ + h8 * 128 + c16 + 8, t);
#pragma unroll
      for (int e = 0; e < 8; ++e) q[8 + e] = t[e];
      ld8bf(crow + C_HF + h8 * 128 + c16, t);
#pragma unroll
      for (int e = 0; e < 8; ++e) f[e] = t[e];
      ld8bf(crow + C_HF + h8 * 128 + c16 + 8, t);
#pragma unroll
      for (int e = 0; e < 8; ++e) f[8 + e] = t[e]; }
    const unsigned rv = *(const unsigned*)(crow + C_HI + h8 * 128 + rg * 16 + (lt2 & 7) * 2);
    const int off = (tok * 128 + c16) * 4;
#pragma unroll
    for (int g = 0; g < 4; ++g) { const f32x4 lb = *(const f32x4*)(lbv + h8 * 128 + c16 + 4 * g); f32x4 fv, kv, qv;
#pragma unroll
        for (int e = 0; e < 4; ++e) { fv[e] = lb[e] + (1.0f - lb[e]) * fast_sigmoid(f[4 * g + e]); kv[e] = 1.0f - fv[e]; qv[e] = fast_silu(q[4 * g + e]); }
        *(LAS f32x4*)(bp + off + 16 * g) = fv; *(LAS f32x4*)(bp + 16384 + off + 16 * g) = kv; *(LAS f32x4*)(bp + 32768 + off + 16 * g) = qv; }
    *(LAS f32x2v*)(bp + 49152 + (tok * 16 + (lt2 & 7) * 2) * 4) = (f32x2v){bflo(rv), bfhi(rv)};
}
__device__ __forceinline__ void hgrn_scan(int s, int bid, int G, int tid, int lane, int wave, LAS unsigned char* lds, const bf16_t* cols, const float* lbv, float* hgo, float* state, bool save) {
    constexpr int NBLK = TS / 32;
    const int rowl = lane >> 4, j = lane & 15, row = (wave & 3) * 4 + rowl;
    for (int it = bid; it < 256; it += G) {
        const int b = it >> 6, h8 = (it >> 3) & 7, rg = it & 7;
        const size_t tok0 = (size_t)b * TS;
        float* stp = state + ((size_t)((b * 8 + h8) * 128 + rg * 16 + row) * 128 + 4 * j);
        float* obase = hgo + (size_t)it * TS * 16;
        f32x4 s0 = (f32x4){0.f, 0.f, 0.f, 0.f}, s1 = s0;
        if (wave < 4 && s > 0) { s0 = *(const f32x4*)stp; s1 = *(const f32x4*)(stp + 64); }
        if (wave >= 4) { hg_load(lds, tid - 256, tok0, h8, rg, cols, lbv); SCAN_BAR_L(); } else { __builtin_amdgcn_s_setprio(2); asm volatile("s_waitcnt vmcnt(0)" ::: "memory"); SCAN_BAR_S(); }
#pragma unroll 1
        for (int blk = 0; blk < NBLK; ++blk) {
            if (wave >= 4) {
                if (blk > 0) y_drain(lds + ((blk - 1) & 1) * HGB + 51200, tid - 256, obase + (size_t)(blk - 1) * 512);
                if (blk + 1 < NBLK) hg_load(lds + ((blk + 1) & 1) * HGB, tid - 256, tok0 + (blk + 1) * 32, h8, rg, cols, lbv);
                SCAN_BAR_L();
            } else {
                const LAS unsigned char* bp = lds + (blk & 1) * HGB;
                const LAS unsigned char* p4 = bp + 16 * j; const LAS unsigned char* pv = bp + 49152 + row * 4; LAS unsigned char* py = (LAS unsigned char*)bp + 51200 + row * 4;
                f32x4 f0 = *(const LAS f32x4*)(p4), f1 = *(const LAS f32x4*)(p4 + 256), k0 = *(const LAS f32x4*)(p4 + 16384), k1 = *(const LAS f32x4*)(p4 + 16384 + 256), q0 = *(const LAS f32x4*)(p4 + 32768), q1 = *(const LAS f32x4*)(p4 + 32768 + 256);
                float iv = *(const LAS float*)(pv); float yprev = 0.f;
#pragma unroll
                for (int t = 0; t < 32; ++t) {
                    f32x4 nf0 = f0, nf1 = f1, nk0 = k0, nk1 = k1, nq0 = q0, nq1 = q1; float niv = iv;
                    if (t < 31) { const int o = (t + 1) * 512; nf0 = *(const LAS f32x4*)(p4 + o); nf1 = *(const LAS f32x4*)(p4 + 256 + o); nk0 = *(const LAS f32x4*)(p4 + 16384 + o); nk1 = *(const LAS f32x4*)(p4 + 16384 + 256 + o);
                                  nq0 = *(const LAS f32x4*)(p4 + 32768 + o); nq1 = *(const LAS f32x4*)(p4 + 32768 + 256 + o); niv = *(const LAS float*)(pv + (t + 1) * 64); }
                    s0 = s0 * f0 + k0 * iv; s1 = s1 * f1 + k1 * iv;
                    float y = ((s0[0] * q0[0] + s0[1] * q0[1]) + (s0[2] * q0[2] + s0[3] * q0[3])) + ((s1[0] * q1[0] + s1[1] * q1[1]) + (s1[2] * q1[2] + s1[3] * q1[3]));
                    if (t & 1) { allreduce16x2(yprev, y); if (j == 0) { *(LAS float*)(py + (t - 1) * 64) = yprev; *(LAS float*)(py + t * 64) = y; } }
                    yprev = y;
                    f0 = nf0; f1 = nf1; k0 = nk0; k1 = nk1; q0 = nq0; q1 = nq1; iv = niv;
                }
                SCAN_BAR_S();
            }
        }
        if (wave >= 4) { y_drain(lds + ((NBLK - 1) & 1) * HGB + 51200, tid - 256, obase + (size_t)(NBLK - 1) * 512); }
        else { __builtin_amdgcn_s_setprio(0); if (save) { *(f32x4*)stp = s0; *(f32x4*)(stp + 64) = s1; } }
    }
}


constexpr int FT = 16;
constexpr int F_RW = 0, F_RWV = 20480, F_RWY = 21504, F_HG = 22528, F_HGQ = 8192, F_HGI = F_HG + 16384, F_HGY = F_HG + 17408, FBUF = 40960;
__device__ __forceinline__ void fused_load(LAS unsigned char* bp, int lt2, size_t ltok0, int h, int rg, int h8, int rg8, const bf16_t* PA, const float* PW, const bf16_t* PB, const bf16_t* PK, const bf16_t* PR, const bf16_t* PV,
        const bf16_t* cols, const float* lbv) {
    if (lt2 < 128) {
        const int tok = lt2 >> 3, c8 = (lt2 & 7) * 8; const size_t base = (ltok0 + tok) * 1024 + h * 64 + c8;
        const u32x4 ra = *(const u32x4*)(PA + base), rb = *(const u32x4*)(PB + base), rk = *(const u32x4*)(PK + base), rr = *(const u32x4*)(PR + base);
        const f32x4 w0 = *(const f32x4*)(PW + base), w1 = *(const f32x4*)(PW + base + 4);
        const unsigned rv = *(const unsigned*)(PV + (ltok0 + tok) * 1024 + h * 64 + rg * 16 + (lt2 & 7) * 2);
        const int off = (tok * 64 + c8) * 4;
#define RW_PUT(arr, u) do { *(LAS f32x4*)(bp + (arr) * 4096 + off) = (f32x4){bflo(u.x), bfhi(u.x), bflo(u.y), bfhi(u.y)}; *(LAS f32x4*)(bp + (arr) * 4096 + off + 16) = (f32x4){bflo(u.z), bfhi(u.z), bflo(u.w), bfhi(u.w)}; } while (0)
        RW_PUT(0, ra); RW_PUT(2, rb); RW_PUT(3, rk); RW_PUT(4, rr);
#undef RW_PUT
        *(LAS f32x4*)(bp + 4096 + off) = w0; *(LAS f32x4*)(bp + 4096 + off + 16) = w1;
        *(LAS f32x2v*)(bp + F_RWV + (tok * 16 + (lt2 & 7) * 2) * 4) = (f32x2v){bflo(rv), bfhi(rv)};
    } else {
        const int l = lt2 - 128, tok = l >> 3, c16 = (l & 7) * 16; const bf16_t* crow = cols + (ltok0 + tok) * CL;
        float q[16], f[16];
        { float t[8]; ld8bf(crow + C_HQ + h8 * 128 + c16, t);
#pragma unroll
          for (int e = 0; e < 8; ++e) q[e] = t[e];
          ld8bf(crow + C_HQ + h8 * 128 + c16 + 8, t);
#pragma unroll
          for (int e = 0; e < 8; ++e) q[8 + e] = t[e];
          ld8bf(crow + C_HF + h8 * 128 + c16, t);
#pragma unroll
          for (int e = 0; e < 8; ++e) f[e] = t[e];
          ld8bf(crow + C_HF + h8 * 128 + c16 + 8, t);
#pragma unroll
          for (int e = 0; e < 8; ++e) f[8 + e] = t[e]; }
        const unsigned rv = *(const unsigned*)(crow + C_HI + h8 * 128 + rg8 * 16 + (l & 7) * 2);
        LAS unsigned char* hp = bp + F_HG; const int off = (tok * 128 + c16) * 4;
#pragma unroll
        for (int g = 0; g < 4; ++g) { const f32x4 lb = *(const f32x4*)(lbv + h8 * 128 + c16 + 4 * g); f32x4 fv, qv;
#pragma unroll
            for (int e = 0; e < 4; ++e) { fv[e] = lb[e] + (1.0f - lb[e]) * f[4 * g + e]; qv[e] = q[4 * g + e]; }
            *(LAS f32x4*)(hp + off + 16 * g) = fv; *(LAS f32x4*)(hp + F_HGQ + off + 16 * g) = qv; }
        *(LAS f32x2v*)(bp + F_HGI + (tok * 16 + (l & 7) * 2) * 4) = (f32x2v){bflo(rv), bfhi(rv)};
    }
}
__device__ __forceinline__ void fused_drain(const LAS unsigned char* bp, int lt2, float* orw, float* ohg) {
    if (lt2 < 128) *(f32x2v*)(orw + lt2 * 2) = *(const LAS f32x2v*)(bp + F_RWY + lt2 * 8);
    else *(f32x2v*)(ohg + (lt2 - 128) * 2) = *(const LAS f32x2v*)(bp + F_HGY + (lt2 - 128) * 8);
}
__device__ __forceinline__ void fused_scan(int s, int bid, int G, int tid, int lane, int wave, LAS unsigned char* lds,
        const bf16_t* PA, const float* PW, const bf16_t* PB, const bf16_t* PK, const bf16_t* PR, const bf16_t* PV, const bf16_t* cols, const float* lbv,
        float* oraw, float* hgo, float* rwstate, float* hgstate, bool save) {
    constexpr int NBLK = TS / FT;
    const int rowl = lane >> 4, j = lane & 15, row = (wave & 3) * 4 + rowl;
    for (int it = bid; it < 256; it += G) {
        const int b = it >> 6, h = (it >> 2) & 15, rg = it & 3, h8 = (it >> 3) & 7, rg8 = it & 7;
        const size_t tok0 = (size_t)b * TS;
        float* stp = rwstate + ((size_t)((b * 16 + h) * 64 + rg * 16 + row) * 64 + 4 * j);
        float* shp = hgstate + ((size_t)((b * 8 + h8) * 128 + rg8 * 16 + row) * 128 + 4 * j);
        float* orw = oraw + (size_t)it * TS * 16; float* ohg = hgo + (size_t)it * TS * 16;
        f32x4 st = (f32x4){0.f, 0.f, 0.f, 0.f}, s0 = st, s1 = st;
        if (wave < 4 && s > 0) { st = *(const f32x4*)stp; s0 = *(const f32x4*)shp; s1 = *(const f32x4*)(shp + 64); }
        if (wave >= 4) { fused_load(lds, tid - 256, tok0, h, rg, h8, rg8, PA, PW, PB, PK, PR, PV, cols, lbv); SCAN_BAR_L(); } else { __builtin_amdgcn_s_setprio(2); asm volatile("s_waitcnt vmcnt(0)" ::: "memory"); SCAN_BAR_S(); }
#pragma unroll 1
        for (int blk = 0; blk < NBLK; ++blk) {
            if (wave >= 4) {
                if (blk > 0) fused_drain(lds + ((blk - 1) & 1) * FBUF, tid - 256, orw + (size_t)(blk - 1) * (FT * 16), ohg + (size_t)(blk - 1) * (FT * 16));
                if (blk + 1 < NBLK) fused_load(lds + ((blk + 1) & 1) * FBUF, tid - 256, tok0 + (blk + 1) * FT, h, rg, h8, rg8, PA, PW, PB, PK, PR, PV, cols, lbv);
                SCAN_BAR_L();
            } else {
                const LAS unsigned char* bp = lds + (blk & 1) * FBUF;
                const LAS unsigned char* p4 = bp + 16 * j; const LAS unsigned char* pv = bp + F_RWV + row * 4; LAS unsigned char* py = (LAS unsigned char*)bp + F_RWY + row * 4;
                const LAS unsigned char* g4 = bp + F_HG + 16 * j; const LAS unsigned char* gi = bp + F_HGI + row * 4; LAS unsigned char* gy = (LAS unsigned char*)bp + F_HGY + row * 4;
                f32x4 a4 = *(const LAS f32x4*)(p4), w4 = *(const LAS f32x4*)(p4 + 4096), b4 = *(const LAS f32x4*)(p4 + 8192), k4 = *(const LAS f32x4*)(p4 + 12288), r4 = *(const LAS f32x4*)(p4 + 16384);
                float vv = *(const LAS float*)(pv);
                f32x4 f0 = *(const LAS f32x4*)(g4), f1 = *(const LAS f32x4*)(g4 + 256), q0 = *(const LAS f32x4*)(g4 + F_HGQ), q1 = *(const LAS f32x4*)(g4 + F_HGQ + 256);
                float iv = *(const LAS float*)(gi);
                float sa = (st[0] * a4[0] + st[1] * a4[1]) + (st[2] * a4[2] + st[3] * a4[3]);
                sa = allreduce16(sa);
#pragma unroll
                for (int t = 0; t < FT; ++t) {
                    f32x4 na = a4, nw = w4, nb = b4, nk = k4, nr = r4; float nv = vv;
                    f32x4 nf0 = f0, nf1 = f1, nq0 = q0, nq1 = q1; float niv = iv;
                    if (t < FT - 1) { const int o = (t + 1) * 256; na = *(const LAS f32x4*)(p4 + o); nw = *(const LAS f32x4*)(p4 + 4096 + o); nb = *(const LAS f32x4*)(p4 + 8192 + o); nk = *(const LAS f32x4*)(p4 + 12288 + o); nr = *(const LAS f32x4*)(p4 + 16384 + o); nv = *(const LAS float*)(pv + (t + 1) * 64);
                        const int o2 = (t + 1) * 512; nf0 = *(const LAS f32x4*)(g4 + o2); nf1 = *(const LAS f32x4*)(g4 + 256 + o2);
                        nq0 = *(const LAS f32x4*)(g4 + F_HGQ + o2); nq1 = *(const LAS f32x4*)(g4 + F_HGQ + 256 + o2); niv = *(const LAS float*)(gi + (t + 1) * 64); }
                    st = st * w4 + (b4 * sa + k4 * vv);
                    s0 = (s0 - iv) * f0 + iv; s1 = (s1 - iv) * f1 + iv;
                    float y = (st[0] * r4[0] + st[1] * r4[1]) + (st[2] * r4[2] + st[3] * r4[3]);
                    float sn = (st[0] * na[0] + st[1] * na[1]) + (st[2] * na[2] + st[3] * na[3]);
                    float yh = ((s0[0] * q0[0] + s0[1] * q0[1]) + (s0[2] * q0[2] + s0[3] * q0[3])) + ((s1[0] * q1[0] + s1[1] * q1[1]) + (s1[2] * q1[2] + s1[3] * q1[3]));
                    sn = dpp_add<0xB1>(sn); y = dpp_add<0xB1>(y); yh = dpp_add<0xB1>(yh); sn = dpp_add<0x4E>(sn); y = dpp_add<0x4E>(y); yh = dpp_add<0x4E>(yh);
                    sn = dpp_add<0x141>(sn); y = dpp_add<0x141>(y); yh = dpp_add<0x141>(yh); sn = dpp_add<0x140>(sn); y = dpp_add<0x140>(y); yh = dpp_add<0x140>(yh);
                    if (j == 0) { *(LAS float*)(py + t * 64) = y; *(LAS float*)(gy + t * 64) = yh; }
                    sa = sn; a4 = na; w4 = nw; b4 = nb; k4 = nk; r4 = nr; vv = nv;
                    f0 = nf0; f1 = nf1; q0 = nq0; q1 = nq1; iv = niv;
                }
                SCAN_BAR_S();
            }
        }
        if (wave >= 4) fused_drain(lds + ((NBLK - 1) & 1) * FBUF, tid - 256, orw + (size_t)(NBLK - 1) * (FT * 16), ohg + (size_t)(NBLK - 1) * (FT * 16));
        else { __builtin_amdgcn_s_setprio(0); if (save) { *(f32x4*)stp = st; *(f32x4*)shp = s0; *(f32x4*)(shp + 64) = s1; } }
    }
}


constexpr int ST = 16;
constexpr int S_RWV = 20480, S_RWY = 22528, S_RWB = 24576;
constexpr int S_HGQ = 8192, S_HGI = 16384, S_HGY = 18432, S_HGB = 20480;
__device__ __forceinline__ void s_rw_load(LAS unsigned char* bp, int lt2, size_t ltok0, int h, int hf, const bf16_t* PA, const float* PW, const bf16_t* PB, const bf16_t* PK, const bf16_t* PR, const bf16_t* PV) {
    const int tok = lt2 >> 4, c4 = (lt2 & 15) * 4; const size_t base = (ltok0 + tok) * 1024 + h * 64 + c4;
    const f32x4 va = ld4bf(PA + base), vb = ld4bf(PB + base), vk = ld4bf(PK + base), vr = ld4bf(PR + base), vw = *(const f32x4*)(PW + base);
    const unsigned rv = *(const unsigned*)(PV + (ltok0 + tok) * 1024 + h * 64 + hf * 32 + (lt2 & 15) * 2);
    const int off = (tok * 64 + c4) * 4;
    *(LAS f32x4*)(bp + off) = va; *(LAS f32x4*)(bp + 4096 + off) = vw; *(LAS f32x4*)(bp + 8192 + off) = vb; *(LAS f32x4*)(bp + 12288 + off) = vk; *(LAS f32x4*)(bp + 16384 + off) = vr;
    *(LAS f32x2v*)(bp + S_RWV + (tok * 32 + (lt2 & 15) * 2) * 4) = (f32x2v){bflo(rv), bfhi(rv)};
}
__device__ __forceinline__ void s_hg_load(LAS unsigned char* bp, int lt2, size_t ltok0, int h8, int q4, const bf16_t* cols, const float* lbv) {
    const int tok = lt2 >> 4, c8 = (lt2 & 15) * 8; const bf16_t* crow = cols + (ltok0 + tok) * CL;
    float q[8], f[8]; ld8bf(crow + C_HQ + h8 * 128 + c8, q); ld8bf(crow + C_HF + h8 * 128 + c8, f);
    const unsigned rv = *(const unsigned*)(crow + C_HI + h8 * 128 + q4 * 32 + (lt2 & 15) * 2);
    const f32x4 lb0 = *(const f32x4*)(lbv + h8 * 128 + c8), lb1 = *(const f32x4*)(lbv + h8 * 128 + c8 + 4);
    const int off = (tok * 128 + c8) * 4;
    *(LAS f32x4*)(bp + off) = (f32x4){lb0[0] + (1.f - lb0[0]) * f[0], lb0[1] + (1.f - lb0[1]) * f[1], lb0[2] + (1.f - lb0[2]) * f[2], lb0[3] + (1.f - lb0[3]) * f[3]};
    *(LAS f32x4*)(bp + off + 16) = (f32x4){lb1[0] + (1.f - lb1[0]) * f[4], lb1[1] + (1.f - lb1[1]) * f[5], lb1[2] + (1.f - lb1[2]) * f[6], lb1[3] + (1.f - lb1[3]) * f[7]};
    *(LAS f32x4*)(bp + S_HGQ + off) = (f32x4){q[0], q[1], q[2], q[3]}; *(LAS f32x4*)(bp + S_HGQ + off + 16) = (f32x4){q[4], q[5], q[6], q[7]};
    *(LAS f32x2v*)(bp + S_HGI + (tok * 32 + (lt2 & 15) * 2) * 4) = (f32x2v){bflo(rv), bfhi(rv)};
}
__device__ __forceinline__ void s_drain(const LAS unsigned char* ybase, int lt2, float* obase  ) {
    const int t = lt2 >> 4, rp = (lt2 & 15) * 2;
    *(f32x2v*)(obase + (size_t)(rp >> 4) * (TS * 16) + t * 16 + (rp & 15)) = *(const LAS f32x2v*)(ybase + (t * 32 + rp) * 4);
}
__device__ __forceinline__ void split_scan(int s, int bid, int G, int tid, int lane, int wave, LAS unsigned char* lds,
        const bf16_t* PA, const float* PW, const bf16_t* PB, const bf16_t* PK, const bf16_t* PR, const bf16_t* PV, const bf16_t* cols, const float* lbv,
        float* oraw, float* hgo, float* rwstate, float* hgstate, bool save) {
    constexpr int NBLK = TS / ST;
    const int rowl = lane >> 4, j = lane & 15, r0 = (wave & 3) * 8 + rowl, r1 = r0 + 4;
    for (int it = bid; it < 256; it += G) {
        if (it < 128) {
            const int b = it >> 5, h = (it >> 1) & 15, hf = it & 1;
            const size_t tok0 = (size_t)b * TS;
            float* sp0 = rwstate + ((size_t)((b * 16 + h) * 64 + hf * 32 + r0) * 64 + 4 * j); float* sp1 = sp0 + 4 * 64;
            float* og = oraw + (size_t)((b * 16 + h) * 4 + hf * 2) * TS * 16;
            f32x4 x0 = (f32x4){0.f, 0.f, 0.f, 0.f}, x1 = x0;
            if (wave < 4 && s > 0) { x0 = *(const f32x4*)sp0; x1 = *(const f32x4*)sp1; }
            if (wave >= 4) { s_rw_load(lds, tid - 256, tok0, h, hf, PA, PW, PB, PK, PR, PV); SCAN_BAR_L(); } else { __builtin_amdgcn_s_setprio(2); asm volatile("s_waitcnt vmcnt(0)" ::: "memory"); SCAN_BAR_S(); }
#pragma unroll 1
            for (int blk = 0; blk < NBLK; ++blk) {
                if (wave >= 4) {
                    if (blk > 0) s_drain(lds + ((blk - 1) & 1) * S_RWB + S_RWY, tid - 256, og + (size_t)(blk - 1) * (ST * 16));
                    if (blk + 1 < NBLK) s_rw_load(lds + ((blk + 1) & 1) * S_RWB, tid - 256, tok0 + (blk + 1) * ST, h, hf, PA, PW, PB, PK, PR, PV);
                    SCAN_BAR_L();
                } else {
                    const LAS unsigned char* bp = lds + (blk & 1) * S_RWB;
                    const LAS unsigned char* p4 = bp + 16 * j; const LAS unsigned char* pv = bp + S_RWV + r0 * 4; LAS unsigned char* py = (LAS unsigned char*)bp + S_RWY + r0 * 4;
                    f32x4 a4 = *(const LAS f32x4*)(p4), w4 = *(const LAS f32x4*)(p4 + 4096), b4 = *(const LAS f32x4*)(p4 + 8192), k4 = *(const LAS f32x4*)(p4 + 12288), r4 = *(const LAS f32x4*)(p4 + 16384);
                    float v0 = *(const LAS float*)(pv), v1 = *(const LAS float*)(pv + 16);
                    float sa0 = (x0[0] * a4[0] + x0[1] * a4[1]) + (x0[2] * a4[2] + x0[3] * a4[3]), sa1 = (x1[0] * a4[0] + x1[1] * a4[1]) + (x1[2] * a4[2] + x1[3] * a4[3]);
                    allreduce16x2(sa0, sa1);
#pragma unroll
                    for (int t = 0; t < ST; ++t) {
                        f32x4 na = a4, nw = w4, nb = b4, nk = k4, nr = r4; float n0 = v0, n1 = v1;
                        if (t < ST - 1) { const int o = (t + 1) * 256; na = *(const LAS f32x4*)(p4 + o); nw = *(const LAS f32x4*)(p4 + 4096 + o); nb = *(const LAS f32x4*)(p4 + 8192 + o); nk = *(const LAS f32x4*)(p4 + 12288 + o); nr = *(const LAS f32x4*)(p4 + 16384 + o);
                            n0 = *(const LAS float*)(pv + (t + 1) * 128); n1 = *(const LAS float*)(pv + (t + 1) * 128 + 16); }
                        x0 = x0 * w4 + (b4 * sa0 + k4 * v0); x1 = x1 * w4 + (b4 * sa1 + k4 * v1);
                        float y0 = (x0[0] * r4[0] + x0[1] * r4[1]) + (x0[2] * r4[2] + x0[3] * r4[3]), y1 = (x1[0] * r4[0] + x1[1] * r4[1]) + (x1[2] * r4[2] + x1[3] * r4[3]);
                        float s0n = (x0[0] * na[0] + x0[1] * na[1]) + (x0[2] * na[2] + x0[3] * na[3]), s1n = (x1[0] * na[0] + x1[1] * na[1]) + (x1[2] * na[2] + x1[3] * na[3]);
                        s0n = dpp_add<0xB1>(s0n); s1n = dpp_add<0xB1>(s1n); y0 = dpp_add<0xB1>(y0); y1 = dpp_add<0xB1>(y1); s0n = dpp_add<0x4E>(s0n); s1n = dpp_add<0x4E>(s1n); y0 = dpp_add<0x4E>(y0); y1 = dpp_add<0x4E>(y1);
                        s0n = dpp_add<0x141>(s0n); s1n = dpp_add<0x141>(s1n); y0 = dpp_add<0x141>(y0); y1 = dpp_add<0x141>(y1); s0n = dpp_add<0x140>(s0n); s1n = dpp_add<0x140>(s1n); y0 = dpp_add<0x140>(y0); y1 = dpp_add<0x140>(y1);
                        if (j == 0) { *(LAS float*)(py + t * 128) = y0; *(LAS float*)(py + t * 128 + 16) = y1; }
                        sa0 = s0n; sa1 = s1n; a4 = na; w4 = nw; b4 = nb; k4 = nk; r4 = nr; v0 = n0; v1 = n1;
                    }
                    SCAN_BAR_S();
                }
            }
            if (wave >= 4) s_drain(lds + ((NBLK - 1) & 1) * S_RWB + S_RWY, tid - 256, og + (size_t)(NBLK - 1) * (ST * 16));
            else { __builtin_amdgcn_s_setprio(0); if (save) { *(f32x4*)sp0 = x0; *(f32x4*)sp1 = x1; } }
        } else {
            const int i2 = it - 128, b = i2 >> 5, h8 = (i2 >> 2) & 7, q4 = i2 & 3;
            const size_t tok0 = (size_t)b * TS;
            float* sp0 = hgstate + ((size_t)((b * 8 + h8) * 128 + q4 * 32 + r0) * 128 + 4 * j); float* sp1 = sp0 + 4 * 128;
            float* og = hgo + (size_t)((b * 8 + h8) * 8 + q4 * 2) * TS * 16;
            f32x4 a0 = (f32x4){0.f, 0.f, 0.f, 0.f}, a1 = a0, c0 = a0, c1 = a0;
            if (wave < 4 && s > 0) { a0 = *(const f32x4*)sp0; a1 = *(const f32x4*)(sp0 + 64); c0 = *(const f32x4*)sp1; c1 = *(const f32x4*)(sp1 + 64); }
            if (wave >= 4) { s_hg_load(lds, tid - 256, tok0, h8, q4, cols, lbv); SCAN_BAR_L(); } else { __builtin_amdgcn_s_setprio(2); asm volatile("s_waitcnt vmcnt(0)" ::: "memory"); SCAN_BAR_S(); }
#pragma unroll 1
            for (int blk = 0; blk < NBLK; ++blk) {
                if (wave >= 4) {
                    if (blk > 0) s_drain(lds + ((blk - 1) & 1) * S_HGB + S_HGY, tid - 256, og + (size_t)(blk - 1) * (ST * 16));
                    if (blk + 1 < NBLK) s_hg_load(lds + ((blk + 1) & 1) * S_HGB, tid - 256, tok0 + (blk + 1) * ST, h8, q4, cols, lbv);
                    SCAN_BAR_L();
                } else {
                    const LAS unsigned char* bp = lds + (blk & 1) * S_HGB;
                    const LAS unsigned char* g4 = bp + 16 * j; const LAS unsigned char* gi = bp + S_HGI + r0 * 4; LAS unsigned char* gy = (LAS unsigned char*)bp + S_HGY + r0 * 4;
                    f32x4 f0 = *(const LAS f32x4*)(g4), f1 = *(const LAS f32x4*)(g4 + 256), q0 = *(const LAS f32x4*)(g4 + S_HGQ), q1 = *(const LAS f32x4*)(g4 + S_HGQ + 256);
                    float i0 = *(const LAS float*)(gi), i1 = *(const LAS float*)(gi + 16);
#pragma unroll
                    for (int t = 0; t < ST; ++t) {
                        f32x4 nf0 = f0, nf1 = f1, nq0 = q0, nq1 = q1; float ni0 = i0, ni1 = i1;
                        if (t < ST - 1) { const int o = (t + 1) * 512; nf0 = *(const LAS f32x4*)(g4 + o); nf1 = *(const LAS f32x4*)(g4 + 256 + o); nq0 = *(const LAS f32x4*)(g4 + S_HGQ + o); nq1 = *(const LAS f32x4*)(g4 + S_HGQ + 256 + o);
                            ni0 = *(const LAS float*)(gi + (t + 1) * 128); ni1 = *(const LAS float*)(gi + (t + 1) * 128 + 16); }
                        a0 = (a0 - i0) * f0 + i0; a1 = (a1 - i0) * f1 + i0; c0 = (c0 - i1) * f0 + i1; c1 = (c1 - i1) * f1 + i1;
                        float y0 = ((a0[0] * q0[0] + a0[1] * q0[1]) + (a0[2] * q0[2] + a0[3] * q0[3])) + ((a1[0] * q1[0] + a1[1] * q1[1]) + (a1[2] * q1[2] + a1[3] * q1[3]));
                        float y1 = ((c0[0] * q0[0] + c0[1] * q0[1]) + (c0[2] * q0[2] + c0[3] * q0[3])) + ((c1[0] * q1[0] + c1[1] * q1[1]) + (c1[2] * q1[2] + c1[3] * q1[3]));
                        allreduce16x2(y0, y1);
                        if (j == 0) { *(LAS float*)(gy + t * 128) = y0; *(LAS float*)(gy + t * 128 + 16) = y1; }
                        f0 = nf0; f1 = nf1; q0 = nq0; q1 = nq1; i0 = ni0; i1 = ni1;
                    }
                    SCAN_BAR_S();
                }
            }
            if (wave >= 4) s_drain(lds + ((NBLK - 1) & 1) * S_HGB + S_HGY, tid - 256, og + (size_t)(NBLK - 1) * (ST * 16));
            else { __builtin_amdgcn_s_setprio(0); if (save) { *(f32x4*)sp0 = a0; *(f32x4*)(sp0 + 64) = a1; *(f32x4*)sp1 = c0; *(f32x4*)(sp1 + 64) = c1; } }
        }
    }
}

__device__ __forceinline__ void attn_phase(int gw, int NGW, int lane, const bf16_t* Q, const bf16_t* KV, const bf16_t* Vt, bf16_t* AO) {
    const int fr = lane & 15, fq = lane >> 4;
    for (int item = gw; item < 8192; item += NGW) {
        const int bh = item >> 9, tile = item & 511, b = bh >> 2, hd = bh & 3;
        const size_t gt = (size_t)b * SEQ + tile * 16 + fr;
        bf16x8 qf[8];
#pragma unroll
        for (int ks = 0; ks < 8; ++ks) qf[ks] = *(const bf16x8*)(Q + gt * 1024 + hd * 256 + ks * 32 + fq * 8);
        f32x4 sc[16]; float mx = -3.0e38f;
#pragma unroll
        for (int kt = 0; kt < 16; ++kt) { f32x4 acc = (f32x4){0.f, 0.f, 0.f, 0.f}; const bf16_t* kp = KV + (size_t)(b * 256 + kt * 16 + fr) * 2048 + hd * 256 + fq * 8;
#pragma unroll
            for (int ks = 0; ks < 8; ++ks) acc = MFMA16(*(const bf16x8*)(kp + ks * 32), qf[ks], acc);
            sc[kt] = acc * 0.0625f; mx = fmaxf(mx, fmaxf(fmaxf(sc[kt][0], sc[kt][1]), fmaxf(sc[kt][2], sc[kt][3]))); }
        mx = fmaxf(mx, __shfl_xor(mx, 16)); mx = fmaxf(mx, __shfl_xor(mx, 32));
        float sum = 0.f;
#pragma unroll
        for (int kt = 0; kt < 16; ++kt) {
#pragma unroll
            for (int jj = 0; jj < 4; ++jj) { sc[kt][jj] = __expf(sc[kt][jj] - mx); sum += sc[kt][jj]; } }
        sum = fq_sum(sum);
        const float inv = 1.0f / sum;
        bf16x8 pf[8];
#pragma unroll
        for (int k2 = 0; k2 < 8; ++k2) { u32x4 w; w.x = cvt_pk_bf16(sc[2 * k2][0], sc[2 * k2][1]); w.y = cvt_pk_bf16(sc[2 * k2][2], sc[2 * k2][3]); w.z = cvt_pk_bf16(sc[2 * k2 + 1][0], sc[2 * k2 + 1][1]); w.w = cvt_pk_bf16(sc[2 * k2 + 1][2], sc[2 * k2 + 1][3]); pf[k2] = __builtin_bit_cast(bf16x8, w); }
#pragma unroll 2
        for (int dt = 0; dt < 16; ++dt) { f32x4 acc = (f32x4){0.f, 0.f, 0.f, 0.f}; const bf16_t* vp = Vt + (size_t)((b * 4 + hd) * 256 + dt * 16 + fr) * 256 + fq * 8;
#pragma unroll
            for (int k2 = 0; k2 < 8; ++k2) acc = MFMA16(*(const bf16x8*)(vp + k2 * 32), pf[k2], acc);
            st4bf(AO + gt * 1024 + hd * 256 + dt * 16 + 4 * fq, acc * inv); }
    }
}

__device__ __forceinline__ int tid_fresh() { int t = threadIdx.x; asm volatile("" : "+v"(t)); return t; }
#define WinT ((bf16_t*)(a.ws + WS_WIN))
#define WoutT ((bf16_t*)(a.ws + WS_WOUT))
#define WqT ((bf16_t*)(a.ws + WS_WQ))
#define WoT ((bf16_t*)(a.ws + WS_WO))
#define WkvT ((bf16_t*)(a.ws + WS_WKV))
#define W13T ((bf16_t*)(a.ws + WS_W13))
#define W2T ((bf16_t*)(a.ws + WS_W2))
#define rw2T ((bf16_t*)(a.ws + WS_RW2T))
#define ra2T ((bf16_t*)(a.ws + WS_RA2T))
#define rg2T ((bf16_t*)(a.ws + WS_RG2T))
#define g2Tp ((bf16_t*)(a.ws + WS_G2TP))
#define GATE ((bf16_t*)(a.ws + WS_GATE))
#define ASG ((bf16_t*)(a.ws + WS_ASG))
#define carry ((bf16_t*)(a.ws + WS_CARRY))
#define lbv ((float*)(a.ws + WS_LB))
#define mbf ((bf16_t*)(a.ws + WS_MBF))
#define KV ((bf16_t*)(a.ws + WS_KV))
#define Vt ((bf16_t*)(a.ws + WS_VT))
#define rwst ((float*)(a.ws + WS_RWST))
#define hgst ((float*)(a.ws + WS_HGST))
#define bonus ((float*)(a.ws + WS_BONUS))
#define merged ((bf16_t*)(a.ws + WS_MERGED))
#define u1 ((bf16_t*)(a.ws + WS_U1))
#define cols ((bf16_t*)(a.ws + WS_COLS))
#define PR ((bf16_t*)(a.ws + WS_PR))
#define PK ((bf16_t*)(a.ws + WS_PK))
#define PA ((bf16_t*)(a.ws + WS_PA))
#define PB ((bf16_t*)(a.ws + WS_PB))
#define PV ((bf16_t*)(a.ws + WS_PV))
#define PW ((float*)(a.ws + WS_PW))
#define oraw ((float*)(a.ws + WS_ORAW))
#define hgo ((float*)(a.ws + WS_HGO))
#define U ((bf16_t*)(a.ws + WS_U))
#define Qb ((bf16_t*)(a.ws + WS_Q))
#define AO ((bf16_t*)(a.ws + WS_AO))
#define FF ((bf16_t*)(a.ws + WS_FF))
#define XIN (a.in[0])
#define OUTP (a.out)
struct Args { const float* in[29]; float* out; unsigned char* ws; int ph_lo, ph_hi; };

typedef const __attribute__((address_space(4))) Args* CArgsP;
__device__ __forceinline__ CArgsP args_fresh() { CArgsP p = (CArgsP)__builtin_amdgcn_kernarg_segment_ptr(); asm volatile("" : "+s"(p)); return p; }
__global__ void __launch_bounds__(512, 2) mega(Args a0) {
    extern __shared__ __attribute__((aligned(16))) unsigned char lds_raw[];
    LAS unsigned char* lds = (LAS unsigned char*)lds_raw;
    cg::grid_group grid = cg::this_grid();
    const int G = gridDim.x, bid = blockIdx.x, NGW = G * 8, NGT = G * 512;
#define IDS const auto& a = *args_fresh(); const int tid = tid_fresh(), lane = tid & 63, wave = __builtin_amdgcn_readfirstlane(tid >> 6), gw = bid * 8 + wave, gtid = bid * 512 + tid; (void)lane; (void)gw; (void)gtid
    const int lo = a0.ph_lo, hi = a0.ph_hi;
    if (lo < 0) grid.sync();
    { volatile LAS unsigned* misc = (volatile LAS unsigned*)(lds + MISC_OFF); if (threadIdx.x < 2) misc[threadIdx.x] = 0u; __syncthreads();
      if (hi - lo > 1) (void)xcd_barrier_post((unsigned*)(a0.ws + WS_CTL), misc); }
#ifndef MK_REP
#define MK_REP -1
#endif
#ifndef MK_REPN
#define MK_REPN 3
#endif
#define RPT(code) for (int rep_ = 0, nrep_ = (MK_REP == (code)) ? MK_REPN : 1; rep_ < nrep_; ++rep_)
#define LASTREP (rep_ == nrep_ - 1)
#define IN(k) (lo <= (k) && (k) < hi)
#define SEAM(k) do { if (IN(k) && IN((k) + 1)) RPT(120) { XcdBarrier xb_; xb_.bar = (unsigned*)(args_fresh()->ws + WS_CTL); xb_.x = xb_xcc_id(); xb_.st = (volatile LAS unsigned*)(lds + MISC_OFF); xcd_barrier(xb_); } } while (0)

    if (IN(0)) { IDS;
        LAS float* scr = (LAS float*)(lds + wave * 16384);
        constexpr int I_IN = 16 * 297, I_SQ = 16 * 32, I_13 = 16 * 88, I_2 = 44 * 32;
        constexpr int NITEMS = I_IN + 5 * I_SQ + 2 * I_13 + I_2;
        for (int it = gw; it < NITEMS; it += NGW) {
            int r = it;
            if (r < I_IN) { const int kb = r / 297, n0 = (r % 297) * 32; tr_item(a.in[3], 1024, 9504, WinT, kb, n0, n0 + (n0 >= 3360 ? 224 : 0), scr, lane); continue; } r -= I_IN;
            if (r < I_SQ) { tr_item(a.in[17], 1024, 1024, WoutT, r / 32, (r % 32) * 32, (r % 32) * 32, scr, lane); continue; } r -= I_SQ;
            if (r < I_SQ) { tr_item(a.in[20], 1024, 1024, WqT, r / 32, (r % 32) * 32, (r % 32) * 32, scr, lane); continue; } r -= I_SQ;
            if (r < I_SQ) { tr_item(a.in[23], 1024, 1024, WoT, r / 32, (r % 32) * 32, (r % 32) * 32, scr, lane); continue; } r -= I_SQ;
            if (r < I_SQ) { tr_item(a.in[21], 1024, 1024, WkvT, r / 32, (r % 32) * 32, (r % 32) * 32, scr, lane); continue; } r -= I_SQ;
            if (r < I_SQ) { tr_item(a.in[22], 1024, 1024, WkvT, r / 32, (r % 32) * 32, 1024 + (r % 32) * 32, scr, lane); continue; } r -= I_SQ;
            if (r < I_13) { const int n0 = (r % 88) * 32; tr_item(a.in[25], 1024, DFF, W13T, r / 88, n0, (n0 / 128) * 256 + (n0 % 128), scr, lane); continue; } r -= I_13;
            if (r < I_13) { const int n0 = (r % 88) * 32; tr_item(a.in[26], 1024, DFF, W13T, r / 88, n0, (n0 / 128) * 256 + 128 + (n0 % 128), scr, lane); continue; } r -= I_13;
            tr_item(a.in[27], DFF, 1024, W2T, r / 32, (r % 32) * 32, (r % 32) * 32, scr, lane);
        }
        for (int i = gtid; i < 28672; i += NGT) ((u32x4*)(WinT + 3360 * 1024))[i] = (u32x4){0u, 0u, 0u, 0u};
        for (int i = gtid; i < 1792; i += NGT) ((u32x4*)carry)[i] = (u32x4){0u, 0u, 0u, 0u};
        for (int n = gw; n < 1024; n += NGW) { rw2T[n * 64 + lane] = (bf16_t)f2bf(a.in[6][lane * 1024 + n]); ra2T[n * 64 + lane] = (bf16_t)f2bf(a.in[8][lane * 1024 + n]); }
        for (int m = gw; m < 512; m += NGW) {
            for (int e = lane; e < 320; e += 64) { const int n = 2 * m + (e >= 160 ? 1 : 0), k = e >= 160 ? e - 160 : e; rg2T[n * 160 + k] = (bf16_t)f2bf(a.in[9][k * 1024 + n]); } }
        for (int n = gw; n < 1024; n += NGW) { f32x4 v;
#pragma unroll
            for (int e = 0; e < 4; ++e) { const int k = 4 * lane + e; v[e] = k < 160 ? a.in[9][k * 1024 + n] : 0.f; }
            st4bf(g2Tp + n * 256 + 4 * lane, v); }
        for (int i = gtid; i < 1024; i += NGT) lbv[i] = 1.0f / (1.0f + __expf(a.in[15][1024 + i] - a.in[15][i]));
        for (int m = gw; m < 1024; m += NGW) rms_row_bf16(a.in[1] + (size_t)m * 1024, a.in[19], mbf + (size_t)m * 1024, lane);
        for (int lt = gw; lt < MS; lt += NGW) { const int b = lt / TS, tl = lt % TS; const size_t gt = (size_t)b * SEQ + tl; rms_row_bf16(XIN + gt * 1024, a.in[2], u1 + (size_t)lt * 1024, lane); }
        __syncthreads();
    }
    SEAM(0);

#pragma unroll 1
    for (int s = 0; s < NSPLIT; ++s) {
        const int pb = 1 + 5 * s;
        if (IN(pb + 1)) { const auto& a = *args_fresh();
            pg8::Gemm g{u1, WinT, MS, CL, 1024}; pg8::StaticOrder S; S.init(MS, CL, G, bid);
            pg8::EpiColsAct E{cols, CL};
            RPT(102) pg8::gemm_phase<pg8::EpiColsAct, pg8::StaticOrder, true, true>(lds, g, S, E);
        }
        SEAM(pb + 1);
#ifndef SKIP_PREP
        if (IN(pb + 2)) { IDS; RPT(103) prep_phase(s, gw, NGW, lane, cols, carry, a.in[4], a.in[5], a.in[7], a.in[10], a.in[11], a.in[12], rw2T, ra2T, PR, PK, PA, PB, PV, PW, bonus, ASG); }
#endif
        SEAM(pb + 2);
        if (IN(pb + 3)) { IDS;
#ifdef MK_ZERO_SCAN
            for (int i = gtid; i < MS * 256; i += NGT) { ((f32x4*)oraw)[i] = (f32x4){0.f, 0.f, 0.f, 0.f}; ((f32x4*)hgo)[i] = (f32x4){0.01f, 0.02f, 0.03f, 0.04f}; }
#endif
#if 0
            RPT(104) { rwkv_scan(s, bid, G, tid, lane, wave, lds, PA, PW, PB, PK, PR, PV, oraw, rwst, LASTREP); __syncthreads(); }
            RPT(105) { hgrn_scan(s, bid, G, tid, lane, wave, lds, cols, lbv, hgo, hgst, LASTREP); __syncthreads(); }
#else
#ifdef MK_FUSED_SCAN
            RPT(104) { fused_scan(s, bid, G, tid, lane, wave, lds, PA, PW, PB, PK, PR, PV, cols, lbv, oraw, hgo, rwst, hgst, LASTREP); __syncthreads(); }
#else
            RPT(104) { split_scan(s, bid, G, tid, lane, wave, lds, PA, PW, PB, PK, PR, PV, cols, lbv, oraw, hgo, rwst, hgst, LASTREP); __syncthreads(); }
#endif
#endif
            { pg8::Gemm g{ASG, g2Tp, MS, 1024, 256}; pg8::StaticOrder S; S.init(MS, 1024, G, bid); pg8::EpiStoreBf16 E{GATE, 1024};
              pg8::gemm_phase<pg8::EpiStoreBf16, pg8::StaticOrder, true, true>(lds, g, S, E); }
        }
        SEAM(pb + 3);
        if (IN(pb + 4)) { IDS;
#ifdef MK_NOMIX
            for (int i = gtid; i < MS * 128; i += NGT) { const int lt = i >> 7, b = lt / TS, tl = lt % TS; const size_t gt = (size_t)b * SEQ + s * TS + tl; ((u32x4*)(merged + gt * 1024))[i & 127] = (u32x4){0u, 0u, 0u, 0u}; }
#endif
#ifndef SKIP_POST
            RPT(106) post_phase(s, gw, NGW, lane, cols, carry, a.in[4], GATE, a.in[13], a.in[14], a.in[16], oraw, hgo, PV, bonus, merged);
#endif
            if (s + 1 < NSPLIT) for (int lt = gw; lt < MS; lt += NGW) { const int b = lt / TS, tl = lt % TS; const size_t gt = (size_t)b * SEQ + (s + 1) * TS + tl; rms_row_bf16(XIN + gt * 1024, a.in[2], u1 + (size_t)lt * 1024, lane); }
            if (bid < 4 && s + 1 < NSPLIT) { const u32x4* src = (const u32x4*)(cols + (size_t)(bid * TS + TS - 1) * CL); u32x4* dst = (u32x4*)(carry + (((s + 1) & 1) * 4 + bid) * CARRY_LD);
                for (int i = tid; i < CARRY_LD / 8; i += 512) dst[i] = src[i]; }
        }
        SEAM(pb + 4);
    }

    if (IN(T0 + 0)) { const auto& a = *args_fresh();
        { pg8::Gemm g{merged, WoutT, NTOK, 1024, 1024}; pg8::StaticOrder S; S.init(NTOK, 1024, G, bid); pg8::EpiResF32 E{XIN, OUTP, 1024};
          pg8::gemm_phase<pg8::EpiResF32, pg8::StaticOrder, true, true>(lds, g, S, E); }
        { pg8::Gemm g{mbf, WkvT, 1024, 2048, 1024}; pg8::StaticOrder S; S.init(1024, 2048, G, bid); pg8::EpiStoreBf16 E{KV, 2048};
          pg8::gemm_phase<pg8::EpiStoreBf16, pg8::StaticOrder, true, true>(lds, g, S, E); }
    }
    SEAM(T0 + 0);
    if (IN(T0 + 1)) { IDS;
        for (int gt = gw; gt < NTOK; gt += NGW) rms_row_bf16(OUTP + (size_t)gt * 1024, a.in[18], U + (size_t)gt * 1024, lane);
        for (int i = gtid; i < 4 * 4 * 256 * 256; i += NGT) { const int kp = i & 255, dim = (i >> 8) & 255, hd = (i >> 16) & 3, b = i >> 18;
            const int k2 = kp >> 5, fq = (kp >> 3) & 3, sl = kp & 7; const int key = 32 * k2 + (sl < 4 ? 4 * fq + sl : 16 + 4 * fq + sl - 4);
            Vt[i] = KV[(size_t)(b * 256 + key) * 2048 + 1024 + hd * 256 + dim]; }
    }
    SEAM(T0 + 1);
    if (IN(T0 + 2)) { const auto& a = *args_fresh(); pg8::Gemm g{U, WqT, NTOK, 1024, 1024}; pg8::StaticOrder S; S.init(NTOK, 1024, G, bid); pg8::EpiStoreBf16 E{Qb, 1024};
        RPT(112) pg8::gemm_phase<pg8::EpiStoreBf16, pg8::StaticOrder, true, true>(lds, g, S, E); }
    SEAM(T0 + 2);
#ifndef SKIP_ATTN
    if (IN(T0 + 3)) { IDS; RPT(113) attn_phase(gw, NGW, lane, Qb, KV, Vt, AO); }
#endif
    SEAM(T0 + 3);
#ifndef MK_NOATT
    if (IN(T0 + 4)) { const auto& a = *args_fresh(); pg8::Gemm g{AO, WoT, NTOK, 1024, 1024}; pg8::StaticOrder S; S.init(NTOK, 1024, G, bid); pg8::EpiResF32 E{OUTP, OUTP, 1024};
        pg8::gemm_phase<pg8::EpiResF32, pg8::StaticOrder, true, true>(lds, g, S, E); }
#endif
    SEAM(T0 + 4);
    if (IN(T0 + 5)) { IDS; RPT(115) for (int gt = gw; gt < NTOK; gt += NGW) rms_row_bf16(OUTP + (size_t)gt * 1024, a.in[24], U + (size_t)gt * 1024, lane); }
    SEAM(T0 + 5);
    if (IN(T0 + 6)) { const auto& a = *args_fresh(); pg8::Gemm g{U, W13T, NTOK, 2 * DFF, 1024}; pg8::StaticOrder S; S.init(NTOK, 2 * DFF, G, bid); pg8::EpiSwiGLU E{FF, DFF};
        RPT(116) pg8::gemm_phase<pg8::EpiSwiGLU, pg8::StaticOrder, true, true>(lds, g, S, E); }
    SEAM(T0 + 6);
    if (IN(T0 + 7)) { const auto& a = *args_fresh(); pg8::Gemm g{FF, W2T, NTOK, 1024, DFF}; pg8::StaticOrder S; S.init(NTOK, 1024, G, bid); pg8::EpiResF32 E{OUTP, OUTP, 1024};
        pg8::gemm_phase<pg8::EpiResF32, pg8::StaticOrder, true, true>(lds, g, S, E); }
    SEAM(T0 + 7);
    if (IN(T0 + 8)) { IDS;
        const float* gf = a.in[28];
        for (int gt = gw; gt < NTOK; gt += NGW) { f32x4* row = (f32x4*)(OUTP + (size_t)gt * 1024); f32x4 v[4]; float sq = 0.f;
#pragma unroll
            for (int j = 0; j < 4; ++j) { v[j] = row[lane + 64 * j]; sq += (v[j][0] * v[j][0] + v[j][1] * v[j][1]) + (v[j][2] * v[j][2] + v[j][3] * v[j][3]); }
            const float rs = 1.0f / sqrtf(wave_sum(sq) * (1.0f / 1024.0f) + 1e-6f);
#pragma unroll
            for (int j = 0; j < 4; ++j) row[lane + 64 * j] = v[j] * rs * ((const f32x4*)gf)[lane + 64 * j]; }
    }
#undef IN
#undef SEAM
}

#ifndef MK_MULTI
#define MK_MULTI 0
#endif
extern "C" void kernel_launch(void* const* d_in, const int* in_sizes, int n_in, void* d_out, int out_size, void* d_ws, size_t ws_size, hipStream_t stream) {
    static int grid = 0;
    if (grid == 0) {
        if (n_in != 29 || in_sizes[0] != NTOK * D || out_size != NTOK * D || ws_size < WS_END) { fprintf(stderr, "kernel_launch: unexpected shapes / workspace (%d inputs, ws %zu)\n", n_in, ws_size); grid = -1; return; }
        int dev = 0, cus = 0, per_cu = 0;
        hipGetDevice(&dev); hipDeviceGetAttribute(&cus, hipDeviceAttributeMultiprocessorCount, dev);
        hipFuncSetAttribute((const void*)mega, hipFuncAttributeMaxDynamicSharedMemorySize, LDS_BYTES);
        hipOccupancyMaxActiveBlocksPerMultiprocessor(&per_cu, (const void*)mega, 512, LDS_BYTES);
        (void)hipGetLastError();
        if (per_cu < 1) per_cu = 1;
        grid = cus;
    }
    if (grid < 0) return;
    Args a{};
    for (int i = 0; i < 29; ++i) a.in[i] = (const float*)d_in[i];
    a.out = (float*)d_out; a.ws = (unsigned char*)d_ws;
    (void)hipMemsetAsync((char*)d_ws + WS_CTL, 0, CTL_BYTES, stream);
    void* args[] = {&a};
#if MK_MULTI
    for (int ph = 0; ph < N_PHASES; ++ph) { a.ph_lo = ph; a.ph_hi = ph + 1; hipLaunchCooperativeKernel((const void*)mega, dim3(grid), dim3(512), args, LDS_BYTES, stream); }
#else
    a.ph_lo = 0; a.ph_hi = N_PHASES;
    hipError_t e = hipLaunchCooperativeKernel((const void*)mega, dim3(grid), dim3(512), args, LDS_BYTES, stream);
    if (e != hipSuccess) fprintf(stderr, "cooperative launch failed: %s (grid %d)\n", hipGetErrorString(e), grid);
#endif
}
```

```cpp
#include <hip/hip_runtime.h>
#include <hip/hip_cooperative_groups.h>
#include <cstdint>
#include <cstdio>
namespace cg = cooperative_groups;
namespace pg8 {
#define PG8_LAS __attribute__((address_space(3)))
typedef unsigned short bf16_t;
typedef short bf16x8 __attribute__((ext_vector_type(8)));
typedef float f32x4 __attribute__((ext_vector_type(4)));
typedef unsigned u32x4 __attribute__((ext_vector_type(4)));
constexpr int BM = 256, BK = 64, HALF = 128, HTB = HALF * BK * 2  , STAGE_BYTES = 8 * HTB, NXCD = 8, WGM = 8;

__host__ __device__ __forceinline__ int lds_byte(int r, int c) { const int st = (r >> 4) * 2 + (c >> 5), rr = r & 15, cc = c & 31, ob = rr * 64 + cc * 2; return st * 1024 + (ob ^ (((ob >> 9) & 1) << 5)); }
__host__ __device__ __forceinline__ void stage_rc(int b, int& R, int& C) { const int st = b / 1024, sb = b % 1024, swz = sb ^ (((sb >> 9) & 1) << 5); R = (st >> 1) * 16 + swz / 64; C = (st & 1) * 32 + (swz % 64) / 2; }
__host__ __device__ __forceinline__ int perm32(int rho) { const int n = rho >> 4, i = rho & 15; return 8 * (i >> 2) + 4 * n + (i & 3); }

struct Unit { int pm, pn; };
struct Gemm { const bf16_t* A; const bf16_t* Bt; int M, N, K; };

struct StaticOrder {
    int nM, nN, nwg, G, c;
    __host__ __device__ void init(int M, int N, int G_, int c_) { nM = M / BM; nN = N / BM; nwg = nM * nN; G = G_; c = c_; }
    __host__ __device__ bool next(int i, Unit& u) const {
        const long L = (long)i * G + c; if (L >= nwg) return false;
        int wgid = (int)L; { const int q = nwg / NXCD, r = nwg % NXCD, xcd = wgid % NXCD, off = wgid / NXCD; wgid = (xcd < r ? xcd * (q + 1) : r * (q + 1) + (xcd - r) * q) + off; }
        const int nig = WGM * nN, gid = wgid / nig, fm = gid * WGM, gsz = (nM - fm) < WGM ? (nM - fm) : WGM;
        u.pm = fm + ((wgid % nig) % gsz); u.pn = (wgid % nig) / gsz; return true;
    }
    __device__ __forceinline__ void a_ready(const Unit&) const {}
    __device__ __forceinline__ void done(const Unit&) const {}
};

__device__ __forceinline__ unsigned cvt_pk_bf16(float lo, float hi) { unsigned r; asm volatile("v_cvt_pk_bf16_f32 %0, %1, %2" : "=v"(r) : "v"(lo), "v"(hi)); return r; }
__device__ __forceinline__ float fast_sigmoid(float x) { return __builtin_amdgcn_rcpf(1.0f + __expf(-x)); }
__device__ __forceinline__ float fast_silu(float x) { return x * fast_sigmoid(x); }
struct EpiStoreBf16 {
    static constexpr bool PERM = true, AFTER_DRAIN = false;
    bf16_t* O; int ldc;
    __device__ __forceinline__ void operator()(const f32x4 (&acc)[2][2][4][2], const Unit& u, int wr, int wc, int fr, int fq) const {
        const int row0 = u.pm * BM + wr * 64 + fr, col0 = u.pn * BM + wc * 32 + 8 * fq;
#pragma unroll
        for (int ai = 0; ai < 2; ++ai)
#pragma unroll
            for (int m = 0; m < 4; ++m) { bf16_t* rowp = O + (size_t)(row0 + ai * HALF + m * 16) * ldc + col0;
#pragma unroll
                for (int bj = 0; bj < 2; ++bj) { const f32x4 v0 = acc[ai][bj][m][0], v1 = acc[ai][bj][m][1];
                    u32x4 w; w.x = cvt_pk_bf16(v0[0], v0[1]); w.y = cvt_pk_bf16(v0[2], v0[3]); w.z = cvt_pk_bf16(v1[0], v1[1]); w.w = cvt_pk_bf16(v1[2], v1[3]);
                    *(u32x4*)(rowp + bj * HALF) = w; } }
    }
};
struct EpiResF32 {
    static constexpr bool PERM = true, AFTER_DRAIN = false;
    const float* base; float* out; int ldc;
    __device__ __forceinline__ void operator()(const f32x4 (&acc)[2][2][4][2], const Unit& u, int wr, int wc, int fr, int fq) const {
        const int row0 = u.pm * BM + wr * 64 + fr, col0 = u.pn * BM + wc * 32 + 8 * fq;
#pragma unroll
        for (int ai = 0; ai < 2; ++ai)
#pragma unroll
            for (int m = 0; m < 4; ++m) { const size_t off = (size_t)(row0 + ai * HALF + m * 16) * ldc + col0;
#pragma unroll
                for (int bj = 0; bj < 2; ++bj)
#pragma unroll
                    for (int n = 0; n < 2; ++n) { const size_t p = off + bj * HALF + 4 * n; const f32x4 b = *(const f32x4*)(base + p); *(f32x4*)(out + p) = b + acc[ai][bj][m][n]; } }
    }
};
struct EpiSwiGLU {
    static constexpr bool PERM = true, AFTER_DRAIN = false;
    bf16_t* O; int ldc;
    __device__ __forceinline__ void operator()(const f32x4 (&acc)[2][2][4][2], const Unit& u, int wr, int wc, int fr, int fq) const {
        const int row0 = u.pm * BM + wr * 64 + fr, col0 = u.pn * HALF + wc * 32 + 8 * fq;
#pragma unroll
        for (int ai = 0; ai < 2; ++ai)
#pragma unroll
            for (int m = 0; m < 4; ++m) { bf16_t* rowp = O + (size_t)(row0 + ai * HALF + m * 16) * ldc + col0;
                f32x4 v0, v1;
#pragma unroll
                for (int j = 0; j < 4; ++j) { v0[j] = fast_silu(acc[ai][0][m][0][j]) * acc[ai][1][m][0][j]; v1[j] = fast_silu(acc[ai][0][m][1][j]) * acc[ai][1][m][1][j]; }
                u32x4 w; w.x = cvt_pk_bf16(v0[0], v0[1]); w.y = cvt_pk_bf16(v0[2], v0[3]); w.z = cvt_pk_bf16(v1[0], v1[1]); w.w = cvt_pk_bf16(v1[2], v1[3]);
                *(u32x4*)rowp = w; }
    }
};

struct EpiColsAct {
    static constexpr bool PERM = true, AFTER_DRAIN = false;
    bf16_t* O; int ldc;
    __device__ __forceinline__ void operator()(const f32x4 (&acc)[2][2][4][2], const Unit& u, int wr, int wc, int fr, int fq) const {
        const int row0 = u.pm * BM + wr * 64 + fr, col0 = u.pn * BM + wc * 32 + 8 * fq;
        const int pn = u.pn; const int act = (pn >= 14 && pn < 18) ? 1 : (pn >= 18 && pn < 22) ? 2 : (pn >= 26 && pn < 30) ? 1 : (pn >= 30) ? 2 : 0;
#pragma unroll
        for (int ai = 0; ai < 2; ++ai)
#pragma unroll
            for (int m = 0; m < 4; ++m) { bf16_t* rowp = O + (size_t)(row0 + ai * HALF + m * 16) * ldc + col0;
#pragma unroll
                for (int bj = 0; bj < 2; ++bj) { f32x4 v0 = acc[ai][bj][m][0], v1 = acc[ai][bj][m][1];
                    if (act == 1) {
#pragma unroll
                        for (int j = 0; j < 4; ++j) { v0[j] = fast_silu(v0[j]); v1[j] = fast_silu(v1[j]); } }
                    else if (act == 2) {
#pragma unroll
                        for (int j = 0; j < 4; ++j) { v0[j] = fast_sigmoid(v0[j]); v1[j] = fast_sigmoid(v1[j]); } }
                    u32x4 w; w.x = cvt_pk_bf16(v0[0], v0[1]); w.y = cvt_pk_bf16(v0[2], v0[3]); w.z = cvt_pk_bf16(v1[0], v1[1]); w.w = cvt_pk_bf16(v1[2], v1[3]);
                    *(u32x4*)(rowp + bj * HALF) = w; } }
    }
};
template <class Epi, class Sched, bool ALIGN_EPI = false, bool SP2 = false>
__device__ __forceinline__ void gemm_phase(PG8_LAS unsigned char* lds, const Gemm g, const Sched& S, const Epi& E) {
    int tid = threadIdx.x; asm volatile("" : "+v"(tid));
    const int wid = __builtin_amdgcn_readfirstlane(tid >> 6), lane = tid & 63, wr = wid >> 2, wc = wid & 3, fr = lane & 15, fq = lane >> 4;
    const int K = g.K, nt = K / BK;
    unsigned voffA[2], voffB[2];
#pragma unroll
    for (int i = 0; i < 2; ++i) { int R, C; stage_rc(tid * 16 + i * 8192, R, C); const int Rb = Epi::PERM ? ((R & ~31) + perm32(R & 31)) : R;
        voffA[i] = (unsigned)(R * K + C) * 2u; voffB[i] = (unsigned)(Rb * K + C) * 2u; }
    const size_t kstep = (size_t)(BK * 2);
    const size_t hstep = (size_t)HALF * K * 2;
    const size_t tstep = 2 * hstep;
    const unsigned ldsw = (unsigned)wid * 1024u;
    const int aoff = lds_byte(wr * 64 + fr, fq * 8), boff = lds_byte(wc * 32 + fr, fq * 8);
#define PG8_SA(b, h) (((b) * 2 + (h)) * HTB)
#define PG8_SB(b, h) ((4 + (b) * 2 + (h)) * HTB)
#define PG8_STAGE(bufoff, gbase, voff) do { _Pragma("unroll") for (int _i = 0; _i < 2; ++_i) \
        __builtin_amdgcn_global_load_lds((const unsigned*)((const char*)(gbase) + (voff)[_i]), (PG8_LAS unsigned*)(lds + (bufoff) + ldsw + _i * 8192), 16, 0, 0); } while (0)
#define PG8_LDA(dst, b, h) do { _Pragma("unroll") for (int m = 0; m < 4; ++m) _Pragma("unroll") for (int k = 0; k < 2; ++k) dst[m][k] = *(const PG8_LAS bf16x8*)(lds + PG8_SA(b, h) + aoff + m * 2048 + k * 1024); } while (0)
#define PG8_LDB(dst, b, h) do { _Pragma("unroll") for (int n = 0; n < 2; ++n) _Pragma("unroll") for (int k = 0; k < 2; ++k) dst[n][k] = *(const PG8_LAS bf16x8*)(lds + PG8_SB(b, h) + boff + n * 2048 + k * 1024); } while (0)
#define PG8_MMA(ai, bj, At, Bt) do { __builtin_amdgcn_s_setprio(1); _Pragma("unroll") for (int m = 0; m < 4; ++m) _Pragma("unroll") for (int n = 0; n < 2; ++n) _Pragma("unroll") for (int k = 0; k < 2; ++k) \
        acc[ai][bj][m][n] = __builtin_amdgcn_mfma_f32_16x16x32_bf16(Bt[n][k], At[m][k], acc[ai][bj][m][n], 0, 0, 0); __builtin_amdgcn_s_setprio(0); } while (0)
#define PG8_WAIT_V(n) asm volatile("s_waitcnt vmcnt(" #n ")" ::: "memory")
#define PG8_WAIT_L(n) asm volatile("s_waitcnt lgkmcnt(" #n ")" ::: "memory")
#define PG8_BAR __builtin_amdgcn_s_barrier()
#define PG8_SCHED __builtin_amdgcn_sched_barrier(0)
    Unit cur, nxt; int ui = 0;
    if (!S.next(0, cur)) return;
    f32x4 acc[2][2][4][2];
#pragma unroll
    for (int a = 0; a < 2; ++a)
#pragma unroll
        for (int b = 0; b < 2; ++b)
#pragma unroll
            for (int m = 0; m < 4; ++m)
#pragma unroll
                for (int n = 0; n < 2; ++n) acc[a][b][m][n] = (f32x4){0.f, 0.f, 0.f, 0.f};
    bf16x8 At[4][2], B0[2][2], B1[2][2];
    const char* cA = (const char*)g.A + (size_t)cur.pm * tstep; const char* cB = (const char*)g.Bt + (size_t)cur.pn * tstep;
    S.a_ready(cur);
    if constexpr (SP2) {
        PG8_STAGE(PG8_SB(0, 0), cB, voffB); PG8_STAGE(PG8_SB(0, 1), cB + hstep, voffB); PG8_STAGE(PG8_SA(0, 0), cA, voffA); PG8_STAGE(PG8_SA(0, 1), cA + hstep, voffA);
        if (wr == 1) PG8_BAR;
        PG8_WAIT_V(2); PG8_BAR;
        PG8_STAGE(PG8_SB(1, 0), cB + kstep, voffB); PG8_STAGE(PG8_SA(1, 0), cA + kstep, voffA); PG8_STAGE(PG8_SB(1, 1), cB + hstep + kstep, voffB);
        PG8_WAIT_V(6); PG8_BAR;
    } else {
        PG8_STAGE(PG8_SB(0, 0), cB, voffB); PG8_STAGE(PG8_SA(0, 0), cA, voffA); PG8_STAGE(PG8_SB(0, 1), cB + hstep, voffB); PG8_STAGE(PG8_SA(0, 1), cA + hstep, voffA);
        if (wr == 1) PG8_BAR;
        PG8_WAIT_V(4); PG8_BAR;
        PG8_STAGE(PG8_SB(1, 0), cB + kstep, voffB); PG8_STAGE(PG8_SA(1, 0), cA + kstep, voffA); PG8_STAGE(PG8_SB(1, 1), cB + hstep + kstep, voffB);
        PG8_WAIT_V(6); PG8_BAR;
    }
    for (;;) {
        const bool has_next = S.next(ui + 1, nxt);
        const char* nA = has_next ? (const char*)g.A + (size_t)nxt.pm * tstep : cA; const char* nB = has_next ? (const char*)g.Bt + (size_t)nxt.pn * tstep : cB;
        for (int t = 0; t < nt; t += 2) {
            const bool last = (t == nt - 2);
            const char* a1 = cA + (size_t)(t + 1) * kstep;
            const char* a2 = last ? nA : cA + (size_t)(t + 2) * kstep; const char* b2 = last ? nB : cB + (size_t)(t + 2) * kstep;
            const char* a3 = a2 + kstep; const char* b3 = b2 + kstep;
            if (last && has_next) S.a_ready(nxt);
            if constexpr (SP2) {
            PG8_LDB(B0, 0, 0); PG8_LDB(B1, 0, 1); PG8_SCHED; PG8_LDA(At, 0, 0); PG8_STAGE(PG8_SA(1, 1), a1 + hstep, voffA);
            PG8_WAIT_V(8); PG8_WAIT_L(0); PG8_BAR; PG8_MMA(0, 0, At, B0); PG8_MMA(0, 1, At, B1); PG8_BAR; PG8_SCHED;
            PG8_LDA(At, 0, 1); PG8_STAGE(PG8_SB(0, 0), b2, voffB); PG8_STAGE(PG8_SB(0, 1), b2 + hstep, voffB); PG8_STAGE(PG8_SA(0, 0), a2, voffA);
            PG8_WAIT_V(8); PG8_WAIT_L(0); PG8_BAR; PG8_MMA(1, 0, At, B0); PG8_MMA(1, 1, At, B1); PG8_BAR; PG8_SCHED;
            PG8_LDB(B0, 1, 0); PG8_LDB(B1, 1, 1); PG8_SCHED; PG8_LDA(At, 1, 0); PG8_STAGE(PG8_SA(0, 1), a2 + hstep, voffA);
            PG8_WAIT_V(8); PG8_WAIT_L(0); PG8_BAR; PG8_MMA(0, 0, At, B0); PG8_MMA(0, 1, At, B1); PG8_BAR; PG8_SCHED;
            PG8_LDA(At, 1, 1); PG8_STAGE(PG8_SB(1, 0), b3, voffB); PG8_STAGE(PG8_SB(1, 1), b3 + hstep, voffB); PG8_STAGE(PG8_SA(1, 0), a3, voffA);
            PG8_WAIT_V(8); PG8_WAIT_L(0); PG8_BAR; PG8_MMA(1, 0, At, B0); PG8_MMA(1, 1, At, B1); PG8_BAR; PG8_SCHED;
            } else {
            PG8_LDB(B0, 0, 0); PG8_SCHED; PG8_LDA(At, 0, 0); PG8_STAGE(PG8_SA(1, 1), a1 + hstep, voffA);
            PG8_WAIT_L(8); PG8_BAR; PG8_WAIT_L(0); PG8_MMA(0, 0, At, B0); PG8_BAR; PG8_SCHED;
            PG8_LDB(B1, 0, 1); PG8_STAGE(PG8_SB(0, 0), b2, voffB);
            PG8_BAR; PG8_WAIT_L(0); PG8_MMA(0, 1, At, B1); PG8_BAR;
            PG8_LDA(At, 0, 1); PG8_STAGE(PG8_SA(0, 0), a2, voffA);
            PG8_BAR; PG8_WAIT_L(0); PG8_MMA(1, 0, At, B0); PG8_BAR; PG8_SCHED;
            PG8_STAGE(PG8_SB(0, 1), b2 + hstep, voffB);
            PG8_WAIT_V(6); PG8_BAR; PG8_MMA(1, 1, At, B1); PG8_BAR;
            PG8_LDB(B0, 1, 0); PG8_SCHED; PG8_LDA(At, 1, 0); PG8_STAGE(PG8_SA(0, 1), a2 + hstep, voffA);
            PG8_WAIT_L(8); PG8_BAR; PG8_WAIT_L(0); PG8_MMA(0, 0, At, B0); PG8_BAR; PG8_SCHED;
            PG8_LDB(B1, 1, 1); PG8_STAGE(PG8_SB(1, 0), b3, voffB);
            PG8_BAR; PG8_WAIT_L(0); PG8_MMA(0, 1, At, B1); PG8_BAR;
            PG8_LDA(At, 1, 1); PG8_STAGE(PG8_SA(1, 0), a3, voffA);
            PG8_BAR; PG8_WAIT_L(0); PG8_MMA(1, 0, At, B0); PG8_BAR; PG8_SCHED;
            PG8_STAGE(PG8_SB(1, 1), b3 + hstep, voffB);
            PG8_WAIT_V(6); PG8_BAR; PG8_MMA(1, 1, At, B1); PG8_BAR;
            }
        }
        if constexpr (ALIGN_EPI) { if (wr == 0) PG8_BAR; }
        if constexpr (!Epi::AFTER_DRAIN) { E(acc, cur, wr, wc, fr, fq); S.done(cur); }
        if (!has_next) break;
#pragma unroll
        for (int a = 0; a < 2; ++a)
#pragma unroll
            for (int b = 0; b < 2; ++b)
#pragma unroll
                for (int m = 0; m < 4; ++m)
#pragma unroll
                    for (int n = 0; n < 2; ++n) acc[a][b][m][n] = (f32x4){0.f, 0.f, 0.f, 0.f};
        cur = nxt; cA = nA; cB = nB; ++ui;
        if constexpr (ALIGN_EPI) { if (wr == 1) PG8_BAR; }
    }
    PG8_WAIT_V(0);
    if constexpr (!ALIGN_EPI) { if (wr == 0) PG8_BAR; }
    PG8_BAR;
    if constexpr (Epi::AFTER_DRAIN) { E.fused(acc, cur, wr, wc, fr, fq, lds, wid, lane); S.done(cur); }
#undef PG8_SA
#undef PG8_SB
#undef PG8_STAGE
#undef PG8_LDA
#undef PG8_LDB
#undef PG8_MMA
#undef PG8_WAIT_V
#undef PG8_WAIT_L
#undef PG8_BAR
#undef PG8_SCHED
}
}

#define LAS __attribute__((address_space(3)))
typedef pg8::bf16_t bf16_t;
typedef pg8::bf16x8 bf16x8;
typedef pg8::f32x4 f32x4;
typedef pg8::u32x4 u32x4;
typedef unsigned u32x2 __attribute__((ext_vector_type(2)));
typedef float f32x2v __attribute__((ext_vector_type(2)));
using pg8::cvt_pk_bf16;
using pg8::fast_sigmoid;
using pg8::fast_silu;

constexpr int D = 1024, NB = 4, SEQ = 8192, NTOK = NB * SEQ;
#ifndef MK_NSPLIT
#define MK_NSPLIT 4
#endif
constexpr int NSPLIT = MK_NSPLIT, TS = SEQ / NSPLIT, MS = NB * TS;
constexpr int CL = 9728;
constexpr int C_R = 0, C_K = 1024, C_V = 2048, C_WLO = 3072, C_ALO = 3136, C_GLO = 3200, C_HQ = 3584, C_HF = 4608, C_HI = 5632, C_HG = 6656, C_GA = 7680, C_GB = 8704;
constexpr int CARRY_LD = 3584;
constexpr int DFF = 2816;
constexpr size_t MiB = 1u << 20, KiB = 1u << 10;
constexpr size_t WS_WIN = 0, WS_WOUT = 19 * MiB, WS_WQ = 21 * MiB, WS_WO = 23 * MiB, WS_WKV = 25 * MiB, WS_W13 = 29 * MiB, WS_W2 = 40 * MiB;
constexpr size_t WS_RW2T = 46 * MiB, WS_RA2T = 46 * MiB + 128 * KiB, WS_RG2T = 46 * MiB + 256 * KiB, WS_CARRY = 46 * MiB + 640 * KiB, WS_LB = 46 * MiB + 704 * KiB;
constexpr size_t WS_MBF = 47 * MiB, WS_KV = 49 * MiB, WS_VT = 53 * MiB, WS_RWST = 55 * MiB, WS_HGST = 56 * MiB, WS_BONUS = 58 * MiB;
constexpr size_t WS_G2TP = 59 * MiB;
constexpr size_t WS_MERGED = 64 * MiB;
constexpr size_t WS_U1 = 128 * MiB, WS_COLS = 144 * MiB, WS_PR = 296 * MiB, WS_PK = 312 * MiB, WS_PA = 328 * MiB, WS_PB = 344 * MiB, WS_PV = 360 * MiB, WS_PW = 376 * MiB, WS_ORAW = 408 * MiB, WS_HGO = 440 * MiB;
constexpr size_t WS_GATE = 472 * MiB, WS_ASG = 488 * MiB;
constexpr size_t WS_U = 128 * MiB, WS_Q = 192 * MiB, WS_AO = 256 * MiB, WS_FF = 320 * MiB, WS_CTL = 496 * MiB, CTL_BYTES = 64 * KiB, WS_END = 496 * MiB + 64 * KiB;
constexpr int LDS_BYTES = 147456, MISC_OFF = 131072 + 320;
constexpr int T0 = 1 + 5 * NSPLIT, N_PHASES = T0 + 9;

__device__ __forceinline__ float bflo(unsigned u) { return __uint_as_float(u << 16); }
__device__ __forceinline__ float bfhi(unsigned u) { return __uint_as_float(u & 0xffff0000u); }
__device__ __forceinline__ unsigned f2bf(float f) { unsigned u = __float_as_uint(f); return (u + 0x7fffu + ((u >> 16) & 1u)) >> 16; }
__device__ __forceinline__ f32x4 ld4bf(const bf16_t* p) { const u32x2 u = *(const u32x2*)p; return (f32x4){bflo(u.x), bfhi(u.x), bflo(u.y), bfhi(u.y)}; }
__device__ __forceinline__ void ld8bf(const bf16_t* p, float (&o)[8]) { const u32x4 u = *(const u32x4*)p; o[0] = bflo(u.x); o[1] = bfhi(u.x); o[2] = bflo(u.y); o[3] = bfhi(u.y); o[4] = bflo(u.z); o[5] = bfhi(u.z); o[6] = bflo(u.w); o[7] = bfhi(u.w); }
__device__ __forceinline__ void st4bf(bf16_t* p, f32x4 v) { u32x2 w; w.x = cvt_pk_bf16(v[0], v[1]); w.y = cvt_pk_bf16(v[2], v[3]); *(u32x2*)p = w; }
__device__ __forceinline__ bf16x8 pack8(const float (&t)[8]) { u32x4 w; w.x = cvt_pk_bf16(t[0], t[1]); w.y = cvt_pk_bf16(t[2], t[3]); w.z = cvt_pk_bf16(t[4], t[5]); w.w = cvt_pk_bf16(t[6], t[7]); return __builtin_bit_cast(bf16x8, w); }
__device__ __forceinline__ float tanh_fast(float x) { return 1.0f - 2.0f * __builtin_amdgcn_rcpf(1.0f + __expf(2.0f * x)); }
__device__ __forceinline__ float wave_sum(float v) {
#pragma unroll
    for (int o = 1; o < 64; o <<= 1) v += __shfl_xor(v, o);
    return v;
}
__device__ __forceinline__ float fq_sum(float v) { v += __shfl_xor(v, 16); v += __shfl_xor(v, 32); return v; }
template <int CTRL> __device__ __forceinline__ float dpp_add(float x) { return x + __builtin_bit_cast(float, __builtin_amdgcn_update_dpp(0, __builtin_bit_cast(int, x), CTRL, 0xf, 0xf, false)); }
#ifdef MK_SHFL_REDUCE
__device__ __forceinline__ float allreduce16(float x) { x += __shfl_xor(x, 1); x += __shfl_xor(x, 2); x += __shfl_xor(x, 4); x += __shfl_xor(x, 8); return x; }
#else
__device__ __forceinline__ float allreduce16(float x) { x = dpp_add<0xB1>(x); x = dpp_add<0x4E>(x); x = dpp_add<0x141>(x); x = dpp_add<0x140>(x); return x; }
#endif
__device__ __forceinline__ void allreduce16x2(float& x, float& y) {
    x = dpp_add<0xB1>(x); y = dpp_add<0xB1>(y); x = dpp_add<0x4E>(x); y = dpp_add<0x4E>(y); x = dpp_add<0x141>(x); y = dpp_add<0x141>(y); x = dpp_add<0x140>(x); y = dpp_add<0x140>(y); }
#define MFMA16(a, b, c) __builtin_amdgcn_mfma_f32_16x16x32_bf16((a), (b), (c), 0, 0, 0)

#define XB_TMO      128
#define XB_XCNT(j)  (256  + 64 * (j))
#define XB_XSUB(j)  (1280 + 64 * (j))
#define XB_XGEN(j)  (2304 + 64 * (j))
#define XB_TOP      3328
#define XB_TOPGEN   3392
#define XCD_BAR_WORDS 3456
#define XB_SPIN_CAP (1u << 18)

__device__ __forceinline__ unsigned xb_ld(unsigned* p)              { return __hip_atomic_load(p, __ATOMIC_RELAXED, __HIP_MEMORY_SCOPE_AGENT); }
__device__ __forceinline__ unsigned xb_add(unsigned* p, unsigned v) { return __hip_atomic_fetch_add(p, v, __ATOMIC_RELAXED, __HIP_MEMORY_SCOPE_AGENT); }
__device__ __forceinline__ unsigned xb_xcc_id() { return (unsigned)__builtin_amdgcn_s_getreg((3 << 11) | 20) & 0xFu; }
#define XB_SPIN(cond, bar) do { unsigned _sp = 0; while (cond) { __builtin_amdgcn_s_sleep(1); \
    if ((++_sp & 255u) == 0u) { if (xb_ld(&(bar)[XB_TMO])) break; if (_sp > XB_SPIN_CAP) { atomicAdd(&(bar)[XB_TMO], 1u); break; } } } } while (0)

struct XcdBarrier {
    unsigned* bar; unsigned x;
    volatile LAS unsigned* st;
};

__device__ __forceinline__ XcdBarrier xcd_barrier_post(unsigned* bar, volatile LAS unsigned* st) {
    XcdBarrier b; b.bar = bar; b.x = xb_xcc_id(); b.st = st;
    if (threadIdx.x == 0) (void)xb_add(&bar[XB_XCNT(b.x)], 1u);
    return b;
}
__device__ __forceinline__ void xcd_barrier_complete(unsigned* bar, unsigned x, unsigned& nloc, unsigned& nx) {
    const unsigned G = gridDim.x * gridDim.y * gridDim.z;
    unsigned sum, cnt, mine, sp = 0u;
    for (;;) {
        sum = 0u; cnt = 0u; mine = 0u;
#pragma unroll
        for (unsigned j = 0; j < 16; ++j) { const unsigned c = xb_ld(&bar[XB_XCNT(j)]); sum += c; cnt += (c > 0u) ? 1u : 0u; mine = (j == x) ? c : mine; }
        if (sum == G) break;
        __builtin_amdgcn_s_sleep(1);
        if ((++sp & 255u) == 0u) { if (xb_ld(&bar[XB_TMO])) break; if (sp > XB_SPIN_CAP) { atomicAdd(&bar[XB_TMO], 1u); break; } }
    }
    nloc = mine > 0u ? mine : 1u; nx = cnt > 0u ? cnt : 1u;
}

__device__ __forceinline__ void xcd_barrier(const XcdBarrier& b) {
    asm volatile("s_waitcnt vmcnt(0)" ::: "memory");
    __syncthreads();
    if (threadIdx.x == 0) {
        unsigned* bar = b.bar;
        __builtin_amdgcn_s_waitcnt(0);
        unsigned nloc = b.st[0], nx = b.st[1];
        if (nloc == 0u) { xcd_barrier_complete(bar, b.x, nloc, nx); b.st[0] = nloc; b.st[1] = nx; }
        const unsigned old = xb_add(&bar[XB_XSUB(b.x)], 1u);
        const unsigned gen = old / nloc;
        if (old + 1u == (gen + 1u) * nloc) {
            __builtin_amdgcn_fence(__ATOMIC_RELEASE, "agent");
            asm volatile("s_waitcnt vmcnt(0)" ::: "memory");
            const unsigned og = xb_add(&bar[XB_TOP], 1u);
            const unsigned tg = og / nx;
            if (og + 1u == (tg + 1u) * nx) xb_add(&bar[XB_TOPGEN], 1u);
            else XB_SPIN(xb_ld(&bar[XB_TOPGEN]) == tg, bar);
            __builtin_amdgcn_fence(__ATOMIC_ACQUIRE, "agent");
            xb_add(&bar[XB_XGEN(b.x)], 1u);
            asm volatile("s_waitcnt vmcnt(0)" ::: "memory");
        } else {
            XB_SPIN(xb_ld(&bar[XB_XGEN(b.x)]) == gen, bar);
            __builtin_amdgcn_fence(__ATOMIC_ACQUIRE, "agent");
            asm volatile("s_waitcnt vmcnt(0)" ::: "memory");
        }
    }
    __syncthreads();
}

__device__ __forceinline__ void rms_row_bf16(const float* src, const float* g, bf16_t* dst, int lane) {
    f32x4 v[4]; float s = 0.f;
#pragma unroll
    for (int j = 0; j < 4; ++j) { v[j] = ((const f32x4*)src)[lane + 64 * j]; s += (v[j][0] * v[j][0] + v[j][1] * v[j][1]) + (v[j][2] * v[j][2] + v[j][3] * v[j][3]); }
    const float rs = 1.0f / sqrtf(wave_sum(s) * (1.0f / 1024.0f) + 1e-6f);
#pragma unroll
    for (int j = 0; j < 4; ++j) { const f32x4 gv = ((const f32x4*)g)[lane + 64 * j]; st4bf(dst + 4 * (lane + 64 * j), v[j] * rs * gv); }
}
__device__ __forceinline__ void tr_item(const float* W, int K, int N, bf16_t* WT, int kb, int n0, int row_base, LAS float* scr, int lane) {
    const int k0 = 64 * kb;
#pragma unroll 8
    for (int i = 0; i < 32; ++i) { const int kk = 2 * i + (lane >> 5); scr[kk * 33 + (lane & 31)] = W[(size_t)(k0 + kk) * N + n0 + (lane & 31)]; }
    asm volatile("s_waitcnt lgkmcnt(0)" ::: "memory");
    const int c = lane & 7;
#pragma unroll
    for (int j = 0; j < 4; ++j) { const int n = (lane >> 3) + 8 * j; const LAS float* sp = scr + (8 * c) * 33 + n;
        u32x4 o; o.x = cvt_pk_bf16(sp[0 * 33], sp[1 * 33]); o.y = cvt_pk_bf16(sp[2 * 33], sp[3 * 33]); o.z = cvt_pk_bf16(sp[4 * 33], sp[5 * 33]); o.w = cvt_pk_bf16(sp[6 * 33], sp[7 * 33]);
        *(u32x4*)(WT + (size_t)(row_base + n) * K + k0 + 8 * c) = o; }
    asm volatile("s_waitcnt lgkmcnt(0)" ::: "memory");
}

__device__ __forceinline__ void prep_phase(int s, int gw, int NGW, int lane, const bf16_t* cols, const bf16_t* carry,
        const float* mu, const float* w0, const float* a0, const float* k_k, const float* k_a, const float* r_k,
        const bf16_t* w2T, const bf16_t* a2T, bf16_t* PR, bf16_t* PK, bf16_t* PA, bf16_t* PB, bf16_t* PV, float* PW, float* bonus, bf16_t* ASG) {
    const int fr = lane & 15, fq = lane >> 4;
    for (int item = gw; item < (MS / 16) * 4; item += NGW) {
        const int tile = item >> 2, hg4 = item & 3;
        const int lt = tile * 16 + fr, b = lt / TS, tl = lt % TS;
        const bf16_t* crow = cols + (size_t)lt * CL;
        const bf16_t* prow = tl > 0 ? crow - CL : carry + ((s & 1) * 4 + b) * CARRY_LD;
        bf16x8 Aw[2], Aa[2];
#pragma unroll
        for (int ks = 0; ks < 2; ++ks) {
            { const int c = C_WLO + ks * 32 + fq * 8; float cur[8], prv[8], t[8]; ld8bf(crow + c, cur); ld8bf(prow + c, prv);
              const f32x4 m0 = *(const f32x4*)(mu + c), m1 = *(const f32x4*)(mu + c + 4);
#pragma unroll
              for (int e = 0; e < 8; ++e) { const float mm = e < 4 ? m0[e & 3] : m1[e & 3]; t[e] = tanh_fast(cur[e] + mm * (prv[e] - cur[e])); }
              Aw[ks] = pack8(t); }
            { const int c = C_ALO + ks * 32 + fq * 8; float cur[8], prv[8], t[8]; ld8bf(crow + c, cur); ld8bf(prow + c, prv);
              const f32x4 m0 = *(const f32x4*)(mu + c), m1 = *(const f32x4*)(mu + c + 4);
#pragma unroll
              for (int e = 0; e < 8; ++e) { const float mm = e < 4 ? m0[e & 3] : m1[e & 3]; t[e] = cur[e] + mm * (prv[e] - cur[e]); }
              Aa[ks] = pack8(t); }
        }
        if (hg4 == 0) {
#pragma unroll
            for (int ks = 0; ks < 5; ++ks) { const int c = C_GLO + ks * 32 + fq * 8; float cur[8], prv[8], t[8]; ld8bf(crow + c, cur); ld8bf(prow + c, prv);
                const f32x4 m0 = *(const f32x4*)(mu + c), m1 = *(const f32x4*)(mu + c + 4);
#pragma unroll
                for (int e = 0; e < 8; ++e) { const float mm = e < 4 ? m0[e & 3] : m1[e & 3]; t[e] = fast_sigmoid(cur[e] + mm * (prv[e] - cur[e])); }
                *(bf16x8*)(ASG + (size_t)lt * 256 + ks * 32 + fq * 8) = pack8(t); }
#pragma unroll
            for (int ks = 5; ks < 8; ++ks) *(u32x4*)(ASG + (size_t)lt * 256 + ks * 32 + fq * 8) = (u32x4){0u, 0u, 0u, 0u};
        }
#pragma unroll 1
        for (int hh = 0; hh < 4; ++hh) {
            const int h = hg4 * 4 + hh;
            f32x4 aw[4], aa[4];
#pragma unroll
            for (int nt = 0; nt < 4; ++nt) { aw[nt] = (f32x4){0.f, 0.f, 0.f, 0.f}; aa[nt] = (f32x4){0.f, 0.f, 0.f, 0.f};
                const int n = h * 64 + nt * 16 + fr;
#pragma unroll
                for (int ks = 0; ks < 2; ++ks) { const bf16x8 bw = *(const bf16x8*)(w2T + n * 64 + ks * 32 + fq * 8); aw[nt] = MFMA16(bw, Aw[ks], aw[nt]);
                    const bf16x8 ba = *(const bf16x8*)(a2T + n * 64 + ks * 32 + fq * 8); aa[nt] = MFMA16(ba, Aa[ks], aa[nt]); } }
            f32x4 kkv[4], av[4]; float ssq = 0.f, bon = 0.f;
#pragma unroll
            for (int nt = 0; nt < 4; ++nt) {
                const int c = h * 64 + nt * 16 + 4 * fq; const size_t o = (size_t)lt * 1024 + c;
                const f32x4 rc = ld4bf(crow + C_R + c), rp = ld4bf(prow + C_R + c), kc = ld4bf(crow + C_K + c), kp = ld4bf(prow + C_K + c), vc = ld4bf(crow + C_V + c), vp = ld4bf(prow + C_V + c);
                const f32x4 r = rc + *(const f32x4*)(mu + C_R + c) * (rp - rc), k = kc + *(const f32x4*)(mu + C_K + c) * (kp - kc), v = vc + *(const f32x4*)(mu + C_V + c) * (vp - vc);
                const f32x4 w0v = *(const f32x4*)(w0 + c), a0v = *(const f32x4*)(a0 + c), kkp = *(const f32x4*)(k_k + c), kap = *(const f32x4*)(k_a + c), rkp = *(const f32x4*)(r_k + c);
                f32x4 wv, a, kk, kmod;
#pragma unroll
                for (int j = 0; j < 4; ++j) {
                    const float z = -(w0v[j] + aw[nt][j]);
                    const float sp = fmaxf(z, 0.f) + __logf(1.0f + __expf(-fabsf(z)));
                    wv[j] = __expf(-__expf(-sp - 0.5f));
                    a[j] = fast_sigmoid(a0v[j] + aa[nt][j]);
                    kk[j] = k[j] * kkp[j]; kmod[j] = k[j] * (1.0f + (a[j] - 1.0f) * kap[j]);
                    ssq += kk[j] * kk[j]; bon += r[j] * kmod[j] * rkp[j];
                }
                kkv[nt] = kk; av[nt] = a;
                st4bf(PR + o, r); st4bf(PK + o, kmod); st4bf(PV + o, v); *(f32x4*)(PW + o) = wv;
            }
            ssq = fq_sum(ssq); bon = fq_sum(bon);
            const float rs = 1.0f / sqrtf(fmaxf(ssq, 1e-24f));
#pragma unroll
            for (int nt = 0; nt < 4; ++nt) { const int c = h * 64 + nt * 16 + 4 * fq; const size_t o = (size_t)lt * 1024 + c;
                const f32x4 kn = kkv[nt] * rs; st4bf(PA + o, -kn); st4bf(PB + o, kn * av[nt]); }
            if (fq == 0) bonus[lt * 16 + h] = bon;
        }
    }
}

__device__ __forceinline__ void post_phase(int s, int gw, int NGW, int lane, const bf16_t* cols, const bf16_t* carry, const float* mu, const bf16_t* gate,
        const float* ln_w, const float* ln_b, const float* hg_g, const float* oraw, const float* hgo, const bf16_t* PV, const float* bonus, bf16_t* merged) {
    const int fr = lane & 15, fq = lane >> 4;
    for (int item = gw; item < (MS / 16) * 4; item += NGW) {
        const int tile = item >> 2, q4 = item & 3;
        const int lt = tile * 16 + fr, b = lt / TS, tl = lt % TS;
        const size_t gt = (size_t)b * SEQ + s * TS + tl;
        const bf16_t* crow = cols + (size_t)lt * CL;
        const bf16_t* prow = tl > 0 ? crow - CL : carry + ((s & 1) * 4 + b) * CARRY_LD;
#pragma unroll 1
        for (int hgh = 0; hgh < 2; ++hgh) {
            const int h8 = q4 * 2 + hgh;
            f32x4 ho[8]; float ss = 0.f;
#pragma unroll
            for (int n8 = 0; n8 < 8; ++n8) { ho[n8] = *(const f32x4*)(hgo + ((size_t)((b * 8 + h8) * 8 + n8) * TS + tl) * 16 + 4 * fq); ss += (ho[n8][0] * ho[n8][0] + ho[n8][1] * ho[n8][1]) + (ho[n8][2] * ho[n8][2] + ho[n8][3] * ho[n8][3]); }
            ss = fq_sum(ss);
            const float rsh = 1.0f / sqrtf(ss * (1.0f / 128.0f) + 1e-6f);
#pragma unroll
            for (int rwh = 0; rwh < 2; ++rwh) {
                const int h = q4 * 4 + hgh * 2 + rwh;
                f32x4 ag[4], o[4]; float sm = 0.f;
#pragma unroll
                for (int nt = 0; nt < 4; ++nt) { ag[nt] = ld4bf(gate + (size_t)lt * 1024 + h * 64 + nt * 16 + 4 * fq);
                    o[nt] = *(const f32x4*)(oraw + ((size_t)((b * 16 + h) * 4 + nt) * TS + tl) * 16 + 4 * fq); sm += (o[nt][0] + o[nt][1]) + (o[nt][2] + o[nt][3]); }
                const float mean = fq_sum(sm) * (1.0f / 64.0f); float vq = 0.f;
#pragma unroll
                for (int nt = 0; nt < 4; ++nt) { o[nt] = o[nt] - mean; vq += (o[nt][0] * o[nt][0] + o[nt][1] * o[nt][1]) + (o[nt][2] * o[nt][2] + o[nt][3] * o[nt][3]); }
                const float rstd = 1.0f / sqrtf(fq_sum(vq) * (1.0f / 64.0f) + 64e-5f);
#ifdef MK_NO_BONUS
                const float bon = 0.f;
#else
                const float bon = bonus[lt * 16 + h];
#endif
#pragma unroll
                for (int nt = 0; nt < 4; ++nt) {
                    const int c = h * 64 + nt * 16 + 4 * fq;
                    const f32x4 lw = *(const f32x4*)(ln_w + c), lb = *(const f32x4*)(ln_b + c), v = ld4bf(PV + (size_t)lt * 1024 + c);
                    const f32x4 ya = (o[nt] * rstd * lw + lb + v * bon) * ag[nt];
                    const f32x4 ng = *(const f32x4*)(hg_g + (c & 127)), gh = ld4bf(crow + C_HG + c), gar = ld4bf(crow + C_GA + c), gbr = ld4bf(crow + C_GB + c);
                    const f32x4 hv = ho[rwh * 4 + nt] * rsh * ng;
                    f32x4 m;
#pragma unroll
                    for (int j = 0; j < 4; ++j) {
#if defined(MK_ZERO_YA)
                        m[j] = fast_sigmoid(gbr[j]) * (hv[j] * fast_silu(gh[j]));
#elif defined(MK_ZERO_YB)
                        m[j] = fast_sigmoid(gar[j]) * ya[j];
#else
                        m[j] = gar[j] * ya[j] + gbr[j] * (hv[j] * gh[j]);
#endif
                    }
                    st4bf(merged + gt * 1024 + c, m);
                }
            }
        }
    }
}

constexpr int RWB = 45056;
#define SCAN_BAR_L() do { asm volatile("s_waitcnt vmcnt(0) lgkmcnt(0)" ::: "memory"); __builtin_amdgcn_s_barrier(); asm volatile("" ::: "memory"); } while (0)
#define SCAN_BAR_S() do { asm volatile("s_waitcnt lgkmcnt(0)" ::: "memory"); __builtin_amdgcn_s_barrier(); asm volatile("" ::: "memory"); } while (0)
__device__ __forceinline__ void rw_load(LAS unsigned char* bp, int lt2, size_t ltok0, int h, int rg, const bf16_t* PA, const float* PW, const bf16_t* PB, const bf16_t* PK, const bf16_t* PR, const bf16_t* PV) {
    const int tok = lt2 >> 3, c8 = (lt2 & 7) * 8; const size_t base = (ltok0 + tok) * 1024 + h * 64 + c8;
    const u32x4 ra = *(const u32x4*)(PA + base), rb = *(const u32x4*)(PB + base), rk = *(const u32x4*)(PK + base), rr = *(const u32x4*)(PR + base);
    const f32x4 w0 = *(const f32x4*)(PW + base), w1 = *(const f32x4*)(PW + base + 4);
    const unsigned rv = *(const unsigned*)(PV + (ltok0 + tok) * 1024 + h * 64 + rg * 16 + (lt2 & 7) * 2);
    const int off = (tok * 64 + c8) * 4;
#define RW_PUT(arr, u) do { *(LAS f32x4*)(bp + (arr) * 8192 + off) = (f32x4){bflo(u.x), bfhi(u.x), bflo(u.y), bfhi(u.y)}; *(LAS f32x4*)(bp + (arr) * 8192 + off + 16) = (f32x4){bflo(u.z), bfhi(u.z), bflo(u.w), bfhi(u.w)}; } while (0)
    RW_PUT(0, ra); RW_PUT(2, rb); RW_PUT(3, rk); RW_PUT(4, rr);
#undef RW_PUT
    *(LAS f32x4*)(bp + 8192 + off) = w0; *(LAS f32x4*)(bp + 8192 + off + 16) = w1;
    *(LAS f32x2v*)(bp + 40960 + (tok * 16 + (lt2 & 7) * 2) * 4) = (f32x2v){bflo(rv), bfhi(rv)};
}
__device__ __forceinline__ void y_drain(const LAS unsigned char* ybase, int lt2, float* dst) { *(f32x2v*)(dst + lt2 * 2) = *(const LAS f32x2v*)(ybase + lt2 * 8); }
__device__ __forceinline__ void rwkv_scan(int s, int bid, int G, int tid, int lane, int wave, LAS unsigned char* lds,
        const bf16_t* PA, const float* PW, const bf16_t* PB, const bf16_t* PK, const bf16_t* PR, const bf16_t* PV, float* oraw, float* state, bool save) {
    constexpr int NBLK = TS / 32;
    const int rowl = lane >> 4, j = lane & 15, row = (wave & 3) * 4 + rowl;
    for (int it = bid; it < 256; it += G) {
        const int b = it >> 6, h = (it >> 2) & 15, rg = it & 3;
        const size_t tok0 = (size_t)b * TS;
        float* stp = state + ((size_t)((b * 16 + h) * 64 + rg * 16 + row) * 64 + 4 * j);
        float* obase = oraw + (size_t)it * TS * 16;
        f32x4 st = (f32x4){0.f, 0.f, 0.f, 0.f};
        if (wave < 4 && s > 0) st = *(const f32x4*)stp;
        if (wave >= 4) { rw_load(lds, tid - 256, tok0, h, rg, PA, PW, PB, PK, PR, PV); SCAN_BAR_L(); } else { __builtin_amdgcn_s_setprio(2); asm volatile("s_waitcnt vmcnt(0)" ::: "memory"); SCAN_BAR_S(); }
#pragma unroll 1
        for (int blk = 0; blk < NBLK; ++blk) {
            if (wave >= 4) {
                if (blk > 0) y_drain(lds + ((blk - 1) & 1) * RWB + 43008, tid - 256, obase + (size_t)(blk - 1) * 512);
                if (blk + 1 < NBLK) rw_load(lds + ((blk + 1) & 1) * RWB, tid - 256, tok0 + (blk + 1) * 32, h, rg, PA, PW, PB, PK, PR, PV);
                SCAN_BAR_L();
            } else {
                const LAS unsigned char* bp = lds + (blk & 1) * RWB;
                const LAS unsigned char* p4 = bp + 16 * j; const LAS unsigned char* pv = bp + 40960 + row * 4; LAS unsigned char* py = (LAS unsigned char*)bp + 43008 + row * 4;
                f32x4 a4 = *(const LAS f32x4*)(p4), w4 = *(const LAS f32x4*)(p4 + 8192), b4 = *(const LAS f32x4*)(p4 + 16384), k4 = *(const LAS f32x4*)(p4 + 24576), r4 = *(const LAS f32x4*)(p4 + 32768);
                float vv = *(const LAS float*)(pv);
                float sa = (st[0] * a4[0] + st[1] * a4[1]) + (st[2] * a4[2] + st[3] * a4[3]);
                sa = allreduce16(sa);
#pragma unroll
                for (int t = 0; t < 32; ++t) {
                    f32x4 na = a4, nw = w4, nb = b4, nk = k4, nr = r4; float nv = vv;
                    if (t < 31) { const int o = (t + 1) * 256; na = *(const LAS f32x4*)(p4 + o); nw = *(const LAS f32x4*)(p4 + 8192 + o); nb = *(const LAS f32x4*)(p4 + 16384 + o); nk = *(const LAS f32x4*)(p4 + 24576 + o); nr = *(const LAS f32x4*)(p4 + 32768 + o); nv = *(const LAS float*)(pv + (t + 1) * 64); }
                    st = st * w4 + (b4 * sa + k4 * vv);
                    float y = (st[0] * r4[0] + st[1] * r4[1]) + (st[2] * r4[2] + st[3] * r4[3]);
                    float sn = (st[0] * na[0] + st[1] * na[1]) + (st[2] * na[2] + st[3] * na[3]);
                    allreduce16x2(sn, y);
                    if (j == 0) *(LAS float*)(py + t * 64) = y;
                    sa = sn; a4 = na; w4 = nw; b4 = nb; k4 = nk; r4 = nr; vv = nv;
                }
                SCAN_BAR_S();
            }
        }
        if (wave >= 4) { y_drain(lds + ((NBLK - 1) & 1) * RWB + 43008, tid - 256, obase + (size_t)(NBLK - 1) * 512); }
        else { __builtin_amdgcn_s_setprio(0); if (save) *(f32x4*)stp = st; }
    }
}

__device__ __forceinline__ void rwkv_scan_naive(int s, int gw, int NGW, int lane, int wave, LAS unsigned char* lds,
        const bf16_t* PA, const float* PW, const bf16_t* PB, const bf16_t* PK, const bf16_t* PR, const bf16_t* PV, float* oraw, float* state) {
    LAS float* slab = (LAS float*)(lds + wave * 2048);
    for (int it = gw; it < 64; it += NGW) {
        const int b = it >> 4, h = it & 15;
        float st[64];
        float* stp = state + (size_t)((b * 16 + h) * 64 + lane) * 64;
#pragma unroll
        for (int k = 0; k < 64; ++k) st[k] = (s > 0) ? stp[k] : 0.f;
        for (int tl = 0; tl < TS; ++tl) {
            const size_t base = ((size_t)b * TS + tl) * 1024 + h * 64 + lane;
            slab[lane] = bflo((unsigned)PA[base]); slab[64 + lane] = PW[base]; slab[128 + lane] = bflo((unsigned)PB[base]); slab[192 + lane] = bflo((unsigned)PK[base]); slab[256 + lane] = bflo((unsigned)PR[base]);
            const float vv = bflo((unsigned)PV[base]);
            asm volatile("s_waitcnt lgkmcnt(0)" ::: "memory");
            float sa = 0.f;
#pragma unroll
            for (int k = 0; k < 64; ++k) sa += st[k] * slab[k];
            float y = 0.f;
#pragma unroll
            for (int k = 0; k < 64; ++k) { st[k] = st[k] * slab[64 + k] + (sa * slab[128 + k] + vv * slab[192 + k]); y += st[k] * slab[256 + k]; }
            asm volatile("s_waitcnt lgkmcnt(0)" ::: "memory");
            oraw[((size_t)(it * 4 + (lane >> 4)) * TS + tl) * 16 + (lane & 15)] = y;
        }
#pragma unroll
        for (int k = 0; k < 64; ++k) stp[k] = st[k];
    }
}
constexpr int HGB = 53248;
__device__ __forceinline__ void hg_load(LAS unsigned char* bp, int lt2, size_t ltok0, int h8, int rg, const bf16_t* cols, const float* lbv) {
    const int tok = lt2 >> 3, c16 = (lt2 & 7) * 16; const bf16_t* crow = cols + (ltok0 + tok) * CL;
    float q[16], f[16];
    { float t[8]; ld8bf(crow + C_HQ + h8 * 128 + c16, t);
#pragma unroll
      for (int e = 0; e < 8; ++e) q[e] = t[e];
      ld8bf(crow + C_HQ + h8 * 128 + c16 + 8, t);
#pragma unroll
      for (int e = 0; e < 8; ++e) q[8 + e] = t[e];
      ld8bf(crow + C_HF + h8 * 128 + c16, t);
#pragma unroll
      for (int e = 0; e < 8; ++e) f[e] = t[e];
      ld8bf(crow + C_HF + h8 * 128 + c16 + 8, t);
#pragma unroll
      for (int e = 0; e < 8; ++e) f[8 + e] = t[e]; }
    const unsigned rv = *(const unsigned*)(crow + C_HI + h8 * 128 + rg * 16 + (lt2 & 7) * 2);
    const int off = (tok * 128 + c16) * 4;
#pragma unroll
    for (int g = 0; g < 4; ++g) { const f32x4 lb = *(const f32x4*)(lbv + h8 * 128 + c16 + 4 * g); f32x4 fv, kv, qv;
#pragma unroll
        for (int e = 0; e < 4; ++e) { fv[e] = lb[e] + (1.0f - lb[e]) * fast_sigmoid(f[4 * g + e]); kv[e] = 1.0f - fv[e]; qv[e] = fast_silu(q[4 * g + e]); }
        *(LAS f32x4*)(bp + off + 16 * g) = fv; *(LAS f32x4*)(bp + 16384 + off + 16 * g) = kv; *(LAS f32x4*)(bp + 32768 + off + 16 * g) = qv; }
    *(LAS f32x2v*)(bp + 49152 + (tok * 16 + (lt2 & 7) * 2) * 4) = (f32x2v){bflo(rv), bfhi(rv)};
}
__device__ __forceinline__ void hgrn_scan(int s, int bid, int G, int tid, int lane, int wave, LAS unsigned char* lds, const bf16_t* cols, const float* lbv, float* hgo, float* state, bool save) {
    constexpr int NBLK = TS / 32;
    const int rowl = lane >> 4, j = lane & 15, row = (wave & 3) * 4 + rowl;
    for (int it = bid; it < 256; it += G) {
        const int b = it >> 6, h8 = (it >> 3) & 7, rg = it & 7;
        const size_t tok0 = (size_t)b * TS;
        float* stp = state + ((size_t)((b * 8 + h8) * 128 + rg * 16 + row) * 128 + 4 * j);
        float* obase = hgo + (size_t)it * TS * 16;
        f32x4 s0 = (f32x4){0.f, 0.f, 0.f, 0.f}, s1 = s0;
        if (wave < 4 && s > 0) { s0 = *(const f32x4*)stp; s1 = *(const f32x4*)(stp + 64); }
        if (wave >= 4) { hg_load(lds, tid - 256, tok0, h8, rg, cols, lbv); SCAN_BAR_L(); } else { __builtin_amdgcn_s_setprio(2); asm volatile("s_waitcnt vmcnt(0)" ::: "memory"); SCAN_BAR_S(); }
#pragma unroll 1
        for (int blk = 0; blk < NBLK; ++blk) {
            if (wave >= 4) {
                if (blk > 0) y_drain(lds + ((blk - 1) & 1) * HGB + 51200, tid - 256, obase + (size_t)(blk - 1) * 512);
                if (blk + 1 < NBLK) hg_load(lds + ((blk + 1) & 1) * HGB, tid - 256, tok0 + (blk + 1) * 32, h8, rg, cols, lbv);
                SCAN_BAR_L();
            } else {
                const LAS unsigned char* bp = lds + (blk & 1) * HGB;
                const LAS unsigned char* p4 = bp + 16 * j; const LAS unsigned char* pv = bp + 49152 + row * 4; LAS unsigned char* py = (LAS unsigned char*)bp + 51200 + row * 4;
                f32x4 f0 = *(const LAS f32x4*)(p4), f1 = *(const LAS f32x4*)(p4 + 256), k0 = *(const LAS f32x4*)(p4 + 16384), k1 = *(const LAS f32x4*)(p4 + 16384 + 256), q0 = *(const LAS f32x4*)(p4 + 32768), q1 = *(const LAS f32x4*)(p4 + 32768 + 256);
                float iv = *(const LAS float*)(pv); float yprev = 0.f;
#pragma unroll
                for (int t = 0; t < 32; ++t) {
                    f32x4 nf0 = f0, nf1 = f1, nk0 = k0, nk1 = k1, nq0 = q0, nq1 = q1; float niv = iv;
                    if (t < 31) { const int o = (t + 1) * 512; nf0 = *(const LAS f32x4*)(p4 + o); nf1 = *(const LAS f32x4*)(p4 + 256 + o); nk0 = *(const LAS f32x4*)(p4 + 16384 + o); nk1 = *(const LAS f32x4*)(p4 + 16384 + 256 + o);
                                  nq0 = *(const LAS f32x4*)(p4 + 32768 + o); nq1 = *(const LAS f32x4*)(p4 + 32768 + 256 + o); niv = *(const LAS float*)(pv + (t + 1) * 64); }
                    s0 = s0 * f0 + k0 * iv; s1 = s1 * f1 + k1 * iv;
                    float y = ((s0[0] * q0[0] + s0[1] * q0[1]) + (s0[2] * q0[2] + s0[3] * q0[3])) + ((s1[0] * q1[0] + s1[1] * q1[1]) + (s1[2] * q1[2] + s1[3] * q1[3]));
                    if (t & 1) { allreduce16x2(yprev, y); if (j == 0) { *(LAS float*)(py + (t - 1) * 64) = yprev; *(LAS float*)(py + t * 64) = y; } }
                    yprev = y;
                    f0 = nf0; f1 = nf1; k0 = nk0; k1 = nk1; q0 = nq0; q1 = nq1; iv = niv;
                }
                SCAN_BAR_S();
            }
        }
        if (wave >= 4) { y_drain(lds + ((NBLK - 1) & 1) * HGB + 51200, tid - 256, obase + (size_t)(NBLK - 1) * 512); }
        else { __builtin_amdgcn_s_setprio(0); if (save) { *(f32x4*)stp = s0; *(f32x4*)(stp + 64) = s1; } }
    }
}


constexpr int FT = 16;
constexpr int F_RW = 0, F_RWV = 20480, F_RWY = 21504, F_HG = 22528, F_HGQ = 8192, F_HGI = F_HG + 16384, F_HGY = F_HG + 17408, FBUF = 40960;
__device__ __forceinline__ void fused_load(LAS unsigned char* bp, int lt2, size_t ltok0, int h, int rg, int h8, int rg8, const bf16_t* PA, const float* PW, const bf16_t* PB, const bf16_t* PK, const bf16_t* PR, const bf16_t* PV,
        const bf16_t* cols, const float* lbv) {
    if (lt2 < 128) {
        const int tok = lt2 >> 3, c8 = (lt2 & 7) * 8; const size_t base = (ltok0 + tok) * 1024 + h * 64 + c8;
        const u32x4 ra = *(const u32x4*)(PA + base), rb = *(const u32x4*)(PB + base), rk = *(const u32x4*)(PK + base), rr = *(const u32x4*)(PR + base);
        const f32x4 w0 = *(const f32x4*)(PW + base), w1 = *(const f32x4*)(PW + base + 4);
        const unsigned rv = *(const unsigned*)(PV + (ltok0 + tok) * 1024 + h * 64 + rg * 16 + (lt2 & 7) * 2);
        const int off = (tok * 64 + c8) * 4;
#define RW_PUT(arr, u) do { *(LAS f32x4*)(bp + (arr) * 4096 + off) = (f32x4){bflo(u.x), bfhi(u.x), bflo(u.y), bfhi(u.y)}; *(LAS f32x4*)(bp + (arr) * 4096 + off + 16) = (f32x4){bflo(u.z), bfhi(u.z), bflo(u.w), bfhi(u.w)}; } while (0)
        RW_PUT(0, ra); RW_PUT(2, rb); RW_PUT(3, rk); RW_PUT(4, rr);
#undef RW_PUT
        *(LAS f32x4*)(bp + 4096 + off) = w0; *(LAS f32x4*)(bp + 4096 + off + 16) = w1;
        *(LAS f32x2v*)(bp + F_RWV + (tok * 16 + (lt2 & 7) * 2) * 4) = (f32x2v){bflo(rv), bfhi(rv)};
    } else {
        const int l = lt2 - 128, tok = l >> 3, c16 = (l & 7) * 16; const bf16_t* crow = cols + (ltok0 + tok) * CL;
        float q[16], f[16];
        { float t[8]; ld8bf(crow + C_HQ + h8 * 128 + c16, t);
#pragma unroll
          for (int e = 0; e < 8; ++e) q[e] = t[e];
          ld8bf(crow + C_HQ + h8 * 128 + c16 + 8, t);
#pragma unroll
          for (int e = 0; e < 8; ++e) q[8 + e] = t[e];
          ld8bf(crow + C_HF + h8 * 128 + c16, t);
#pragma unroll
          for (int e = 0; e < 8; ++e) f[e] = t[e];
          ld8bf(crow + C_HF + h8 * 128 + c16 + 8, t);
#pragma unroll
          for (int e = 0; e < 8; ++e) f[8 + e] = t[e]; }
        const unsigned rv = *(const unsigned*)(crow + C_HI + h8 * 128 + rg8 * 16 + (l & 7) * 2);
        LAS unsigned char* hp = bp + F_HG; const int off = (tok * 128 + c16) * 4;
#pragma unroll
        for (int g = 0; g < 4; ++g) { const f32x4 lb = *(const f32x4*)(lbv + h8 * 128 + c16 + 4 * g); f32x4 fv, qv;
#pragma unroll
            for (int e = 0; e < 4; ++e) { fv[e] = lb[e] + (1.0f - lb[e]) * f[4 * g + e]; qv[e] = q[4 * g + e]; }
            *(LAS f32x4*)(hp + off + 16 * g) = fv; *(LAS f32x4*)(hp + F_HGQ + off + 16 * g) = qv; }
        *(LAS f32x2v*)(bp + F_HGI + (tok * 16 + (l & 7) * 2) * 4) = (f32x2v){bflo(rv), bfhi(rv)};
    }
}
__device__ __forceinline__ void fused_drain(const LAS unsigned char* bp, int lt2, float* orw, float* ohg) {
    if (lt2 < 128) *(f32x2v*)(orw + lt2 * 2) = *(const LAS f32x2v*)(bp + F_RWY + lt2 * 8);
    else *(f32x2v*)(ohg + (lt2 - 128) * 2) = *(const LAS f32x2v*)(bp + F_HGY + (lt2 - 128) * 8);
}
__device__ __forceinline__ void fused_scan(int s, int bid, int G, int tid, int lane, int wave, LAS unsigned char* lds,
        const bf16_t* PA, const float* PW, const bf16_t* PB, const bf16_t* PK, const bf16_t* PR, const bf16_t* PV, const bf16_t* cols, const float* lbv,
        float* oraw, float* hgo, float* rwstate, float* hgstate, bool save) {
    constexpr int NBLK = TS / FT;
    const int rowl = lane >> 4, j = lane & 15, row = (wave & 3) * 4 + rowl;
    for (int it = bid; it < 256; it += G) {
        const int b = it >> 6, h = (it >> 2) & 15, rg = it & 3, h8 = (it >> 3) & 7, rg8 = it & 7;
        const size_t tok0 = (size_t)b * TS;
        float* stp = rwstate + ((size_t)((b * 16 + h) * 64 + rg * 16 + row) * 64 + 4 * j);
        float* shp = hgstate + ((size_t)((b * 8 + h8) * 128 + rg8 * 16 + row) * 128 + 4 * j);
        float* orw = oraw + (size_t)it * TS * 16; float* ohg = hgo + (size_t)it * TS * 16;
        f32x4 st = (f32x4){0.f, 0.f, 0.f, 0.f}, s0 = st, s1 = st;
        if (wave < 4 && s > 0) { st = *(const f32x4*)stp; s0 = *(const f32x4*)shp; s1 = *(const f32x4*)(shp + 64); }
        if (wave >= 4) { fused_load(lds, tid - 256, tok0, h, rg, h8, rg8, PA, PW, PB, PK, PR, PV, cols, lbv); SCAN_BAR_L(); } else { __builtin_amdgcn_s_setprio(2); asm volatile("s_waitcnt vmcnt(0)" ::: "memory"); SCAN_BAR_S(); }
#pragma unroll 1
        for (int blk = 0; blk < NBLK; ++blk) {
            if (wave >= 4) {
                if (blk > 0) fused_drain(lds + ((blk - 1) & 1) * FBUF, tid - 256, orw + (size_t)(blk - 1) * (FT * 16), ohg + (size_t)(blk - 1) * (FT * 16));
                if (blk + 1 < NBLK) fused_load(lds + ((blk + 1) & 1) * FBUF, tid - 256, tok0 + (blk + 1) * FT, h, rg, h8, rg8, PA, PW, PB, PK, PR, PV, cols, lbv);
                SCAN_BAR_L();
            } else {
                const LAS unsigned char* bp = lds + (blk & 1) * FBUF;
                const LAS unsigned char* p4 = bp + 16 * j; const LAS unsigned char* pv = bp + F_RWV + row * 4; LAS unsigned char* py = (LAS unsigned char*)bp + F_RWY + row * 4;
                const LAS unsigned char* g4 = bp + F_HG + 16 * j; const LAS unsigned char* gi = bp + F_HGI + row * 4; LAS unsigned char* gy = (LAS unsigned char*)bp + F_HGY + row * 4;
                f32x4 a4 = *(const LAS f32x4*)(p4), w4 = *(const LAS f32x4*)(p4 + 4096), b4 = *(const LAS f32x4*)(p4 + 8192), k4 = *(const LAS f32x4*)(p4 + 12288), r4 = *(const LAS f32x4*)(p4 + 16384);
                float vv = *(const LAS float*)(pv);
                f32x4 f0 = *(const LAS f32x4*)(g4), f1 = *(const LAS f32x4*)(g4 + 256), q0 = *(const LAS f32x4*)(g4 + F_HGQ), q1 = *(const LAS f32x4*)(g4 + F_HGQ + 256);
                float iv = *(const LAS float*)(gi);
                float sa = (st[0] * a4[0] + st[1] * a4[1]) + (st[2] * a4[2] + st[3] * a4[3]);
                sa = allreduce16(sa);
#pragma unroll
                for (int t = 0; t < FT; ++t) {
                    f32x4 na = a4, nw = w4, nb = b4, nk = k4, nr = r4; float nv = vv;
                    f32x4 nf0 = f0, nf1 = f1, nq0 = q0, nq1 = q1; float niv = iv;
                    if (t < FT - 1) { const int o = (t + 1) * 256; na = *(const LAS f32x4*)(p4 + o); nw = *(const LAS f32x4*)(p4 + 4096 + o); nb = *(const LAS f32x4*)(p4 + 8192 + o); nk = *(const LAS f32x4*)(p4 + 12288 + o); nr = *(const LAS f32x4*)(p4 + 16384 + o); nv = *(const LAS float*)(pv + (t + 1) * 64);
                        const int o2 = (t + 1) * 512; nf0 = *(const LAS f32x4*)(g4 + o2); nf1 = *(const LAS f32x4*)(g4 + 256 + o2);
                        nq0 = *(const LAS f32x4*)(g4 + F_HGQ + o2); nq1 = *(const LAS f32x4*)(g4 + F_HGQ + 256 + o2); niv = *(const LAS float*)(gi + (t + 1) * 64); }
                    st = st * w4 + (b4 * sa + k4 * vv);
                    s0 = (s0 - iv) * f0 + iv; s1 = (s1 - iv) * f1 + iv;
                    float y = (st[0] * r4[0] + st[1] * r4[1]) + (st[2] * r4[2] + st[3] * r4[3]);
                    float sn = (st[0] * na[0] + st[1] * na[1]) + (st[2] * na[2] + st[3] * na[3]);
                    float yh = ((s0[0] * q0[0] + s0[1] * q0[1]) + (s0[2] * q0[2] + s0[3] * q0[3])) + ((s1[0] * q1[0] + s1[1] * q1[1]) + (s1[2] * q1[2] + s1[3] * q1[3]));
                    sn = dpp_add<0xB1>(sn); y = dpp_add<0xB1>(y); yh = dpp_add<0xB1>(yh); sn = dpp_add<0x4E>(sn); y = dpp_add<0x4E>(y); yh = dpp_add<0x4E>(yh);
                    sn = dpp_add<0x141>(sn); y = dpp_add<0x141>(y); yh = dpp_add<0x141>(yh); sn = dpp_add<0x140>(sn); y = dpp_add<0x140>(y); yh = dpp_add<0x140>(yh);
                    if (j == 0) { *(LAS float*)(py + t * 64) = y; *(LAS float*)(gy + t * 64) = yh; }
                    sa = sn; a4 = na; w4 = nw; b4 = nb; k4 = nk; r4 = nr; vv = nv;
                    f0 = nf0; f1 = nf1; q0 = nq0; q1 = nq1; iv = niv;
                }
                SCAN_BAR_S();
            }
        }
        if (wave >= 4) fused_drain(lds + ((NBLK - 1) & 1) * FBUF, tid - 256, orw + (size_t)(NBLK - 1) * (FT * 16), ohg + (size_t)(NBLK - 1) * (FT * 16));
        else { __builtin_amdgcn_s_setprio(0); if (save) { *(f32x4*)stp = st; *(f32x4*)shp = s0; *(f32x4*)(shp + 64) = s1; } }
    }
}


constexpr int ST = 16;
constexpr int S_RWV = 20480, S_RWY = 22528, S_RWB = 24576;
constexpr int S_HGQ = 8192, S_HGI = 16384, S_HGY = 18432, S_HGB = 20480;
__device__ __forceinline__ void s_rw_load(LAS unsigned char* bp, int lt2, size_t ltok0, int h, int hf, const bf16_t* PA, const float* PW, const bf16_t* PB, const bf16_t* PK, const bf16_t* PR, const bf16_t* PV) {
    const int tok = lt2 >> 4, c4 = (lt2 & 15) * 4; const size_t base = (ltok0 + tok) * 1024 + h * 64 + c4;
    const f32x4 va = ld4bf(PA + base), vb = ld4bf(PB + base), vk = ld4bf(PK + base), vr = ld4bf(PR + base), vw = *(const f32x4*)(PW + base);
    const unsigned rv = *(const unsigned*)(PV + (ltok0 + tok) * 1024 + h * 64 + hf * 32 + (lt2 & 15) * 2);
    const int off = (tok * 64 + c4) * 4;
    *(LAS f32x4*)(bp + off) = va; *(LAS f32x4*)(bp + 4096 + off) = vw; *(LAS f32x4*)(bp + 8192 + off) = vb; *(LAS f32x4*)(bp + 12288 + off) = vk; *(LAS f32x4*)(bp + 16384 + off) = vr;
    *(LAS f32x2v*)(bp + S_RWV + (tok * 32 + (lt2 & 15) * 2) * 4) = (f32x2v){bflo(rv), bfhi(rv)};
}
__device__ __forceinline__ void s_hg_load(LAS unsigned char* bp, int lt2, size_t ltok0, int h8, int q4, const bf16_t* cols, const float* lbv) {
    const int tok = lt2 >> 4, c8 = (lt2 & 15) * 8; const bf16_t* crow = cols + (ltok0 + tok) * CL;
    float q[8], f[8]; ld8bf(crow + C_HQ + h8 * 128 + c8, q); ld8bf(crow + C_HF + h8 * 128 + c8, f);
    const unsigned rv = *(const unsigned*)(crow + C_HI + h8 * 128 + q4 * 32 + (lt2 & 15) * 2);
    const f32x4 lb0 = *(const f32x4*)(lbv + h8 * 128 + c8), lb1 = *(const f32x4*)(lbv + h8 * 128 + c8 + 4);
    const int off = (tok * 128 + c8) * 4;
    *(LAS f32x4*)(bp + off) = (f32x4){lb0[0] + (1.f - lb0[0]) * f[0], lb0[1] + (1.f - lb0[1]) * f[1], lb0[2] + (1.f - lb0[2]) * f[2], lb0[3] + (1.f - lb0[3]) * f[3]};
    *(LAS f32x4*)(bp + off + 16) = (f32x4){lb1[0] + (1.f - lb1[0]) * f[4], lb1[1] + (1.f - lb1[1]) * f[5], lb1[2] + (1.f - lb1[2]) * f[6], lb1[3] + (1.f - lb1[3]) * f[7]};
    *(LAS f32x4*)(bp + S_HGQ + off) = (f32x4){q[0], q[1], q[2], q[3]}; *(LAS f32x4*)(bp + S_HGQ + off + 16) = (f32x4){q[4], q[5], q[6], q[7]};
    *(LAS f32x2v*)(bp + S_HGI + (tok * 32 + (lt2 & 15) * 2) * 4) = (f32x2v){bflo(rv), bfhi(rv)};
}
__device__ __forceinline__ void s_drain(const LAS unsigned char* ybase, int lt2, float* obase  ) {
    const int t = lt2 >> 4, rp = (lt2 & 15) * 2;
    *(f32x2v*)(obase + (size_t)(rp >> 4) * (TS * 16) + t * 16 + (rp & 15)) = *(const LAS f32x2v*)(ybase + (t * 32 + rp) * 4);
}
__device__ __forceinline__ float dot4(f32x4 a, f32x4 b) { return __builtin_fmaf(a[3], b[3], __builtin_fmaf(a[2], b[2], __builtin_fmaf(a[1], b[1], a[0] * b[0]))); }
__device__ __forceinline__ float dot4acc(f32x4 a, f32x4 b, float c) { return __builtin_fmaf(a[3], b[3], __builtin_fmaf(a[2], b[2], __builtin_fmaf(a[1], b[1], __builtin_fmaf(a[0], b[0], c)))); }
__device__ __forceinline__ void split_scan(int s, int bid, int G, int tid, int lane, int wave, LAS unsigned char* lds,
        const bf16_t* PA, const float* PW, const bf16_t* PB, const bf16_t* PK, const bf16_t* PR, const bf16_t* PV, const bf16_t* cols, const float* lbv,
        float* oraw, float* hgo, float* rwstate, float* hgstate, bool save) {
    constexpr int NBLK = TS / ST;
    const int rowl = lane >> 4, j = lane & 15, r0 = (wave & 3) * 8 + rowl, r1 = r0 + 4;
    for (int it = bid; it < 256; it += G) {
        if (it < 128) {
            const int b = it >> 5, h = (it >> 1) & 15, hf = it & 1;
            const size_t tok0 = (size_t)b * TS;
            float* sp0 = rwstate + ((size_t)((b * 16 + h) * 64 + hf * 32 + r0) * 64 + 4 * j); float* sp1 = sp0 + 4 * 64;
            float* og = oraw + (size_t)((b * 16 + h) * 4 + hf * 2) * TS * 16;
            f32x4 x0 = (f32x4){0.f, 0.f, 0.f, 0.f}, x1 = x0;
            if (wave < 4 && s > 0) { x0 = *(const f32x4*)sp0; x1 = *(const f32x4*)sp1; }
            if (wave >= 4) { s_rw_load(lds, tid - 256, tok0, h, hf, PA, PW, PB, PK, PR, PV); SCAN_BAR_L(); } else { __builtin_amdgcn_s_setprio(2); asm volatile("s_waitcnt vmcnt(0)" ::: "memory"); SCAN_BAR_S(); }
#pragma unroll 1
            for (int blk = 0; blk < NBLK; ++blk) {
                if (wave >= 4) {
                    if (blk > 0) s_drain(lds + ((blk - 1) & 1) * S_RWB + S_RWY, tid - 256, og + (size_t)(blk - 1) * (ST * 16));
                    if (blk + 1 < NBLK) s_rw_load(lds + ((blk + 1) & 1) * S_RWB, tid - 256, tok0 + (blk + 1) * ST, h, hf, PA, PW, PB, PK, PR, PV);
                    SCAN_BAR_L();
                } else {
                    const LAS unsigned char* bp = lds + (blk & 1) * S_RWB;
                    const LAS unsigned char* p4 = bp + 16 * j; const LAS unsigned char* pv = bp + S_RWV + r0 * 4; LAS unsigned char* py = (LAS unsigned char*)bp + S_RWY + r0 * 4;
                    f32x4 a4 = *(const LAS f32x4*)(p4), w4 = *(const LAS f32x4*)(p4 + 4096), b4 = *(const LAS f32x4*)(p4 + 8192), k4 = *(const LAS f32x4*)(p4 + 12288), r4 = *(const LAS f32x4*)(p4 + 16384);
                    float v0 = *(const LAS float*)(pv), v1 = *(const LAS float*)(pv + 16);
                    float sa0 = dot4(x0, a4), sa1 = dot4(x1, a4);
                    allreduce16x2(sa0, sa1);
#pragma unroll
                    for (int t = 0; t < ST; ++t) {
                        f32x4 na = a4, nw = w4, nb = b4, nk = k4, nr = r4; float n0 = v0, n1 = v1;
                        if (t < ST - 1) { const int o = (t + 1) * 256; na = *(const LAS f32x4*)(p4 + o); nw = *(const LAS f32x4*)(p4 + 4096 + o); nb = *(const LAS f32x4*)(p4 + 8192 + o); nk = *(const LAS f32x4*)(p4 + 12288 + o); nr = *(const LAS f32x4*)(p4 + 16384 + o);
                            n0 = *(const LAS float*)(pv + (t + 1) * 128); n1 = *(const LAS float*)(pv + (t + 1) * 128 + 16); }
                        x0 = x0 * w4 + (b4 * sa0 + k4 * v0); x1 = x1 * w4 + (b4 * sa1 + k4 * v1);
                        float y0 = dot4(x0, r4), y1 = dot4(x1, r4);
                        float s0n = dot4(x0, na), s1n = dot4(x1, na);
                        s0n = dpp_add<0xB1>(s0n); s1n = dpp_add<0xB1>(s1n); y0 = dpp_add<0xB1>(y0); y1 = dpp_add<0xB1>(y1); s0n = dpp_add<0x4E>(s0n); s1n = dpp_add<0x4E>(s1n); y0 = dpp_add<0x4E>(y0); y1 = dpp_add<0x4E>(y1);
                        s0n = dpp_add<0x141>(s0n); s1n = dpp_add<0x141>(s1n); y0 = dpp_add<0x141>(y0); y1 = dpp_add<0x141>(y1); s0n = dpp_add<0x140>(s0n); s1n = dpp_add<0x140>(s1n); y0 = dpp_add<0x140>(y0); y1 = dpp_add<0x140>(y1);
                        *(LAS float*)(py + t * 128) = y0; *(LAS float*)(py + t * 128 + 16) = y1;
                        sa0 = s0n; sa1 = s1n; a4 = na; w4 = nw; b4 = nb; k4 = nk; r4 = nr; v0 = n0; v1 = n1;
                    }
                    SCAN_BAR_S();
                }
            }
            if (wave >= 4) s_drain(lds + ((NBLK - 1) & 1) * S_RWB + S_RWY, tid - 256, og + (size_t)(NBLK - 1) * (ST * 16));
            else { __builtin_amdgcn_s_setprio(0); if (save) { *(f32x4*)sp0 = x0; *(f32x4*)sp1 = x1; } }
        } else {
            const int i2 = it - 128, b = i2 >> 5, h8 = (i2 >> 2) & 7, q4 = i2 & 3;
            const size_t tok0 = (size_t)b * TS;
            float* sp0 = hgstate + ((size_t)((b * 8 + h8) * 128 + q4 * 32 + r0) * 128 + 4 * j); float* sp1 = sp0 + 4 * 128;
            float* og = hgo + (size_t)((b * 8 + h8) * 8 + q4 * 2) * TS * 16;
            f32x4 a0 = (f32x4){0.f, 0.f, 0.f, 0.f}, a1 = a0, c0 = a0, c1 = a0;
            if (wave < 4 && s > 0) { a0 = *(const f32x4*)sp0; a1 = *(const f32x4*)(sp0 + 64); c0 = *(const f32x4*)sp1; c1 = *(const f32x4*)(sp1 + 64); }
            if (wave >= 4) { s_hg_load(lds, tid - 256, tok0, h8, q4, cols, lbv); SCAN_BAR_L(); } else { __builtin_amdgcn_s_setprio(2); asm volatile("s_waitcnt vmcnt(0)" ::: "memory"); SCAN_BAR_S(); }
#pragma unroll 1
            for (int blk = 0; blk < NBLK; ++blk) {
                if (wave >= 4) {
                    if (blk > 0) s_drain(lds + ((blk - 1) & 1) * S_HGB + S_HGY, tid - 256, og + (size_t)(blk - 1) * (ST * 16));
                    if (blk + 1 < NBLK) s_hg_load(lds + ((blk + 1) & 1) * S_HGB, tid - 256, tok0 + (blk + 1) * ST, h8, q4, cols, lbv);
                    SCAN_BAR_L();
                } else {
                    const LAS unsigned char* bp = lds + (blk & 1) * S_HGB;
                    const LAS unsigned char* g4 = bp + 16 * j; const LAS unsigned char* gi = bp + S_HGI + r0 * 4; LAS unsigned char* gy = (LAS unsigned char*)bp + S_HGY + r0 * 4;
                    f32x4 f0 = *(const LAS f32x4*)(g4), f1 = *(const LAS f32x4*)(g4 + 256), q0 = *(const LAS f32x4*)(g4 + S_HGQ), q1 = *(const LAS f32x4*)(g4 + S_HGQ + 256);
                    float i0 = *(const LAS float*)(gi), i1 = *(const LAS float*)(gi + 16);
#pragma unroll
                    for (int t = 0; t < ST; ++t) {
                        f32x4 nf0 = f0, nf1 = f1, nq0 = q0, nq1 = q1; float ni0 = i0, ni1 = i1;
                        if (t < ST - 1) { const int o = (t + 1) * 512; nf0 = *(const LAS f32x4*)(g4 + o); nf1 = *(const LAS f32x4*)(g4 + 256 + o); nq0 = *(const LAS f32x4*)(g4 + S_HGQ + o); nq1 = *(const LAS f32x4*)(g4 + S_HGQ + 256 + o);
                            ni0 = *(const LAS float*)(gi + (t + 1) * 128); ni1 = *(const LAS float*)(gi + (t + 1) * 128 + 16); }
                        a0 = (a0 - i0) * f0 + i0; a1 = (a1 - i0) * f1 + i0; c0 = (c0 - i1) * f0 + i1; c1 = (c1 - i1) * f1 + i1;
                        float y0 = dot4acc(a1, q1, dot4(a0, q0));
                        float y1 = dot4acc(c1, q1, dot4(c0, q0));
                        allreduce16x2(y0, y1);
                        *(LAS float*)(gy + t * 128) = y0; *(LAS float*)(gy + t * 128 + 16) = y1;
                        f0 = nf0; f1 = nf1; q0 = nq0; q1 = nq1; i0 = ni0; i1 = ni1;
                    }
                    SCAN_BAR_S();
                }
            }
            if (wave >= 4) s_drain(lds + ((NBLK - 1) & 1) * S_HGB + S_HGY, tid - 256, og + (size_t)(NBLK - 1) * (ST * 16));
            else { __builtin_amdgcn_s_setprio(0); if (save) { *(f32x4*)sp0 = a0; *(f32x4*)(sp0 + 64) = a1; *(f32x4*)sp1 = c0; *(f32x4*)(sp1 + 64) = c1; } }
        }
    }
}

__device__ __forceinline__ void attn_phase(int gw, int NGW, int lane, const bf16_t* Q, const bf16_t* KV, const bf16_t* Vt, bf16_t* AO) {
    const int fr = lane & 15, fq = lane >> 4;
    for (int item = gw; item < 8192; item += NGW) {
        const int bh = item >> 9, tile = item & 511, b = bh >> 2, hd = bh & 3;
        const size_t gt = (size_t)b * SEQ + tile * 16 + fr;
        bf16x8 qf[8];
#pragma unroll
        for (int ks = 0; ks < 8; ++ks) qf[ks] = *(const bf16x8*)(Q + gt * 1024 + hd * 256 + ks * 32 + fq * 8);
        f32x4 sc[16]; float mx = -3.0e38f;
#pragma unroll
        for (int kt = 0; kt < 16; ++kt) { f32x4 acc = (f32x4){0.f, 0.f, 0.f, 0.f}; const bf16_t* kp = KV + (size_t)(b * 256 + kt * 16 + fr) * 2048 + hd * 256 + fq * 8;
#pragma unroll
            for (int ks = 0; ks < 8; ++ks) acc = MFMA16(*(const bf16x8*)(kp + ks * 32), qf[ks], acc);
            sc[kt] = acc * 0.0625f; mx = fmaxf(mx, fmaxf(fmaxf(sc[kt][0], sc[kt][1]), fmaxf(sc[kt][2], sc[kt][3]))); }
        mx = fmaxf(mx, __shfl_xor(mx, 16)); mx = fmaxf(mx, __shfl_xor(mx, 32));
        float sum = 0.f;
#pragma unroll
        for (int kt = 0; kt < 16; ++kt) {
#pragma unroll
            for (int jj = 0; jj < 4; ++jj) { sc[kt][jj] = __expf(sc[kt][jj] - mx); sum += sc[kt][jj]; } }
        sum = fq_sum(sum);
        const float inv = 1.0f / sum;
        bf16x8 pf[8];
#pragma unroll
        for (int k2 = 0; k2 < 8; ++k2) { u32x4 w; w.x = cvt_pk_bf16(sc[2 * k2][0], sc[2 * k2][1]); w.y = cvt_pk_bf16(sc[2 * k2][2], sc[2 * k2][3]); w.z = cvt_pk_bf16(sc[2 * k2 + 1][0], sc[2 * k2 + 1][1]); w.w = cvt_pk_bf16(sc[2 * k2 + 1][2], sc[2 * k2 + 1][3]); pf[k2] = __builtin_bit_cast(bf16x8, w); }
#pragma unroll 2
        for (int dt = 0; dt < 16; ++dt) { f32x4 acc = (f32x4){0.f, 0.f, 0.f, 0.f}; const bf16_t* vp = Vt + (size_t)((b * 4 + hd) * 256 + dt * 16 + fr) * 256 + fq * 8;
#pragma unroll
            for (int k2 = 0; k2 < 8; ++k2) acc = MFMA16(*(const bf16x8*)(vp + k2 * 32), pf[k2], acc);
            st4bf(AO + gt * 1024 + hd * 256 + dt * 16 + 4 * fq, acc * inv); }
    }
}

__device__ __forceinline__ int tid_fresh() { int t = threadIdx.x; asm volatile("" : "+v"(t)); return t; }
#define WinT ((bf16_t*)(a.ws + WS_WIN))
#define WoutT ((bf16_t*)(a.ws + WS_WOUT))
#define WqT ((bf16_t*)(a.ws + WS_WQ))
#define WoT ((bf16_t*)(a.ws + WS_WO))
#define WkvT ((bf16_t*)(a.ws + WS_WKV))
#define W13T ((bf16_t*)(a.ws + WS_W13))
#define W2T ((bf16_t*)(a.ws + WS_W2))
#define rw2T ((bf16_t*)(a.ws + WS_RW2T))
#define ra2T ((bf16_t*)(a.ws + WS_RA2T))
#define rg2T ((bf16_t*)(a.ws + WS_RG2T))
#define g2Tp ((bf16_t*)(a.ws + WS_G2TP))
#define GATE ((bf16_t*)(a.ws + WS_GATE))
#define ASG ((bf16_t*)(a.ws + WS_ASG))
#define carry ((bf16_t*)(a.ws + WS_CARRY))
#define lbv ((float*)(a.ws + WS_LB))
#define mbf ((bf16_t*)(a.ws + WS_MBF))
#define KV ((bf16_t*)(a.ws + WS_KV))
#define Vt ((bf16_t*)(a.ws + WS_VT))
#define rwst ((float*)(a.ws + WS_RWST))
#define hgst ((float*)(a.ws + WS_HGST))
#define bonus ((float*)(a.ws + WS_BONUS))
#define merged ((bf16_t*)(a.ws + WS_MERGED))
#define u1 ((bf16_t*)(a.ws + WS_U1))
#define cols ((bf16_t*)(a.ws + WS_COLS))
#define PR ((bf16_t*)(a.ws + WS_PR))
#define PK ((bf16_t*)(a.ws + WS_PK))
#define PA ((bf16_t*)(a.ws + WS_PA))
#define PB ((bf16_t*)(a.ws + WS_PB))
#define PV ((bf16_t*)(a.ws + WS_PV))
#define PW ((float*)(a.ws + WS_PW))
#define oraw ((float*)(a.ws + WS_ORAW))
#define hgo ((float*)(a.ws + WS_HGO))
#define U ((bf16_t*)(a.ws + WS_U))
#define Qb ((bf16_t*)(a.ws + WS_Q))
#define AO ((bf16_t*)(a.ws + WS_AO))
#define FF ((bf16_t*)(a.ws + WS_FF))
#define XIN (a.in[0])
#define OUTP (a.out)
struct Args { const float* in[29]; float* out; unsigned char* ws; int ph_lo, ph_hi; };

typedef const __attribute__((address_space(4))) Args* CArgsP;
__device__ __forceinline__ CArgsP args_fresh() { CArgsP p = (CArgsP)__builtin_amdgcn_kernarg_segment_ptr(); asm volatile("" : "+s"(p)); return p; }
__global__ void __launch_bounds__(512, 2) mega(Args a0) {
    extern __shared__ __attribute__((aligned(16))) unsigned char lds_raw[];
    LAS unsigned char* lds = (LAS unsigned char*)lds_raw;
    cg::grid_group grid = cg::this_grid();
    const int G = gridDim.x, bid = blockIdx.x, NGW = G * 8, NGT = G * 512;
#define IDS const auto& a = *args_fresh(); const int tid = tid_fresh(), lane = tid & 63, wave = __builtin_amdgcn_readfirstlane(tid >> 6), gw = bid * 8 + wave, gtid = bid * 512 + tid; (void)lane; (void)gw; (void)gtid
    const int lo = a0.ph_lo, hi = a0.ph_hi;
    if (lo < 0) grid.sync();
    { volatile LAS unsigned* misc = (volatile LAS unsigned*)(lds + MISC_OFF); if (threadIdx.x < 2) misc[threadIdx.x] = 0u; __syncthreads();
      if (hi - lo > 1) (void)xcd_barrier_post((unsigned*)(a0.ws + WS_CTL), misc); }
#ifndef MK_REP
#define MK_REP -1
#endif
#ifndef MK_REPN
#define MK_REPN 3
#endif
#define RPT(code) for (int rep_ = 0, nrep_ = (MK_REP == (code)) ? MK_REPN : 1; rep_ < nrep_; ++rep_)
#define LASTREP (rep_ == nrep_ - 1)
#define IN(k) (lo <= (k) && (k) < hi)
#define SEAM(k) do { if (IN(k) && IN((k) + 1)) RPT(120) { XcdBarrier xb_; xb_.bar = (unsigned*)(args_fresh()->ws + WS_CTL); xb_.x = xb_xcc_id(); xb_.st = (volatile LAS unsigned*)(lds + MISC_OFF); xcd_barrier(xb_); } } while (0)

    if (IN(0)) { IDS;
        LAS float* scr = (LAS float*)(lds + wave * 16384);
        constexpr int I_IN = 16 * 297, I_SQ = 16 * 32, I_13 = 16 * 88, I_2 = 44 * 32;
        constexpr int NITEMS = I_IN + 5 * I_SQ + 2 * I_13 + I_2;
        for (int it = gw; it < NITEMS; it += NGW) {
            int r = it;
            if (r < I_IN) { const int kb = r / 297, n0 = (r % 297) * 32; tr_item(a.in[3], 1024, 9504, WinT, kb, n0, n0 + (n0 >= 3360 ? 224 : 0), scr, lane); continue; } r -= I_IN;
            if (r < I_SQ) { tr_item(a.in[17], 1024, 1024, WoutT, r / 32, (r % 32) * 32, (r % 32) * 32, scr, lane); continue; } r -= I_SQ;
            if (r < I_SQ) { tr_item(a.in[20], 1024, 1024, WqT, r / 32, (r % 32) * 32, (r % 32) * 32, scr, lane); continue; } r -= I_SQ;
            if (r < I_SQ) { tr_item(a.in[23], 1024, 1024, WoT, r / 32, (r % 32) * 32, (r % 32) * 32, scr, lane); continue; } r -= I_SQ;
            if (r < I_SQ) { tr_item(a.in[21], 1024, 1024, WkvT, r / 32, (r % 32) * 32, (r % 32) * 32, scr, lane); continue; } r -= I_SQ;
            if (r < I_SQ) { tr_item(a.in[22], 1024, 1024, WkvT, r / 32, (r % 32) * 32, 1024 + (r % 32) * 32, scr, lane); continue; } r -= I_SQ;
            if (r < I_13) { const int n0 = (r % 88) * 32; tr_item(a.in[25], 1024, DFF, W13T, r / 88, n0, (n0 / 128) * 256 + (n0 % 128), scr, lane); continue; } r -= I_13;
            if (r < I_13) { const int n0 = (r % 88) * 32; tr_item(a.in[26], 1024, DFF, W13T, r / 88, n0, (n0 / 128) * 256 + 128 + (n0 % 128), scr, lane); continue; } r -= I_13;
            tr_item(a.in[27], DFF, 1024, W2T, r / 32, (r % 32) * 32, (r % 32) * 32, scr, lane);
        }
        for (int i = gtid; i < 28672; i += NGT) ((u32x4*)(WinT + 3360 * 1024))[i] = (u32x4){0u, 0u, 0u, 0u};
        for (int i = gtid; i < 1792; i += NGT) ((u32x4*)carry)[i] = (u32x4){0u, 0u, 0u, 0u};
        for (int n = gw; n < 1024; n += NGW) { rw2T[n * 64 + lane] = (bf16_t)f2bf(a.in[6][lane * 1024 + n]); ra2T[n * 64 + lane] = (bf16_t)f2bf(a.in[8][lane * 1024 + n]); }
        for (int m = gw; m < 512; m += NGW) {
            for (int e = lane; e < 320; e += 64) { const int n = 2 * m + (e >= 160 ? 1 : 0), k = e >= 160 ? e - 160 : e; rg2T[n * 160 + k] = (bf16_t)f2bf(a.in[9][k * 1024 + n]); } }
        for (int n = gw; n < 1024; n += NGW) { f32x4 v;
#pragma unroll
            for (int e = 0; e < 4; ++e) { const int k = 4 * lane + e; v[e] = k < 160 ? a.in[9][k * 1024 + n] : 0.f; }
            st4bf(g2Tp + n * 256 + 4 * lane, v); }
        for (int i = gtid; i < 1024; i += NGT) lbv[i] = 1.0f / (1.0f + __expf(a.in[15][1024 + i] - a.in[15][i]));
        for (int m = gw; m < 1024; m += NGW) rms_row_bf16(a.in[1] + (size_t)m * 1024, a.in[19], mbf + (size_t)m * 1024, lane);
        for (int lt = gw; lt < MS; lt += NGW) { const int b = lt / TS, tl = lt % TS; const size_t gt = (size_t)b * SEQ + tl; rms_row_bf16(XIN + gt * 1024, a.in[2], u1 + (size_t)lt * 1024, lane); }
        __syncthreads();
    }
    SEAM(0);

#pragma unroll 1
    for (int s = 0; s < NSPLIT; ++s) {
        const int pb = 1 + 5 * s;
        if (IN(pb + 1)) { const auto& a = *args_fresh();
            pg8::Gemm g{u1, WinT, MS, CL, 1024}; pg8::StaticOrder S; S.init(MS, CL, G, bid);
            pg8::EpiColsAct E{cols, CL};
            RPT(102) pg8::gemm_phase<pg8::EpiColsAct, pg8::StaticOrder, true, true>(lds, g, S, E);
        }
        SEAM(pb + 1);
#ifndef SKIP_PREP
        if (IN(pb + 2)) { IDS; RPT(103) prep_phase(s, gw, NGW, lane, cols, carry, a.in[4], a.in[5], a.in[7], a.in[10], a.in[11], a.in[12], rw2T, ra2T, PR, PK, PA, PB, PV, PW, bonus, ASG); }
#endif
        SEAM(pb + 2);
        if (IN(pb + 3)) { IDS;
#ifdef MK_ZERO_SCAN
            for (int i = gtid; i < MS * 256; i += NGT) { ((f32x4*)oraw)[i] = (f32x4){0.f, 0.f, 0.f, 0.f}; ((f32x4*)hgo)[i] = (f32x4){0.01f, 0.02f, 0.03f, 0.04f}; }
#endif
#if 0
            RPT(104) { rwkv_scan(s, bid, G, tid, lane, wave, lds, PA, PW, PB, PK, PR, PV, oraw, rwst, LASTREP); __syncthreads(); }
            RPT(105) { hgrn_scan(s, bid, G, tid, lane, wave, lds, cols, lbv, hgo, hgst, LASTREP); __syncthreads(); }
#else
#ifdef MK_FUSED_SCAN
            RPT(104) { fused_scan(s, bid, G, tid, lane, wave, lds, PA, PW, PB, PK, PR, PV, cols, lbv, oraw, hgo, rwst, hgst, LASTREP); __syncthreads(); }
#else
            RPT(104) { split_scan(s, bid, G, tid, lane, wave, lds, PA, PW, PB, PK, PR, PV, cols, lbv, oraw, hgo, rwst, hgst, LASTREP); __syncthreads(); }
#endif
#endif
            { pg8::Gemm g{ASG, g2Tp, MS, 1024, 256}; pg8::StaticOrder S; S.init(MS, 1024, G, bid); pg8::EpiStoreBf16 E{GATE, 1024};
              pg8::gemm_phase<pg8::EpiStoreBf16, pg8::StaticOrder, true, true>(lds, g, S, E); }
        }
        SEAM(pb + 3);
        if (IN(pb + 4)) { IDS;
#ifdef MK_NOMIX
            for (int i = gtid; i < MS * 128; i += NGT) { const int lt = i >> 7, b = lt / TS, tl = lt % TS; const size_t gt = (size_t)b * SEQ + s * TS + tl; ((u32x4*)(merged + gt * 1024))[i & 127] = (u32x4){0u, 0u, 0u, 0u}; }
#endif
#ifndef SKIP_POST
            RPT(106) post_phase(s, gw, NGW, lane, cols, carry, a.in[4], GATE, a.in[13], a.in[14], a.in[16], oraw, hgo, PV, bonus, merged);
#endif
            if (s + 1 < NSPLIT) for (int lt = gw; lt < MS; lt += NGW) { const int b = lt / TS, tl = lt % TS; const size_t gt = (size_t)b * SEQ + (s + 1) * TS + tl; rms_row_bf16(XIN + gt * 1024, a.in[2], u1 + (size_t)lt * 1024, lane); }
            if (bid < 4 && s + 1 < NSPLIT) { const u32x4* src = (const u32x4*)(cols + (size_t)(bid * TS + TS - 1) * CL); u32x4* dst = (u32x4*)(carry + (((s + 1) & 1) * 4 + bid) * CARRY_LD);
                for (int i = tid; i < CARRY_LD / 8; i += 512) dst[i] = src[i]; }
        }
        SEAM(pb + 4);
    }

    if (IN(T0 + 0)) { const auto& a = *args_fresh();
        { pg8::Gemm g{merged, WoutT, NTOK, 1024, 1024}; pg8::StaticOrder S; S.init(NTOK, 1024, G, bid); pg8::EpiResF32 E{XIN, OUTP, 1024};
          pg8::gemm_phase<pg8::EpiResF32, pg8::StaticOrder, true, true>(lds, g, S, E); }
        { pg8::Gemm g{mbf, WkvT, 1024, 2048, 1024}; pg8::StaticOrder S; S.init(1024, 2048, G, bid); pg8::EpiStoreBf16 E{KV, 2048};
          pg8::gemm_phase<pg8::EpiStoreBf16, pg8::StaticOrder, true, true>(lds, g, S, E); }
    }
    SEAM(T0 + 0);
    if (IN(T0 + 1)) { IDS;
        for (int gt = gw; gt < NTOK; gt += NGW) rms_row_bf16(OUTP + (size_t)gt * 1024, a.in[18], U + (size_t)gt * 1024, lane);
        for (int i = gtid; i < 4 * 4 * 256 * 256; i += NGT) { const int kp = i & 255, dim = (i >> 8) & 255, hd = (i >> 16) & 3, b = i >> 18;
            const int k2 = kp >> 5, fq = (kp >> 3) & 3, sl = kp & 7; const int key = 32 * k2 + (sl < 4 ? 4 * fq + sl : 16 + 4 * fq + sl - 4);
            Vt[i] = KV[(size_t)(b * 256 + key) * 2048 + 1024 + hd * 256 + dim]; }
    }
    SEAM(T0 + 1);
    if (IN(T0 + 2)) { const auto& a = *args_fresh(); pg8::Gemm g{U, WqT, NTOK, 1024, 1024}; pg8::StaticOrder S; S.init(NTOK, 1024, G, bid); pg8::EpiStoreBf16 E{Qb, 1024};
        RPT(112) pg8::gemm_phase<pg8::EpiStoreBf16, pg8::StaticOrder, true, true>(lds, g, S, E); }
    SEAM(T0 + 2);
#ifndef SKIP_ATTN
    if (IN(T0 + 3)) { IDS; RPT(113) attn_phase(gw, NGW, lane, Qb, KV, Vt, AO); }
#endif
    SEAM(T0 + 3);
#ifndef MK_NOATT
    if (IN(T0 + 4)) { const auto& a = *args_fresh(); pg8::Gemm g{AO, WoT, NTOK, 1024, 1024}; pg8::StaticOrder S; S.init(NTOK, 1024, G, bid); pg8::EpiResF32 E{OUTP, OUTP, 1024};
        pg8::gemm_phase<pg8::EpiResF32, pg8::StaticOrder, true, true>(lds, g, S, E); }
#endif
    SEAM(T0 + 4);
    if (IN(T0 + 5)) { IDS; RPT(115) for (int gt = gw; gt < NTOK; gt += NGW) rms_row_bf16(OUTP + (size_t)gt * 1024, a.in[24], U + (size_t)gt * 1024, lane); }
    SEAM(T0 + 5);
    if (IN(T0 + 6)) { const auto& a = *args_fresh(); pg8::Gemm g{U, W13T, NTOK, 2 * DFF, 1024}; pg8::StaticOrder S; S.init(NTOK, 2 * DFF, G, bid); pg8::EpiSwiGLU E{FF, DFF};
        RPT(116) pg8::gemm_phase<pg8::EpiSwiGLU, pg8::StaticOrder, true, true>(lds, g, S, E); }
    SEAM(T0 + 6);
    if (IN(T0 + 7)) { const auto& a = *args_fresh(); pg8::Gemm g{FF, W2T, NTOK, 1024, DFF}; pg8::StaticOrder S; S.init(NTOK, 1024, G, bid); pg8::EpiResF32 E{OUTP, OUTP, 1024};
        pg8::gemm_phase<pg8::EpiResF32, pg8::StaticOrder, true, true>(lds, g, S, E); }
    SEAM(T0 + 7);
    if (IN(T0 + 8)) { IDS;
        const float* gf = a.in[28];
        for (int gt = gw; gt < NTOK; gt += NGW) { f32x4* row = (f32x4*)(OUTP + (size_t)gt * 1024); f32x4 v[4]; float sq = 0.f;
#pragma unroll
            for (int j = 0; j < 4; ++j) { v[j] = row[lane + 64 * j]; sq += (v[j][0] * v[j][0] + v[j][1] * v[j][1]) + (v[j][2] * v[j][2] + v[j][3] * v[j][3]); }
            const float rs = 1.0f / sqrtf(wave_sum(sq) * (1.0f / 1024.0f) + 1e-6f);
#pragma unroll
            for (int j = 0; j < 4; ++j) row[lane + 64 * j] = v[j] * rs * ((const f32x4*)gf)[lane + 64 * j]; }
    }
#undef IN
#undef SEAM
}

#ifndef MK_MULTI
#define MK_MULTI 0
#endif
extern "C" void kernel_launch(void* const* d_in, const int* in_sizes, int n_in, void* d_out, int out_size, void* d_ws, size_t ws_size, hipStream_t stream) {
    static int grid = 0;
    if (grid == 0) {
        if (n_in != 29 || in_sizes[0] != NTOK * D || out_size != NTOK * D || ws_size < WS_END) { fprintf(stderr, "kernel_launch: unexpected shapes / workspace (%d inputs, ws %zu)\n", n_in, ws_size); grid = -1; return; }
        int dev = 0, cus = 0, per_cu = 0;
        hipGetDevice(&dev); hipDeviceGetAttribute(&cus, hipDeviceAttributeMultiprocessorCount, dev);
        hipFuncSetAttribute((const void*)mega, hipFuncAttributeMaxDynamicSharedMemorySize, LDS_BYTES);
        hipOccupancyMaxActiveBlocksPerMultiprocessor(&per_cu, (const void*)mega, 512, LDS_BYTES);
        (void)hipGetLastError();
        if (per_cu < 1) per_cu = 1;
        grid = cus;
    }
    if (grid < 0) return;
    Args a{};
    for (int i = 0; i < 29; ++i) a.in[i] = (const float*)d_in[i];
    a.out = (float*)d_out; a.ws = (unsigned char*)d_ws;
    (void)hipMemsetAsync((char*)d_ws + WS_CTL, 0, CTL_BYTES, stream);
    void* args[] = {&a};
#if MK_MULTI
    for (int ph = 0; ph < N_PHASES; ++ph) { a.ph_lo = ph; a.ph_hi = ph + 1; hipLaunchCooperativeKernel((const void*)mega, dim3(grid), dim3(512), args, LDS_BYTES, stream); }
#else
    a.ph_lo = 0; a.ph_hi = N_PHASES;
    hipError_t e = hipLaunchCooperativeKernel((const void*)mega, dim3(grid), dim3(512), args, LDS_BYTES, stream);
    if (e != hipSuccess) fprintf(stderr, "cooperative launch failed: %s (grid %d)\n", hipGetErrorString(e), grid);
#endif
}
```

```cpp
#include <hip/hip_runtime.h>
#include <hip/hip_cooperative_groups.h>
#include <cstdint>
#include <cstdio>
namespace cg = cooperative_groups;
namespace pg8 {
#define PG8_LAS __attribute__((address_space(3)))
typedef unsigned short bf16_t;
typedef short bf16x8 __attribute__((ext_vector_type(8)));
typedef float f32x4 __attribute__((ext_vector_type(4)));
typedef unsigned u32x4 __attribute__((ext_vector_type(4)));
constexpr int BM = 256, BK = 64, HALF = 128, HTB = HALF * BK * 2  , STAGE_BYTES = 8 * HTB, NXCD = 8, WGM = 8;

__host__ __device__ __forceinline__ int lds_byte(int r, int c) { const int st = (r >> 4) * 2 + (c >> 5), rr = r & 15, cc = c & 31, ob = rr * 64 + cc * 2; return st * 1024 + (ob ^ (((ob >> 9) & 1) << 5)); }
__host__ __device__ __forceinline__ void stage_rc(int b, int& R, int& C) { const int st = b / 1024, sb = b % 1024, swz = sb ^ (((sb >> 9) & 1) << 5); R = (st >> 1) * 16 + swz / 64; C = (st & 1) * 32 + (swz % 64) / 2; }
__host__ __device__ __forceinline__ int perm32(int rho) { const int n = rho >> 4, i = rho & 15; return 8 * (i >> 2) + 4 * n + (i & 3); }

struct Unit { int pm, pn; };
struct Gemm { const bf16_t* A; const bf16_t* Bt; int M, N, K; };

struct StaticOrder {
    int nM, nN, nwg, G, c;
    __host__ __device__ void init(int M, int N, int G_, int c_) { nM = M / BM; nN = N / BM; nwg = nM * nN; G = G_; c = c_; }
    __host__ __device__ bool next(int i, Unit& u) const {
        const long L = (long)i * G + c; if (L >= nwg) return false;
        int wgid = (int)L; { const int q = nwg / NXCD, r = nwg % NXCD, xcd = wgid % NXCD, off = wgid / NXCD; wgid = (xcd < r ? xcd * (q + 1) : r * (q + 1) + (xcd - r) * q) + off; }
        const int nig = WGM * nN, gid = wgid / nig, fm = gid * WGM, gsz = (nM - fm) < WGM ? (nM - fm) : WGM;
        u.pm = fm + ((wgid % nig) % gsz); u.pn = (wgid % nig) / gsz; return true;
    }
    __device__ __forceinline__ void a_ready(const Unit&) const {}
    __device__ __forceinline__ void done(const Unit&) const {}
};

__device__ __forceinline__ unsigned cvt_pk_bf16(float lo, float hi) { unsigned r; asm volatile("v_cvt_pk_bf16_f32 %0, %1, %2" : "=v"(r) : "v"(lo), "v"(hi)); return r; }
__device__ __forceinline__ float fast_sigmoid(float x) { return __builtin_amdgcn_rcpf(1.0f + __expf(-x)); }
__device__ __forceinline__ float fast_silu(float x) { return x * fast_sigmoid(x); }
struct EpiStoreBf16 {
    static constexpr bool PERM = true, AFTER_DRAIN = false;
    bf16_t* O; int ldc;
    __device__ __forceinline__ void operator()(const f32x4 (&acc)[2][2][4][2], const Unit& u, int wr, int wc, int fr, int fq) const {
        const int row0 = u.pm * BM + wr * 64 + fr, col0 = u.pn * BM + wc * 32 + 8 * fq;
#pragma unroll
        for (int ai = 0; ai < 2; ++ai)
#pragma unroll
            for (int m = 0; m < 4; ++m) { bf16_t* rowp = O + (size_t)(row0 + ai * HALF + m * 16) * ldc + col0;
#pragma unroll
                for (int bj = 0; bj < 2; ++bj) { const f32x4 v0 = acc[ai][bj][m][0], v1 = acc[ai][bj][m][1];
                    u32x4 w; w.x = cvt_pk_bf16(v0[0], v0[1]); w.y = cvt_pk_bf16(v0[2], v0[3]); w.z = cvt_pk_bf16(v1[0], v1[1]); w.w = cvt_pk_bf16(v1[2], v1[3]);
                    *(u32x4*)(rowp + bj * HALF) = w; } }
    }
};
struct EpiResF32 {
    static constexpr bool PERM = true, AFTER_DRAIN = false;
    const float* base; float* out; int ldc;
    __device__ __forceinline__ void operator()(const f32x4 (&acc)[2][2][4][2], const Unit& u, int wr, int wc, int fr, int fq) const {
        const int row0 = u.pm * BM + wr * 64 + fr, col0 = u.pn * BM + wc * 32 + 8 * fq;
#pragma unroll
        for (int ai = 0; ai < 2; ++ai)
#pragma unroll
            for (int m = 0; m < 4; ++m) { const size_t off = (size_t)(row0 + ai * HALF + m * 16) * ldc + col0;
#pragma unroll
                for (int bj = 0; bj < 2; ++bj)
#pragma unroll
                    for (int n = 0; n < 2; ++n) { const size_t p = off + bj * HALF + 4 * n; const f32x4 b = *(const f32x4*)(base + p); *(f32x4*)(out + p) = b + acc[ai][bj][m][n]; } }
    }
};
struct EpiSwiGLU {
    static constexpr bool PERM = true, AFTER_DRAIN = false;
    bf16_t* O; int ldc;
    __device__ __forceinline__ void operator()(const f32x4 (&acc)[2][2][4][2], const Unit& u, int wr, int wc, int fr, int fq) const {
        const int row0 = u.pm * BM + wr * 64 + fr, col0 = u.pn * HALF + wc * 32 + 8 * fq;
#pragma unroll
        for (int ai = 0; ai < 2; ++ai)
#pragma unroll
            for (int m = 0; m < 4; ++m) { bf16_t* rowp = O + (size_t)(row0 + ai * HALF + m * 16) * ldc + col0;
                f32x4 v0, v1;
#pragma unroll
                for (int j = 0; j < 4; ++j) { v0[j] = fast_silu(acc[ai][0][m][0][j]) * acc[ai][1][m][0][j]; v1[j] = fast_silu(acc[ai][0][m][1][j]) * acc[ai][1][m][1][j]; }
                u32x4 w; w.x = cvt_pk_bf16(v0[0], v0[1]); w.y = cvt_pk_bf16(v0[2], v0[3]); w.z = cvt_pk_bf16(v1[0], v1[1]); w.w = cvt_pk_bf16(v1[2], v1[3]);
                *(u32x4*)rowp = w; }
    }
};

struct EpiColsAct {
    static constexpr bool PERM = true, AFTER_DRAIN = false;
    bf16_t* O; int ldc;
    __device__ __forceinline__ void operator()(const f32x4 (&acc)[2][2][4][2], const Unit& u, int wr, int wc, int fr, int fq) const {
        const int row0 = u.pm * BM + wr * 64 + fr, col0 = u.pn * BM + wc * 32 + 8 * fq;
        const int pn = u.pn; const int act = (pn >= 14 && pn < 18) ? 1 : (pn >= 18 && pn < 22) ? 2 : (pn >= 26 && pn < 30) ? 1 : (pn >= 30) ? 2 : 0;
#pragma unroll
        for (int ai = 0; ai < 2; ++ai)
#pragma unroll
            for (int m = 0; m < 4; ++m) { bf16_t* rowp = O + (size_t)(row0 + ai * HALF + m * 16) * ldc + col0;
#pragma unroll
                for (int bj = 0; bj < 2; ++bj) { f32x4 v0 = acc[ai][bj][m][0], v1 = acc[ai][bj][m][1];
                    if (act == 1) {
#pragma unroll
                        for (int j = 0; j < 4; ++j) { v0[j] = fast_silu(v0[j]); v1[j] = fast_silu(v1[j]); } }
                    else if (act == 2) {
#pragma unroll
                        for (int j = 0; j < 4; ++j) { v0[j] = fast_sigmoid(v0[j]); v1[j] = fast_sigmoid(v1[j]); } }
                    u32x4 w; w.x = cvt_pk_bf16(v0[0], v0[1]); w.y = cvt_pk_bf16(v0[2], v0[3]); w.z = cvt_pk_bf16(v1[0], v1[1]); w.w = cvt_pk_bf16(v1[2], v1[3]);
                    *(u32x4*)(rowp + bj * HALF) = w; } }
    }
};
template <class Epi, class Sched, bool ALIGN_EPI = false, bool SP2 = false>
__device__ __forceinline__ void gemm_phase(PG8_LAS unsigned char* lds, const Gemm g, const Sched& S, const Epi& E) {
    int tid = threadIdx.x; asm volatile("" : "+v"(tid));
    const int wid = __builtin_amdgcn_readfirstlane(tid >> 6), lane = tid & 63, wr = wid >> 2, wc = wid & 3, fr = lane & 15, fq = lane >> 4;
    const int K = g.K, nt = K / BK;
    unsigned voffA[2], voffB[2];
#pragma unroll
    for (int i = 0; i < 2; ++i) { int R, C; stage_rc(tid * 16 + i * 8192, R, C); const int Rb = Epi::PERM ? ((R & ~31) + perm32(R & 31)) : R;
        voffA[i] = (unsigned)(R * K + C) * 2u; voffB[i] = (unsigned)(Rb * K + C) * 2u; }
    const size_t kstep = (size_t)(BK * 2);
    const size_t hstep = (size_t)HALF * K * 2;
    const size_t tstep = 2 * hstep;
    const unsigned ldsw = (unsigned)wid * 1024u;
    const int aoff = lds_byte(wr * 64 + fr, fq * 8), boff = lds_byte(wc * 32 + fr, fq * 8);
#define PG8_SA(b, h) (((b) * 2 + (h)) * HTB)
#define PG8_SB(b, h) ((4 + (b) * 2 + (h)) * HTB)
#define PG8_STAGE(bufoff, gbase, voff) do { _Pragma("unroll") for (int _i = 0; _i < 2; ++_i) \
        __builtin_amdgcn_global_load_lds((const unsigned*)((const char*)(gbase) + (voff)[_i]), (PG8_LAS unsigned*)(lds + (bufoff) + ldsw + _i * 8192), 16, 0, 0); } while (0)
#define PG8_LDA(dst, b, h) do { _Pragma("unroll") for (int m = 0; m < 4; ++m) _Pragma("unroll") for (int k = 0; k < 2; ++k) dst[m][k] = *(const PG8_LAS bf16x8*)(lds + PG8_SA(b, h) + aoff + m * 2048 + k * 1024); } while (0)
#define PG8_LDB(dst, b, h) do { _Pragma("unroll") for (int n = 0; n < 2; ++n) _Pragma("unroll") for (int k = 0; k < 2; ++k) dst[n][k] = *(const PG8_LAS bf16x8*)(lds + PG8_SB(b, h) + boff + n * 2048 + k * 1024); } while (0)
#define PG8_MMA(ai, bj, At, Bt) do { __builtin_amdgcn_s_setprio(1); _Pragma("unroll") for (int m = 0; m < 4; ++m) _Pragma("unroll") for (int n = 0; n < 2; ++n) _Pragma("unroll") for (int k = 0; k < 2; ++k) \
        acc[ai][bj][m][n] = __builtin_amdgcn_mfma_f32_16x16x32_bf16(Bt[n][k], At[m][k], acc[ai][bj][m][n], 0, 0, 0); __builtin_amdgcn_s_setprio(0); } while (0)
#define PG8_WAIT_V(n) asm volatile("s_waitcnt vmcnt(" #n ")" ::: "memory")
#define PG8_WAIT_L(n) asm volatile("s_waitcnt lgkmcnt(" #n ")" ::: "memory")
#define PG8_BAR __builtin_amdgcn_s_barrier()
#define PG8_SCHED __builtin_amdgcn_sched_barrier(0)
    Unit cur, nxt; int ui = 0;
    if (!S.next(0, cur)) return;
    f32x4 acc[2][2][4][2];
#pragma unroll
    for (int a = 0; a < 2; ++a)
#pragma unroll
        for (int b = 0; b < 2; ++b)
#pragma unroll
            for (int m = 0; m < 4; ++m)
#pragma unroll
                for (int n = 0; n < 2; ++n) acc[a][b][m][n] = (f32x4){0.f, 0.f, 0.f, 0.f};
    bf16x8 At[4][2], B0[2][2], B1[2][2];
    const char* cA = (const char*)g.A + (size_t)cur.pm * tstep; const char* cB = (const char*)g.Bt + (size_t)cur.pn * tstep;
    S.a_ready(cur);
    if constexpr (SP2) {
        PG8_STAGE(PG8_SB(0, 0), cB, voffB); PG8_STAGE(PG8_SB(0, 1), cB + hstep, voffB); PG8_STAGE(PG8_SA(0, 0), cA, voffA); PG8_STAGE(PG8_SA(0, 1), cA + hstep, voffA);
        if (wr == 1) PG8_BAR;
        PG8_WAIT_V(2); PG8_BAR;
        PG8_STAGE(PG8_SB(1, 0), cB + kstep, voffB); PG8_STAGE(PG8_SA(1, 0), cA + kstep, voffA); PG8_STAGE(PG8_SB(1, 1), cB + hstep + kstep, voffB);
        PG8_WAIT_V(6); PG8_BAR;
    } else {
        PG8_STAGE(PG8_SB(0, 0), cB, voffB); PG8_STAGE(PG8_SA(0, 0), cA, voffA); PG8_STAGE(PG8_SB(0, 1), cB + hstep, voffB); PG8_STAGE(PG8_SA(0, 1), cA + hstep, voffA);
        if (wr == 1) PG8_BAR;
        PG8_WAIT_V(4); PG8_BAR;
        PG8_STAGE(PG8_SB(1, 0), cB + kstep, voffB); PG8_STAGE(PG8_SA(1, 0), cA + kstep, voffA); PG8_STAGE(PG8_SB(1, 1), cB + hstep + kstep, voffB);
        PG8_WAIT_V(6); PG8_BAR;
    }
    for (;;) {
        const bool has_next = S.next(ui + 1, nxt);
        const char* nA = has_next ? (const char*)g.A + (size_t)nxt.pm * tstep : cA; const char* nB = has_next ? (const char*)g.Bt + (size_t)nxt.pn * tstep : cB;
        for (int t = 0; t < nt; t += 2) {
            const bool last = (t == nt - 2);
            const char* a1 = cA + (size_t)(t + 1) * kstep;
            const char* a2 = last ? nA : cA + (size_t)(t + 2) * kstep; const char* b2 = last ? nB : cB + (size_t)(t + 2) * kstep;
            const char* a3 = a2 + kstep; const char* b3 = b2 + kstep;
            if (last && has_next) S.a_ready(nxt);
            if constexpr (SP2) {
            PG8_LDB(B0, 0, 0); PG8_LDB(B1, 0, 1); PG8_SCHED; PG8_LDA(At, 0, 0); PG8_STAGE(PG8_SA(1, 1), a1 + hstep, voffA);
            PG8_WAIT_V(8); PG8_WAIT_L(0); PG8_BAR; PG8_MMA(0, 0, At, B0); PG8_MMA(0, 1, At, B1); PG8_BAR; PG8_SCHED;
            PG8_LDA(At, 0, 1); PG8_STAGE(PG8_SB(0, 0), b2, voffB); PG8_STAGE(PG8_SB(0, 1), b2 + hstep, voffB); PG8_STAGE(PG8_SA(0, 0), a2, voffA);
            PG8_WAIT_V(8); PG8_WAIT_L(0); PG8_BAR; PG8_MMA(1, 0, At, B0); PG8_MMA(1, 1, At, B1); PG8_BAR; PG8_SCHED;
            PG8_LDB(B0, 1, 0); PG8_LDB(B1, 1, 1); PG8_SCHED; PG8_LDA(At, 1, 0); PG8_STAGE(PG8_SA(0, 1), a2 + hstep, voffA);
            PG8_WAIT_V(8); PG8_WAIT_L(0); PG8_BAR; PG8_MMA(0, 0, At, B0); PG8_MMA(0, 1, At, B1); PG8_BAR; PG8_SCHED;
            PG8_LDA(At, 1, 1); PG8_STAGE(PG8_SB(1, 0), b3, voffB); PG8_STAGE(PG8_SB(1, 1), b3 + hstep, voffB); PG8_STAGE(PG8_SA(1, 0), a3, voffA);
            PG8_WAIT_V(8); PG8_WAIT_L(0); PG8_BAR; PG8_MMA(1, 0, At, B0); PG8_MMA(1, 1, At, B1); PG8_BAR; PG8_SCHED;
            } else {
            PG8_LDB(B0, 0, 0); PG8_SCHED; PG8_LDA(At, 0, 0); PG8_STAGE(PG8_SA(1, 1), a1 + hstep, voffA);
            PG8_WAIT_L(8); PG8_BAR; PG8_WAIT_L(0); PG8_MMA(0, 0, At, B0); PG8_BAR; PG8_SCHED;
            PG8_LDB(B1, 0, 1); PG8_STAGE(PG8_SB(0, 0), b2, voffB);
            PG8_BAR; PG8_WAIT_L(0); PG8_MMA(0, 1, At, B1); PG8_BAR;
            PG8_LDA(At, 0, 1); PG8_STAGE(PG8_SA(0, 0), a2, voffA);
            PG8_BAR; PG8_WAIT_L(0); PG8_MMA(1, 0, At, B0); PG8_BAR; PG8_SCHED;
            PG8_STAGE(PG8_SB(0, 1), b2 + hstep, voffB);
            PG8_WAIT_V(6); PG8_BAR; PG8_MMA(1, 1, At, B1); PG8_BAR;
            PG8_LDB(B0, 1, 0); PG8_SCHED; PG8_LDA(At, 1, 0); PG8_STAGE(PG8_SA(0, 1), a2 + hstep, voffA);
            PG8_WAIT_L(8); PG8_BAR; PG8_WAIT_L(0); PG8_MMA(0, 0, At, B0); PG8_BAR; PG8_SCHED;
            PG8_LDB(B1, 1, 1); PG8_STAGE(PG8_SB(1, 0), b3, voffB);
            PG8_BAR; PG8_WAIT_L(0); PG8_MMA(0, 1, At, B1); PG8_BAR;
            PG8_LDA(At, 1, 1); PG8_STAGE(PG8_SA(1, 0), a3, voffA);
            PG8_BAR; PG8_WAIT_L(0); PG8_MMA(1, 0, At, B0); PG8_BAR; PG8_SCHED;
            PG8_STAGE(PG8_SB(1, 1), b3 + hstep, voffB);
            PG8_WAIT_V(6); PG8_BAR; PG8_MMA(1, 1, At, B1); PG8_BAR;
            }
        }
        if constexpr (ALIGN_EPI) { if (wr == 0) PG8_BAR; }
        if constexpr (!Epi::AFTER_DRAIN) { E(acc, cur, wr, wc, fr, fq); S.done(cur); }
        if (!has_next) break;
#pragma unroll
        for (int a = 0; a < 2; ++a)
#pragma unroll
            for (int b = 0; b < 2; ++b)
#pragma unroll
                for (int m = 0; m < 4; ++m)
#pragma unroll
                    for (int n = 0; n < 2; ++n) acc[a][b][m][n] = (f32x4){0.f, 0.f, 0.f, 0.f};
        cur = nxt; cA = nA; cB = nB; ++ui;
        if constexpr (ALIGN_EPI) { if (wr == 1) PG8_BAR; }
    }
    PG8_WAIT_V(0);
    if constexpr (!ALIGN_EPI) { if (wr == 0) PG8_BAR; }
    PG8_BAR;
    if constexpr (Epi::AFTER_DRAIN) { E.fused(acc, cur, wr, wc, fr, fq, lds, wid, lane); S.done(cur); }
#undef PG8_SA
#undef PG8_SB
#undef PG8_STAGE
#undef PG8_LDA
#undef PG8_LDB
#undef PG8_MMA
#undef PG8_WAIT_V
#undef PG8_WAIT_L
#undef PG8_BAR
#undef PG8_SCHED
}
}

#define LAS __attribute__((address_space(3)))
typedef pg8::bf16_t bf16_t;
typedef pg8::bf16x8 bf16x8;
typedef pg8::f32x4 f32x4;
typedef pg8::u32x4 u32x4;
typedef unsigned u32x2 __attribute__((ext_vector_type(2)));
typedef float f32x2v __attribute__((ext_vector_type(2)));
using pg8::cvt_pk_bf16;
using pg8::fast_sigmoid;
using pg8::fast_silu;

constexpr int D = 1024, NB = 4, SEQ = 8192, NTOK = NB * SEQ;
#ifndef MK_NSPLIT
#define MK_NSPLIT 4
#endif
constexpr int NSPLIT = MK_NSPLIT, TS = SEQ / NSPLIT, MS = NB * TS;
constexpr int CL = 9728;
constexpr int C_R = 0, C_K = 1024, C_V = 2048, C_WLO = 3072, C_ALO = 3136, C_GLO = 3200, C_HQ = 3584, C_HF = 4608, C_HI = 5632, C_HG = 6656, C_GA = 7680, C_GB = 8704;
constexpr int CARRY_LD = 3584;
constexpr int DFF = 2816;
constexpr size_t MiB = 1u << 20, KiB = 1u << 10;
constexpr size_t WS_WIN = 0, WS_WOUT = 19 * MiB, WS_WQ = 21 * MiB, WS_WO = 23 * MiB, WS_WKV = 25 * MiB, WS_W13 = 29 * MiB, WS_W2 = 40 * MiB;
constexpr size_t WS_RW2T = 46 * MiB, WS_RA2T = 46 * MiB + 128 * KiB, WS_RG2T = 46 * MiB + 256 * KiB, WS_CARRY = 46 * MiB + 640 * KiB, WS_LB = 46 * MiB + 704 * KiB;
constexpr size_t WS_MBF = 47 * MiB, WS_KV = 49 * MiB, WS_VT = 53 * MiB, WS_RWST = 55 * MiB, WS_HGST = 56 * MiB, WS_BONUS = 58 * MiB;
constexpr size_t WS_G2TP = 59 * MiB;
constexpr size_t WS_MERGED = 64 * MiB;
constexpr size_t WS_U1 = 128 * MiB, WS_COLS = 144 * MiB, WS_PR = 296 * MiB, WS_PK = 312 * MiB, WS_PA = 328 * MiB, WS_PB = 344 * MiB, WS_PV = 360 * MiB, WS_PW = 376 * MiB, WS_ORAW = 408 * MiB, WS_HGO = 440 * MiB;
constexpr size_t WS_GATE = 472 * MiB, WS_ASG = 488 * MiB;
constexpr size_t WS_U = 128 * MiB, WS_Q = 192 * MiB, WS_AO = 256 * MiB, WS_FF = 320 * MiB, WS_CTL = 496 * MiB, CTL_BYTES = 64 * KiB, WS_END = 496 * MiB + 64 * KiB;
constexpr int LDS_BYTES = 147456, MISC_OFF = 131072 + 320;
constexpr int T0 = 1 + 5 * NSPLIT, N_PHASES = T0 + 9;

__device__ __forceinline__ float bflo(unsigned u) { return __uint_as_float(u << 16); }
__device__ __forceinline__ float bfhi(unsigned u) { return __uint_as_float(u & 0xffff0000u); }
__device__ __forceinline__ unsigned f2bf(float f) { unsigned u = __float_as_uint(f); return (u + 0x7fffu + ((u >> 16) & 1u)) >> 16; }
__device__ __forceinline__ f32x4 ld4bf(const bf16_t* p) { const u32x2 u = *(const u32x2*)p; return (f32x4){bflo(u.x), bfhi(u.x), bflo(u.y), bfhi(u.y)}; }
__device__ __forceinline__ void ld8bf(const bf16_t* p, float (&o)[8]) { const u32x4 u = *(const u32x4*)p; o[0] = bflo(u.x); o[1] = bfhi(u.x); o[2] = bflo(u.y); o[3] = bfhi(u.y); o[4] = bflo(u.z); o[5] = bfhi(u.z); o[6] = bflo(u.w); o[7] = bfhi(u.w); }
__device__ __forceinline__ void st4bf(bf16_t* p, f32x4 v) { u32x2 w; w.x = cvt_pk_bf16(v[0], v[1]); w.y = cvt_pk_bf16(v[2], v[3]); *(u32x2*)p = w; }
__device__ __forceinline__ bf16x8 pack8(const float (&t)[8]) { u32x4 w; w.x = cvt_pk_bf16(t[0], t[1]); w.y = cvt_pk_bf16(t[2], t[3]); w.z = cvt_pk_bf16(t[4], t[5]); w.w = cvt_pk_bf16(t[6], t[7]); return __builtin_bit_cast(bf16x8, w); }
__device__ __forceinline__ float tanh_fast(float x) { return 1.0f - 2.0f * __builtin_amdgcn_rcpf(1.0f + __expf(2.0f * x)); }
__device__ __forceinline__ float wave_sum(float v) {
#pragma unroll
    for (int o = 1; o < 64; o <<= 1) v += __shfl_xor(v, o);
    return v;
}
__device__ __forceinline__ float fq_sum(float v) { v += __shfl_xor(v, 16); v += __shfl_xor(v, 32); return v; }
template <int CTRL> __device__ __forceinline__ float dpp_add(float x) { return x + __builtin_bit_cast(float, __builtin_amdgcn_update_dpp(0, __builtin_bit_cast(int, x), CTRL, 0xf, 0xf, false)); }
#ifdef MK_SHFL_REDUCE
__device__ __forceinline__ float allreduce16(float x) { x += __shfl_xor(x, 1); x += __shfl_xor(x, 2); x += __shfl_xor(x, 4); x += __shfl_xor(x, 8); return x; }
#else
__device__ __forceinline__ float allreduce16(float x) { x = dpp_add<0xB1>(x); x = dpp_add<0x4E>(x); x = dpp_add<0x141>(x); x = dpp_add<0x140>(x); return x; }
#endif
__device__ __forceinline__ void allreduce16x2(float& x, float& y) {
    x = dpp_add<0xB1>(x); y = dpp_add<0xB1>(y); x = dpp_add<0x4E>(x); y = dpp_add<0x4E>(y); x = dpp_add<0x141>(x); y = dpp_add<0x141>(y); x = dpp_add<0x140>(x); y = dpp_add<0x140>(y); }
#define MFMA16(a, b, c) __builtin_amdgcn_mfma_f32_16x16x32_bf16((a), (b), (c), 0, 0, 0)

#define XB_TMO      128
#define XB_XCNT(j)  (256  + 64 * (j))
#define XB_XSUB(j)  (1280 + 64 * (j))
#define XB_XGEN(j)  (2304 + 64 * (j))
#define XB_TOP      3328
#define XB_TOPGEN   3392
#define XCD_BAR_WORDS 3456
#define XB_SPIN_CAP (1u << 18)

__device__ __forceinline__ unsigned xb_ld(unsigned* p)              { return __hip_atomic_load(p, __ATOMIC_RELAXED, __HIP_MEMORY_SCOPE_AGENT); }
__device__ __forceinline__ unsigned xb_add(unsigned* p, unsigned v) { return __hip_atomic_fetch_add(p, v, __ATOMIC_RELAXED, __HIP_MEMORY_SCOPE_AGENT); }
__device__ __forceinline__ unsigned xb_xcc_id() { return (unsigned)__builtin_amdgcn_s_getreg((3 << 11) | 20) & 0xFu; }
#define XB_SPIN(cond, bar) do { unsigned _sp = 0; while (cond) { __builtin_amdgcn_s_sleep(1); \
    if ((++_sp & 255u) == 0u) { if (xb_ld(&(bar)[XB_TMO])) break; if (_sp > XB_SPIN_CAP) { atomicAdd(&(bar)[XB_TMO], 1u); break; } } } } while (0)

struct XcdBarrier {
    unsigned* bar; unsigned x;
    volatile LAS unsigned* st;
};

__device__ __forceinline__ XcdBarrier xcd_barrier_post(unsigned* bar, volatile LAS unsigned* st) {
    XcdBarrier b; b.bar = bar; b.x = xb_xcc_id(); b.st = st;
    if (threadIdx.x == 0) (void)xb_add(&bar[XB_XCNT(b.x)], 1u);
    return b;
}
__device__ __forceinline__ void xcd_barrier_complete(unsigned* bar, unsigned x, unsigned& nloc, unsigned& nx) {
    const unsigned G = gridDim.x * gridDim.y * gridDim.z;
    unsigned sum, cnt, mine, sp = 0u;
    for (;;) {
        sum = 0u; cnt = 0u; mine = 0u;
#pragma unroll
        for (unsigned j = 0; j < 16; ++j) { const unsigned c = xb_ld(&bar[XB_XCNT(j)]); sum += c; cnt += (c > 0u) ? 1u : 0u; mine = (j == x) ? c : mine; }
        if (sum == G) break;
        __builtin_amdgcn_s_sleep(1);
        if ((++sp & 255u) == 0u) { if (xb_ld(&bar[XB_TMO])) break; if (sp > XB_SPIN_CAP) { atomicAdd(&bar[XB_TMO], 1u); break; } }
    }
    nloc = mine > 0u ? mine : 1u; nx = cnt > 0u ? cnt : 1u;
}

__device__ __forceinline__ void xcd_barrier(const XcdBarrier& b) {
    asm volatile("s_waitcnt vmcnt(0)" ::: "memory");
    __syncthreads();
    if (threadIdx.x == 0) {
        unsigned* bar = b.bar;
        __builtin_amdgcn_s_waitcnt(0);
        unsigned nloc = b.st[0], nx = b.st[1];
        if (nloc == 0u) { xcd_barrier_complete(bar, b.x, nloc, nx); b.st[0] = nloc; b.st[1] = nx; }
        const unsigned old = xb_add(&bar[XB_XSUB(b.x)], 1u);
        const unsigned gen = old / nloc;
        if (old + 1u == (gen + 1u) * nloc) {
            __builtin_amdgcn_fence(__ATOMIC_RELEASE, "agent");
            asm volatile("s_waitcnt vmcnt(0)" ::: "memory");
            const unsigned og = xb_add(&bar[XB_TOP], 1u);
            const unsigned tg = og / nx;
            if (og + 1u == (tg + 1u) * nx) xb_add(&bar[XB_TOPGEN], 1u);
            else XB_SPIN(xb_ld(&bar[XB_TOPGEN]) == tg, bar);
            __builtin_amdgcn_fence(__ATOMIC_ACQUIRE, "agent");
            xb_add(&bar[XB_XGEN(b.x)], 1u);
            asm volatile("s_waitcnt vmcnt(0)" ::: "memory");
        } else {
            XB_SPIN(xb_ld(&bar[XB_XGEN(b.x)]) == gen, bar);
            __builtin_amdgcn_fence(__ATOMIC_ACQUIRE, "agent");
            asm volatile("s_waitcnt vmcnt(0)" ::: "memory");
        }
    }
    __syncthreads();
}

__device__ __forceinline__ void rms_row_bf16(const float* src, const float* g, bf16_t* dst, int lane) {
    f32x4 v[4]; float s = 0.f;
#pragma unroll
    for (int j = 0; j < 4; ++j) { v[j] = ((const f32x4*)src)[lane + 64 * j]; s += (v[j][0] * v[j][0] + v[j][1] * v[j][1]) + (v[j][2] * v[j][2] + v[j][3] * v[j][3]); }
    const float rs = 1.0f / sqrtf(wave_sum(s) * (1.0f / 1024.0f) + 1e-6f);
#pragma unroll
    for (int j = 0; j < 4; ++j) { const f32x4 gv = ((const f32x4*)g)[lane + 64 * j]; st4bf(dst + 4 * (lane + 64 * j), v[j] * rs * gv); }
}
__device__ __forceinline__ void tr_item(const float* W, int K, int N, bf16_t* WT, int kb, int n0, int row_base, LAS float* scr, int lane) {
    const int k0 = 64 * kb;
#pragma unroll 8
    for (int i = 0; i < 32; ++i) { const int kk = 2 * i + (lane >> 5); scr[kk * 33 + (lane & 31)] = W[(size_t)(k0 + kk) * N + n0 + (lane & 31)]; }
    asm volatile("s_waitcnt lgkmcnt(0)" ::: "memory");
    const int c = lane & 7;
#pragma unroll
    for (int j = 0; j < 4; ++j) { const int n = (lane >> 3) + 8 * j; const LAS float* sp = scr + (8 * c) * 33 + n;
        u32x4 o; o.x = cvt_pk_bf16(sp[0 * 33], sp[1 * 33]); o.y = cvt_pk_bf16(sp[2 * 33], sp[3 * 33]); o.z = cvt_pk_bf16(sp[4 * 33], sp[5 * 33]); o.w = cvt_pk_bf16(sp[6 * 33], sp[7 * 33]);
        *(u32x4*)(WT + (size_t)(row_base + n) * K + k0 + 8 * c) = o; }
    asm volatile("s_waitcnt lgkmcnt(0)" ::: "memory");
}

__device__ __forceinline__ void prep_phase(int s, int gw, int NGW, int lane, const bf16_t* cols, const bf16_t* carry,
        const float* mu, const float* w0, const float* a0, const float* k_k, const float* k_a, const float* r_k,
        const bf16_t* w2T, const bf16_t* a2T, bf16_t* PR, bf16_t* PK, bf16_t* PA, bf16_t* PB, bf16_t* PV, float* PW, float* bonus, bf16_t* ASG) {
    const int fr = lane & 15, fq = lane >> 4;
    for (int item = gw; item < (MS / 16) * 4; item += NGW) {
        const int tile = item >> 2, hg4 = item & 3;
        const int lt = tile * 16 + fr, b = lt / TS, tl = lt % TS;
        const bf16_t* crow = cols + (size_t)lt * CL;
        const bf16_t* prow = tl > 0 ? crow - CL : carry + ((s & 1) * 4 + b) * CARRY_LD;
        bf16x8 Aw[2], Aa[2];
#pragma unroll
        for (int ks = 0; ks < 2; ++ks) {
            { const int c = C_WLO + ks * 32 + fq * 8; float cur[8], prv[8], t[8]; ld8bf(crow + c, cur); ld8bf(prow + c, prv);
              const f32x4 m0 = *(const f32x4*)(mu + c), m1 = *(const f32x4*)(mu + c + 4);
#pragma unroll
              for (int e = 0; e < 8; ++e) { const float mm = e < 4 ? m0[e & 3] : m1[e & 3]; t[e] = tanh_fast(cur[e] + mm * (prv[e] - cur[e])); }
              Aw[ks] = pack8(t); }
            { const int c = C_ALO + ks * 32 + fq * 8; float cur[8], prv[8], t[8]; ld8bf(crow + c, cur); ld8bf(prow + c, prv);
              const f32x4 m0 = *(const f32x4*)(mu + c), m1 = *(const f32x4*)(mu + c + 4);
#pragma unroll
              for (int e = 0; e < 8; ++e) { const float mm = e < 4 ? m0[e & 3] : m1[e & 3]; t[e] = cur[e] + mm * (prv[e] - cur[e]); }
              Aa[ks] = pack8(t); }
        }
        if (hg4 == 0) {
#pragma unroll
            for (int ks = 0; ks < 5; ++ks) { const int c = C_GLO + ks * 32 + fq * 8; float cur[8], prv[8], t[8]; ld8bf(crow + c, cur); ld8bf(prow + c, prv);
                const f32x4 m0 = *(const f32x4*)(mu + c), m1 = *(const f32x4*)(mu + c + 4);
#pragma unroll
                for (int e = 0; e < 8; ++e) { const float mm = e < 4 ? m0[e & 3] : m1[e & 3]; t[e] = fast_sigmoid(cur[e] + mm * (prv[e] - cur[e])); }
                *(bf16x8*)(ASG + (size_t)lt * 256 + ks * 32 + fq * 8) = pack8(t); }
#pragma unroll
            for (int ks = 5; ks < 8; ++ks) *(u32x4*)(ASG + (size_t)lt * 256 + ks * 32 + fq * 8) = (u32x4){0u, 0u, 0u, 0u};
        }
#pragma unroll 1
        for (int hh = 0; hh < 4; ++hh) {
            const int h = hg4 * 4 + hh;
            f32x4 aw[4], aa[4];
#pragma unroll
            for (int nt = 0; nt < 4; ++nt) { aw[nt] = (f32x4){0.f, 0.f, 0.f, 0.f}; aa[nt] = (f32x4){0.f, 0.f, 0.f, 0.f};
                const int n = h * 64 + nt * 16 + fr;
#pragma unroll
                for (int ks = 0; ks < 2; ++ks) { const bf16x8 bw = *(const bf16x8*)(w2T + n * 64 + ks * 32 + fq * 8); aw[nt] = MFMA16(bw, Aw[ks], aw[nt]);
                    const bf16x8 ba = *(const bf16x8*)(a2T + n * 64 + ks * 32 + fq * 8); aa[nt] = MFMA16(ba, Aa[ks], aa[nt]); } }
            f32x4 kkv[4], av[4]; float ssq = 0.f, bon = 0.f;
#pragma unroll
            for (int nt = 0; nt < 4; ++nt) {
                const int c = h * 64 + nt * 16 + 4 * fq; const size_t o = (size_t)lt * 1024 + c;
                const f32x4 rc = ld4bf(crow + C_R + c), rp = ld4bf(prow + C_R + c), kc = ld4bf(crow + C_K + c), kp = ld4bf(prow + C_K + c), vc = ld4bf(crow + C_V + c), vp = ld4bf(prow + C_V + c);
                const f32x4 r = rc + *(const f32x4*)(mu + C_R + c) * (rp - rc), k = kc + *(const f32x4*)(mu + C_K + c) * (kp - kc), v = vc + *(const f32x4*)(mu + C_V + c) * (vp - vc);
                const f32x4 w0v = *(const f32x4*)(w0 + c), a0v = *(const f32x4*)(a0 + c), kkp = *(const f32x4*)(k_k + c), kap = *(const f32x4*)(k_a + c), rkp = *(const f32x4*)(r_k + c);
                f32x4 wv, a, kk, kmod;
#pragma unroll
                for (int j = 0; j < 4; ++j) {
                    const float z = -(w0v[j] + aw[nt][j]);
                    const float sp = fmaxf(z, 0.f) + __logf(1.0f + __expf(-fabsf(z)));
                    wv[j] = __expf(-__expf(-sp - 0.5f));
                    a[j] = fast_sigmoid(a0v[j] + aa[nt][j]);
                    kk[j] = k[j] * kkp[j]; kmod[j] = k[j] * (1.0f + (a[j] - 1.0f) * kap[j]);
                    ssq += kk[j] * kk[j]; bon += r[j] * kmod[j] * rkp[j];
                }
                kkv[nt] = kk; av[nt] = a;
                st4bf(PR + o, r); st4bf(PK + o, kmod); st4bf(PV + o, v); *(f32x4*)(PW + o) = wv;
            }
            ssq = fq_sum(ssq); bon = fq_sum(bon);
            const float rs = 1.0f / sqrtf(fmaxf(ssq, 1e-24f));
#pragma unroll
            for (int nt = 0; nt < 4; ++nt) { const int c = h * 64 + nt * 16 + 4 * fq; const size_t o = (size_t)lt * 1024 + c;
                const f32x4 kn = kkv[nt] * rs; st4bf(PA + o, -kn); st4bf(PB + o, kn * av[nt]); }
            if (fq == 0) bonus[lt * 16 + h] = bon;
        }
    }
}

__device__ __forceinline__ void post_phase(int s, int gw, int NGW, int lane, const bf16_t* cols, const bf16_t* carry, const float* mu, const bf16_t* gate,
        const float* ln_w, const float* ln_b, const float* hg_g, const float* oraw, const float* hgo, const bf16_t* PV, const float* bonus, bf16_t* merged) {
    const int fr = lane & 15, fq = lane >> 4;
    for (int item = gw; item < (MS / 16) * 4; item += NGW) {
        const int tile = item >> 2, q4 = item & 3;
        const int lt = tile * 16 + fr, b = lt / TS, tl = lt % TS;
        const size_t gt = (size_t)b * SEQ + s * TS + tl;
        const bf16_t* crow = cols + (size_t)lt * CL;
        const bf16_t* prow = tl > 0 ? crow - CL : carry + ((s & 1) * 4 + b) * CARRY_LD;
#pragma unroll 1
        for (int hgh = 0; hgh < 2; ++hgh) {
            const int h8 = q4 * 2 + hgh;
            f32x4 ho[8]; float ss = 0.f;
#pragma unroll
            for (int n8 = 0; n8 < 8; ++n8) { ho[n8] = *(const f32x4*)(hgo + ((size_t)((b * 8 + h8) * 8 + n8) * TS + tl) * 16 + 4 * fq); ss += (ho[n8][0] * ho[n8][0] + ho[n8][1] * ho[n8][1]) + (ho[n8][2] * ho[n8][2] + ho[n8][3] * ho[n8][3]); }
            ss = fq_sum(ss);
            const float rsh = 1.0f / sqrtf(ss * (1.0f / 128.0f) + 1e-6f);
#pragma unroll
            for (int rwh = 0; rwh < 2; ++rwh) {
                const int h = q4 * 4 + hgh * 2 + rwh;
                f32x4 ag[4], o[4]; float sm = 0.f;
#pragma unroll
                for (int nt = 0; nt < 4; ++nt) { ag[nt] = ld4bf(gate + (size_t)lt * 1024 + h * 64 + nt * 16 + 4 * fq);
                    o[nt] = *(const f32x4*)(oraw + ((size_t)((b * 16 + h) * 4 + nt) * TS + tl) * 16 + 4 * fq); sm += (o[nt][0] + o[nt][1]) + (o[nt][2] + o[nt][3]); }
                const float mean = fq_sum(sm) * (1.0f / 64.0f); float vq = 0.f;
#pragma unroll
                for (int nt = 0; nt < 4; ++nt) { o[nt] = o[nt] - mean; vq += (o[nt][0] * o[nt][0] + o[nt][1] * o[nt][1]) + (o[nt][2] * o[nt][2] + o[nt][3] * o[nt][3]); }
                const float rstd = 1.0f / sqrtf(fq_sum(vq) * (1.0f / 64.0f) + 64e-5f);
#ifdef MK_NO_BONUS
                const float bon = 0.f;
#else
                const float bon = bonus[lt * 16 + h];
#endif
#pragma unroll
                for (int nt = 0; nt < 4; ++nt) {
                    const int c = h * 64 + nt * 16 + 4 * fq;
                    const f32x4 lw = *(const f32x4*)(ln_w + c), lb = *(const f32x4*)(ln_b + c), v = ld4bf(PV + (size_t)lt * 1024 + c);
                    const f32x4 ya = (o[nt] * rstd * lw + lb + v * bon) * ag[nt];
                    const f32x4 ng = *(const f32x4*)(hg_g + (c & 127)), gh = ld4bf(crow + C_HG + c), gar = ld4bf(crow + C_GA + c), gbr = ld4bf(crow + C_GB + c);
                    const f32x4 hv = ho[rwh * 4 + nt] * rsh * ng;
                    f32x4 m;
#pragma unroll
                    for (int j = 0; j < 4; ++j) {
#if defined(MK_ZERO_YA)
                        m[j] = fast_sigmoid(gbr[j]) * (hv[j] * fast_silu(gh[j]));
#elif defined(MK_ZERO_YB)
                        m[j] = fast_sigmoid(gar[j]) * ya[j];
#else
                        m[j] = gar[j] * ya[j] + gbr[j] * (hv[j] * gh[j]);
#endif
                    }
                    st4bf(merged + gt * 1024 + c, m);
                }
            }
        }
    }
}

constexpr int RWB = 45056;
#define SCAN_BAR_L() do { asm volatile("s_waitcnt vmcnt(0) lgkmcnt(0)" ::: "memory"); __builtin_amdgcn_s_barrier(); asm volatile("" ::: "memory"); } while (0)
#define SCAN_BAR_S() do { asm volatile("s_waitcnt lgkmcnt(0)" ::: "memory"); __builtin_amdgcn_s_barrier(); asm volatile("" ::: "memory"); } while (0)
__device__ __forceinline__ void rw_load(LAS unsigned char* bp, int lt2, size_t ltok0, int h, int rg, const bf16_t* PA, const float* PW, const bf16_t* PB, const bf16_t* PK, const bf16_t* PR, const bf16_t* PV) {
    const int tok = lt2 >> 3, c8 = (lt2 & 7) * 8; const size_t base = (ltok0 + tok) * 1024 + h * 64 + c8;
    const u32x4 ra = *(const u32x4*)(PA + base), rb = *(const u32x4*)(PB + base), rk = *(const u32x4*)(PK + base), rr = *(const u32x4*)(PR + base);
    const f32x4 w0 = *(const f32x4*)(PW + base), w1 = *(const f32x4*)(PW + base + 4);
    const unsigned rv = *(const unsigned*)(PV + (ltok0 + tok) * 1024 + h * 64 + rg * 16 + (lt2 & 7) * 2);
    const int off = (tok * 64 + c8) * 4;
#define RW_PUT(arr, u) do { *(LAS f32x4*)(bp + (arr) * 8192 + off) = (f32x4){bflo(u.x), bfhi(u.x), bflo(u.y), bfhi(u.y)}; *(LAS f32x4*)(bp + (arr) * 8192 + off + 16) = (f32x4){bflo(u.z), bfhi(u.z), bflo(u.w), bfhi(u.w)}; } while (0)
    RW_PUT(0, ra); RW_PUT(2, rb); RW_PUT(3, rk); RW_PUT(4, rr);
#undef RW_PUT
    *(LAS f32x4*)(bp + 8192 + off) = w0; *(LAS f32x4*)(bp + 8192 + off + 16) = w1;
    *(LAS f32x2v*)(bp + 40960 + (tok * 16 + (lt2 & 7) * 2) * 4) = (f32x2v){bflo(rv), bfhi(rv)};
}
__device__ __forceinline__ void y_drain(const LAS unsigned char* ybase, int lt2, float* dst) { *(f32x2v*)(dst + lt2 * 2) = *(const LAS f32x2v*)(ybase + lt2 * 8); }
__device__ __forceinline__ void rwkv_scan(int s, int bid, int G, int tid, int lane, int wave, LAS unsigned char* lds,
        const bf16_t* PA, const float* PW, const bf16_t* PB, const bf16_t* PK, const bf16_t* PR, const bf16_t* PV, float* oraw, float* state, bool save) {
    constexpr int NBLK = TS / 32;
    const int rowl = lane >> 4, j = lane & 15, row = (wave & 3) * 4 + rowl;
    for (int it = bid; it < 256; it += G) {
        const int b = it >> 6, h = (it >> 2) & 15, rg = it & 3;
        const size_t tok0 = (size_t)b * TS;
        float* stp = state + ((size_t)((b * 16 + h) * 64 + rg * 16 + row) * 64 + 4 * j);
        float* obase = oraw + (size_t)it * TS * 16;
        f32x4 st = (f32x4){0.f, 0.f, 0.f, 0.f};
        if (wave < 4 && s > 0) st = *(const f32x4*)stp;
        if (wave >= 4) { rw_load(lds, tid - 256, tok0, h, rg, PA, PW, PB, PK, PR, PV); SCAN_BAR_L(); } else { __builtin_amdgcn_s_setprio(2); asm volatile("s_waitcnt vmcnt(0)" ::: "memory"); SCAN_BAR_S(); }
#pragma unroll 1
        for (int blk = 0; blk < NBLK; ++blk) {
            if (wave >= 4) {
                if (blk > 0) y_drain(lds + ((blk - 1) & 1) * RWB + 43008, tid - 256, obase + (size_t)(blk - 1) * 512);
                if (blk + 1 < NBLK) rw_load(lds + ((blk + 1) & 1) * RWB, tid - 256, tok0 + (blk + 1) * 32, h, rg, PA, PW, PB, PK, PR, PV);
                SCAN_BAR_L();
            } else {
                const LAS unsigned char* bp = lds + (blk & 1) * RWB;
                const LAS unsigned char* p4 = bp + 16 * j; const LAS unsigned char* pv = bp + 40960 + row * 4; LAS unsigned char* py = (LAS unsigned char*)bp + 43008 + row * 4;
                f32x4 a4 = *(const LAS f32x4*)(p4), w4 = *(const LAS f32x4*)(p4 + 8192), b4 = *(const LAS f32x4*)(p4 + 16384), k4 = *(const LAS f32x4*)(p4 + 24576), r4 = *(const LAS f32x4*)(p4 + 32768);
                float vv = *(const LAS float*)(pv);
                float sa = (st[0] * a4[0] + st[1] * a4[1]) + (st[2] * a4[2] + st[3] * a4[3]);
                sa = allreduce16(sa);
#pragma unroll
                for (int t = 0; t < 32; ++t) {
                    f32x4 na = a4, nw = w4, nb = b4, nk = k4, nr = r4; float nv = vv;
                    if (t < 31) { const int o = (t + 1) * 256; na = *(const LAS f32x4*)(p4 + o); nw = *(const LAS f32x4*)(p4 + 8192 + o); nb = *(const LAS f32x4*)(p4 + 16384 + o); nk = *(const LAS f32x4*)(p4 + 24576 + o); nr = *(const LAS f32x4*)(p4 + 32768 + o); nv = *(const LAS float*)(pv + (t + 1) * 64); }
                    st = st * w4 + (b4 * sa + k4 * vv);
                    float y = (st[0] * r4[0] + st[1] * r4[1]) + (st[2] * r4[2] + st[3] * r4[3]);
                    float sn = (st[0] * na[0] + st[1] * na[1]) + (st[2] * na[2] + st[3] * na[3]);
                    allreduce16x2(sn, y);
                    if (j == 0) *(LAS float*)(py + t * 64) = y;
                    sa = sn; a4 = na; w4 = nw; b4 = nb; k4 = nk; r4 = nr; vv = nv;
                }
                SCAN_BAR_S();
            }
        }
        if (wave >= 4) { y_drain(lds + ((NBLK - 1) & 1) * RWB + 43008, tid - 256, obase + (size_t)(NBLK - 1) * 512); }
        else { __builtin_amdgcn_s_setprio(0); if (save) *(f32x4*)stp = st; }
    }
}

__device__ __forceinline__ void rwkv_scan_naive(int s, int gw, int NGW, int lane, int wave, LAS unsigned char* lds,
        const bf16_t* PA, const float* PW, const bf16_t* PB, const bf16_t* PK, const bf16_t* PR, const bf16_t* PV, float* oraw, float* state) {
    LAS float* slab = (LAS float*)(lds + wave * 2048);
    for (int it = gw; it < 64; it += NGW) {
        const int b = it >> 4, h = it & 15;
        float st[64];
        float* stp = state + (size_t)((b * 16 + h) * 64 + lane) * 64;
#pragma unroll
        for (int k = 0; k < 64; ++k) st[k] = (s > 0) ? stp[k] : 0.f;
        for (int tl = 0; tl < TS; ++tl) {
            const size_t base = ((size_t)b * TS + tl) * 1024 + h * 64 + lane;
            slab[lane] = bflo((unsigned)PA[base]); slab[64 + lane] = PW[base]; slab[128 + lane] = bflo((unsigned)PB[base]); slab[192 + lane] = bflo((unsigned)PK[base]); slab[256 + lane] = bflo((unsigned)PR[base]);
            const float vv = bflo((unsigned)PV[base]);
            asm volatile("s_waitcnt lgkmcnt(0)" ::: "memory");
            float sa = 0.f;
#pragma unroll
            for (int k = 0; k < 64; ++k) sa += st[k] * slab[k];
            float y = 0.f;
#pragma unroll
            for (int k = 0; k < 64; ++k) { st[k] = st[k] * slab[64 + k] + (sa * slab[128 + k] + vv * slab[192 + k]); y += st[k] * slab[256 + k]; }
            asm volatile("s_waitcnt lgkmcnt(0)" ::: "memory");
            oraw[((size_t)(it * 4 + (lane >> 4)) * TS + tl) * 16 + (lane & 15)] = y;
        }
#pragma unroll
        for (int k = 0; k < 64; ++k) stp[k] = st[k];
    }
}
constexpr int HGB = 53248;
__device__ __forceinline__ void hg_load(LAS unsigned char* bp, int lt2, size_t ltok0, int h8, int rg, const bf16_t* cols, const float* lbv) {
    const int tok = lt2 >> 3, c16 = (lt2 & 7) * 16; const bf16_t* crow = cols + (ltok0 + tok) * CL;
    float q[16], f[16];
    { float t[8]; ld8bf(crow + C_HQ + h8 * 128 + c16, t);
#pragma unroll
      for (int e = 0; e < 8; ++e) q[e] = t[e];
      ld8bf(crow + C_HQ + h8 * 128 + c16 + 8, t);
#pragma unroll
      for (int e = 0; e < 8; ++e) q[8 + e] = t[e];
      ld8bf(crow + C_HF + h8 * 128 + c16, t);
#pragma unroll
      for (int e = 0; e < 8; ++e) f[e] = t[e];
      ld8bf(crow + C_HF + h8 * 128 + c16 + 8, t);
#pragma unroll
      for (int e = 0; e < 8; ++e) f[8 + e] = t[e]; }
    const unsigned rv = *(const unsigned*)(crow + C_HI + h8 * 128 + rg * 16 + (lt2 & 7) * 2);
    const int off = (tok * 128 + c16) * 4;
#pragma unroll
    for (int g = 0; g < 4; ++g) { const f32x4 lb = *(const f32x4*)(lbv + h8 * 128 + c16 + 4 * g); f32x4 fv, kv, qv;
#pragma unroll
        for (int e = 0; e < 4; ++e) { fv[e] = lb[e] + (1.0f - lb[e]) * fast_sigmoid(f[4 * g + e]); kv[e] = 1.0f - fv[e]; qv[e] = fast_silu(q[4 * g + e]); }
        *(LAS f32x4*)(bp + off + 16 * g) = fv; *(LAS f32x4*)(bp + 16384 + off + 16 * g) = kv; *(LAS f32x4*)(bp + 32768 + off + 16 * g) = qv; }
    *(LAS f32x2v*)(bp + 49152 + (tok * 16 + (lt2 & 7) * 2) * 4) = (f32x2v){bflo(rv), bfhi(rv)};
}
__device__ __forceinline__ void hgrn_scan(int s, int bid, int G, int tid, int lane, int wave, LAS unsigned char* lds, const bf16_t* cols, const float* lbv, float* hgo, float* state, bool save) {
    constexpr int NBLK = TS / 32;
    const int rowl = lane >> 4, j = lane & 15, row = (wave & 3) * 4 + rowl;
    for (int it = bid; it < 256; it += G) {
        const int b = it >> 6, h8 = (it >> 3) & 7, rg = it & 7;
        const size_t tok0 = (size_t)b * TS;
        float* stp = state + ((size_t)((b * 8 + h8) * 128 + rg * 16 + row) * 128 + 4 * j);
        float* obase = hgo + (size_t)it * TS * 16;
        f32x4 s0 = (f32x4){0.f, 0.f, 0.f, 0.f}, s1 = s0;
        if (wave < 4 && s > 0) { s0 = *(const f32x4*)stp; s1 = *(const f32x4*)(stp + 64); }
        if (wave >= 4) { hg_load(lds, tid - 256, tok0, h8, rg, cols, lbv); SCAN_BAR_L(); } else { __builtin_amdgcn_s_setprio(2); asm volatile("s_waitcnt vmcnt(0)" ::: "memory"); SCAN_BAR_S(); }
#pragma unroll 1
        for (int blk = 0; blk < NBLK; ++blk) {
            if (wave >= 4) {
                if (blk > 0) y_drain(lds + ((blk - 1) & 1) * HGB + 51200, tid - 256, obase + (size_t)(blk - 1) * 512);
                if (blk + 1 < NBLK) hg_load(lds + ((blk + 1) & 1) * HGB, tid - 256, tok0 + (blk + 1) * 32, h8, rg, cols, lbv);
                SCAN_BAR_L();
            } else {
                const LAS unsigned char* bp = lds + (blk & 1) * HGB;
                const LAS unsigned char* p4 = bp + 16 * j; const LAS unsigned char* pv = bp + 49152 + row * 4; LAS unsigned char* py = (LAS unsigned char*)bp + 51200 + row * 4;
                f32x4 f0 = *(const LAS f32x4*)(p4), f1 = *(const LAS f32x4*)(p4 + 256), k0 = *(const LAS f32x4*)(p4 + 16384), k1 = *(const LAS f32x4*)(p4 + 16384 + 256), q0 = *(const LAS f32x4*)(p4 + 32768), q1 = *(const LAS f32x4*)(p4 + 32768 + 256);
                float iv = *(const LAS float*)(pv); float yprev = 0.f;
#pragma unroll
                for (int t = 0; t < 32; ++t) {
                    f32x4 nf0 = f0, nf1 = f1, nk0 = k0, nk1 = k1, nq0 = q0, nq1 = q1; float niv = iv;
                    if (t < 31) { const int o = (t + 1) * 512; nf0 = *(const LAS f32x4*)(p4 + o); nf1 = *(const LAS f32x4*)(p4 + 256 + o); nk0 = *(const LAS f32x4*)(p4 + 16384 + o); nk1 = *(const LAS f32x4*)(p4 + 16384 + 256 + o);
                                  nq0 = *(const LAS f32x4*)(p4 + 32768 + o); nq1 = *(const LAS f32x4*)(p4 + 32768 + 256 + o); niv = *(const LAS float*)(pv + (t + 1) * 64); }
                    s0 = s0 * f0 + k0 * iv; s1 = s1 * f1 + k1 * iv;
                    float y = ((s0[0] * q0[0] + s0[1] * q0[1]) + (s0[2] * q0[2] + s0[3] * q0[3])) + ((s1[0] * q1[0] + s1[1] * q1[1]) + (s1[2] * q1[2] + s1[3] * q1[3]));
                    if (t & 1) { allreduce16x2(yprev, y); if (j == 0) { *(LAS float*)(py + (t - 1) * 64) = yprev; *(LAS float*)(py + t * 64) = y; } }
                    yprev = y;
                    f0 = nf0; f1 = nf1; k0 = nk0; k1 = nk1; q0 = nq0; q1 = nq1; iv = niv;
                }
                SCAN_BAR_S();
            }
        }
        if (wave >= 4) { y_drain(lds + ((NBLK - 1) & 1) * HGB + 51200, tid - 256, obase + (size_t)(NBLK - 1) * 512); }
        else { __builtin_amdgcn_s_setprio(0); if (save) { *(f32x4*)stp = s0; *(f32x4*)(stp + 64) = s1; } }
    }
}


constexpr int FT = 16;
constexpr int F_RW = 0, F_RWV = 20480, F_RWY = 21504, F_HG = 22528, F_HGQ = 8192, F_HGI = F_HG + 16384, F_HGY = F_HG + 17408, FBUF = 40960;
__device__ __forceinline__ void fused_load(LAS unsigned char* bp, int lt2, size_t ltok0, int h, int rg, int h8, int rg8, const bf16_t* PA, const float* PW, const bf16_t* PB, const bf16_t* PK, const bf16_t* PR, const bf16_t* PV,
        const bf16_t* cols, const float* lbv) {
    if (lt2 < 128) {
        const int tok = lt2 >> 3, c8 = (lt2 & 7) * 8; const size_t base = (ltok0 + tok) * 1024 + h * 64 + c8;
        const u32x4 ra = *(const u32x4*)(PA + base), rb = *(const u32x4*)(PB + base), rk = *(const u32x4*)(PK + base), rr = *(const u32x4*)(PR + base);
        const f32x4 w0 = *(const f32x4*)(PW + base), w1 = *(const f32x4*)(PW + base + 4);
        const unsigned rv = *(const unsigned*)(PV + (ltok0 + tok) * 1024 + h * 64 + rg * 16 + (lt2 & 7) * 2);
        const int off = (tok * 64 + c8) * 4;
#define RW_PUT(arr, u) do { *(LAS f32x4*)(bp + (arr) * 4096 + off) = (f32x4){bflo(u.x), bfhi(u.x), bflo(u.y), bfhi(u.y)}; *(LAS f32x4*)(bp + (arr) * 4096 + off + 16) = (f32x4){bflo(u.z), bfhi(u.z), bflo(u.w), bfhi(u.w)}; } while (0)
        RW_PUT(0, ra); RW_PUT(2, rb); RW_PUT(3, rk); RW_PUT(4, rr);
#undef RW_PUT
        *(LAS f32x4*)(bp + 4096 + off) = w0; *(LAS f32x4*)(bp + 4096 + off + 16) = w1;
        *(LAS f32x2v*)(bp + F_RWV + (tok * 16 + (lt2 & 7) * 2) * 4) = (f32x2v){bflo(rv), bfhi(rv)};
    } else {
        const int l = lt2 - 128, tok = l >> 3, c16 = (l & 7) * 16; const bf16_t* crow = cols + (ltok0 + tok) * CL;
        float q[16], f[16];
        { float t[8]; ld8bf(crow + C_HQ + h8 * 128 + c16, t);
#pragma unroll
          for (int e = 0; e < 8; ++e) q[e] = t[e];
          ld8bf(crow + C_HQ + h8 * 128 + c16 + 8, t);
#pragma unroll
          for (int e = 0; e < 8; ++e) q[8 + e] = t[e];
          ld8bf(crow + C_HF + h8 * 128 + c16, t);
#pragma unroll
          for (int e = 0; e < 8; ++e) f[e] = t[e];
          ld8bf(crow + C_HF + h8 * 128 + c16 + 8, t);
#pragma unroll
          for (int e = 0; e < 8; ++e) f[8 + e] = t[e]; }
        const unsigned rv = *(const unsigned*)(crow + C_HI + h8 * 128 + rg8 * 16 + (l & 7) * 2);
        LAS unsigned char* hp = bp + F_HG; const int off = (tok * 128 + c16) * 4;
#pragma unroll
        for (int g = 0; g < 4; ++g) { const f32x4 lb = *(const f32x4*)(lbv + h8 * 128 + c16 + 4 * g); f32x4 fv, qv;
#pragma unroll
            for (int e = 0; e < 4; ++e) { fv[e] = lb[e] + (1.0f - lb[e]) * f[4 * g + e]; qv[e] = q[4 * g + e]; }
            *(LAS f32x4*)(hp + off + 16 * g) = fv; *(LAS f32x4*)(hp + F_HGQ + off + 16 * g) = qv; }
        *(LAS f32x2v*)(bp + F_HGI + (tok * 16 + (l & 7) * 2) * 4) = (f32x2v){bflo(rv), bfhi(rv)};
    }
}
__device__ __forceinline__ void fused_drain(const LAS unsigned char* bp, int lt2, float* orw, float* ohg) {
    if (lt2 < 128) *(f32x2v*)(orw + lt2 * 2) = *(const LAS f32x2v*)(bp + F_RWY + lt2 * 8);
    else *(f32x2v*)(ohg + (lt2 - 128) * 2) = *(const LAS f32x2v*)(bp + F_HGY + (lt2 - 128) * 8);
}
__device__ __forceinline__ void fused_scan(int s, int bid, int G, int tid, int lane, int wave, LAS unsigned char* lds,
        const bf16_t* PA, const float* PW, const bf16_t* PB, const bf16_t* PK, const bf16_t* PR, const bf16_t* PV, const bf16_t* cols, const float* lbv,
        float* oraw, float* hgo, float* rwstate, float* hgstate, bool save) {
    constexpr int NBLK = TS / FT;
    const int rowl = lane >> 4, j = lane & 15, row = (wave & 3) * 4 + rowl;
    for (int it = bid; it < 256; it += G) {
        const int b = it >> 6, h = (it >> 2) & 15, rg = it & 3, h8 = (it >> 3) & 7, rg8 = it & 7;
        const size_t tok0 = (size_t)b * TS;
        float* stp = rwstate + ((size_t)((b * 16 + h) * 64 + rg * 16 + row) * 64 + 4 * j);
        float* shp = hgstate + ((size_t)((b * 8 + h8) * 128 + rg8 * 16 + row) * 128 + 4 * j);
        float* orw = oraw + (size_t)it * TS * 16; float* ohg = hgo + (size_t)it * TS * 16;
        f32x4 st = (f32x4){0.f, 0.f, 0.f, 0.f}, s0 = st, s1 = st;
        if (wave < 4 && s > 0) { st = *(const f32x4*)stp; s0 = *(const f32x4*)shp; s1 = *(const f32x4*)(shp + 64); }
        if (wave >= 4) { fused_load(lds, tid - 256, tok0, h, rg, h8, rg8, PA, PW, PB, PK, PR, PV, cols, lbv); SCAN_BAR_L(); } else { __builtin_amdgcn_s_setprio(2); asm volatile("s_waitcnt vmcnt(0)" ::: "memory"); SCAN_BAR_S(); }
#pragma unroll 1
        for (int blk = 0; blk < NBLK; ++blk) {
            if (wave >= 4) {
                if (blk > 0) fused_drain(lds + ((blk - 1) & 1) * FBUF, tid - 256, orw + (size_t)(blk - 1) * (FT * 16), ohg + (size_t)(blk - 1) * (FT * 16));
                if (blk + 1 < NBLK) fused_load(lds + ((blk + 1) & 1) * FBUF, tid - 256, tok0 + (blk + 1) * FT, h, rg, h8, rg8, PA, PW, PB, PK, PR, PV, cols, lbv);
                SCAN_BAR_L();
            } else {
                const LAS unsigned char* bp = lds + (blk & 1) * FBUF;
                const LAS unsigned char* p4 = bp + 16 * j; const LAS unsigned char* pv = bp + F_RWV + row * 4; LAS unsigned char* py = (LAS unsigned char*)bp + F_RWY + row * 4;
                const LAS unsigned char* g4 = bp + F_HG + 16 * j; const LAS unsigned char* gi = bp + F_HGI + row * 4; LAS unsigned char* gy = (LAS unsigned char*)bp + F_HGY + row * 4;
                f32x4 a4 = *(const LAS f32x4*)(p4), w4 = *(const LAS f32x4*)(p4 + 4096), b4 = *(const LAS f32x4*)(p4 + 8192), k4 = *(const LAS f32x4*)(p4 + 12288), r4 = *(const LAS f32x4*)(p4 + 16384);
                float vv = *(const LAS float*)(pv);
                f32x4 f0 = *(const LAS f32x4*)(g4), f1 = *(const LAS f32x4*)(g4 + 256), q0 = *(const LAS f32x4*)(g4 + F_HGQ), q1 = *(const LAS f32x4*)(g4 + F_HGQ + 256);
                float iv = *(const LAS float*)(gi);
                float sa = (st[0] * a4[0] + st[1] * a4[1]) + (st[2] * a4[2] + st[3] * a4[3]);
                sa = allreduce16(sa);
#pragma unroll
                for (int t = 0; t < FT; ++t) {
                    f32x4 na = a4, nw = w4, nb = b4, nk = k4, nr = r4; float nv = vv;
                    f32x4 nf0 = f0, nf1 = f1, nq0 = q0, nq1 = q1; float niv = iv;
                    if (t < FT - 1) { const int o = (t + 1) * 256; na = *(const LAS f32x4*)(p4 + o); nw = *(const LAS f32x4*)(p4 + 4096 + o); nb = *(const LAS f32x4*)(p4 + 8192 + o); nk = *(const LAS f32x4*)(p4 + 12288 + o); nr = *(const LAS f32x4*)(p4 + 16384 + o); nv = *(const LAS float*)(pv + (t + 1) * 64);
                        const int o2 = (t + 1) * 512; nf0 = *(const LAS f32x4*)(g4 + o2); nf1 = *(const LAS f32x4*)(g4 + 256 + o2);
                        nq0 = *(const LAS f32x4*)(g4 + F_HGQ + o2); nq1 = *(const LAS f32x4*)(g4 + F_HGQ + 256 + o2); niv = *(const LAS float*)(gi + (t + 1) * 64); }
                    st = st * w4 + (b4 * sa + k4 * vv);
                    s0 = (s0 - iv) * f0 + iv; s1 = (s1 - iv) * f1 + iv;
                    float y = (st[0] * r4[0] + st[1] * r4[1]) + (st[2] * r4[2] + st[3] * r4[3]);
                    float sn = (st[0] * na[0] + st[1] * na[1]) + (st[2] * na[2] + st[3] * na[3]);
                    float yh = ((s0[0] * q0[0] + s0[1] * q0[1]) + (s0[2] * q0[2] + s0[3] * q0[3])) + ((s1[0] * q1[0] + s1[1] * q1[1]) + (s1[2] * q1[2] + s1[3] * q1[3]));
                    sn = dpp_add<0xB1>(sn); y = dpp_add<0xB1>(y); yh = dpp_add<0xB1>(yh); sn = dpp_add<0x4E>(sn); y = dpp_add<0x4E>(y); yh = dpp_add<0x4E>(yh);
                    sn = dpp_add<0x141>(sn); y = dpp_add<0x141>(y); yh = dpp_add<0x141>(yh); sn = dpp_add<0x140>(sn); y = dpp_add<0x140>(y); yh = dpp_add<0x140>(yh);
                    if (j == 0) { *(LAS float*)(py + t * 64) = y; *(LAS float*)(gy + t * 64) = yh; }
                    sa = sn; a4 = na; w4 = nw; b4 = nb; k4 = nk; r4 = nr; vv = nv;
                    f0 = nf0; f1 = nf1; q0 = nq0; q1 = nq1; iv = niv;
                }
                SCAN_BAR_S();
            }
        }
        if (wave >= 4) fused_drain(lds + ((NBLK - 1) & 1) * FBUF, tid - 256, orw + (size_t)(NBLK - 1) * (FT * 16), ohg + (size_t)(NBLK - 1) * (FT * 16));
        else { __builtin_amdgcn_s_setprio(0); if (save) { *(f32x4*)stp = st; *(f32x4*)shp = s0; *(f32x4*)(shp + 64) = s1; } }
    }
}


constexpr int ST = 16;
constexpr int S_RWV = 20480, S_RWY = 22528, S_RWB = 30720;
constexpr int S_HGQ = 8192, S_HGI = 16384, S_HGY = 18432, S_HGB = 26624;
__device__ __forceinline__ void s_rw_load(LAS unsigned char* bp, int lt2, size_t ltok0, int h, int hf, const bf16_t* PA, const float* PW, const bf16_t* PB, const bf16_t* PK, const bf16_t* PR, const bf16_t* PV) {
    const int tok = lt2 >> 4, c4 = (lt2 & 15) * 4; const size_t base = (ltok0 + tok) * 1024 + h * 64 + c4;
    const f32x4 va = ld4bf(PA + base), vb = ld4bf(PB + base), vk = ld4bf(PK + base), vr = ld4bf(PR + base), vw = *(const f32x4*)(PW + base);
    const unsigned rv = *(const unsigned*)(PV + (ltok0 + tok) * 1024 + h * 64 + hf * 32 + (lt2 & 15) * 2);
    const int off = (tok * 64 + c4) * 4;
    *(LAS f32x4*)(bp + off) = va; *(LAS f32x4*)(bp + 4096 + off) = vw; *(LAS f32x4*)(bp + 8192 + off) = vb; *(LAS f32x4*)(bp + 12288 + off) = vk; *(LAS f32x4*)(bp + 16384 + off) = vr;
    *(LAS f32x2v*)(bp + S_RWV + (tok * 32 + (lt2 & 15) * 2) * 4) = (f32x2v){bflo(rv), bfhi(rv)};
}
__device__ __forceinline__ void s_hg_load(LAS unsigned char* bp, int lt2, size_t ltok0, int h8, int q4, const bf16_t* cols, const float* lbv) {
    const int tok = lt2 >> 4, c8 = (lt2 & 15) * 8; const bf16_t* crow = cols + (ltok0 + tok) * CL;
    float q[8], f[8]; ld8bf(crow + C_HQ + h8 * 128 + c8, q); ld8bf(crow + C_HF + h8 * 128 + c8, f);
    const unsigned rv = *(const unsigned*)(crow + C_HI + h8 * 128 + q4 * 32 + (lt2 & 15) * 2);
    const f32x4 lb0 = *(const f32x4*)(lbv + h8 * 128 + c8), lb1 = *(const f32x4*)(lbv + h8 * 128 + c8 + 4);
    const int off = (tok * 128 + c8) * 4;
    *(LAS f32x4*)(bp + off) = (f32x4){lb0[0] + (1.f - lb0[0]) * f[0], lb0[1] + (1.f - lb0[1]) * f[1], lb0[2] + (1.f - lb0[2]) * f[2], lb0[3] + (1.f - lb0[3]) * f[3]};
    *(LAS f32x4*)(bp + off + 16) = (f32x4){lb1[0] + (1.f - lb1[0]) * f[4], lb1[1] + (1.f - lb1[1]) * f[5], lb1[2] + (1.f - lb1[2]) * f[6], lb1[3] + (1.f - lb1[3]) * f[7]};
    *(LAS f32x4*)(bp + S_HGQ + off) = (f32x4){q[0], q[1], q[2], q[3]}; *(LAS f32x4*)(bp + S_HGQ + off + 16) = (f32x4){q[4], q[5], q[6], q[7]};
    *(LAS f32x2v*)(bp + S_HGI + (tok * 32 + (lt2 & 15) * 2) * 4) = (f32x2v){bflo(rv), bfhi(rv)};
}
__device__ __forceinline__ void s_drain(const LAS unsigned char* ybase, int lt2, float* obase  ) {
    const int t = lt2 >> 4, rp = (lt2 & 15) * 2;
    const f32x4 pa = *(const LAS f32x4*)(ybase + (t * 32 + rp) * 16), pb = *(const LAS f32x4*)(ybase + (t * 32 + rp) * 16 + 16);
    *(f32x2v*)(obase + (size_t)(rp >> 4) * (TS * 16) + t * 16 + (rp & 15)) = (f32x2v){(pa[0] + pa[1]) + (pa[2] + pa[3]), (pb[0] + pb[1]) + (pb[2] + pb[3])};
}
__device__ __forceinline__ float dot4(f32x4 a, f32x4 b) { return __builtin_fmaf(a[3], b[3], __builtin_fmaf(a[2], b[2], __builtin_fmaf(a[1], b[1], a[0] * b[0]))); }
__device__ __forceinline__ float dot4acc(f32x4 a, f32x4 b, float c) { return __builtin_fmaf(a[3], b[3], __builtin_fmaf(a[2], b[2], __builtin_fmaf(a[1], b[1], __builtin_fmaf(a[0], b[0], c)))); }
__device__ __forceinline__ void split_scan(int s, int bid, int G, int tid, int lane, int wave, LAS unsigned char* lds,
        const bf16_t* PA, const float* PW, const bf16_t* PB, const bf16_t* PK, const bf16_t* PR, const bf16_t* PV, const bf16_t* cols, const float* lbv,
        float* oraw, float* hgo, float* rwstate, float* hgstate, bool save) {
    constexpr int NBLK = TS / ST;
    const int rowl = lane >> 4, j = lane & 15, r0 = (wave & 3) * 8 + rowl, r1 = r0 + 4;
    for (int it = bid; it < 256; it += G) {
        if (it < 128) {
            const int b = it >> 5, h = (it >> 1) & 15, hf = it & 1;
            const size_t tok0 = (size_t)b * TS;
            float* sp0 = rwstate + ((size_t)((b * 16 + h) * 64 + hf * 32 + r0) * 64 + 4 * j); float* sp1 = sp0 + 4 * 64;
            float* og = oraw + (size_t)((b * 16 + h) * 4 + hf * 2) * TS * 16;
            f32x4 x0 = (f32x4){0.f, 0.f, 0.f, 0.f}, x1 = x0;
            if (wave < 4 && s > 0) { x0 = *(const f32x4*)sp0; x1 = *(const f32x4*)sp1; }
            if (wave >= 4) { s_rw_load(lds, tid - 256, tok0, h, hf, PA, PW, PB, PK, PR, PV); SCAN_BAR_L(); } else { __builtin_amdgcn_s_setprio(2); asm volatile("s_waitcnt vmcnt(0)" ::: "memory"); SCAN_BAR_S(); }
#pragma unroll 1
            for (int blk = 0; blk < NBLK; ++blk) {
                if (wave >= 4) {
                    if (blk > 0) s_drain(lds + ((blk - 1) & 1) * S_RWB + S_RWY, tid - 256, og + (size_t)(blk - 1) * (ST * 16));
                    if (blk + 1 < NBLK) s_rw_load(lds + ((blk + 1) & 1) * S_RWB, tid - 256, tok0 + (blk + 1) * ST, h, hf, PA, PW, PB, PK, PR, PV);
                    SCAN_BAR_L();
                } else {
                    const LAS unsigned char* bp = lds + (blk & 1) * S_RWB;
                    const LAS unsigned char* p4 = bp + 16 * j; const LAS unsigned char* pv = bp + S_RWV + r0 * 4; LAS unsigned char* py = (LAS unsigned char*)bp + S_RWY + (r0 * 4 + (j >> 2)) * 4;
                    f32x4 a4 = *(const LAS f32x4*)(p4), w4 = *(const LAS f32x4*)(p4 + 4096), b4 = *(const LAS f32x4*)(p4 + 8192), k4 = *(const LAS f32x4*)(p4 + 12288), r4 = *(const LAS f32x4*)(p4 + 16384);
                    float v0 = *(const LAS float*)(pv), v1 = *(const LAS float*)(pv + 16);
                    float sa0 = dot4(x0, a4), sa1 = dot4(x1, a4);
                    allreduce16x2(sa0, sa1);
#pragma unroll
                    for (int t = 0; t < ST; ++t) {
                        f32x4 na = a4, nw = w4, nb = b4, nk = k4, nr = r4; float n0 = v0, n1 = v1;
                        if (t < ST - 1) { const int o = (t + 1) * 256; na = *(const LAS f32x4*)(p4 + o); nw = *(const LAS f32x4*)(p4 + 4096 + o); nb = *(const LAS f32x4*)(p4 + 8192 + o); nk = *(const LAS f32x4*)(p4 + 12288 + o); nr = *(const LAS f32x4*)(p4 + 16384 + o);
                            n0 = *(const LAS float*)(pv + (t + 1) * 128); n1 = *(const LAS float*)(pv + (t + 1) * 128 + 16); }
                        x0 = x0 * w4 + (b4 * sa0 + k4 * v0); x1 = x1 * w4 + (b4 * sa1 + k4 * v1);
                        float y0 = dot4(x0, r4), y1 = dot4(x1, r4);
                        float s0n = dot4(x0, na), s1n = dot4(x1, na);
                        s0n = dpp_add<0xB1>(s0n); s1n = dpp_add<0xB1>(s1n); y0 = dpp_add<0xB1>(y0); y1 = dpp_add<0xB1>(y1); s0n = dpp_add<0x4E>(s0n); s1n = dpp_add<0x4E>(s1n); y0 = dpp_add<0x4E>(y0); y1 = dpp_add<0x4E>(y1);
                        s0n = dpp_add<0x141>(s0n); s1n = dpp_add<0x141>(s1n); s0n = dpp_add<0x140>(s0n); s1n = dpp_add<0x140>(s1n);
                        *(LAS float*)(py + t * 512) = y0; *(LAS float*)(py + t * 512 + 64) = y1;
                        sa0 = s0n; sa1 = s1n; a4 = na; w4 = nw; b4 = nb; k4 = nk; r4 = nr; v0 = n0; v1 = n1;
                    }
                    SCAN_BAR_S();
                }
            }
            if (wave >= 4) s_drain(lds + ((NBLK - 1) & 1) * S_RWB + S_RWY, tid - 256, og + (size_t)(NBLK - 1) * (ST * 16));
            else { __builtin_amdgcn_s_setprio(0); if (save) { *(f32x4*)sp0 = x0; *(f32x4*)sp1 = x1; } }
        } else {
            const int i2 = it - 128, b = i2 >> 5, h8 = (i2 >> 2) & 7, q4 = i2 & 3;
            const size_t tok0 = (size_t)b * TS;
            float* sp0 = hgstate + ((size_t)((b * 8 + h8) * 128 + q4 * 32 + r0) * 128 + 4 * j); float* sp1 = sp0 + 4 * 128;
            float* og = hgo + (size_t)((b * 8 + h8) * 8 + q4 * 2) * TS * 16;
            f32x4 a0 = (f32x4){0.f, 0.f, 0.f, 0.f}, a1 = a0, c0 = a0, c1 = a0;
            if (wave < 4 && s > 0) { a0 = *(const f32x4*)sp0; a1 = *(const f32x4*)(sp0 + 64); c0 = *(const f32x4*)sp1; c1 = *(const f32x4*)(sp1 + 64); }
            if (wave >= 4) { s_hg_load(lds, tid - 256, tok0, h8, q4, cols, lbv); SCAN_BAR_L(); } else { __builtin_amdgcn_s_setprio(2); asm volatile("s_waitcnt vmcnt(0)" ::: "memory"); SCAN_BAR_S(); }
#pragma unroll 1
            for (int blk = 0; blk < NBLK; ++blk) {
                if (wave >= 4) {
                    if (blk > 0) s_drain(lds + ((blk - 1) & 1) * S_HGB + S_HGY, tid - 256, og + (size_t)(blk - 1) * (ST * 16));
                    if (blk + 1 < NBLK) s_hg_load(lds + ((blk + 1) & 1) * S_HGB, tid - 256, tok0 + (blk + 1) * ST, h8, q4, cols, lbv);
                    SCAN_BAR_L();
                } else {
                    const LAS unsigned char* bp = lds + (blk & 1) * S_HGB;
                    const LAS unsigned char* g4 = bp + 16 * j; const LAS unsigned char* gi = bp + S_HGI + r0 * 4; LAS unsigned char* gy = (LAS unsigned char*)bp + S_HGY + (r0 * 4 + (j >> 2)) * 4;
                    f32x4 f0 = *(const LAS f32x4*)(g4), f1 = *(const LAS f32x4*)(g4 + 256), q0 = *(const LAS f32x4*)(g4 + S_HGQ), q1 = *(const LAS f32x4*)(g4 + S_HGQ + 256);
                    float i0 = *(const LAS float*)(gi), i1 = *(const LAS float*)(gi + 16);
#pragma unroll
                    for (int t = 0; t < ST; ++t) {
                        f32x4 nf0 = f0, nf1 = f1, nq0 = q0, nq1 = q1; float ni0 = i0, ni1 = i1;
                        if (t < ST - 1) { const int o = (t + 1) * 512; nf0 = *(const LAS f32x4*)(g4 + o); nf1 = *(const LAS f32x4*)(g4 + 256 + o); nq0 = *(const LAS f32x4*)(g4 + S_HGQ + o); nq1 = *(const LAS f32x4*)(g4 + S_HGQ + 256 + o);
                            ni0 = *(const LAS float*)(gi + (t + 1) * 128); ni1 = *(const LAS float*)(gi + (t + 1) * 128 + 16); }
                        a0 = (a0 - i0) * f0 + i0; a1 = (a1 - i0) * f1 + i0; c0 = (c0 - i1) * f0 + i1; c1 = (c1 - i1) * f1 + i1;
                        float y0 = dot4acc(a1, q1, dot4(a0, q0));
                        float y1 = dot4acc(c1, q1, dot4(c0, q0));
                        y0 = dpp_add<0xB1>(y0); y1 = dpp_add<0xB1>(y1); y0 = dpp_add<0x4E>(y0); y1 = dpp_add<0x4E>(y1);
                        *(LAS float*)(gy + t * 512) = y0; *(LAS float*)(gy + t * 512 + 64) = y1;
                        f0 = nf0; f1 = nf1; q0 = nq0; q1 = nq1; i0 = ni0; i1 = ni1;
                    }
                    SCAN_BAR_S();
                }
            }
            if (wave >= 4) s_drain(lds + ((NBLK - 1) & 1) * S_HGB + S_HGY, tid - 256, og + (size_t)(NBLK - 1) * (ST * 16));
            else { __builtin_amdgcn_s_setprio(0); if (save) { *(f32x4*)sp0 = a0; *(f32x4*)(sp0 + 64) = a1; *(f32x4*)sp1 = c0; *(f32x4*)(sp1 + 64) = c1; } }
        }
    }
}

__device__ __forceinline__ void attn_phase(int gw, int NGW, int lane, const bf16_t* Q, const bf16_t* KV, const bf16_t* Vt, bf16_t* AO) {
    const int fr = lane & 15, fq = lane >> 4;
    for (int item = gw; item < 8192; item += NGW) {
        const int bh = item >> 9, tile = item & 511, b = bh >> 2, hd = bh & 3;
        const size_t gt = (size_t)b * SEQ + tile * 16 + fr;
        bf16x8 qf[8];
#pragma unroll
        for (int ks = 0; ks < 8; ++ks) qf[ks] = *(const bf16x8*)(Q + gt * 1024 + hd * 256 + ks * 32 + fq * 8);
        f32x4 sc[16]; float mx = -3.0e38f;
#pragma unroll
        for (int kt = 0; kt < 16; ++kt) { f32x4 acc = (f32x4){0.f, 0.f, 0.f, 0.f}; const bf16_t* kp = KV + (size_t)(b * 256 + kt * 16 + fr) * 2048 + hd * 256 + fq * 8;
#pragma unroll
            for (int ks = 0; ks < 8; ++ks) acc = MFMA16(*(const bf16x8*)(kp + ks * 32), qf[ks], acc);
            sc[kt] = acc * 0.0625f; mx = fmaxf(mx, fmaxf(fmaxf(sc[kt][0], sc[kt][1]), fmaxf(sc[kt][2], sc[kt][3]))); }
        mx = fmaxf(mx, __shfl_xor(mx, 16)); mx = fmaxf(mx, __shfl_xor(mx, 32));
        float sum = 0.f;
#pragma unroll
        for (int kt = 0; kt < 16; ++kt) {
#pragma unroll
            for (int jj = 0; jj < 4; ++jj) { sc[kt][jj] = __expf(sc[kt][jj] - mx); sum += sc[kt][jj]; } }
        sum = fq_sum(sum);
        const float inv = 1.0f / sum;
        bf16x8 pf[8];
#pragma unroll
        for (int k2 = 0; k2 < 8; ++k2) { u32x4 w; w.x = cvt_pk_bf16(sc[2 * k2][0], sc[2 * k2][1]); w.y = cvt_pk_bf16(sc[2 * k2][2], sc[2 * k2][3]); w.z = cvt_pk_bf16(sc[2 * k2 + 1][0], sc[2 * k2 + 1][1]); w.w = cvt_pk_bf16(sc[2 * k2 + 1][2], sc[2 * k2 + 1][3]); pf[k2] = __builtin_bit_cast(bf16x8, w); }
#pragma unroll 2
        for (int dt = 0; dt < 16; ++dt) { f32x4 acc = (f32x4){0.f, 0.f, 0.f, 0.f}; const bf16_t* vp = Vt + (size_t)((b * 4 + hd) * 256 + dt * 16 + fr) * 256 + fq * 8;
#pragma unroll
            for (int k2 = 0; k2 < 8; ++k2) acc = MFMA16(*(const bf16x8*)(vp + k2 * 32), pf[k2], acc);
            st4bf(AO + gt * 1024 + hd * 256 + dt * 16 + 4 * fq, acc * inv); }
    }
}

__device__ __forceinline__ int tid_fresh() { int t = threadIdx.x; asm volatile("" : "+v"(t)); return t; }
#define WinT ((bf16_t*)(a.ws + WS_WIN))
#define WoutT ((bf16_t*)(a.ws + WS_WOUT))
#define WqT ((bf16_t*)(a.ws + WS_WQ))
#define WoT ((bf16_t*)(a.ws + WS_WO))
#define WkvT ((bf16_t*)(a.ws + WS_WKV))
#define W13T ((bf16_t*)(a.ws + WS_W13))
#define W2T ((bf16_t*)(a.ws + WS_W2))
#define rw2T ((bf16_t*)(a.ws + WS_RW2T))
#define ra2T ((bf16_t*)(a.ws + WS_RA2T))
#define rg2T ((bf16_t*)(a.ws + WS_RG2T))
#define g2Tp ((bf16_t*)(a.ws + WS_G2TP))
#define GATE ((bf16_t*)(a.ws + WS_GATE))
#define ASG ((bf16_t*)(a.ws + WS_ASG))
#define carry ((bf16_t*)(a.ws + WS_CARRY))
#define lbv ((float*)(a.ws + WS_LB))
#define mbf ((bf16_t*)(a.ws + WS_MBF))
#define KV ((bf16_t*)(a.ws + WS_KV))
#define Vt ((bf16_t*)(a.ws + WS_VT))
#define rwst ((float*)(a.ws + WS_RWST))
#define hgst ((float*)(a.ws + WS_HGST))
#define bonus ((float*)(a.ws + WS_BONUS))
#define merged ((bf16_t*)(a.ws + WS_MERGED))
#define u1 ((bf16_t*)(a.ws + WS_U1))
#define cols ((bf16_t*)(a.ws + WS_COLS))
#define PR ((bf16_t*)(a.ws + WS_PR))
#define PK ((bf16_t*)(a.ws + WS_PK))
#define PA ((bf16_t*)(a.ws + WS_PA))
#define PB ((bf16_t*)(a.ws + WS_PB))
#define PV ((bf16_t*)(a.ws + WS_PV))
#define PW ((float*)(a.ws + WS_PW))
#define oraw ((float*)(a.ws + WS_ORAW))
#define hgo ((float*)(a.ws + WS_HGO))
#define U ((bf16_t*)(a.ws + WS_U))
#define Qb ((bf16_t*)(a.ws + WS_Q))
#define AO ((bf16_t*)(a.ws + WS_AO))
#define FF ((bf16_t*)(a.ws + WS_FF))
#define XIN (a.in[0])
#define OUTP (a.out)
struct Args { const float* in[29]; float* out; unsigned char* ws; int ph_lo, ph_hi; };

typedef const __attribute__((address_space(4))) Args* CArgsP;
__device__ __forceinline__ CArgsP args_fresh() { CArgsP p = (CArgsP)__builtin_amdgcn_kernarg_segment_ptr(); asm volatile("" : "+s"(p)); return p; }
__global__ void __launch_bounds__(512, 2) mega(Args a0) {
    extern __shared__ __attribute__((aligned(16))) unsigned char lds_raw[];
    LAS unsigned char* lds = (LAS unsigned char*)lds_raw;
    cg::grid_group grid = cg::this_grid();
    const int G = gridDim.x, bid = blockIdx.x, NGW = G * 8, NGT = G * 512;
#define IDS const auto& a = *args_fresh(); const int tid = tid_fresh(), lane = tid & 63, wave = __builtin_amdgcn_readfirstlane(tid >> 6), gw = bid * 8 + wave, gtid = bid * 512 + tid; (void)lane; (void)gw; (void)gtid
    const int lo = a0.ph_lo, hi = a0.ph_hi;
    if (lo < 0) grid.sync();
    { volatile LAS unsigned* misc = (volatile LAS unsigned*)(lds + MISC_OFF); if (threadIdx.x < 2) misc[threadIdx.x] = 0u; __syncthreads();
      if (hi - lo > 1) (void)xcd_barrier_post((unsigned*)(a0.ws + WS_CTL), misc); }
#ifndef MK_REP
#define MK_REP -1
#endif
#ifndef MK_REPN
#define MK_REPN 3
#endif
#define RPT(code) for (int rep_ = 0, nrep_ = (MK_REP == (code)) ? MK_REPN : 1; rep_ < nrep_; ++rep_)
#define LASTREP (rep_ == nrep_ - 1)
#define IN(k) (lo <= (k) && (k) < hi)
#define SEAM(k) do { if (IN(k) && IN((k) + 1)) RPT(120) { XcdBarrier xb_; xb_.bar = (unsigned*)(args_fresh()->ws + WS_CTL); xb_.x = xb_xcc_id(); xb_.st = (volatile LAS unsigned*)(lds + MISC_OFF); xcd_barrier(xb_); } } while (0)

    if (IN(0)) RPT(100) { IDS;
        LAS float* scr = (LAS float*)(lds + wave * 16384);
        constexpr int I_IN = 16 * 297, I_SQ = 16 * 32, I_13 = 16 * 88, I_2 = 44 * 32;
        constexpr int NITEMS = I_IN + 5 * I_SQ + 2 * I_13 + I_2;
        for (int it = gw; it < NITEMS; it += NGW) {
            int r = it;
            if (r < I_IN) { const int kb = r / 297, n0 = (r % 297) * 32; tr_item(a.in[3], 1024, 9504, WinT, kb, n0, n0 + (n0 >= 3360 ? 224 : 0), scr, lane); continue; } r -= I_IN;
            if (r < I_SQ) { tr_item(a.in[17], 1024, 1024, WoutT, r / 32, (r % 32) * 32, (r % 32) * 32, scr, lane); continue; } r -= I_SQ;
            if (r < I_SQ) { tr_item(a.in[20], 1024, 1024, WqT, r / 32, (r % 32) * 32, (r % 32) * 32, scr, lane); continue; } r -= I_SQ;
            if (r < I_SQ) { tr_item(a.in[23], 1024, 1024, WoT, r / 32, (r % 32) * 32, (r % 32) * 32, scr, lane); continue; } r -= I_SQ;
            if (r < I_SQ) { tr_item(a.in[21], 1024, 1024, WkvT, r / 32, (r % 32) * 32, (r % 32) * 32, scr, lane); continue; } r -= I_SQ;
            if (r < I_SQ) { tr_item(a.in[22], 1024, 1024, WkvT, r / 32, (r % 32) * 32, 1024 + (r % 32) * 32, scr, lane); continue; } r -= I_SQ;
            if (r < I_13) { const int n0 = (r % 88) * 32; tr_item(a.in[25], 1024, DFF, W13T, r / 88, n0, (n0 / 128) * 256 + (n0 % 128), scr, lane); continue; } r -= I_13;
            if (r < I_13) { const int n0 = (r % 88) * 32; tr_item(a.in[26], 1024, DFF, W13T, r / 88, n0, (n0 / 128) * 256 + 128 + (n0 % 128), scr, lane); continue; } r -= I_13;
            tr_item(a.in[27], DFF, 1024, W2T, r / 32, (r % 32) * 32, (r % 32) * 32, scr, lane);
        }
        for (int i = gtid; i < 28672; i += NGT) ((u32x4*)(WinT + 3360 * 1024))[i] = (u32x4){0u, 0u, 0u, 0u};
        for (int i = gtid; i < 1792; i += NGT) ((u32x4*)carry)[i] = (u32x4){0u, 0u, 0u, 0u};
        for (int n = gw; n < 1024; n += NGW) { rw2T[n * 64 + lane] = (bf16_t)f2bf(a.in[6][lane * 1024 + n]); ra2T[n * 64 + lane] = (bf16_t)f2bf(a.in[8][lane * 1024 + n]); }
        for (int m = gw; m < 512; m += NGW) {
            for (int e = lane; e < 320; e += 64) { const int n = 2 * m + (e >= 160 ? 1 : 0), k = e >= 160 ? e - 160 : e; rg2T[n * 160 + k] = (bf16_t)f2bf(a.in[9][k * 1024 + n]); } }
        for (int n = gw; n < 1024; n += NGW) { f32x4 v;
#pragma unroll
            for (int e = 0; e < 4; ++e) { const int k = 4 * lane + e; v[e] = k < 160 ? a.in[9][k * 1024 + n] : 0.f; }
            st4bf(g2Tp + n * 256 + 4 * lane, v); }
        for (int i = gtid; i < 1024; i += NGT) lbv[i] = 1.0f / (1.0f + __expf(a.in[15][1024 + i] - a.in[15][i]));
        for (int m = gw; m < 1024; m += NGW) rms_row_bf16(a.in[1] + (size_t)m * 1024, a.in[19], mbf + (size_t)m * 1024, lane);
        for (int lt = gw; lt < MS; lt += NGW) { const int b = lt / TS, tl = lt % TS; const size_t gt = (size_t)b * SEQ + tl; rms_row_bf16(XIN + gt * 1024, a.in[2], u1 + (size_t)lt * 1024, lane); }
        __syncthreads();
    }
    SEAM(0);

#pragma unroll 1
    for (int s = 0; s < NSPLIT; ++s) {
        const int pb = 1 + 5 * s;
        if (IN(pb + 1)) { const auto& a = *args_fresh();
            pg8::Gemm g{u1, WinT, MS, CL, 1024}; pg8::StaticOrder S; S.init(MS, CL, G, bid);
            pg8::EpiColsAct E{cols, CL};
            RPT(102) pg8::gemm_phase<pg8::EpiColsAct, pg8::StaticOrder, true, true>(lds, g, S, E);
        }
        SEAM(pb + 1);
#ifndef SKIP_PREP
        if (IN(pb + 2)) { IDS; RPT(103) prep_phase(s, gw, NGW, lane, cols, carry, a.in[4], a.in[5], a.in[7], a.in[10], a.in[11], a.in[12], rw2T, ra2T, PR, PK, PA, PB, PV, PW, bonus, ASG); }
#endif
        SEAM(pb + 2);
        if (IN(pb + 3)) { IDS;
#ifdef MK_ZERO_SCAN
            for (int i = gtid; i < MS * 256; i += NGT) { ((f32x4*)oraw)[i] = (f32x4){0.f, 0.f, 0.f, 0.f}; ((f32x4*)hgo)[i] = (f32x4){0.01f, 0.02f, 0.03f, 0.04f}; }
#endif
#if 0
            RPT(104) { rwkv_scan(s, bid, G, tid, lane, wave, lds, PA, PW, PB, PK, PR, PV, oraw, rwst, LASTREP); __syncthreads(); }
            RPT(105) { hgrn_scan(s, bid, G, tid, lane, wave, lds, cols, lbv, hgo, hgst, LASTREP); __syncthreads(); }
#else
#ifdef MK_FUSED_SCAN
            RPT(104) { fused_scan(s, bid, G, tid, lane, wave, lds, PA, PW, PB, PK, PR, PV, cols, lbv, oraw, hgo, rwst, hgst, LASTREP); __syncthreads(); }
#else
            RPT(104) { split_scan(s, bid, G, tid, lane, wave, lds, PA, PW, PB, PK, PR, PV, cols, lbv, oraw, hgo, rwst, hgst, LASTREP); __syncthreads(); }
#endif
#endif
            if (G != 256 || bid < 128) { pg8::Gemm g{ASG, g2Tp, MS, 1024, 256}; pg8::StaticOrder S; if (G == 256) S.init(MS, 1024, 128, bid); else S.init(MS, 1024, G, bid); pg8::EpiStoreBf16 E{GATE, 1024};
              pg8::gemm_phase<pg8::EpiStoreBf16, pg8::StaticOrder, true, true>(lds, g, S, E); }
        }
        SEAM(pb + 3);
        if (IN(pb + 4)) { IDS;
#ifdef MK_NOMIX
            for (int i = gtid; i < MS * 128; i += NGT) { const int lt = i >> 7, b = lt / TS, tl = lt % TS; const size_t gt = (size_t)b * SEQ + s * TS + tl; ((u32x4*)(merged + gt * 1024))[i & 127] = (u32x4){0u, 0u, 0u, 0u}; }
#endif
#ifndef SKIP_POST
            RPT(106) post_phase(s, gw, NGW, lane, cols, carry, a.in[4], GATE, a.in[13], a.in[14], a.in[16], oraw, hgo, PV, bonus, merged);
#endif
            if (s + 1 < NSPLIT) for (int lt = gw; lt < MS; lt += NGW) { const int b = lt / TS, tl = lt % TS; const size_t gt = (size_t)b * SEQ + (s + 1) * TS + tl; rms_row_bf16(XIN + gt * 1024, a.in[2], u1 + (size_t)lt * 1024, lane); }
            if (bid < 4 && s + 1 < NSPLIT) { const u32x4* src = (const u32x4*)(cols + (size_t)(bid * TS + TS - 1) * CL); u32x4* dst = (u32x4*)(carry + (((s + 1) & 1) * 4 + bid) * CARRY_LD);
                for (int i = tid; i < CARRY_LD / 8; i += 512) dst[i] = src[i]; }
        }
        SEAM(pb + 4);
    }

    if (IN(T0 + 0)) { const auto& a = *args_fresh();
        { pg8::Gemm g{merged, WoutT, NTOK, 1024, 1024}; pg8::StaticOrder S; S.init(NTOK, 1024, G, bid); pg8::EpiResF32 E{XIN, OUTP, 1024};
          pg8::gemm_phase<pg8::EpiResF32, pg8::StaticOrder, true, true>(lds, g, S, E); }
        { pg8::Gemm g{mbf, WkvT, 1024, 2048, 1024}; pg8::StaticOrder S; S.init(1024, 2048, G, bid); pg8::EpiStoreBf16 E{KV, 2048};
          pg8::gemm_phase<pg8::EpiStoreBf16, pg8::StaticOrder, true, true>(lds, g, S, E); }
    }
    SEAM(T0 + 0);
    if (IN(T0 + 1)) { IDS;
        for (int gt = gw; gt < NTOK; gt += NGW) rms_row_bf16(OUTP + (size_t)gt * 1024, a.in[18], U + (size_t)gt * 1024, lane);
        for (int i = gtid; i < 4 * 4 * 256 * 256; i += NGT) { const int kp = i & 255, dim = (i >> 8) & 255, hd = (i >> 16) & 3, b = i >> 18;
            const int k2 = kp >> 5, fq = (kp >> 3) & 3, sl = kp & 7; const int key = 32 * k2 + (sl < 4 ? 4 * fq + sl : 16 + 4 * fq + sl - 4);
            Vt[i] = KV[(size_t)(b * 256 + key) * 2048 + 1024 + hd * 256 + dim]; }
    }
    SEAM(T0 + 1);
    if (IN(T0 + 2)) { const auto& a = *args_fresh(); pg8::Gemm g{U, WqT, NTOK, 1024, 1024}; pg8::StaticOrder S; S.init(NTOK, 1024, G, bid); pg8::EpiStoreBf16 E{Qb, 1024};
        RPT(112) pg8::gemm_phase<pg8::EpiStoreBf16, pg8::StaticOrder, true, true>(lds, g, S, E); }
    SEAM(T0 + 2);
#ifndef SKIP_ATTN
    if (IN(T0 + 3)) { IDS; RPT(113) attn_phase(gw, NGW, lane, Qb, KV, Vt, AO); }
#endif
    SEAM(T0 + 3);
#ifndef MK_NOATT
    if (IN(T0 + 4)) { const auto& a = *args_fresh(); pg8::Gemm g{AO, WoT, NTOK, 1024, 1024}; pg8::StaticOrder S; S.init(NTOK, 1024, G, bid); pg8::EpiResF32 E{OUTP, OUTP, 1024};
        pg8::gemm_phase<pg8::EpiResF32, pg8::StaticOrder, true, true>(lds, g, S, E); }
#endif
    SEAM(T0 + 4);
    if (IN(T0 + 5)) { IDS; RPT(115) for (int gt = gw; gt < NTOK; gt += NGW) rms_row_bf16(OUTP + (size_t)gt * 1024, a.in[24], U + (size_t)gt * 1024, lane); }
    SEAM(T0 + 5);
    if (IN(T0 + 6)) { const auto& a = *args_fresh(); pg8::Gemm g{U, W13T, NTOK, 2 * DFF, 1024}; pg8::StaticOrder S; S.init(NTOK, 2 * DFF, G, bid); pg8::EpiSwiGLU E{FF, DFF};
        RPT(116) pg8::gemm_phase<pg8::EpiSwiGLU, pg8::StaticOrder, true, true>(lds, g, S, E); }
    SEAM(T0 + 6);
    if (IN(T0 + 7)) { const auto& a = *args_fresh(); pg8::Gemm g{FF, W2T, NTOK, 1024, DFF}; pg8::StaticOrder S; S.init(NTOK, 1024, G, bid); pg8::EpiResF32 E{OUTP, OUTP, 1024};
        pg8::gemm_phase<pg8::EpiResF32, pg8::StaticOrder, true, true>(lds, g, S, E); }
    SEAM(T0 + 7);
    if (IN(T0 + 8)) { IDS;
        const float* gf = a.in[28];
        for (int gt = gw; gt < NTOK; gt += NGW) { f32x4* row = (f32x4*)(OUTP + (size_t)gt * 1024); f32x4 v[4]; float sq = 0.f;
#pragma unroll
            for (int j = 0; j < 4; ++j) { v[j] = row[lane + 64 * j]; sq += (v[j][0] * v[j][0] + v[j][1] * v[j][1]) + (v[j][2] * v[j][2] + v[j][3] * v[j][3]); }
            const float rs = 1.0f / sqrtf(wave_sum(sq) * (1.0f / 1024.0f) + 1e-6f);
#pragma unroll
            for (int j = 0; j < 4; ++j) row[lane + 64 * j] = v[j] * rs * ((const f32x4*)gf)[lane + 64 * j]; }
    }
#undef IN
#undef SEAM
}

#ifndef MK_MULTI
#define MK_MULTI 0
#endif
extern "C" void kernel_launch(void* const* d_in, const int* in_sizes, int n_in, void* d_out, int out_size, void* d_ws, size_t ws_size, hipStream_t stream) {
    static int grid = 0;
    if (grid == 0) {
        if (n_in != 29 || in_sizes[0] != NTOK * D || out_size != NTOK * D || ws_size < WS_END) { fprintf(stderr, "kernel_launch: unexpected shapes / workspace (%d inputs, ws %zu)\n", n_in, ws_size); grid = -1; return; }
        int dev = 0, cus = 0, per_cu = 0;
        hipGetDevice(&dev); hipDeviceGetAttribute(&cus, hipDeviceAttributeMultiprocessorCount, dev);
        hipFuncSetAttribute((const void*)mega, hipFuncAttributeMaxDynamicSharedMemorySize, LDS_BYTES);
        hipOccupancyMaxActiveBlocksPerMultiprocessor(&per_cu, (const void*)mega, 512, LDS_BYTES);
        (void)hipGetLastError();
        if (per_cu < 1) per_cu = 1;
        grid = cus;
    }
    if (grid < 0) return;
    Args a{};
    for (int i = 0; i < 29; ++i) a.in[i] = (const float*)d_in[i];
    a.out = (float*)d_out; a.ws = (unsigned char*)d_ws;
    (void)hipMemsetAsync((char*)d_ws + WS_CTL, 0, CTL_BYTES, stream);
    void* args[] = {&a};
#if MK_MULTI
    for (int ph = 0; ph < N_PHASES; ++ph) { a.ph_lo = ph; a.ph_hi = ph + 1; hipLaunchCooperativeKernel((const void*)mega, dim3(grid), dim3(512), args, LDS_BYTES, stream); }
#else
    a.ph_lo = 0; a.ph_hi = N_PHASES;
    hipError_t e = hipLaunchCooperativeKernel((const void*)mega, dim3(grid), dim3(512), args, LDS_BYTES, stream);
    if (e != hipSuccess) fprintf(stderr, "cooperative launch failed: %s (grid %d)\n", hipGetErrorString(e), grid);
#endif
}
```

```cpp
#include <hip/hip_runtime.h>
#include <hip/hip_cooperative_groups.h>
#include <cstdint>
#include <cstdio>
namespace cg = cooperative_groups;
namespace pg8 {
#define PG8_LAS __attribute__((address_space(3)))
typedef unsigned short bf16_t;
typedef short bf16x8 __attribute__((ext_vector_type(8)));
typedef float f32x4 __attribute__((ext_vector_type(4)));
typedef unsigned u32x4 __attribute__((ext_vector_type(4)));
constexpr int BM = 256, BK = 64, HALF = 128, HTB = HALF * BK * 2  , STAGE_BYTES = 8 * HTB, NXCD = 8, WGM = 8;

__host__ __device__ __forceinline__ int lds_byte(int r, int c) { const int st = (r >> 4) * 2 + (c >> 5), rr = r & 15, cc = c & 31, ob = rr * 64 + cc * 2; return st * 1024 + (ob ^ (((ob >> 9) & 1) << 5)); }
__host__ __device__ __forceinline__ void stage_rc(int b, int& R, int& C) { const int st = b / 1024, sb = b % 1024, swz = sb ^ (((sb >> 9) & 1) << 5); R = (st >> 1) * 16 + swz / 64; C = (st & 1) * 32 + (swz % 64) / 2; }
__host__ __device__ __forceinline__ int perm32(int rho) { const int n = rho >> 4, i = rho & 15; return 8 * (i >> 2) + 4 * n + (i & 3); }

struct Unit { int pm, pn; };
struct Gemm { const bf16_t* A; const bf16_t* Bt; int M, N, K; };

struct StaticOrder {
    int nM, nN, nwg, G, c;
    __host__ __device__ void init(int M, int N, int G_, int c_) { nM = M / BM; nN = N / BM; nwg = nM * nN; G = G_; c = c_; }
    __host__ __device__ bool next(int i, Unit& u) const {
        const long L = (long)i * G + c; if (L >= nwg) return false;
        int wgid = (int)L; { const int q = nwg / NXCD, r = nwg % NXCD, xcd = wgid % NXCD, off = wgid / NXCD; wgid = (xcd < r ? xcd * (q + 1) : r * (q + 1) + (xcd - r) * q) + off; }
        const int nig = WGM * nN, gid = wgid / nig, fm = gid * WGM, gsz = (nM - fm) < WGM ? (nM - fm) : WGM;
        u.pm = fm + ((wgid % nig) % gsz); u.pn = (wgid % nig) / gsz; return true;
    }
    __device__ __forceinline__ void a_ready(const Unit&) const {}
    __device__ __forceinline__ void done(const Unit&) const {}
};

__device__ __forceinline__ unsigned cvt_pk_bf16(float lo, float hi) { unsigned r; asm volatile("v_cvt_pk_bf16_f32 %0, %1, %2" : "=v"(r) : "v"(lo), "v"(hi)); return r; }
__device__ __forceinline__ float fast_sigmoid(float x) { return __builtin_amdgcn_rcpf(1.0f + __expf(-x)); }
__device__ __forceinline__ float fast_silu(float x) { return x * fast_sigmoid(x); }
struct EpiStoreBf16 {
    static constexpr bool PERM = true, AFTER_DRAIN = false;
    bf16_t* O; int ldc;
    __device__ __forceinline__ void operator()(const f32x4 (&acc)[2][2][4][2], const Unit& u, int wr, int wc, int fr, int fq) const {
        const int row0 = u.pm * BM + wr * 64 + fr, col0 = u.pn * BM + wc * 32 + 8 * fq;
#pragma unroll
        for (int ai = 0; ai < 2; ++ai)
#pragma unroll
            for (int m = 0; m < 4; ++m) { bf16_t* rowp = O + (size_t)(row0 + ai * HALF + m * 16) * ldc + col0;
#pragma unroll
                for (int bj = 0; bj < 2; ++bj) { const f32x4 v0 = acc[ai][bj][m][0], v1 = acc[ai][bj][m][1];
                    u32x4 w; w.x = cvt_pk_bf16(v0[0], v0[1]); w.y = cvt_pk_bf16(v0[2], v0[3]); w.z = cvt_pk_bf16(v1[0], v1[1]); w.w = cvt_pk_bf16(v1[2], v1[3]);
                    *(u32x4*)(rowp + bj * HALF) = w; } }
    }
};
struct EpiResF32 {
    static constexpr bool PERM = true, AFTER_DRAIN = false;
    const float* base; float* out; int ldc;
    __device__ __forceinline__ void operator()(const f32x4 (&acc)[2][2][4][2], const Unit& u, int wr, int wc, int fr, int fq) const {
        const int row0 = u.pm * BM + wr * 64 + fr, col0 = u.pn * BM + wc * 32 + 8 * fq;
#pragma unroll
        for (int ai = 0; ai < 2; ++ai)
#pragma unroll
            for (int m = 0; m < 4; ++m) { const size_t off = (size_t)(row0 + ai * HALF + m * 16) * ldc + col0;
#pragma unroll
                for (int bj = 0; bj < 2; ++bj)
#pragma unroll
                    for (int n = 0; n < 2; ++n) { const size_t p = off + bj * HALF + 4 * n; const f32x4 b = *(const f32x4*)(base + p); *(f32x4*)(out + p) = b + acc[ai][bj][m][n]; } }
    }
};
struct EpiSwiGLU {
    static constexpr bool PERM = true, AFTER_DRAIN = false;
    bf16_t* O; int ldc;
    __device__ __forceinline__ void operator()(const f32x4 (&acc)[2][2][4][2], const Unit& u, int wr, int wc, int fr, int fq) const {
        const int row0 = u.pm * BM + wr * 64 + fr, col0 = u.pn * HALF + wc * 32 + 8 * fq;
#pragma unroll
        for (int ai = 0; ai < 2; ++ai)
#pragma unroll
            for (int m = 0; m < 4; ++m) { bf16_t* rowp = O + (size_t)(row0 + ai * HALF + m * 16) * ldc + col0;
                f32x4 v0, v1;
#pragma unroll
                for (int j = 0; j < 4; ++j) { v0[j] = fast_silu(acc[ai][0][m][0][j]) * acc[ai][1][m][0][j]; v1[j] = fast_silu(acc[ai][0][m][1][j]) * acc[ai][1][m][1][j]; }
                u32x4 w; w.x = cvt_pk_bf16(v0[0], v0[1]); w.y = cvt_pk_bf16(v0[2], v0[3]); w.z = cvt_pk_bf16(v1[0], v1[1]); w.w = cvt_pk_bf16(v1[2], v1[3]);
                *(u32x4*)rowp = w; }
    }
};

struct EpiColsAct {
    static constexpr bool PERM = true, AFTER_DRAIN = false;
    bf16_t* O; int ldc;
    __device__ __forceinline__ void operator()(const f32x4 (&acc)[2][2][4][2], const Unit& u, int wr, int wc, int fr, int fq) const {
        const int row0 = u.pm * BM + wr * 64 + fr, col0 = u.pn * BM + wc * 32 + 8 * fq;
        const int pn = u.pn; const int act = (pn >= 14 && pn < 18) ? 1 : (pn >= 18 && pn < 22) ? 2 : (pn >= 26 && pn < 30) ? 1 : (pn >= 30) ? 2 : 0;
#pragma unroll
        for (int ai = 0; ai < 2; ++ai)
#pragma unroll
            for (int m = 0; m < 4; ++m) { bf16_t* rowp = O + (size_t)(row0 + ai * HALF + m * 16) * ldc + col0;
#pragma unroll
                for (int bj = 0; bj < 2; ++bj) { f32x4 v0 = acc[ai][bj][m][0], v1 = acc[ai][bj][m][1];
                    if (act == 1) {
#pragma unroll
                        for (int j = 0; j < 4; ++j) { v0[j] = fast_silu(v0[j]); v1[j] = fast_silu(v1[j]); } }
                    else if (act == 2) {
#pragma unroll
                        for (int j = 0; j < 4; ++j) { v0[j] = fast_sigmoid(v0[j]); v1[j] = fast_sigmoid(v1[j]); } }
                    u32x4 w; w.x = cvt_pk_bf16(v0[0], v0[1]); w.y = cvt_pk_bf16(v0[2], v0[3]); w.z = cvt_pk_bf16(v1[0], v1[1]); w.w = cvt_pk_bf16(v1[2], v1[3]);
                    *(u32x4*)(rowp + bj * HALF) = w; } }
    }
};
template <class Epi, class Sched, bool ALIGN_EPI = false, bool SP2 = false>
__device__ __forceinline__ void gemm_phase(PG8_LAS unsigned char* lds, const Gemm g, const Sched& S, const Epi& E) {
    int tid = threadIdx.x; asm volatile("" : "+v"(tid));
    const int wid = __builtin_amdgcn_readfirstlane(tid >> 6), lane = tid & 63, wr = wid >> 2, wc = wid & 3, fr = lane & 15, fq = lane >> 4;
    const int K = g.K, nt = K / BK;
    unsigned voffA[2], voffB[2];
#pragma unroll
    for (int i = 0; i < 2; ++i) { int R, C; stage_rc(tid * 16 + i * 8192, R, C); const int Rb = Epi::PERM ? ((R & ~31) + perm32(R & 31)) : R;
        voffA[i] = (unsigned)(R * K + C) * 2u; voffB[i] = (unsigned)(Rb * K + C) * 2u; }
    const size_t kstep = (size_t)(BK * 2);
    const size_t hstep = (size_t)HALF * K * 2;
    const size_t tstep = 2 * hstep;
    const unsigned ldsw = (unsigned)wid * 1024u;
    const int aoff = lds_byte(wr * 64 + fr, fq * 8), boff = lds_byte(wc * 32 + fr, fq * 8);
#define PG8_SA(b, h) (((b) * 2 + (h)) * HTB)
#define PG8_SB(b, h) ((4 + (b) * 2 + (h)) * HTB)
#define PG8_STAGE(bufoff, gbase, voff) do { _Pragma("unroll") for (int _i = 0; _i < 2; ++_i) \
        __builtin_amdgcn_global_load_lds((const unsigned*)((const char*)(gbase) + (voff)[_i]), (PG8_LAS unsigned*)(lds + (bufoff) + ldsw + _i * 8192), 16, 0, 0); } while (0)
#define PG8_LDA(dst, b, h) do { _Pragma("unroll") for (int m = 0; m < 4; ++m) _Pragma("unroll") for (int k = 0; k < 2; ++k) dst[m][k] = *(const PG8_LAS bf16x8*)(lds + PG8_SA(b, h) + aoff + m * 2048 + k * 1024); } while (0)
#define PG8_LDB(dst, b, h) do { _Pragma("unroll") for (int n = 0; n < 2; ++n) _Pragma("unroll") for (int k = 0; k < 2; ++k) dst[n][k] = *(const PG8_LAS bf16x8*)(lds + PG8_SB(b, h) + boff + n * 2048 + k * 1024); } while (0)
#define PG8_MMA(ai, bj, At, Bt) do { __builtin_amdgcn_s_setprio(1); _Pragma("unroll") for (int m = 0; m < 4; ++m) _Pragma("unroll") for (int n = 0; n < 2; ++n) _Pragma("unroll") for (int k = 0; k < 2; ++k) \
        acc[ai][bj][m][n] = __builtin_amdgcn_mfma_f32_16x16x32_bf16(Bt[n][k], At[m][k], acc[ai][bj][m][n], 0, 0, 0); __builtin_amdgcn_s_setprio(0); } while (0)
#define PG8_WAIT_V(n) asm volatile("s_waitcnt vmcnt(" #n ")" ::: "memory")
#define PG8_WAIT_L(n) asm volatile("s_waitcnt lgkmcnt(" #n ")" ::: "memory")
#define PG8_BAR __builtin_amdgcn_s_barrier()
#define PG8_SCHED __builtin_amdgcn_sched_barrier(0)
    Unit cur, nxt; int ui = 0;
    if (!S.next(0, cur)) return;
    f32x4 acc[2][2][4][2];
#pragma unroll
    for (int a = 0; a < 2; ++a)
#pragma unroll
        for (int b = 0; b < 2; ++b)
#pragma unroll
            for (int m = 0; m < 4; ++m)
#pragma unroll
                for (int n = 0; n < 2; ++n) acc[a][b][m][n] = (f32x4){0.f, 0.f, 0.f, 0.f};
    bf16x8 At[4][2], B0[2][2], B1[2][2];
    const char* cA = (const char*)g.A + (size_t)cur.pm * tstep; const char* cB = (const char*)g.Bt + (size_t)cur.pn * tstep;
    S.a_ready(cur);
    if constexpr (SP2) {
        PG8_STAGE(PG8_SB(0, 0), cB, voffB); PG8_STAGE(PG8_SB(0, 1), cB + hstep, voffB); PG8_STAGE(PG8_SA(0, 0), cA, voffA); PG8_STAGE(PG8_SA(0, 1), cA + hstep, voffA);
        if (wr == 1) PG8_BAR;
        PG8_WAIT_V(2); PG8_BAR;
        PG8_STAGE(PG8_SB(1, 0), cB + kstep, voffB); PG8_STAGE(PG8_SA(1, 0), cA + kstep, voffA); PG8_STAGE(PG8_SB(1, 1), cB + hstep + kstep, voffB);
        PG8_WAIT_V(6); PG8_BAR;
    } else {
        PG8_STAGE(PG8_SB(0, 0), cB, voffB); PG8_STAGE(PG8_SA(0, 0), cA, voffA); PG8_STAGE(PG8_SB(0, 1), cB + hstep, voffB); PG8_STAGE(PG8_SA(0, 1), cA + hstep, voffA);
        if (wr == 1) PG8_BAR;
        PG8_WAIT_V(4); PG8_BAR;
        PG8_STAGE(PG8_SB(1, 0), cB + kstep, voffB); PG8_STAGE(PG8_SA(1, 0), cA + kstep, voffA); PG8_STAGE(PG8_SB(1, 1), cB + hstep + kstep, voffB);
        PG8_WAIT_V(6); PG8_BAR;
    }
    for (;;) {
        const bool has_next = S.next(ui + 1, nxt);
        const char* nA = has_next ? (const char*)g.A + (size_t)nxt.pm * tstep : cA; const char* nB = has_next ? (const char*)g.Bt + (size_t)nxt.pn * tstep : cB;
        for (int t = 0; t < nt; t += 2) {
            const bool last = (t == nt - 2);
            const char* a1 = cA + (size_t)(t + 1) * kstep;
            const char* a2 = last ? nA : cA + (size_t)(t + 2) * kstep; const char* b2 = last ? nB : cB + (size_t)(t + 2) * kstep;
            const char* a3 = a2 + kstep; const char* b3 = b2 + kstep;
            if (last && has_next) S.a_ready(nxt);
            if constexpr (SP2) {
            PG8_LDB(B0, 0, 0); PG8_LDB(B1, 0, 1); PG8_SCHED; PG8_LDA(At, 0, 0); PG8_STAGE(PG8_SA(1, 1), a1 + hstep, voffA);
            PG8_WAIT_V(8); PG8_WAIT_L(0); PG8_BAR; PG8_MMA(0, 0, At, B0); PG8_MMA(0, 1, At, B1); PG8_BAR; PG8_SCHED;
            PG8_LDA(At, 0, 1); PG8_STAGE(PG8_SB(0, 0), b2, voffB); PG8_STAGE(PG8_SB(0, 1), b2 + hstep, voffB); PG8_STAGE(PG8_SA(0, 0), a2, voffA);
            PG8_WAIT_V(8); PG8_WAIT_L(0); PG8_BAR; PG8_MMA(1, 0, At, B0); PG8_MMA(1, 1, At, B1); PG8_BAR; PG8_SCHED;
            PG8_LDB(B0, 1, 0); PG8_LDB(B1, 1, 1); PG8_SCHED; PG8_LDA(At, 1, 0); PG8_STAGE(PG8_SA(0, 1), a2 + hstep, voffA);
            PG8_WAIT_V(8); PG8_WAIT_L(0); PG8_BAR; PG8_MMA(0, 0, At, B0); PG8_MMA(0, 1, At, B1); PG8_BAR; PG8_SCHED;
            PG8_LDA(At, 1, 1); PG8_STAGE(PG8_SB(1, 0), b3, voffB); PG8_STAGE(PG8_SB(1, 1), b3 + hstep, voffB); PG8_STAGE(PG8_SA(1, 0), a3, voffA);
            PG8_WAIT_V(8); PG8_WAIT_L(0); PG8_BAR; PG8_MMA(1, 0, At, B0); PG8_MMA(1, 1, At, B1); PG8_BAR; PG8_SCHED;
            } else {
            PG8_LDB(B0, 0, 0); PG8_SCHED; PG8_LDA(At, 0, 0); PG8_STAGE(PG8_SA(1, 1), a1 + hstep, voffA);
            PG8_WAIT_L(8); PG8_BAR; PG8_WAIT_L(0); PG8_MMA(0, 0, At, B0); PG8_BAR; PG8_SCHED;
            PG8_LDB(B1, 0, 1); PG8_STAGE(PG8_SB(0, 0), b2, voffB);
            PG8_BAR; PG8_WAIT_L(0); PG8_MMA(0, 1, At, B1); PG8_BAR;
            PG8_LDA(At, 0, 1); PG8_STAGE(PG8_SA(0, 0), a2, voffA);
            PG8_BAR; PG8_WAIT_L(0); PG8_MMA(1, 0, At, B0); PG8_BAR; PG8_SCHED;
            PG8_STAGE(PG8_SB(0, 1), b2 + hstep, voffB);
            PG8_WAIT_V(6); PG8_BAR; PG8_MMA(1, 1, At, B1); PG8_BAR;
            PG8_LDB(B0, 1, 0); PG8_SCHED; PG8_LDA(At, 1, 0); PG8_STAGE(PG8_SA(0, 1), a2 + hstep, voffA);
            PG8_WAIT_L(8); PG8_BAR; PG8_WAIT_L(0); PG8_MMA(0, 0, At, B0); PG8_BAR; PG8_SCHED;
            PG8_LDB(B1, 1, 1); PG8_STAGE(PG8_SB(1, 0), b3, voffB);
            PG8_BAR; PG8_WAIT_L(0); PG8_MMA(0, 1, At, B1); PG8_BAR;
            PG8_LDA(At, 1, 1); PG8_STAGE(PG8_SA(1, 0), a3, voffA);
            PG8_BAR; PG8_WAIT_L(0); PG8_MMA(1, 0, At, B0); PG8_BAR; PG8_SCHED;
            PG8_STAGE(PG8_SB(1, 1), b3 + hstep, voffB);
            PG8_WAIT_V(6); PG8_BAR; PG8_MMA(1, 1, At, B1); PG8_BAR;
            }
        }
        if constexpr (ALIGN_EPI) { if (wr == 0) PG8_BAR; }
        if constexpr (!Epi::AFTER_DRAIN) { E(acc, cur, wr, wc, fr, fq); S.done(cur); }
        if (!has_next) break;
#pragma unroll
        for (int a = 0; a < 2; ++a)
#pragma unroll
            for (int b = 0; b < 2; ++b)
#pragma unroll
                for (int m = 0; m < 4; ++m)
#pragma unroll
                    for (int n = 0; n < 2; ++n) acc[a][b][m][n] = (f32x4){0.f, 0.f, 0.f, 0.f};
        cur = nxt; cA = nA; cB = nB; ++ui;
        if constexpr (ALIGN_EPI) { if (wr == 1) PG8_BAR; }
    }
    PG8_WAIT_V(0);
    if constexpr (!ALIGN_EPI) { if (wr == 0) PG8_BAR; }
    PG8_BAR;
    if constexpr (Epi::AFTER_DRAIN) { E.fused(acc, cur, wr, wc, fr, fq, lds, wid, lane); S.done(cur); }
#undef PG8_SA
#undef PG8_SB
#undef PG8_STAGE
#undef PG8_LDA
#undef PG8_LDB
#undef PG8_MMA
#undef PG8_WAIT_V
#undef PG8_WAIT_L
#undef PG8_BAR
#undef PG8_SCHED
}
}

#define LAS __attribute__((address_space(3)))
typedef pg8::bf16_t bf16_t;
typedef pg8::bf16x8 bf16x8;
typedef pg8::f32x4 f32x4;
typedef pg8::u32x4 u32x4;
typedef unsigned u32x2 __attribute__((ext_vector_type(2)));
typedef float f32x2v __attribute__((ext_vector_type(2)));
using pg8::cvt_pk_bf16;
using pg8::fast_sigmoid;
using pg8::fast_silu;

constexpr int D = 1024, NB = 4, SEQ = 8192, NTOK = NB * SEQ;
#ifndef MK_NSPLIT
#define MK_NSPLIT 4
#endif
constexpr int NSPLIT = MK_NSPLIT, TS = SEQ / NSPLIT, MS = NB * TS;
constexpr int CL = 9728;
constexpr int C_R = 0, C_K = 1024, C_V = 2048, C_WLO = 3072, C_ALO = 3136, C_GLO = 3200, C_HQ = 3584, C_HF = 4608, C_HI = 5632, C_HG = 6656, C_GA = 7680, C_GB = 8704;
constexpr int CARRY_LD = 3584;
constexpr int DFF = 2816;
constexpr size_t MiB = 1u << 20, KiB = 1u << 10;
constexpr size_t WS_WIN = 0, WS_WOUT = 19 * MiB, WS_WQ = 21 * MiB, WS_WO = 23 * MiB, WS_WKV = 25 * MiB, WS_W13 = 29 * MiB, WS_W2 = 40 * MiB;
constexpr size_t WS_RW2T = 46 * MiB, WS_RA2T = 46 * MiB + 128 * KiB, WS_RG2T = 46 * MiB + 256 * KiB, WS_CARRY = 46 * MiB + 640 * KiB, WS_LB = 46 * MiB + 704 * KiB;
constexpr size_t WS_MBF = 47 * MiB, WS_KV = 49 * MiB, WS_VT = 53 * MiB, WS_RWST = 55 * MiB, WS_HGST = 56 * MiB, WS_BONUS = 58 * MiB;
constexpr size_t WS_KMAX = 58 * MiB + 768 * KiB;
constexpr size_t WS_G2TP = 59 * MiB;
constexpr size_t WS_MERGED = 64 * MiB;
constexpr size_t WS_U1 = 128 * MiB, WS_COLS = 144 * MiB, WS_PR = 296 * MiB, WS_PK = 312 * MiB, WS_PA = 328 * MiB, WS_PB = 344 * MiB, WS_PV = 360 * MiB, WS_PW = 376 * MiB, WS_ORAW = 408 * MiB, WS_HGO = 440 * MiB;
constexpr size_t WS_GATE = 472 * MiB, WS_ASG = 488 * MiB;
constexpr size_t WS_U = 128 * MiB, WS_Q = 192 * MiB, WS_AO = 256 * MiB, WS_FF = 320 * MiB, WS_CTL = 496 * MiB, CTL_BYTES = 64 * KiB, WS_END = 496 * MiB + 64 * KiB;
constexpr int LDS_BYTES = 147456, MISC_OFF = 131072 + 320;
constexpr int T0 = 1 + 5 * NSPLIT, N_PHASES = T0 + 9;

__device__ __forceinline__ float bflo(unsigned u) { return __uint_as_float(u << 16); }
__device__ __forceinline__ float bfhi(unsigned u) { return __uint_as_float(u & 0xffff0000u); }
__device__ __forceinline__ unsigned f2bf(float f) { unsigned u = __float_as_uint(f); return (u + 0x7fffu + ((u >> 16) & 1u)) >> 16; }
__device__ __forceinline__ f32x4 ld4bf(const bf16_t* p) { const u32x2 u = *(const u32x2*)p; return (f32x4){bflo(u.x), bfhi(u.x), bflo(u.y), bfhi(u.y)}; }
__device__ __forceinline__ f32x4 up4(u32x2 u) { return (f32x4){bflo(u.x), bfhi(u.x), bflo(u.y), bfhi(u.y)}; }
__device__ __forceinline__ void ld8bf(const bf16_t* p, float (&o)[8]) { const u32x4 u = *(const u32x4*)p; o[0] = bflo(u.x); o[1] = bfhi(u.x); o[2] = bflo(u.y); o[3] = bfhi(u.y); o[4] = bflo(u.z); o[5] = bfhi(u.z); o[6] = bflo(u.w); o[7] = bfhi(u.w); }
__device__ __forceinline__ void st4bf(bf16_t* p, f32x4 v) { u32x2 w; w.x = cvt_pk_bf16(v[0], v[1]); w.y = cvt_pk_bf16(v[2], v[3]); *(u32x2*)p = w; }
__device__ __forceinline__ bf16x8 pack8(const float (&t)[8]) { u32x4 w; w.x = cvt_pk_bf16(t[0], t[1]); w.y = cvt_pk_bf16(t[2], t[3]); w.z = cvt_pk_bf16(t[4], t[5]); w.w = cvt_pk_bf16(t[6], t[7]); return __builtin_bit_cast(bf16x8, w); }
__device__ __forceinline__ float tanh_fast(float x) { return 1.0f - 2.0f * __builtin_amdgcn_rcpf(1.0f + __expf(2.0f * x)); }
__device__ __forceinline__ float wave_sum(float v) {
#pragma unroll
    for (int o = 1; o < 64; o <<= 1) v += __shfl_xor(v, o);
    return v;
}
__device__ __forceinline__ float fq_sum(float v) { v += __shfl_xor(v, 16); v += __shfl_xor(v, 32); return v; }
template <int CTRL> __device__ __forceinline__ float dpp_add(float x) { return x + __builtin_bit_cast(float, __builtin_amdgcn_update_dpp(0, __builtin_bit_cast(int, x), CTRL, 0xf, 0xf, false)); }
#ifdef MK_SHFL_REDUCE
__device__ __forceinline__ float allreduce16(float x) { x += __shfl_xor(x, 1); x += __shfl_xor(x, 2); x += __shfl_xor(x, 4); x += __shfl_xor(x, 8); return x; }
#else
__device__ __forceinline__ float allreduce16(float x) { x = dpp_add<0xB1>(x); x = dpp_add<0x4E>(x); x = dpp_add<0x141>(x); x = dpp_add<0x140>(x); return x; }
#endif
__device__ __forceinline__ void allreduce16x2(float& x, float& y) {
    x = dpp_add<0xB1>(x); y = dpp_add<0xB1>(y); x = dpp_add<0x4E>(x); y = dpp_add<0x4E>(y); x = dpp_add<0x141>(x); y = dpp_add<0x141>(y); x = dpp_add<0x140>(x); y = dpp_add<0x140>(y); }
#define MFMA16(a, b, c) __builtin_amdgcn_mfma_f32_16x16x32_bf16((a), (b), (c), 0, 0, 0)

#define XB_TMO      128
#define XB_XCNT(j)  (256  + 64 * (j))
#define XB_XSUB(j)  (1280 + 64 * (j))
#define XB_XGEN(j)  (2304 + 64 * (j))
#define XB_TOP      3328
#define XB_TOPGEN   3392
#define XCD_BAR_WORDS 3456
#define XB_SPIN_CAP (1u << 18)

__device__ __forceinline__ unsigned xb_ld(unsigned* p)              { return __hip_atomic_load(p, __ATOMIC_RELAXED, __HIP_MEMORY_SCOPE_AGENT); }
__device__ __forceinline__ unsigned xb_add(unsigned* p, unsigned v) { return __hip_atomic_fetch_add(p, v, __ATOMIC_RELAXED, __HIP_MEMORY_SCOPE_AGENT); }
__device__ __forceinline__ unsigned xb_xcc_id() { return (unsigned)__builtin_amdgcn_s_getreg((3 << 11) | 20) & 0xFu; }
#define XB_SPIN(cond, bar) do { unsigned _sp = 0; while (cond) { __builtin_amdgcn_s_sleep(1); \
    if ((++_sp & 255u) == 0u) { if (xb_ld(&(bar)[XB_TMO])) break; if (_sp > XB_SPIN_CAP) { atomicAdd(&(bar)[XB_TMO], 1u); break; } } } } while (0)

struct XcdBarrier {
    unsigned* bar; unsigned x;
    volatile LAS unsigned* st;
};

__device__ __forceinline__ XcdBarrier xcd_barrier_post(unsigned* bar, volatile LAS unsigned* st) {
    XcdBarrier b; b.bar = bar; b.x = xb_xcc_id(); b.st = st;
    if (threadIdx.x == 0) (void)xb_add(&bar[XB_XCNT(b.x)], 1u);
    return b;
}
__device__ __forceinline__ void xcd_barrier_complete(unsigned* bar, unsigned x, unsigned& nloc, unsigned& nx) {
    const unsigned G = gridDim.x * gridDim.y * gridDim.z;
    unsigned sum, cnt, mine, sp = 0u;
    for (;;) {
        sum = 0u; cnt = 0u; mine = 0u;
#pragma unroll
        for (unsigned j = 0; j < 16; ++j) { const unsigned c = xb_ld(&bar[XB_XCNT(j)]); sum += c; cnt += (c > 0u) ? 1u : 0u; mine = (j == x) ? c : mine; }
        if (sum == G) break;
        __builtin_amdgcn_s_sleep(1);
        if ((++sp & 255u) == 0u) { if (xb_ld(&bar[XB_TMO])) break; if (sp > XB_SPIN_CAP) { atomicAdd(&bar[XB_TMO], 1u); break; } }
    }
    nloc = mine > 0u ? mine : 1u; nx = cnt > 0u ? cnt : 1u;
}

__device__ __forceinline__ void xcd_barrier(const XcdBarrier& b) {
    asm volatile("s_waitcnt vmcnt(0)" ::: "memory");
    __syncthreads();
    if (threadIdx.x == 0) {
        unsigned* bar = b.bar;
        __builtin_amdgcn_s_waitcnt(0);
        unsigned nloc = b.st[0], nx = b.st[1];
        if (nloc == 0u) { xcd_barrier_complete(bar, b.x, nloc, nx); b.st[0] = nloc; b.st[1] = nx; }
        const unsigned old = xb_add(&bar[XB_XSUB(b.x)], 1u);
        const unsigned gen = old / nloc;
        if (old + 1u == (gen + 1u) * nloc) {
            __builtin_amdgcn_fence(__ATOMIC_RELEASE, "agent");
            asm volatile("s_waitcnt vmcnt(0)" ::: "memory");
            const unsigned og = xb_add(&bar[XB_TOP], 1u);
            const unsigned tg = og / nx;
            if (og + 1u == (tg + 1u) * nx) xb_add(&bar[XB_TOPGEN], 1u);
            else XB_SPIN(xb_ld(&bar[XB_TOPGEN]) == tg, bar);
            __builtin_amdgcn_fence(__ATOMIC_ACQUIRE, "agent");
            xb_add(&bar[XB_XGEN(b.x)], 1u);
            asm volatile("s_waitcnt vmcnt(0)" ::: "memory");
        } else {
            XB_SPIN(xb_ld(&bar[XB_XGEN(b.x)]) == gen, bar);
            __builtin_amdgcn_fence(__ATOMIC_ACQUIRE, "agent");
            asm volatile("s_waitcnt vmcnt(0)" ::: "memory");
        }
    }
    __syncthreads();
}

__device__ __forceinline__ void rms_row_bf16(const float* src, const float* g, bf16_t* dst, int lane) {
    f32x4 v[4]; float s = 0.f;
#pragma unroll
    for (int j = 0; j < 4; ++j) { v[j] = ((const f32x4*)src)[lane + 64 * j]; s += (v[j][0] * v[j][0] + v[j][1] * v[j][1]) + (v[j][2] * v[j][2] + v[j][3] * v[j][3]); }
    const float rs = 1.0f / sqrtf(wave_sum(s) * (1.0f / 1024.0f) + 1e-6f);
#pragma unroll
    for (int j = 0; j < 4; ++j) { const f32x4 gv = ((const f32x4*)g)[lane + 64 * j]; st4bf(dst + 4 * (lane + 64 * j), v[j] * rs * gv); }
}
__device__ __forceinline__ void tr_item(const float* W, int K, int N, bf16_t* WT, int kb, int n0, int row_base, LAS float* scr, int lane) {
    const int k0 = 64 * kb;
#pragma unroll 8
    for (int i = 0; i < 32; ++i) { const int kk = 2 * i + (lane >> 5); scr[kk * 33 + (lane & 31)] = W[(size_t)(k0 + kk) * N + n0 + (lane & 31)]; }
    asm volatile("s_waitcnt lgkmcnt(0)" ::: "memory");
    const int c = lane & 7;
#pragma unroll
    for (int j = 0; j < 4; ++j) { const int n = (lane >> 3) + 8 * j; const LAS float* sp = scr + (8 * c) * 33 + n;
        u32x4 o; o.x = cvt_pk_bf16(sp[0 * 33], sp[1 * 33]); o.y = cvt_pk_bf16(sp[2 * 33], sp[3 * 33]); o.z = cvt_pk_bf16(sp[4 * 33], sp[5 * 33]); o.w = cvt_pk_bf16(sp[6 * 33], sp[7 * 33]);
        *(u32x4*)(WT + (size_t)(row_base + n) * K + k0 + 8 * c) = o; }
    asm volatile("s_waitcnt lgkmcnt(0)" ::: "memory");
}

__device__ __forceinline__ void prep_phase(int s, int gw, int NGW, int lane, const bf16_t* cols, const bf16_t* carry,
        const float* mu, const float* w0, const float* a0, const float* k_k, const float* k_a, const float* r_k,
        const bf16_t* w2T, const bf16_t* a2T, bf16_t* PR, bf16_t* PK, bf16_t* PA, bf16_t* PB, bf16_t* PV, float* PW, float* bonus, bf16_t* ASG) {
    const int fr = lane & 15, fq = lane >> 4;
    for (int item = gw; item < (MS / 16) * 4; item += NGW) {
        const int tile = item >> 2, hg4 = item & 3;
        const int lt = tile * 16 + fr, b = lt / TS, tl = lt % TS;
        const bf16_t* crow = cols + (size_t)lt * CL;
        const bf16_t* prow = tl > 0 ? crow - CL : carry + ((s & 1) * 4 + b) * CARRY_LD;
        bf16x8 Aw[2], Aa[2];
#pragma unroll
        for (int ks = 0; ks < 2; ++ks) {
            { const int c = C_WLO + ks * 32 + fq * 8; float cur[8], prv[8], t[8]; ld8bf(crow + c, cur); ld8bf(prow + c, prv);
              const f32x4 m0 = *(const f32x4*)(mu + c), m1 = *(const f32x4*)(mu + c + 4);
#pragma unroll
              for (int e = 0; e < 8; ++e) { const float mm = e < 4 ? m0[e & 3] : m1[e & 3]; t[e] = tanh_fast(cur[e] + mm * (prv[e] - cur[e])); }
              Aw[ks] = pack8(t); }
            { const int c = C_ALO + ks * 32 + fq * 8; float cur[8], prv[8], t[8]; ld8bf(crow + c, cur); ld8bf(prow + c, prv);
              const f32x4 m0 = *(const f32x4*)(mu + c), m1 = *(const f32x4*)(mu + c + 4);
#pragma unroll
              for (int e = 0; e < 8; ++e) { const float mm = e < 4 ? m0[e & 3] : m1[e & 3]; t[e] = cur[e] + mm * (prv[e] - cur[e]); }
              Aa[ks] = pack8(t); }
        }
        if (hg4 == 0) {
#pragma unroll
            for (int ks = 0; ks < 5; ++ks) { const int c = C_GLO + ks * 32 + fq * 8; float cur[8], prv[8], t[8]; ld8bf(crow + c, cur); ld8bf(prow + c, prv);
                const f32x4 m0 = *(const f32x4*)(mu + c), m1 = *(const f32x4*)(mu + c + 4);
#pragma unroll
                for (int e = 0; e < 8; ++e) { const float mm = e < 4 ? m0[e & 3] : m1[e & 3]; t[e] = fast_sigmoid(cur[e] + mm * (prv[e] - cur[e])); }
                *(bf16x8*)(ASG + (size_t)lt * 256 + ks * 32 + fq * 8) = pack8(t); }
#pragma unroll
            for (int ks = 5; ks < 8; ++ks) *(u32x4*)(ASG + (size_t)lt * 256 + ks * 32 + fq * 8) = (u32x4){0u, 0u, 0u, 0u};
        }
#pragma unroll 1
        for (int hh = 0; hh < 4; ++hh) {
            const int h = hg4 * 4 + hh;
            f32x4 aw[4], aa[4];
#pragma unroll
            for (int nt = 0; nt < 4; ++nt) { aw[nt] = (f32x4){0.f, 0.f, 0.f, 0.f}; aa[nt] = (f32x4){0.f, 0.f, 0.f, 0.f};
                const int n = h * 64 + nt * 16 + fr;
#pragma unroll
                for (int ks = 0; ks < 2; ++ks) { const bf16x8 bw = *(const bf16x8*)(w2T + n * 64 + ks * 32 + fq * 8); aw[nt] = MFMA16(bw, Aw[ks], aw[nt]);
                    const bf16x8 ba = *(const bf16x8*)(a2T + n * 64 + ks * 32 + fq * 8); aa[nt] = MFMA16(ba, Aa[ks], aa[nt]); } }
            f32x4 kkv[4], av[4]; float ssq = 0.f, bon = 0.f;
#pragma unroll
            for (int nt = 0; nt < 4; ++nt) {
                const int c = h * 64 + nt * 16 + 4 * fq; const size_t o = (size_t)lt * 1024 + c;
                const f32x4 rc = ld4bf(crow + C_R + c), rp = ld4bf(prow + C_R + c), kc = ld4bf(crow + C_K + c), kp = ld4bf(prow + C_K + c), vc = ld4bf(crow + C_V + c), vp = ld4bf(prow + C_V + c);
                const f32x4 r = rc + *(const f32x4*)(mu + C_R + c) * (rp - rc), k = kc + *(const f32x4*)(mu + C_K + c) * (kp - kc), v = vc + *(const f32x4*)(mu + C_V + c) * (vp - vc);
                const f32x4 w0v = *(const f32x4*)(w0 + c), a0v = *(const f32x4*)(a0 + c), kkp = *(const f32x4*)(k_k + c), kap = *(const f32x4*)(k_a + c), rkp = *(const f32x4*)(r_k + c);
                f32x4 wv, a, kk, kmod;
#pragma unroll
                for (int j = 0; j < 4; ++j) {
                    const float z = -(w0v[j] + aw[nt][j]);
                    const float sp = fmaxf(z, 0.f) + __logf(1.0f + __expf(-fabsf(z)));
                    wv[j] = __expf(-__expf(-sp - 0.5f));
                    a[j] = fast_sigmoid(a0v[j] + aa[nt][j]);
                    kk[j] = k[j] * kkp[j]; kmod[j] = k[j] * (1.0f + (a[j] - 1.0f) * kap[j]);
                    ssq += kk[j] * kk[j]; bon += r[j] * kmod[j] * rkp[j];
                }
                kkv[nt] = kk; av[nt] = a;
                st4bf(PR + o, r); st4bf(PK + o, kmod); st4bf(PV + o, v); *(f32x4*)(PW + o) = wv;
            }
            ssq = fq_sum(ssq); bon = fq_sum(bon);
            const float rs = 1.0f / sqrtf(fmaxf(ssq, 1e-24f));
#pragma unroll
            for (int nt = 0; nt < 4; ++nt) { const int c = h * 64 + nt * 16 + 4 * fq; const size_t o = (size_t)lt * 1024 + c;
                const f32x4 kn = kkv[nt] * rs; st4bf(PA + o, -kn); st4bf(PB + o, kn * av[nt]); }
            if (fq == 0) bonus[lt * 16 + h] = bon;
        }
    }
}

__device__ __forceinline__ void post_phase(int s, int gw, int NGW, int lane, const bf16_t* cols, const bf16_t* carry, const float* mu, const bf16_t* gate,
        const float* ln_w, const float* ln_b, const float* hg_g, const float* oraw, const float* hgo, const bf16_t* PV, const float* bonus, bf16_t* merged) {
    const int fr = lane & 15, fq = lane >> 4;
    for (int item = gw; item < (MS / 16) * 4; item += NGW) {
        const int tile = item >> 2, q4 = item & 3;
        const int lt = tile * 16 + fr, b = lt / TS, tl = lt % TS;
        const size_t gt = (size_t)b * SEQ + s * TS + tl;
        const bf16_t* crow = cols + (size_t)lt * CL;
        const bf16_t* prow = tl > 0 ? crow - CL : carry + ((s & 1) * 4 + b) * CARRY_LD;
#pragma unroll 1
        for (int hgh = 0; hgh < 2; ++hgh) {
            const int h8 = q4 * 2 + hgh;
            f32x4 ho[8]; float ss = 0.f;
#pragma unroll
            for (int n8 = 0; n8 < 8; ++n8) { ho[n8] = *(const f32x4*)(hgo + ((size_t)((b * 8 + h8) * 8 + n8) * TS + tl) * 16 + 4 * fq); ss += (ho[n8][0] * ho[n8][0] + ho[n8][1] * ho[n8][1]) + (ho[n8][2] * ho[n8][2] + ho[n8][3] * ho[n8][3]); }
            ss = fq_sum(ss);
            const float rsh = 1.0f / sqrtf(ss * (1.0f / 128.0f) + 1e-6f);
#pragma unroll
            for (int rwh = 0; rwh < 2; ++rwh) {
                const int h = q4 * 4 + hgh * 2 + rwh;
                f32x4 ag[4], o[4]; float sm = 0.f;
#pragma unroll
                for (int nt = 0; nt < 4; ++nt) { ag[nt] = ld4bf(gate + (size_t)lt * 1024 + h * 64 + nt * 16 + 4 * fq);
                    o[nt] = *(const f32x4*)(oraw + ((size_t)((b * 16 + h) * 4 + nt) * TS + tl) * 16 + 4 * fq); sm += (o[nt][0] + o[nt][1]) + (o[nt][2] + o[nt][3]); }
                const float mean = fq_sum(sm) * (1.0f / 64.0f); float vq = 0.f;
#pragma unroll
                for (int nt = 0; nt < 4; ++nt) { o[nt] = o[nt] - mean; vq += (o[nt][0] * o[nt][0] + o[nt][1] * o[nt][1]) + (o[nt][2] * o[nt][2] + o[nt][3] * o[nt][3]); }
                const float rstd = 1.0f / sqrtf(fq_sum(vq) * (1.0f / 64.0f) + 64e-5f);
#ifdef MK_NO_BONUS
                const float bon = 0.f;
#else
                const float bon = bonus[lt * 16 + h];
#endif
#pragma unroll
                for (int nt = 0; nt < 4; ++nt) {
                    const int c = h * 64 + nt * 16 + 4 * fq;
                    const f32x4 lw = *(const f32x4*)(ln_w + c), lb = *(const f32x4*)(ln_b + c), v = ld4bf(PV + (size_t)lt * 1024 + c);
                    const f32x4 ya = (o[nt] * rstd * lw + lb + v * bon) * ag[nt];
                    const f32x4 ng = *(const f32x4*)(hg_g + (c & 127)), gh = ld4bf(crow + C_HG + c), gar = ld4bf(crow + C_GA + c), gbr = ld4bf(crow + C_GB + c);
                    const f32x4 hv = ho[rwh * 4 + nt] * rsh * ng;
                    f32x4 m;
#pragma unroll
                    for (int j = 0; j < 4; ++j) {
#if defined(MK_ZERO_YA)
                        m[j] = fast_sigmoid(gbr[j]) * (hv[j] * fast_silu(gh[j]));
#elif defined(MK_ZERO_YB)
                        m[j] = fast_sigmoid(gar[j]) * ya[j];
#else
                        m[j] = gar[j] * ya[j] + gbr[j] * (hv[j] * gh[j]);
#endif
                    }
                    st4bf(merged + gt * 1024 + c, m);
                }
            }
        }
    }
}

constexpr int RWB = 45056;
#define SCAN_BAR_L() do { asm volatile("s_waitcnt vmcnt(0) lgkmcnt(0)" ::: "memory"); __builtin_amdgcn_s_barrier(); asm volatile("" ::: "memory"); } while (0)
#define SCAN_BAR_S() do { asm volatile("s_waitcnt lgkmcnt(0)" ::: "memory"); __builtin_amdgcn_s_barrier(); asm volatile("" ::: "memory"); } while (0)
__device__ __forceinline__ void rw_load(LAS unsigned char* bp, int lt2, size_t ltok0, int h, int rg, const bf16_t* PA, const float* PW, const bf16_t* PB, const bf16_t* PK, const bf16_t* PR, const bf16_t* PV) {
    const int tok = lt2 >> 3, c8 = (lt2 & 7) * 8; const size_t base = (ltok0 + tok) * 1024 + h * 64 + c8;
    const u32x4 ra = *(const u32x4*)(PA + base), rb = *(const u32x4*)(PB + base), rk = *(const u32x4*)(PK + base), rr = *(const u32x4*)(PR + base);
    const f32x4 w0 = *(const f32x4*)(PW + base), w1 = *(const f32x4*)(PW + base + 4);
    const unsigned rv = *(const unsigned*)(PV + (ltok0 + tok) * 1024 + h * 64 + rg * 16 + (lt2 & 7) * 2);
    const int off = (tok * 64 + c8) * 4;
#define RW_PUT(arr, u) do { *(LAS f32x4*)(bp + (arr) * 8192 + off) = (f32x4){bflo(u.x), bfhi(u.x), bflo(u.y), bfhi(u.y)}; *(LAS f32x4*)(bp + (arr) * 8192 + off + 16) = (f32x4){bflo(u.z), bfhi(u.z), bflo(u.w), bfhi(u.w)}; } while (0)
    RW_PUT(0, ra); RW_PUT(2, rb); RW_PUT(3, rk); RW_PUT(4, rr);
#undef RW_PUT
    *(LAS f32x4*)(bp + 8192 + off) = w0; *(LAS f32x4*)(bp + 8192 + off + 16) = w1;
    *(LAS f32x2v*)(bp + 40960 + (tok * 16 + (lt2 & 7) * 2) * 4) = (f32x2v){bflo(rv), bfhi(rv)};
}
__device__ __forceinline__ void y_drain(const LAS unsigned char* ybase, int lt2, float* dst) { *(f32x2v*)(dst + lt2 * 2) = *(const LAS f32x2v*)(ybase + lt2 * 8); }
__device__ __forceinline__ void rwkv_scan(int s, int bid, int G, int tid, int lane, int wave, LAS unsigned char* lds,
        const bf16_t* PA, const float* PW, const bf16_t* PB, const bf16_t* PK, const bf16_t* PR, const bf16_t* PV, float* oraw, float* state, bool save) {
    constexpr int NBLK = TS / 32;
    const int rowl = lane >> 4, j = lane & 15, row = (wave & 3) * 4 + rowl;
    for (int it = bid; it < 256; it += G) {
        const int b = it >> 6, h = (it >> 2) & 15, rg = it & 3;
        const size_t tok0 = (size_t)b * TS;
        float* stp = state + ((size_t)((b * 16 + h) * 64 + rg * 16 + row) * 64 + 4 * j);
        float* obase = oraw + (size_t)it * TS * 16;
        f32x4 st = (f32x4){0.f, 0.f, 0.f, 0.f};
        if (wave < 4 && s > 0) st = *(const f32x4*)stp;
        if (wave >= 4) { rw_load(lds, tid - 256, tok0, h, rg, PA, PW, PB, PK, PR, PV); SCAN_BAR_L(); } else { __builtin_amdgcn_s_setprio(2); asm volatile("s_waitcnt vmcnt(0)" ::: "memory"); SCAN_BAR_S(); }
#pragma unroll 1
        for (int blk = 0; blk < NBLK; ++blk) {
            if (wave >= 4) {
                if (blk > 0) y_drain(lds + ((blk - 1) & 1) * RWB + 43008, tid - 256, obase + (size_t)(blk - 1) * 512);
                if (blk + 1 < NBLK) rw_load(lds + ((blk + 1) & 1) * RWB, tid - 256, tok0 + (blk + 1) * 32, h, rg, PA, PW, PB, PK, PR, PV);
                SCAN_BAR_L();
            } else {
                const LAS unsigned char* bp = lds + (blk & 1) * RWB;
                const LAS unsigned char* p4 = bp + 16 * j; const LAS unsigned char* pv = bp + 40960 + row * 4; LAS unsigned char* py = (LAS unsigned char*)bp + 43008 + row * 4;
                f32x4 a4 = *(const LAS f32x4*)(p4), w4 = *(const LAS f32x4*)(p4 + 8192), b4 = *(const LAS f32x4*)(p4 + 16384), k4 = *(const LAS f32x4*)(p4 + 24576), r4 = *(const LAS f32x4*)(p4 + 32768);
                float vv = *(const LAS float*)(pv);
                float sa = (st[0] * a4[0] + st[1] * a4[1]) + (st[2] * a4[2] + st[3] * a4[3]);
                sa = allreduce16(sa);
#pragma unroll
                for (int t = 0; t < 32; ++t) {
                    f32x4 na = a4, nw = w4, nb = b4, nk = k4, nr = r4; float nv = vv;
                    if (t < 31) { const int o = (t + 1) * 256; na = *(const LAS f32x4*)(p4 + o); nw = *(const LAS f32x4*)(p4 + 8192 + o); nb = *(const LAS f32x4*)(p4 + 16384 + o); nk = *(const LAS f32x4*)(p4 + 24576 + o); nr = *(const LAS f32x4*)(p4 + 32768 + o); nv = *(const LAS float*)(pv + (t + 1) * 64); }
                    st = st * w4 + (b4 * sa + k4 * vv);
                    float y = (st[0] * r4[0] + st[1] * r4[1]) + (st[2] * r4[2] + st[3] * r4[3]);
                    float sn = (st[0] * na[0] + st[1] * na[1]) + (st[2] * na[2] + st[3] * na[3]);
                    allreduce16x2(sn, y);
                    if (j == 0) *(LAS float*)(py + t * 64) = y;
                    sa = sn; a4 = na; w4 = nw; b4 = nb; k4 = nk; r4 = nr; vv = nv;
                }
                SCAN_BAR_S();
            }
        }
        if (wave >= 4) { y_drain(lds + ((NBLK - 1) & 1) * RWB + 43008, tid - 256, obase + (size_t)(NBLK - 1) * 512); }
        else { __builtin_amdgcn_s_setprio(0); if (save) *(f32x4*)stp = st; }
    }
}

__device__ __forceinline__ void rwkv_scan_naive(int s, int gw, int NGW, int lane, int wave, LAS unsigned char* lds,
        const bf16_t* PA, const float* PW, const bf16_t* PB, const bf16_t* PK, const bf16_t* PR, const bf16_t* PV, float* oraw, float* state) {
    LAS float* slab = (LAS float*)(lds + wave * 2048);
    for (int it = gw; it < 64; it += NGW) {
        const int b = it >> 4, h = it & 15;
        float st[64];
        float* stp = state + (size_t)((b * 16 + h) * 64 + lane) * 64;
#pragma unroll
        for (int k = 0; k < 64; ++k) st[k] = (s > 0) ? stp[k] : 0.f;
        for (int tl = 0; tl < TS; ++tl) {
            const size_t base = ((size_t)b * TS + tl) * 1024 + h * 64 + lane;
            slab[lane] = bflo((unsigned)PA[base]); slab[64 + lane] = PW[base]; slab[128 + lane] = bflo((unsigned)PB[base]); slab[192 + lane] = bflo((unsigned)PK[base]); slab[256 + lane] = bflo((unsigned)PR[base]);
            const float vv = bflo((unsigned)PV[base]);
            asm volatile("s_waitcnt lgkmcnt(0)" ::: "memory");
            float sa = 0.f;
#pragma unroll
            for (int k = 0; k < 64; ++k) sa += st[k] * slab[k];
            float y = 0.f;
#pragma unroll
            for (int k = 0; k < 64; ++k) { st[k] = st[k] * slab[64 + k] + (sa * slab[128 + k] + vv * slab[192 + k]); y += st[k] * slab[256 + k]; }
            asm volatile("s_waitcnt lgkmcnt(0)" ::: "memory");
            oraw[((size_t)(it * 4 + (lane >> 4)) * TS + tl) * 16 + (lane & 15)] = y;
        }
#pragma unroll
        for (int k = 0; k < 64; ++k) stp[k] = st[k];
    }
}
constexpr int HGB = 53248;
__device__ __forceinline__ void hg_load(LAS unsigned char* bp, int lt2, size_t ltok0, int h8, int rg, const bf16_t* cols, const float* lbv) {
    const int tok = lt2 >> 3, c16 = (lt2 & 7) * 16; const bf16_t* crow = cols + (ltok0 + tok) * CL;
    float q[16], f[16];
    { float t[8]; ld8bf(crow + C_HQ + h8 * 128 + c16, t);
#pragma unroll
      for (int e = 0; e < 8; ++e) q[e] = t[e];
      ld8bf(crow + C_HQ + h8 * 128 + c16 + 8, t);
#pragma unroll
      for (int e = 0; e < 8; ++e) q[8 + e] = t[e];
      ld8bf(crow + C_HF + h8 * 128 + c16, t);
#pragma unroll
      for (int e = 0; e < 8; ++e) f[e] = t[e];
      ld8bf(crow + C_HF + h8 * 128 + c16 + 8, t);
#pragma unroll
      for (int e = 0; e < 8; ++e) f[8 + e] = t[e]; }
    const unsigned rv = *(const unsigned*)(crow + C_HI + h8 * 128 + rg * 16 + (lt2 & 7) * 2);
    const int off = (tok * 128 + c16) * 4;
#pragma unroll
    for (int g = 0; g < 4; ++g) { const f32x4 lb = *(const f32x4*)(lbv + h8 * 128 + c16 + 4 * g); f32x4 fv, kv, qv;
#pragma unroll
        for (int e = 0; e < 4; ++e) { fv[e] = lb[e] + (1.0f - lb[e]) * fast_sigmoid(f[4 * g + e]); kv[e] = 1.0f - fv[e]; qv[e] = fast_silu(q[4 * g + e]); }
        *(LAS f32x4*)(bp + off + 16 * g) = fv; *(LAS f32x4*)(bp + 16384 + off + 16 * g) = kv; *(LAS f32x4*)(bp + 32768 + off + 16 * g) = qv; }
    *(LAS f32x2v*)(bp + 49152 + (tok * 16 + (lt2 & 7) * 2) * 4) = (f32x2v){bflo(rv), bfhi(rv)};
}
__device__ __forceinline__ void hgrn_scan(int s, int bid, int G, int tid, int lane, int wave, LAS unsigned char* lds, const bf16_t* cols, const float* lbv, float* hgo, float* state, bool save) {
    constexpr int NBLK = TS / 32;
    const int rowl = lane >> 4, j = lane & 15, row = (wave & 3) * 4 + rowl;
    for (int it = bid; it < 256; it += G) {
        const int b = it >> 6, h8 = (it >> 3) & 7, rg = it & 7;
        const size_t tok0 = (size_t)b * TS;
        float* stp = state + ((size_t)((b * 8 + h8) * 128 + rg * 16 + row) * 128 + 4 * j);
        float* obase = hgo + (size_t)it * TS * 16;
        f32x4 s0 = (f32x4){0.f, 0.f, 0.f, 0.f}, s1 = s0;
        if (wave < 4 && s > 0) { s0 = *(const f32x4*)stp; s1 = *(const f32x4*)(stp + 64); }
        if (wave >= 4) { hg_load(lds, tid - 256, tok0, h8, rg, cols, lbv); SCAN_BAR_L(); } else { __builtin_amdgcn_s_setprio(2); asm volatile("s_waitcnt vmcnt(0)" ::: "memory"); SCAN_BAR_S(); }
#pragma unroll 1
        for (int blk = 0; blk < NBLK; ++blk) {
            if (wave >= 4) {
                if (blk > 0) y_drain(lds + ((blk - 1) & 1) * HGB + 51200, tid - 256, obase + (size_t)(blk - 1) * 512);
                if (blk + 1 < NBLK) hg_load(lds + ((blk + 1) & 1) * HGB, tid - 256, tok0 + (blk + 1) * 32, h8, rg, cols, lbv);
                SCAN_BAR_L();
            } else {
                const LAS unsigned char* bp = lds + (blk & 1) * HGB;
                const LAS unsigned char* p4 = bp + 16 * j; const LAS unsigned char* pv = bp + 49152 + row * 4; LAS unsigned char* py = (LAS unsigned char*)bp + 51200 + row * 4;
                f32x4 f0 = *(const LAS f32x4*)(p4), f1 = *(const LAS f32x4*)(p4 + 256), k0 = *(const LAS f32x4*)(p4 + 16384), k1 = *(const LAS f32x4*)(p4 + 16384 + 256), q0 = *(const LAS f32x4*)(p4 + 32768), q1 = *(const LAS f32x4*)(p4 + 32768 + 256);
                float iv = *(const LAS float*)(pv); float yprev = 0.f;
#pragma unroll
                for (int t = 0; t < 32; ++t) {
                    f32x4 nf0 = f0, nf1 = f1, nk0 = k0, nk1 = k1, nq0 = q0, nq1 = q1; float niv = iv;
                    if (t < 31) { const int o = (t + 1) * 512; nf0 = *(const LAS f32x4*)(p4 + o); nf1 = *(const LAS f32x4*)(p4 + 256 + o); nk0 = *(const LAS f32x4*)(p4 + 16384 + o); nk1 = *(const LAS f32x4*)(p4 + 16384 + 256 + o);
                                  nq0 = *(const LAS f32x4*)(p4 + 32768 + o); nq1 = *(const LAS f32x4*)(p4 + 32768 + 256 + o); niv = *(const LAS float*)(pv + (t + 1) * 64); }
                    s0 = s0 * f0 + k0 * iv; s1 = s1 * f1 + k1 * iv;
                    float y = ((s0[0] * q0[0] + s0[1] * q0[1]) + (s0[2] * q0[2] + s0[3] * q0[3])) + ((s1[0] * q1[0] + s1[1] * q1[1]) + (s1[2] * q1[2] + s1[3] * q1[3]));
                    if (t & 1) { allreduce16x2(yprev, y); if (j == 0) { *(LAS float*)(py + (t - 1) * 64) = yprev; *(LAS float*)(py + t * 64) = y; } }
                    yprev = y;
                    f0 = nf0; f1 = nf1; k0 = nk0; k1 = nk1; q0 = nq0; q1 = nq1; iv = niv;
                }
                SCAN_BAR_S();
            }
        }
        if (wave >= 4) { y_drain(lds + ((NBLK - 1) & 1) * HGB + 51200, tid - 256, obase + (size_t)(NBLK - 1) * 512); }
        else { __builtin_amdgcn_s_setprio(0); if (save) { *(f32x4*)stp = s0; *(f32x4*)(stp + 64) = s1; } }
    }
}


constexpr int FT = 16;
constexpr int F_RW = 0, F_RWV = 20480, F_RWY = 21504, F_HG = 22528, F_HGQ = 8192, F_HGI = F_HG + 16384, F_HGY = F_HG + 17408, FBUF = 40960;
__device__ __forceinline__ void fused_load(LAS unsigned char* bp, int lt2, size_t ltok0, int h, int rg, int h8, int rg8, const bf16_t* PA, const float* PW, const bf16_t* PB, const bf16_t* PK, const bf16_t* PR, const bf16_t* PV,
        const bf16_t* cols, const float* lbv) {
    if (lt2 < 128) {
        const int tok = lt2 >> 3, c8 = (lt2 & 7) * 8; const size_t base = (ltok0 + tok) * 1024 + h * 64 + c8;
        const u32x4 ra = *(const u32x4*)(PA + base), rb = *(const u32x4*)(PB + base), rk = *(const u32x4*)(PK + base), rr = *(const u32x4*)(PR + base);
        const f32x4 w0 = *(const f32x4*)(PW + base), w1 = *(const f32x4*)(PW + base + 4);
        const unsigned rv = *(const unsigned*)(PV + (ltok0 + tok) * 1024 + h * 64 + rg * 16 + (lt2 & 7) * 2);
        const int off = (tok * 64 + c8) * 4;
#define RW_PUT(arr, u) do { *(LAS f32x4*)(bp + (arr) * 4096 + off) = (f32x4){bflo(u.x), bfhi(u.x), bflo(u.y), bfhi(u.y)}; *(LAS f32x4*)(bp + (arr) * 4096 + off + 16) = (f32x4){bflo(u.z), bfhi(u.z), bflo(u.w), bfhi(u.w)}; } while (0)
        RW_PUT(0, ra); RW_PUT(2, rb); RW_PUT(3, rk); RW_PUT(4, rr);
#undef RW_PUT
        *(LAS f32x4*)(bp + 4096 + off) = w0; *(LAS f32x4*)(bp + 4096 + off + 16) = w1;
        *(LAS f32x2v*)(bp + F_RWV + (tok * 16 + (lt2 & 7) * 2) * 4) = (f32x2v){bflo(rv), bfhi(rv)};
    } else {
        const int l = lt2 - 128, tok = l >> 3, c16 = (l & 7) * 16; const bf16_t* crow = cols + (ltok0 + tok) * CL;
        float q[16], f[16];
        { float t[8]; ld8bf(crow + C_HQ + h8 * 128 + c16, t);
#pragma unroll
          for (int e = 0; e < 8; ++e) q[e] = t[e];
          ld8bf(crow + C_HQ + h8 * 128 + c16 + 8, t);
#pragma unroll
          for (int e = 0; e < 8; ++e) q[8 + e] = t[e];
          ld8bf(crow + C_HF + h8 * 128 + c16, t);
#pragma unroll
          for (int e = 0; e < 8; ++e) f[e] = t[e];
          ld8bf(crow + C_HF + h8 * 128 + c16 + 8, t);
#pragma unroll
          for (int e = 0; e < 8; ++e) f[8 + e] = t[e]; }
        const unsigned rv = *(const unsigned*)(crow + C_HI + h8 * 128 + rg8 * 16 + (l & 7) * 2);
        LAS unsigned char* hp = bp + F_HG; const int off = (tok * 128 + c16) * 4;
#pragma unroll
        for (int g = 0; g < 4; ++g) { const f32x4 lb = *(const f32x4*)(lbv + h8 * 128 + c16 + 4 * g); f32x4 fv, qv;
#pragma unroll
            for (int e = 0; e < 4; ++e) { fv[e] = lb[e] + (1.0f - lb[e]) * f[4 * g + e]; qv[e] = q[4 * g + e]; }
            *(LAS f32x4*)(hp + off + 16 * g) = fv; *(LAS f32x4*)(hp + F_HGQ + off + 16 * g) = qv; }
        *(LAS f32x2v*)(bp + F_HGI + (tok * 16 + (l & 7) * 2) * 4) = (f32x2v){bflo(rv), bfhi(rv)};
    }
}
__device__ __forceinline__ void fused_drain(const LAS unsigned char* bp, int lt2, float* orw, float* ohg) {
    if (lt2 < 128) *(f32x2v*)(orw + lt2 * 2) = *(const LAS f32x2v*)(bp + F_RWY + lt2 * 8);
    else *(f32x2v*)(ohg + (lt2 - 128) * 2) = *(const LAS f32x2v*)(bp + F_HGY + (lt2 - 128) * 8);
}
__device__ __forceinline__ void fused_scan(int s, int bid, int G, int tid, int lane, int wave, LAS unsigned char* lds,
        const bf16_t* PA, const float* PW, const bf16_t* PB, const bf16_t* PK, const bf16_t* PR, const bf16_t* PV, const bf16_t* cols, const float* lbv,
        float* oraw, float* hgo, float* rwstate, float* hgstate, bool save) {
    constexpr int NBLK = TS / FT;
    const int rowl = lane >> 4, j = lane & 15, row = (wave & 3) * 4 + rowl;
    for (int it = bid; it < 256; it += G) {
        const int b = it >> 6, h = (it >> 2) & 15, rg = it & 3, h8 = (it >> 3) & 7, rg8 = it & 7;
        const size_t tok0 = (size_t)b * TS;
        float* stp = rwstate + ((size_t)((b * 16 + h) * 64 + rg * 16 + row) * 64 + 4 * j);
        float* shp = hgstate + ((size_t)((b * 8 + h8) * 128 + rg8 * 16 + row) * 128 + 4 * j);
        float* orw = oraw + (size_t)it * TS * 16; float* ohg = hgo + (size_t)it * TS * 16;
        f32x4 st = (f32x4){0.f, 0.f, 0.f, 0.f}, s0 = st, s1 = st;
        if (wave < 4 && s > 0) { st = *(const f32x4*)stp; s0 = *(const f32x4*)shp; s1 = *(const f32x4*)(shp + 64); }
        if (wave >= 4) { fused_load(lds, tid - 256, tok0, h, rg, h8, rg8, PA, PW, PB, PK, PR, PV, cols, lbv); SCAN_BAR_L(); } else { __builtin_amdgcn_s_setprio(2); asm volatile("s_waitcnt vmcnt(0)" ::: "memory"); SCAN_BAR_S(); }
#pragma unroll 1
        for (int blk = 0; blk < NBLK; ++blk) {
            if (wave >= 4) {
                if (blk > 0) fused_drain(lds + ((blk - 1) & 1) * FBUF, tid - 256, orw + (size_t)(blk - 1) * (FT * 16), ohg + (size_t)(blk - 1) * (FT * 16));
                if (blk + 1 < NBLK) fused_load(lds + ((blk + 1) & 1) * FBUF, tid - 256, tok0 + (blk + 1) * FT, h, rg, h8, rg8, PA, PW, PB, PK, PR, PV, cols, lbv);
                SCAN_BAR_L();
            } else {
                const LAS unsigned char* bp = lds + (blk & 1) * FBUF;
                const LAS unsigned char* p4 = bp + 16 * j; const LAS unsigned char* pv = bp + F_RWV + row * 4; LAS unsigned char* py = (LAS unsigned char*)bp + F_RWY + row * 4;
                const LAS unsigned char* g4 = bp + F_HG + 16 * j; const LAS unsigned char* gi = bp + F_HGI + row * 4; LAS unsigned char* gy = (LAS unsigned char*)bp + F_HGY + row * 4;
                f32x4 a4 = *(const LAS f32x4*)(p4), w4 = *(const LAS f32x4*)(p4 + 4096), b4 = *(const LAS f32x4*)(p4 + 8192), k4 = *(const LAS f32x4*)(p4 + 12288), r4 = *(const LAS f32x4*)(p4 + 16384);
                float vv = *(const LAS float*)(pv);
                f32x4 f0 = *(const LAS f32x4*)(g4), f1 = *(const LAS f32x4*)(g4 + 256), q0 = *(const LAS f32x4*)(g4 + F_HGQ), q1 = *(const LAS f32x4*)(g4 + F_HGQ + 256);
                float iv = *(const LAS float*)(gi);
                float sa = (st[0] * a4[0] + st[1] * a4[1]) + (st[2] * a4[2] + st[3] * a4[3]);
                sa = allreduce16(sa);
#pragma unroll
                for (int t = 0; t < FT; ++t) {
                    f32x4 na = a4, nw = w4, nb = b4, nk = k4, nr = r4; float nv = vv;
                    f32x4 nf0 = f0, nf1 = f1, nq0 = q0, nq1 = q1; float niv = iv;
                    if (t < FT - 1) { const int o = (t + 1) * 256; na = *(const LAS f32x4*)(p4 + o); nw = *(const LAS f32x4*)(p4 + 4096 + o); nb = *(const LAS f32x4*)(p4 + 8192 + o); nk = *(const LAS f32x4*)(p4 + 12288 + o); nr = *(const LAS f32x4*)(p4 + 16384 + o); nv = *(const LAS float*)(pv + (t + 1) * 64);
                        const int o2 = (t + 1) * 512; nf0 = *(const LAS f32x4*)(g4 + o2); nf1 = *(const LAS f32x4*)(g4 + 256 + o2);
                        nq0 = *(const LAS f32x4*)(g4 + F_HGQ + o2); nq1 = *(const LAS f32x4*)(g4 + F_HGQ + 256 + o2); niv = *(const LAS float*)(gi + (t + 1) * 64); }
                    st = st * w4 + (b4 * sa + k4 * vv);
                    s0 = (s0 - iv) * f0 + iv; s1 = (s1 - iv) * f1 + iv;
                    float y = (st[0] * r4[0] + st[1] * r4[1]) + (st[2] * r4[2] + st[3] * r4[3]);
                    float sn = (st[0] * na[0] + st[1] * na[1]) + (st[2] * na[2] + st[3] * na[3]);
                    float yh = ((s0[0] * q0[0] + s0[1] * q0[1]) + (s0[2] * q0[2] + s0[3] * q0[3])) + ((s1[0] * q1[0] + s1[1] * q1[1]) + (s1[2] * q1[2] + s1[3] * q1[3]));
                    sn = dpp_add<0xB1>(sn); y = dpp_add<0xB1>(y); yh = dpp_add<0xB1>(yh); sn = dpp_add<0x4E>(sn); y = dpp_add<0x4E>(y); yh = dpp_add<0x4E>(yh);
                    sn = dpp_add<0x141>(sn); y = dpp_add<0x141>(y); yh = dpp_add<0x141>(yh); sn = dpp_add<0x140>(sn); y = dpp_add<0x140>(y); yh = dpp_add<0x140>(yh);
                    if (j == 0) { *(LAS float*)(py + t * 64) = y; *(LAS float*)(gy + t * 64) = yh; }
                    sa = sn; a4 = na; w4 = nw; b4 = nb; k4 = nk; r4 = nr; vv = nv;
                    f0 = nf0; f1 = nf1; q0 = nq0; q1 = nq1; iv = niv;
                }
                SCAN_BAR_S();
            }
        }
        if (wave >= 4) fused_drain(lds + ((NBLK - 1) & 1) * FBUF, tid - 256, orw + (size_t)(NBLK - 1) * (FT * 16), ohg + (size_t)(NBLK - 1) * (FT * 16));
        else { __builtin_amdgcn_s_setprio(0); if (save) { *(f32x4*)stp = st; *(f32x4*)shp = s0; *(f32x4*)(shp + 64) = s1; } }
    }
}


constexpr int ST = 16;
constexpr int S_RWV = 20480, S_RWY = 22528, S_RWB = 30720;
constexpr int S_HGQ = 8192, S_HGI = 16384, S_HGY = 18432, S_HGB = 26624;
__device__ __forceinline__ void s_rw_load(LAS unsigned char* bp, int lt2, size_t ltok0, int h, int hf, const bf16_t* PA, const float* PW, const bf16_t* PB, const bf16_t* PK, const bf16_t* PR, const bf16_t* PV) {
    const int tok = lt2 >> 4, c4 = (lt2 & 15) * 4; const size_t base = (ltok0 + tok) * 1024 + h * 64 + c4;
    const f32x4 va = ld4bf(PA + base), vb = ld4bf(PB + base), vk = ld4bf(PK + base), vr = ld4bf(PR + base), vw = *(const f32x4*)(PW + base);
    const unsigned rv = *(const unsigned*)(PV + (ltok0 + tok) * 1024 + h * 64 + hf * 32 + (lt2 & 15) * 2);
    const int off = (tok * 64 + c4) * 4;
    *(LAS f32x4*)(bp + off) = va; *(LAS f32x4*)(bp + 4096 + off) = vw; *(LAS f32x4*)(bp + 8192 + off) = vb; *(LAS f32x4*)(bp + 12288 + off) = vk; *(LAS f32x4*)(bp + 16384 + off) = vr;
    *(LAS f32x2v*)(bp + S_RWV + (tok * 32 + (lt2 & 15) * 2) * 4) = (f32x2v){bflo(rv), bfhi(rv)};
}
__device__ __forceinline__ void s_hg_load(LAS unsigned char* bp, int lt2, size_t ltok0, int h8, int q4, const bf16_t* cols, const float* lbv) {
    const int tok = lt2 >> 4, c8 = (lt2 & 15) * 8; const bf16_t* crow = cols + (ltok0 + tok) * CL;
    float q[8], f[8]; ld8bf(crow + C_HQ + h8 * 128 + c8, q); ld8bf(crow + C_HF + h8 * 128 + c8, f);
    const unsigned rv = *(const unsigned*)(crow + C_HI + h8 * 128 + q4 * 32 + (lt2 & 15) * 2);
    const f32x4 lb0 = *(const f32x4*)(lbv + h8 * 128 + c8), lb1 = *(const f32x4*)(lbv + h8 * 128 + c8 + 4);
    const int off = (tok * 128 + c8) * 4;
    *(LAS f32x4*)(bp + off) = (f32x4){lb0[0] + (1.f - lb0[0]) * f[0], lb0[1] + (1.f - lb0[1]) * f[1], lb0[2] + (1.f - lb0[2]) * f[2], lb0[3] + (1.f - lb0[3]) * f[3]};
    *(LAS f32x4*)(bp + off + 16) = (f32x4){lb1[0] + (1.f - lb1[0]) * f[4], lb1[1] + (1.f - lb1[1]) * f[5], lb1[2] + (1.f - lb1[2]) * f[6], lb1[3] + (1.f - lb1[3]) * f[7]};
    *(LAS f32x4*)(bp + S_HGQ + off) = (f32x4){q[0], q[1], q[2], q[3]}; *(LAS f32x4*)(bp + S_HGQ + off + 16) = (f32x4){q[4], q[5], q[6], q[7]};
    *(LAS f32x2v*)(bp + S_HGI + (tok * 32 + (lt2 & 15) * 2) * 4) = (f32x2v){bflo(rv), bfhi(rv)};
}
__device__ __forceinline__ void s_drain(const LAS unsigned char* ybase, int lt2, float* obase  ) {
    const int t = lt2 >> 4, rp = (lt2 & 15) * 2;
    const f32x4 pa = *(const LAS f32x4*)(ybase + (t * 32 + rp) * 16), pb = *(const LAS f32x4*)(ybase + (t * 32 + rp) * 16 + 16);
    *(f32x2v*)(obase + (size_t)(rp >> 4) * (TS * 16) + t * 16 + (rp & 15)) = (f32x2v){(pa[0] + pa[1]) + (pa[2] + pa[3]), (pb[0] + pb[1]) + (pb[2] + pb[3])};
}
__device__ __forceinline__ float dot4(f32x4 a, f32x4 b) { return __builtin_fmaf(a[3], b[3], __builtin_fmaf(a[2], b[2], __builtin_fmaf(a[1], b[1], a[0] * b[0]))); }
__device__ __forceinline__ float dot4acc(f32x4 a, f32x4 b, float c) { return __builtin_fmaf(a[3], b[3], __builtin_fmaf(a[2], b[2], __builtin_fmaf(a[1], b[1], __builtin_fmaf(a[0], b[0], c)))); }
__device__ __forceinline__ void split_scan(int s, int bid, int G, int tid, int lane, int wave, LAS unsigned char* lds,
        const bf16_t* PA, const float* PW, const bf16_t* PB, const bf16_t* PK, const bf16_t* PR, const bf16_t* PV, const bf16_t* cols, const float* lbv,
        float* oraw, float* hgo, float* rwstate, float* hgstate, bool save) {
    constexpr int NBLK = TS / ST;
    const int rowl = lane >> 4, j = lane & 15, r0 = (wave & 3) * 8 + rowl, r1 = r0 + 4;
    for (int it = bid; it < 256; it += G) {
        if (it < 128) {
            const int b = it >> 5, h = (it >> 1) & 15, hf = it & 1;
            const size_t tok0 = (size_t)b * TS;
            float* sp0 = rwstate + ((size_t)((b * 16 + h) * 64 + hf * 32 + r0) * 64 + 4 * j); float* sp1 = sp0 + 4 * 64;
            float* og = oraw + (size_t)((b * 16 + h) * 4 + hf * 2) * TS * 16;
            f32x4 x0 = (f32x4){0.f, 0.f, 0.f, 0.f}, x1 = x0;
            if (wave < 4 && s > 0) { x0 = *(const f32x4*)sp0; x1 = *(const f32x4*)sp1; }
            if (wave >= 4) { s_rw_load(lds, tid - 256, tok0, h, hf, PA, PW, PB, PK, PR, PV); SCAN_BAR_L(); } else { __builtin_amdgcn_s_setprio(2); asm volatile("s_waitcnt vmcnt(0)" ::: "memory"); SCAN_BAR_S(); }
#pragma unroll 1
            for (int blk = 0; blk < NBLK; ++blk) {
                if (wave >= 4) {
                    if (blk > 0) s_drain(lds + ((blk - 1) & 1) * S_RWB + S_RWY, tid - 256, og + (size_t)(blk - 1) * (ST * 16));
                    if (blk + 1 < NBLK) s_rw_load(lds + ((blk + 1) & 1) * S_RWB, tid - 256, tok0 + (blk + 1) * ST, h, hf, PA, PW, PB, PK, PR, PV);
                    SCAN_BAR_L();
                } else {
                    const LAS unsigned char* bp = lds + (blk & 1) * S_RWB;
                    const LAS unsigned char* p4 = bp + 16 * j; const LAS unsigned char* pv = bp + S_RWV + r0 * 4; LAS unsigned char* py = (LAS unsigned char*)bp + S_RWY + (r0 * 4 + (j >> 2)) * 4;
                    f32x4 a4 = *(const LAS f32x4*)(p4), w4 = *(const LAS f32x4*)(p4 + 4096), b4 = *(const LAS f32x4*)(p4 + 8192), k4 = *(const LAS f32x4*)(p4 + 12288), r4 = *(const LAS f32x4*)(p4 + 16384);
                    float v0 = *(const LAS float*)(pv), v1 = *(const LAS float*)(pv + 16);
                    float sa0 = dot4(x0, a4), sa1 = dot4(x1, a4);
                    allreduce16x2(sa0, sa1);
#pragma unroll
                    for (int t = 0; t < ST; ++t) {
                        f32x4 na = a4, nw = w4, nb = b4, nk = k4, nr = r4; float n0 = v0, n1 = v1;
                        if (t < ST - 1) { const int o = (t + 1) * 256; na = *(const LAS f32x4*)(p4 + o); nw = *(const LAS f32x4*)(p4 + 4096 + o); nb = *(const LAS f32x4*)(p4 + 8192 + o); nk = *(const LAS f32x4*)(p4 + 12288 + o); nr = *(const LAS f32x4*)(p4 + 16384 + o);
                            n0 = *(const LAS float*)(pv + (t + 1) * 128); n1 = *(const LAS float*)(pv + (t + 1) * 128 + 16); }
                        x0 = x0 * w4 + (b4 * sa0 + k4 * v0); x1 = x1 * w4 + (b4 * sa1 + k4 * v1);
                        float y0 = dot4(x0, r4), y1 = dot4(x1, r4);
                        float s0n = dot4(x0, na), s1n = dot4(x1, na);
                        s0n = dpp_add<0xB1>(s0n); s1n = dpp_add<0xB1>(s1n); y0 = dpp_add<0xB1>(y0); y1 = dpp_add<0xB1>(y1); s0n = dpp_add<0x4E>(s0n); s1n = dpp_add<0x4E>(s1n); y0 = dpp_add<0x4E>(y0); y1 = dpp_add<0x4E>(y1);
                        s0n = dpp_add<0x141>(s0n); s1n = dpp_add<0x141>(s1n); s0n = dpp_add<0x140>(s0n); s1n = dpp_add<0x140>(s1n);
                        *(LAS float*)(py + t * 512) = y0; *(LAS float*)(py + t * 512 + 64) = y1;
                        sa0 = s0n; sa1 = s1n; a4 = na; w4 = nw; b4 = nb; k4 = nk; r4 = nr; v0 = n0; v1 = n1;
                    }
                    SCAN_BAR_S();
                }
            }
            if (wave >= 4) s_drain(lds + ((NBLK - 1) & 1) * S_RWB + S_RWY, tid - 256, og + (size_t)(NBLK - 1) * (ST * 16));
            else { __builtin_amdgcn_s_setprio(0); if (save) { *(f32x4*)sp0 = x0; *(f32x4*)sp1 = x1; } }
        } else {
            const int i2 = it - 128, b = i2 >> 5, h8 = (i2 >> 2) & 7, q4 = i2 & 3;
            const size_t tok0 = (size_t)b * TS;
            float* sp0 = hgstate + ((size_t)((b * 8 + h8) * 128 + q4 * 32 + r0) * 128 + 4 * j); float* sp1 = sp0 + 4 * 128;
            float* og = hgo + (size_t)((b * 8 + h8) * 8 + q4 * 2) * TS * 16;
            f32x4 a0 = (f32x4){0.f, 0.f, 0.f, 0.f}, a1 = a0, c0 = a0, c1 = a0;
            if (wave < 4 && s > 0) { a0 = *(const f32x4*)sp0; a1 = *(const f32x4*)(sp0 + 64); c0 = *(const f32x4*)sp1; c1 = *(const f32x4*)(sp1 + 64); }
            if (wave >= 4) { s_hg_load(lds, tid - 256, tok0, h8, q4, cols, lbv); SCAN_BAR_L(); } else { __builtin_amdgcn_s_setprio(2); asm volatile("s_waitcnt vmcnt(0)" ::: "memory"); SCAN_BAR_S(); }
#pragma unroll 1
            for (int blk = 0; blk < NBLK; ++blk) {
                if (wave >= 4) {
                    if (blk > 0) s_drain(lds + ((blk - 1) & 1) * S_HGB + S_HGY, tid - 256, og + (size_t)(blk - 1) * (ST * 16));
                    if (blk + 1 < NBLK) s_hg_load(lds + ((blk + 1) & 1) * S_HGB, tid - 256, tok0 + (blk + 1) * ST, h8, q4, cols, lbv);
                    SCAN_BAR_L();
                } else {
                    const LAS unsigned char* bp = lds + (blk & 1) * S_HGB;
                    const LAS unsigned char* g4 = bp + 16 * j; const LAS unsigned char* gi = bp + S_HGI + r0 * 4; LAS unsigned char* gy = (LAS unsigned char*)bp + S_HGY + (r0 * 4 + (j >> 2)) * 4;
                    f32x4 f0 = *(const LAS f32x4*)(g4), f1 = *(const LAS f32x4*)(g4 + 256), q0 = *(const LAS f32x4*)(g4 + S_HGQ), q1 = *(const LAS f32x4*)(g4 + S_HGQ + 256);
                    float i0 = *(const LAS float*)(gi), i1 = *(const LAS float*)(gi + 16);
#pragma unroll
                    for (int t = 0; t < ST; ++t) {
                        f32x4 nf0 = f0, nf1 = f1, nq0 = q0, nq1 = q1; float ni0 = i0, ni1 = i1;
                        if (t < ST - 1) { const int o = (t + 1) * 512; nf0 = *(const LAS f32x4*)(g4 + o); nf1 = *(const LAS f32x4*)(g4 + 256 + o); nq0 = *(const LAS f32x4*)(g4 + S_HGQ + o); nq1 = *(const LAS f32x4*)(g4 + S_HGQ + 256 + o);
                            ni0 = *(const LAS float*)(gi + (t + 1) * 128); ni1 = *(const LAS float*)(gi + (t + 1) * 128 + 16); }
                        a0 = (a0 - i0) * f0 + i0; a1 = (a1 - i0) * f1 + i0; c0 = (c0 - i1) * f0 + i1; c1 = (c1 - i1) * f1 + i1;
                        float y0 = dot4acc(a1, q1, dot4(a0, q0));
                        float y1 = dot4acc(c1, q1, dot4(c0, q0));
                        y0 = dpp_add<0xB1>(y0); y1 = dpp_add<0xB1>(y1); y0 = dpp_add<0x4E>(y0); y1 = dpp_add<0x4E>(y1);
                        *(LAS float*)(gy + t * 512) = y0; *(LAS float*)(gy + t * 512 + 64) = y1;
                        f0 = nf0; f1 = nf1; q0 = nq0; q1 = nq1; i0 = ni0; i1 = ni1;
                    }
                    SCAN_BAR_S();
                }
            }
            if (wave >= 4) s_drain(lds + ((NBLK - 1) & 1) * S_HGB + S_HGY, tid - 256, og + (size_t)(NBLK - 1) * (ST * 16));
            else { __builtin_amdgcn_s_setprio(0); if (save) { *(f32x4*)sp0 = a0; *(f32x4*)(sp0 + 64) = a1; *(f32x4*)sp1 = c0; *(f32x4*)(sp1 + 64) = c1; } }
        }
    }
}

__device__ __forceinline__ void attn_phase(int gw, int NGW, int lane, const bf16_t* Q, const bf16_t* KV, const bf16_t* Vt, bf16_t* AO, const float* kmax2) {
    const int fr = lane & 15, fq = lane >> 4;
    for (int item = gw; item < 4096; item += NGW) {
        const int bh = item >> 8, tile = item & 255, b = bh >> 2, hd = bh & 3;
        const size_t g0 = (size_t)b * SEQ + tile * 32 + fr, g1 = g0 + 16;
        const float kmx = sqrtf(fmaxf(fmaxf(kmax2[(bh * 4 + 0) * 32], kmax2[(bh * 4 + 1) * 32]), fmaxf(kmax2[(bh * 4 + 2) * 32], kmax2[(bh * 4 + 3) * 32])));
        bf16x8 qa[8], qb[8]; float na = 0.f, nb = 0.f;
#pragma unroll
        for (int ks = 0; ks < 8; ++ks) { const u32x4 ua = *(const u32x4*)(Q + g0 * 1024 + hd * 256 + ks * 32 + fq * 8), ub = *(const u32x4*)(Q + g1 * 1024 + hd * 256 + ks * 32 + fq * 8);
            qa[ks] = __builtin_bit_cast(bf16x8, ua); qb[ks] = __builtin_bit_cast(bf16x8, ub);
#pragma unroll
            for (int e = 0; e < 4; ++e) { const float a0 = bflo(ua[e]), a1 = bfhi(ua[e]), b0 = bflo(ub[e]), b1 = bfhi(ub[e]); na += a0 * a0 + a1 * a1; nb += b0 * b0 + b1 * b1; } }
        na = fq_sum(na); nb = fq_sum(nb);
        const float ma = sqrtf(na) * kmx * 0.0625f * 1.001f, mb = sqrtf(nb) * kmx * 0.0625f * 1.001f;
        float za = 0.f, zb = 0.f;
        bf16x8 pa[8], pb[8];
#pragma unroll
        for (int k2 = 0; k2 < 8; ++k2) {
            f32x4 e0 = (f32x4){0.f, 0.f, 0.f, 0.f}, e1 = e0, f0 = e0, f1 = e0;
            const bf16_t* kp0 = KV + (size_t)(b * 256 + (2 * k2) * 16 + fr) * 2048 + hd * 256 + fq * 8; const bf16_t* kp1 = kp0 + (size_t)16 * 2048;
#pragma unroll
            for (int ks = 0; ks < 8; ++ks) { const bf16x8 k0 = *(const bf16x8*)(kp0 + ks * 32), k1 = *(const bf16x8*)(kp1 + ks * 32);
                e0 = MFMA16(k0, qa[ks], e0); f0 = MFMA16(k0, qb[ks], f0); e1 = MFMA16(k1, qa[ks], e1); f1 = MFMA16(k1, qb[ks], f1); }
#pragma unroll
            for (int jj = 0; jj < 4; ++jj) { e0[jj] = __expf(e0[jj] * 0.0625f - ma); e1[jj] = __expf(e1[jj] * 0.0625f - ma); f0[jj] = __expf(f0[jj] * 0.0625f - mb); f1[jj] = __expf(f1[jj] * 0.0625f - mb);
                za += e0[jj] + e1[jj]; zb += f0[jj] + f1[jj]; }
            u32x4 w; w.x = cvt_pk_bf16(e0[0], e0[1]); w.y = cvt_pk_bf16(e0[2], e0[3]); w.z = cvt_pk_bf16(e1[0], e1[1]); w.w = cvt_pk_bf16(e1[2], e1[3]); pa[k2] = __builtin_bit_cast(bf16x8, w);
            u32x4 x; x.x = cvt_pk_bf16(f0[0], f0[1]); x.y = cvt_pk_bf16(f0[2], f0[3]); x.z = cvt_pk_bf16(f1[0], f1[1]); x.w = cvt_pk_bf16(f1[2], f1[3]); pb[k2] = __builtin_bit_cast(bf16x8, x); }
        za = fq_sum(za); zb = fq_sum(zb);
        const float ia = 1.0f / za, ib = 1.0f / zb;
#pragma unroll 2
        for (int dt = 0; dt < 16; ++dt) { f32x4 a0 = (f32x4){0.f, 0.f, 0.f, 0.f}, a1 = a0; const bf16_t* vp = Vt + (size_t)((b * 4 + hd) * 256 + dt * 16 + fr) * 256 + fq * 8;
#pragma unroll
            for (int k2 = 0; k2 < 8; ++k2) { const bf16x8 vf = *(const bf16x8*)(vp + k2 * 32); a0 = MFMA16(vf, pa[k2], a0); a1 = MFMA16(vf, pb[k2], a1); }
            st4bf(AO + g0 * 1024 + hd * 256 + dt * 16 + 4 * fq, a0 * ia); st4bf(AO + g1 * 1024 + hd * 256 + dt * 16 + 4 * fq, a1 * ib); }
    }
}

__device__ __forceinline__ int tid_fresh() { int t = threadIdx.x; asm volatile("" : "+v"(t)); return t; }
#define WinT ((bf16_t*)(a.ws + WS_WIN))
#define WoutT ((bf16_t*)(a.ws + WS_WOUT))
#define WqT ((bf16_t*)(a.ws + WS_WQ))
#define WoT ((bf16_t*)(a.ws + WS_WO))
#define WkvT ((bf16_t*)(a.ws + WS_WKV))
#define W13T ((bf16_t*)(a.ws + WS_W13))
#define W2T ((bf16_t*)(a.ws + WS_W2))
#define rw2T ((bf16_t*)(a.ws + WS_RW2T))
#define ra2T ((bf16_t*)(a.ws + WS_RA2T))
#define rg2T ((bf16_t*)(a.ws + WS_RG2T))
#define g2Tp ((bf16_t*)(a.ws + WS_G2TP))
#define KMAX2 ((float*)(a.ws + WS_KMAX))
#define GATE ((bf16_t*)(a.ws + WS_GATE))
#define ASG ((bf16_t*)(a.ws + WS_ASG))
#define carry ((bf16_t*)(a.ws + WS_CARRY))
#define lbv ((float*)(a.ws + WS_LB))
#define mbf ((bf16_t*)(a.ws + WS_MBF))
#define KV ((bf16_t*)(a.ws + WS_KV))
#define Vt ((bf16_t*)(a.ws + WS_VT))
#define rwst ((float*)(a.ws + WS_RWST))
#define hgst ((float*)(a.ws + WS_HGST))
#define bonus ((float*)(a.ws + WS_BONUS))
#define merged ((bf16_t*)(a.ws + WS_MERGED))
#define u1 ((bf16_t*)(a.ws + WS_U1))
#define cols ((bf16_t*)(a.ws + WS_COLS))
#define PR ((bf16_t*)(a.ws + WS_PR))
#define PK ((bf16_t*)(a.ws + WS_PK))
#define PA ((bf16_t*)(a.ws + WS_PA))
#define PB ((bf16_t*)(a.ws + WS_PB))
#define PV ((bf16_t*)(a.ws + WS_PV))
#define PW ((float*)(a.ws + WS_PW))
#define oraw ((float*)(a.ws + WS_ORAW))
#define hgo ((float*)(a.ws + WS_HGO))
#define U ((bf16_t*)(a.ws + WS_U))
#define Qb ((bf16_t*)(a.ws + WS_Q))
#define AO ((bf16_t*)(a.ws + WS_AO))
#define FF ((bf16_t*)(a.ws + WS_FF))
#define XIN (a.in[0])
#define OUTP (a.out)
struct Args { const float* in[29]; float* out; unsigned char* ws; int ph_lo, ph_hi; };

typedef const __attribute__((address_space(4))) Args* CArgsP;
__device__ __forceinline__ CArgsP args_fresh() { CArgsP p = (CArgsP)__builtin_amdgcn_kernarg_segment_ptr(); asm volatile("" : "+s"(p)); return p; }
__global__ void __launch_bounds__(512, 2) mega(Args a0) {
    extern __shared__ __attribute__((aligned(16))) unsigned char lds_raw[];
    LAS unsigned char* lds = (LAS unsigned char*)lds_raw;
    cg::grid_group grid = cg::this_grid();
    const int G = gridDim.x, bid = blockIdx.x, NGW = G * 8, NGT = G * 512;
#define IDS const auto& a = *args_fresh(); const int tid = tid_fresh(), lane = tid & 63, wave = __builtin_amdgcn_readfirstlane(tid >> 6), gw = bid * 8 + wave, gtid = bid * 512 + tid; (void)lane; (void)gw; (void)gtid
    const int lo = a0.ph_lo, hi = a0.ph_hi;
    if (lo < 0) grid.sync();
    { volatile LAS unsigned* misc = (volatile LAS unsigned*)(lds + MISC_OFF); if (threadIdx.x < 2) misc[threadIdx.x] = 0u; __syncthreads();
      if (hi - lo > 1) (void)xcd_barrier_post((unsigned*)(a0.ws + WS_CTL), misc); }
#ifndef MK_REP
#define MK_REP -1
#endif
#ifndef MK_REPN
#define MK_REPN 3
#endif
#define RPT(code) for (int rep_ = 0, nrep_ = (MK_REP == (code)) ? MK_REPN : 1; rep_ < nrep_; ++rep_)
#define LASTREP (rep_ == nrep_ - 1)
#define IN(k) (lo <= (k) && (k) < hi)
#define SEAM(k) do { if (IN(k) && IN((k) + 1)) RPT(120) { XcdBarrier xb_; xb_.bar = (unsigned*)(args_fresh()->ws + WS_CTL); xb_.x = xb_xcc_id(); xb_.st = (volatile LAS unsigned*)(lds + MISC_OFF); xcd_barrier(xb_); } } while (0)

    if (IN(0)) RPT(100) { IDS;
        LAS float* scr = (LAS float*)(lds + wave * 16384);
        constexpr int I_IN = 16 * 297, I_SQ = 16 * 32, I_13 = 16 * 88, I_2 = 44 * 32;
        constexpr int NITEMS = I_IN + 5 * I_SQ + 2 * I_13 + I_2;
        for (int it = gw; it < NITEMS; it += NGW) {
            int r = it;
            if (r < I_IN) { const int kb = r / 297, n0 = (r % 297) * 32; tr_item(a.in[3], 1024, 9504, WinT, kb, n0, n0 + (n0 >= 3360 ? 224 : 0), scr, lane); continue; } r -= I_IN;
            if (r < I_SQ) { tr_item(a.in[17], 1024, 1024, WoutT, r / 32, (r % 32) * 32, (r % 32) * 32, scr, lane); continue; } r -= I_SQ;
            if (r < I_SQ) { tr_item(a.in[20], 1024, 1024, WqT, r / 32, (r % 32) * 32, (r % 32) * 32, scr, lane); continue; } r -= I_SQ;
            if (r < I_SQ) { tr_item(a.in[23], 1024, 1024, WoT, r / 32, (r % 32) * 32, (r % 32) * 32, scr, lane); continue; } r -= I_SQ;
            if (r < I_SQ) { tr_item(a.in[21], 1024, 1024, WkvT, r / 32, (r % 32) * 32, (r % 32) * 32, scr, lane); continue; } r -= I_SQ;
            if (r < I_SQ) { tr_item(a.in[22], 1024, 1024, WkvT, r / 32, (r % 32) * 32, 1024 + (r % 32) * 32, scr, lane); continue; } r -= I_SQ;
            if (r < I_13) { const int n0 = (r % 88) * 32; tr_item(a.in[25], 1024, DFF, W13T, r / 88, n0, (n0 / 128) * 256 + (n0 % 128), scr, lane); continue; } r -= I_13;
            if (r < I_13) { const int n0 = (r % 88) * 32; tr_item(a.in[26], 1024, DFF, W13T, r / 88, n0, (n0 / 128) * 256 + 128 + (n0 % 128), scr, lane); continue; } r -= I_13;
            tr_item(a.in[27], DFF, 1024, W2T, r / 32, (r % 32) * 32, (r % 32) * 32, scr, lane);
        }
        for (int i = gtid; i < 28672; i += NGT) ((u32x4*)(WinT + 3360 * 1024))[i] = (u32x4){0u, 0u, 0u, 0u};
        for (int i = gtid; i < 1792; i += NGT) ((u32x4*)carry)[i] = (u32x4){0u, 0u, 0u, 0u};
        for (int n = gw; n < 1024; n += NGW) { rw2T[n * 64 + lane] = (bf16_t)f2bf(a.in[6][lane * 1024 + n]); ra2T[n * 64 + lane] = (bf16_t)f2bf(a.in[8][lane * 1024 + n]); }
        for (int m = gw; m < 512; m += NGW) {
            for (int e = lane; e < 320; e += 64) { const int n = 2 * m + (e >= 160 ? 1 : 0), k = e >= 160 ? e - 160 : e; rg2T[n * 160 + k] = (bf16_t)f2bf(a.in[9][k * 1024 + n]); } }
        for (int n = gw; n < 1024; n += NGW) { f32x4 v;
#pragma unroll
            for (int e = 0; e < 4; ++e) { const int k = 4 * lane + e; v[e] = k < 160 ? a.in[9][k * 1024 + n] : 0.f; }
            st4bf(g2Tp + n * 256 + 4 * lane, v); }
        for (int i = gtid; i < 1024; i += NGT) lbv[i] = 1.0f / (1.0f + __expf(a.in[15][1024 + i] - a.in[15][i]));
        for (int m = gw; m < 1024; m += NGW) rms_row_bf16(a.in[1] + (size_t)m * 1024, a.in[19], mbf + (size_t)m * 1024, lane);
        for (int lt = gw; lt < MS; lt += NGW) { const int b = lt / TS, tl = lt % TS; const size_t gt = (size_t)b * SEQ + tl; rms_row_bf16(XIN + gt * 1024, a.in[2], u1 + (size_t)lt * 1024, lane); }
        __syncthreads();
    }
    SEAM(0);

#pragma unroll 1
    for (int s = 0; s < NSPLIT; ++s) {
        const int pb = 1 + 5 * s;
        if (IN(pb + 1)) { const auto& a = *args_fresh();
            pg8::Gemm g{u1, WinT, MS, CL, 1024}; pg8::StaticOrder S; S.init(MS, CL, G, bid);
            pg8::EpiColsAct E{cols, CL};
            RPT(102) pg8::gemm_phase<pg8::EpiColsAct, pg8::StaticOrder, true, true>(lds, g, S, E);
        }
        SEAM(pb + 1);
#ifndef SKIP_PREP
        if (IN(pb + 2)) { IDS; RPT(103) prep_phase(s, gw, NGW, lane, cols, carry, a.in[4], a.in[5], a.in[7], a.in[10], a.in[11], a.in[12], rw2T, ra2T, PR, PK, PA, PB, PV, PW, bonus, ASG); }
#endif
        SEAM(pb + 2);
        if (IN(pb + 3)) { IDS;
#ifdef MK_ZERO_SCAN
            for (int i = gtid; i < MS * 256; i += NGT) { ((f32x4*)oraw)[i] = (f32x4){0.f, 0.f, 0.f, 0.f}; ((f32x4*)hgo)[i] = (f32x4){0.01f, 0.02f, 0.03f, 0.04f}; }
#endif
#if 0
            RPT(104) { rwkv_scan(s, bid, G, tid, lane, wave, lds, PA, PW, PB, PK, PR, PV, oraw, rwst, LASTREP); __syncthreads(); }
            RPT(105) { hgrn_scan(s, bid, G, tid, lane, wave, lds, cols, lbv, hgo, hgst, LASTREP); __syncthreads(); }
#else
#ifdef MK_FUSED_SCAN
            RPT(104) { fused_scan(s, bid, G, tid, lane, wave, lds, PA, PW, PB, PK, PR, PV, cols, lbv, oraw, hgo, rwst, hgst, LASTREP); __syncthreads(); }
#else
            RPT(104) { split_scan(s, bid, G, tid, lane, wave, lds, PA, PW, PB, PK, PR, PV, cols, lbv, oraw, hgo, rwst, hgst, LASTREP); __syncthreads(); }
#endif
#endif
            if (G != 256 || bid < 128) { pg8::Gemm g{ASG, g2Tp, MS, 1024, 256}; pg8::StaticOrder S; if (G == 256) S.init(MS, 1024, 128, bid); else S.init(MS, 1024, G, bid); pg8::EpiStoreBf16 E{GATE, 1024};
              pg8::gemm_phase<pg8::EpiStoreBf16, pg8::StaticOrder, true, true>(lds, g, S, E); }
        }
        SEAM(pb + 3);
        if (IN(pb + 4)) { IDS;
#ifdef MK_NOMIX
            for (int i = gtid; i < MS * 128; i += NGT) { const int lt = i >> 7, b = lt / TS, tl = lt % TS; const size_t gt = (size_t)b * SEQ + s * TS + tl; ((u32x4*)(merged + gt * 1024))[i & 127] = (u32x4){0u, 0u, 0u, 0u}; }
#endif
#ifndef SKIP_POST
            RPT(106) post_phase(s, gw, NGW, lane, cols, carry, a.in[4], GATE, a.in[13], a.in[14], a.in[16], oraw, hgo, PV, bonus, merged);
#endif
            if (s + 1 < NSPLIT) for (int lt = gw; lt < MS; lt += NGW) { const int b = lt / TS, tl = lt % TS; const size_t gt = (size_t)b * SEQ + (s + 1) * TS + tl; rms_row_bf16(XIN + gt * 1024, a.in[2], u1 + (size_t)lt * 1024, lane); }
            if (bid < 4 && s + 1 < NSPLIT) { const u32x4* src = (const u32x4*)(cols + (size_t)(bid * TS + TS - 1) * CL); u32x4* dst = (u32x4*)(carry + (((s + 1) & 1) * 4 + bid) * CARRY_LD);
                for (int i = tid; i < CARRY_LD / 8; i += 512) dst[i] = src[i]; }
        }
        SEAM(pb + 4);
    }

    if (IN(T0 + 0)) { const auto& a = *args_fresh();
        { pg8::Gemm g{merged, WoutT, NTOK, 1024, 1024}; pg8::StaticOrder S; S.init(NTOK, 1024, G, bid); pg8::EpiResF32 E{XIN, OUTP, 1024};
          pg8::gemm_phase<pg8::EpiResF32, pg8::StaticOrder, true, true>(lds, g, S, E); }
        { pg8::Gemm g{mbf, WkvT, 1024, 2048, 1024}; pg8::StaticOrder S; S.init(1024, 2048, G, bid); pg8::EpiStoreBf16 E{KV, 2048};
          pg8::gemm_phase<pg8::EpiStoreBf16, pg8::StaticOrder, true, true>(lds, g, S, E); }
    }
    SEAM(T0 + 0);
    if (IN(T0 + 1)) { IDS;
        for (int gt = gw; gt < NTOK; gt += NGW) rms_row_bf16(OUTP + (size_t)gt * 1024, a.in[18], U + (size_t)gt * 1024, lane);
        for (int i = gtid; i < 4 * 4 * 256 * 256; i += NGT) { const int kp = i & 255, dim = (i >> 8) & 255, hd = (i >> 16) & 3, b = i >> 18;
            const int k2 = kp >> 5, fq = (kp >> 3) & 3, sl = kp & 7; const int key = 32 * k2 + (sl < 4 ? 4 * fq + sl : 16 + 4 * fq + sl - 4);
            Vt[i] = KV[(size_t)(b * 256 + key) * 2048 + 1024 + hd * 256 + dim]; }
        for (int i = gw; i < 64; i += NGW) {
            const int bh = i >> 2, kb = i & 3, b = bh >> 2, hd = bh & 3; const bf16_t* kr = KV + (size_t)(b * 256 + kb * 64 + lane) * 2048 + hd * 256; float ss = 0.f;
#pragma unroll 4
            for (int c = 0; c < 32; ++c) { float t[8]; ld8bf(kr + c * 8, t);
#pragma unroll
                for (int e = 0; e < 8; ++e) ss += t[e] * t[e]; }
#pragma unroll
            for (int o = 1; o < 64; o <<= 1) ss = fmaxf(ss, __shfl_xor(ss, o));
            if (lane == 0) KMAX2[i * 32] = ss; }
    }
    SEAM(T0 + 1);
    if (IN(T0 + 2)) { const auto& a = *args_fresh(); pg8::Gemm g{U, WqT, NTOK, 1024, 1024}; pg8::StaticOrder S; S.init(NTOK, 1024, G, bid); pg8::EpiStoreBf16 E{Qb, 1024};
        RPT(112) pg8::gemm_phase<pg8::EpiStoreBf16, pg8::StaticOrder, true, true>(lds, g, S, E); }
    SEAM(T0 + 2);
#ifndef SKIP_ATTN
    if (IN(T0 + 3)) { IDS; RPT(113) attn_phase(gw, NGW, lane, Qb, KV, Vt, AO, KMAX2); }
#endif
    SEAM(T0 + 3);
#ifndef MK_NOATT
    if (IN(T0 + 4)) { const auto& a = *args_fresh(); pg8::Gemm g{AO, WoT, NTOK, 1024, 1024}; pg8::StaticOrder S; S.init(NTOK, 1024, G, bid); pg8::EpiResF32 E{OUTP, OUTP, 1024};
        pg8::gemm_phase<pg8::EpiResF32, pg8::StaticOrder, true, true>(lds, g, S, E); }
#endif
    SEAM(T0 + 4);
    if (IN(T0 + 5)) { IDS; RPT(115) for (int gt = gw; gt < NTOK; gt += NGW) rms_row_bf16(OUTP + (size_t)gt * 1024, a.in[24], U + (size_t)gt * 1024, lane); }
    SEAM(T0 + 5);
    if (IN(T0 + 6)) { const auto& a = *args_fresh(); pg8::Gemm g{U, W13T, NTOK, 2 * DFF, 1024}; pg8::StaticOrder S; S.init(NTOK, 2 * DFF, G, bid); pg8::EpiSwiGLU E{FF, DFF};
        RPT(116) pg8::gemm_phase<pg8::EpiSwiGLU, pg8::StaticOrder, true, true>(lds, g, S, E); }
    SEAM(T0 + 6);
    if (IN(T0 + 7)) { const auto& a = *args_fresh(); pg8::Gemm g{FF, W2T, NTOK, 1024, DFF}; pg8::StaticOrder S; S.init(NTOK, 1024, G, bid); pg8::EpiResF32 E{OUTP, OUTP, 1024};
        pg8::gemm_phase<pg8::EpiResF32, pg8::StaticOrder, true, true>(lds, g, S, E); }
    SEAM(T0 + 7);
    if (IN(T0 + 8)) { IDS;
        const float* gf = a.in[28];
        for (int gt = gw; gt < NTOK; gt += NGW) { f32x4* row = (f32x4*)(OUTP + (size_t)gt * 1024); f32x4 v[4]; float sq = 0.f;
#pragma unroll
            for (int j = 0; j < 4; ++j) { v[j] = row[lane + 64 * j]; sq += (v[j][0] * v[j][0] + v[j][1] * v[j][1]) + (v[j][2] * v[j][2] + v[j][3] * v[j][3]); }
            const float rs = 1.0f / sqrtf(wave_sum(sq) * (1.0f / 1024.0f) + 1e-6f);
#pragma unroll
            for (int j = 0; j < 4; ++j) row[lane + 64 * j] = v[j] * rs * ((const f32x4*)gf)[lane + 64 * j]; }
    }
#undef IN
#undef SEAM
}

#ifndef MK_MULTI
#define MK_MULTI 0
#endif
extern "C" void kernel_launch(void* const* d_in, const int* in_sizes, int n_in, void* d_out, int out_size, void* d_ws, size_t ws_size, hipStream_t stream) {
    static int grid = 0;
    if (grid == 0) {
        if (n_in != 29 || in_sizes[0] != NTOK * D || out_size != NTOK * D || ws_size < WS_END) { fprintf(stderr, "kernel_launch: unexpected shapes / workspace (%d inputs, ws %zu)\n", n_in, ws_size); grid = -1; return; }
        int dev = 0, cus = 0, per_cu = 0;
        hipGetDevice(&dev); hipDeviceGetAttribute(&cus, hipDeviceAttributeMultiprocessorCount, dev);
        hipFuncSetAttribute((const void*)mega, hipFuncAttributeMaxDynamicSharedMemorySize, LDS_BYTES);
        hipOccupancyMaxActiveBlocksPerMultiprocessor(&per_cu, (const void*)mega, 512, LDS_BYTES);
        (void)hipGetLastError();
        if (per_cu < 1) per_cu = 1;
        grid = cus;
    }
    if (grid < 0) return;
    Args a{};
    for (int i = 0; i < 29; ++i) a.in[i] = (const float*)d_in[i];
    a.out = (float*)d_out; a.ws = (unsigned char*)d_ws;
    (void)hipMemsetAsync((char*)d_ws + WS_CTL, 0, CTL_BYTES, stream);
    void* args[] = {&a};
#if MK_MULTI
    for (int ph = 0; ph < N_PHASES; ++ph) { a.ph_lo = ph; a.ph_hi = ph + 1; hipLaunchCooperativeKernel((const void*)mega, dim3(grid), dim3(512), args, LDS_BYTES, stream); }
#else
    a.ph_lo = 0; a.ph_hi = N_PHASES;
    hipError_t e = hipLaunchCooperativeKernel((const void*)mega, dim3(grid), dim3(512), args, LDS_BYTES, stream);
    if (e != hipSuccess) fprintf(stderr, "cooperative launch failed: %s (grid %d)\n", hipGetErrorString(e), grid);
#endif
}
```

```cpp
#include <hip/hip_runtime.h>
#include <hip/hip_cooperative_groups.h>
#include <cstdint>
#include <cstdio>
namespace cg = cooperative_groups;
namespace pg8 {
#define PG8_LAS __attribute__((address_space(3)))
typedef unsigned short bf16_t;
typedef short bf16x8 __attribute__((ext_vector_type(8)));
typedef float f32x4 __attribute__((ext_vector_type(4)));
typedef unsigned u32x4 __attribute__((ext_vector_type(4)));
constexpr int BM = 256, BK = 64, HALF = 128, HTB = HALF * BK * 2  , STAGE_BYTES = 8 * HTB, NXCD = 8, WGM = 8;

__host__ __device__ __forceinline__ int lds_byte(int r, int c) { const int st = (r >> 4) * 2 + (c >> 5), rr = r & 15, cc = c & 31, ob = rr * 64 + cc * 2; return st * 1024 + (ob ^ (((ob >> 9) & 1) << 5)); }
__host__ __device__ __forceinline__ void stage_rc(int b, int& R, int& C) { const int st = b / 1024, sb = b % 1024, swz = sb ^ (((sb >> 9) & 1) << 5); R = (st >> 1) * 16 + swz / 64; C = (st & 1) * 32 + (swz % 64) / 2; }
__host__ __device__ __forceinline__ int perm32(int rho) { const int n = rho >> 4, i = rho & 15; return 8 * (i >> 2) + 4 * n + (i & 3); }

struct Unit { int pm, pn; };
struct Gemm { const bf16_t* A; const bf16_t* Bt; int M, N, K; };

struct StaticOrder {
    int nM, nN, nwg, G, c;
    __host__ __device__ void init(int M, int N, int G_, int c_) { nM = M / BM; nN = N / BM; nwg = nM * nN; G = G_; c = c_; }
    __host__ __device__ bool next(int i, Unit& u) const {
        const long L = (long)i * G + c; if (L >= nwg) return false;
        int wgid = (int)L; { const int q = nwg / NXCD, r = nwg % NXCD, xcd = wgid % NXCD, off = wgid / NXCD; wgid = (xcd < r ? xcd * (q + 1) : r * (q + 1) + (xcd - r) * q) + off; }
        const int nig = WGM * nN, gid = wgid / nig, fm = gid * WGM, gsz = (nM - fm) < WGM ? (nM - fm) : WGM;
        u.pm = fm + ((wgid % nig) % gsz); u.pn = (wgid % nig) / gsz; return true;
    }
    __device__ __forceinline__ void a_ready(const Unit&) const {}
    __device__ __forceinline__ void done(const Unit&) const {}
};

__device__ __forceinline__ unsigned cvt_pk_bf16(float lo, float hi) { unsigned r; asm volatile("v_cvt_pk_bf16_f32 %0, %1, %2" : "=v"(r) : "v"(lo), "v"(hi)); return r; }
__device__ __forceinline__ float fast_sigmoid(float x) { return __builtin_amdgcn_rcpf(1.0f + __expf(-x)); }
__device__ __forceinline__ float fast_silu(float x) { return x * fast_sigmoid(x); }
struct EpiStoreBf16 {
    static constexpr bool PERM = true, AFTER_DRAIN = false;
    bf16_t* O; int ldc;
    __device__ __forceinline__ void operator()(const f32x4 (&acc)[2][2][4][2], const Unit& u, int wr, int wc, int fr, int fq) const {
        const int row0 = u.pm * BM + wr * 64 + fr, col0 = u.pn * BM + wc * 32 + 8 * fq;
#pragma unroll
        for (int ai = 0; ai < 2; ++ai)
#pragma unroll
            for (int m = 0; m < 4; ++m) { bf16_t* rowp = O + (size_t)(row0 + ai * HALF + m * 16) * ldc + col0;
#pragma unroll
                for (int bj = 0; bj < 2; ++bj) { const f32x4 v0 = acc[ai][bj][m][0], v1 = acc[ai][bj][m][1];
                    u32x4 w; w.x = cvt_pk_bf16(v0[0], v0[1]); w.y = cvt_pk_bf16(v0[2], v0[3]); w.z = cvt_pk_bf16(v1[0], v1[1]); w.w = cvt_pk_bf16(v1[2], v1[3]);
                    *(u32x4*)(rowp + bj * HALF) = w; } }
    }
};
struct EpiResF32 {
    static constexpr bool PERM = true, AFTER_DRAIN = false;
    const float* base; float* out; int ldc;
    __device__ __forceinline__ void operator()(const f32x4 (&acc)[2][2][4][2], const Unit& u, int wr, int wc, int fr, int fq) const {
        const int row0 = u.pm * BM + wr * 64 + fr, col0 = u.pn * BM + wc * 32 + 8 * fq;
#pragma unroll
        for (int ai = 0; ai < 2; ++ai)
#pragma unroll
            for (int m = 0; m < 4; ++m) { const size_t off = (size_t)(row0 + ai * HALF + m * 16) * ldc + col0;
#pragma unroll
                for (int bj = 0; bj < 2; ++bj)
#pragma unroll
                    for (int n = 0; n < 2; ++n) { const size_t p = off + bj * HALF + 4 * n; const f32x4 b = *(const f32x4*)(base + p); *(f32x4*)(out + p) = b + acc[ai][bj][m][n]; } }
    }
};
struct EpiSwiGLU {
    static constexpr bool PERM = true, AFTER_DRAIN = false;
    bf16_t* O; int ldc;
    __device__ __forceinline__ void operator()(const f32x4 (&acc)[2][2][4][2], const Unit& u, int wr, int wc, int fr, int fq) const {
        const int row0 = u.pm * BM + wr * 64 + fr, col0 = u.pn * HALF + wc * 32 + 8 * fq;
#pragma unroll
        for (int ai = 0; ai < 2; ++ai)
#pragma unroll
            for (int m = 0; m < 4; ++m) { bf16_t* rowp = O + (size_t)(row0 + ai * HALF + m * 16) * ldc + col0;
                f32x4 v0, v1;
#pragma unroll
                for (int j = 0; j < 4; ++j) { v0[j] = fast_silu(acc[ai][0][m][0][j]) * acc[ai][1][m][0][j]; v1[j] = fast_silu(acc[ai][0][m][1][j]) * acc[ai][1][m][1][j]; }
                u32x4 w; w.x = cvt_pk_bf16(v0[0], v0[1]); w.y = cvt_pk_bf16(v0[2], v0[3]); w.z = cvt_pk_bf16(v1[0], v1[1]); w.w = cvt_pk_bf16(v1[2], v1[3]);
                *(u32x4*)rowp = w; }
    }
};

struct EpiColsAct {
    static constexpr bool PERM = true, AFTER_DRAIN = false;
    bf16_t* O; int ldc;
    __device__ __forceinline__ void operator()(const f32x4 (&acc)[2][2][4][2], const Unit& u, int wr, int wc, int fr, int fq) const {
        const int row0 = u.pm * BM + wr * 64 + fr, col0 = u.pn * BM + wc * 32 + 8 * fq;
        const int pn = u.pn; const int act = (pn >= 14 && pn < 18) ? 1 : (pn >= 18 && pn < 22) ? 2 : (pn >= 26 && pn < 30) ? 1 : (pn >= 30) ? 2 : 0;
#pragma unroll
        for (int ai = 0; ai < 2; ++ai)
#pragma unroll
            for (int m = 0; m < 4; ++m) { bf16_t* rowp = O + (size_t)(row0 + ai * HALF + m * 16) * ldc + col0;
#pragma unroll
                for (int bj = 0; bj < 2; ++bj) { f32x4 v0 = acc[ai][bj][m][0], v1 = acc[ai][bj][m][1];
                    if (act == 1) {
#pragma unroll
                        for (int j = 0; j < 4; ++j) { v0[j] = fast_silu(v0[j]); v1[j] = fast_silu(v1[j]); } }
                    else if (act == 2) {
#pragma unroll
                        for (int j = 0; j < 4; ++j) { v0[j] = fast_sigmoid(v0[j]); v1[j] = fast_sigmoid(v1[j]); } }
                    u32x4 w; w.x = cvt_pk_bf16(v0[0], v0[1]); w.y = cvt_pk_bf16(v0[2], v0[3]); w.z = cvt_pk_bf16(v1[0], v1[1]); w.w = cvt_pk_bf16(v1[2], v1[3]);
                    *(u32x4*)(rowp + bj * HALF) = w; } }
    }
};
template <class Epi, class Sched, bool ALIGN_EPI = false, bool SP2 = false>
__device__ __forceinline__ void gemm_phase(PG8_LAS unsigned char* lds, const Gemm g, const Sched& S, const Epi& E) {
    int tid = threadIdx.x; asm volatile("" : "+v"(tid));
    const int wid = __builtin_amdgcn_readfirstlane(tid >> 6), lane = tid & 63, wr = wid >> 2, wc = wid & 3, fr = lane & 15, fq = lane >> 4;
    const int K = g.K, nt = K / BK;
    unsigned voffA[2], voffB[2];
#pragma unroll
    for (int i = 0; i < 2; ++i) { int R, C; stage_rc(tid * 16 + i * 8192, R, C); const int Rb = Epi::PERM ? ((R & ~31) + perm32(R & 31)) : R;
        voffA[i] = (unsigned)(R * K + C) * 2u; voffB[i] = (unsigned)(Rb * K + C) * 2u; }
    const size_t kstep = (size_t)(BK * 2);
    const size_t hstep = (size_t)HALF * K * 2;
    const size_t tstep = 2 * hstep;
    const unsigned ldsw = (unsigned)wid * 1024u;
    const int aoff = lds_byte(wr * 64 + fr, fq * 8), boff = lds_byte(wc * 32 + fr, fq * 8);
#define PG8_SA(b, h) (((b) * 2 + (h)) * HTB)
#define PG8_SB(b, h) ((4 + (b) * 2 + (h)) * HTB)
#define PG8_STAGE(bufoff, gbase, voff) do { _Pragma("unroll") for (int _i = 0; _i < 2; ++_i) \
        __builtin_amdgcn_global_load_lds((const unsigned*)((const char*)(gbase) + (voff)[_i]), (PG8_LAS unsigned*)(lds + (bufoff) + ldsw + _i * 8192), 16, 0, 0); } while (0)
#define PG8_LDA(dst, b, h) do { _Pragma("unroll") for (int m = 0; m < 4; ++m) _Pragma("unroll") for (int k = 0; k < 2; ++k) dst[m][k] = *(const PG8_LAS bf16x8*)(lds + PG8_SA(b, h) + aoff + m * 2048 + k * 1024); } while (0)
#define PG8_LDB(dst, b, h) do { _Pragma("unroll") for (int n = 0; n < 2; ++n) _Pragma("unroll") for (int k = 0; k < 2; ++k) dst[n][k] = *(const PG8_LAS bf16x8*)(lds + PG8_SB(b, h) + boff + n * 2048 + k * 1024); } while (0)
#define PG8_MMA(ai, bj, At, Bt) do { __builtin_amdgcn_s_setprio(1); _Pragma("unroll") for (int m = 0; m < 4; ++m) _Pragma("unroll") for (int n = 0; n < 2; ++n) _Pragma("unroll") for (int k = 0; k < 2; ++k) \
        acc[ai][bj][m][n] = __builtin_amdgcn_mfma_f32_16x16x32_bf16(Bt[n][k], At[m][k], acc[ai][bj][m][n], 0, 0, 0); __builtin_amdgcn_s_setprio(0); } while (0)
#define PG8_WAIT_V(n) asm volatile("s_waitcnt vmcnt(" #n ")" ::: "memory")
#define PG8_WAIT_L(n) asm volatile("s_waitcnt lgkmcnt(" #n ")" ::: "memory")
#define PG8_BAR __builtin_amdgcn_s_barrier()
#define PG8_SCHED __builtin_amdgcn_sched_barrier(0)
    Unit cur, nxt; int ui = 0;
    if (!S.next(0, cur)) return;
    f32x4 acc[2][2][4][2];
#pragma unroll
    for (int a = 0; a < 2; ++a)
#pragma unroll
        for (int b = 0; b < 2; ++b)
#pragma unroll
            for (int m = 0; m < 4; ++m)
#pragma unroll
                for (int n = 0; n < 2; ++n) acc[a][b][m][n] = (f32x4){0.f, 0.f, 0.f, 0.f};
    bf16x8 At[4][2], B0[2][2], B1[2][2];
    const char* cA = (const char*)g.A + (size_t)cur.pm * tstep; const char* cB = (const char*)g.Bt + (size_t)cur.pn * tstep;
    S.a_ready(cur);
    if constexpr (SP2) {
        PG8_STAGE(PG8_SB(0, 0), cB, voffB); PG8_STAGE(PG8_SB(0, 1), cB + hstep, voffB); PG8_STAGE(PG8_SA(0, 0), cA, voffA); PG8_STAGE(PG8_SA(0, 1), cA + hstep, voffA);
        if (wr == 1) PG8_BAR;
        PG8_WAIT_V(2); PG8_BAR;
        PG8_STAGE(PG8_SB(1, 0), cB + kstep, voffB); PG8_STAGE(PG8_SA(1, 0), cA + kstep, voffA); PG8_STAGE(PG8_SB(1, 1), cB + hstep + kstep, voffB);
        PG8_WAIT_V(6); PG8_BAR;
    } else {
        PG8_STAGE(PG8_SB(0, 0), cB, voffB); PG8_STAGE(PG8_SA(0, 0), cA, voffA); PG8_STAGE(PG8_SB(0, 1), cB + hstep, voffB); PG8_STAGE(PG8_SA(0, 1), cA + hstep, voffA);
        if (wr == 1) PG8_BAR;
        PG8_WAIT_V(4); PG8_BAR;
        PG8_STAGE(PG8_SB(1, 0), cB + kstep, voffB); PG8_STAGE(PG8_SA(1, 0), cA + kstep, voffA); PG8_STAGE(PG8_SB(1, 1), cB + hstep + kstep, voffB);
        PG8_WAIT_V(6); PG8_BAR;
    }
    for (;;) {
        const bool has_next = S.next(ui + 1, nxt);
        const char* nA = has_next ? (const char*)g.A + (size_t)nxt.pm * tstep : cA; const char* nB = has_next ? (const char*)g.Bt + (size_t)nxt.pn * tstep : cB;
        for (int t = 0; t < nt; t += 2) {
            const bool last = (t == nt - 2);
            const char* a1 = cA + (size_t)(t + 1) * kstep;
            const char* a2 = last ? nA : cA + (size_t)(t + 2) * kstep; const char* b2 = last ? nB : cB + (size_t)(t + 2) * kstep;
            const char* a3 = a2 + kstep; const char* b3 = b2 + kstep;
            if (last && has_next) S.a_ready(nxt);
            if constexpr (SP2) {
            PG8_LDB(B0, 0, 0); PG8_LDB(B1, 0, 1); PG8_SCHED; PG8_LDA(At, 0, 0); PG8_STAGE(PG8_SA(1, 1), a1 + hstep, voffA);
            PG8_WAIT_V(8); PG8_WAIT_L(0); PG8_BAR; PG8_MMA(0, 0, At, B0); PG8_MMA(0, 1, At, B1); PG8_BAR; PG8_SCHED;
            PG8_LDA(At, 0, 1); PG8_STAGE(PG8_SB(0, 0), b2, voffB); PG8_STAGE(PG8_SB(0, 1), b2 + hstep, voffB); PG8_STAGE(PG8_SA(0, 0), a2, voffA);
            PG8_WAIT_V(8); PG8_WAIT_L(0); PG8_BAR; PG8_MMA(1, 0, At, B0); PG8_MMA(1, 1, At, B1); PG8_BAR; PG8_SCHED;
            PG8_LDB(B0, 1, 0); PG8_LDB(B1, 1, 1); PG8_SCHED; PG8_LDA(At, 1, 0); PG8_STAGE(PG8_SA(0, 1), a2 + hstep, voffA);
            PG8_WAIT_V(8); PG8_WAIT_L(0); PG8_BAR; PG8_MMA(0, 0, At, B0); PG8_MMA(0, 1, At, B1); PG8_BAR; PG8_SCHED;
            PG8_LDA(At, 1, 1); PG8_STAGE(PG8_SB(1, 0), b3, voffB); PG8_STAGE(PG8_SB(1, 1), b3 + hstep, voffB); PG8_STAGE(PG8_SA(1, 0), a3, voffA);
            PG8_WAIT_V(8); PG8_WAIT_L(0); PG8_BAR; PG8_MMA(1, 0, At, B0); PG8_MMA(1, 1, At, B1); PG8_BAR; PG8_SCHED;
            } else {
            PG8_LDB(B0, 0, 0); PG8_SCHED; PG8_LDA(At, 0, 0); PG8_STAGE(PG8_SA(1, 1), a1 + hstep, voffA);
            PG8_WAIT_L(8); PG8_BAR; PG8_WAIT_L(0); PG8_MMA(0, 0, At, B0); PG8_BAR; PG8_SCHED;
            PG8_LDB(B1, 0, 1); PG8_STAGE(PG8_SB(0, 0), b2, voffB);
            PG8_BAR; PG8_WAIT_L(0); PG8_MMA(0, 1, At, B1); PG8_BAR;
            PG8_LDA(At, 0, 1); PG8_STAGE(PG8_SA(0, 0), a2, voffA);
            PG8_BAR; PG8_WAIT_L(0); PG8_MMA(1, 0, At, B0); PG8_BAR; PG8_SCHED;
            PG8_STAGE(PG8_SB(0, 1), b2 + hstep, voffB);
            PG8_WAIT_V(6); PG8_BAR; PG8_MMA(1, 1, At, B1); PG8_BAR;
            PG8_LDB(B0, 1, 0); PG8_SCHED; PG8_LDA(At, 1, 0); PG8_STAGE(PG8_SA(0, 1), a2 + hstep, voffA);
            PG8_WAIT_L(8); PG8_BAR; PG8_WAIT_L(0); PG8_MMA(0, 0, At, B0); PG8_BAR; PG8_SCHED;
            PG8_LDB(B1, 1, 1); PG8_STAGE(PG8_SB(1, 0), b3, voffB);
            PG8_BAR; PG8_WAIT_L(0); PG8_MMA(0, 1, At, B1); PG8_BAR;
            PG8_LDA(At, 1, 1); PG8_STAGE(PG8_SA(1, 0), a3, voffA);
            PG8_BAR; PG8_WAIT_L(0); PG8_MMA(1, 0, At, B0); PG8_BAR; PG8_SCHED;
            PG8_STAGE(PG8_SB(1, 1), b3 + hstep, voffB);
            PG8_WAIT_V(6); PG8_BAR; PG8_MMA(1, 1, At, B1); PG8_BAR;
            }
        }
        if constexpr (ALIGN_EPI) { if (wr == 0) PG8_BAR; }
        if constexpr (!Epi::AFTER_DRAIN) { E(acc, cur, wr, wc, fr, fq); S.done(cur); }
        if (!has_next) break;
#pragma unroll
        for (int a = 0; a < 2; ++a)
#pragma unroll
            for (int b = 0; b < 2; ++b)
#pragma unroll
                for (int m = 0; m < 4; ++m)
#pragma unroll
                    for (int n = 0; n < 2; ++n) acc[a][b][m][n] = (f32x4){0.f, 0.f, 0.f, 0.f};
        cur = nxt; cA = nA; cB = nB; ++ui;
        if constexpr (ALIGN_EPI) { if (wr == 1) PG8_BAR; }
    }
    PG8_WAIT_V(0);
    if constexpr (!ALIGN_EPI) { if (wr == 0) PG8_BAR; }
    PG8_BAR;
    if constexpr (Epi::AFTER_DRAIN) { E.fused(acc, cur, wr, wc, fr, fq, lds, wid, lane); S.done(cur); }
#undef PG8_SA
#undef PG8_SB
#undef PG8_STAGE
#undef PG8_LDA
#undef PG8_LDB
#undef PG8_MMA
#undef PG8_WAIT_V
#undef PG8_WAIT_L
#undef PG8_BAR
#undef PG8_SCHED
}
}

#define LAS __attribute__((address_space(3)))
typedef pg8::bf16_t bf16_t;
typedef pg8::bf16x8 bf16x8;
typedef pg8::f32x4 f32x4;
typedef pg8::u32x4 u32x4;
typedef unsigned u32x2 __attribute__((ext_vector_type(2)));
typedef float f32x2v __attribute__((ext_vector_type(2)));
using pg8::cvt_pk_bf16;
using pg8::fast_sigmoid;
using pg8::fast_silu;

constexpr int D = 1024, NB = 4, SEQ = 8192, NTOK = NB * SEQ;
#ifndef MK_NSPLIT
#define MK_NSPLIT 4
#endif
constexpr int NSPLIT = MK_NSPLIT, TS = SEQ / NSPLIT, MS = NB * TS;
constexpr int CL = 9728;
constexpr int C_R = 0, C_K = 1024, C_V = 2048, C_WLO = 3072, C_ALO = 3136, C_GLO = 3200, C_HQ = 3584, C_HF = 4608, C_HI = 5632, C_HG = 6656, C_GA = 7680, C_GB = 8704;
constexpr int CARRY_LD = 3584;
constexpr int DFF = 2816;
constexpr size_t MiB = 1u << 20, KiB = 1u << 10;
constexpr size_t WS_WIN = 0, WS_WOUT = 19 * MiB, WS_WQ = 21 * MiB, WS_WO = 23 * MiB, WS_WKV = 25 * MiB, WS_W13 = 29 * MiB, WS_W2 = 40 * MiB;
constexpr size_t WS_RW2T = 46 * MiB, WS_RA2T = 46 * MiB + 128 * KiB, WS_RG2T = 46 * MiB + 256 * KiB, WS_CARRY = 46 * MiB + 640 * KiB, WS_LB = 46 * MiB + 704 * KiB;
constexpr size_t WS_MBF = 47 * MiB, WS_KV = 49 * MiB, WS_VT = 53 * MiB, WS_RWST = 55 * MiB, WS_HGST = 56 * MiB, WS_BONUS = 58 * MiB;
constexpr size_t WS_KMAX = 58 * MiB + 768 * KiB;
constexpr size_t WS_G2TP = 59 * MiB;
constexpr size_t WS_MERGED = 64 * MiB;
constexpr size_t WS_U1 = 128 * MiB, WS_COLS = 144 * MiB, WS_PR = 296 * MiB, WS_PK = 312 * MiB, WS_PA = 328 * MiB, WS_PB = 344 * MiB, WS_PV = 360 * MiB, WS_PW = 376 * MiB, WS_ORAW = 408 * MiB, WS_HGO = 440 * MiB;
constexpr size_t WS_GATE = 472 * MiB, WS_ASG = 488 * MiB;
constexpr size_t WS_U = 128 * MiB, WS_Q = 192 * MiB, WS_AO = 256 * MiB, WS_FF = 320 * MiB, WS_CTL = 496 * MiB, CTL_BYTES = 64 * KiB, WS_END = 496 * MiB + 64 * KiB;
constexpr int LDS_BYTES = 147456, MISC_OFF = 131072 + 320;
constexpr int T0 = 1 + 5 * NSPLIT, N_PHASES = T0 + 9;

__device__ __forceinline__ float bflo(unsigned u) { return __uint_as_float(u << 16); }
__device__ __forceinline__ float bfhi(unsigned u) { return __uint_as_float(u & 0xffff0000u); }
__device__ __forceinline__ unsigned f2bf(float f) { unsigned u = __float_as_uint(f); return (u + 0x7fffu + ((u >> 16) & 1u)) >> 16; }
__device__ __forceinline__ f32x4 ld4bf(const bf16_t* p) { const u32x2 u = *(const u32x2*)p; return (f32x4){bflo(u.x), bfhi(u.x), bflo(u.y), bfhi(u.y)}; }
__device__ __forceinline__ f32x4 up4(u32x2 u) { return (f32x4){bflo(u.x), bfhi(u.x), bflo(u.y), bfhi(u.y)}; }
__device__ __forceinline__ void ld8bf(const bf16_t* p, float (&o)[8]) { const u32x4 u = *(const u32x4*)p; o[0] = bflo(u.x); o[1] = bfhi(u.x); o[2] = bflo(u.y); o[3] = bfhi(u.y); o[4] = bflo(u.z); o[5] = bfhi(u.z); o[6] = bflo(u.w); o[7] = bfhi(u.w); }
__device__ __forceinline__ void st4bf(bf16_t* p, f32x4 v) { u32x2 w; w.x = cvt_pk_bf16(v[0], v[1]); w.y = cvt_pk_bf16(v[2], v[3]); *(u32x2*)p = w; }
__device__ __forceinline__ bf16x8 pack8(const float (&t)[8]) { u32x4 w; w.x = cvt_pk_bf16(t[0], t[1]); w.y = cvt_pk_bf16(t[2], t[3]); w.z = cvt_pk_bf16(t[4], t[5]); w.w = cvt_pk_bf16(t[6], t[7]); return __builtin_bit_cast(bf16x8, w); }
__device__ __forceinline__ float tanh_fast(float x) { return 1.0f - 2.0f * __builtin_amdgcn_rcpf(1.0f + __expf(2.0f * x)); }
__device__ __forceinline__ float wave_sum(float v) {
#pragma unroll
    for (int o = 1; o < 64; o <<= 1) v += __shfl_xor(v, o);
    return v;
}
__device__ __forceinline__ float fq_sum(float v) { v += __shfl_xor(v, 16); v += __shfl_xor(v, 32); return v; }
template <int CTRL> __device__ __forceinline__ float dpp_add(float x) { return x + __builtin_bit_cast(float, __builtin_amdgcn_update_dpp(0, __builtin_bit_cast(int, x), CTRL, 0xf, 0xf, false)); }
#ifdef MK_SHFL_REDUCE
__device__ __forceinline__ float allreduce16(float x) { x += __shfl_xor(x, 1); x += __shfl_xor(x, 2); x += __shfl_xor(x, 4); x += __shfl_xor(x, 8); return x; }
#else
__device__ __forceinline__ float allreduce16(float x) { x = dpp_add<0xB1>(x); x = dpp_add<0x4E>(x); x = dpp_add<0x141>(x); x = dpp_add<0x140>(x); return x; }
#endif
__device__ __forceinline__ void allreduce16x2(float& x, float& y) {
    x = dpp_add<0xB1>(x); y = dpp_add<0xB1>(y); x = dpp_add<0x4E>(x); y = dpp_add<0x4E>(y); x = dpp_add<0x141>(x); y = dpp_add<0x141>(y); x = dpp_add<0x140>(x); y = dpp_add<0x140>(y); }
#define MFMA16(a, b, c) __builtin_amdgcn_mfma_f32_16x16x32_bf16((a), (b), (c), 0, 0, 0)

#define XB_TMO      128
#define XB_XCNT(j)  (256  + 64 * (j))
#define XB_XSUB(j)  (1280 + 64 * (j))
#define XB_XGEN(j)  (2304 + 64 * (j))
#define XB_TOP      3328
#define XB_TOPGEN   3392
#define XCD_BAR_WORDS 3456
#define XB_SPIN_CAP (1u << 18)

__device__ __forceinline__ unsigned xb_ld(unsigned* p)              { return __hip_atomic_load(p, __ATOMIC_RELAXED, __HIP_MEMORY_SCOPE_AGENT); }
__device__ __forceinline__ unsigned xb_add(unsigned* p, unsigned v) { return __hip_atomic_fetch_add(p, v, __ATOMIC_RELAXED, __HIP_MEMORY_SCOPE_AGENT); }
__device__ __forceinline__ unsigned xb_xcc_id() { return (unsigned)__builtin_amdgcn_s_getreg((3 << 11) | 20) & 0xFu; }
#define XB_SPIN(cond, bar) do { unsigned _sp = 0; while (cond) { __builtin_amdgcn_s_sleep(1); \
    if ((++_sp & 255u) == 0u) { if (xb_ld(&(bar)[XB_TMO])) break; if (_sp > XB_SPIN_CAP) { atomicAdd(&(bar)[XB_TMO], 1u); break; } } } } while (0)

struct XcdBarrier {
    unsigned* bar; unsigned x;
    volatile LAS unsigned* st;
};

__device__ __forceinline__ XcdBarrier xcd_barrier_post(unsigned* bar, volatile LAS unsigned* st) {
    XcdBarrier b; b.bar = bar; b.x = xb_xcc_id(); b.st = st;
    if (threadIdx.x == 0) (void)xb_add(&bar[XB_XCNT(b.x)], 1u);
    return b;
}
__device__ __forceinline__ void xcd_barrier_complete(unsigned* bar, unsigned x, unsigned& nloc, unsigned& nx) {
    const unsigned G = gridDim.x * gridDim.y * gridDim.z;
    unsigned sum, cnt, mine, sp = 0u;
    for (;;) {
        sum = 0u; cnt = 0u; mine = 0u;
#pragma unroll
        for (unsigned j = 0; j < 16; ++j) { const unsigned c = xb_ld(&bar[XB_XCNT(j)]); sum += c; cnt += (c > 0u) ? 1u : 0u; mine = (j == x) ? c : mine; }
        if (sum == G) break;
        __builtin_amdgcn_s_sleep(1);
        if ((++sp & 255u) == 0u) { if (xb_ld(&bar[XB_TMO])) break; if (sp > XB_SPIN_CAP) { atomicAdd(&bar[XB_TMO], 1u); break; } }
    }
    nloc = mine > 0u ? mine : 1u; nx = cnt > 0u ? cnt : 1u;
}

__device__ __forceinline__ void xcd_barrier(const XcdBarrier& b) {
    asm volatile("s_waitcnt vmcnt(0)" ::: "memory");
    __syncthreads();
    if (threadIdx.x == 0) {
        unsigned* bar = b.bar;
        __builtin_amdgcn_s_waitcnt(0);
        unsigned nloc = b.st[0], nx = b.st[1];
        if (nloc == 0u) { xcd_barrier_complete(bar, b.x, nloc, nx); b.st[0] = nloc; b.st[1] = nx; }
        const unsigned old = xb_add(&bar[XB_XSUB(b.x)], 1u);
        const unsigned gen = old / nloc;
        if (old + 1u == (gen + 1u) * nloc) {
            __builtin_amdgcn_fence(__ATOMIC_RELEASE, "agent");
            asm volatile("s_waitcnt vmcnt(0)" ::: "memory");
            const unsigned og = xb_add(&bar[XB_TOP], 1u);
            const unsigned tg = og / nx;
            if (og + 1u == (tg + 1u) * nx) xb_add(&bar[XB_TOPGEN], 1u);
            else XB_SPIN(xb_ld(&bar[XB_TOPGEN]) == tg, bar);
            __builtin_amdgcn_fence(__ATOMIC_ACQUIRE, "agent");
            xb_add(&bar[XB_XGEN(b.x)], 1u);
            asm volatile("s_waitcnt vmcnt(0)" ::: "memory");
        } else {
            XB_SPIN(xb_ld(&bar[XB_XGEN(b.x)]) == gen, bar);
            __builtin_amdgcn_fence(__ATOMIC_ACQUIRE, "agent");
            asm volatile("s_waitcnt vmcnt(0)" ::: "memory");
        }
    }
    __syncthreads();
}

__device__ __forceinline__ void rms_row_bf16(const float* src, const float* g, bf16_t* dst, int lane) {
    f32x4 v[4]; float s = 0.f;
#pragma unroll
    for (int j = 0; j < 4; ++j) { v[j] = ((const f32x4*)src)[lane + 64 * j]; s += (v[j][0] * v[j][0] + v[j][1] * v[j][1]) + (v[j][2] * v[j][2] + v[j][3] * v[j][3]); }
    const float rs = 1.0f / sqrtf(wave_sum(s) * (1.0f / 1024.0f) + 1e-6f);
#pragma unroll
    for (int j = 0; j < 4; ++j) { const f32x4 gv = ((const f32x4*)g)[lane + 64 * j]; st4bf(dst + 4 * (lane + 64 * j), v[j] * rs * gv); }
}
__device__ __forceinline__ void tr_item(const float* W, int K, int N, bf16_t* WT, int kb, int n0, int row_base, LAS float* scr, int lane) {
    const int k0 = 64 * kb;
#pragma unroll 8
    for (int i = 0; i < 32; ++i) { const int kk = 2 * i + (lane >> 5); scr[kk * 33 + (lane & 31)] = W[(size_t)(k0 + kk) * N + n0 + (lane & 31)]; }
    asm volatile("s_waitcnt lgkmcnt(0)" ::: "memory");
    const int c = lane & 7;
#pragma unroll
    for (int j = 0; j < 4; ++j) { const int n = (lane >> 3) + 8 * j; const LAS float* sp = scr + (8 * c) * 33 + n;
        u32x4 o; o.x = cvt_pk_bf16(sp[0 * 33], sp[1 * 33]); o.y = cvt_pk_bf16(sp[2 * 33], sp[3 * 33]); o.z = cvt_pk_bf16(sp[4 * 33], sp[5 * 33]); o.w = cvt_pk_bf16(sp[6 * 33], sp[7 * 33]);
        *(u32x4*)(WT + (size_t)(row_base + n) * K + k0 + 8 * c) = o; }
    asm volatile("s_waitcnt lgkmcnt(0)" ::: "memory");
}

__device__ __forceinline__ void prep_phase(int s, int gw, int NGW, int lane, const bf16_t* cols, const bf16_t* carry,
        const float* mu, const float* w0, const float* a0, const float* k_k, const float* k_a, const float* r_k,
        const bf16_t* w2T, const bf16_t* a2T, bf16_t* PR, bf16_t* PK, bf16_t* PA, bf16_t* PB, bf16_t* PV, float* PW, float* bonus, bf16_t* ASG) {
    const int fr = lane & 15, fq = lane >> 4;
    for (int item = gw; item < (MS / 16) * 4; item += NGW) {
        const int tile = item >> 2, hg4 = item & 3;
        const int lt = tile * 16 + fr, b = lt / TS, tl = lt % TS;
        const bf16_t* crow = cols + (size_t)lt * CL;
        const bf16_t* prow = tl > 0 ? crow - CL : carry + ((s & 1) * 4 + b) * CARRY_LD;
        bf16x8 Aw[2], Aa[2];
#pragma unroll
        for (int ks = 0; ks < 2; ++ks) {
            { const int c = C_WLO + ks * 32 + fq * 8; float cur[8], prv[8], t[8]; ld8bf(crow + c, cur); ld8bf(prow + c, prv);
              const f32x4 m0 = *(const f32x4*)(mu + c), m1 = *(const f32x4*)(mu + c + 4);
#pragma unroll
              for (int e = 0; e < 8; ++e) { const float mm = e < 4 ? m0[e & 3] : m1[e & 3]; t[e] = tanh_fast(cur[e] + mm * (prv[e] - cur[e])); }
              Aw[ks] = pack8(t); }
            { const int c = C_ALO + ks * 32 + fq * 8; float cur[8], prv[8], t[8]; ld8bf(crow + c, cur); ld8bf(prow + c, prv);
              const f32x4 m0 = *(const f32x4*)(mu + c), m1 = *(const f32x4*)(mu + c + 4);
#pragma unroll
              for (int e = 0; e < 8; ++e) { const float mm = e < 4 ? m0[e & 3] : m1[e & 3]; t[e] = cur[e] + mm * (prv[e] - cur[e]); }
              Aa[ks] = pack8(t); }
        }
        if (hg4 == 0) {
#pragma unroll
            for (int ks = 0; ks < 5; ++ks) { const int c = C_GLO + ks * 32 + fq * 8; float cur[8], prv[8], t[8]; ld8bf(crow + c, cur); ld8bf(prow + c, prv);
                const f32x4 m0 = *(const f32x4*)(mu + c), m1 = *(const f32x4*)(mu + c + 4);
#pragma unroll
                for (int e = 0; e < 8; ++e) { const float mm = e < 4 ? m0[e & 3] : m1[e & 3]; t[e] = fast_sigmoid(cur[e] + mm * (prv[e] - cur[e])); }
                *(bf16x8*)(ASG + (size_t)lt * 256 + ks * 32 + fq * 8) = pack8(t); }
#pragma unroll
            for (int ks = 5; ks < 8; ++ks) *(u32x4*)(ASG + (size_t)lt * 256 + ks * 32 + fq * 8) = (u32x4){0u, 0u, 0u, 0u};
        }
#pragma unroll 1
        for (int hh = 0; hh < 4; ++hh) {
            const int h = hg4 * 4 + hh;
            f32x4 aw[4], aa[4];
#pragma unroll
            for (int nt = 0; nt < 4; ++nt) { aw[nt] = (f32x4){0.f, 0.f, 0.f, 0.f}; aa[nt] = (f32x4){0.f, 0.f, 0.f, 0.f};
                const int n = h * 64 + nt * 16 + fr;
#pragma unroll
                for (int ks = 0; ks < 2; ++ks) { const bf16x8 bw = *(const bf16x8*)(w2T + n * 64 + ks * 32 + fq * 8); aw[nt] = MFMA16(bw, Aw[ks], aw[nt]);
                    const bf16x8 ba = *(const bf16x8*)(a2T + n * 64 + ks * 32 + fq * 8); aa[nt] = MFMA16(ba, Aa[ks], aa[nt]); } }
            f32x4 kkv[4], av[4]; float ssq = 0.f, bon = 0.f;
#pragma unroll
            for (int nt = 0; nt < 4; ++nt) {
                const int c = h * 64 + nt * 16 + 4 * fq; const size_t o = ((size_t)(b * 16 + h) * TS + tl) * 64 + nt * 16 + 4 * fq;
                const f32x4 rc = ld4bf(crow + C_R + c), rp = ld4bf(prow + C_R + c), kc = ld4bf(crow + C_K + c), kp = ld4bf(prow + C_K + c), vc = ld4bf(crow + C_V + c), vp = ld4bf(prow + C_V + c);
                const f32x4 r = rc + *(const f32x4*)(mu + C_R + c) * (rp - rc), k = kc + *(const f32x4*)(mu + C_K + c) * (kp - kc), v = vc + *(const f32x4*)(mu + C_V + c) * (vp - vc);
                const f32x4 w0v = *(const f32x4*)(w0 + c), a0v = *(const f32x4*)(a0 + c), kkp = *(const f32x4*)(k_k + c), kap = *(const f32x4*)(k_a + c), rkp = *(const f32x4*)(r_k + c);
                f32x4 wv, a, kk, kmod;
#pragma unroll
                for (int j = 0; j < 4; ++j) {
                    const float z = -(w0v[j] + aw[nt][j]);
                    const float sp = fmaxf(z, 0.f) + __logf(1.0f + __expf(-fabsf(z)));
                    wv[j] = __expf(-__expf(-sp - 0.5f));
                    a[j] = fast_sigmoid(a0v[j] + aa[nt][j]);
                    kk[j] = k[j] * kkp[j]; kmod[j] = k[j] * (1.0f + (a[j] - 1.0f) * kap[j]);
                    ssq += kk[j] * kk[j]; bon += r[j] * kmod[j] * rkp[j];
                }
                kkv[nt] = kk; av[nt] = a;
                st4bf(PR + o, r); st4bf(PK + o, kmod); st4bf(PV + o, v); *(f32x4*)(PW + o) = wv;
            }
            ssq = fq_sum(ssq); bon = fq_sum(bon);
            const float rs = 1.0f / sqrtf(fmaxf(ssq, 1e-24f));
#pragma unroll
            for (int nt = 0; nt < 4; ++nt) { const size_t o = ((size_t)(b * 16 + h) * TS + tl) * 64 + nt * 16 + 4 * fq;
                const f32x4 kn = kkv[nt] * rs; st4bf(PA + o, -kn); st4bf(PB + o, kn * av[nt]); }
            if (fq == 0) bonus[lt * 16 + h] = bon;
        }
    }
}

__device__ __forceinline__ void post_phase(int s, int gw, int NGW, int lane, const bf16_t* cols, const bf16_t* carry, const float* mu, const bf16_t* gate,
        const float* ln_w, const float* ln_b, const float* hg_g, const float* oraw, const float* hgo, const bf16_t* PV, const float* bonus, bf16_t* merged) {
    const int fr = lane & 15, fq = lane >> 4;
    for (int item = gw; item < (MS / 16) * 4; item += NGW) {
        const int tile = item >> 2, q4 = item & 3;
        const int lt = tile * 16 + fr, b = lt / TS, tl = lt % TS;
        const size_t gt = (size_t)b * SEQ + s * TS + tl;
        const bf16_t* crow = cols + (size_t)lt * CL;
        const bf16_t* prow = tl > 0 ? crow - CL : carry + ((s & 1) * 4 + b) * CARRY_LD;
#pragma unroll 1
        for (int hgh = 0; hgh < 2; ++hgh) {
            const int h8 = q4 * 2 + hgh;
            f32x4 ho[8]; float ss = 0.f;
#pragma unroll
            for (int n8 = 0; n8 < 8; ++n8) { ho[n8] = *(const f32x4*)(hgo + ((size_t)((b * 8 + h8) * 8 + n8) * TS + tl) * 16 + 4 * fq); ss += (ho[n8][0] * ho[n8][0] + ho[n8][1] * ho[n8][1]) + (ho[n8][2] * ho[n8][2] + ho[n8][3] * ho[n8][3]); }
            ss = fq_sum(ss);
            const float rsh = 1.0f / sqrtf(ss * (1.0f / 128.0f) + 1e-6f);
#pragma unroll
            for (int rwh = 0; rwh < 2; ++rwh) {
                const int h = q4 * 4 + hgh * 2 + rwh;
                f32x4 ag[4], o[4]; float sm = 0.f;
#pragma unroll
                for (int nt = 0; nt < 4; ++nt) { ag[nt] = ld4bf(gate + (size_t)lt * 1024 + h * 64 + nt * 16 + 4 * fq);
                    o[nt] = *(const f32x4*)(oraw + ((size_t)((b * 16 + h) * 4 + nt) * TS + tl) * 16 + 4 * fq); sm += (o[nt][0] + o[nt][1]) + (o[nt][2] + o[nt][3]); }
                const float mean = fq_sum(sm) * (1.0f / 64.0f); float vq = 0.f;
#pragma unroll
                for (int nt = 0; nt < 4; ++nt) { o[nt] = o[nt] - mean; vq += (o[nt][0] * o[nt][0] + o[nt][1] * o[nt][1]) + (o[nt][2] * o[nt][2] + o[nt][3] * o[nt][3]); }
                const float rstd = 1.0f / sqrtf(fq_sum(vq) * (1.0f / 64.0f) + 64e-5f);
#ifdef MK_NO_BONUS
                const float bon = 0.f;
#else
                const float bon = bonus[lt * 16 + h];
#endif
#pragma unroll
                for (int nt = 0; nt < 4; ++nt) {
                    const int c = h * 64 + nt * 16 + 4 * fq;
                    const f32x4 lw = *(const f32x4*)(ln_w + c), lb = *(const f32x4*)(ln_b + c), v = ld4bf(PV + ((size_t)(b * 16 + h) * TS + tl) * 64 + nt * 16 + 4 * fq);
                    const f32x4 ya = (o[nt] * rstd * lw + lb + v * bon) * ag[nt];
                    const f32x4 ng = *(const f32x4*)(hg_g + (c & 127)), gh = ld4bf(crow + C_HG + c), gar = ld4bf(crow + C_GA + c), gbr = ld4bf(crow + C_GB + c);
                    const f32x4 hv = ho[rwh * 4 + nt] * rsh * ng;
                    f32x4 m;
#pragma unroll
                    for (int j = 0; j < 4; ++j) {
#if defined(MK_ZERO_YA)
                        m[j] = fast_sigmoid(gbr[j]) * (hv[j] * fast_silu(gh[j]));
#elif defined(MK_ZERO_YB)
                        m[j] = fast_sigmoid(gar[j]) * ya[j];
#else
                        m[j] = gar[j] * ya[j] + gbr[j] * (hv[j] * gh[j]);
#endif
                    }
                    st4bf(merged + gt * 1024 + c, m);
                }
            }
        }
    }
}

constexpr int RWB = 45056;
#define SCAN_BAR_L() do { asm volatile("s_waitcnt vmcnt(0) lgkmcnt(0)" ::: "memory"); __builtin_amdgcn_s_barrier(); asm volatile("" ::: "memory"); } while (0)
#define SCAN_BAR_S() do { asm volatile("s_waitcnt lgkmcnt(0)" ::: "memory"); __builtin_amdgcn_s_barrier(); asm volatile("" ::: "memory"); } while (0)
__device__ __forceinline__ void rw_load(LAS unsigned char* bp, int lt2, size_t ltok0, int h, int rg, const bf16_t* PA, const float* PW, const bf16_t* PB, const bf16_t* PK, const bf16_t* PR, const bf16_t* PV) {
    const int tok = lt2 >> 3, c8 = (lt2 & 7) * 8; const size_t base = (ltok0 + tok) * 1024 + h * 64 + c8;
    const u32x4 ra = *(const u32x4*)(PA + base), rb = *(const u32x4*)(PB + base), rk = *(const u32x4*)(PK + base), rr = *(const u32x4*)(PR + base);
    const f32x4 w0 = *(const f32x4*)(PW + base), w1 = *(const f32x4*)(PW + base + 4);
    const unsigned rv = *(const unsigned*)(PV + (ltok0 + tok) * 1024 + h * 64 + rg * 16 + (lt2 & 7) * 2);
    const int off = (tok * 64 + c8) * 4;
#define RW_PUT(arr, u) do { *(LAS f32x4*)(bp + (arr) * 8192 + off) = (f32x4){bflo(u.x), bfhi(u.x), bflo(u.y), bfhi(u.y)}; *(LAS f32x4*)(bp + (arr) * 8192 + off + 16) = (f32x4){bflo(u.z), bfhi(u.z), bflo(u.w), bfhi(u.w)}; } while (0)
    RW_PUT(0, ra); RW_PUT(2, rb); RW_PUT(3, rk); RW_PUT(4, rr);
#undef RW_PUT
    *(LAS f32x4*)(bp + 8192 + off) = w0; *(LAS f32x4*)(bp + 8192 + off + 16) = w1;
    *(LAS f32x2v*)(bp + 40960 + (tok * 16 + (lt2 & 7) * 2) * 4) = (f32x2v){bflo(rv), bfhi(rv)};
}
__device__ __forceinline__ void y_drain(const LAS unsigned char* ybase, int lt2, float* dst) { *(f32x2v*)(dst + lt2 * 2) = *(const LAS f32x2v*)(ybase + lt2 * 8); }
__device__ __forceinline__ void rwkv_scan(int s, int bid, int G, int tid, int lane, int wave, LAS unsigned char* lds,
        const bf16_t* PA, const float* PW, const bf16_t* PB, const bf16_t* PK, const bf16_t* PR, const bf16_t* PV, float* oraw, float* state, bool save) {
    constexpr int NBLK = TS / 32;
    const int rowl = lane >> 4, j = lane & 15, row = (wave & 3) * 4 + rowl;
    for (int it = bid; it < 256; it += G) {
        const int b = it >> 6, h = (it >> 2) & 15, rg = it & 3;
        const size_t tok0 = (size_t)b * TS;
        float* stp = state + ((size_t)((b * 16 + h) * 64 + rg * 16 + row) * 64 + 4 * j);
        float* obase = oraw + (size_t)it * TS * 16;
        f32x4 st = (f32x4){0.f, 0.f, 0.f, 0.f};
        if (wave < 4 && s > 0) st = *(const f32x4*)stp;
        if (wave >= 4) { rw_load(lds, tid - 256, tok0, h, rg, PA, PW, PB, PK, PR, PV); SCAN_BAR_L(); } else { __builtin_amdgcn_s_setprio(2); asm volatile("s_waitcnt vmcnt(0)" ::: "memory"); SCAN_BAR_S(); }
#pragma unroll 1
        for (int blk = 0; blk < NBLK; ++blk) {
            if (wave >= 4) {
                if (blk > 0) y_drain(lds + ((blk - 1) & 1) * RWB + 43008, tid - 256, obase + (size_t)(blk - 1) * 512);
                if (blk + 1 < NBLK) rw_load(lds + ((blk + 1) & 1) * RWB, tid - 256, tok0 + (blk + 1) * 32, h, rg, PA, PW, PB, PK, PR, PV);
                SCAN_BAR_L();
            } else {
                const LAS unsigned char* bp = lds + (blk & 1) * RWB;
                const LAS unsigned char* p4 = bp + 16 * j; const LAS unsigned char* pv = bp + 40960 + row * 4; LAS unsigned char* py = (LAS unsigned char*)bp + 43008 + row * 4;
                f32x4 a4 = *(const LAS f32x4*)(p4), w4 = *(const LAS f32x4*)(p4 + 8192), b4 = *(const LAS f32x4*)(p4 + 16384), k4 = *(const LAS f32x4*)(p4 + 24576), r4 = *(const LAS f32x4*)(p4 + 32768);
                float vv = *(const LAS float*)(pv);
                float sa = (st[0] * a4[0] + st[1] * a4[1]) + (st[2] * a4[2] + st[3] * a4[3]);
                sa = allreduce16(sa);
#pragma unroll
                for (int t = 0; t < 32; ++t) {
                    f32x4 na = a4, nw = w4, nb = b4, nk = k4, nr = r4; float nv = vv;
                    if (t < 31) { const int o = (t + 1) * 256; na = *(const LAS f32x4*)(p4 + o); nw = *(const LAS f32x4*)(p4 + 8192 + o); nb = *(const LAS f32x4*)(p4 + 16384 + o); nk = *(const LAS f32x4*)(p4 + 24576 + o); nr = *(const LAS f32x4*)(p4 + 32768 + o); nv = *(const LAS float*)(pv + (t + 1) * 64); }
                    st = st * w4 + (b4 * sa + k4 * vv);
                    float y = (st[0] * r4[0] + st[1] * r4[1]) + (st[2] * r4[2] + st[3] * r4[3]);
                    float sn = (st[0] * na[0] + st[1] * na[1]) + (st[2] * na[2] + st[3] * na[3]);
                    allreduce16x2(sn, y);
                    if (j == 0) *(LAS float*)(py + t * 64) = y;
                    sa = sn; a4 = na; w4 = nw; b4 = nb; k4 = nk; r4 = nr; vv = nv;
                }
                SCAN_BAR_S();
            }
        }
        if (wave >= 4) { y_drain(lds + ((NBLK - 1) & 1) * RWB + 43008, tid - 256, obase + (size_t)(NBLK - 1) * 512); }
        else { __builtin_amdgcn_s_setprio(0); if (save) *(f32x4*)stp = st; }
    }
}

__device__ __forceinline__ void rwkv_scan_naive(int s, int gw, int NGW, int lane, int wave, LAS unsigned char* lds,
        const bf16_t* PA, const float* PW, const bf16_t* PB, const bf16_t* PK, const bf16_t* PR, const bf16_t* PV, float* oraw, float* state) {
    LAS float* slab = (LAS float*)(lds + wave * 2048);
    for (int it = gw; it < 64; it += NGW) {
        const int b = it >> 4, h = it & 15;
        float st[64];
        float* stp = state + (size_t)((b * 16 + h) * 64 + lane) * 64;
#pragma unroll
        for (int k = 0; k < 64; ++k) st[k] = (s > 0) ? stp[k] : 0.f;
        for (int tl = 0; tl < TS; ++tl) {
            const size_t base = ((size_t)b * TS + tl) * 1024 + h * 64 + lane;
            slab[lane] = bflo((unsigned)PA[base]); slab[64 + lane] = PW[base]; slab[128 + lane] = bflo((unsigned)PB[base]); slab[192 + lane] = bflo((unsigned)PK[base]); slab[256 + lane] = bflo((unsigned)PR[base]);
            const float vv = bflo((unsigned)PV[base]);
            asm volatile("s_waitcnt lgkmcnt(0)" ::: "memory");
            float sa = 0.f;
#pragma unroll
            for (int k = 0; k < 64; ++k) sa += st[k] * slab[k];
            float y = 0.f;
#pragma unroll
            for (int k = 0; k < 64; ++k) { st[k] = st[k] * slab[64 + k] + (sa * slab[128 + k] + vv * slab[192 + k]); y += st[k] * slab[256 + k]; }
            asm volatile("s_waitcnt lgkmcnt(0)" ::: "memory");
            oraw[((size_t)(it * 4 + (lane >> 4)) * TS + tl) * 16 + (lane & 15)] = y;
        }
#pragma unroll
        for (int k = 0; k < 64; ++k) stp[k] = st[k];
    }
}
constexpr int HGB = 53248;
__device__ __forceinline__ void hg_load(LAS unsigned char* bp, int lt2, size_t ltok0, int h8, int rg, const bf16_t* cols, const float* lbv) {
    const int tok = lt2 >> 3, c16 = (lt2 & 7) * 16; const bf16_t* crow = cols + (ltok0 + tok) * CL;
    float q[16], f[16];
    { float t[8]; ld8bf(crow + C_HQ + h8 * 128 + c16, t);
#pragma unroll
      for (int e = 0; e < 8; ++e) q[e] = t[e];
      ld8bf(crow + C_HQ + h8 * 128 + c16 + 8, t);
#pragma unroll
      for (int e = 0; e < 8; ++e) q[8 + e] = t[e];
      ld8bf(crow + C_HF + h8 * 128 + c16, t);
#pragma unroll
      for (int e = 0; e < 8; ++e) f[e] = t[e];
      ld8bf(crow + C_HF + h8 * 128 + c16 + 8, t);
#pragma unroll
      for (int e = 0; e < 8; ++e) f[8 + e] = t[e]; }
    const unsigned rv = *(const unsigned*)(crow + C_HI + h8 * 128 + rg * 16 + (lt2 & 7) * 2);
    const int off = (tok * 128 + c16) * 4;
#pragma unroll
    for (int g = 0; g < 4; ++g) { const f32x4 lb = *(const f32x4*)(lbv + h8 * 128 + c16 + 4 * g); f32x4 fv, kv, qv;
#pragma unroll
        for (int e = 0; e < 4; ++e) { fv[e] = lb[e] + (1.0f - lb[e]) * fast_sigmoid(f[4 * g + e]); kv[e] = 1.0f - fv[e]; qv[e] = fast_silu(q[4 * g + e]); }
        *(LAS f32x4*)(bp + off + 16 * g) = fv; *(LAS f32x4*)(bp + 16384 + off + 16 * g) = kv; *(LAS f32x4*)(bp + 32768 + off + 16 * g) = qv; }
    *(LAS f32x2v*)(bp + 49152 + (tok * 16 + (lt2 & 7) * 2) * 4) = (f32x2v){bflo(rv), bfhi(rv)};
}
__device__ __forceinline__ void hgrn_scan(int s, int bid, int G, int tid, int lane, int wave, LAS unsigned char* lds, const bf16_t* cols, const float* lbv, float* hgo, float* state, bool save) {
    constexpr int NBLK = TS / 32;
    const int rowl = lane >> 4, j = lane & 15, row = (wave & 3) * 4 + rowl;
    for (int it = bid; it < 256; it += G) {
        const int b = it >> 6, h8 = (it >> 3) & 7, rg = it & 7;
        const size_t tok0 = (size_t)b * TS;
        float* stp = state + ((size_t)((b * 8 + h8) * 128 + rg * 16 + row) * 128 + 4 * j);
        float* obase = hgo + (size_t)it * TS * 16;
        f32x4 s0 = (f32x4){0.f, 0.f, 0.f, 0.f}, s1 = s0;
        if (wave < 4 && s > 0) { s0 = *(const f32x4*)stp; s1 = *(const f32x4*)(stp + 64); }
        if (wave >= 4) { hg_load(lds, tid - 256, tok0, h8, rg, cols, lbv); SCAN_BAR_L(); } else { __builtin_amdgcn_s_setprio(2); asm volatile("s_waitcnt vmcnt(0)" ::: "memory"); SCAN_BAR_S(); }
#pragma unroll 1
        for (int blk = 0; blk < NBLK; ++blk) {
            if (wave >= 4) {
                if (blk > 0) y_drain(lds + ((blk - 1) & 1) * HGB + 51200, tid - 256, obase + (size_t)(blk - 1) * 512);
                if (blk + 1 < NBLK) hg_load(lds + ((blk + 1) & 1) * HGB, tid - 256, tok0 + (blk + 1) * 32, h8, rg, cols, lbv);
                SCAN_BAR_L();
            } else {
                const LAS unsigned char* bp = lds + (blk & 1) * HGB;
                const LAS unsigned char* p4 = bp + 16 * j; const LAS unsigned char* pv = bp + 49152 + row * 4; LAS unsigned char* py = (LAS unsigned char*)bp + 51200 + row * 4;
                f32x4 f0 = *(const LAS f32x4*)(p4), f1 = *(const LAS f32x4*)(p4 + 256), k0 = *(const LAS f32x4*)(p4 + 16384), k1 = *(const LAS f32x4*)(p4 + 16384 + 256), q0 = *(const LAS f32x4*)(p4 + 32768), q1 = *(const LAS f32x4*)(p4 + 32768 + 256);
                float iv = *(const LAS float*)(pv); float yprev = 0.f;
#pragma unroll
                for (int t = 0; t < 32; ++t) {
                    f32x4 nf0 = f0, nf1 = f1, nk0 = k0, nk1 = k1, nq0 = q0, nq1 = q1; float niv = iv;
                    if (t < 31) { const int o = (t + 1) * 512; nf0 = *(const LAS f32x4*)(p4 + o); nf1 = *(const LAS f32x4*)(p4 + 256 + o); nk0 = *(const LAS f32x4*)(p4 + 16384 + o); nk1 = *(const LAS f32x4*)(p4 + 16384 + 256 + o);
                                  nq0 = *(const LAS f32x4*)(p4 + 32768 + o); nq1 = *(const LAS f32x4*)(p4 + 32768 + 256 + o); niv = *(const LAS float*)(pv + (t + 1) * 64); }
                    s0 = s0 * f0 + k0 * iv; s1 = s1 * f1 + k1 * iv;
                    float y = ((s0[0] * q0[0] + s0[1] * q0[1]) + (s0[2] * q0[2] + s0[3] * q0[3])) + ((s1[0] * q1[0] + s1[1] * q1[1]) + (s1[2] * q1[2] + s1[3] * q1[3]));
                    if (t & 1) { allreduce16x2(yprev, y); if (j == 0) { *(LAS float*)(py + (t - 1) * 64) = yprev; *(LAS float*)(py + t * 64) = y; } }
                    yprev = y;
                    f0 = nf0; f1 = nf1; k0 = nk0; k1 = nk1; q0 = nq0; q1 = nq1; iv = niv;
                }
                SCAN_BAR_S();
            }
        }
        if (wave >= 4) { y_drain(lds + ((NBLK - 1) & 1) * HGB + 51200, tid - 256, obase + (size_t)(NBLK - 1) * 512); }
        else { __builtin_amdgcn_s_setprio(0); if (save) { *(f32x4*)stp = s0; *(f32x4*)(stp + 64) = s1; } }
    }
}


constexpr int FT = 16;
constexpr int F_RW = 0, F_RWV = 20480, F_RWY = 21504, F_HG = 22528, F_HGQ = 8192, F_HGI = F_HG + 16384, F_HGY = F_HG + 17408, FBUF = 40960;
__device__ __forceinline__ void fused_load(LAS unsigned char* bp, int lt2, size_t ltok0, int h, int rg, int h8, int rg8, const bf16_t* PA, const float* PW, const bf16_t* PB, const bf16_t* PK, const bf16_t* PR, const bf16_t* PV,
        const bf16_t* cols, const float* lbv) {
    if (lt2 < 128) {
        const int tok = lt2 >> 3, c8 = (lt2 & 7) * 8; const size_t base = (ltok0 + tok) * 1024 + h * 64 + c8;
        const u32x4 ra = *(const u32x4*)(PA + base), rb = *(const u32x4*)(PB + base), rk = *(const u32x4*)(PK + base), rr = *(const u32x4*)(PR + base);
        const f32x4 w0 = *(const f32x4*)(PW + base), w1 = *(const f32x4*)(PW + base + 4);
        const unsigned rv = *(const unsigned*)(PV + (ltok0 + tok) * 1024 + h * 64 + rg * 16 + (lt2 & 7) * 2);
        const int off = (tok * 64 + c8) * 4;
#define RW_PUT(arr, u) do { *(LAS f32x4*)(bp + (arr) * 4096 + off) = (f32x4){bflo(u.x), bfhi(u.x), bflo(u.y), bfhi(u.y)}; *(LAS f32x4*)(bp + (arr) * 4096 + off + 16) = (f32x4){bflo(u.z), bfhi(u.z), bflo(u.w), bfhi(u.w)}; } while (0)
        RW_PUT(0, ra); RW_PUT(2, rb); RW_PUT(3, rk); RW_PUT(4, rr);
#undef RW_PUT
        *(LAS f32x4*)(bp + 4096 + off) = w0; *(LAS f32x4*)(bp + 4096 + off + 16) = w1;
        *(LAS f32x2v*)(bp + F_RWV + (tok * 16 + (lt2 & 7) * 2) * 4) = (f32x2v){bflo(rv), bfhi(rv)};
    } else {
        const int l = lt2 - 128, tok = l >> 3, c16 = (l & 7) * 16; const bf16_t* crow = cols + (ltok0 + tok) * CL;
        float q[16], f[16];
        { float t[8]; ld8bf(crow + C_HQ + h8 * 128 + c16, t);
#pragma unroll
          for (int e = 0; e < 8; ++e) q[e] = t[e];
          ld8bf(crow + C_HQ + h8 * 128 + c16 + 8, t);
#pragma unroll
          for (int e = 0; e < 8; ++e) q[8 + e] = t[e];
          ld8bf(crow + C_HF + h8 * 128 + c16, t);
#pragma unroll
          for (int e = 0; e < 8; ++e) f[e] = t[e];
          ld8bf(crow + C_HF + h8 * 128 + c16 + 8, t);
#pragma unroll
          for (int e = 0; e < 8; ++e) f[8 + e] = t[e]; }
        const unsigned rv = *(const unsigned*)(crow + C_HI + h8 * 128 + rg8 * 16 + (l & 7) * 2);
        LAS unsigned char* hp = bp + F_HG; const int off = (tok * 128 + c16) * 4;
#pragma unroll
        for (int g = 0; g < 4; ++g) { const f32x4 lb = *(const f32x4*)(lbv + h8 * 128 + c16 + 4 * g); f32x4 fv, qv;
#pragma unroll
            for (int e = 0; e < 4; ++e) { fv[e] = lb[e] + (1.0f - lb[e]) * f[4 * g + e]; qv[e] = q[4 * g + e]; }
            *(LAS f32x4*)(hp + off + 16 * g) = fv; *(LAS f32x4*)(hp + F_HGQ + off + 16 * g) = qv; }
        *(LAS f32x2v*)(bp + F_HGI + (tok * 16 + (l & 7) * 2) * 4) = (f32x2v){bflo(rv), bfhi(rv)};
    }
}
__device__ __forceinline__ void fused_drain(const LAS unsigned char* bp, int lt2, float* orw, float* ohg) {
    if (lt2 < 128) *(f32x2v*)(orw + lt2 * 2) = *(const LAS f32x2v*)(bp + F_RWY + lt2 * 8);
    else *(f32x2v*)(ohg + (lt2 - 128) * 2) = *(const LAS f32x2v*)(bp + F_HGY + (lt2 - 128) * 8);
}
__device__ __forceinline__ void fused_scan(int s, int bid, int G, int tid, int lane, int wave, LAS unsigned char* lds,
        const bf16_t* PA, const float* PW, const bf16_t* PB, const bf16_t* PK, const bf16_t* PR, const bf16_t* PV, const bf16_t* cols, const float* lbv,
        float* oraw, float* hgo, float* rwstate, float* hgstate, bool save) {
    constexpr int NBLK = TS / FT;
    const int rowl = lane >> 4, j = lane & 15, row = (wave & 3) * 4 + rowl;
    for (int it = bid; it < 256; it += G) {
        const int b = it >> 6, h = (it >> 2) & 15, rg = it & 3, h8 = (it >> 3) & 7, rg8 = it & 7;
        const size_t tok0 = (size_t)b * TS;
        float* stp = rwstate + ((size_t)((b * 16 + h) * 64 + rg * 16 + row) * 64 + 4 * j);
        float* shp = hgstate + ((size_t)((b * 8 + h8) * 128 + rg8 * 16 + row) * 128 + 4 * j);
        float* orw = oraw + (size_t)it * TS * 16; float* ohg = hgo + (size_t)it * TS * 16;
        f32x4 st = (f32x4){0.f, 0.f, 0.f, 0.f}, s0 = st, s1 = st;
        if (wave < 4 && s > 0) { st = *(const f32x4*)stp; s0 = *(const f32x4*)shp; s1 = *(const f32x4*)(shp + 64); }
        if (wave >= 4) { fused_load(lds, tid - 256, tok0, h, rg, h8, rg8, PA, PW, PB, PK, PR, PV, cols, lbv); SCAN_BAR_L(); } else { __builtin_amdgcn_s_setprio(2); asm volatile("s_waitcnt vmcnt(0)" ::: "memory"); SCAN_BAR_S(); }
#pragma unroll 1
        for (int blk = 0; blk < NBLK; ++blk) {
            if (wave >= 4) {
                if (blk > 0) fused_drain(lds + ((blk - 1) & 1) * FBUF, tid - 256, orw + (size_t)(blk - 1) * (FT * 16), ohg + (size_t)(blk - 1) * (FT * 16));
                if (blk + 1 < NBLK) fused_load(lds + ((blk + 1) & 1) * FBUF, tid - 256, tok0 + (blk + 1) * FT, h, rg, h8, rg8, PA, PW, PB, PK, PR, PV, cols, lbv);
                SCAN_BAR_L();
            } else {
                const LAS unsigned char* bp = lds + (blk & 1) * FBUF;
                const LAS unsigned char* p4 = bp + 16 * j; const LAS unsigned char* pv = bp + F_RWV + row * 4; LAS unsigned char* py = (LAS unsigned char*)bp + F_RWY + row * 4;
                const LAS unsigned char* g4 = bp + F_HG + 16 * j; const LAS unsigned char* gi = bp + F_HGI + row * 4; LAS unsigned char* gy = (LAS unsigned char*)bp + F_HGY + row * 4;
                f32x4 a4 = *(const LAS f32x4*)(p4), w4 = *(const LAS f32x4*)(p4 + 4096), b4 = *(const LAS f32x4*)(p4 + 8192), k4 = *(const LAS f32x4*)(p4 + 12288), r4 = *(const LAS f32x4*)(p4 + 16384);
                float vv = *(const LAS float*)(pv);
                f32x4 f0 = *(const LAS f32x4*)(g4), f1 = *(const LAS f32x4*)(g4 + 256), q0 = *(const LAS f32x4*)(g4 + F_HGQ), q1 = *(const LAS f32x4*)(g4 + F_HGQ + 256);
                float iv = *(const LAS float*)(gi);
                float sa = (st[0] * a4[0] + st[1] * a4[1]) + (st[2] * a4[2] + st[3] * a4[3]);
                sa = allreduce16(sa);
#pragma unroll
                for (int t = 0; t < FT; ++t) {
                    f32x4 na = a4, nw = w4, nb = b4, nk = k4, nr = r4; float nv = vv;
                    f32x4 nf0 = f0, nf1 = f1, nq0 = q0, nq1 = q1; float niv = iv;
                    if (t < FT - 1) { const int o = (t + 1) * 256; na = *(const LAS f32x4*)(p4 + o); nw = *(const LAS f32x4*)(p4 + 4096 + o); nb = *(const LAS f32x4*)(p4 + 8192 + o); nk = *(const LAS f32x4*)(p4 + 12288 + o); nr = *(const LAS f32x4*)(p4 + 16384 + o); nv = *(const LAS float*)(pv + (t + 1) * 64);
                        const int o2 = (t + 1) * 512; nf0 = *(const LAS f32x4*)(g4 + o2); nf1 = *(const LAS f32x4*)(g4 + 256 + o2);
                        nq0 = *(const LAS f32x4*)(g4 + F_HGQ + o2); nq1 = *(const LAS f32x4*)(g4 + F_HGQ + 256 + o2); niv = *(const LAS float*)(gi + (t + 1) * 64); }
                    st = st * w4 + (b4 * sa + k4 * vv);
                    s0 = (s0 - iv) * f0 + iv; s1 = (s1 - iv) * f1 + iv;
                    float y = (st[0] * r4[0] + st[1] * r4[1]) + (st[2] * r4[2] + st[3] * r4[3]);
                    float sn = (st[0] * na[0] + st[1] * na[1]) + (st[2] * na[2] + st[3] * na[3]);
                    float yh = ((s0[0] * q0[0] + s0[1] * q0[1]) + (s0[2] * q0[2] + s0[3] * q0[3])) + ((s1[0] * q1[0] + s1[1] * q1[1]) + (s1[2] * q1[2] + s1[3] * q1[3]));
                    sn = dpp_add<0xB1>(sn); y = dpp_add<0xB1>(y); yh = dpp_add<0xB1>(yh); sn = dpp_add<0x4E>(sn); y = dpp_add<0x4E>(y); yh = dpp_add<0x4E>(yh);
                    sn = dpp_add<0x141>(sn); y = dpp_add<0x141>(y); yh = dpp_add<0x141>(yh); sn = dpp_add<0x140>(sn); y = dpp_add<0x140>(y); yh = dpp_add<0x140>(yh);
                    if (j == 0) { *(LAS float*)(py + t * 64) = y; *(LAS float*)(gy + t * 64) = yh; }
                    sa = sn; a4 = na; w4 = nw; b4 = nb; k4 = nk; r4 = nr; vv = nv;
                    f0 = nf0; f1 = nf1; q0 = nq0; q1 = nq1; iv = niv;
                }
                SCAN_BAR_S();
            }
        }
        if (wave >= 4) fused_drain(lds + ((NBLK - 1) & 1) * FBUF, tid - 256, orw + (size_t)(NBLK - 1) * (FT * 16), ohg + (size_t)(NBLK - 1) * (FT * 16));
        else { __builtin_amdgcn_s_setprio(0); if (save) { *(f32x4*)stp = st; *(f32x4*)shp = s0; *(f32x4*)(shp + 64) = s1; } }
    }
}


constexpr int ST = 16;
constexpr int S_RWV = 20480, S_RWY = 22528, S_RWB = 30720;
constexpr int S_HGQ = 8192, S_HGI = 16384, S_HGY = 18432, S_HGB = 26624;
__device__ __forceinline__ void s_rw_load(LAS unsigned char* bp, int lt2, size_t htok0  , int hf, const bf16_t* PA, const float* PW, const bf16_t* PB, const bf16_t* PK, const bf16_t* PR, const bf16_t* PV) {
    const int tok = lt2 >> 4, c4 = (lt2 & 15) * 4; const size_t base = (htok0 + tok) * 64 + c4;
    const f32x4 va = ld4bf(PA + base), vb = ld4bf(PB + base), vk = ld4bf(PK + base), vr = ld4bf(PR + base), vw = *(const f32x4*)(PW + base);
    const unsigned rv = *(const unsigned*)(PV + (htok0 + tok) * 64 + hf * 32 + (lt2 & 15) * 2);
    const int off = (tok * 64 + c4) * 4;
    *(LAS f32x4*)(bp + off) = va; *(LAS f32x4*)(bp + 4096 + off) = vw; *(LAS f32x4*)(bp + 8192 + off) = vb; *(LAS f32x4*)(bp + 12288 + off) = vk; *(LAS f32x4*)(bp + 16384 + off) = vr;
    *(LAS f32x2v*)(bp + S_RWV + (tok * 32 + (lt2 & 15) * 2) * 4) = (f32x2v){bflo(rv), bfhi(rv)};
}
__device__ __forceinline__ void s_hg_load(LAS unsigned char* bp, int lt2, size_t ltok0, int h8, int q4, const bf16_t* cols, const float* lbv) {
    const int tok = lt2 >> 4, c8 = (lt2 & 15) * 8; const bf16_t* crow = cols + (ltok0 + tok) * CL;
    float q[8], f[8]; ld8bf(crow + C_HQ + h8 * 128 + c8, q); ld8bf(crow + C_HF + h8 * 128 + c8, f);
    const unsigned rv = *(const unsigned*)(crow + C_HI + h8 * 128 + q4 * 32 + (lt2 & 15) * 2);
    const f32x4 lb0 = *(const f32x4*)(lbv + h8 * 128 + c8), lb1 = *(const f32x4*)(lbv + h8 * 128 + c8 + 4);
    const int off = (tok * 128 + c8) * 4;
    *(LAS f32x4*)(bp + off) = (f32x4){lb0[0] + (1.f - lb0[0]) * f[0], lb0[1] + (1.f - lb0[1]) * f[1], lb0[2] + (1.f - lb0[2]) * f[2], lb0[3] + (1.f - lb0[3]) * f[3]};
    *(LAS f32x4*)(bp + off + 16) = (f32x4){lb1[0] + (1.f - lb1[0]) * f[4], lb1[1] + (1.f - lb1[1]) * f[5], lb1[2] + (1.f - lb1[2]) * f[6], lb1[3] + (1.f - lb1[3]) * f[7]};
    *(LAS f32x4*)(bp + S_HGQ + off) = (f32x4){q[0], q[1], q[2], q[3]}; *(LAS f32x4*)(bp + S_HGQ + off + 16) = (f32x4){q[4], q[5], q[6], q[7]};
    *(LAS f32x2v*)(bp + S_HGI + (tok * 32 + (lt2 & 15) * 2) * 4) = (f32x2v){bflo(rv), bfhi(rv)};
}
__device__ __forceinline__ void s_drain(const LAS unsigned char* ybase, int lt2, float* obase  ) {
    const int t = lt2 >> 4, rp = (lt2 & 15) * 2;
    const f32x4 pa = *(const LAS f32x4*)(ybase + (t * 32 + rp) * 16), pb = *(const LAS f32x4*)(ybase + (t * 32 + rp) * 16 + 16);
    *(f32x2v*)(obase + (size_t)(rp >> 4) * (TS * 16) + t * 16 + (rp & 15)) = (f32x2v){(pa[0] + pa[1]) + (pa[2] + pa[3]), (pb[0] + pb[1]) + (pb[2] + pb[3])};
}
__device__ __forceinline__ float dot4(f32x4 a, f32x4 b) { return __builtin_fmaf(a[3], b[3], __builtin_fmaf(a[2], b[2], __builtin_fmaf(a[1], b[1], a[0] * b[0]))); }
__device__ __forceinline__ float dot4acc(f32x4 a, f32x4 b, float c) { return __builtin_fmaf(a[3], b[3], __builtin_fmaf(a[2], b[2], __builtin_fmaf(a[1], b[1], __builtin_fmaf(a[0], b[0], c)))); }
__device__ __forceinline__ void split_scan(int s, int bid, int G, int tid, int lane, int wave, LAS unsigned char* lds,
        const bf16_t* PA, const float* PW, const bf16_t* PB, const bf16_t* PK, const bf16_t* PR, const bf16_t* PV, const bf16_t* cols, const float* lbv,
        float* oraw, float* hgo, float* rwstate, float* hgstate, bool save) {
    constexpr int NBLK = TS / ST;
    const int rowl = lane >> 4, j = lane & 15, r0 = (wave & 3) * 8 + rowl, r1 = r0 + 4;
    for (int it = bid; it < 256; it += G) {
        if (it < 128) {
            const int b = it >> 5, h = (it >> 1) & 15, hf = it & 1;
            const size_t tok0 = (size_t)b * TS;
            float* sp0 = rwstate + ((size_t)((b * 16 + h) * 64 + hf * 32 + r0) * 64 + 4 * j); float* sp1 = sp0 + 4 * 64;
            float* og = oraw + (size_t)((b * 16 + h) * 4 + hf * 2) * TS * 16;
            f32x4 x0 = (f32x4){0.f, 0.f, 0.f, 0.f}, x1 = x0;
            if (wave < 4 && s > 0) { x0 = *(const f32x4*)sp0; x1 = *(const f32x4*)sp1; }
            if (wave >= 4) { s_rw_load(lds, tid - 256, (size_t)(b * 16 + h) * TS, hf, PA, PW, PB, PK, PR, PV); SCAN_BAR_L(); } else { __builtin_amdgcn_s_setprio(2); asm volatile("s_waitcnt vmcnt(0)" ::: "memory"); SCAN_BAR_S(); }
#pragma unroll 1
            for (int blk = 0; blk < NBLK; ++blk) {
                if (wave >= 4) {
                    if (blk > 0) s_drain(lds + ((blk - 1) & 1) * S_RWB + S_RWY, tid - 256, og + (size_t)(blk - 1) * (ST * 16));
                    if (blk + 1 < NBLK) s_rw_load(lds + ((blk + 1) & 1) * S_RWB, tid - 256, (size_t)(b * 16 + h) * TS + (blk + 1) * ST, hf, PA, PW, PB, PK, PR, PV);
                    SCAN_BAR_L();
                } else {
                    const LAS unsigned char* bp = lds + (blk & 1) * S_RWB;
                    const LAS unsigned char* p4 = bp + 16 * j; const LAS unsigned char* pv = bp + S_RWV + r0 * 4; LAS unsigned char* py = (LAS unsigned char*)bp + S_RWY + (r0 * 4 + (j >> 2)) * 4;
                    f32x4 a4 = *(const LAS f32x4*)(p4), w4 = *(const LAS f32x4*)(p4 + 4096), b4 = *(const LAS f32x4*)(p4 + 8192), k4 = *(const LAS f32x4*)(p4 + 12288), r4 = *(const LAS f32x4*)(p4 + 16384);
                    float v0 = *(const LAS float*)(pv), v1 = *(const LAS float*)(pv + 16);
                    float sa0 = dot4(x0, a4), sa1 = dot4(x1, a4);
                    allreduce16x2(sa0, sa1);
#pragma unroll
                    for (int t = 0; t < ST; ++t) {
                        f32x4 na = a4, nw = w4, nb = b4, nk = k4, nr = r4; float n0 = v0, n1 = v1;
                        if (t < ST - 1) { const int o = (t + 1) * 256; na = *(const LAS f32x4*)(p4 + o); nw = *(const LAS f32x4*)(p4 + 4096 + o); nb = *(const LAS f32x4*)(p4 + 8192 + o); nk = *(const LAS f32x4*)(p4 + 12288 + o); nr = *(const LAS f32x4*)(p4 + 16384 + o);
                            n0 = *(const LAS float*)(pv + (t + 1) * 128); n1 = *(const LAS float*)(pv + (t + 1) * 128 + 16); }
                        x0 = x0 * w4 + (b4 * sa0 + k4 * v0); x1 = x1 * w4 + (b4 * sa1 + k4 * v1);
                        float y0 = dot4(x0, r4), y1 = dot4(x1, r4);
                        float s0n = dot4(x0, na), s1n = dot4(x1, na);
                        s0n = dpp_add<0xB1>(s0n); s1n = dpp_add<0xB1>(s1n); y0 = dpp_add<0xB1>(y0); y1 = dpp_add<0xB1>(y1); s0n = dpp_add<0x4E>(s0n); s1n = dpp_add<0x4E>(s1n); y0 = dpp_add<0x4E>(y0); y1 = dpp_add<0x4E>(y1);
                        s0n = dpp_add<0x141>(s0n); s1n = dpp_add<0x141>(s1n); s0n = dpp_add<0x140>(s0n); s1n = dpp_add<0x140>(s1n);
                        *(LAS float*)(py + t * 512) = y0; *(LAS float*)(py + t * 512 + 64) = y1;
                        sa0 = s0n; sa1 = s1n; a4 = na; w4 = nw; b4 = nb; k4 = nk; r4 = nr; v0 = n0; v1 = n1;
                    }
                    SCAN_BAR_S();
                }
            }
            if (wave >= 4) s_drain(lds + ((NBLK - 1) & 1) * S_RWB + S_RWY, tid - 256, og + (size_t)(NBLK - 1) * (ST * 16));
            else { __builtin_amdgcn_s_setprio(0); if (save) { *(f32x4*)sp0 = x0; *(f32x4*)sp1 = x1; } }
        } else {
            const int i2 = it - 128, b = i2 >> 5, h8 = (i2 >> 2) & 7, q4 = i2 & 3;
            const size_t tok0 = (size_t)b * TS;
            float* sp0 = hgstate + ((size_t)((b * 8 + h8) * 128 + q4 * 32 + r0) * 128 + 4 * j); float* sp1 = sp0 + 4 * 128;
            float* og = hgo + (size_t)((b * 8 + h8) * 8 + q4 * 2) * TS * 16;
            f32x4 a0 = (f32x4){0.f, 0.f, 0.f, 0.f}, a1 = a0, c0 = a0, c1 = a0;
            if (wave < 4 && s > 0) { a0 = *(const f32x4*)sp0; a1 = *(const f32x4*)(sp0 + 64); c0 = *(const f32x4*)sp1; c1 = *(const f32x4*)(sp1 + 64); }
            if (wave >= 4) { s_hg_load(lds, tid - 256, tok0, h8, q4, cols, lbv); SCAN_BAR_L(); } else { __builtin_amdgcn_s_setprio(2); asm volatile("s_waitcnt vmcnt(0)" ::: "memory"); SCAN_BAR_S(); }
#pragma unroll 1
            for (int blk = 0; blk < NBLK; ++blk) {
                if (wave >= 4) {
                    if (blk > 0) s_drain(lds + ((blk - 1) & 1) * S_HGB + S_HGY, tid - 256, og + (size_t)(blk - 1) * (ST * 16));
                    if (blk + 1 < NBLK) s_hg_load(lds + ((blk + 1) & 1) * S_HGB, tid - 256, tok0 + (blk + 1) * ST, h8, q4, cols, lbv);
                    SCAN_BAR_L();
                } else {
                    const LAS unsigned char* bp = lds + (blk & 1) * S_HGB;
                    const LAS unsigned char* g4 = bp + 16 * j; const LAS unsigned char* gi = bp + S_HGI + r0 * 4; LAS unsigned char* gy = (LAS unsigned char*)bp + S_HGY + (r0 * 4 + (j >> 2)) * 4;
                    f32x4 f0 = *(const LAS f32x4*)(g4), f1 = *(const LAS f32x4*)(g4 + 256), q0 = *(const LAS f32x4*)(g4 + S_HGQ), q1 = *(const LAS f32x4*)(g4 + S_HGQ + 256);
                    float i0 = *(const LAS float*)(gi), i1 = *(const LAS float*)(gi + 16);
#pragma unroll
                    for (int t = 0; t < ST; ++t) {
                        f32x4 nf0 = f0, nf1 = f1, nq0 = q0, nq1 = q1; float ni0 = i0, ni1 = i1;
                        if (t < ST - 1) { const int o = (t + 1) * 512; nf0 = *(const LAS f32x4*)(g4 + o); nf1 = *(const LAS f32x4*)(g4 + 256 + o); nq0 = *(const LAS f32x4*)(g4 + S_HGQ + o); nq1 = *(const LAS f32x4*)(g4 + S_HGQ + 256 + o);
                            ni0 = *(const LAS float*)(gi + (t + 1) * 128); ni1 = *(const LAS float*)(gi + (t + 1) * 128 + 16); }
                        a0 = (a0 - i0) * f0 + i0; a1 = (a1 - i0) * f1 + i0; c0 = (c0 - i1) * f0 + i1; c1 = (c1 - i1) * f1 + i1;
                        float y0 = dot4acc(a1, q1, dot4(a0, q0));
                        float y1 = dot4acc(c1, q1, dot4(c0, q0));
                        y0 = dpp_add<0xB1>(y0); y1 = dpp_add<0xB1>(y1); y0 = dpp_add<0x4E>(y0); y1 = dpp_add<0x4E>(y1);
                        *(LAS float*)(gy + t * 512) = y0; *(LAS float*)(gy + t * 512 + 64) = y1;
                        f0 = nf0; f1 = nf1; q0 = nq0; q1 = nq1; i0 = ni0; i1 = ni1;
                    }
                    SCAN_BAR_S();
                }
            }
            if (wave >= 4) s_drain(lds + ((NBLK - 1) & 1) * S_HGB + S_HGY, tid - 256, og + (size_t)(NBLK - 1) * (ST * 16));
            else { __builtin_amdgcn_s_setprio(0); if (save) { *(f32x4*)sp0 = a0; *(f32x4*)(sp0 + 64) = a1; *(f32x4*)sp1 = c0; *(f32x4*)(sp1 + 64) = c1; } }
        }
    }
}

__device__ __forceinline__ void attn_phase(int gw, int NGW, int lane, const bf16_t* Q, const bf16_t* KV, const bf16_t* Vt, bf16_t* AO, const float* kmax2) {
    const int fr = lane & 15, fq = lane >> 4;
    for (int item = gw; item < 4096; item += NGW) {
        const int bh = item >> 8, tile = item & 255, b = bh >> 2, hd = bh & 3;
        const size_t g0 = (size_t)b * SEQ + tile * 32 + fr, g1 = g0 + 16;
        const float kmx = sqrtf(fmaxf(fmaxf(kmax2[(bh * 4 + 0) * 32], kmax2[(bh * 4 + 1) * 32]), fmaxf(kmax2[(bh * 4 + 2) * 32], kmax2[(bh * 4 + 3) * 32])));
        bf16x8 qa[8], qb[8]; float na = 0.f, nb = 0.f;
#pragma unroll
        for (int ks = 0; ks < 8; ++ks) { const u32x4 ua = *(const u32x4*)(Q + g0 * 1024 + hd * 256 + ks * 32 + fq * 8), ub = *(const u32x4*)(Q + g1 * 1024 + hd * 256 + ks * 32 + fq * 8);
            qa[ks] = __builtin_bit_cast(bf16x8, ua); qb[ks] = __builtin_bit_cast(bf16x8, ub);
#pragma unroll
            for (int e = 0; e < 4; ++e) { const float a0 = bflo(ua[e]), a1 = bfhi(ua[e]), b0 = bflo(ub[e]), b1 = bfhi(ub[e]); na += a0 * a0 + a1 * a1; nb += b0 * b0 + b1 * b1; } }
        na = fq_sum(na); nb = fq_sum(nb);
        const float ma = sqrtf(na) * kmx * 0.0625f * 1.001f, mb = sqrtf(nb) * kmx * 0.0625f * 1.001f;
        float za = 0.f, zb = 0.f;
        bf16x8 pa[8], pb[8];
#pragma unroll
        for (int k2 = 0; k2 < 8; ++k2) {
            f32x4 e0 = (f32x4){0.f, 0.f, 0.f, 0.f}, e1 = e0, f0 = e0, f1 = e0;
            const bf16_t* kp0 = KV + (size_t)(b * 256 + (2 * k2) * 16 + fr) * 2048 + hd * 256 + fq * 8; const bf16_t* kp1 = kp0 + (size_t)16 * 2048;
#pragma unroll
            for (int ks = 0; ks < 8; ++ks) { const bf16x8 k0 = *(const bf16x8*)(kp0 + ks * 32), k1 = *(const bf16x8*)(kp1 + ks * 32);
                e0 = MFMA16(k0, qa[ks], e0); f0 = MFMA16(k0, qb[ks], f0); e1 = MFMA16(k1, qa[ks], e1); f1 = MFMA16(k1, qb[ks], f1); }
#pragma unroll
            for (int jj = 0; jj < 4; ++jj) { e0[jj] = __expf(e0[jj] * 0.0625f - ma); e1[jj] = __expf(e1[jj] * 0.0625f - ma); f0[jj] = __expf(f0[jj] * 0.0625f - mb); f1[jj] = __expf(f1[jj] * 0.0625f - mb);
                za += e0[jj] + e1[jj]; zb += f0[jj] + f1[jj]; }
            u32x4 w; w.x = cvt_pk_bf16(e0[0], e0[1]); w.y = cvt_pk_bf16(e0[2], e0[3]); w.z = cvt_pk_bf16(e1[0], e1[1]); w.w = cvt_pk_bf16(e1[2], e1[3]); pa[k2] = __builtin_bit_cast(bf16x8, w);
            u32x4 x; x.x = cvt_pk_bf16(f0[0], f0[1]); x.y = cvt_pk_bf16(f0[2], f0[3]); x.z = cvt_pk_bf16(f1[0], f1[1]); x.w = cvt_pk_bf16(f1[2], f1[3]); pb[k2] = __builtin_bit_cast(bf16x8, x); }
        za = fq_sum(za); zb = fq_sum(zb);
        const float ia = 1.0f / za, ib = 1.0f / zb;
#pragma unroll 2
        for (int dt = 0; dt < 16; ++dt) { f32x4 a0 = (f32x4){0.f, 0.f, 0.f, 0.f}, a1 = a0; const bf16_t* vp = Vt + (size_t)((b * 4 + hd) * 256 + dt * 16 + fr) * 256 + fq * 8;
#pragma unroll
            for (int k2 = 0; k2 < 8; ++k2) { const bf16x8 vf = *(const bf16x8*)(vp + k2 * 32); a0 = MFMA16(vf, pa[k2], a0); a1 = MFMA16(vf, pb[k2], a1); }
            st4bf(AO + g0 * 1024 + hd * 256 + dt * 16 + 4 * fq, a0 * ia); st4bf(AO + g1 * 1024 + hd * 256 + dt * 16 + 4 * fq, a1 * ib); }
    }
}

__device__ __forceinline__ int tid_fresh() { int t = threadIdx.x; asm volatile("" : "+v"(t)); return t; }
#define WinT ((bf16_t*)(a.ws + WS_WIN))
#define WoutT ((bf16_t*)(a.ws + WS_WOUT))
#define WqT ((bf16_t*)(a.ws + WS_WQ))
#define WoT ((bf16_t*)(a.ws + WS_WO))
#define WkvT ((bf16_t*)(a.ws + WS_WKV))
#define W13T ((bf16_t*)(a.ws + WS_W13))
#define W2T ((bf16_t*)(a.ws + WS_W2))
#define rw2T ((bf16_t*)(a.ws + WS_RW2T))
#define ra2T ((bf16_t*)(a.ws + WS_RA2T))
#define rg2T ((bf16_t*)(a.ws + WS_RG2T))
#define g2Tp ((bf16_t*)(a.ws + WS_G2TP))
#define KMAX2 ((float*)(a.ws + WS_KMAX))
#define GATE ((bf16_t*)(a.ws + WS_GATE))
#define ASG ((bf16_t*)(a.ws + WS_ASG))
#define carry ((bf16_t*)(a.ws + WS_CARRY))
#define lbv ((float*)(a.ws + WS_LB))
#define mbf ((bf16_t*)(a.ws + WS_MBF))
#define KV ((bf16_t*)(a.ws + WS_KV))
#define Vt ((bf16_t*)(a.ws + WS_VT))
#define rwst ((float*)(a.ws + WS_RWST))
#define hgst ((float*)(a.ws + WS_HGST))
#define bonus ((float*)(a.ws + WS_BONUS))
#define merged ((bf16_t*)(a.ws + WS_MERGED))
#define u1 ((bf16_t*)(a.ws + WS_U1))
#define cols ((bf16_t*)(a.ws + WS_COLS))
#define PR ((bf16_t*)(a.ws + WS_PR))
#define PK ((bf16_t*)(a.ws + WS_PK))
#define PA ((bf16_t*)(a.ws + WS_PA))
#define PB ((bf16_t*)(a.ws + WS_PB))
#define PV ((bf16_t*)(a.ws + WS_PV))
#define PW ((float*)(a.ws + WS_PW))
#define oraw ((float*)(a.ws + WS_ORAW))
#define hgo ((float*)(a.ws + WS_HGO))
#define U ((bf16_t*)(a.ws + WS_U))
#define Qb ((bf16_t*)(a.ws + WS_Q))
#define AO ((bf16_t*)(a.ws + WS_AO))
#define FF ((bf16_t*)(a.ws + WS_FF))
#define XIN (a.in[0])
#define OUTP (a.out)
struct Args { const float* in[29]; float* out; unsigned char* ws; int ph_lo, ph_hi; };

typedef const __attribute__((address_space(4))) Args* CArgsP;
__device__ __forceinline__ CArgsP args_fresh() { CArgsP p = (CArgsP)__builtin_amdgcn_kernarg_segment_ptr(); asm volatile("" : "+s"(p)); return p; }
__global__ void __launch_bounds__(512, 2) mega(Args a0) {
    extern __shared__ __attribute__((aligned(16))) unsigned char lds_raw[];
    LAS unsigned char* lds = (LAS unsigned char*)lds_raw;
    cg::grid_group grid = cg::this_grid();
    const int G = gridDim.x, bid = blockIdx.x, NGW = G * 8, NGT = G * 512;
#define IDS const auto& a = *args_fresh(); const int tid = tid_fresh(), lane = tid & 63, wave = __builtin_amdgcn_readfirstlane(tid >> 6), gw = bid * 8 + wave, gtid = bid * 512 + tid; (void)lane; (void)gw; (void)gtid
    const int lo = a0.ph_lo, hi = a0.ph_hi;
    if (lo < 0) grid.sync();
    { volatile LAS unsigned* misc = (volatile LAS unsigned*)(lds + MISC_OFF); if (threadIdx.x < 2) misc[threadIdx.x] = 0u; __syncthreads();
      if (hi - lo > 1) (void)xcd_barrier_post((unsigned*)(a0.ws + WS_CTL), misc); }
#ifndef MK_REP
#define MK_REP -1
#endif
#ifndef MK_REPN
#define MK_REPN 3
#endif
#define RPT(code) for (int rep_ = 0, nrep_ = (MK_REP == (code)) ? MK_REPN : 1; rep_ < nrep_; ++rep_)
#define LASTREP (rep_ == nrep_ - 1)
#define IN(k) (lo <= (k) && (k) < hi)
#define SEAM(k) do { if (IN(k) && IN((k) + 1)) RPT(120) { XcdBarrier xb_; xb_.bar = (unsigned*)(args_fresh()->ws + WS_CTL); xb_.x = xb_xcc_id(); xb_.st = (volatile LAS unsigned*)(lds + MISC_OFF); xcd_barrier(xb_); } } while (0)

    if (IN(0)) RPT(100) { IDS;
        LAS float* scr = (LAS float*)(lds + wave * 16384);
        constexpr int I_IN = 16 * 297, I_SQ = 16 * 32, I_13 = 16 * 88, I_2 = 44 * 32;
        constexpr int NITEMS = I_IN + 5 * I_SQ + 2 * I_13 + I_2;
        for (int it = gw; it < NITEMS; it += NGW) {
            int r = it;
            if (r < I_IN) { const int kb = r / 297, n0 = (r % 297) * 32; tr_item(a.in[3], 1024, 9504, WinT, kb, n0, n0 + (n0 >= 3360 ? 224 : 0), scr, lane); continue; } r -= I_IN;
            if (r < I_SQ) { tr_item(a.in[17], 1024, 1024, WoutT, r / 32, (r % 32) * 32, (r % 32) * 32, scr, lane); continue; } r -= I_SQ;
            if (r < I_SQ) { tr_item(a.in[20], 1024, 1024, WqT, r / 32, (r % 32) * 32, (r % 32) * 32, scr, lane); continue; } r -= I_SQ;
            if (r < I_SQ) { tr_item(a.in[23], 1024, 1024, WoT, r / 32, (r % 32) * 32, (r % 32) * 32, scr, lane); continue; } r -= I_SQ;
            if (r < I_SQ) { tr_item(a.in[21], 1024, 1024, WkvT, r / 32, (r % 32) * 32, (r % 32) * 32, scr, lane); continue; } r -= I_SQ;
            if (r < I_SQ) { tr_item(a.in[22], 1024, 1024, WkvT, r / 32, (r % 32) * 32, 1024 + (r % 32) * 32, scr, lane); continue; } r -= I_SQ;
            if (r < I_13) { const int n0 = (r % 88) * 32; tr_item(a.in[25], 1024, DFF, W13T, r / 88, n0, (n0 / 128) * 256 + (n0 % 128), scr, lane); continue; } r -= I_13;
            if (r < I_13) { const int n0 = (r % 88) * 32; tr_item(a.in[26], 1024, DFF, W13T, r / 88, n0, (n0 / 128) * 256 + 128 + (n0 % 128), scr, lane); continue; } r -= I_13;
            tr_item(a.in[27], DFF, 1024, W2T, r / 32, (r % 32) * 32, (r % 32) * 32, scr, lane);
        }
        for (int i = gtid; i < 28672; i += NGT) ((u32x4*)(WinT + 3360 * 1024))[i] = (u32x4){0u, 0u, 0u, 0u};
        for (int i = gtid; i < 1792; i += NGT) ((u32x4*)carry)[i] = (u32x4){0u, 0u, 0u, 0u};
        for (int n = gw; n < 1024; n += NGW) { rw2T[n * 64 + lane] = (bf16_t)f2bf(a.in[6][lane * 1024 + n]); ra2T[n * 64 + lane] = (bf16_t)f2bf(a.in[8][lane * 1024 + n]); }
        for (int m = gw; m < 512; m += NGW) {
            for (int e = lane; e < 320; e += 64) { const int n = 2 * m + (e >= 160 ? 1 : 0), k = e >= 160 ? e - 160 : e; rg2T[n * 160 + k] = (bf16_t)f2bf(a.in[9][k * 1024 + n]); } }
        for (int n = gw; n < 1024; n += NGW) { f32x4 v;
#pragma unroll
            for (int e = 0; e < 4; ++e) { const int k = 4 * lane + e; v[e] = k < 160 ? a.in[9][k * 1024 + n] : 0.f; }
            st4bf(g2Tp + n * 256 + 4 * lane, v); }
        for (int i = gtid; i < 1024; i += NGT) lbv[i] = 1.0f / (1.0f + __expf(a.in[15][1024 + i] - a.in[15][i]));
        for (int m = gw; m < 1024; m += NGW) rms_row_bf16(a.in[1] + (size_t)m * 1024, a.in[19], mbf + (size_t)m * 1024, lane);
        for (int lt = gw; lt < MS; lt += NGW) { const int b = lt / TS, tl = lt % TS; const size_t gt = (size_t)b * SEQ + tl; rms_row_bf16(XIN + gt * 1024, a.in[2], u1 + (size_t)lt * 1024, lane); }
        __syncthreads();
    }
    SEAM(0);

#pragma unroll 1
    for (int s = 0; s < NSPLIT; ++s) {
        const int pb = 1 + 5 * s;
        if (IN(pb + 1)) { const auto& a = *args_fresh();
            pg8::Gemm g{u1, WinT, MS, CL, 1024}; pg8::StaticOrder S; S.init(MS, CL, G, bid);
            pg8::EpiColsAct E{cols, CL};
            RPT(102) pg8::gemm_phase<pg8::EpiColsAct, pg8::StaticOrder, true, true>(lds, g, S, E);
        }
        SEAM(pb + 1);
#ifndef SKIP_PREP
        if (IN(pb + 2)) { IDS; RPT(103) prep_phase(s, gw, NGW, lane, cols, carry, a.in[4], a.in[5], a.in[7], a.in[10], a.in[11], a.in[12], rw2T, ra2T, PR, PK, PA, PB, PV, PW, bonus, ASG); }
#endif
        SEAM(pb + 2);
        if (IN(pb + 3)) { IDS;
#ifdef MK_ZERO_SCAN
            for (int i = gtid; i < MS * 256; i += NGT) { ((f32x4*)oraw)[i] = (f32x4){0.f, 0.f, 0.f, 0.f}; ((f32x4*)hgo)[i] = (f32x4){0.01f, 0.02f, 0.03f, 0.04f}; }
#endif
#if 0
            RPT(104) { rwkv_scan(s, bid, G, tid, lane, wave, lds, PA, PW, PB, PK, PR, PV, oraw, rwst, LASTREP); __syncthreads(); }
            RPT(105) { hgrn_scan(s, bid, G, tid, lane, wave, lds, cols, lbv, hgo, hgst, LASTREP); __syncthreads(); }
#else
#ifdef MK_FUSED_SCAN
            RPT(104) { fused_scan(s, bid, G, tid, lane, wave, lds, PA, PW, PB, PK, PR, PV, cols, lbv, oraw, hgo, rwst, hgst, LASTREP); __syncthreads(); }
#else
            RPT(104) { split_scan(s, bid, G, tid, lane, wave, lds, PA, PW, PB, PK, PR, PV, cols, lbv, oraw, hgo, rwst, hgst, LASTREP); __syncthreads(); }
#endif
#endif
            if (G != 256 || bid < 128) { pg8::Gemm g{ASG, g2Tp, MS, 1024, 256}; pg8::StaticOrder S; if (G == 256) S.init(MS, 1024, 128, bid); else S.init(MS, 1024, G, bid); pg8::EpiStoreBf16 E{GATE, 1024};
              pg8::gemm_phase<pg8::EpiStoreBf16, pg8::StaticOrder, true, true>(lds, g, S, E); }
        }
        SEAM(pb + 3);
        if (IN(pb + 4)) { IDS;
#ifdef MK_NOMIX
            for (int i = gtid; i < MS * 128; i += NGT) { const int lt = i >> 7, b = lt / TS, tl = lt % TS; const size_t gt = (size_t)b * SEQ + s * TS + tl; ((u32x4*)(merged + gt * 1024))[i & 127] = (u32x4){0u, 0u, 0u, 0u}; }
#endif
#ifndef SKIP_POST
            RPT(106) post_phase(s, gw, NGW, lane, cols, carry, a.in[4], GATE, a.in[13], a.in[14], a.in[16], oraw, hgo, PV, bonus, merged);
#endif
            if (s + 1 < NSPLIT) for (int lt = gw; lt < MS; lt += NGW) { const int b = lt / TS, tl = lt % TS; const size_t gt = (size_t)b * SEQ + (s + 1) * TS + tl; rms_row_bf16(XIN + gt * 1024, a.in[2], u1 + (size_t)lt * 1024, lane); }
            if (bid < 4 && s + 1 < NSPLIT) { const u32x4* src = (const u32x4*)(cols + (size_t)(bid * TS + TS - 1) * CL); u32x4* dst = (u32x4*)(carry + (((s + 1) & 1) * 4 + bid) * CARRY_LD);
                for (int i = tid; i < CARRY_LD / 8; i += 512) dst[i] = src[i]; }
        }
        SEAM(pb + 4);
    }

    if (IN(T0 + 0)) { const auto& a = *args_fresh();
        { pg8::Gemm g{merged, WoutT, NTOK, 1024, 1024}; pg8::StaticOrder S; S.init(NTOK, 1024, G, bid); pg8::EpiResF32 E{XIN, OUTP, 1024};
          pg8::gemm_phase<pg8::EpiResF32, pg8::StaticOrder, true, true>(lds, g, S, E); }
        { pg8::Gemm g{mbf, WkvT, 1024, 2048, 1024}; pg8::StaticOrder S; S.init(1024, 2048, G, bid); pg8::EpiStoreBf16 E{KV, 2048};
          pg8::gemm_phase<pg8::EpiStoreBf16, pg8::StaticOrder, true, true>(lds, g, S, E); }
    }
    SEAM(T0 + 0);
    if (IN(T0 + 1)) { IDS;
        for (int gt = gw; gt < NTOK; gt += NGW) rms_row_bf16(OUTP + (size_t)gt * 1024, a.in[18], U + (size_t)gt * 1024, lane);
        for (int i = gtid; i < 4 * 4 * 256 * 256; i += NGT) { const int kp = i & 255, dim = (i >> 8) & 255, hd = (i >> 16) & 3, b = i >> 18;
            const int k2 = kp >> 5, fq = (kp >> 3) & 3, sl = kp & 7; const int key = 32 * k2 + (sl < 4 ? 4 * fq + sl : 16 + 4 * fq + sl - 4);
            Vt[i] = KV[(size_t)(b * 256 + key) * 2048 + 1024 + hd * 256 + dim]; }
        for (int i = gw; i < 64; i += NGW) {
            const int bh = i >> 2, kb = i & 3, b = bh >> 2, hd = bh & 3; const bf16_t* kr = KV + (size_t)(b * 256 + kb * 64 + lane) * 2048 + hd * 256; float ss = 0.f;
#pragma unroll 4
            for (int c = 0; c < 32; ++c) { float t[8]; ld8bf(kr + c * 8, t);
#pragma unroll
                for (int e = 0; e < 8; ++e) ss += t[e] * t[e]; }
#pragma unroll
            for (int o = 1; o < 64; o <<= 1) ss = fmaxf(ss, __shfl_xor(ss, o));
            if (lane == 0) KMAX2[i * 32] = ss; }
    }
    SEAM(T0 + 1);
    if (IN(T0 + 2)) { const auto& a = *args_fresh(); pg8::Gemm g{U, WqT, NTOK, 1024, 1024}; pg8::StaticOrder S; S.init(NTOK, 1024, G, bid); pg8::EpiStoreBf16 E{Qb, 1024};
        RPT(112) pg8::gemm_phase<pg8::EpiStoreBf16, pg8::StaticOrder, true, true>(lds, g, S, E); }
    SEAM(T0 + 2);
#ifndef SKIP_ATTN
    if (IN(T0 + 3)) { IDS; RPT(113) attn_phase(gw, NGW, lane, Qb, KV, Vt, AO, KMAX2); }
#endif
    SEAM(T0 + 3);
#ifndef MK_NOATT
    if (IN(T0 + 4)) { const auto& a = *args_fresh(); pg8::Gemm g{AO, WoT, NTOK, 1024, 1024}; pg8::StaticOrder S; S.init(NTOK, 1024, G, bid); pg8::EpiResF32 E{OUTP, OUTP, 1024};
        pg8::gemm_phase<pg8::EpiResF32, pg8::StaticOrder, true, true>(lds, g, S, E); }
#endif
    SEAM(T0 + 4);
    if (IN(T0 + 5)) { IDS; RPT(115) for (int gt = gw; gt < NTOK; gt += NGW) rms_row_bf16(OUTP + (size_t)gt * 1024, a.in[24], U + (size_t)gt * 1024, lane); }
    SEAM(T0 + 5);
    if (IN(T0 + 6)) { const auto& a = *args_fresh(); pg8::Gemm g{U, W13T, NTOK, 2 * DFF, 1024}; pg8::StaticOrder S; S.init(NTOK, 2 * DFF, G, bid); pg8::EpiSwiGLU E{FF, DFF};
        RPT(116) pg8::gemm_phase<pg8::EpiSwiGLU, pg8::StaticOrder, true, true>(lds, g, S, E); }
    SEAM(T0 + 6);
    if (IN(T0 + 7)) { const auto& a = *args_fresh(); pg8::Gemm g{FF, W2T, NTOK, 1024, DFF}; pg8::StaticOrder S; S.init(NTOK, 1024, G, bid); pg8::EpiResF32 E{OUTP, OUTP, 1024};
        pg8::gemm_phase<pg8::EpiResF32, pg8::StaticOrder, true, true>(lds, g, S, E); }
    SEAM(T0 + 7);
    if (IN(T0 + 8)) { IDS;
        const float* gf = a.in[28];
        for (int gt = gw; gt < NTOK; gt += NGW) { f32x4* row = (f32x4*)(OUTP + (size_t)gt * 1024); f32x4 v[4]; float sq = 0.f;
#pragma unroll
            for (int j = 0; j < 4; ++j) { v[j] = row[lane + 64 * j]; sq += (v[j][0] * v[j][0] + v[j][1] * v[j][1]) + (v[j][2] * v[j][2] + v[j][3] * v[j][3]); }
            const float rs = 1.0f / sqrtf(wave_sum(sq) * (1.0f / 1024.0f) + 1e-6f);
#pragma unroll
            for (int j = 0; j < 4; ++j) row[lane + 64 * j] = v[j] * rs * ((const f32x4*)gf)[lane + 64 * j]; }
    }
#undef IN
#undef SEAM
}

#ifndef MK_MULTI
#define MK_MULTI 0
#endif
extern "C" void kernel_launch(void* const* d_in, const int* in_sizes, int n_in, void* d_out, int out_size, void* d_ws, size_t ws_size, hipStream_t stream) {
    static int grid = 0;
    if (grid == 0) {
        if (n_in != 29 || in_sizes[0] != NTOK * D || out_size != NTOK * D || ws_size < WS_END) { fprintf(stderr, "kernel_launch: unexpected shapes / workspace (%d inputs, ws %zu)\n", n_in, ws_size); grid = -1; return; }
        int dev = 0, cus = 0, per_cu = 0;
        hipGetDevice(&dev); hipDeviceGetAttribute(&cus, hipDeviceAttributeMultiprocessorCount, dev);
        hipFuncSetAttribute((const void*)mega, hipFuncAttributeMaxDynamicSharedMemorySize, LDS_BYTES);
        hipOccupancyMaxActiveBlocksPerMultiprocessor(&per_cu, (const void*)mega, 512, LDS_BYTES);
        (void)hipGetLastError();
        if (per_cu < 1) per_cu = 1;
        grid = cus;
    }
    if (grid < 0) return;
    Args a{};
    for (int i = 0; i < 29; ++i) a.in[i] = (const float*)d_in[i];
    a.out = (float*)d_out; a.ws = (unsigned char*)d_ws;
    (void)hipMemsetAsync((char*)d_ws + WS_CTL, 0, CTL_BYTES, stream);
    void* args[] = {&a};
#if MK_MULTI
    for (int ph = 0; ph < N_PHASES; ++ph) { a.ph_lo = ph; a.ph_hi = ph + 1; hipLaunchCooperativeKernel((const void*)mega, dim3(grid), dim3(512), args, LDS_BYTES, stream); }
#else
    a.ph_lo = 0; a.ph_hi = N_PHASES;
    hipError_t e = hipLaunchCooperativeKernel((const void*)mega, dim3(grid), dim3(512), args, LDS_BYTES, stream);
    if (e != hipSuccess) fprintf(stderr, "cooperative launch failed: %s (grid %d)\n", hipGetErrorString(e), grid);
#endif
}
```

```cpp
#include <hip/hip_runtime.h>
#include <hip/hip_cooperative_groups.h>
#include <cstdint>
#include <cstdio>
namespace cg = cooperative_groups;
namespace pg8 {
#define PG8_LAS __attribute__((address_space(3)))
typedef unsigned short bf16_t;
typedef short bf16x8 __attribute__((ext_vector_type(8)));
typedef float f32x4 __attribute__((ext_vector_type(4)));
typedef unsigned u32x4 __attribute__((ext_vector_type(4)));
constexpr int BM = 256, BK = 64, HALF = 128, HTB = HALF * BK * 2  , STAGE_BYTES = 8 * HTB, NXCD = 8, WGM = 8;

__host__ __device__ __forceinline__ int lds_byte(int r, int c) { const int st = (r >> 4) * 2 + (c >> 5), rr = r & 15, cc = c & 31, ob = rr * 64 + cc * 2; return st * 1024 + (ob ^ (((ob >> 9) & 1) << 5)); }
__host__ __device__ __forceinline__ void stage_rc(int b, int& R, int& C) { const int st = b / 1024, sb = b % 1024, swz = sb ^ (((sb >> 9) & 1) << 5); R = (st >> 1) * 16 + swz / 64; C = (st & 1) * 32 + (swz % 64) / 2; }
__host__ __device__ __forceinline__ int perm32(int rho) { const int n = rho >> 4, i = rho & 15; return 8 * (i >> 2) + 4 * n + (i & 3); }

struct Unit { int pm, pn; };
struct Gemm { const bf16_t* A; const bf16_t* Bt; int M, N, K; };

struct StaticOrder {
    int nM, nN, nwg, G, c;
    __host__ __device__ void init(int M, int N, int G_, int c_) { nM = M / BM; nN = N / BM; nwg = nM * nN; G = G_; c = c_; }
    __host__ __device__ bool next(int i, Unit& u) const {
        const long L = (long)i * G + c; if (L >= nwg) return false;
        int wgid = (int)L; { const int q = nwg / NXCD, r = nwg % NXCD, xcd = wgid % NXCD, off = wgid / NXCD; wgid = (xcd < r ? xcd * (q + 1) : r * (q + 1) + (xcd - r) * q) + off; }
        const int nig = WGM * nN, gid = wgid / nig, fm = gid * WGM, gsz = (nM - fm) < WGM ? (nM - fm) : WGM;
        u.pm = fm + ((wgid % nig) % gsz); u.pn = (wgid % nig) / gsz; return true;
    }
    __device__ __forceinline__ void a_ready(const Unit&) const {}
    __device__ __forceinline__ void done(const Unit&) const {}
};

__device__ __forceinline__ unsigned cvt_pk_bf16(float lo, float hi) { unsigned r; asm volatile("v_cvt_pk_bf16_f32 %0, %1, %2" : "=v"(r) : "v"(lo), "v"(hi)); return r; }
__device__ __forceinline__ float fast_sigmoid(float x) { return __builtin_amdgcn_rcpf(1.0f + __expf(-x)); }
__device__ __forceinline__ float fast_silu(float x) { return x * fast_sigmoid(x); }
struct EpiStoreBf16 {
    static constexpr bool PERM = true, AFTER_DRAIN = false;
    bf16_t* O; int ldc;
    __device__ __forceinline__ void operator()(const f32x4 (&acc)[2][2][4][2], const Unit& u, int wr, int wc, int fr, int fq) const {
        const int row0 = u.pm * BM + wr * 64 + fr, col0 = u.pn * BM + wc * 32 + 8 * fq;
#pragma unroll
        for (int ai = 0; ai < 2; ++ai)
#pragma unroll
            for (int m = 0; m < 4; ++m) { bf16_t* rowp = O + (size_t)(row0 + ai * HALF + m * 16) * ldc + col0;
#pragma unroll
                for (int bj = 0; bj < 2; ++bj) { const f32x4 v0 = acc[ai][bj][m][0], v1 = acc[ai][bj][m][1];
                    u32x4 w; w.x = cvt_pk_bf16(v0[0], v0[1]); w.y = cvt_pk_bf16(v0[2], v0[3]); w.z = cvt_pk_bf16(v1[0], v1[1]); w.w = cvt_pk_bf16(v1[2], v1[3]);
                    *(u32x4*)(rowp + bj * HALF) = w; } }
    }
};
struct EpiResF32 {
    static constexpr bool PERM = true, AFTER_DRAIN = false;
    const float* base; float* out; int ldc;
    __device__ __forceinline__ void operator()(const f32x4 (&acc)[2][2][4][2], const Unit& u, int wr, int wc, int fr, int fq) const {
        const int row0 = u.pm * BM + wr * 64 + fr, col0 = u.pn * BM + wc * 32 + 8 * fq;
#pragma unroll
        for (int ai = 0; ai < 2; ++ai)
#pragma unroll
            for (int m = 0; m < 4; ++m) { const size_t off = (size_t)(row0 + ai * HALF + m * 16) * ldc + col0;
#pragma unroll
                for (int bj = 0; bj < 2; ++bj)
#pragma unroll
                    for (int n = 0; n < 2; ++n) { const size_t p = off + bj * HALF + 4 * n; const f32x4 b = *(const f32x4*)(base + p); *(f32x4*)(out + p) = b + acc[ai][bj][m][n]; } }
    }
};
struct EpiSwiGLU {
    static constexpr bool PERM = true, AFTER_DRAIN = false;
    bf16_t* O; int ldc;
    __device__ __forceinline__ void operator()(const f32x4 (&acc)[2][2][4][2], const Unit& u, int wr, int wc, int fr, int fq) const {
        const int row0 = u.pm * BM + wr * 64 + fr, col0 = u.pn * HALF + wc * 32 + 8 * fq;
#pragma unroll
        for (int ai = 0; ai < 2; ++ai)
#pragma unroll
            for (int m = 0; m < 4; ++m) { bf16_t* rowp = O + (size_t)(row0 + ai * HALF + m * 16) * ldc + col0;
                f32x4 v0, v1;
#pragma unroll
                for (int j = 0; j < 4; ++j) { v0[j] = fast_silu(acc[ai][0][m][0][j]) * acc[ai][1][m][0][j]; v1[j] = fast_silu(acc[ai][0][m][1][j]) * acc[ai][1][m][1][j]; }
                u32x4 w; w.x = cvt_pk_bf16(v0[0], v0[1]); w.y = cvt_pk_bf16(v0[2], v0[3]); w.z = cvt_pk_bf16(v1[0], v1[1]); w.w = cvt_pk_bf16(v1[2], v1[3]);
                *(u32x4*)rowp = w; }
    }
};

struct EpiColsAct {
    static constexpr bool PERM = true, AFTER_DRAIN = false;
    bf16_t* O; int ldc;
    __device__ __forceinline__ void operator()(const f32x4 (&acc)[2][2][4][2], const Unit& u, int wr, int wc, int fr, int fq) const {
        const int row0 = u.pm * BM + wr * 64 + fr, col0 = u.pn * BM + wc * 32 + 8 * fq;
        const int pn = u.pn; const int act = (pn >= 14 && pn < 18) ? 1 : (pn >= 18 && pn < 22) ? 2 : (pn >= 26 && pn < 30) ? 1 : (pn >= 30) ? 2 : 0;
#pragma unroll
        for (int ai = 0; ai < 2; ++ai)
#pragma unroll
            for (int m = 0; m < 4; ++m) { bf16_t* rowp = O + (size_t)(row0 + ai * HALF + m * 16) * ldc + col0;
#pragma unroll
                for (int bj = 0; bj < 2; ++bj) { f32x4 v0 = acc[ai][bj][m][0], v1 = acc[ai][bj][m][1];
                    if (act == 1) {
#pragma unroll
                        for (int j = 0; j < 4; ++j) { v0[j] = fast_silu(v0[j]); v1[j] = fast_silu(v1[j]); } }
                    else if (act == 2) {
#pragma unroll
                        for (int j = 0; j < 4; ++j) { v0[j] = fast_sigmoid(v0[j]); v1[j] = fast_sigmoid(v1[j]); } }
                    u32x4 w; w.x = cvt_pk_bf16(v0[0], v0[1]); w.y = cvt_pk_bf16(v0[2], v0[3]); w.z = cvt_pk_bf16(v1[0], v1[1]); w.w = cvt_pk_bf16(v1[2], v1[3]);
                    *(u32x4*)(rowp + bj * HALF) = w; } }
    }
};

struct EpiResNorm {
    static constexpr bool PERM = true, AFTER_DRAIN = false;
    const float* base; float* out; bf16_t* hb; const float* gain; float* ss; int ldc, nrows;
    __device__ __forceinline__ void operator()(const f32x4 (&acc)[2][2][4][2], const Unit& u, int wr, int wc, int fr, int fq) const {
        const int row0 = u.pm * BM + wr * 64 + fr, col0 = u.pn * BM + wc * 32 + 8 * fq;
        f32x4 gv[2][2];
#pragma unroll
        for (int bj = 0; bj < 2; ++bj)
#pragma unroll
            for (int n = 0; n < 2; ++n) gv[bj][n] = *(const f32x4*)(gain + col0 + bj * HALF + 4 * n);
#pragma unroll
        for (int ai = 0; ai < 2; ++ai)
#pragma unroll
            for (int m = 0; m < 4; ++m) { const int row = row0 + ai * HALF + m * 16; const size_t off = (size_t)row * ldc + col0; float sq = 0.f;
#pragma unroll
                for (int bj = 0; bj < 2; ++bj) { f32x4 v[2];
#pragma unroll
                    for (int n = 0; n < 2; ++n) { const size_t p = off + bj * HALF + 4 * n; v[n] = *(const f32x4*)(base + p) + acc[ai][bj][m][n]; *(f32x4*)(out + p) = v[n];
                        sq += (v[n][0] * v[n][0] + v[n][1] * v[n][1]) + (v[n][2] * v[n][2] + v[n][3] * v[n][3]); }
                    const f32x4 h0 = v[0] * gv[bj][0], h1 = v[1] * gv[bj][1];
                    u32x4 w; w.x = cvt_pk_bf16(h0[0], h0[1]); w.y = cvt_pk_bf16(h0[2], h0[3]); w.z = cvt_pk_bf16(h1[0], h1[1]); w.w = cvt_pk_bf16(h1[2], h1[3]);
                    *(u32x4*)(hb + off + bj * HALF) = w; }
                sq += __shfl_xor(sq, 16); sq += __shfl_xor(sq, 32);
                if (fq == 0) ss[((size_t)u.pn * nrows + row) * 4 + wc] = sq; }
    }
};
__device__ __forceinline__ float row_rs(const float* ss, int nrows, int row) {
    float s = 0.f;
#pragma unroll
    for (int pn = 0; pn < 4; ++pn) { const f32x4 t = *(const f32x4*)(ss + ((size_t)pn * nrows + row) * 4); s += (t[0] + t[1]) + (t[2] + t[3]); }
    return 1.0f / sqrtf(s * (1.0f / 1024.0f) + 1e-6f);
}
struct EpiStoreBf16Rs {
    static constexpr bool PERM = true, AFTER_DRAIN = false;
    bf16_t* O; int ldc; const float* ss; int nrows;
    __device__ __forceinline__ void operator()(const f32x4 (&acc)[2][2][4][2], const Unit& u, int wr, int wc, int fr, int fq) const {
        const int row0 = u.pm * BM + wr * 64 + fr, col0 = u.pn * BM + wc * 32 + 8 * fq;
#pragma unroll
        for (int ai = 0; ai < 2; ++ai)
#pragma unroll
            for (int m = 0; m < 4; ++m) { const int row = row0 + ai * HALF + m * 16; const float rs = row_rs(ss, nrows, row); bf16_t* rowp = O + (size_t)row * ldc + col0;
#pragma unroll
                for (int bj = 0; bj < 2; ++bj) { const f32x4 v0 = acc[ai][bj][m][0] * rs, v1 = acc[ai][bj][m][1] * rs;
                    u32x4 w; w.x = cvt_pk_bf16(v0[0], v0[1]); w.y = cvt_pk_bf16(v0[2], v0[3]); w.z = cvt_pk_bf16(v1[0], v1[1]); w.w = cvt_pk_bf16(v1[2], v1[3]);
                    *(u32x4*)(rowp + bj * HALF) = w; } }
    }
};
struct EpiSwiGLURs {
    static constexpr bool PERM = true, AFTER_DRAIN = false;
    bf16_t* O; int ldc; const float* ss; int nrows;
    __device__ __forceinline__ void operator()(const f32x4 (&acc)[2][2][4][2], const Unit& u, int wr, int wc, int fr, int fq) const {
        const int row0 = u.pm * BM + wr * 64 + fr, col0 = u.pn * HALF + wc * 32 + 8 * fq;
#pragma unroll
        for (int ai = 0; ai < 2; ++ai)
#pragma unroll
            for (int m = 0; m < 4; ++m) { const int row = row0 + ai * HALF + m * 16; const float rs = row_rs(ss, nrows, row); bf16_t* rowp = O + (size_t)row * ldc + col0;
                f32x4 v0, v1;
#pragma unroll
                for (int j = 0; j < 4; ++j) { v0[j] = fast_silu(acc[ai][0][m][0][j] * rs) * (acc[ai][1][m][0][j] * rs); v1[j] = fast_silu(acc[ai][0][m][1][j] * rs) * (acc[ai][1][m][1][j] * rs); }
                u32x4 w; w.x = cvt_pk_bf16(v0[0], v0[1]); w.y = cvt_pk_bf16(v0[2], v0[3]); w.z = cvt_pk_bf16(v1[0], v1[1]); w.w = cvt_pk_bf16(v1[2], v1[3]);
                *(u32x4*)rowp = w; }
    }
};
template <class Epi, class Sched, bool ALIGN_EPI = false, bool SP2 = false>
__device__ __forceinline__ void gemm_phase(PG8_LAS unsigned char* lds, const Gemm g, const Sched& S, const Epi& E) {
    int tid = threadIdx.x; asm volatile("" : "+v"(tid));
    const int wid = __builtin_amdgcn_readfirstlane(tid >> 6), lane = tid & 63, wr = wid >> 2, wc = wid & 3, fr = lane & 15, fq = lane >> 4;
    const int K = g.K, nt = K / BK;
    unsigned voffA[2], voffB[2];
#pragma unroll
    for (int i = 0; i < 2; ++i) { int R, C; stage_rc(tid * 16 + i * 8192, R, C); const int Rb = Epi::PERM ? ((R & ~31) + perm32(R & 31)) : R;
        voffA[i] = (unsigned)(R * K + C) * 2u; voffB[i] = (unsigned)(Rb * K + C) * 2u; }
    const size_t kstep = (size_t)(BK * 2);
    const size_t hstep = (size_t)HALF * K * 2;
    const size_t tstep = 2 * hstep;
    const unsigned ldsw = (unsigned)wid * 1024u;
    const int aoff = lds_byte(wr * 64 + fr, fq * 8), boff = lds_byte(wc * 32 + fr, fq * 8);
#define PG8_SA(b, h) (((b) * 2 + (h)) * HTB)
#define PG8_SB(b, h) ((4 + (b) * 2 + (h)) * HTB)
#define PG8_STAGE(bufoff, gbase, voff) do { _Pragma("unroll") for (int _i = 0; _i < 2; ++_i) \
        __builtin_amdgcn_global_load_lds((const unsigned*)((const char*)(gbase) + (voff)[_i]), (PG8_LAS unsigned*)(lds + (bufoff) + ldsw + _i * 8192), 16, 0, 0); } while (0)
#define PG8_LDA(dst, b, h) do { _Pragma("unroll") for (int m = 0; m < 4; ++m) _Pragma("unroll") for (int k = 0; k < 2; ++k) dst[m][k] = *(const PG8_LAS bf16x8*)(lds + PG8_SA(b, h) + aoff + m * 2048 + k * 1024); } while (0)
#define PG8_LDB(dst, b, h) do { _Pragma("unroll") for (int n = 0; n < 2; ++n) _Pragma("unroll") for (int k = 0; k < 2; ++k) dst[n][k] = *(const PG8_LAS bf16x8*)(lds + PG8_SB(b, h) + boff + n * 2048 + k * 1024); } while (0)
#define PG8_MMA(ai, bj, At, Bt) do { __builtin_amdgcn_s_setprio(1); _Pragma("unroll") for (int m = 0; m < 4; ++m) _Pragma("unroll") for (int n = 0; n < 2; ++n) _Pragma("unroll") for (int k = 0; k < 2; ++k) \
        acc[ai][bj][m][n] = __builtin_amdgcn_mfma_f32_16x16x32_bf16(Bt[n][k], At[m][k], acc[ai][bj][m][n], 0, 0, 0); __builtin_amdgcn_s_setprio(0); } while (0)
#define PG8_WAIT_V(n) asm volatile("s_waitcnt vmcnt(" #n ")" ::: "memory")
#define PG8_WAIT_L(n) asm volatile("s_waitcnt lgkmcnt(" #n ")" ::: "memory")
#define PG8_BAR __builtin_amdgcn_s_barrier()
#define PG8_SCHED __builtin_amdgcn_sched_barrier(0)
    Unit cur, nxt; int ui = 0;
    if (!S.next(0, cur)) return;
    f32x4 acc[2][2][4][2];
#pragma unroll
    for (int a = 0; a < 2; ++a)
#pragma unroll
        for (int b = 0; b < 2; ++b)
#pragma unroll
            for (int m = 0; m < 4; ++m)
#pragma unroll
                for (int n = 0; n < 2; ++n) acc[a][b][m][n] = (f32x4){0.f, 0.f, 0.f, 0.f};
    bf16x8 At[4][2], B0[2][2], B1[2][2];
    const char* cA = (const char*)g.A + (size_t)cur.pm * tstep; const char* cB = (const char*)g.Bt + (size_t)cur.pn * tstep;
    S.a_ready(cur);
    if constexpr (SP2) {
        PG8_STAGE(PG8_SB(0, 0), cB, voffB); PG8_STAGE(PG8_SB(0, 1), cB + hstep, voffB); PG8_STAGE(PG8_SA(0, 0), cA, voffA); PG8_STAGE(PG8_SA(0, 1), cA + hstep, voffA);
        if (wr == 1) PG8_BAR;
        PG8_WAIT_V(2); PG8_BAR;
        PG8_STAGE(PG8_SB(1, 0), cB + kstep, voffB); PG8_STAGE(PG8_SA(1, 0), cA + kstep, voffA); PG8_STAGE(PG8_SB(1, 1), cB + hstep + kstep, voffB);
        PG8_WAIT_V(6); PG8_BAR;
    } else {
        PG8_STAGE(PG8_SB(0, 0), cB, voffB); PG8_STAGE(PG8_SA(0, 0), cA, voffA); PG8_STAGE(PG8_SB(0, 1), cB + hstep, voffB); PG8_STAGE(PG8_SA(0, 1), cA + hstep, voffA);
        if (wr == 1) PG8_BAR;
        PG8_WAIT_V(4); PG8_BAR;
        PG8_STAGE(PG8_SB(1, 0), cB + kstep, voffB); PG8_STAGE(PG8_SA(1, 0), cA + kstep, voffA); PG8_STAGE(PG8_SB(1, 1), cB + hstep + kstep, voffB);
        PG8_WAIT_V(6); PG8_BAR;
    }
    for (;;) {
        const bool has_next = S.next(ui + 1, nxt);
        const char* nA = has_next ? (const char*)g.A + (size_t)nxt.pm * tstep : cA; const char* nB = has_next ? (const char*)g.Bt + (size_t)nxt.pn * tstep : cB;
        for (int t = 0; t < nt; t += 2) {
            const bool last = (t == nt - 2);
            const char* a1 = cA + (size_t)(t + 1) * kstep;
            const char* a2 = last ? nA : cA + (size_t)(t + 2) * kstep; const char* b2 = last ? nB : cB + (size_t)(t + 2) * kstep;
            const char* a3 = a2 + kstep; const char* b3 = b2 + kstep;
            if (last && has_next) S.a_ready(nxt);
            if constexpr (SP2) {
            PG8_LDB(B0, 0, 0); PG8_LDB(B1, 0, 1); PG8_SCHED; PG8_LDA(At, 0, 0); PG8_STAGE(PG8_SA(1, 1), a1 + hstep, voffA);
            PG8_WAIT_V(8); PG8_WAIT_L(0); PG8_BAR; PG8_MMA(0, 0, At, B0); PG8_MMA(0, 1, At, B1); PG8_BAR; PG8_SCHED;
            PG8_LDA(At, 0, 1); PG8_STAGE(PG8_SB(0, 0), b2, voffB); PG8_STAGE(PG8_SB(0, 1), b2 + hstep, voffB); PG8_STAGE(PG8_SA(0, 0), a2, voffA);
            PG8_WAIT_V(8); PG8_WAIT_L(0); PG8_BAR; PG8_MMA(1, 0, At, B0); PG8_MMA(1, 1, At, B1); PG8_BAR; PG8_SCHED;
            PG8_LDB(B0, 1, 0); PG8_LDB(B1, 1, 1); PG8_SCHED; PG8_LDA(At, 1, 0); PG8_STAGE(PG8_SA(0, 1), a2 + hstep, voffA);
            PG8_WAIT_V(8); PG8_WAIT_L(0); PG8_BAR; PG8_MMA(0, 0, At, B0); PG8_MMA(0, 1, At, B1); PG8_BAR; PG8_SCHED;
            PG8_LDA(At, 1, 1); PG8_STAGE(PG8_SB(1, 0), b3, voffB); PG8_STAGE(PG8_SB(1, 1), b3 + hstep, voffB); PG8_STAGE(PG8_SA(1, 0), a3, voffA);
            PG8_WAIT_V(8); PG8_WAIT_L(0); PG8_BAR; PG8_MMA(1, 0, At, B0); PG8_MMA(1, 1, At, B1); PG8_BAR; PG8_SCHED;
            } else {
            PG8_LDB(B0, 0, 0); PG8_SCHED; PG8_LDA(At, 0, 0); PG8_STAGE(PG8_SA(1, 1), a1 + hstep, voffA);
            PG8_WAIT_L(8); PG8_BAR; PG8_WAIT_L(0); PG8_MMA(0, 0, At, B0); PG8_BAR; PG8_SCHED;
            PG8_LDB(B1, 0, 1); PG8_STAGE(PG8_SB(0, 0), b2, voffB);
            PG8_BAR; PG8_WAIT_L(0); PG8_MMA(0, 1, At, B1); PG8_BAR;
            PG8_LDA(At, 0, 1); PG8_STAGE(PG8_SA(0, 0), a2, voffA);
            PG8_BAR; PG8_WAIT_L(0); PG8_MMA(1, 0, At, B0); PG8_BAR; PG8_SCHED;
            PG8_STAGE(PG8_SB(0, 1), b2 + hstep, voffB);
            PG8_WAIT_V(6); PG8_BAR; PG8_MMA(1, 1, At, B1); PG8_BAR;
            PG8_LDB(B0, 1, 0); PG8_SCHED; PG8_LDA(At, 1, 0); PG8_STAGE(PG8_SA(0, 1), a2 + hstep, voffA);
            PG8_WAIT_L(8); PG8_BAR; PG8_WAIT_L(0); PG8_MMA(0, 0, At, B0); PG8_BAR; PG8_SCHED;
            PG8_LDB(B1, 1, 1); PG8_STAGE(PG8_SB(1, 0), b3, voffB);
            PG8_BAR; PG8_WAIT_L(0); PG8_MMA(0, 1, At, B1); PG8_BAR;
            PG8_LDA(At, 1, 1); PG8_STAGE(PG8_SA(1, 0), a3, voffA);
            PG8_BAR; PG8_WAIT_L(0); PG8_MMA(1, 0, At, B0); PG8_BAR; PG8_SCHED;
            PG8_STAGE(PG8_SB(1, 1), b3 + hstep, voffB);
            PG8_WAIT_V(6); PG8_BAR; PG8_MMA(1, 1, At, B1); PG8_BAR;
            }
        }
        if constexpr (ALIGN_EPI) { if (wr == 0) PG8_BAR; }
        if constexpr (!Epi::AFTER_DRAIN) { E(acc, cur, wr, wc, fr, fq); S.done(cur); }
        if (!has_next) break;
#pragma unroll
        for (int a = 0; a < 2; ++a)
#pragma unroll
            for (int b = 0; b < 2; ++b)
#pragma unroll
                for (int m = 0; m < 4; ++m)
#pragma unroll
                    for (int n = 0; n < 2; ++n) acc[a][b][m][n] = (f32x4){0.f, 0.f, 0.f, 0.f};
        cur = nxt; cA = nA; cB = nB; ++ui;
        if constexpr (ALIGN_EPI) { if (wr == 1) PG8_BAR; }
    }
    PG8_WAIT_V(0);
    if constexpr (!ALIGN_EPI) { if (wr == 0) PG8_BAR; }
    PG8_BAR;
    if constexpr (Epi::AFTER_DRAIN) { E.fused(acc, cur, wr, wc, fr, fq, lds, wid, lane); S.done(cur); }
#undef PG8_SA
#undef PG8_SB
#undef PG8_STAGE
#undef PG8_LDA
#undef PG8_LDB
#undef PG8_MMA
#undef PG8_WAIT_V
#undef PG8_WAIT_L
#undef PG8_BAR
#undef PG8_SCHED
}
}

#define LAS __attribute__((address_space(3)))
typedef pg8::bf16_t bf16_t;
typedef pg8::bf16x8 bf16x8;
typedef pg8::f32x4 f32x4;
typedef pg8::u32x4 u32x4;
typedef unsigned u32x2 __attribute__((ext_vector_type(2)));
typedef float f32x2v __attribute__((ext_vector_type(2)));
using pg8::cvt_pk_bf16;
using pg8::fast_sigmoid;
using pg8::fast_silu;

constexpr int D = 1024, NB = 4, SEQ = 8192, NTOK = NB * SEQ;
#ifndef MK_NSPLIT
#define MK_NSPLIT 4
#endif
constexpr int NSPLIT = MK_NSPLIT, TS = SEQ / NSPLIT, MS = NB * TS;
constexpr int CL = 9728;
constexpr int C_R = 0, C_K = 1024, C_V = 2048, C_WLO = 3072, C_ALO = 3136, C_GLO = 3200, C_HQ = 3584, C_HF = 4608, C_HI = 5632, C_HG = 6656, C_GA = 7680, C_GB = 8704;
constexpr int CARRY_LD = 3584;
constexpr int DFF = 2816;
constexpr size_t MiB = 1u << 20, KiB = 1u << 10;
constexpr size_t WS_WIN = 0, WS_WOUT = 19 * MiB, WS_WQ = 21 * MiB, WS_WO = 23 * MiB, WS_WKV = 25 * MiB, WS_W13 = 29 * MiB, WS_W2 = 40 * MiB;
constexpr size_t WS_RW2T = 46 * MiB, WS_RA2T = 46 * MiB + 128 * KiB, WS_RG2T = 46 * MiB + 256 * KiB, WS_CARRY = 46 * MiB + 640 * KiB, WS_LB = 46 * MiB + 704 * KiB;
constexpr size_t WS_MBF = 47 * MiB, WS_KV = 49 * MiB, WS_VT = 53 * MiB, WS_RWST = 55 * MiB, WS_HGST = 56 * MiB, WS_BONUS = 58 * MiB;
constexpr size_t WS_KMAX = 58 * MiB + 768 * KiB;
constexpr size_t WS_G2TP = 59 * MiB;
constexpr size_t WS_SS1 = 60 * MiB, WS_SS2 = 62 * MiB;
constexpr size_t WS_MERGED = 64 * MiB;
constexpr size_t WS_U1 = 128 * MiB, WS_COLS = 144 * MiB, WS_PR = 296 * MiB, WS_PK = 312 * MiB, WS_PA = 328 * MiB, WS_PB = 344 * MiB, WS_PV = 360 * MiB, WS_PW = 376 * MiB, WS_ORAW = 408 * MiB, WS_HGO = 440 * MiB;
constexpr size_t WS_GATE = 472 * MiB, WS_ASG = 488 * MiB;
constexpr size_t WS_U = 128 * MiB, WS_Q = 192 * MiB, WS_AO = 256 * MiB, WS_FF = 320 * MiB, WS_CTL = 496 * MiB, CTL_BYTES = 64 * KiB, WS_END = 496 * MiB + 64 * KiB;
constexpr int LDS_BYTES = 147456, MISC_OFF = 131072 + 320;
constexpr int T0 = 1 + 5 * NSPLIT, N_PHASES = T0 + 9;

__device__ __forceinline__ float bflo(unsigned u) { return __uint_as_float(u << 16); }
__device__ __forceinline__ float bfhi(unsigned u) { return __uint_as_float(u & 0xffff0000u); }
__device__ __forceinline__ unsigned f2bf(float f) { unsigned u = __float_as_uint(f); return (u + 0x7fffu + ((u >> 16) & 1u)) >> 16; }
__device__ __forceinline__ f32x4 ld4bf(const bf16_t* p) { const u32x2 u = *(const u32x2*)p; return (f32x4){bflo(u.x), bfhi(u.x), bflo(u.y), bfhi(u.y)}; }
__device__ __forceinline__ f32x4 up4(u32x2 u) { return (f32x4){bflo(u.x), bfhi(u.x), bflo(u.y), bfhi(u.y)}; }
__device__ __forceinline__ void ld8bf(const bf16_t* p, float (&o)[8]) { const u32x4 u = *(const u32x4*)p; o[0] = bflo(u.x); o[1] = bfhi(u.x); o[2] = bflo(u.y); o[3] = bfhi(u.y); o[4] = bflo(u.z); o[5] = bfhi(u.z); o[6] = bflo(u.w); o[7] = bfhi(u.w); }
__device__ __forceinline__ void st4bf(bf16_t* p, f32x4 v) { u32x2 w; w.x = cvt_pk_bf16(v[0], v[1]); w.y = cvt_pk_bf16(v[2], v[3]); *(u32x2*)p = w; }
__device__ __forceinline__ bf16x8 pack8(const float (&t)[8]) { u32x4 w; w.x = cvt_pk_bf16(t[0], t[1]); w.y = cvt_pk_bf16(t[2], t[3]); w.z = cvt_pk_bf16(t[4], t[5]); w.w = cvt_pk_bf16(t[6], t[7]); return __builtin_bit_cast(bf16x8, w); }
__device__ __forceinline__ float tanh_fast(float x) { return 1.0f - 2.0f * __builtin_amdgcn_rcpf(1.0f + __expf(2.0f * x)); }
__device__ __forceinline__ float wave_sum(float v) {
#pragma unroll
    for (int o = 1; o < 64; o <<= 1) v += __shfl_xor(v, o);
    return v;
}
__device__ __forceinline__ float fq_sum(float v) { v += __shfl_xor(v, 16); v += __shfl_xor(v, 32); return v; }
template <int CTRL> __device__ __forceinline__ float dpp_add(float x) { return x + __builtin_bit_cast(float, __builtin_amdgcn_update_dpp(0, __builtin_bit_cast(int, x), CTRL, 0xf, 0xf, false)); }
#ifdef MK_SHFL_REDUCE
__device__ __forceinline__ float allreduce16(float x) { x += __shfl_xor(x, 1); x += __shfl_xor(x, 2); x += __shfl_xor(x, 4); x += __shfl_xor(x, 8); return x; }
#else
__device__ __forceinline__ float allreduce16(float x) { x = dpp_add<0xB1>(x); x = dpp_add<0x4E>(x); x = dpp_add<0x141>(x); x = dpp_add<0x140>(x); return x; }
#endif
__device__ __forceinline__ void allreduce16x2(float& x, float& y) {
    x = dpp_add<0xB1>(x); y = dpp_add<0xB1>(y); x = dpp_add<0x4E>(x); y = dpp_add<0x4E>(y); x = dpp_add<0x141>(x); y = dpp_add<0x141>(y); x = dpp_add<0x140>(x); y = dpp_add<0x140>(y); }
#define MFMA16(a, b, c) __builtin_amdgcn_mfma_f32_16x16x32_bf16((a), (b), (c), 0, 0, 0)

#define XB_TMO      128
#define XB_XCNT(j)  (256  + 64 * (j))
#define XB_XSUB(j)  (1280 + 64 * (j))
#define XB_XGEN(j)  (2304 + 64 * (j))
#define XB_TOP      3328
#define XB_TOPGEN   3392
#define XCD_BAR_WORDS 3456
#define XB_SPIN_CAP (1u << 18)

__device__ __forceinline__ unsigned xb_ld(unsigned* p)              { return __hip_atomic_load(p, __ATOMIC_RELAXED, __HIP_MEMORY_SCOPE_AGENT); }
__device__ __forceinline__ unsigned xb_add(unsigned* p, unsigned v) { return __hip_atomic_fetch_add(p, v, __ATOMIC_RELAXED, __HIP_MEMORY_SCOPE_AGENT); }
__device__ __forceinline__ unsigned xb_xcc_id() { return (unsigned)__builtin_amdgcn_s_getreg((3 << 11) | 20) & 0xFu; }
#define XB_SPIN(cond, bar) do { unsigned _sp = 0; while (cond) { __builtin_amdgcn_s_sleep(1); \
    if ((++_sp & 255u) == 0u) { if (xb_ld(&(bar)[XB_TMO])) break; if (_sp > XB_SPIN_CAP) { atomicAdd(&(bar)[XB_TMO], 1u); break; } } } } while (0)

struct XcdBarrier {
    unsigned* bar; unsigned x;
    volatile LAS unsigned* st;
};

__device__ __forceinline__ XcdBarrier xcd_barrier_post(unsigned* bar, volatile LAS unsigned* st) {
    XcdBarrier b; b.bar = bar; b.x = xb_xcc_id(); b.st = st;
    if (threadIdx.x == 0) (void)xb_add(&bar[XB_XCNT(b.x)], 1u);
    return b;
}
__device__ __forceinline__ void xcd_barrier_complete(unsigned* bar, unsigned x, unsigned& nloc, unsigned& nx) {
    const unsigned G = gridDim.x * gridDim.y * gridDim.z;
    unsigned sum, cnt, mine, sp = 0u;
    for (;;) {
        sum = 0u; cnt = 0u; mine = 0u;
#pragma unroll
        for (unsigned j = 0; j < 16; ++j) { const unsigned c = xb_ld(&bar[XB_XCNT(j)]); sum += c; cnt += (c > 0u) ? 1u : 0u; mine = (j == x) ? c : mine; }
        if (sum == G) break;
        __builtin_amdgcn_s_sleep(1);
        if ((++sp & 255u) == 0u) { if (xb_ld(&bar[XB_TMO])) break; if (sp > XB_SPIN_CAP) { atomicAdd(&bar[XB_TMO], 1u); break; } }
    }
    nloc = mine > 0u ? mine : 1u; nx = cnt > 0u ? cnt : 1u;
}

__device__ __forceinline__ void xcd_barrier(const XcdBarrier& b) {
    asm volatile("s_waitcnt vmcnt(0)" ::: "memory");
    __syncthreads();
    if (threadIdx.x == 0) {
        unsigned* bar = b.bar;
        __builtin_amdgcn_s_waitcnt(0);
        unsigned nloc = b.st[0], nx = b.st[1];
        if (nloc == 0u) { xcd_barrier_complete(bar, b.x, nloc, nx); b.st[0] = nloc; b.st[1] = nx; }
        const unsigned old = xb_add(&bar[XB_XSUB(b.x)], 1u);
        const unsigned gen = old / nloc;
        if (old + 1u == (gen + 1u) * nloc) {
            __builtin_amdgcn_fence(__ATOMIC_RELEASE, "agent");
            asm volatile("s_waitcnt vmcnt(0)" ::: "memory");
            const unsigned og = xb_add(&bar[XB_TOP], 1u);
            const unsigned tg = og / nx;
            if (og + 1u == (tg + 1u) * nx) xb_add(&bar[XB_TOPGEN], 1u);
            else XB_SPIN(xb_ld(&bar[XB_TOPGEN]) == tg, bar);
            __builtin_amdgcn_fence(__ATOMIC_ACQUIRE, "agent");
            xb_add(&bar[XB_XGEN(b.x)], 1u);
            asm volatile("s_waitcnt vmcnt(0)" ::: "memory");
        } else {
            XB_SPIN(xb_ld(&bar[XB_XGEN(b.x)]) == gen, bar);
            __builtin_amdgcn_fence(__ATOMIC_ACQUIRE, "agent");
            asm volatile("s_waitcnt vmcnt(0)" ::: "memory");
        }
    }
    __syncthreads();
}

__device__ __forceinline__ void rms_row_bf16(const float* src, const float* g, bf16_t* dst, int lane) {
    f32x4 v[4]; float s = 0.f;
#pragma unroll
    for (int j = 0; j < 4; ++j) { v[j] = ((const f32x4*)src)[lane + 64 * j]; s += (v[j][0] * v[j][0] + v[j][1] * v[j][1]) + (v[j][2] * v[j][2] + v[j][3] * v[j][3]); }
    const float rs = 1.0f / sqrtf(wave_sum(s) * (1.0f / 1024.0f) + 1e-6f);
#pragma unroll
    for (int j = 0; j < 4; ++j) { const f32x4 gv = ((const f32x4*)g)[lane + 64 * j]; st4bf(dst + 4 * (lane + 64 * j), v[j] * rs * gv); }
}
__device__ __forceinline__ void tr_item(const float* W, int K, int N, bf16_t* WT, int kb, int n0, int row_base, LAS float* scr, int lane) {
    const int k0 = 64 * kb;
#pragma unroll 8
    for (int i = 0; i < 32; ++i) { const int kk = 2 * i + (lane >> 5); scr[kk * 33 + (lane & 31)] = W[(size_t)(k0 + kk) * N + n0 + (lane & 31)]; }
    asm volatile("s_waitcnt lgkmcnt(0)" ::: "memory");
    const int c = lane & 7;
#pragma unroll
    for (int j = 0; j < 4; ++j) { const int n = (lane >> 3) + 8 * j; const LAS float* sp = scr + (8 * c) * 33 + n;
        u32x4 o; o.x = cvt_pk_bf16(sp[0 * 33], sp[1 * 33]); o.y = cvt_pk_bf16(sp[2 * 33], sp[3 * 33]); o.z = cvt_pk_bf16(sp[4 * 33], sp[5 * 33]); o.w = cvt_pk_bf16(sp[6 * 33], sp[7 * 33]);
        *(u32x4*)(WT + (size_t)(row_base + n) * K + k0 + 8 * c) = o; }
    asm volatile("s_waitcnt lgkmcnt(0)" ::: "memory");
}

__device__ __forceinline__ void prep_phase(int s, int gw, int NGW, int lane, const bf16_t* cols, const bf16_t* carry,
        const float* mu, const float* w0, const float* a0, const float* k_k, const float* k_a, const float* r_k,
        const bf16_t* w2T, const bf16_t* a2T, bf16_t* PR, bf16_t* PK, bf16_t* PA, bf16_t* PB, bf16_t* PV, float* PW, float* bonus, bf16_t* ASG) {
    const int fr = lane & 15, fq = lane >> 4;
    for (int item = gw; item < (MS / 16) * 4; item += NGW) {
        const int tile = item >> 2, hg4 = item & 3;
        const int lt = tile * 16 + fr, b = lt / TS, tl = lt % TS;
        const bf16_t* crow = cols + (size_t)lt * CL;
        const bf16_t* prow = tl > 0 ? crow - CL : carry + ((s & 1) * 4 + b) * CARRY_LD;
        bf16x8 Aw[2], Aa[2];
#pragma unroll
        for (int ks = 0; ks < 2; ++ks) {
            { const int c = C_WLO + ks * 32 + fq * 8; float cur[8], prv[8], t[8]; ld8bf(crow + c, cur); ld8bf(prow + c, prv);
              const f32x4 m0 = *(const f32x4*)(mu + c), m1 = *(const f32x4*)(mu + c + 4);
#pragma unroll
              for (int e = 0; e < 8; ++e) { const float mm = e < 4 ? m0[e & 3] : m1[e & 3]; t[e] = tanh_fast(cur[e] + mm * (prv[e] - cur[e])); }
              Aw[ks] = pack8(t); }
            { const int c = C_ALO + ks * 32 + fq * 8; float cur[8], prv[8], t[8]; ld8bf(crow + c, cur); ld8bf(prow + c, prv);
              const f32x4 m0 = *(const f32x4*)(mu + c), m1 = *(const f32x4*)(mu + c + 4);
#pragma unroll
              for (int e = 0; e < 8; ++e) { const float mm = e < 4 ? m0[e & 3] : m1[e & 3]; t[e] = cur[e] + mm * (prv[e] - cur[e]); }
              Aa[ks] = pack8(t); }
        }
        if (hg4 == 0) {
#pragma unroll
            for (int ks = 0; ks < 5; ++ks) { const int c = C_GLO + ks * 32 + fq * 8; float cur[8], prv[8], t[8]; ld8bf(crow + c, cur); ld8bf(prow + c, prv);
                const f32x4 m0 = *(const f32x4*)(mu + c), m1 = *(const f32x4*)(mu + c + 4);
#pragma unroll
                for (int e = 0; e < 8; ++e) { const float mm = e < 4 ? m0[e & 3] : m1[e & 3]; t[e] = fast_sigmoid(cur[e] + mm * (prv[e] - cur[e])); }
                *(bf16x8*)(ASG + (size_t)lt * 256 + ks * 32 + fq * 8) = pack8(t); }
#pragma unroll
            for (int ks = 5; ks < 8; ++ks) *(u32x4*)(ASG + (size_t)lt * 256 + ks * 32 + fq * 8) = (u32x4){0u, 0u, 0u, 0u};
        }
#pragma unroll 1
        for (int hh = 0; hh < 4; ++hh) {
            const int h = hg4 * 4 + hh;
            f32x4 aw[4], aa[4];
#pragma unroll
            for (int nt = 0; nt < 4; ++nt) { aw[nt] = (f32x4){0.f, 0.f, 0.f, 0.f}; aa[nt] = (f32x4){0.f, 0.f, 0.f, 0.f};
                const int n = h * 64 + nt * 16 + fr;
#pragma unroll
                for (int ks = 0; ks < 2; ++ks) { const bf16x8 bw = *(const bf16x8*)(w2T + n * 64 + ks * 32 + fq * 8); aw[nt] = MFMA16(bw, Aw[ks], aw[nt]);
                    const bf16x8 ba = *(const bf16x8*)(a2T + n * 64 + ks * 32 + fq * 8); aa[nt] = MFMA16(ba, Aa[ks], aa[nt]); } }
            f32x4 kkv[4], av[4]; float ssq = 0.f, bon = 0.f;
#pragma unroll
            for (int nt = 0; nt < 4; ++nt) {
                const int c = h * 64 + nt * 16 + 4 * fq; const size_t o = ((size_t)(b * 16 + h) * TS + tl) * 64 + nt * 16 + 4 * fq;
                const f32x4 rc = ld4bf(crow + C_R + c), rp = ld4bf(prow + C_R + c), kc = ld4bf(crow + C_K + c), kp = ld4bf(prow + C_K + c), vc = ld4bf(crow + C_V + c), vp = ld4bf(prow + C_V + c);
                const f32x4 r = rc + *(const f32x4*)(mu + C_R + c) * (rp - rc), k = kc + *(const f32x4*)(mu + C_K + c) * (kp - kc), v = vc + *(const f32x4*)(mu + C_V + c) * (vp - vc);
                const f32x4 w0v = *(const f32x4*)(w0 + c), a0v = *(const f32x4*)(a0 + c), kkp = *(const f32x4*)(k_k + c), kap = *(const f32x4*)(k_a + c), rkp = *(const f32x4*)(r_k + c);
                f32x4 wv, a, kk, kmod;
#pragma unroll
                for (int j = 0; j < 4; ++j) {
                    const float z = -(w0v[j] + aw[nt][j]);
                    const float sp = fmaxf(z, 0.f) + __logf(1.0f + __expf(-fabsf(z)));
                    wv[j] = __expf(-__expf(-sp - 0.5f));
                    a[j] = fast_sigmoid(a0v[j] + aa[nt][j]);
                    kk[j] = k[j] * kkp[j]; kmod[j] = k[j] * (1.0f + (a[j] - 1.0f) * kap[j]);
                    ssq += kk[j] * kk[j]; bon += r[j] * kmod[j] * rkp[j];
                }
                kkv[nt] = kk; av[nt] = a;
                st4bf(PR + o, r); st4bf(PK + o, kmod); st4bf(PV + o, v); *(f32x4*)(PW + o) = wv;
            }
            ssq = fq_sum(ssq); bon = fq_sum(bon);
            const float rs = 1.0f / sqrtf(fmaxf(ssq, 1e-24f));
#pragma unroll
            for (int nt = 0; nt < 4; ++nt) { const size_t o = ((size_t)(b * 16 + h) * TS + tl) * 64 + nt * 16 + 4 * fq;
                const f32x4 kn = kkv[nt] * rs; st4bf(PA + o, -kn); st4bf(PB + o, kn * av[nt]); }
            if (fq == 0) bonus[lt * 16 + h] = bon;
        }
    }
}

__device__ __forceinline__ void post_phase(int s, int gw, int NGW, int lane, const bf16_t* cols, const bf16_t* carry, const float* mu, const bf16_t* gate,
        const float* ln_w, const float* ln_b, const float* hg_g, const float* oraw, const float* hgo, const bf16_t* PV, const float* bonus, bf16_t* merged) {
    const int fr = lane & 15, fq = lane >> 4;
    for (int item = gw; item < (MS / 16) * 4; item += NGW) {
        const int tile = item >> 2, q4 = item & 3;
        const int lt = tile * 16 + fr, b = lt / TS, tl = lt % TS;
        const size_t gt = (size_t)b * SEQ + s * TS + tl;
        const bf16_t* crow = cols + (size_t)lt * CL;
        const bf16_t* prow = tl > 0 ? crow - CL : carry + ((s & 1) * 4 + b) * CARRY_LD;
#pragma unroll 1
        for (int hgh = 0; hgh < 2; ++hgh) {
            const int h8 = q4 * 2 + hgh;
            f32x4 ho[8]; float ss = 0.f;
#pragma unroll
            for (int n8 = 0; n8 < 8; ++n8) { ho[n8] = *(const f32x4*)(hgo + ((size_t)((b * 8 + h8) * 8 + n8) * TS + tl) * 16 + 4 * fq); ss += (ho[n8][0] * ho[n8][0] + ho[n8][1] * ho[n8][1]) + (ho[n8][2] * ho[n8][2] + ho[n8][3] * ho[n8][3]); }
            ss = fq_sum(ss);
            const float rsh = 1.0f / sqrtf(ss * (1.0f / 128.0f) + 1e-6f);
#pragma unroll
            for (int rwh = 0; rwh < 2; ++rwh) {
                const int h = q4 * 4 + hgh * 2 + rwh;
                f32x4 ag[4], o[4]; float sm = 0.f;
#pragma unroll
                for (int nt = 0; nt < 4; ++nt) { ag[nt] = ld4bf(gate + (size_t)lt * 1024 + h * 64 + nt * 16 + 4 * fq);
                    o[nt] = *(const f32x4*)(oraw + ((size_t)((b * 16 + h) * 4 + nt) * TS + tl) * 16 + 4 * fq); sm += (o[nt][0] + o[nt][1]) + (o[nt][2] + o[nt][3]); }
                const float mean = fq_sum(sm) * (1.0f / 64.0f); float vq = 0.f;
#pragma unroll
                for (int nt = 0; nt < 4; ++nt) { o[nt] = o[nt] - mean; vq += (o[nt][0] * o[nt][0] + o[nt][1] * o[nt][1]) + (o[nt][2] * o[nt][2] + o[nt][3] * o[nt][3]); }
                const float rstd = 1.0f / sqrtf(fq_sum(vq) * (1.0f / 64.0f) + 64e-5f);
#ifdef MK_NO_BONUS
                const float bon = 0.f;
#else
                const float bon = bonus[lt * 16 + h];
#endif
#pragma unroll
                for (int nt = 0; nt < 4; ++nt) {
                    const int c = h * 64 + nt * 16 + 4 * fq;
                    const f32x4 lw = *(const f32x4*)(ln_w + c), lb = *(const f32x4*)(ln_b + c), v = ld4bf(PV + ((size_t)(b * 16 + h) * TS + tl) * 64 + nt * 16 + 4 * fq);
                    const f32x4 ya = (o[nt] * rstd * lw + lb + v * bon) * ag[nt];
                    const f32x4 ng = *(const f32x4*)(hg_g + (c & 127)), gh = ld4bf(crow + C_HG + c), gar = ld4bf(crow + C_GA + c), gbr = ld4bf(crow + C_GB + c);
                    const f32x4 hv = ho[rwh * 4 + nt] * rsh * ng;
                    f32x4 m;
#pragma unroll
                    for (int j = 0; j < 4; ++j) {
#if defined(MK_ZERO_YA)
                        m[j] = fast_sigmoid(gbr[j]) * (hv[j] * fast_silu(gh[j]));
#elif defined(MK_ZERO_YB)
                        m[j] = fast_sigmoid(gar[j]) * ya[j];
#else
                        m[j] = gar[j] * ya[j] + gbr[j] * (hv[j] * gh[j]);
#endif
                    }
                    st4bf(merged + gt * 1024 + c, m);
                }
            }
        }
    }
}

constexpr int RWB = 45056;
#define SCAN_BAR_L() do { asm volatile("s_waitcnt vmcnt(0) lgkmcnt(0)" ::: "memory"); __builtin_amdgcn_s_barrier(); asm volatile("" ::: "memory"); } while (0)
#define SCAN_BAR_S() do { asm volatile("s_waitcnt lgkmcnt(0)" ::: "memory"); __builtin_amdgcn_s_barrier(); asm volatile("" ::: "memory"); } while (0)
__device__ __forceinline__ void rw_load(LAS unsigned char* bp, int lt2, size_t ltok0, int h, int rg, const bf16_t* PA, const float* PW, const bf16_t* PB, const bf16_t* PK, const bf16_t* PR, const bf16_t* PV) {
    const int tok = lt2 >> 3, c8 = (lt2 & 7) * 8; const size_t base = (ltok0 + tok) * 1024 + h * 64 + c8;
    const u32x4 ra = *(const u32x4*)(PA + base), rb = *(const u32x4*)(PB + base), rk = *(const u32x4*)(PK + base), rr = *(const u32x4*)(PR + base);
    const f32x4 w0 = *(const f32x4*)(PW + base), w1 = *(const f32x4*)(PW + base + 4);
    const unsigned rv = *(const unsigned*)(PV + (ltok0 + tok) * 1024 + h * 64 + rg * 16 + (lt2 & 7) * 2);
    const int off = (tok * 64 + c8) * 4;
#define RW_PUT(arr, u) do { *(LAS f32x4*)(bp + (arr) * 8192 + off) = (f32x4){bflo(u.x), bfhi(u.x), bflo(u.y), bfhi(u.y)}; *(LAS f32x4*)(bp + (arr) * 8192 + off + 16) = (f32x4){bflo(u.z), bfhi(u.z), bflo(u.w), bfhi(u.w)}; } while (0)
    RW_PUT(0, ra); RW_PUT(2, rb); RW_PUT(3, rk); RW_PUT(4, rr);
#undef RW_PUT
    *(LAS f32x4*)(bp + 8192 + off) = w0; *(LAS f32x4*)(bp + 8192 + off + 16) = w1;
    *(LAS f32x2v*)(bp + 40960 + (tok * 16 + (lt2 & 7) * 2) * 4) = (f32x2v){bflo(rv), bfhi(rv)};
}
__device__ __forceinline__ void y_drain(const LAS unsigned char* ybase, int lt2, float* dst) { *(f32x2v*)(dst + lt2 * 2) = *(const LAS f32x2v*)(ybase + lt2 * 8); }
__device__ __forceinline__ void rwkv_scan(int s, int bid, int G, int tid, int lane, int wave, LAS unsigned char* lds,
        const bf16_t* PA, const float* PW, const bf16_t* PB, const bf16_t* PK, const bf16_t* PR, const bf16_t* PV, float* oraw, float* state, bool save) {
    constexpr int NBLK = TS / 32;
    const int rowl = lane >> 4, j = lane & 15, row = (wave & 3) * 4 + rowl;
    for (int it = bid; it < 256; it += G) {
        const int b = it >> 6, h = (it >> 2) & 15, rg = it & 3;
        const size_t tok0 = (size_t)b * TS;
        float* stp = state + ((size_t)((b * 16 + h) * 64 + rg * 16 + row) * 64 + 4 * j);
        float* obase = oraw + (size_t)it * TS * 16;
        f32x4 st = (f32x4){0.f, 0.f, 0.f, 0.f};
        if (wave < 4 && s > 0) st = *(const f32x4*)stp;
        if (wave >= 4) { rw_load(lds, tid - 256, tok0, h, rg, PA, PW, PB, PK, PR, PV); SCAN_BAR_L(); } else { __builtin_amdgcn_s_setprio(2); asm volatile("s_waitcnt vmcnt(0)" ::: "memory"); SCAN_BAR_S(); }
#pragma unroll 1
        for (int blk = 0; blk < NBLK; ++blk) {
            if (wave >= 4) {
                if (blk > 0) y_drain(lds + ((blk - 1) & 1) * RWB + 43008, tid - 256, obase + (size_t)(blk - 1) * 512);
                if (blk + 1 < NBLK) rw_load(lds + ((blk + 1) & 1) * RWB, tid - 256, tok0 + (blk + 1) * 32, h, rg, PA, PW, PB, PK, PR, PV);
                SCAN_BAR_L();
            } else {
                const LAS unsigned char* bp = lds + (blk & 1) * RWB;
                const LAS unsigned char* p4 = bp + 16 * j; const LAS unsigned char* pv = bp + 40960 + row * 4; LAS unsigned char* py = (LAS unsigned char*)bp + 43008 + row * 4;
                f32x4 a4 = *(const LAS f32x4*)(p4), w4 = *(const LAS f32x4*)(p4 + 8192), b4 = *(const LAS f32x4*)(p4 + 16384), k4 = *(const LAS f32x4*)(p4 + 24576), r4 = *(const LAS f32x4*)(p4 + 32768);
                float vv = *(const LAS float*)(pv);
                float sa = (st[0] * a4[0] + st[1] * a4[1]) + (st[2] * a4[2] + st[3] * a4[3]);
                sa = allreduce16(sa);
#pragma unroll
                for (int t = 0; t < 32; ++t) {
                    f32x4 na = a4, nw = w4, nb = b4, nk = k4, nr = r4; float nv = vv;
                    if (t < 31) { const int o = (t + 1) * 256; na = *(const LAS f32x4*)(p4 + o); nw = *(const LAS f32x4*)(p4 + 8192 + o); nb = *(const LAS f32x4*)(p4 + 16384 + o); nk = *(const LAS f32x4*)(p4 + 24576 + o); nr = *(const LAS f32x4*)(p4 + 32768 + o); nv = *(const LAS float*)(pv + (t + 1) * 64); }
                    st = st * w4 + (b4 * sa + k4 * vv);
                    float y = (st[0] * r4[0] + st[1] * r4[1]) + (st[2] * r4[2] + st[3] * r4[3]);
                    float sn = (st[0] * na[0] + st[1] * na[1]) + (st[2] * na[2] + st[3] * na[3]);
                    allreduce16x2(sn, y);
                    if (j == 0) *(LAS float*)(py + t * 64) = y;
                    sa = sn; a4 = na; w4 = nw; b4 = nb; k4 = nk; r4 = nr; vv = nv;
                }
                SCAN_BAR_S();
            }
        }
        if (wave >= 4) { y_drain(lds + ((NBLK - 1) & 1) * RWB + 43008, tid - 256, obase + (size_t)(NBLK - 1) * 512); }
        else { __builtin_amdgcn_s_setprio(0); if (save) *(f32x4*)stp = st; }
    }
}

__device__ __forceinline__ void rwkv_scan_naive(int s, int gw, int NGW, int lane, int wave, LAS unsigned char* lds,
        const bf16_t* PA, const float* PW, const bf16_t* PB, const bf16_t* PK, const bf16_t* PR, const bf16_t* PV, float* oraw, float* state) {
    LAS float* slab = (LAS float*)(lds + wave * 2048);
    for (int it = gw; it < 64; it += NGW) {
        const int b = it >> 4, h = it & 15;
        float st[64];
        float* stp = state + (size_t)((b * 16 + h) * 64 + lane) * 64;
#pragma unroll
        for (int k = 0; k < 64; ++k) st[k] = (s > 0) ? stp[k] : 0.f;
        for (int tl = 0; tl < TS; ++tl) {
            const size_t base = ((size_t)b * TS + tl) * 1024 + h * 64 + lane;
            slab[lane] = bflo((unsigned)PA[base]); slab[64 + lane] = PW[base]; slab[128 + lane] = bflo((unsigned)PB[base]); slab[192 + lane] = bflo((unsigned)PK[base]); slab[256 + lane] = bflo((unsigned)PR[base]);
            const float vv = bflo((unsigned)PV[base]);
            asm volatile("s_waitcnt lgkmcnt(0)" ::: "memory");
            float sa = 0.f;
#pragma unroll
            for (int k = 0; k < 64; ++k) sa += st[k] * slab[k];
            float y = 0.f;
#pragma unroll
            for (int k = 0; k < 64; ++k) { st[k] = st[k] * slab[64 + k] + (sa * slab[128 + k] + vv * slab[192 + k]); y += st[k] * slab[256 + k]; }
            asm volatile("s_waitcnt lgkmcnt(0)" ::: "memory");
            oraw[((size_t)(it * 4 + (lane >> 4)) * TS + tl) * 16 + (lane & 15)] = y;
        }
#pragma unroll
        for (int k = 0; k < 64; ++k) stp[k] = st[k];
    }
}
constexpr int HGB = 53248;
__device__ __forceinline__ void hg_load(LAS unsigned char* bp, int lt2, size_t ltok0, int h8, int rg, const bf16_t* cols, const float* lbv) {
    const int tok = lt2 >> 3, c16 = (lt2 & 7) * 16; const bf16_t* crow = cols + (ltok0 + tok) * CL;
    float q[16], f[16];
    { float t[8]; ld8bf(crow + C_HQ + h8 * 128 + c16, t);
#pragma unroll
      for (int e = 0; e < 8; ++e) q[e] = t[e];
      ld8bf(crow + C_HQ + h8 * 128 + c16 + 8, t);
#pragma unroll
      for (int e = 0; e < 8; ++e) q[8 + e] = t[e];
      ld8bf(crow + C_HF + h8 * 128 + c16, t);
#pragma unroll
      for (int e = 0; e < 8; ++e) f[e] = t[e];
      ld8bf(crow + C_HF + h8 * 128 + c16 + 8, t);
#pragma unroll
      for (int e = 0; e < 8; ++e) f[8 + e] = t[e]; }
    const unsigned rv = *(const unsigned*)(crow + C_HI + h8 * 128 + rg * 16 + (lt2 & 7) * 2);
    const int off = (tok * 128 + c16) * 4;
#pragma unroll
    for (int g = 0; g < 4; ++g) { const f32x4 lb = *(const f32x4*)(lbv + h8 * 128 + c16 + 4 * g); f32x4 fv, kv, qv;
#pragma unroll
        for (int e = 0; e < 4; ++e) { fv[e] = lb[e] + (1.0f - lb[e]) * fast_sigmoid(f[4 * g + e]); kv[e] = 1.0f - fv[e]; qv[e] = fast_silu(q[4 * g + e]); }
        *(LAS f32x4*)(bp + off + 16 * g) = fv; *(LAS f32x4*)(bp + 16384 + off + 16 * g) = kv; *(LAS f32x4*)(bp + 32768 + off + 16 * g) = qv; }
    *(LAS f32x2v*)(bp + 49152 + (tok * 16 + (lt2 & 7) * 2) * 4) = (f32x2v){bflo(rv), bfhi(rv)};
}
__device__ __forceinline__ void hgrn_scan(int s, int bid, int G, int tid, int lane, int wave, LAS unsigned char* lds, const bf16_t* cols, const float* lbv, float* hgo, float* state, bool save) {
    constexpr int NBLK = TS / 32;
    const int rowl = lane >> 4, j = lane & 15, row = (wave & 3) * 4 + rowl;
    for (int it = bid; it < 256; it += G) {
        const int b = it >> 6, h8 = (it >> 3) & 7, rg = it & 7;
        const size_t tok0 = (size_t)b * TS;
        float* stp = state + ((size_t)((b * 8 + h8) * 128 + rg * 16 + row) * 128 + 4 * j);
        float* obase = hgo + (size_t)it * TS * 16;
        f32x4 s0 = (f32x4){0.f, 0.f, 0.f, 0.f}, s1 = s0;
        if (wave < 4 && s > 0) { s0 = *(const f32x4*)stp; s1 = *(const f32x4*)(stp + 64); }
        if (wave >= 4) { hg_load(lds, tid - 256, tok0, h8, rg, cols, lbv); SCAN_BAR_L(); } else { __builtin_amdgcn_s_setprio(2); asm volatile("s_waitcnt vmcnt(0)" ::: "memory"); SCAN_BAR_S(); }
#pragma unroll 1
        for (int blk = 0; blk < NBLK; ++blk) {
            if (wave >= 4) {
                if (blk > 0) y_drain(lds + ((blk - 1) & 1) * HGB + 51200, tid - 256, obase + (size_t)(blk - 1) * 512);
                if (blk + 1 < NBLK) hg_load(lds + ((blk + 1) & 1) * HGB, tid - 256, tok0 + (blk + 1) * 32, h8, rg, cols, lbv);
                SCAN_BAR_L();
            } else {
                const LAS unsigned char* bp = lds + (blk & 1) * HGB;
                const LAS unsigned char* p4 = bp + 16 * j; const LAS unsigned char* pv = bp + 49152 + row * 4; LAS unsigned char* py = (LAS unsigned char*)bp + 51200 + row * 4;
                f32x4 f0 = *(const LAS f32x4*)(p4), f1 = *(const LAS f32x4*)(p4 + 256), k0 = *(const LAS f32x4*)(p4 + 16384), k1 = *(const LAS f32x4*)(p4 + 16384 + 256), q0 = *(const LAS f32x4*)(p4 + 32768), q1 = *(const LAS f32x4*)(p4 + 32768 + 256);
                float iv = *(const LAS float*)(pv); float yprev = 0.f;
#pragma unroll
                for (int t = 0; t < 32; ++t) {
                    f32x4 nf0 = f0, nf1 = f1, nk0 = k0, nk1 = k1, nq0 = q0, nq1 = q1; float niv = iv;
                    if (t < 31) { const int o = (t + 1) * 512; nf0 = *(const LAS f32x4*)(p4 + o); nf1 = *(const LAS f32x4*)(p4 + 256 + o); nk0 = *(const LAS f32x4*)(p4 + 16384 + o); nk1 = *(const LAS f32x4*)(p4 + 16384 + 256 + o);
                                  nq0 = *(const LAS f32x4*)(p4 + 32768 + o); nq1 = *(const LAS f32x4*)(p4 + 32768 + 256 + o); niv = *(const LAS float*)(pv + (t + 1) * 64); }
                    s0 = s0 * f0 + k0 * iv; s1 = s1 * f1 + k1 * iv;
                    float y = ((s0[0] * q0[0] + s0[1] * q0[1]) + (s0[2] * q0[2] + s0[3] * q0[3])) + ((s1[0] * q1[0] + s1[1] * q1[1]) + (s1[2] * q1[2] + s1[3] * q1[3]));
                    if (t & 1) { allreduce16x2(yprev, y); if (j == 0) { *(LAS float*)(py + (t - 1) * 64) = yprev; *(LAS float*)(py + t * 64) = y; } }
                    yprev = y;
                    f0 = nf0; f1 = nf1; k0 = nk0; k1 = nk1; q0 = nq0; q1 = nq1; iv = niv;
                }
                SCAN_BAR_S();
            }
        }
        if (wave >= 4) { y_drain(lds + ((NBLK - 1) & 1) * HGB + 51200, tid - 256, obase + (size_t)(NBLK - 1) * 512); }
        else { __builtin_amdgcn_s_setprio(0); if (save) { *(f32x4*)stp = s0; *(f32x4*)(stp + 64) = s1; } }
    }
}


constexpr int FT = 16;
constexpr int F_RW = 0, F_RWV = 20480, F_RWY = 21504, F_HG = 22528, F_HGQ = 8192, F_HGI = F_HG + 16384, F_HGY = F_HG + 17408, FBUF = 40960;
__device__ __forceinline__ void fused_load(LAS unsigned char* bp, int lt2, size_t ltok0, int h, int rg, int h8, int rg8, const bf16_t* PA, const float* PW, const bf16_t* PB, const bf16_t* PK, const bf16_t* PR, const bf16_t* PV,
        const bf16_t* cols, const float* lbv) {
    if (lt2 < 128) {
        const int tok = lt2 >> 3, c8 = (lt2 & 7) * 8; const size_t base = (ltok0 + tok) * 1024 + h * 64 + c8;
        const u32x4 ra = *(const u32x4*)(PA + base), rb = *(const u32x4*)(PB + base), rk = *(const u32x4*)(PK + base), rr = *(const u32x4*)(PR + base);
        const f32x4 w0 = *(const f32x4*)(PW + base), w1 = *(const f32x4*)(PW + base + 4);
        const unsigned rv = *(const unsigned*)(PV + (ltok0 + tok) * 1024 + h * 64 + rg * 16 + (lt2 & 7) * 2);
        const int off = (tok * 64 + c8) * 4;
#define RW_PUT(arr, u) do { *(LAS f32x4*)(bp + (arr) * 4096 + off) = (f32x4){bflo(u.x), bfhi(u.x), bflo(u.y), bfhi(u.y)}; *(LAS f32x4*)(bp + (arr) * 4096 + off + 16) = (f32x4){bflo(u.z), bfhi(u.z), bflo(u.w), bfhi(u.w)}; } while (0)
        RW_PUT(0, ra); RW_PUT(2, rb); RW_PUT(3, rk); RW_PUT(4, rr);
#undef RW_PUT
        *(LAS f32x4*)(bp + 4096 + off) = w0; *(LAS f32x4*)(bp + 4096 + off + 16) = w1;
        *(LAS f32x2v*)(bp + F_RWV + (tok * 16 + (lt2 & 7) * 2) * 4) = (f32x2v){bflo(rv), bfhi(rv)};
    } else {
        const int l = lt2 - 128, tok = l >> 3, c16 = (l & 7) * 16; const bf16_t* crow = cols + (ltok0 + tok) * CL;
        float q[16], f[16];
        { float t[8]; ld8bf(crow + C_HQ + h8 * 128 + c16, t);
#pragma unroll
          for (int e = 0; e < 8; ++e) q[e] = t[e];
          ld8bf(crow + C_HQ + h8 * 128 + c16 + 8, t);
#pragma unroll
          for (int e = 0; e < 8; ++e) q[8 + e] = t[e];
          ld8bf(crow + C_HF + h8 * 128 + c16, t);
#pragma unroll
          for (int e = 0; e < 8; ++e) f[e] = t[e];
          ld8bf(crow + C_HF + h8 * 128 + c16 + 8, t);
#pragma unroll
          for (int e = 0; e < 8; ++e) f[8 + e] = t[e]; }
        const unsigned rv = *(const unsigned*)(crow + C_HI + h8 * 128 + rg8 * 16 + (l & 7) * 2);
        LAS unsigned char* hp = bp + F_HG; const int off = (tok * 128 + c16) * 4;
#pragma unroll
        for (int g = 0; g < 4; ++g) { const f32x4 lb = *(const f32x4*)(lbv + h8 * 128 + c16 + 4 * g); f32x4 fv, qv;
#pragma unroll
            for (int e = 0; e < 4; ++e) { fv[e] = lb[e] + (1.0f - lb[e]) * f[4 * g + e]; qv[e] = q[4 * g + e]; }
            *(LAS f32x4*)(hp + off + 16 * g) = fv; *(LAS f32x4*)(hp + F_HGQ + off + 16 * g) = qv; }
        *(LAS f32x2v*)(bp + F_HGI + (tok * 16 + (l & 7) * 2) * 4) = (f32x2v){bflo(rv), bfhi(rv)};
    }
}
__device__ __forceinline__ void fused_drain(const LAS unsigned char* bp, int lt2, float* orw, float* ohg) {
    if (lt2 < 128) *(f32x2v*)(orw + lt2 * 2) = *(const LAS f32x2v*)(bp + F_RWY + lt2 * 8);
    else *(f32x2v*)(ohg + (lt2 - 128) * 2) = *(const LAS f32x2v*)(bp + F_HGY + (lt2 - 128) * 8);
}
__device__ __forceinline__ void fused_scan(int s, int bid, int G, int tid, int lane, int wave, LAS unsigned char* lds,
        const bf16_t* PA, const float* PW, const bf16_t* PB, const bf16_t* PK, const bf16_t* PR, const bf16_t* PV, const bf16_t* cols, const float* lbv,
        float* oraw, float* hgo, float* rwstate, float* hgstate, bool save) {
    constexpr int NBLK = TS / FT;
    const int rowl = lane >> 4, j = lane & 15, row = (wave & 3) * 4 + rowl;
    for (int it = bid; it < 256; it += G) {
        const int b = it >> 6, h = (it >> 2) & 15, rg = it & 3, h8 = (it >> 3) & 7, rg8 = it & 7;
        const size_t tok0 = (size_t)b * TS;
        float* stp = rwstate + ((size_t)((b * 16 + h) * 64 + rg * 16 + row) * 64 + 4 * j);
        float* shp = hgstate + ((size_t)((b * 8 + h8) * 128 + rg8 * 16 + row) * 128 + 4 * j);
        float* orw = oraw + (size_t)it * TS * 16; float* ohg = hgo + (size_t)it * TS * 16;
        f32x4 st = (f32x4){0.f, 0.f, 0.f, 0.f}, s0 = st, s1 = st;
        if (wave < 4 && s > 0) { st = *(const f32x4*)stp; s0 = *(const f32x4*)shp; s1 = *(const f32x4*)(shp + 64); }
        if (wave >= 4) { fused_load(lds, tid - 256, tok0, h, rg, h8, rg8, PA, PW, PB, PK, PR, PV, cols, lbv); SCAN_BAR_L(); } else { __builtin_amdgcn_s_setprio(2); asm volatile("s_waitcnt vmcnt(0)" ::: "memory"); SCAN_BAR_S(); }
#pragma unroll 1
        for (int blk = 0; blk < NBLK; ++blk) {
            if (wave >= 4) {
                if (blk > 0) fused_drain(lds + ((blk - 1) & 1) * FBUF, tid - 256, orw + (size_t)(blk - 1) * (FT * 16), ohg + (size_t)(blk - 1) * (FT * 16));
                if (blk + 1 < NBLK) fused_load(lds + ((blk + 1) & 1) * FBUF, tid - 256, tok0 + (blk + 1) * FT, h, rg, h8, rg8, PA, PW, PB, PK, PR, PV, cols, lbv);
                SCAN_BAR_L();
            } else {
                const LAS unsigned char* bp = lds + (blk & 1) * FBUF;
                const LAS unsigned char* p4 = bp + 16 * j; const LAS unsigned char* pv = bp + F_RWV + row * 4; LAS unsigned char* py = (LAS unsigned char*)bp + F_RWY + row * 4;
                const LAS unsigned char* g4 = bp + F_HG + 16 * j; const LAS unsigned char* gi = bp + F_HGI + row * 4; LAS unsigned char* gy = (LAS unsigned char*)bp + F_HGY + row * 4;
                f32x4 a4 = *(const LAS f32x4*)(p4), w4 = *(const LAS f32x4*)(p4 + 4096), b4 = *(const LAS f32x4*)(p4 + 8192), k4 = *(const LAS f32x4*)(p4 + 12288), r4 = *(const LAS f32x4*)(p4 + 16384);
                float vv = *(const LAS float*)(pv);
                f32x4 f0 = *(const LAS f32x4*)(g4), f1 = *(const LAS f32x4*)(g4 + 256), q0 = *(const LAS f32x4*)(g4 + F_HGQ), q1 = *(const LAS f32x4*)(g4 + F_HGQ + 256);
                float iv = *(const LAS float*)(gi);
                float sa = (st[0] * a4[0] + st[1] * a4[1]) + (st[2] * a4[2] + st[3] * a4[3]);
                sa = allreduce16(sa);
#pragma unroll
                for (int t = 0; t < FT; ++t) {
                    f32x4 na = a4, nw = w4, nb = b4, nk = k4, nr = r4; float nv = vv;
                    f32x4 nf0 = f0, nf1 = f1, nq0 = q0, nq1 = q1; float niv = iv;
                    if (t < FT - 1) { const int o = (t + 1) * 256; na = *(const LAS f32x4*)(p4 + o); nw = *(const LAS f32x4*)(p4 + 4096 + o); nb = *(const LAS f32x4*)(p4 + 8192 + o); nk = *(const LAS f32x4*)(p4 + 12288 + o); nr = *(const LAS f32x4*)(p4 + 16384 + o); nv = *(const LAS float*)(pv + (t + 1) * 64);
                        const int o2 = (t + 1) * 512; nf0 = *(const LAS f32x4*)(g4 + o2); nf1 = *(const LAS f32x4*)(g4 + 256 + o2);
                        nq0 = *(const LAS f32x4*)(g4 + F_HGQ + o2); nq1 = *(const LAS f32x4*)(g4 + F_HGQ + 256 + o2); niv = *(const LAS float*)(gi + (t + 1) * 64); }
                    st = st * w4 + (b4 * sa + k4 * vv);
                    s0 = (s0 - iv) * f0 + iv; s1 = (s1 - iv) * f1 + iv;
                    float y = (st[0] * r4[0] + st[1] * r4[1]) + (st[2] * r4[2] + st[3] * r4[3]);
                    float sn = (st[0] * na[0] + st[1] * na[1]) + (st[2] * na[2] + st[3] * na[3]);
                    float yh = ((s0[0] * q0[0] + s0[1] * q0[1]) + (s0[2] * q0[2] + s0[3] * q0[3])) + ((s1[0] * q1[0] + s1[1] * q1[1]) + (s1[2] * q1[2] + s1[3] * q1[3]));
                    sn = dpp_add<0xB1>(sn); y = dpp_add<0xB1>(y); yh = dpp_add<0xB1>(yh); sn = dpp_add<0x4E>(sn); y = dpp_add<0x4E>(y); yh = dpp_add<0x4E>(yh);
                    sn = dpp_add<0x141>(sn); y = dpp_add<0x141>(y); yh = dpp_add<0x141>(yh); sn = dpp_add<0x140>(sn); y = dpp_add<0x140>(y); yh = dpp_add<0x140>(yh);
                    if (j == 0) { *(LAS float*)(py + t * 64) = y; *(LAS float*)(gy + t * 64) = yh; }
                    sa = sn; a4 = na; w4 = nw; b4 = nb; k4 = nk; r4 = nr; vv = nv;
                    f0 = nf0; f1 = nf1; q0 = nq0; q1 = nq1; iv = niv;
                }
                SCAN_BAR_S();
            }
        }
        if (wave >= 4) fused_drain(lds + ((NBLK - 1) & 1) * FBUF, tid - 256, orw + (size_t)(NBLK - 1) * (FT * 16), ohg + (size_t)(NBLK - 1) * (FT * 16));
        else { __builtin_amdgcn_s_setprio(0); if (save) { *(f32x4*)stp = st; *(f32x4*)shp = s0; *(f32x4*)(shp + 64) = s1; } }
    }
}


constexpr int ST = 16;
constexpr int S_RWV = 20480, S_RWY = 22528, S_RWB = 30720;
constexpr int S_HGQ = 8192, S_HGI = 16384, S_HGY = 18432, S_HGB = 26624;
__device__ __forceinline__ void s_rw_load(LAS unsigned char* bp, int lt2, size_t htok0  , int hf, const bf16_t* PA, const float* PW, const bf16_t* PB, const bf16_t* PK, const bf16_t* PR, const bf16_t* PV) {
    const int tok = lt2 >> 4, c4 = (lt2 & 15) * 4; const size_t base = (htok0 + tok) * 64 + c4;
    const f32x4 va = ld4bf(PA + base), vb = ld4bf(PB + base), vk = ld4bf(PK + base), vr = ld4bf(PR + base), vw = *(const f32x4*)(PW + base);
    const unsigned rv = *(const unsigned*)(PV + (htok0 + tok) * 64 + hf * 32 + (lt2 & 15) * 2);
    const int off = (tok * 64 + c4) * 4;
    *(LAS f32x4*)(bp + off) = va; *(LAS f32x4*)(bp + 4096 + off) = vw; *(LAS f32x4*)(bp + 8192 + off) = vb; *(LAS f32x4*)(bp + 12288 + off) = vk; *(LAS f32x4*)(bp + 16384 + off) = vr;
    *(LAS f32x2v*)(bp + S_RWV + (tok * 32 + (lt2 & 15) * 2) * 4) = (f32x2v){bflo(rv), bfhi(rv)};
}
__device__ __forceinline__ void s_hg_load(LAS unsigned char* bp, int lt2, size_t ltok0, int h8, int q4, const bf16_t* cols, const float* lbv) {
    const int tok = lt2 >> 4, c8 = (lt2 & 15) * 8; const bf16_t* crow = cols + (ltok0 + tok) * CL;
    float q[8], f[8]; ld8bf(crow + C_HQ + h8 * 128 + c8, q); ld8bf(crow + C_HF + h8 * 128 + c8, f);
    const unsigned rv = *(const unsigned*)(crow + C_HI + h8 * 128 + q4 * 32 + (lt2 & 15) * 2);
    const f32x4 lb0 = *(const f32x4*)(lbv + h8 * 128 + c8), lb1 = *(const f32x4*)(lbv + h8 * 128 + c8 + 4);
    const int off = (tok * 128 + c8) * 4;
    *(LAS f32x4*)(bp + off) = (f32x4){lb0[0] + (1.f - lb0[0]) * f[0], lb0[1] + (1.f - lb0[1]) * f[1], lb0[2] + (1.f - lb0[2]) * f[2], lb0[3] + (1.f - lb0[3]) * f[3]};
    *(LAS f32x4*)(bp + off + 16) = (f32x4){lb1[0] + (1.f - lb1[0]) * f[4], lb1[1] + (1.f - lb1[1]) * f[5], lb1[2] + (1.f - lb1[2]) * f[6], lb1[3] + (1.f - lb1[3]) * f[7]};
    *(LAS f32x4*)(bp + S_HGQ + off) = (f32x4){q[0], q[1], q[2], q[3]}; *(LAS f32x4*)(bp + S_HGQ + off + 16) = (f32x4){q[4], q[5], q[6], q[7]};
    *(LAS f32x2v*)(bp + S_HGI + (tok * 32 + (lt2 & 15) * 2) * 4) = (f32x2v){bflo(rv), bfhi(rv)};
}
__device__ __forceinline__ void s_drain(const LAS unsigned char* ybase, int lt2, float* obase  ) {
    const int t = lt2 >> 4, rp = (lt2 & 15) * 2;
    const f32x4 pa = *(const LAS f32x4*)(ybase + (t * 32 + rp) * 16), pb = *(const LAS f32x4*)(ybase + (t * 32 + rp) * 16 + 16);
    *(f32x2v*)(obase + (size_t)(rp >> 4) * (TS * 16) + t * 16 + (rp & 15)) = (f32x2v){(pa[0] + pa[1]) + (pa[2] + pa[3]), (pb[0] + pb[1]) + (pb[2] + pb[3])};
}
__device__ __forceinline__ float dot4(f32x4 a, f32x4 b) { return __builtin_fmaf(a[3], b[3], __builtin_fmaf(a[2], b[2], __builtin_fmaf(a[1], b[1], a[0] * b[0]))); }
__device__ __forceinline__ float dot4acc(f32x4 a, f32x4 b, float c) { return __builtin_fmaf(a[3], b[3], __builtin_fmaf(a[2], b[2], __builtin_fmaf(a[1], b[1], __builtin_fmaf(a[0], b[0], c)))); }
__device__ __forceinline__ void split_scan(int s, int bid, int G, int tid, int lane, int wave, LAS unsigned char* lds,
        const bf16_t* PA, const float* PW, const bf16_t* PB, const bf16_t* PK, const bf16_t* PR, const bf16_t* PV, const bf16_t* cols, const float* lbv,
        float* oraw, float* hgo, float* rwstate, float* hgstate, bool save) {
    constexpr int NBLK = TS / ST;
    const int rowl = lane >> 4, j = lane & 15, r0 = (wave & 3) * 8 + rowl, r1 = r0 + 4;
    for (int it = bid; it < 256; it += G) {
        if (it < 128) {
            const int b = it >> 5, h = (it >> 1) & 15, hf = it & 1;
            const size_t tok0 = (size_t)b * TS;
            float* sp0 = rwstate + ((size_t)((b * 16 + h) * 64 + hf * 32 + r0) * 64 + 4 * j); float* sp1 = sp0 + 4 * 64;
            float* og = oraw + (size_t)((b * 16 + h) * 4 + hf * 2) * TS * 16;
            f32x4 x0 = (f32x4){0.f, 0.f, 0.f, 0.f}, x1 = x0;
            if (wave < 4 && s > 0) { x0 = *(const f32x4*)sp0; x1 = *(const f32x4*)sp1; }
            if (wave >= 4) { s_rw_load(lds, tid - 256, (size_t)(b * 16 + h) * TS, hf, PA, PW, PB, PK, PR, PV); SCAN_BAR_L(); } else { __builtin_amdgcn_s_setprio(2); asm volatile("s_waitcnt vmcnt(0)" ::: "memory"); SCAN_BAR_S(); }
#pragma unroll 1
            for (int blk = 0; blk < NBLK; ++blk) {
                if (wave >= 4) {
                    if (blk > 0) s_drain(lds + ((blk - 1) & 1) * S_RWB + S_RWY, tid - 256, og + (size_t)(blk - 1) * (ST * 16));
                    if (blk + 1 < NBLK) s_rw_load(lds + ((blk + 1) & 1) * S_RWB, tid - 256, (size_t)(b * 16 + h) * TS + (blk + 1) * ST, hf, PA, PW, PB, PK, PR, PV);
                    SCAN_BAR_L();
                } else {
                    const LAS unsigned char* bp = lds + (blk & 1) * S_RWB;
                    const LAS unsigned char* p4 = bp + 16 * j; const LAS unsigned char* pv = bp + S_RWV + r0 * 4; LAS unsigned char* py = (LAS unsigned char*)bp + S_RWY + (r0 * 4 + (j >> 2)) * 4;
                    f32x4 a4 = *(const LAS f32x4*)(p4), w4 = *(const LAS f32x4*)(p4 + 4096), b4 = *(const LAS f32x4*)(p4 + 8192), k4 = *(const LAS f32x4*)(p4 + 12288), r4 = *(const LAS f32x4*)(p4 + 16384);
                    float v0 = *(const LAS float*)(pv), v1 = *(const LAS float*)(pv + 16);
                    float sa0 = dot4(x0, a4), sa1 = dot4(x1, a4);
                    allreduce16x2(sa0, sa1);
#pragma unroll
                    for (int t = 0; t < ST; ++t) {
                        f32x4 na = a4, nw = w4, nb = b4, nk = k4, nr = r4; float n0 = v0, n1 = v1;
                        if (t < ST - 1) { const int o = (t + 1) * 256; na = *(const LAS f32x4*)(p4 + o); nw = *(const LAS f32x4*)(p4 + 4096 + o); nb = *(const LAS f32x4*)(p4 + 8192 + o); nk = *(const LAS f32x4*)(p4 + 12288 + o); nr = *(const LAS f32x4*)(p4 + 16384 + o);
                            n0 = *(const LAS float*)(pv + (t + 1) * 128); n1 = *(const LAS float*)(pv + (t + 1) * 128 + 16); }
                        x0 = x0 * w4 + (b4 * sa0 + k4 * v0); x1 = x1 * w4 + (b4 * sa1 + k4 * v1);
                        float y0 = dot4(x0, r4), y1 = dot4(x1, r4);
                        float s0n = dot4(x0, na), s1n = dot4(x1, na);
                        s0n = dpp_add<0xB1>(s0n); s1n = dpp_add<0xB1>(s1n); y0 = dpp_add<0xB1>(y0); y1 = dpp_add<0xB1>(y1); s0n = dpp_add<0x4E>(s0n); s1n = dpp_add<0x4E>(s1n); y0 = dpp_add<0x4E>(y0); y1 = dpp_add<0x4E>(y1);
                        s0n = dpp_add<0x141>(s0n); s1n = dpp_add<0x141>(s1n); s0n = dpp_add<0x140>(s0n); s1n = dpp_add<0x140>(s1n);
                        *(LAS float*)(py + t * 512) = y0; *(LAS float*)(py + t * 512 + 64) = y1;
                        sa0 = s0n; sa1 = s1n; a4 = na; w4 = nw; b4 = nb; k4 = nk; r4 = nr; v0 = n0; v1 = n1;
                    }
                    SCAN_BAR_S();
                }
            }
            if (wave >= 4) s_drain(lds + ((NBLK - 1) & 1) * S_RWB + S_RWY, tid - 256, og + (size_t)(NBLK - 1) * (ST * 16));
            else { __builtin_amdgcn_s_setprio(0); if (save) { *(f32x4*)sp0 = x0; *(f32x4*)sp1 = x1; } }
        } else {
            const int i2 = it - 128, b = i2 >> 5, h8 = (i2 >> 2) & 7, q4 = i2 & 3;
            const size_t tok0 = (size_t)b * TS;
            float* sp0 = hgstate + ((size_t)((b * 8 + h8) * 128 + q4 * 32 + r0) * 128 + 4 * j); float* sp1 = sp0 + 4 * 128;
            float* og = hgo + (size_t)((b * 8 + h8) * 8 + q4 * 2) * TS * 16;
            f32x4 a0 = (f32x4){0.f, 0.f, 0.f, 0.f}, a1 = a0, c0 = a0, c1 = a0;
            if (wave < 4 && s > 0) { a0 = *(const f32x4*)sp0; a1 = *(const f32x4*)(sp0 + 64); c0 = *(const f32x4*)sp1; c1 = *(const f32x4*)(sp1 + 64); }
            if (wave >= 4) { s_hg_load(lds, tid - 256, tok0, h8, q4, cols, lbv); SCAN_BAR_L(); } else { __builtin_amdgcn_s_setprio(2); asm volatile("s_waitcnt vmcnt(0)" ::: "memory"); SCAN_BAR_S(); }
#pragma unroll 1
            for (int blk = 0; blk < NBLK; ++blk) {
                if (wave >= 4) {
                    if (blk > 0) s_drain(lds + ((blk - 1) & 1) * S_HGB + S_HGY, tid - 256, og + (size_t)(blk - 1) * (ST * 16));
                    if (blk + 1 < NBLK) s_hg_load(lds + ((blk + 1) & 1) * S_HGB, tid - 256, tok0 + (blk + 1) * ST, h8, q4, cols, lbv);
                    SCAN_BAR_L();
                } else {
                    const LAS unsigned char* bp = lds + (blk & 1) * S_HGB;
                    const LAS unsigned char* g4 = bp + 16 * j; const LAS unsigned char* gi = bp + S_HGI + r0 * 4; LAS unsigned char* gy = (LAS unsigned char*)bp + S_HGY + (r0 * 4 + (j >> 2)) * 4;
                    f32x4 f0 = *(const LAS f32x4*)(g4), f1 = *(const LAS f32x4*)(g4 + 256), q0 = *(const LAS f32x4*)(g4 + S_HGQ), q1 = *(const LAS f32x4*)(g4 + S_HGQ + 256);
                    float i0 = *(const LAS float*)(gi), i1 = *(const LAS float*)(gi + 16);
#pragma unroll
                    for (int t = 0; t < ST; ++t) {
                        f32x4 nf0 = f0, nf1 = f1, nq0 = q0, nq1 = q1; float ni0 = i0, ni1 = i1;
                        if (t < ST - 1) { const int o = (t + 1) * 512; nf0 = *(const LAS f32x4*)(g4 + o); nf1 = *(const LAS f32x4*)(g4 + 256 + o); nq0 = *(const LAS f32x4*)(g4 + S_HGQ + o); nq1 = *(const LAS f32x4*)(g4 + S_HGQ + 256 + o);
                            ni0 = *(const LAS float*)(gi + (t + 1) * 128); ni1 = *(const LAS float*)(gi + (t + 1) * 128 + 16); }
                        a0 = (a0 - i0) * f0 + i0; a1 = (a1 - i0) * f1 + i0; c0 = (c0 - i1) * f0 + i1; c1 = (c1 - i1) * f1 + i1;
                        float y0 = dot4acc(a1, q1, dot4(a0, q0));
                        float y1 = dot4acc(c1, q1, dot4(c0, q0));
                        y0 = dpp_add<0xB1>(y0); y1 = dpp_add<0xB1>(y1); y0 = dpp_add<0x4E>(y0); y1 = dpp_add<0x4E>(y1);
                        *(LAS float*)(gy + t * 512) = y0; *(LAS float*)(gy + t * 512 + 64) = y1;
                        f0 = nf0; f1 = nf1; q0 = nq0; q1 = nq1; i0 = ni0; i1 = ni1;
                    }
                    SCAN_BAR_S();
                }
            }
            if (wave >= 4) s_drain(lds + ((NBLK - 1) & 1) * S_HGB + S_HGY, tid - 256, og + (size_t)(NBLK - 1) * (ST * 16));
            else { __builtin_amdgcn_s_setprio(0); if (save) { *(f32x4*)sp0 = a0; *(f32x4*)(sp0 + 64) = a1; *(f32x4*)sp1 = c0; *(f32x4*)(sp1 + 64) = c1; } }
        }
    }
}

__device__ __forceinline__ void attn_phase(int gw, int NGW, int lane, const bf16_t* Q, const bf16_t* KV, const bf16_t* Vt, bf16_t* AO, const float* kmax2) {
    const int fr = lane & 15, fq = lane >> 4;
    for (int item = gw; item < 4096; item += NGW) {
        const int bh = item >> 8, tile = item & 255, b = bh >> 2, hd = bh & 3;
        const size_t g0 = (size_t)b * SEQ + tile * 32 + fr, g1 = g0 + 16;
        const float kmx = sqrtf(fmaxf(fmaxf(kmax2[(bh * 4 + 0) * 32], kmax2[(bh * 4 + 1) * 32]), fmaxf(kmax2[(bh * 4 + 2) * 32], kmax2[(bh * 4 + 3) * 32])));
        bf16x8 qa[8], qb[8]; float na = 0.f, nb = 0.f;
#pragma unroll
        for (int ks = 0; ks < 8; ++ks) { const u32x4 ua = *(const u32x4*)(Q + g0 * 1024 + hd * 256 + ks * 32 + fq * 8), ub = *(const u32x4*)(Q + g1 * 1024 + hd * 256 + ks * 32 + fq * 8);
            qa[ks] = __builtin_bit_cast(bf16x8, ua); qb[ks] = __builtin_bit_cast(bf16x8, ub);
#pragma unroll
            for (int e = 0; e < 4; ++e) { const float a0 = bflo(ua[e]), a1 = bfhi(ua[e]), b0 = bflo(ub[e]), b1 = bfhi(ub[e]); na += a0 * a0 + a1 * a1; nb += b0 * b0 + b1 * b1; } }
        na = fq_sum(na); nb = fq_sum(nb);
        const float ma = sqrtf(na) * kmx * 0.0625f * 1.001f, mb = sqrtf(nb) * kmx * 0.0625f * 1.001f;
        float za = 0.f, zb = 0.f;
        bf16x8 pa[8], pb[8];
#pragma unroll
        for (int k2 = 0; k2 < 8; ++k2) {
            f32x4 e0 = (f32x4){0.f, 0.f, 0.f, 0.f}, e1 = e0, f0 = e0, f1 = e0;
            const bf16_t* kp0 = KV + (size_t)(b * 256 + (2 * k2) * 16 + fr) * 2048 + hd * 256 + fq * 8; const bf16_t* kp1 = kp0 + (size_t)16 * 2048;
#pragma unroll
            for (int ks = 0; ks < 8; ++ks) { const bf16x8 k0 = *(const bf16x8*)(kp0 + ks * 32), k1 = *(const bf16x8*)(kp1 + ks * 32);
                e0 = MFMA16(k0, qa[ks], e0); f0 = MFMA16(k0, qb[ks], f0); e1 = MFMA16(k1, qa[ks], e1); f1 = MFMA16(k1, qb[ks], f1); }
#pragma unroll
            for (int jj = 0; jj < 4; ++jj) { e0[jj] = __expf(e0[jj] * 0.0625f - ma); e1[jj] = __expf(e1[jj] * 0.0625f - ma); f0[jj] = __expf(f0[jj] * 0.0625f - mb); f1[jj] = __expf(f1[jj] * 0.0625f - mb);
                za += e0[jj] + e1[jj]; zb += f0[jj] + f1[jj]; }
            u32x4 w; w.x = cvt_pk_bf16(e0[0], e0[1]); w.y = cvt_pk_bf16(e0[2], e0[3]); w.z = cvt_pk_bf16(e1[0], e1[1]); w.w = cvt_pk_bf16(e1[2], e1[3]); pa[k2] = __builtin_bit_cast(bf16x8, w);
            u32x4 x; x.x = cvt_pk_bf16(f0[0], f0[1]); x.y = cvt_pk_bf16(f0[2], f0[3]); x.z = cvt_pk_bf16(f1[0], f1[1]); x.w = cvt_pk_bf16(f1[2], f1[3]); pb[k2] = __builtin_bit_cast(bf16x8, x); }
        za = fq_sum(za); zb = fq_sum(zb);
        const float ia = 1.0f / za, ib = 1.0f / zb;
#pragma unroll 2
        for (int dt = 0; dt < 16; ++dt) { f32x4 a0 = (f32x4){0.f, 0.f, 0.f, 0.f}, a1 = a0; const bf16_t* vp = Vt + (size_t)((b * 4 + hd) * 256 + dt * 16 + fr) * 256 + fq * 8;
#pragma unroll
            for (int k2 = 0; k2 < 8; ++k2) { const bf16x8 vf = *(const bf16x8*)(vp + k2 * 32); a0 = MFMA16(vf, pa[k2], a0); a1 = MFMA16(vf, pb[k2], a1); }
            st4bf(AO + g0 * 1024 + hd * 256 + dt * 16 + 4 * fq, a0 * ia); st4bf(AO + g1 * 1024 + hd * 256 + dt * 16 + 4 * fq, a1 * ib); }
    }
}

__device__ __forceinline__ int tid_fresh() { int t = threadIdx.x; asm volatile("" : "+v"(t)); return t; }
#define WinT ((bf16_t*)(a.ws + WS_WIN))
#define WoutT ((bf16_t*)(a.ws + WS_WOUT))
#define WqT ((bf16_t*)(a.ws + WS_WQ))
#define WoT ((bf16_t*)(a.ws + WS_WO))
#define WkvT ((bf16_t*)(a.ws + WS_WKV))
#define W13T ((bf16_t*)(a.ws + WS_W13))
#define W2T ((bf16_t*)(a.ws + WS_W2))
#define rw2T ((bf16_t*)(a.ws + WS_RW2T))
#define ra2T ((bf16_t*)(a.ws + WS_RA2T))
#define rg2T ((bf16_t*)(a.ws + WS_RG2T))
#define g2Tp ((bf16_t*)(a.ws + WS_G2TP))
#define SS1 ((float*)(a.ws + WS_SS1))
#define SS2 ((float*)(a.ws + WS_SS2))
#define KMAX2 ((float*)(a.ws + WS_KMAX))
#define GATE ((bf16_t*)(a.ws + WS_GATE))
#define ASG ((bf16_t*)(a.ws + WS_ASG))
#define carry ((bf16_t*)(a.ws + WS_CARRY))
#define lbv ((float*)(a.ws + WS_LB))
#define mbf ((bf16_t*)(a.ws + WS_MBF))
#define KV ((bf16_t*)(a.ws + WS_KV))
#define Vt ((bf16_t*)(a.ws + WS_VT))
#define rwst ((float*)(a.ws + WS_RWST))
#define hgst ((float*)(a.ws + WS_HGST))
#define bonus ((float*)(a.ws + WS_BONUS))
#define merged ((bf16_t*)(a.ws + WS_MERGED))
#define u1 ((bf16_t*)(a.ws + WS_U1))
#define cols ((bf16_t*)(a.ws + WS_COLS))
#define PR ((bf16_t*)(a.ws + WS_PR))
#define PK ((bf16_t*)(a.ws + WS_PK))
#define PA ((bf16_t*)(a.ws + WS_PA))
#define PB ((bf16_t*)(a.ws + WS_PB))
#define PV ((bf16_t*)(a.ws + WS_PV))
#define PW ((float*)(a.ws + WS_PW))
#define oraw ((float*)(a.ws + WS_ORAW))
#define hgo ((float*)(a.ws + WS_HGO))
#define U ((bf16_t*)(a.ws + WS_U))
#define Qb ((bf16_t*)(a.ws + WS_Q))
#define AO ((bf16_t*)(a.ws + WS_AO))
#define FF ((bf16_t*)(a.ws + WS_FF))
#define XIN (a.in[0])
#define OUTP (a.out)
struct Args { const float* in[29]; float* out; unsigned char* ws; int ph_lo, ph_hi; };

typedef const __attribute__((address_space(4))) Args* CArgsP;
__device__ __forceinline__ CArgsP args_fresh() { CArgsP p = (CArgsP)__builtin_amdgcn_kernarg_segment_ptr(); asm volatile("" : "+s"(p)); return p; }
__global__ void __launch_bounds__(512, 2) mega(Args a0) {
    extern __shared__ __attribute__((aligned(16))) unsigned char lds_raw[];
    LAS unsigned char* lds = (LAS unsigned char*)lds_raw;
    cg::grid_group grid = cg::this_grid();
    const int G = gridDim.x, bid = blockIdx.x, NGW = G * 8, NGT = G * 512;
#define IDS const auto& a = *args_fresh(); const int tid = tid_fresh(), lane = tid & 63, wave = __builtin_amdgcn_readfirstlane(tid >> 6), gw = bid * 8 + wave, gtid = bid * 512 + tid; (void)lane; (void)gw; (void)gtid
    const int lo = a0.ph_lo, hi = a0.ph_hi;
    if (lo < 0) grid.sync();
    { volatile LAS unsigned* misc = (volatile LAS unsigned*)(lds + MISC_OFF); if (threadIdx.x < 2) misc[threadIdx.x] = 0u; __syncthreads();
      if (hi - lo > 1) (void)xcd_barrier_post((unsigned*)(a0.ws + WS_CTL), misc); }
#ifndef MK_REP
#define MK_REP -1
#endif
#ifndef MK_REPN
#define MK_REPN 3
#endif
#define RPT(code) for (int rep_ = 0, nrep_ = (MK_REP == (code)) ? MK_REPN : 1; rep_ < nrep_; ++rep_)
#define LASTREP (rep_ == nrep_ - 1)
#define IN(k) (lo <= (k) && (k) < hi)
#define SEAM(k) do { if (IN(k) && IN((k) + 1)) RPT(120) { XcdBarrier xb_; xb_.bar = (unsigned*)(args_fresh()->ws + WS_CTL); xb_.x = xb_xcc_id(); xb_.st = (volatile LAS unsigned*)(lds + MISC_OFF); xcd_barrier(xb_); } } while (0)

    if (IN(0)) RPT(100) { IDS;
        LAS float* scr = (LAS float*)(lds + wave * 16384);
        constexpr int I_IN = 16 * 297, I_SQ = 16 * 32, I_13 = 16 * 88, I_2 = 44 * 32;
        constexpr int NITEMS = I_IN + 5 * I_SQ + 2 * I_13 + I_2;
        for (int it = gw; it < NITEMS; it += NGW) {
            int r = it;
            if (r < I_IN) { const int kb = r / 297, n0 = (r % 297) * 32; tr_item(a.in[3], 1024, 9504, WinT, kb, n0, n0 + (n0 >= 3360 ? 224 : 0), scr, lane); continue; } r -= I_IN;
            if (r < I_SQ) { tr_item(a.in[17], 1024, 1024, WoutT, r / 32, (r % 32) * 32, (r % 32) * 32, scr, lane); continue; } r -= I_SQ;
            if (r < I_SQ) { tr_item(a.in[20], 1024, 1024, WqT, r / 32, (r % 32) * 32, (r % 32) * 32, scr, lane); continue; } r -= I_SQ;
            if (r < I_SQ) { tr_item(a.in[23], 1024, 1024, WoT, r / 32, (r % 32) * 32, (r % 32) * 32, scr, lane); continue; } r -= I_SQ;
            if (r < I_SQ) { tr_item(a.in[21], 1024, 1024, WkvT, r / 32, (r % 32) * 32, (r % 32) * 32, scr, lane); continue; } r -= I_SQ;
            if (r < I_SQ) { tr_item(a.in[22], 1024, 1024, WkvT, r / 32, (r % 32) * 32, 1024 + (r % 32) * 32, scr, lane); continue; } r -= I_SQ;
            if (r < I_13) { const int n0 = (r % 88) * 32; tr_item(a.in[25], 1024, DFF, W13T, r / 88, n0, (n0 / 128) * 256 + (n0 % 128), scr, lane); continue; } r -= I_13;
            if (r < I_13) { const int n0 = (r % 88) * 32; tr_item(a.in[26], 1024, DFF, W13T, r / 88, n0, (n0 / 128) * 256 + 128 + (n0 % 128), scr, lane); continue; } r -= I_13;
            tr_item(a.in[27], DFF, 1024, W2T, r / 32, (r % 32) * 32, (r % 32) * 32, scr, lane);
        }
        for (int i = gtid; i < 28672; i += NGT) ((u32x4*)(WinT + 3360 * 1024))[i] = (u32x4){0u, 0u, 0u, 0u};
        for (int i = gtid; i < 1792; i += NGT) ((u32x4*)carry)[i] = (u32x4){0u, 0u, 0u, 0u};
        for (int n = gw; n < 1024; n += NGW) { rw2T[n * 64 + lane] = (bf16_t)f2bf(a.in[6][lane * 1024 + n]); ra2T[n * 64 + lane] = (bf16_t)f2bf(a.in[8][lane * 1024 + n]); }
        for (int m = gw; m < 512; m += NGW) {
            for (int e = lane; e < 320; e += 64) { const int n = 2 * m + (e >= 160 ? 1 : 0), k = e >= 160 ? e - 160 : e; rg2T[n * 160 + k] = (bf16_t)f2bf(a.in[9][k * 1024 + n]); } }
        for (int n = gw; n < 1024; n += NGW) { f32x4 v;
#pragma unroll
            for (int e = 0; e < 4; ++e) { const int k = 4 * lane + e; v[e] = k < 160 ? a.in[9][k * 1024 + n] : 0.f; }
            st4bf(g2Tp + n * 256 + 4 * lane, v); }
        for (int i = gtid; i < 1024; i += NGT) lbv[i] = 1.0f / (1.0f + __expf(a.in[15][1024 + i] - a.in[15][i]));
        for (int m = gw; m < 1024; m += NGW) rms_row_bf16(a.in[1] + (size_t)m * 1024, a.in[19], mbf + (size_t)m * 1024, lane);
        for (int lt = gw; lt < MS; lt += NGW) { const int b = lt / TS, tl = lt % TS; const size_t gt = (size_t)b * SEQ + tl; rms_row_bf16(XIN + gt * 1024, a.in[2], u1 + (size_t)lt * 1024, lane); }
        __syncthreads();
    }
    SEAM(0);

#pragma unroll 1
    for (int s = 0; s < NSPLIT; ++s) {
        const int pb = 1 + 5 * s;
        if (IN(pb + 1)) { const auto& a = *args_fresh();
            pg8::Gemm g{u1, WinT, MS, CL, 1024}; pg8::StaticOrder S; S.init(MS, CL, G, bid);
            pg8::EpiColsAct E{cols, CL};
            RPT(102) pg8::gemm_phase<pg8::EpiColsAct, pg8::StaticOrder, true, true>(lds, g, S, E);
        }
        SEAM(pb + 1);
#ifndef SKIP_PREP
        if (IN(pb + 2)) { IDS; RPT(103) prep_phase(s, gw, NGW, lane, cols, carry, a.in[4], a.in[5], a.in[7], a.in[10], a.in[11], a.in[12], rw2T, ra2T, PR, PK, PA, PB, PV, PW, bonus, ASG); }
#endif
        SEAM(pb + 2);
        if (IN(pb + 3)) { IDS;
#ifdef MK_ZERO_SCAN
            for (int i = gtid; i < MS * 256; i += NGT) { ((f32x4*)oraw)[i] = (f32x4){0.f, 0.f, 0.f, 0.f}; ((f32x4*)hgo)[i] = (f32x4){0.01f, 0.02f, 0.03f, 0.04f}; }
#endif
#if 0
            RPT(104) { rwkv_scan(s, bid, G, tid, lane, wave, lds, PA, PW, PB, PK, PR, PV, oraw, rwst, LASTREP); __syncthreads(); }
            RPT(105) { hgrn_scan(s, bid, G, tid, lane, wave, lds, cols, lbv, hgo, hgst, LASTREP); __syncthreads(); }
#else
#ifdef MK_FUSED_SCAN
            RPT(104) { fused_scan(s, bid, G, tid, lane, wave, lds, PA, PW, PB, PK, PR, PV, cols, lbv, oraw, hgo, rwst, hgst, LASTREP); __syncthreads(); }
#else
            RPT(104) { split_scan(s, bid, G, tid, lane, wave, lds, PA, PW, PB, PK, PR, PV, cols, lbv, oraw, hgo, rwst, hgst, LASTREP); __syncthreads(); }
#endif
#endif
            if (G != 256 || bid < 128) { pg8::Gemm g{ASG, g2Tp, MS, 1024, 256}; pg8::StaticOrder S; if (G == 256) S.init(MS, 1024, 128, bid); else S.init(MS, 1024, G, bid); pg8::EpiStoreBf16 E{GATE, 1024};
              pg8::gemm_phase<pg8::EpiStoreBf16, pg8::StaticOrder, true, true>(lds, g, S, E); }
        }
        SEAM(pb + 3);
        if (IN(pb + 4)) { IDS;
#ifdef MK_NOMIX
            for (int i = gtid; i < MS * 128; i += NGT) { const int lt = i >> 7, b = lt / TS, tl = lt % TS; const size_t gt = (size_t)b * SEQ + s * TS + tl; ((u32x4*)(merged + gt * 1024))[i & 127] = (u32x4){0u, 0u, 0u, 0u}; }
#endif
#ifndef SKIP_POST
            RPT(106) post_phase(s, gw, NGW, lane, cols, carry, a.in[4], GATE, a.in[13], a.in[14], a.in[16], oraw, hgo, PV, bonus, merged);
#endif
            if (s + 1 < NSPLIT) for (int lt = gw; lt < MS; lt += NGW) { const int b = lt / TS, tl = lt % TS; const size_t gt = (size_t)b * SEQ + (s + 1) * TS + tl; rms_row_bf16(XIN + gt * 1024, a.in[2], u1 + (size_t)lt * 1024, lane); }
            if (bid < 4 && s + 1 < NSPLIT) { const u32x4* src = (const u32x4*)(cols + (size_t)(bid * TS + TS - 1) * CL); u32x4* dst = (u32x4*)(carry + (((s + 1) & 1) * 4 + bid) * CARRY_LD);
                for (int i = tid; i < CARRY_LD / 8; i += 512) dst[i] = src[i]; }
        }
        SEAM(pb + 4);
    }

    if (IN(T0 + 0)) { const auto& a = *args_fresh();
        { pg8::Gemm g{merged, WoutT, NTOK, 1024, 1024}; pg8::StaticOrder S; S.init(NTOK, 1024, G, bid); pg8::EpiResNorm E{XIN, OUTP, U, a.in[18], SS1, 1024, NTOK};
          pg8::gemm_phase<pg8::EpiResNorm, pg8::StaticOrder, true, true>(lds, g, S, E); }
        { pg8::Gemm g{mbf, WkvT, 1024, 2048, 1024}; pg8::StaticOrder S; S.init(1024, 2048, G, bid); pg8::EpiStoreBf16 E{KV, 2048};
          pg8::gemm_phase<pg8::EpiStoreBf16, pg8::StaticOrder, true, true>(lds, g, S, E); }
    }
    SEAM(T0 + 0);
    if (IN(T0 + 1)) { IDS;
        for (int i = gtid; i < 4 * 4 * 256 * 256; i += NGT) { const int kp = i & 255, dim = (i >> 8) & 255, hd = (i >> 16) & 3, b = i >> 18;
            const int k2 = kp >> 5, fq = (kp >> 3) & 3, sl = kp & 7; const int key = 32 * k2 + (sl < 4 ? 4 * fq + sl : 16 + 4 * fq + sl - 4);
            Vt[i] = KV[(size_t)(b * 256 + key) * 2048 + 1024 + hd * 256 + dim]; }
        for (int i = gw; i < 64; i += NGW) {
            const int bh = i >> 2, kb = i & 3, b = bh >> 2, hd = bh & 3; const bf16_t* kr = KV + (size_t)(b * 256 + kb * 64 + lane) * 2048 + hd * 256; float ss = 0.f;
#pragma unroll 4
            for (int c = 0; c < 32; ++c) { float t[8]; ld8bf(kr + c * 8, t);
#pragma unroll
                for (int e = 0; e < 8; ++e) ss += t[e] * t[e]; }
#pragma unroll
            for (int o = 1; o < 64; o <<= 1) ss = fmaxf(ss, __shfl_xor(ss, o));
            if (lane == 0) KMAX2[i * 32] = ss; }
    }
    SEAM(T0 + 1);
    if (IN(T0 + 2)) { const auto& a = *args_fresh(); pg8::Gemm g{U, WqT, NTOK, 1024, 1024}; pg8::StaticOrder S; S.init(NTOK, 1024, G, bid); pg8::EpiStoreBf16Rs E{Qb, 1024, SS1, NTOK};
        RPT(112) pg8::gemm_phase<pg8::EpiStoreBf16Rs, pg8::StaticOrder, true, true>(lds, g, S, E); }
    SEAM(T0 + 2);
#ifndef SKIP_ATTN
    if (IN(T0 + 3)) { IDS; RPT(113) attn_phase(gw, NGW, lane, Qb, KV, Vt, AO, KMAX2); }
#endif
    SEAM(T0 + 3);
#ifndef MK_NOATT
    if (IN(T0 + 4)) { const auto& a = *args_fresh(); pg8::Gemm g{AO, WoT, NTOK, 1024, 1024}; pg8::StaticOrder S; S.init(NTOK, 1024, G, bid); pg8::EpiResNorm E{OUTP, OUTP, U, a.in[24], SS2, 1024, NTOK};
        pg8::gemm_phase<pg8::EpiResNorm, pg8::StaticOrder, true, true>(lds, g, S, E); }
#endif
    SEAM(T0 + 4);
    if (IN(T0 + 6)) { const auto& a = *args_fresh(); pg8::Gemm g{U, W13T, NTOK, 2 * DFF, 1024}; pg8::StaticOrder S; S.init(NTOK, 2 * DFF, G, bid); pg8::EpiSwiGLURs E{FF, DFF, SS2, NTOK};
        RPT(116) pg8::gemm_phase<pg8::EpiSwiGLURs, pg8::StaticOrder, true, true>(lds, g, S, E); }
    SEAM(T0 + 6);
    if (IN(T0 + 7)) { const auto& a = *args_fresh(); pg8::Gemm g{FF, W2T, NTOK, 1024, DFF}; pg8::StaticOrder S; S.init(NTOK, 1024, G, bid); pg8::EpiResF32 E{OUTP, OUTP, 1024};
        pg8::gemm_phase<pg8::EpiResF32, pg8::StaticOrder, true, true>(lds, g, S, E); }
    SEAM(T0 + 7);
    if (IN(T0 + 8)) { IDS;
        const float* gf = a.in[28];
        for (int gt = gw; gt < NTOK; gt += NGW) { f32x4* row = (f32x4*)(OUTP + (size_t)gt * 1024); f32x4 v[4]; float sq = 0.f;
#pragma unroll
            for (int j = 0; j < 4; ++j) { v[j] = row[lane + 64 * j]; sq += (v[j][0] * v[j][0] + v[j][1] * v[j][1]) + (v[j][2] * v[j][2] + v[j][3] * v[j][3]); }
            const float rs = 1.0f / sqrtf(wave_sum(sq) * (1.0f / 1024.0f) + 1e-6f);
#pragma unroll
            for (int j = 0; j < 4; ++j) row[lane + 64 * j] = v[j] * rs * ((const f32x4*)gf)[lane + 64 * j]; }
    }
#undef IN
#undef SEAM
}

#ifndef MK_MULTI
#define MK_MULTI 0
#endif
extern "C" void kernel_launch(void* const* d_in, const int* in_sizes, int n_in, void* d_out, int out_size, void* d_ws, size_t ws_size, hipStream_t stream) {
    static int grid = 0;
    if (grid == 0) {
        if (n_in != 29 || in_sizes[0] != NTOK * D || out_size != NTOK * D || ws_size < WS_END) { fprintf(stderr, "kernel_launch: unexpected shapes / workspace (%d inputs, ws %zu)\n", n_in, ws_size); grid = -1; return; }
        int dev = 0, cus = 0, per_cu = 0;
        hipGetDevice(&dev); hipDeviceGetAttribute(&cus, hipDeviceAttributeMultiprocessorCount, dev);
        hipFuncSetAttribute((const void*)mega, hipFuncAttributeMaxDynamicSharedMemorySize, LDS_BYTES);
        hipOccupancyMaxActiveBlocksPerMultiprocessor(&per_cu, (const void*)mega, 512, LDS_BYTES);
        (void)hipGetLastError();
        if (per_cu < 1) per_cu = 1;
        grid = cus;
    }
    if (grid < 0) return;
    Args a{};
    for (int i = 0; i < 29; ++i) a.in[i] = (const float*)d_in[i];
    a.out = (float*)d_out; a.ws = (unsigned char*)d_ws;
    (void)hipMemsetAsync((char*)d_ws + WS_CTL, 0, CTL_BYTES, stream);
    void* args[] = {&a};
#if MK_MULTI
    for (int ph = 0; ph < N_PHASES; ++ph) { a.ph_lo = ph; a.ph_hi = ph + 1; hipLaunchCooperativeKernel((const void*)mega, dim3(grid), dim3(512), args, LDS_BYTES, stream); }
#else
    a.ph_lo = 0; a.ph_hi = N_PHASES;
    hipError_t e = hipLaunchCooperativeKernel((const void*)mega, dim3(grid), dim3(512), args, LDS_BYTES, stream);
    if (e != hipSuccess) fprintf(stderr, "cooperative launch failed: %s (grid %d)\n", hipGetErrorString(e), grid);
#endif
}
```

```cpp
#include <hip/hip_runtime.h>
#include <hip/hip_cooperative_groups.h>
#include <cstdint>
#include <cstdio>
namespace cg = cooperative_groups;
namespace pg8 {
#define PG8_LAS __attribute__((address_space(3)))
typedef unsigned short bf16_t;
typedef short bf16x8 __attribute__((ext_vector_type(8)));
typedef float f32x4 __attribute__((ext_vector_type(4)));
typedef unsigned u32x4 __attribute__((ext_vector_type(4)));
constexpr int BM = 256, BK = 64, HALF = 128, HTB = HALF * BK * 2  , STAGE_BYTES = 8 * HTB, NXCD = 8, WGM = 8;

__host__ __device__ __forceinline__ int lds_byte(int r, int c) { const int st = (r >> 4) * 2 + (c >> 5), rr = r & 15, cc = c & 31, ob = rr * 64 + cc * 2; return st * 1024 + (ob ^ (((ob >> 9) & 1) << 5)); }
__host__ __device__ __forceinline__ void stage_rc(int b, int& R, int& C) { const int st = b / 1024, sb = b % 1024, swz = sb ^ (((sb >> 9) & 1) << 5); R = (st >> 1) * 16 + swz / 64; C = (st & 1) * 32 + (swz % 64) / 2; }
__host__ __device__ __forceinline__ int perm32(int rho) { const int n = rho >> 4, i = rho & 15; return 8 * (i >> 2) + 4 * n + (i & 3); }

struct Unit { int pm, pn; };
struct Gemm { const bf16_t* A; const bf16_t* Bt; int M, N, K; };

struct StaticOrder {
    int nM, nN, nwg, G, c;
    __host__ __device__ void init(int M, int N, int G_, int c_) { nM = M / BM; nN = N / BM; nwg = nM * nN; G = G_; c = c_; }
    __host__ __device__ bool next(int i, Unit& u) const {
        const long L = (long)i * G + c; if (L >= nwg) return false;
        int wgid = (int)L; { const int q = nwg / NXCD, r = nwg % NXCD, xcd = wgid % NXCD, off = wgid / NXCD; wgid = (xcd < r ? xcd * (q + 1) : r * (q + 1) + (xcd - r) * q) + off; }
        const int nig = WGM * nN, gid = wgid / nig, fm = gid * WGM, gsz = (nM - fm) < WGM ? (nM - fm) : WGM;
        u.pm = fm + ((wgid % nig) % gsz); u.pn = (wgid % nig) / gsz; return true;
    }
    __device__ __forceinline__ void a_ready(const Unit&) const {}
    __device__ __forceinline__ void done(const Unit&) const {}
};

__device__ __forceinline__ unsigned cvt_pk_bf16(float lo, float hi) { unsigned r; asm volatile("v_cvt_pk_bf16_f32 %0, %1, %2" : "=v"(r) : "v"(lo), "v"(hi)); return r; }
__device__ __forceinline__ float fast_sigmoid(float x) { return __builtin_amdgcn_rcpf(1.0f + __expf(-x)); }
__device__ __forceinline__ float fast_silu(float x) { return x * fast_sigmoid(x); }
struct EpiStoreBf16 {
    static constexpr bool PERM = true, AFTER_DRAIN = false;
    bf16_t* O; int ldc;
    __device__ __forceinline__ void operator()(const f32x4 (&acc)[2][2][4][2], const Unit& u, int wr, int wc, int fr, int fq) const {
        const int row0 = u.pm * BM + wr * 64 + fr, col0 = u.pn * BM + wc * 32 + 8 * fq;
#pragma unroll
        for (int ai = 0; ai < 2; ++ai)
#pragma unroll
            for (int m = 0; m < 4; ++m) { bf16_t* rowp = O + (size_t)(row0 + ai * HALF + m * 16) * ldc + col0;
#pragma unroll
                for (int bj = 0; bj < 2; ++bj) { const f32x4 v0 = acc[ai][bj][m][0], v1 = acc[ai][bj][m][1];
                    u32x4 w; w.x = cvt_pk_bf16(v0[0], v0[1]); w.y = cvt_pk_bf16(v0[2], v0[3]); w.z = cvt_pk_bf16(v1[0], v1[1]); w.w = cvt_pk_bf16(v1[2], v1[3]);
                    *(u32x4*)(rowp + bj * HALF) = w; } }
    }
};
struct EpiResF32 {
    static constexpr bool PERM = true, AFTER_DRAIN = false;
    const float* base; float* out; int ldc;
    __device__ __forceinline__ void operator()(const f32x4 (&acc)[2][2][4][2], const Unit& u, int wr, int wc, int fr, int fq) const {
        const int row0 = u.pm * BM + wr * 64 + fr, col0 = u.pn * BM + wc * 32 + 8 * fq;
#pragma unroll
        for (int ai = 0; ai < 2; ++ai)
#pragma unroll
            for (int m = 0; m < 4; ++m) { const size_t off = (size_t)(row0 + ai * HALF + m * 16) * ldc + col0;
#pragma unroll
                for (int bj = 0; bj < 2; ++bj)
#pragma unroll
                    for (int n = 0; n < 2; ++n) { const size_t p = off + bj * HALF + 4 * n; const f32x4 b = *(const f32x4*)(base + p); *(f32x4*)(out + p) = b + acc[ai][bj][m][n]; } }
    }
};
struct EpiSwiGLU {
    static constexpr bool PERM = true, AFTER_DRAIN = false;
    bf16_t* O; int ldc;
    __device__ __forceinline__ void operator()(const f32x4 (&acc)[2][2][4][2], const Unit& u, int wr, int wc, int fr, int fq) const {
        const int row0 = u.pm * BM + wr * 64 + fr, col0 = u.pn * HALF + wc * 32 + 8 * fq;
#pragma unroll
        for (int ai = 0; ai < 2; ++ai)
#pragma unroll
            for (int m = 0; m < 4; ++m) { bf16_t* rowp = O + (size_t)(row0 + ai * HALF + m * 16) * ldc + col0;
                f32x4 v0, v1;
#pragma unroll
                for (int j = 0; j < 4; ++j) { v0[j] = fast_silu(acc[ai][0][m][0][j]) * acc[ai][1][m][0][j]; v1[j] = fast_silu(acc[ai][0][m][1][j]) * acc[ai][1][m][1][j]; }
                u32x4 w; w.x = cvt_pk_bf16(v0[0], v0[1]); w.y = cvt_pk_bf16(v0[2], v0[3]); w.z = cvt_pk_bf16(v1[0], v1[1]); w.w = cvt_pk_bf16(v1[2], v1[3]);
                *(u32x4*)rowp = w; }
    }
};

struct EpiColsAct {
    static constexpr bool PERM = true, AFTER_DRAIN = false;
    bf16_t* O; int ldc;
    __device__ __forceinline__ void operator()(const f32x4 (&acc)[2][2][4][2], const Unit& u, int wr, int wc, int fr, int fq) const {
        const int row0 = u.pm * BM + wr * 64 + fr, col0 = u.pn * BM + wc * 32 + 8 * fq;
        const int pn = u.pn; const int act = (pn >= 14 && pn < 18) ? 1 : (pn >= 18 && pn < 22) ? 2 : (pn >= 26 && pn < 30) ? 1 : (pn >= 30) ? 2 : 0;
#pragma unroll
        for (int ai = 0; ai < 2; ++ai)
#pragma unroll
            for (int m = 0; m < 4; ++m) { bf16_t* rowp = O + (size_t)(row0 + ai * HALF + m * 16) * ldc + col0;
#pragma unroll
                for (int bj = 0; bj < 2; ++bj) { f32x4 v0 = acc[ai][bj][m][0], v1 = acc[ai][bj][m][1];
                    if (act == 1) {
#pragma unroll
                        for (int j = 0; j < 4; ++j) { v0[j] = fast_silu(v0[j]); v1[j] = fast_silu(v1[j]); } }
                    else if (act == 2) {
#pragma unroll
                        for (int j = 0; j < 4; ++j) { v0[j] = fast_sigmoid(v0[j]); v1[j] = fast_sigmoid(v1[j]); } }
                    u32x4 w; w.x = cvt_pk_bf16(v0[0], v0[1]); w.y = cvt_pk_bf16(v0[2], v0[3]); w.z = cvt_pk_bf16(v1[0], v1[1]); w.w = cvt_pk_bf16(v1[2], v1[3]);
                    *(u32x4*)(rowp + bj * HALF) = w; } }
    }
};

struct EpiResNorm {
    static constexpr bool PERM = true, AFTER_DRAIN = false;
    const float* base; float* out; bf16_t* hb; const float* gain; float* ss; int ldc, nrows;
    __device__ __forceinline__ void operator()(const f32x4 (&acc)[2][2][4][2], const Unit& u, int wr, int wc, int fr, int fq) const {
        const int row0 = u.pm * BM + wr * 64 + fr, col0 = u.pn * BM + wc * 32 + 8 * fq;
        f32x4 gv[2][2];
#pragma unroll
        for (int bj = 0; bj < 2; ++bj)
#pragma unroll
            for (int n = 0; n < 2; ++n) gv[bj][n] = *(const f32x4*)(gain + col0 + bj * HALF + 4 * n);
#pragma unroll
        for (int ai = 0; ai < 2; ++ai)
#pragma unroll
            for (int m = 0; m < 4; ++m) { const int row = row0 + ai * HALF + m * 16; const size_t off = (size_t)row * ldc + col0; float sq = 0.f;
#pragma unroll
                for (int bj = 0; bj < 2; ++bj) { f32x4 v[2];
#pragma unroll
                    for (int n = 0; n < 2; ++n) { const size_t p = off + bj * HALF + 4 * n; v[n] = *(const f32x4*)(base + p) + acc[ai][bj][m][n]; *(f32x4*)(out + p) = v[n];
                        sq += (v[n][0] * v[n][0] + v[n][1] * v[n][1]) + (v[n][2] * v[n][2] + v[n][3] * v[n][3]); }
                    const f32x4 h0 = v[0] * gv[bj][0], h1 = v[1] * gv[bj][1];
                    u32x4 w; w.x = cvt_pk_bf16(h0[0], h0[1]); w.y = cvt_pk_bf16(h0[2], h0[3]); w.z = cvt_pk_bf16(h1[0], h1[1]); w.w = cvt_pk_bf16(h1[2], h1[3]);
                    *(u32x4*)(hb + off + bj * HALF) = w; }
                sq += __shfl_xor(sq, 16); sq += __shfl_xor(sq, 32);
                if (fq == 0) ss[((size_t)u.pn * nrows + row) * 4 + wc] = sq; }
    }
};
__device__ __forceinline__ float row_rs(const float* ss, int nrows, int row) {
    float s = 0.f;
#pragma unroll
    for (int pn = 0; pn < 4; ++pn) { const f32x4 t = *(const f32x4*)(ss + ((size_t)pn * nrows + row) * 4); s += (t[0] + t[1]) + (t[2] + t[3]); }
    return 1.0f / sqrtf(s * (1.0f / 1024.0f) + 1e-6f);
}
struct EpiStoreBf16Rs {
    static constexpr bool PERM = true, AFTER_DRAIN = false;
    bf16_t* O; int ldc; const float* ss; int nrows;
    __device__ __forceinline__ void operator()(const f32x4 (&acc)[2][2][4][2], const Unit& u, int wr, int wc, int fr, int fq) const {
        const int row0 = u.pm * BM + wr * 64 + fr, col0 = u.pn * BM + wc * 32 + 8 * fq;
        float rsv[2][4];
#pragma unroll
        for (int ai = 0; ai < 2; ++ai)
#pragma unroll
            for (int m = 0; m < 4; ++m) rsv[ai][m] = row_rs(ss, nrows, row0 + ai * HALF + m * 16);
#pragma unroll
        for (int ai = 0; ai < 2; ++ai)
#pragma unroll
            for (int m = 0; m < 4; ++m) { const int row = row0 + ai * HALF + m * 16; const float rs = rsv[ai][m]; bf16_t* rowp = O + (size_t)row * ldc + col0;
#pragma unroll
                for (int bj = 0; bj < 2; ++bj) { const f32x4 v0 = acc[ai][bj][m][0] * rs, v1 = acc[ai][bj][m][1] * rs;
                    u32x4 w; w.x = cvt_pk_bf16(v0[0], v0[1]); w.y = cvt_pk_bf16(v0[2], v0[3]); w.z = cvt_pk_bf16(v1[0], v1[1]); w.w = cvt_pk_bf16(v1[2], v1[3]);
                    *(u32x4*)(rowp + bj * HALF) = w; } }
    }
};
struct EpiSwiGLURs {
    static constexpr bool PERM = true, AFTER_DRAIN = false;
    bf16_t* O; int ldc; const float* ss; int nrows;
    __device__ __forceinline__ void operator()(const f32x4 (&acc)[2][2][4][2], const Unit& u, int wr, int wc, int fr, int fq) const {
        const int row0 = u.pm * BM + wr * 64 + fr, col0 = u.pn * HALF + wc * 32 + 8 * fq;
        float rsv[2][4];
#pragma unroll
        for (int ai = 0; ai < 2; ++ai)
#pragma unroll
            for (int m = 0; m < 4; ++m) rsv[ai][m] = row_rs(ss, nrows, row0 + ai * HALF + m * 16);
#pragma unroll
        for (int ai = 0; ai < 2; ++ai)
#pragma unroll
            for (int m = 0; m < 4; ++m) { const int row = row0 + ai * HALF + m * 16; const float rs = rsv[ai][m]; bf16_t* rowp = O + (size_t)row * ldc + col0;
                f32x4 v0, v1;
#pragma unroll
                for (int j = 0; j < 4; ++j) { v0[j] = fast_silu(acc[ai][0][m][0][j] * rs) * (acc[ai][1][m][0][j] * rs); v1[j] = fast_silu(acc[ai][0][m][1][j] * rs) * (acc[ai][1][m][1][j] * rs); }
                u32x4 w; w.x = cvt_pk_bf16(v0[0], v0[1]); w.y = cvt_pk_bf16(v0[2], v0[3]); w.z = cvt_pk_bf16(v1[0], v1[1]); w.w = cvt_pk_bf16(v1[2], v1[3]);
                *(u32x4*)rowp = w; }
    }
};
template <class Epi, class Sched, bool ALIGN_EPI = false, bool SP2 = false>
__device__ __forceinline__ void gemm_phase(PG8_LAS unsigned char* lds, const Gemm g, const Sched& S, const Epi& E) {
    int tid = threadIdx.x; asm volatile("" : "+v"(tid));
    const int wid = __builtin_amdgcn_readfirstlane(tid >> 6), lane = tid & 63, wr = wid >> 2, wc = wid & 3, fr = lane & 15, fq = lane >> 4;
    const int K = g.K, nt = K / BK;
    unsigned voffA[2], voffB[2];
#pragma unroll
    for (int i = 0; i < 2; ++i) { int R, C; stage_rc(tid * 16 + i * 8192, R, C); const int Rb = Epi::PERM ? ((R & ~31) + perm32(R & 31)) : R;
        voffA[i] = (unsigned)(R * K + C) * 2u; voffB[i] = (unsigned)(Rb * K + C) * 2u; }
    const size_t kstep = (size_t)(BK * 2);
    const size_t hstep = (size_t)HALF * K * 2;
    const size_t tstep = 2 * hstep;
    const unsigned ldsw = (unsigned)wid * 1024u;
    const int aoff = lds_byte(wr * 64 + fr, fq * 8), boff = lds_byte(wc * 32 + fr, fq * 8);
#define PG8_SA(b, h) (((b) * 2 + (h)) * HTB)
#define PG8_SB(b, h) ((4 + (b) * 2 + (h)) * HTB)
#define PG8_STAGE(bufoff, gbase, voff) do { _Pragma("unroll") for (int _i = 0; _i < 2; ++_i) \
        __builtin_amdgcn_global_load_lds((const unsigned*)((const char*)(gbase) + (voff)[_i]), (PG8_LAS unsigned*)(lds + (bufoff) + ldsw + _i * 8192), 16, 0, 0); } while (0)
#define PG8_LDA(dst, b, h) do { _Pragma("unroll") for (int m = 0; m < 4; ++m) _Pragma("unroll") for (int k = 0; k < 2; ++k) dst[m][k] = *(const PG8_LAS bf16x8*)(lds + PG8_SA(b, h) + aoff + m * 2048 + k * 1024); } while (0)
#define PG8_LDB(dst, b, h) do { _Pragma("unroll") for (int n = 0; n < 2; ++n) _Pragma("unroll") for (int k = 0; k < 2; ++k) dst[n][k] = *(const PG8_LAS bf16x8*)(lds + PG8_SB(b, h) + boff + n * 2048 + k * 1024); } while (0)
#define PG8_MMA(ai, bj, At, Bt) do { __builtin_amdgcn_s_setprio(1); _Pragma("unroll") for (int m = 0; m < 4; ++m) _Pragma("unroll") for (int n = 0; n < 2; ++n) _Pragma("unroll") for (int k = 0; k < 2; ++k) \
        acc[ai][bj][m][n] = __builtin_amdgcn_mfma_f32_16x16x32_bf16(Bt[n][k], At[m][k], acc[ai][bj][m][n], 0, 0, 0); __builtin_amdgcn_s_setprio(0); } while (0)
#define PG8_WAIT_V(n) asm volatile("s_waitcnt vmcnt(" #n ")" ::: "memory")
#define PG8_WAIT_L(n) asm volatile("s_waitcnt lgkmcnt(" #n ")" ::: "memory")
#define PG8_BAR __builtin_amdgcn_s_barrier()
#define PG8_SCHED __builtin_amdgcn_sched_barrier(0)
    Unit cur, nxt; int ui = 0;
    if (!S.next(0, cur)) return;
    f32x4 acc[2][2][4][2];
#pragma unroll
    for (int a = 0; a < 2; ++a)
#pragma unroll
        for (int b = 0; b < 2; ++b)
#pragma unroll
            for (int m = 0; m < 4; ++m)
#pragma unroll
                for (int n = 0; n < 2; ++n) acc[a][b][m][n] = (f32x4){0.f, 0.f, 0.f, 0.f};
    bf16x8 At[4][2], B0[2][2], B1[2][2];
    const char* cA = (const char*)g.A + (size_t)cur.pm * tstep; const char* cB = (const char*)g.Bt + (size_t)cur.pn * tstep;
    S.a_ready(cur);
    if constexpr (SP2) {
        PG8_STAGE(PG8_SB(0, 0), cB, voffB); PG8_STAGE(PG8_SB(0, 1), cB + hstep, voffB); PG8_STAGE(PG8_SA(0, 0), cA, voffA); PG8_STAGE(PG8_SA(0, 1), cA + hstep, voffA);
        if (wr == 1) PG8_BAR;
        PG8_WAIT_V(2); PG8_BAR;
        PG8_STAGE(PG8_SB(1, 0), cB + kstep, voffB); PG8_STAGE(PG8_SA(1, 0), cA + kstep, voffA); PG8_STAGE(PG8_SB(1, 1), cB + hstep + kstep, voffB);
        PG8_WAIT_V(6); PG8_BAR;
    } else {
        PG8_STAGE(PG8_SB(0, 0), cB, voffB); PG8_STAGE(PG8_SA(0, 0), cA, voffA); PG8_STAGE(PG8_SB(0, 1), cB + hstep, voffB); PG8_STAGE(PG8_SA(0, 1), cA + hstep, voffA);
        if (wr == 1) PG8_BAR;
        PG8_WAIT_V(4); PG8_BAR;
        PG8_STAGE(PG8_SB(1, 0), cB + kstep, voffB); PG8_STAGE(PG8_SA(1, 0), cA + kstep, voffA); PG8_STAGE(PG8_SB(1, 1), cB + hstep + kstep, voffB);
        PG8_WAIT_V(6); PG8_BAR;
    }
    for (;;) {
        const bool has_next = S.next(ui + 1, nxt);
        const char* nA = has_next ? (const char*)g.A + (size_t)nxt.pm * tstep : cA; const char* nB = has_next ? (const char*)g.Bt + (size_t)nxt.pn * tstep : cB;
        for (int t = 0; t < nt; t += 2) {
            const bool last = (t == nt - 2);
            const char* a1 = cA + (size_t)(t + 1) * kstep;
            const char* a2 = last ? nA : cA + (size_t)(t + 2) * kstep; const char* b2 = last ? nB : cB + (size_t)(t + 2) * kstep;
            const char* a3 = a2 + kstep; const char* b3 = b2 + kstep;
            if (last && has_next) S.a_ready(nxt);
            if constexpr (SP2) {
            PG8_LDB(B0, 0, 0); PG8_LDB(B1, 0, 1); PG8_SCHED; PG8_LDA(At, 0, 0); PG8_STAGE(PG8_SA(1, 1), a1 + hstep, voffA);
            PG8_WAIT_V(8); PG8_WAIT_L(0); PG8_BAR; PG8_MMA(0, 0, At, B0); PG8_MMA(0, 1, At, B1); PG8_BAR; PG8_SCHED;
            PG8_LDA(At, 0, 1); PG8_STAGE(PG8_SB(0, 0), b2, voffB); PG8_STAGE(PG8_SB(0, 1), b2 + hstep, voffB); PG8_STAGE(PG8_SA(0, 0), a2, voffA);
            PG8_WAIT_V(8); PG8_WAIT_L(0); PG8_BAR; PG8_MMA(1, 0, At, B0); PG8_MMA(1, 1, At, B1); PG8_BAR; PG8_SCHED;
            PG8_LDB(B0, 1, 0); PG8_LDB(B1, 1, 1); PG8_SCHED; PG8_LDA(At, 1, 0); PG8_STAGE(PG8_SA(0, 1), a2 + hstep, voffA);
            PG8_WAIT_V(8); PG8_WAIT_L(0); PG8_BAR; PG8_MMA(0, 0, At, B0); PG8_MMA(0, 1, At, B1); PG8_BAR; PG8_SCHED;
            PG8_LDA(At, 1, 1); PG8_STAGE(PG8_SB(1, 0), b3, voffB); PG8_STAGE(PG8_SB(1, 1), b3 + hstep, voffB); PG8_STAGE(PG8_SA(1, 0), a3, voffA);
            PG8_WAIT_V(8); PG8_WAIT_L(0); PG8_BAR; PG8_MMA(1, 0, At, B0); PG8_MMA(1, 1, At, B1); PG8_BAR; PG8_SCHED;
            } else {
            PG8_LDB(B0, 0, 0); PG8_SCHED; PG8_LDA(At, 0, 0); PG8_STAGE(PG8_SA(1, 1), a1 + hstep, voffA);
            PG8_WAIT_L(8); PG8_BAR; PG8_WAIT_L(0); PG8_MMA(0, 0, At, B0); PG8_BAR; PG8_SCHED;
            PG8_LDB(B1, 0, 1); PG8_STAGE(PG8_SB(0, 0), b2, voffB);
            PG8_BAR; PG8_WAIT_L(0); PG8_MMA(0, 1, At, B1); PG8_BAR;
            PG8_LDA(At, 0, 1); PG8_STAGE(PG8_SA(0, 0), a2, voffA);
            PG8_BAR; PG8_WAIT_L(0); PG8_MMA(1, 0, At, B0); PG8_BAR; PG8_SCHED;
            PG8_STAGE(PG8_SB(0, 1), b2 + hstep, voffB);
            PG8_WAIT_V(6); PG8_BAR; PG8_MMA(1, 1, At, B1); PG8_BAR;
            PG8_LDB(B0, 1, 0); PG8_SCHED; PG8_LDA(At, 1, 0); PG8_STAGE(PG8_SA(0, 1), a2 + hstep, voffA);
            PG8_WAIT_L(8); PG8_BAR; PG8_WAIT_L(0); PG8_MMA(0, 0, At, B0); PG8_BAR; PG8_SCHED;
            PG8_LDB(B1, 1, 1); PG8_STAGE(PG8_SB(1, 0), b3, voffB);
            PG8_BAR; PG8_WAIT_L(0); PG8_MMA(0, 1, At, B1); PG8_BAR;
            PG8_LDA(At, 1, 1); PG8_STAGE(PG8_SA(1, 0), a3, voffA);
            PG8_BAR; PG8_WAIT_L(0); PG8_MMA(1, 0, At, B0); PG8_BAR; PG8_SCHED;
            PG8_STAGE(PG8_SB(1, 1), b3 + hstep, voffB);
            PG8_WAIT_V(6); PG8_BAR; PG8_MMA(1, 1, At, B1); PG8_BAR;
            }
        }
        if constexpr (ALIGN_EPI) { if (wr == 0) PG8_BAR; }
        if constexpr (!Epi::AFTER_DRAIN) { E(acc, cur, wr, wc, fr, fq); S.done(cur); }
        if (!has_next) break;
#pragma unroll
        for (int a = 0; a < 2; ++a)
#pragma unroll
            for (int b = 0; b < 2; ++b)
#pragma unroll
                for (int m = 0; m < 4; ++m)
#pragma unroll
                    for (int n = 0; n < 2; ++n) acc[a][b][m][n] = (f32x4){0.f, 0.f, 0.f, 0.f};
        cur = nxt; cA = nA; cB = nB; ++ui;
        if constexpr (ALIGN_EPI) { if (wr == 1) PG8_BAR; }
    }
    PG8_WAIT_V(0);
    if constexpr (!ALIGN_EPI) { if (wr == 0) PG8_BAR; }
    PG8_BAR;
    if constexpr (Epi::AFTER_DRAIN) { E.fused(acc, cur, wr, wc, fr, fq, lds, wid, lane); S.done(cur); }
#undef PG8_SA
#undef PG8_SB
#undef PG8_STAGE
#undef PG8_LDA
#undef PG8_LDB
#undef PG8_MMA
#undef PG8_WAIT_V
#undef PG8_WAIT_L
#undef PG8_BAR
#undef PG8_SCHED
}
}

#define LAS __attribute__((address_space(3)))
typedef pg8::bf16_t bf16_t;
typedef pg8::bf16x8 bf16x8;
typedef pg8::f32x4 f32x4;
typedef pg8::u32x4 u32x4;
typedef unsigned u32x2 __attribute__((ext_vector_type(2)));
typedef float f32x2v __attribute__((ext_vector_type(2)));
using pg8::cvt_pk_bf16;
using pg8::fast_sigmoid;
using pg8::fast_silu;

constexpr int D = 1024, NB = 4, SEQ = 8192, NTOK = NB * SEQ;
#ifndef MK_NSPLIT
#define MK_NSPLIT 4
#endif
constexpr int NSPLIT = MK_NSPLIT, TS = SEQ / NSPLIT, MS = NB * TS;
constexpr int CL = 9728;
constexpr int C_R = 0, C_K = 1024, C_V = 2048, C_WLO = 3072, C_ALO = 3136, C_GLO = 3200, C_HQ = 3584, C_HF = 4608, C_HI = 5632, C_HG = 6656, C_GA = 7680, C_GB = 8704;
constexpr int CARRY_LD = 3584;
constexpr int DFF = 2816;
constexpr size_t MiB = 1u << 20, KiB = 1u << 10;
constexpr size_t WS_WIN = 0, WS_WOUT = 19 * MiB, WS_WQ = 21 * MiB, WS_WO = 23 * MiB, WS_WKV = 25 * MiB, WS_W13 = 29 * MiB, WS_W2 = 40 * MiB;
constexpr size_t WS_RW2T = 46 * MiB, WS_RA2T = 46 * MiB + 128 * KiB, WS_RG2T = 46 * MiB + 256 * KiB, WS_CARRY = 46 * MiB + 640 * KiB, WS_LB = 46 * MiB + 704 * KiB;
constexpr size_t WS_MBF = 47 * MiB, WS_KV = 49 * MiB, WS_VT = 53 * MiB, WS_RWST = 55 * MiB, WS_HGST = 56 * MiB, WS_BONUS = 58 * MiB;
constexpr size_t WS_KMAX = 58 * MiB + 768 * KiB;
constexpr size_t WS_G2TP = 59 * MiB;
constexpr size_t WS_SS1 = 60 * MiB, WS_SS2 = 62 * MiB;
constexpr size_t WS_MERGED = 64 * MiB;
constexpr size_t WS_U1 = 128 * MiB, WS_COLS = 144 * MiB, WS_PR = 296 * MiB, WS_PK = 312 * MiB, WS_PA = 328 * MiB, WS_PB = 344 * MiB, WS_PV = 360 * MiB, WS_PW = 376 * MiB, WS_ORAW = 408 * MiB, WS_HGO = 440 * MiB;
constexpr size_t WS_GATE = 472 * MiB, WS_ASG = 488 * MiB;
constexpr size_t WS_KH = 472 * MiB;
constexpr size_t WS_U = 128 * MiB, WS_Q = 192 * MiB, WS_AO = 256 * MiB, WS_FF = 320 * MiB, WS_CTL = 496 * MiB, CTL_BYTES = 64 * KiB, WS_END = 496 * MiB + 64 * KiB;
constexpr int LDS_BYTES = 147456, MISC_OFF = 131072 + 320;
constexpr int T0 = 1 + 5 * NSPLIT, N_PHASES = T0 + 9;

__device__ __forceinline__ float bflo(unsigned u) { return __uint_as_float(u << 16); }
__device__ __forceinline__ float bfhi(unsigned u) { return __uint_as_float(u & 0xffff0000u); }
__device__ __forceinline__ unsigned f2bf(float f) { unsigned u = __float_as_uint(f); return (u + 0x7fffu + ((u >> 16) & 1u)) >> 16; }
__device__ __forceinline__ f32x4 ld4bf(const bf16_t* p) { const u32x2 u = *(const u32x2*)p; return (f32x4){bflo(u.x), bfhi(u.x), bflo(u.y), bfhi(u.y)}; }
__device__ __forceinline__ f32x4 up4(u32x2 u) { return (f32x4){bflo(u.x), bfhi(u.x), bflo(u.y), bfhi(u.y)}; }
__device__ __forceinline__ void ld8bf(const bf16_t* p, float (&o)[8]) { const u32x4 u = *(const u32x4*)p; o[0] = bflo(u.x); o[1] = bfhi(u.x); o[2] = bflo(u.y); o[3] = bfhi(u.y); o[4] = bflo(u.z); o[5] = bfhi(u.z); o[6] = bflo(u.w); o[7] = bfhi(u.w); }
__device__ __forceinline__ void st4bf(bf16_t* p, f32x4 v) { u32x2 w; w.x = cvt_pk_bf16(v[0], v[1]); w.y = cvt_pk_bf16(v[2], v[3]); *(u32x2*)p = w; }
__device__ __forceinline__ bf16x8 pack8(const float (&t)[8]) { u32x4 w; w.x = cvt_pk_bf16(t[0], t[1]); w.y = cvt_pk_bf16(t[2], t[3]); w.z = cvt_pk_bf16(t[4], t[5]); w.w = cvt_pk_bf16(t[6], t[7]); return __builtin_bit_cast(bf16x8, w); }
__device__ __forceinline__ float tanh_fast(float x) { return 1.0f - 2.0f * __builtin_amdgcn_rcpf(1.0f + __expf(2.0f * x)); }
__device__ __forceinline__ float wave_sum(float v) {
#pragma unroll
    for (int o = 1; o < 64; o <<= 1) v += __shfl_xor(v, o);
    return v;
}
__device__ __forceinline__ float fq_sum(float v) { v += __shfl_xor(v, 16); v += __shfl_xor(v, 32); return v; }
template <int CTRL> __device__ __forceinline__ float dpp_add(float x) { return x + __builtin_bit_cast(float, __builtin_amdgcn_update_dpp(0, __builtin_bit_cast(int, x), CTRL, 0xf, 0xf, false)); }
#ifdef MK_SHFL_REDUCE
__device__ __forceinline__ float allreduce16(float x) { x += __shfl_xor(x, 1); x += __shfl_xor(x, 2); x += __shfl_xor(x, 4); x += __shfl_xor(x, 8); return x; }
#else
__device__ __forceinline__ float allreduce16(float x) { x = dpp_add<0xB1>(x); x = dpp_add<0x4E>(x); x = dpp_add<0x141>(x); x = dpp_add<0x140>(x); return x; }
#endif
__device__ __forceinline__ void allreduce16x2(float& x, float& y) {
    x = dpp_add<0xB1>(x); y = dpp_add<0xB1>(y); x = dpp_add<0x4E>(x); y = dpp_add<0x4E>(y); x = dpp_add<0x141>(x); y = dpp_add<0x141>(y); x = dpp_add<0x140>(x); y = dpp_add<0x140>(y); }
#define MFMA16(a, b, c) __builtin_amdgcn_mfma_f32_16x16x32_bf16((a), (b), (c), 0, 0, 0)

#define XB_TMO      128
#define XB_XCNT(j)  (256  + 64 * (j))
#define XB_XSUB(j)  (1280 + 64 * (j))
#define XB_XGEN(j)  (2304 + 64 * (j))
#define XB_TOP      3328
#define XB_TOPGEN   3392
#define XCD_BAR_WORDS 3456
#define XB_SPIN_CAP (1u << 18)

__device__ __forceinline__ unsigned xb_ld(unsigned* p)              { return __hip_atomic_load(p, __ATOMIC_RELAXED, __HIP_MEMORY_SCOPE_AGENT); }
__device__ __forceinline__ unsigned xb_add(unsigned* p, unsigned v) { return __hip_atomic_fetch_add(p, v, __ATOMIC_RELAXED, __HIP_MEMORY_SCOPE_AGENT); }
__device__ __forceinline__ unsigned xb_xcc_id() { return (unsigned)__builtin_amdgcn_s_getreg((3 << 11) | 20) & 0xFu; }
#define XB_SPIN(cond, bar) do { unsigned _sp = 0; while (cond) { __builtin_amdgcn_s_sleep(1); \
    if ((++_sp & 255u) == 0u) { if (xb_ld(&(bar)[XB_TMO])) break; if (_sp > XB_SPIN_CAP) { atomicAdd(&(bar)[XB_TMO], 1u); break; } } } } while (0)

struct XcdBarrier {
    unsigned* bar; unsigned x;
    volatile LAS unsigned* st;
};

__device__ __forceinline__ XcdBarrier xcd_barrier_post(unsigned* bar, volatile LAS unsigned* st) {
    XcdBarrier b; b.bar = bar; b.x = xb_xcc_id(); b.st = st;
    if (threadIdx.x == 0) (void)xb_add(&bar[XB_XCNT(b.x)], 1u);
    return b;
}
__device__ __forceinline__ void xcd_barrier_complete(unsigned* bar, unsigned x, unsigned& nloc, unsigned& nx) {
    const unsigned G = gridDim.x * gridDim.y * gridDim.z;
    unsigned sum, cnt, mine, sp = 0u;
    for (;;) {
        sum = 0u; cnt = 0u; mine = 0u;
#pragma unroll
        for (unsigned j = 0; j < 16; ++j) { const unsigned c = xb_ld(&bar[XB_XCNT(j)]); sum += c; cnt += (c > 0u) ? 1u : 0u; mine = (j == x) ? c : mine; }
        if (sum == G) break;
        __builtin_amdgcn_s_sleep(1);
        if ((++sp & 255u) == 0u) { if (xb_ld(&bar[XB_TMO])) break; if (sp > XB_SPIN_CAP) { atomicAdd(&bar[XB_TMO], 1u); break; } }
    }
    nloc = mine > 0u ? mine : 1u; nx = cnt > 0u ? cnt : 1u;
}

__device__ __forceinline__ void xcd_barrier(const XcdBarrier& b) {
    asm volatile("s_waitcnt vmcnt(0)" ::: "memory");
    __syncthreads();
    if (threadIdx.x == 0) {
        unsigned* bar = b.bar;
        __builtin_amdgcn_s_waitcnt(0);
        unsigned nloc = b.st[0], nx = b.st[1];
        if (nloc == 0u) { xcd_barrier_complete(bar, b.x, nloc, nx); b.st[0] = nloc; b.st[1] = nx; }
        const unsigned old = xb_add(&bar[XB_XSUB(b.x)], 1u);
        const unsigned gen = old / nloc;
        if (old + 1u == (gen + 1u) * nloc) {
            __builtin_amdgcn_fence(__ATOMIC_RELEASE, "agent");
            asm volatile("s_waitcnt vmcnt(0)" ::: "memory");
            const unsigned og = xb_add(&bar[XB_TOP], 1u);
            const unsigned tg = og / nx;
            if (og + 1u == (tg + 1u) * nx) xb_add(&bar[XB_TOPGEN], 1u);
            else XB_SPIN(xb_ld(&bar[XB_TOPGEN]) == tg, bar);
            __builtin_amdgcn_fence(__ATOMIC_ACQUIRE, "agent");
            xb_add(&bar[XB_XGEN(b.x)], 1u);
            asm volatile("s_waitcnt vmcnt(0)" ::: "memory");
        } else {
            XB_SPIN(xb_ld(&bar[XB_XGEN(b.x)]) == gen, bar);
            __builtin_amdgcn_fence(__ATOMIC_ACQUIRE, "agent");
            asm volatile("s_waitcnt vmcnt(0)" ::: "memory");
        }
    }
    __syncthreads();
}

__device__ __forceinline__ void rms_row_bf16(const float* src, const float* g, bf16_t* dst, int lane) {
    f32x4 v[4]; float s = 0.f;
#pragma unroll
    for (int j = 0; j < 4; ++j) { v[j] = ((const f32x4*)src)[lane + 64 * j]; s += (v[j][0] * v[j][0] + v[j][1] * v[j][1]) + (v[j][2] * v[j][2] + v[j][3] * v[j][3]); }
    const float rs = 1.0f / sqrtf(wave_sum(s) * (1.0f / 1024.0f) + 1e-6f);
#pragma unroll
    for (int j = 0; j < 4; ++j) { const f32x4 gv = ((const f32x4*)g)[lane + 64 * j]; st4bf(dst + 4 * (lane + 64 * j), v[j] * rs * gv); }
}
__device__ __forceinline__ void tr_item(const float* W, int K, int N, bf16_t* WT, int kb, int n0, int row_base, LAS float* scr, int lane) {
    const int k0 = 64 * kb;
#pragma unroll 8
    for (int i = 0; i < 32; ++i) { const int kk = 2 * i + (lane >> 5); scr[kk * 33 + (lane & 31)] = W[(size_t)(k0 + kk) * N + n0 + (lane & 31)]; }
    asm volatile("s_waitcnt lgkmcnt(0)" ::: "memory");
    const int c = lane & 7;
#pragma unroll
    for (int j = 0; j < 4; ++j) { const int n = (lane >> 3) + 8 * j; const LAS float* sp = scr + (8 * c) * 33 + n;
        u32x4 o; o.x = cvt_pk_bf16(sp[0 * 33], sp[1 * 33]); o.y = cvt_pk_bf16(sp[2 * 33], sp[3 * 33]); o.z = cvt_pk_bf16(sp[4 * 33], sp[5 * 33]); o.w = cvt_pk_bf16(sp[6 * 33], sp[7 * 33]);
        *(u32x4*)(WT + (size_t)(row_base + n) * K + k0 + 8 * c) = o; }
    asm volatile("s_waitcnt lgkmcnt(0)" ::: "memory");
}

__device__ __forceinline__ void prep_phase(int s, int gw, int NGW, int lane, const bf16_t* cols, const bf16_t* carry,
        const float* mu, const float* w0, const float* a0, const float* k_k, const float* k_a, const float* r_k,
        const bf16_t* w2T, const bf16_t* a2T, bf16_t* PR, bf16_t* PK, bf16_t* PA, bf16_t* PB, bf16_t* PV, float* PW, float* bonus, bf16_t* ASG) {
    const int fr = lane & 15, fq = lane >> 4;
    for (int item = gw; item < (MS / 16) * 4; item += NGW) {
        const int tile = item >> 2, hg4 = item & 3;
        const int lt = tile * 16 + fr, b = lt / TS, tl = lt % TS;
        const bf16_t* crow = cols + (size_t)lt * CL;
        const bf16_t* prow = tl > 0 ? crow - CL : carry + ((s & 1) * 4 + b) * CARRY_LD;
        bf16x8 Aw[2], Aa[2];
#pragma unroll
        for (int ks = 0; ks < 2; ++ks) {
            { const int c = C_WLO + ks * 32 + fq * 8; float cur[8], prv[8], t[8]; ld8bf(crow + c, cur); ld8bf(prow + c, prv);
              const f32x4 m0 = *(const f32x4*)(mu + c), m1 = *(const f32x4*)(mu + c + 4);
#pragma unroll
              for (int e = 0; e < 8; ++e) { const float mm = e < 4 ? m0[e & 3] : m1[e & 3]; t[e] = tanh_fast(cur[e] + mm * (prv[e] - cur[e])); }
              Aw[ks] = pack8(t); }
            { const int c = C_ALO + ks * 32 + fq * 8; float cur[8], prv[8], t[8]; ld8bf(crow + c, cur); ld8bf(prow + c, prv);
              const f32x4 m0 = *(const f32x4*)(mu + c), m1 = *(const f32x4*)(mu + c + 4);
#pragma unroll
              for (int e = 0; e < 8; ++e) { const float mm = e < 4 ? m0[e & 3] : m1[e & 3]; t[e] = cur[e] + mm * (prv[e] - cur[e]); }
              Aa[ks] = pack8(t); }
        }
#pragma unroll 1
        for (int pass = 0; pass < 2; ++pass) {
            const int ks = hg4 + 4 * pass;
            if (ks < 5) { const int c = C_GLO + ks * 32 + fq * 8; float cur[8], prv[8], t[8]; ld8bf(crow + c, cur); ld8bf(prow + c, prv);
                const f32x4 m0 = *(const f32x4*)(mu + c), m1 = *(const f32x4*)(mu + c + 4);
#pragma unroll
                for (int e = 0; e < 8; ++e) { const float mm = e < 4 ? m0[e & 3] : m1[e & 3]; t[e] = fast_sigmoid(cur[e] + mm * (prv[e] - cur[e])); }
                *(bf16x8*)(ASG + (size_t)lt * 256 + ks * 32 + fq * 8) = pack8(t); }
            else *(u32x4*)(ASG + (size_t)lt * 256 + ks * 32 + fq * 8) = (u32x4){0u, 0u, 0u, 0u};
        }
#pragma unroll 1
        for (int hh = 0; hh < 4; ++hh) {
            const int h = hg4 * 4 + hh;
            f32x4 aw[4], aa[4];
#pragma unroll
            for (int nt = 0; nt < 4; ++nt) { aw[nt] = (f32x4){0.f, 0.f, 0.f, 0.f}; aa[nt] = (f32x4){0.f, 0.f, 0.f, 0.f};
                const int n = h * 64 + nt * 16 + fr;
#pragma unroll
                for (int ks = 0; ks < 2; ++ks) { const bf16x8 bw = *(const bf16x8*)(w2T + n * 64 + ks * 32 + fq * 8); aw[nt] = MFMA16(bw, Aw[ks], aw[nt]);
                    const bf16x8 ba = *(const bf16x8*)(a2T + n * 64 + ks * 32 + fq * 8); aa[nt] = MFMA16(ba, Aa[ks], aa[nt]); } }
            u32x2 raw[4][6];
#pragma unroll
            for (int nt = 0; nt < 4; ++nt) { const int c = h * 64 + nt * 16 + 4 * fq;
                raw[nt][0] = *(const u32x2*)(crow + C_R + c); raw[nt][1] = *(const u32x2*)(prow + C_R + c); raw[nt][2] = *(const u32x2*)(crow + C_K + c); raw[nt][3] = *(const u32x2*)(prow + C_K + c); raw[nt][4] = *(const u32x2*)(crow + C_V + c); raw[nt][5] = *(const u32x2*)(prow + C_V + c); }
            asm volatile("" :: "v"(raw[0][0]), "v"(raw[1][0]), "v"(raw[2][0]), "v"(raw[3][0]));
            f32x4 kkv[4], av[4]; float ssq = 0.f, bon = 0.f;
#pragma unroll
            for (int nt = 0; nt < 4; ++nt) {
                const int c = h * 64 + nt * 16 + 4 * fq; const size_t o = ((size_t)(b * 16 + h) * TS + tl) * 64 + nt * 16 + 4 * fq;
                const f32x4 rc = up4(raw[nt][0]), rp = up4(raw[nt][1]), kc = up4(raw[nt][2]), kp = up4(raw[nt][3]), vc = up4(raw[nt][4]), vp = up4(raw[nt][5]);
                const f32x4 r = rc + *(const f32x4*)(mu + C_R + c) * (rp - rc), k = kc + *(const f32x4*)(mu + C_K + c) * (kp - kc), v = vc + *(const f32x4*)(mu + C_V + c) * (vp - vc);
                const f32x4 w0v = *(const f32x4*)(w0 + c), a0v = *(const f32x4*)(a0 + c), kkp = *(const f32x4*)(k_k + c), kap = *(const f32x4*)(k_a + c), rkp = *(const f32x4*)(r_k + c);
                f32x4 wv, a, kk, kmod;
#pragma unroll
                for (int j = 0; j < 4; ++j) {
                    const float z = -(w0v[j] + aw[nt][j]);
                    const float sp = fmaxf(z, 0.f) + __logf(1.0f + __expf(-fabsf(z)));
                    wv[j] = __expf(-__expf(-sp - 0.5f));
                    a[j] = fast_sigmoid(a0v[j] + aa[nt][j]);
                    kk[j] = k[j] * kkp[j]; kmod[j] = k[j] * (1.0f + (a[j] - 1.0f) * kap[j]);
                    ssq += kk[j] * kk[j]; bon += r[j] * kmod[j] * rkp[j];
                }
                kkv[nt] = kk; av[nt] = a;
                st4bf(PR + o, r); st4bf(PK + o, kmod); st4bf(PV + o, v); *(f32x4*)(PW + o) = wv;
            }
            ssq = fq_sum(ssq); bon = fq_sum(bon);
            const float rs = 1.0f / sqrtf(fmaxf(ssq, 1e-24f));
#pragma unroll
            for (int nt = 0; nt < 4; ++nt) { const size_t o = ((size_t)(b * 16 + h) * TS + tl) * 64 + nt * 16 + 4 * fq;
                const f32x4 kn = kkv[nt] * rs; st4bf(PA + o, -kn); st4bf(PB + o, kn * av[nt]); }
            if (fq == 0) bonus[lt * 16 + h] = bon;
        }
    }
}

__device__ __forceinline__ void post_phase(int s, int gw, int NGW, int lane, const bf16_t* cols, const bf16_t* carry, const float* mu, const bf16_t* gate,
        const float* ln_w, const float* ln_b, const float* hg_g, const bf16_t* oraw, const bf16_t* hgo, const bf16_t* PV, const float* bonus, bf16_t* merged) {
    const int fr = lane & 15, fq = lane >> 4;
    for (int item = gw; item < (MS / 16) * 4; item += NGW) {
        const int tile = item >> 2, q4 = item & 3;
        const int lt = tile * 16 + fr, b = lt / TS, tl = lt % TS;
        const size_t gt = (size_t)b * SEQ + s * TS + tl;
        const bf16_t* crow = cols + (size_t)lt * CL;
        const bf16_t* prow = tl > 0 ? crow - CL : carry + ((s & 1) * 4 + b) * CARRY_LD;
#pragma unroll 1
        for (int hgh = 0; hgh < 2; ++hgh) {
            const int h8 = q4 * 2 + hgh;
            f32x4 ho[8]; float ss = 0.f;
#pragma unroll
            for (int n8 = 0; n8 < 8; ++n8) { ho[n8] = ld4bf(hgo + ((size_t)((b * 8 + h8) * 8 + n8) * TS + tl) * 16 + 4 * fq); ss += (ho[n8][0] * ho[n8][0] + ho[n8][1] * ho[n8][1]) + (ho[n8][2] * ho[n8][2] + ho[n8][3] * ho[n8][3]); }
            ss = fq_sum(ss);
            const float rsh = 1.0f / sqrtf(ss * (1.0f / 128.0f) + 1e-6f);
#pragma unroll
            for (int rwh = 0; rwh < 2; ++rwh) {
                const int h = q4 * 4 + hgh * 2 + rwh;
                f32x4 ag[4], o[4]; float sm = 0.f;
                for (int nt = 0; nt < 4; ++nt) { ag[nt] = ld4bf(gate + (size_t)lt * 1024 + h * 64 + nt * 16 + 4 * fq);
                    o[nt] = ld4bf(oraw + ((size_t)((b * 16 + h) * 4 + nt) * TS + tl) * 16 + 4 * fq); sm += (o[nt][0] + o[nt][1]) + (o[nt][2] + o[nt][3]); }
                const float mean = fq_sum(sm) * (1.0f / 64.0f); float vq = 0.f;
#pragma unroll
                for (int nt = 0; nt < 4; ++nt) { o[nt] = o[nt] - mean; vq += (o[nt][0] * o[nt][0] + o[nt][1] * o[nt][1]) + (o[nt][2] * o[nt][2] + o[nt][3] * o[nt][3]); }
                const float rstd = 1.0f / sqrtf(fq_sum(vq) * (1.0f / 64.0f) + 64e-5f);
#ifdef MK_NO_BONUS
                const float bon = 0.f;
#else
                const float bon = bonus[lt * 16 + h];
#endif
#pragma unroll
                for (int nt = 0; nt < 4; ++nt) {
                    const int c = h * 64 + nt * 16 + 4 * fq;
                    const f32x4 lw = *(const f32x4*)(ln_w + c), lb = *(const f32x4*)(ln_b + c), v = ld4bf(PV + ((size_t)(b * 16 + h) * TS + tl) * 64 + nt * 16 + 4 * fq);
                    const f32x4 ya = (o[nt] * rstd * lw + lb + v * bon) * ag[nt];
                    const f32x4 ng = *(const f32x4*)(hg_g + (c & 127)), gh = ld4bf(crow + C_HG + c), gar = ld4bf(crow + C_GA + c), gbr = ld4bf(crow + C_GB + c);
                    const f32x4 hv = ho[rwh * 4 + nt] * rsh * ng;
                    f32x4 m;
#pragma unroll
                    for (int j = 0; j < 4; ++j) {
#if defined(MK_ZERO_YA)
                        m[j] = fast_sigmoid(gbr[j]) * (hv[j] * fast_silu(gh[j]));
#elif defined(MK_ZERO_YB)
                        m[j] = fast_sigmoid(gar[j]) * ya[j];
#else
                        m[j] = gar[j] * ya[j] + gbr[j] * (hv[j] * gh[j]);
#endif
                    }
                    st4bf(merged + gt * 1024 + c, m);
                }
            }
        }
    }
}

#define SCAN_BAR_L() do { asm volatile("s_waitcnt vmcnt(0) lgkmcnt(0)" ::: "memory"); __builtin_amdgcn_s_barrier(); asm volatile("" ::: "memory"); } while (0)
#define SCAN_BAR_S() do { asm volatile("s_waitcnt lgkmcnt(0)" ::: "memory"); __builtin_amdgcn_s_barrier(); asm volatile("" ::: "memory"); } while (0)
constexpr int ST = 32;
constexpr int S_RWA = 8192, S_RWV = 40960, S_RWY = 45056, S_RWB = 61440;
constexpr int S_HGQ = 16384, S_HGI = 32768, S_HGY = 36864, S_HGB = 53248;
__device__ __forceinline__ void s_rw_load(LAS unsigned char* bp, int lt2, size_t htok0  , int hf, const bf16_t* PA, const float* PW, const bf16_t* PB, const bf16_t* PK, const bf16_t* PR, const bf16_t* PV) {
#pragma unroll
    for (int half = 0; half < 2; ++half) {
    const int tok = (lt2 >> 4) + 16 * half, c4 = (lt2 & 15) * 4; const size_t base = (htok0 + tok) * 64 + c4;
    const f32x4 va = ld4bf(PA + base), vb = ld4bf(PB + base), vk = ld4bf(PK + base), vr = ld4bf(PR + base), vw = *(const f32x4*)(PW + base);
    const unsigned rv = *(const unsigned*)(PV + (htok0 + tok) * 64 + hf * 32 + (lt2 & 15) * 2);
    const int off = (tok * 64 + c4) * 4;
    *(LAS f32x4*)(bp + off) = va; *(LAS f32x4*)(bp + S_RWA + off) = vw; *(LAS f32x4*)(bp + 2 * S_RWA + off) = vb; *(LAS f32x4*)(bp + 3 * S_RWA + off) = vk; *(LAS f32x4*)(bp + 4 * S_RWA + off) = vr;
    *(LAS f32x2v*)(bp + S_RWV + (tok * 32 + (lt2 & 15) * 2) * 4) = (f32x2v){bflo(rv), bfhi(rv)}; }
}
__device__ __forceinline__ void s_hg_load(LAS unsigned char* bp, int lt2, size_t ltok0, int h8, int q4, const bf16_t* cols, const float* lbv) {
#pragma unroll
    for (int half = 0; half < 2; ++half) {
    const int tok = (lt2 >> 4) + 16 * half, c8 = (lt2 & 15) * 8; const bf16_t* crow = cols + (ltok0 + tok) * CL;
    float q[8], f[8]; ld8bf(crow + C_HQ + h8 * 128 + c8, q); ld8bf(crow + C_HF + h8 * 128 + c8, f);
    const unsigned rv = *(const unsigned*)(crow + C_HI + h8 * 128 + q4 * 32 + (lt2 & 15) * 2);
    const f32x4 lb0 = *(const f32x4*)(lbv + h8 * 128 + c8), lb1 = *(const f32x4*)(lbv + h8 * 128 + c8 + 4);
    const int off = (tok * 128 + c8) * 4;
    *(LAS f32x4*)(bp + off) = (f32x4){lb0[0] + (1.f - lb0[0]) * f[0], lb0[1] + (1.f - lb0[1]) * f[1], lb0[2] + (1.f - lb0[2]) * f[2], lb0[3] + (1.f - lb0[3]) * f[3]};
    *(LAS f32x4*)(bp + off + 16) = (f32x4){lb1[0] + (1.f - lb1[0]) * f[4], lb1[1] + (1.f - lb1[1]) * f[5], lb1[2] + (1.f - lb1[2]) * f[6], lb1[3] + (1.f - lb1[3]) * f[7]};
    *(LAS f32x4*)(bp + S_HGQ + off) = (f32x4){q[0], q[1], q[2], q[3]}; *(LAS f32x4*)(bp + S_HGQ + off + 16) = (f32x4){q[4], q[5], q[6], q[7]};
    *(LAS f32x2v*)(bp + S_HGI + (tok * 32 + (lt2 & 15) * 2) * 4) = (f32x2v){bflo(rv), bfhi(rv)}; }
}
__device__ __forceinline__ void s_drain(const LAS unsigned char* ybase, int lt2, bf16_t* obase  ) {
#pragma unroll
    for (int half = 0; half < 2; ++half) {
    const int t = (lt2 >> 4) + 16 * half, rp = (lt2 & 15) * 2;
    const f32x4 pa = *(const LAS f32x4*)(ybase + (t * 32 + rp) * 16), pb = *(const LAS f32x4*)(ybase + (t * 32 + rp) * 16 + 16);
    *(unsigned*)(obase + (size_t)(rp >> 4) * (TS * 16) + t * 16 + (rp & 15)) = cvt_pk_bf16((pa[0] + pa[1]) + (pa[2] + pa[3]), (pb[0] + pb[1]) + (pb[2] + pb[3])); }
}
__device__ __forceinline__ float dot4(f32x4 a, f32x4 b) { return __builtin_fmaf(a[3], b[3], __builtin_fmaf(a[2], b[2], __builtin_fmaf(a[1], b[1], a[0] * b[0]))); }
__device__ __forceinline__ float dot4acc(f32x4 a, f32x4 b, float c) { return __builtin_fmaf(a[3], b[3], __builtin_fmaf(a[2], b[2], __builtin_fmaf(a[1], b[1], __builtin_fmaf(a[0], b[0], c)))); }
__device__ __forceinline__ void split_scan(int s, int bid, int G, int tid, int lane, int wave, LAS unsigned char* lds,
        const bf16_t* PA, const float* PW, const bf16_t* PB, const bf16_t* PK, const bf16_t* PR, const bf16_t* PV, const bf16_t* cols, const float* lbv,
        bf16_t* oraw, bf16_t* hgo, float* rwstate, float* hgstate, bool save) {
    constexpr int NBLK = TS / ST;
    const int rowl = lane >> 4, j = lane & 15, r0 = (wave & 3) * 8 + rowl, r1 = r0 + 4;
    for (int it = bid; it < 256; it += G) {
        if (it < 128) {
            const int xq = it & 7, yq = it >> 3; const int hid = (G == 256) ? xq * 8 + (yq >> 1) : (it >> 1); const int hf = (G == 256) ? (yq & 1) : (it & 1);
            const int b = hid >> 4, h = hid & 15;
            const size_t tok0 = (size_t)b * TS;
            float* sp0 = rwstate + ((size_t)((b * 16 + h) * 64 + hf * 32 + r0) * 64 + 4 * j); float* sp1 = sp0 + 4 * 64;
            bf16_t* og = oraw + (size_t)((b * 16 + h) * 4 + hf * 2) * TS * 16;
            f32x4 x0 = (f32x4){0.f, 0.f, 0.f, 0.f}, x1 = x0;
            if (wave < 4 && s > 0) { x0 = *(const f32x4*)sp0; x1 = *(const f32x4*)sp1; }
            if (wave >= 4) { s_rw_load(lds, tid - 256, (size_t)(b * 16 + h) * TS, hf, PA, PW, PB, PK, PR, PV); SCAN_BAR_L(); } else { __builtin_amdgcn_s_setprio(2); asm volatile("s_waitcnt vmcnt(0)" ::: "memory"); SCAN_BAR_S(); }
#pragma unroll 1
            for (int blk = 0; blk < NBLK; ++blk) {
                if (wave >= 4) {
                    if (blk > 0) s_drain(lds + ((blk - 1) & 1) * S_RWB + S_RWY, tid - 256, og + (size_t)(blk - 1) * (ST * 16));
                    if (blk + 1 < NBLK) s_rw_load(lds + ((blk + 1) & 1) * S_RWB, tid - 256, (size_t)(b * 16 + h) * TS + (blk + 1) * ST, hf, PA, PW, PB, PK, PR, PV);
                    SCAN_BAR_L();
                } else {
                    const LAS unsigned char* bp = lds + (blk & 1) * S_RWB;
                    const LAS unsigned char* p4 = bp + 16 * j; const LAS unsigned char* pv = bp + S_RWV + r0 * 4; LAS unsigned char* py = (LAS unsigned char*)bp + S_RWY + (r0 * 4 + (j >> 2)) * 4;
                    f32x4 a4 = *(const LAS f32x4*)(p4), w4 = *(const LAS f32x4*)(p4 + S_RWA), b4 = *(const LAS f32x4*)(p4 + 2 * S_RWA), k4 = *(const LAS f32x4*)(p4 + 3 * S_RWA), r4 = *(const LAS f32x4*)(p4 + 4 * S_RWA);
                    float v0 = *(const LAS float*)(pv), v1 = *(const LAS float*)(pv + 16);
                    float sa0 = dot4(x0, a4), sa1 = dot4(x1, a4);
                    allreduce16x2(sa0, sa1);
#pragma unroll
                    for (int t = 0; t < ST; ++t) {
                        f32x4 na = a4, nw = w4, nb = b4, nk = k4, nr = r4; float n0 = v0, n1 = v1;
                        if (t < ST - 1) { const int o = (t + 1) * 256; na = *(const LAS f32x4*)(p4 + o); nw = *(const LAS f32x4*)(p4 + S_RWA + o); nb = *(const LAS f32x4*)(p4 + 2 * S_RWA + o); nk = *(const LAS f32x4*)(p4 + 3 * S_RWA + o); nr = *(const LAS f32x4*)(p4 + 4 * S_RWA + o);
                            n0 = *(const LAS float*)(pv + (t + 1) * 128); n1 = *(const LAS float*)(pv + (t + 1) * 128 + 16); }
                        x0 = x0 * w4 + (b4 * sa0 + k4 * v0); x1 = x1 * w4 + (b4 * sa1 + k4 * v1);
                        float y0 = dot4(x0, r4), y1 = dot4(x1, r4);
                        float s0n = dot4(x0, na), s1n = dot4(x1, na);
                        s0n = dpp_add<0xB1>(s0n); s1n = dpp_add<0xB1>(s1n); y0 = dpp_add<0xB1>(y0); y1 = dpp_add<0xB1>(y1); s0n = dpp_add<0x4E>(s0n); s1n = dpp_add<0x4E>(s1n); y0 = dpp_add<0x4E>(y0); y1 = dpp_add<0x4E>(y1);
                        s0n = dpp_add<0x141>(s0n); s1n = dpp_add<0x141>(s1n); s0n = dpp_add<0x140>(s0n); s1n = dpp_add<0x140>(s1n);
                        *(LAS float*)(py + t * 512) = y0; *(LAS float*)(py + t * 512 + 64) = y1;
                        sa0 = s0n; sa1 = s1n; a4 = na; w4 = nw; b4 = nb; k4 = nk; r4 = nr; v0 = n0; v1 = n1;
                    }
                    SCAN_BAR_S();
                }
            }
            if (wave >= 4) s_drain(lds + ((NBLK - 1) & 1) * S_RWB + S_RWY, tid - 256, og + (size_t)(NBLK - 1) * (ST * 16));
            else { __builtin_amdgcn_s_setprio(0); if (save) { *(f32x4*)sp0 = x0; *(f32x4*)sp1 = x1; } }
        } else {
            const int i2 = it - 128, xq = i2 & 7, yq = i2 >> 3; const int gid = (G == 256) ? xq * 4 + (yq >> 2) : (i2 >> 2); const int q4 = (G == 256) ? (yq & 3) : (i2 & 3);
            const int b = gid >> 3, h8 = gid & 7;
            const size_t tok0 = (size_t)b * TS;
            float* sp0 = hgstate + ((size_t)((b * 8 + h8) * 128 + q4 * 32 + r0) * 128 + 4 * j); float* sp1 = sp0 + 4 * 128;
            bf16_t* og = hgo + (size_t)((b * 8 + h8) * 8 + q4 * 2) * TS * 16;
            f32x4 a0 = (f32x4){0.f, 0.f, 0.f, 0.f}, a1 = a0, c0 = a0, c1 = a0;
            if (wave < 4 && s > 0) { a0 = *(const f32x4*)sp0; a1 = *(const f32x4*)(sp0 + 64); c0 = *(const f32x4*)sp1; c1 = *(const f32x4*)(sp1 + 64); }
            if (wave >= 4) { s_hg_load(lds, tid - 256, tok0, h8, q4, cols, lbv); SCAN_BAR_L(); } else { __builtin_amdgcn_s_setprio(2); asm volatile("s_waitcnt vmcnt(0)" ::: "memory"); SCAN_BAR_S(); }
#pragma unroll 1
            for (int blk = 0; blk < NBLK; ++blk) {
                if (wave >= 4) {
                    if (blk > 0) s_drain(lds + ((blk - 1) & 1) * S_HGB + S_HGY, tid - 256, og + (size_t)(blk - 1) * (ST * 16));
                    if (blk + 1 < NBLK) s_hg_load(lds + ((blk + 1) & 1) * S_HGB, tid - 256, tok0 + (blk + 1) * ST, h8, q4, cols, lbv);
                    SCAN_BAR_L();
                } else {
                    const LAS unsigned char* bp = lds + (blk & 1) * S_HGB;
                    const LAS unsigned char* g4 = bp + 16 * j; const LAS unsigned char* gi = bp + S_HGI + r0 * 4; LAS unsigned char* gy = (LAS unsigned char*)bp + S_HGY + (r0 * 4 + (j >> 2)) * 4;
                    f32x4 f0 = *(const LAS f32x4*)(g4), f1 = *(const LAS f32x4*)(g4 + 256), q0 = *(const LAS f32x4*)(g4 + S_HGQ), q1 = *(const LAS f32x4*)(g4 + S_HGQ + 256);
                    float i0 = *(const LAS float*)(gi), i1 = *(const LAS float*)(gi + 16);
#pragma unroll
                    for (int t = 0; t < ST; ++t) {
                        f32x4 nf0 = f0, nf1 = f1, nq0 = q0, nq1 = q1; float ni0 = i0, ni1 = i1;
                        if (t < ST - 1) { const int o = (t + 1) * 512; nf0 = *(const LAS f32x4*)(g4 + o); nf1 = *(const LAS f32x4*)(g4 + 256 + o); nq0 = *(const LAS f32x4*)(g4 + S_HGQ + o); nq1 = *(const LAS f32x4*)(g4 + S_HGQ + 256 + o);
                            ni0 = *(const LAS float*)(gi + (t + 1) * 128); ni1 = *(const LAS float*)(gi + (t + 1) * 128 + 16); }
                        { f32x2v iA = (f32x2v){i0, i0}, iB = (f32x2v){i1, i1}; asm volatile("" : "+v"(iA), "+v"(iB));
                          const f32x4 i0v = (f32x4){iA[0], iA[1], iA[0], iA[1]}, i1v = (f32x4){iB[0], iB[1], iB[0], iB[1]};
                          a0 = (a0 - i0v) * f0 + i0v; a1 = (a1 - i0v) * f1 + i0v; c0 = (c0 - i1v) * f0 + i1v; c1 = (c1 - i1v) * f1 + i1v; }
                        float y0 = dot4acc(a1, q1, dot4(a0, q0));
                        float y1 = dot4acc(c1, q1, dot4(c0, q0));
                        y0 = dpp_add<0xB1>(y0); y1 = dpp_add<0xB1>(y1); y0 = dpp_add<0x4E>(y0); y1 = dpp_add<0x4E>(y1);
                        *(LAS float*)(gy + t * 512) = y0; *(LAS float*)(gy + t * 512 + 64) = y1;
                        f0 = nf0; f1 = nf1; q0 = nq0; q1 = nq1; i0 = ni0; i1 = ni1;
                    }
                    SCAN_BAR_S();
                }
            }
            if (wave >= 4) s_drain(lds + ((NBLK - 1) & 1) * S_HGB + S_HGY, tid - 256, og + (size_t)(NBLK - 1) * (ST * 16));
            else { __builtin_amdgcn_s_setprio(0); if (save) { *(f32x4*)sp0 = a0; *(f32x4*)(sp0 + 64) = a1; *(f32x4*)sp1 = c0; *(f32x4*)(sp1 + 64) = c1; } }
        }
    }
}

__device__ __forceinline__ void attn_phase(int gw, int NGW, int lane, const bf16_t* Q, const bf16_t* KV, const bf16_t* Vt, bf16_t* AO, const float* kmax2) {
    const int fr = lane & 15, fq = lane >> 4;
    const bool xcd_map = (NGW == 2048);
    for (int it0 = xcd_map ? 0 : gw; it0 < (xcd_map ? 2 : 4096); it0 += (xcd_map ? 1 : NGW)) {
        int item = it0;
        if (xcd_map) { const int wgi = gw >> 3, wv = gw & 7, xq = wgi & 7, yq = wgi >> 3; item = ((2 * xq + it0) << 8) | (yq * 8 + wv); }
        const int bh = item >> 8, tile = item & 255, b = bh >> 2, hd = bh & 3;
        const size_t g0 = (size_t)b * SEQ + tile * 32 + fr, g1 = g0 + 16;
        const float kmx = sqrtf(fmaxf(fmaxf(kmax2[(bh * 4 + 0) * 32], kmax2[(bh * 4 + 1) * 32]), fmaxf(kmax2[(bh * 4 + 2) * 32], kmax2[(bh * 4 + 3) * 32])));
        bf16x8 qa[8], qb[8]; float na = 0.f, nb = 0.f;
#pragma unroll
        for (int ks = 0; ks < 8; ++ks) { const u32x4 ua = *(const u32x4*)(Q + g0 * 1024 + hd * 256 + ks * 32 + fq * 8), ub = *(const u32x4*)(Q + g1 * 1024 + hd * 256 + ks * 32 + fq * 8);
            qa[ks] = __builtin_bit_cast(bf16x8, ua); qb[ks] = __builtin_bit_cast(bf16x8, ub);
#pragma unroll
            for (int e = 0; e < 4; ++e) { const float a0 = bflo(ua[e]), a1 = bfhi(ua[e]), b0 = bflo(ub[e]), b1 = bfhi(ub[e]); na += a0 * a0 + a1 * a1; nb += b0 * b0 + b1 * b1; } }
        na = fq_sum(na); nb = fq_sum(nb);
        const float ma = sqrtf(na) * kmx * 0.0625f * 1.001f, mb = sqrtf(nb) * kmx * 0.0625f * 1.001f;
        float za = 0.f, zb = 0.f;
        bf16x8 pa[8], pb[8];
        const bf16_t* kbase = KV + (size_t)((b * 4 + hd) * 256 + fr) * 256 + fq * 8;
        bf16x8 kc[8], kn[8];
#pragma unroll
        for (int i = 0; i < 4; ++i) { kc[2 * i] = *(const bf16x8*)(kbase + i * 32); kc[2 * i + 1] = *(const bf16x8*)(kbase + (size_t)16 * 256 + i * 32); }
        f32x4 e0, e1, f0, f1;
#pragma unroll
        for (int st = 0; st < 16; ++st) {
            const int k2 = st >> 1, hs = st & 1;
            if (st < 15) { const int n2 = (st + 1) >> 1, nh = (st + 1) & 1; const bf16_t* p0 = kbase + (size_t)(2 * n2) * 16 * 256 + nh * 128;
#pragma unroll
                for (int i = 0; i < 4; ++i) { kn[2 * i] = *(const bf16x8*)(p0 + i * 32); kn[2 * i + 1] = *(const bf16x8*)(p0 + (size_t)16 * 256 + i * 32); } }
            if (hs == 0) { e0 = (f32x4){0.f, 0.f, 0.f, 0.f}; e1 = e0; f0 = e0; f1 = e0; }
#pragma unroll
            for (int i = 0; i < 4; ++i) { const int ks = hs * 4 + i; e0 = MFMA16(kc[2 * i], qa[ks], e0); f0 = MFMA16(kc[2 * i], qb[ks], f0); e1 = MFMA16(kc[2 * i + 1], qa[ks], e1); f1 = MFMA16(kc[2 * i + 1], qb[ks], f1); }
            if (hs == 1) {
#pragma unroll
                for (int jj = 0; jj < 4; ++jj) { e0[jj] = __expf(e0[jj] * 0.0625f - ma); e1[jj] = __expf(e1[jj] * 0.0625f - ma); f0[jj] = __expf(f0[jj] * 0.0625f - mb); f1[jj] = __expf(f1[jj] * 0.0625f - mb);
                    za += e0[jj] + e1[jj]; zb += f0[jj] + f1[jj]; }
                u32x4 w; w.x = cvt_pk_bf16(e0[0], e0[1]); w.y = cvt_pk_bf16(e0[2], e0[3]); w.z = cvt_pk_bf16(e1[0], e1[1]); w.w = cvt_pk_bf16(e1[2], e1[3]); pa[k2] = __builtin_bit_cast(bf16x8, w);
                u32x4 x; x.x = cvt_pk_bf16(f0[0], f0[1]); x.y = cvt_pk_bf16(f0[2], f0[3]); x.z = cvt_pk_bf16(f1[0], f1[1]); x.w = cvt_pk_bf16(f1[2], f1[3]); pb[k2] = __builtin_bit_cast(bf16x8, x); }
#pragma unroll
            for (int i = 0; i < 8; ++i) kc[i] = kn[i];
        }
        za = fq_sum(za); zb = fq_sum(zb);
        const float ia = 1.0f / za, ib = 1.0f / zb;
#pragma unroll 4
        for (int dt = 0; dt < 16; ++dt) { f32x4 a0 = (f32x4){0.f, 0.f, 0.f, 0.f}, a1 = a0; const bf16_t* vp = Vt + (size_t)((b * 4 + hd) * 256 + dt * 16 + fr) * 256 + fq * 8;
#pragma unroll
            for (int k2 = 0; k2 < 8; ++k2) { const bf16x8 vf = *(const bf16x8*)(vp + k2 * 32); a0 = MFMA16(vf, pa[k2], a0); a1 = MFMA16(vf, pb[k2], a1); }
            st4bf(AO + g0 * 1024 + hd * 256 + dt * 16 + 4 * fq, a0 * ia); st4bf(AO + g1 * 1024 + hd * 256 + dt * 16 + 4 * fq, a1 * ib); }
    }
}

__device__ __forceinline__ int tid_fresh() { int t = threadIdx.x; asm volatile("" : "+v"(t)); return t; }
#define WinT ((bf16_t*)(a.ws + WS_WIN))
#define WoutT ((bf16_t*)(a.ws + WS_WOUT))
#define WqT ((bf16_t*)(a.ws + WS_WQ))
#define WoT ((bf16_t*)(a.ws + WS_WO))
#define WkvT ((bf16_t*)(a.ws + WS_WKV))
#define W13T ((bf16_t*)(a.ws + WS_W13))
#define W2T ((bf16_t*)(a.ws + WS_W2))
#define rw2T ((bf16_t*)(a.ws + WS_RW2T))
#define ra2T ((bf16_t*)(a.ws + WS_RA2T))
#define rg2T ((bf16_t*)(a.ws + WS_RG2T))
#define g2Tp ((bf16_t*)(a.ws + WS_G2TP))
#define SS1 ((float*)(a.ws + WS_SS1))
#define SS2 ((float*)(a.ws + WS_SS2))
#define KMAX2 ((float*)(a.ws + WS_KMAX))
#define KH ((bf16_t*)(a.ws + WS_KH))
#define GATE ((bf16_t*)(a.ws + WS_GATE))
#define ASG ((bf16_t*)(a.ws + WS_ASG))
#define carry ((bf16_t*)(a.ws + WS_CARRY))
#define lbv ((float*)(a.ws + WS_LB))
#define mbf ((bf16_t*)(a.ws + WS_MBF))
#define KV ((bf16_t*)(a.ws + WS_KV))
#define Vt ((bf16_t*)(a.ws + WS_VT))
#define rwst ((float*)(a.ws + WS_RWST))
#define hgst ((float*)(a.ws + WS_HGST))
#define bonus ((float*)(a.ws + WS_BONUS))
#define merged ((bf16_t*)(a.ws + WS_MERGED))
#define u1 ((bf16_t*)(a.ws + WS_U1))
#define cols ((bf16_t*)(a.ws + WS_COLS))
#define PR ((bf16_t*)(a.ws + WS_PR))
#define PK ((bf16_t*)(a.ws + WS_PK))
#define PA ((bf16_t*)(a.ws + WS_PA))
#define PB ((bf16_t*)(a.ws + WS_PB))
#define PV ((bf16_t*)(a.ws + WS_PV))
#define PW ((float*)(a.ws + WS_PW))
#define oraw ((bf16_t*)(a.ws + WS_ORAW))
#define hgo ((bf16_t*)(a.ws + WS_HGO))
#define U ((bf16_t*)(a.ws + WS_U))
#define Qb ((bf16_t*)(a.ws + WS_Q))
#define AO ((bf16_t*)(a.ws + WS_AO))
#define FF ((bf16_t*)(a.ws + WS_FF))
#define XIN (a.in[0])
#define OUTP (a.out)
struct Args { const float* in[29]; float* out; unsigned char* ws; int ph_lo, ph_hi; };

typedef const __attribute__((address_space(4))) Args* CArgsP;
__device__ __forceinline__ CArgsP args_fresh() { CArgsP p = (CArgsP)__builtin_amdgcn_kernarg_segment_ptr(); asm volatile("" : "+s"(p)); return p; }
__global__ void __launch_bounds__(512, 2) mega(Args a0) {
    extern __shared__ __attribute__((aligned(16))) unsigned char lds_raw[];
    LAS unsigned char* lds = (LAS unsigned char*)lds_raw;
    cg::grid_group grid = cg::this_grid();
    const int G = gridDim.x, bid = blockIdx.x, NGW = G * 8, NGT = G * 512;
#define IDS const auto& a = *args_fresh(); const int tid = tid_fresh(), lane = tid & 63, wave = __builtin_amdgcn_readfirstlane(tid >> 6), gw = bid * 8 + wave, gtid = bid * 512 + tid; (void)lane; (void)gw; (void)gtid
    const int lo = a0.ph_lo, hi = a0.ph_hi;
    if (lo < 0) grid.sync();
    { volatile LAS unsigned* misc = (volatile LAS unsigned*)(lds + MISC_OFF); if (threadIdx.x < 2) misc[threadIdx.x] = 0u; __syncthreads();
      if (hi - lo > 1) (void)xcd_barrier_post((unsigned*)(a0.ws + WS_CTL), misc); }
#ifndef MK_REP
#define MK_REP -1
#endif
#ifndef MK_REPN
#define MK_REPN 3
#endif
#define RPT(code) for (int rep_ = 0, nrep_ = (MK_REP == (code)) ? MK_REPN : 1; rep_ < nrep_; ++rep_)
#define LASTREP (rep_ == nrep_ - 1)
#ifdef MK_PROBE
    unsigned long long probe_acc = 0ull, probe_t0 = 0ull;
#define PB_BEGIN(code) do { if ((code) == MK_PROBE) probe_t0 = __builtin_amdgcn_s_memrealtime(); } while (0)
#define PB_END(code) do { if ((code) == MK_PROBE) probe_acc += __builtin_amdgcn_s_memrealtime() - probe_t0; } while (0)
#else
#define PB_BEGIN(code) do { } while (0)
#define PB_END(code) do { } while (0)
#endif
#define IN(k) (lo <= (k) && (k) < hi)
#define SEAM(k) do { if (IN(k) && IN((k) + 1)) RPT(120) { XcdBarrier xb_; xb_.bar = (unsigned*)(args_fresh()->ws + WS_CTL); xb_.x = xb_xcc_id(); xb_.st = (volatile LAS unsigned*)(lds + MISC_OFF); xcd_barrier(xb_); } } while (0)

    PB_BEGIN(100);
    if (IN(0)) RPT(100) { IDS;
        LAS float* scr = (LAS float*)(lds + wave * 16384);
        constexpr int I_IN = 16 * 297, I_SQ = 16 * 32, I_13 = 16 * 88, I_2 = 44 * 32;
        constexpr int NITEMS = I_IN + 5 * I_SQ + 2 * I_13 + I_2;
        for (int it = gw; it < NITEMS; it += NGW) {
            int r = it;
            if (r < I_IN) { const int kb = r / 297, n0 = (r % 297) * 32; tr_item(a.in[3], 1024, 9504, WinT, kb, n0, n0 + (n0 >= 3360 ? 224 : 0), scr, lane); continue; } r -= I_IN;
            if (r < I_SQ) { tr_item(a.in[17], 1024, 1024, WoutT, r / 32, (r % 32) * 32, (r % 32) * 32, scr, lane); continue; } r -= I_SQ;
            if (r < I_SQ) { tr_item(a.in[20], 1024, 1024, WqT, r / 32, (r % 32) * 32, (r % 32) * 32, scr, lane); continue; } r -= I_SQ;
            if (r < I_SQ) { tr_item(a.in[23], 1024, 1024, WoT, r / 32, (r % 32) * 32, (r % 32) * 32, scr, lane); continue; } r -= I_SQ;
            if (r < I_SQ) { tr_item(a.in[21], 1024, 1024, WkvT, r / 32, (r % 32) * 32, (r % 32) * 32, scr, lane); continue; } r -= I_SQ;
            if (r < I_SQ) { tr_item(a.in[22], 1024, 1024, WkvT, r / 32, (r % 32) * 32, 1024 + (r % 32) * 32, scr, lane); continue; } r -= I_SQ;
            if (r < I_13) { const int n0 = (r % 88) * 32; tr_item(a.in[25], 1024, DFF, W13T, r / 88, n0, (n0 / 128) * 256 + (n0 % 128), scr, lane); continue; } r -= I_13;
            if (r < I_13) { const int n0 = (r % 88) * 32; tr_item(a.in[26], 1024, DFF, W13T, r / 88, n0, (n0 / 128) * 256 + 128 + (n0 % 128), scr, lane); continue; } r -= I_13;
            tr_item(a.in[27], DFF, 1024, W2T, r / 32, (r % 32) * 32, (r % 32) * 32, scr, lane);
        }
        for (int i = gtid; i < 28672; i += NGT) ((u32x4*)(WinT + 3360 * 1024))[i] = (u32x4){0u, 0u, 0u, 0u};
        for (int i = gtid; i < 1792; i += NGT) ((u32x4*)carry)[i] = (u32x4){0u, 0u, 0u, 0u};
        for (int n = gw; n < 1024; n += NGW) { rw2T[n * 64 + lane] = (bf16_t)f2bf(a.in[6][lane * 1024 + n]); ra2T[n * 64 + lane] = (bf16_t)f2bf(a.in[8][lane * 1024 + n]); }
        for (int m = gw; m < 512; m += NGW) {
            for (int e = lane; e < 320; e += 64) { const int n = 2 * m + (e >= 160 ? 1 : 0), k = e >= 160 ? e - 160 : e; rg2T[n * 160 + k] = (bf16_t)f2bf(a.in[9][k * 1024 + n]); } }
        for (int n = gw; n < 1024; n += NGW) { f32x4 v;
#pragma unroll
            for (int e = 0; e < 4; ++e) { const int k = 4 * lane + e; v[e] = k < 160 ? a.in[9][k * 1024 + n] : 0.f; }
            st4bf(g2Tp + n * 256 + 4 * lane, v); }
        for (int i = gtid; i < 1024; i += NGT) lbv[i] = 1.0f / (1.0f + __expf(a.in[15][1024 + i] - a.in[15][i]));
        for (int m = gw; m < 1024; m += NGW) rms_row_bf16(a.in[1] + (size_t)m * 1024, a.in[19], mbf + (size_t)m * 1024, lane);
        for (int lt = gw; lt < MS; lt += NGW) { const int b = lt / TS, tl = lt % TS; const size_t gt = (size_t)b * SEQ + tl; rms_row_bf16(XIN + gt * 1024, a.in[2], u1 + (size_t)lt * 1024, lane); }
        __syncthreads();
    }
    SEAM(0);
    PB_END(100);

#pragma unroll 1
    for (int s = 0; s < NSPLIT; ++s) {
        const int pb = 1 + 5 * s;
        PB_BEGIN(102);
        if (IN(pb + 1)) { const auto& a = *args_fresh();
            pg8::Gemm g{u1, WinT, MS, CL, 1024}; pg8::StaticOrder S; S.init(MS, CL, G, bid);
            pg8::EpiColsAct E{cols, CL};
            RPT(102) pg8::gemm_phase<pg8::EpiColsAct, pg8::StaticOrder, true, true>(lds, g, S, E);
            if (s == 0 && (G != 256 || bid >= 224)) {
                pg8::Gemm g2{mbf, WkvT, 1024, 2048, 1024}; pg8::StaticOrder S2; if (G == 256) S2.init(1024, 2048, 32, bid - 224); else S2.init(1024, 2048, G, bid); pg8::EpiStoreBf16 E2{KV, 2048};
                pg8::gemm_phase<pg8::EpiStoreBf16, pg8::StaticOrder, true, true>(lds, g2, S2, E2); }
        }
        SEAM(pb + 1);
        PB_END(102); PB_BEGIN(103);
#ifndef SKIP_PREP
        if (IN(pb + 2)) { IDS; RPT(103) prep_phase(s, gw, NGW, lane, cols, carry, a.in[4], a.in[5], a.in[7], a.in[10], a.in[11], a.in[12], rw2T, ra2T, PR, PK, PA, PB, PV, PW, bonus, ASG); }
#endif
        SEAM(pb + 2);
        PB_END(103); PB_BEGIN(104);
        if (IN(pb + 3)) { IDS;
            RPT(104) { split_scan(s, bid, G, tid, lane, wave, lds, PA, PW, PB, PK, PR, PV, cols, lbv, oraw, hgo, rwst, hgst, LASTREP); __syncthreads(); }
            if (G != 256 || bid < 128) { pg8::Gemm g{ASG, g2Tp, MS, 1024, 256}; pg8::StaticOrder S; if (G == 256) S.init(MS, 1024, 128, bid); else S.init(MS, 1024, G, bid); pg8::EpiStoreBf16 E{GATE, 1024};
              pg8::gemm_phase<pg8::EpiStoreBf16, pg8::StaticOrder, true, true>(lds, g, S, E); }
        }
        SEAM(pb + 3);
        PB_END(104); PB_BEGIN(106);
        if (IN(pb + 4)) { IDS;
#ifdef MK_NOMIX
            for (int i = gtid; i < MS * 128; i += NGT) { const int lt = i >> 7, b = lt / TS, tl = lt % TS; const size_t gt = (size_t)b * SEQ + s * TS + tl; ((u32x4*)(merged + gt * 1024))[i & 127] = (u32x4){0u, 0u, 0u, 0u}; }
#endif
#ifndef SKIP_POST
            RPT(106) post_phase(s, gw, NGW, lane, cols, carry, a.in[4], GATE, a.in[13], a.in[14], a.in[16], oraw, hgo, PV, bonus, merged);
#endif
            if (s + 1 < NSPLIT) for (int lt = gw; lt < MS; lt += NGW) { const int b = lt / TS, tl = lt % TS; const size_t gt = (size_t)b * SEQ + (s + 1) * TS + tl; rms_row_bf16(XIN + gt * 1024, a.in[2], u1 + (size_t)lt * 1024, lane); }
            if (bid < 4 && s + 1 < NSPLIT) { const u32x4* src = (const u32x4*)(cols + (size_t)(bid * TS + TS - 1) * CL); u32x4* dst = (u32x4*)(carry + (((s + 1) & 1) * 4 + bid) * CARRY_LD);
                for (int i = tid; i < CARRY_LD / 8; i += 512) dst[i] = src[i]; }
        }
        SEAM(pb + 4);
        PB_END(106);
    }

    PB_BEGIN(110);
    if (IN(T0 + 0)) { const auto& a = *args_fresh();
        { pg8::Gemm g{merged, WoutT, NTOK, 1024, 1024}; pg8::StaticOrder S; S.init(NTOK, 1024, G, bid); pg8::EpiResNorm E{XIN, OUTP, U, a.in[18], SS1, 1024, NTOK};
          pg8::gemm_phase<pg8::EpiResNorm, pg8::StaticOrder, false, true>(lds, g, S, E); }
    }
    SEAM(T0 + 0);
    PB_END(110); PB_BEGIN(111);
    if (IN(T0 + 2)) { IDS;
#pragma unroll 4
        for (int i = gtid; i < 4 * 4 * 256 * 256; i += NGT) { const int kp = i & 255, dim = (i >> 8) & 255, hd = (i >> 16) & 3, b = i >> 18;
            const int k2 = kp >> 5, fq = (kp >> 3) & 3, sl = kp & 7; const int key = 32 * k2 + (sl < 4 ? 4 * fq + sl : 16 + 4 * fq + sl - 4);
            Vt[i] = KV[(size_t)(b * 256 + key) * 2048 + 1024 + hd * 256 + dim]; }
        for (int i = gtid; i < 4 * 4 * 256 * 32; i += NGT) { const int c8 = i & 31, key = (i >> 5) & 255, hd = (i >> 13) & 3, b = i >> 15;
            ((u32x4*)KH)[i] = *(const u32x4*)(KV + (size_t)(b * 256 + key) * 2048 + hd * 256 + c8 * 8); }
        for (int i = gw; i < 64; i += NGW) {
            const int bh = i >> 2, kb = i & 3, b = bh >> 2, hd = bh & 3; const bf16_t* kr = KV + (size_t)(b * 256 + kb * 64 + lane) * 2048 + hd * 256; float ss = 0.f;
#pragma unroll 4
            for (int c = 0; c < 32; ++c) { float t[8]; ld8bf(kr + c * 8, t);
#pragma unroll
                for (int e = 0; e < 8; ++e) ss += t[e] * t[e]; }
#pragma unroll
            for (int o = 1; o < 64; o <<= 1) ss = fmaxf(ss, __shfl_xor(ss, o));
            if (lane == 0) KMAX2[i * 32] = ss; }
    }
    PB_END(111); PB_BEGIN(112);
    if (IN(T0 + 2)) { const auto& a = *args_fresh(); pg8::Gemm g{U, WqT, NTOK, 1024, 1024}; pg8::StaticOrder S; S.init(NTOK, 1024, G, bid); pg8::EpiStoreBf16Rs E{Qb, 1024, SS1, NTOK};
        RPT(112) pg8::gemm_phase<pg8::EpiStoreBf16Rs, pg8::StaticOrder, true, true>(lds, g, S, E); }
    SEAM(T0 + 2);
    PB_END(112); PB_BEGIN(113);
#ifndef SKIP_ATTN
    if (IN(T0 + 3)) { IDS; RPT(113) attn_phase(gw, NGW, lane, Qb, KH, Vt, AO, KMAX2); }
#endif
    SEAM(T0 + 3);
    PB_END(113); PB_BEGIN(114);
#ifndef MK_NOATT
    if (IN(T0 + 4)) { const auto& a = *args_fresh(); pg8::Gemm g{AO, WoT, NTOK, 1024, 1024}; pg8::StaticOrder S; S.init(NTOK, 1024, G, bid); pg8::EpiResNorm E{OUTP, OUTP, U, a.in[24], SS2, 1024, NTOK};
        pg8::gemm_phase<pg8::EpiResNorm, pg8::StaticOrder, false, true>(lds, g, S, E); }
#endif
    SEAM(T0 + 4);
    PB_END(114); PB_BEGIN(116);
    if (IN(T0 + 6)) { const auto& a = *args_fresh(); pg8::Gemm g{U, W13T, NTOK, 2 * DFF, 1024}; pg8::StaticOrder S; S.init(NTOK, 2 * DFF, G, bid); pg8::EpiSwiGLURs E{FF, DFF, SS2, NTOK};
        RPT(116) pg8::gemm_phase<pg8::EpiSwiGLURs, pg8::StaticOrder, true, true>(lds, g, S, E); }
    SEAM(T0 + 6);
    PB_END(116); PB_BEGIN(117);
    if (IN(T0 + 7)) { const auto& a = *args_fresh(); pg8::Gemm g{FF, W2T, NTOK, 1024, DFF}; pg8::StaticOrder S; S.init(NTOK, 1024, G, bid); pg8::EpiResF32 E{OUTP, OUTP, 1024};
        pg8::gemm_phase<pg8::EpiResF32, pg8::StaticOrder, true, true>(lds, g, S, E); }
    SEAM(T0 + 7);
    PB_END(117); PB_BEGIN(118);
    if (IN(T0 + 8)) { IDS;
        const float* gf = a.in[28];
        f32x4 g4[4];
#pragma unroll
        for (int j = 0; j < 4; ++j) g4[j] = ((const f32x4*)gf)[lane + 64 * j];
        for (int g0 = gw * 8; g0 < NTOK; g0 += NGW * 8) {
            f32x4 v[8][4]; float sq[8];
#pragma unroll
            for (int r = 0; r < 8; ++r) { const f32x4* row = (const f32x4*)(OUTP + (size_t)(g0 + r) * 1024);
#pragma unroll
                for (int j = 0; j < 4; ++j) v[r][j] = row[lane + 64 * j]; }
#pragma unroll
            for (int r = 0; r < 8; ++r) { sq[r] = 0.f;
#pragma unroll
                for (int j = 0; j < 4; ++j) sq[r] += (v[r][j][0] * v[r][j][0] + v[r][j][1] * v[r][j][1]) + (v[r][j][2] * v[r][j][2] + v[r][j][3] * v[r][j][3]); }
#pragma unroll
            for (int o = 1; o < 64; o <<= 1) {
#pragma unroll
                for (int r = 0; r < 8; ++r) sq[r] += __shfl_xor(sq[r], o); }
#pragma unroll
            for (int r = 0; r < 8; ++r) { const float rs = 1.0f / sqrtf(sq[r] * (1.0f / 1024.0f) + 1e-6f); f32x4* row = (f32x4*)(OUTP + (size_t)(g0 + r) * 1024);
#pragma unroll
                for (int j = 0; j < 4; ++j) row[lane + 64 * j] = v[r][j] * rs * g4[j]; }
        }
    }
#ifdef MK_PROBE
    PB_END(118);
    if (blockIdx.x == 0) { const unsigned long long t1 = __builtin_amdgcn_s_memrealtime(); while (__builtin_amdgcn_s_memrealtime() - t1 < probe_acc) __builtin_amdgcn_s_sleep(8); }
#endif
#undef IN
#undef SEAM
}

#ifndef MK_MULTI
#define MK_MULTI 0
#endif
extern "C" void kernel_launch(void* const* d_in, const int* in_sizes, int n_in, void* d_out, int out_size, void* d_ws, size_t ws_size, hipStream_t stream) {
    static int grid = 0;
    if (grid == 0) {
        if (n_in != 29 || in_sizes[0] != NTOK * D || out_size != NTOK * D || ws_size < WS_END) { fprintf(stderr, "kernel_launch: unexpected shapes / workspace (%d inputs, ws %zu)\n", n_in, ws_size); grid = -1; return; }
        int dev = 0, cus = 0, per_cu = 0;
        hipGetDevice(&dev); hipDeviceGetAttribute(&cus, hipDeviceAttributeMultiprocessorCount, dev);
        hipFuncSetAttribute((const void*)mega, hipFuncAttributeMaxDynamicSharedMemorySize, LDS_BYTES);
        hipOccupancyMaxActiveBlocksPerMultiprocessor(&per_cu, (const void*)mega, 512, LDS_BYTES);
        (void)hipGetLastError();
        if (per_cu < 1) per_cu = 1;
        grid = cus;
    }
    if (grid < 0) return;
    Args a{};
    for (int i = 0; i < 29; ++i) a.in[i] = (const float*)d_in[i];
    a.out = (float*)d_out; a.ws = (unsigned char*)d_ws;
    (void)hipMemsetAsync((char*)d_ws + WS_CTL, 0, CTL_BYTES, stream);
    void* args[] = {&a};
#if MK_MULTI
    for (int ph = 0; ph < N_PHASES; ++ph) { a.ph_lo = ph; a.ph_hi = ph + 1; hipLaunchCooperativeKernel((const void*)mega, dim3(grid), dim3(512), args, LDS_BYTES, stream); }
#else
    a.ph_lo = 0; a.ph_hi = N_PHASES;
    hipError_t e = hipLaunchCooperativeKernel((const void*)mega, dim3(grid), dim3(512), args, LDS_BYTES, stream);
    if (e != hipSuccess) fprintf(stderr, "cooperative launch failed: %s (grid %d)\n", hipGetErrorString(e), grid);
#endif
}
```

```cpp
#include <hip/hip_runtime.h>
#include <hip/hip_cooperative_groups.h>
#include <cstdint>
#include <cstdio>
namespace cg = cooperative_groups;
namespace pg8 {
#define PG8_LAS __attribute__((address_space(3)))
typedef unsigned short bf16_t;
typedef short bf16x8 __attribute__((ext_vector_type(8)));
typedef float f32x4 __attribute__((ext_vector_type(4)));
typedef unsigned u32x4 __attribute__((ext_vector_type(4)));
constexpr int BM = 256, BK = 64, HALF = 128, HTB = HALF * BK * 2  , STAGE_BYTES = 8 * HTB, NXCD = 8, WGM = 8;

__host__ __device__ __forceinline__ int lds_byte(int r, int c) { const int st = (r >> 4) * 2 + (c >> 5), rr = r & 15, cc = c & 31, ob = rr * 64 + cc * 2; return st * 1024 + (ob ^ (((ob >> 9) & 1) << 5)); }
__host__ __device__ __forceinline__ void stage_rc(int b, int& R, int& C) { const int st = b / 1024, sb = b % 1024, swz = sb ^ (((sb >> 9) & 1) << 5); R = (st >> 1) * 16 + swz / 64; C = (st & 1) * 32 + (swz % 64) / 2; }
__host__ __device__ __forceinline__ int perm32(int rho) { const int n = rho >> 4, i = rho & 15; return 8 * (i >> 2) + 4 * n + (i & 3); }

struct Unit { int pm, pn; };
struct Gemm { const bf16_t* A; const bf16_t* Bt; int M, N, K; };

struct StaticOrder {
    int nM, nN, nwg, G, c;
    __host__ __device__ void init(int M, int N, int G_, int c_) { nM = M / BM; nN = N / BM; nwg = nM * nN; G = G_; c = c_; }
    __host__ __device__ bool next(int i, Unit& u) const {
        const long L = (long)i * G + c; if (L >= nwg) return false;
        int wgid = (int)L; { const int q = nwg / NXCD, r = nwg % NXCD, xcd = wgid % NXCD, off = wgid / NXCD; wgid = (xcd < r ? xcd * (q + 1) : r * (q + 1) + (xcd - r) * q) + off; }
        const int nig = WGM * nN, gid = wgid / nig, fm = gid * WGM, gsz = (nM - fm) < WGM ? (nM - fm) : WGM;
        u.pm = fm + ((wgid % nig) % gsz); u.pn = (wgid % nig) / gsz; return true;
    }
    __device__ __forceinline__ void a_ready(const Unit&) const {}
    __device__ __forceinline__ void done(const Unit&) const {}
};

__device__ __forceinline__ unsigned cvt_pk_bf16(float lo, float hi) { unsigned r; asm volatile("v_cvt_pk_bf16_f32 %0, %1, %2" : "=v"(r) : "v"(lo), "v"(hi)); return r; }
__device__ __forceinline__ float fast_sigmoid(float x) { return __builtin_amdgcn_rcpf(1.0f + __expf(-x)); }
__device__ __forceinline__ float fast_silu(float x) { return x * fast_sigmoid(x); }
struct EpiStoreBf16 {
    static constexpr bool PERM = true, AFTER_DRAIN = false;
    bf16_t* O; int ldc;
    __device__ __forceinline__ void operator()(const f32x4 (&acc)[2][2][4][2], const Unit& u, int wr, int wc, int fr, int fq) const {
        const int row0 = u.pm * BM + wr * 64 + fr, col0 = u.pn * BM + wc * 32 + 8 * fq;
#pragma unroll
        for (int ai = 0; ai < 2; ++ai)
#pragma unroll
            for (int m = 0; m < 4; ++m) { bf16_t* rowp = O + (size_t)(row0 + ai * HALF + m * 16) * ldc + col0;
#pragma unroll
                for (int bj = 0; bj < 2; ++bj) { const f32x4 v0 = acc[ai][bj][m][0], v1 = acc[ai][bj][m][1];
                    u32x4 w; w.x = cvt_pk_bf16(v0[0], v0[1]); w.y = cvt_pk_bf16(v0[2], v0[3]); w.z = cvt_pk_bf16(v1[0], v1[1]); w.w = cvt_pk_bf16(v1[2], v1[3]);
                    *(u32x4*)(rowp + bj * HALF) = w; } }
    }
};
struct EpiResF32 {
    static constexpr bool PERM = true, AFTER_DRAIN = false;
    const float* base; float* out; int ldc;
    __device__ __forceinline__ void operator()(const f32x4 (&acc)[2][2][4][2], const Unit& u, int wr, int wc, int fr, int fq) const {
        const int row0 = u.pm * BM + wr * 64 + fr, col0 = u.pn * BM + wc * 32 + 8 * fq;
#pragma unroll
        for (int ai = 0; ai < 2; ++ai)
#pragma unroll
            for (int m = 0; m < 4; ++m) { const size_t off = (size_t)(row0 + ai * HALF + m * 16) * ldc + col0;
#pragma unroll
                for (int bj = 0; bj < 2; ++bj)
#pragma unroll
                    for (int n = 0; n < 2; ++n) { const size_t p = off + bj * HALF + 4 * n; const f32x4 b = *(const f32x4*)(base + p); *(f32x4*)(out + p) = b + acc[ai][bj][m][n]; } }
    }
};
struct EpiSwiGLU {
    static constexpr bool PERM = true, AFTER_DRAIN = false;
    bf16_t* O; int ldc;
    __device__ __forceinline__ void operator()(const f32x4 (&acc)[2][2][4][2], const Unit& u, int wr, int wc, int fr, int fq) const {
        const int row0 = u.pm * BM + wr * 64 + fr, col0 = u.pn * HALF + wc * 32 + 8 * fq;
#pragma unroll
        for (int ai = 0; ai < 2; ++ai)
#pragma unroll
            for (int m = 0; m < 4; ++m) { bf16_t* rowp = O + (size_t)(row0 + ai * HALF + m * 16) * ldc + col0;
                f32x4 v0, v1;
#pragma unroll
                for (int j = 0; j < 4; ++j) { v0[j] = fast_silu(acc[ai][0][m][0][j]) * acc[ai][1][m][0][j]; v1[j] = fast_silu(acc[ai][0][m][1][j]) * acc[ai][1][m][1][j]; }
                u32x4 w; w.x = cvt_pk_bf16(v0[0], v0[1]); w.y = cvt_pk_bf16(v0[2], v0[3]); w.z = cvt_pk_bf16(v1[0], v1[1]); w.w = cvt_pk_bf16(v1[2], v1[3]);
                *(u32x4*)rowp = w; }
    }
};

struct EpiColsAct {
    static constexpr bool PERM = true, AFTER_DRAIN = false;
    bf16_t* O; int ldc;
    __device__ __forceinline__ void operator()(const f32x4 (&acc)[2][2][4][2], const Unit& u, int wr, int wc, int fr, int fq) const {
        const int row0 = u.pm * BM + wr * 64 + fr, col0 = u.pn * BM + wc * 32 + 8 * fq;
        const int pn = u.pn; const int act = (pn >= 14 && pn < 18) ? 1 : (pn >= 18 && pn < 22) ? 2 : (pn >= 26 && pn < 30) ? 1 : (pn >= 30) ? 2 : 0;
#pragma unroll
        for (int ai = 0; ai < 2; ++ai)
#pragma unroll
            for (int m = 0; m < 4; ++m) { bf16_t* rowp = O + (size_t)(row0 + ai * HALF + m * 16) * ldc + col0;
#pragma unroll
                for (int bj = 0; bj < 2; ++bj) { f32x4 v0 = acc[ai][bj][m][0], v1 = acc[ai][bj][m][1];
                    if (act == 1) {
#pragma unroll
                        for (int j = 0; j < 4; ++j) { v0[j] = fast_silu(v0[j]); v1[j] = fast_silu(v1[j]); } }
                    else if (act == 2) {
#pragma unroll
                        for (int j = 0; j < 4; ++j) { v0[j] = fast_sigmoid(v0[j]); v1[j] = fast_sigmoid(v1[j]); } }
                    u32x4 w; w.x = cvt_pk_bf16(v0[0], v0[1]); w.y = cvt_pk_bf16(v0[2], v0[3]); w.z = cvt_pk_bf16(v1[0], v1[1]); w.w = cvt_pk_bf16(v1[2], v1[3]);
                    *(u32x4*)(rowp + bj * HALF) = w; } }
    }
};

struct EpiResNorm {
    static constexpr bool PERM = true, AFTER_DRAIN = false;
    const float* base; float* out; bf16_t* hb; const float* gain; float* ss; int ldc, nrows;
    __device__ __forceinline__ void operator()(const f32x4 (&acc)[2][2][4][2], const Unit& u, int wr, int wc, int fr, int fq) const {
        const int row0 = u.pm * BM + wr * 64 + fr, col0 = u.pn * BM + wc * 32 + 8 * fq;
        f32x4 gv[2][2];
#pragma unroll
        for (int bj = 0; bj < 2; ++bj)
#pragma unroll
            for (int n = 0; n < 2; ++n) gv[bj][n] = *(const f32x4*)(gain + col0 + bj * HALF + 4 * n);
#pragma unroll
        for (int ai = 0; ai < 2; ++ai)
#pragma unroll
            for (int m = 0; m < 4; ++m) { const int row = row0 + ai * HALF + m * 16; const size_t off = (size_t)row * ldc + col0; float sq = 0.f;
#pragma unroll
                for (int bj = 0; bj < 2; ++bj) { f32x4 v[2];
#pragma unroll
                    for (int n = 0; n < 2; ++n) { const size_t p = off + bj * HALF + 4 * n; v[n] = *(const f32x4*)(base + p) + acc[ai][bj][m][n]; *(f32x4*)(out + p) = v[n];
                        sq += (v[n][0] * v[n][0] + v[n][1] * v[n][1]) + (v[n][2] * v[n][2] + v[n][3] * v[n][3]); }
                    const f32x4 h0 = v[0] * gv[bj][0], h1 = v[1] * gv[bj][1];
                    u32x4 w; w.x = cvt_pk_bf16(h0[0], h0[1]); w.y = cvt_pk_bf16(h0[2], h0[3]); w.z = cvt_pk_bf16(h1[0], h1[1]); w.w = cvt_pk_bf16(h1[2], h1[3]);
                    *(u32x4*)(hb + off + bj * HALF) = w; }
                sq += __shfl_xor(sq, 16); sq += __shfl_xor(sq, 32);
                if (fq == 0) ss[((size_t)u.pn * nrows + row) * 4 + wc] = sq; }
    }
};
__device__ __forceinline__ float row_rs(const float* ss, int nrows, int row) {
    float s = 0.f;
#pragma unroll
    for (int pn = 0; pn < 4; ++pn) { const f32x4 t = *(const f32x4*)(ss + ((size_t)pn * nrows + row) * 4); s += (t[0] + t[1]) + (t[2] + t[3]); }
    return 1.0f / sqrtf(s * (1.0f / 1024.0f) + 1e-6f);
}
struct EpiStoreBf16Rs {
    static constexpr bool PERM = true, AFTER_DRAIN = false;
    bf16_t* O; int ldc; const float* ss; int nrows;
    __device__ __forceinline__ void operator()(const f32x4 (&acc)[2][2][4][2], const Unit& u, int wr, int wc, int fr, int fq) const {
        const int row0 = u.pm * BM + wr * 64 + fr, col0 = u.pn * BM + wc * 32 + 8 * fq;
        float rsv[2][4];
#pragma unroll
        for (int ai = 0; ai < 2; ++ai)
#pragma unroll
            for (int m = 0; m < 4; ++m) rsv[ai][m] = row_rs(ss, nrows, row0 + ai * HALF + m * 16);
#pragma unroll
        for (int ai = 0; ai < 2; ++ai)
#pragma unroll
            for (int m = 0; m < 4; ++m) { const int row = row0 + ai * HALF + m * 16; const float rs = rsv[ai][m]; bf16_t* rowp = O + (size_t)row * ldc + col0;
#pragma unroll
                for (int bj = 0; bj < 2; ++bj) { const f32x4 v0 = acc[ai][bj][m][0] * rs, v1 = acc[ai][bj][m][1] * rs;
                    u32x4 w; w.x = cvt_pk_bf16(v0[0], v0[1]); w.y = cvt_pk_bf16(v0[2], v0[3]); w.z = cvt_pk_bf16(v1[0], v1[1]); w.w = cvt_pk_bf16(v1[2], v1[3]);
                    *(u32x4*)(rowp + bj * HALF) = w; } }
    }
};
struct EpiSwiGLURs {
    static constexpr bool PERM = true, AFTER_DRAIN = false;
    bf16_t* O; int ldc; const float* ss; int nrows;
    __device__ __forceinline__ void operator()(const f32x4 (&acc)[2][2][4][2], const Unit& u, int wr, int wc, int fr, int fq) const {
        const int row0 = u.pm * BM + wr * 64 + fr, col0 = u.pn * HALF + wc * 32 + 8 * fq;
        float rsv[2][4];
#pragma unroll
        for (int ai = 0; ai < 2; ++ai)
#pragma unroll
            for (int m = 0; m < 4; ++m) rsv[ai][m] = row_rs(ss, nrows, row0 + ai * HALF + m * 16);
#pragma unroll
        for (int ai = 0; ai < 2; ++ai)
#pragma unroll
            for (int m = 0; m < 4; ++m) { const int row = row0 + ai * HALF + m * 16; const float rs = rsv[ai][m]; bf16_t* rowp = O + (size_t)row * ldc + col0;
                f32x4 v0, v1;
#pragma unroll
                for (int j = 0; j < 4; ++j) { v0[j] = fast_silu(acc[ai][0][m][0][j] * rs) * (acc[ai][1][m][0][j] * rs); v1[j] = fast_silu(acc[ai][0][m][1][j] * rs) * (acc[ai][1][m][1][j] * rs); }
                u32x4 w; w.x = cvt_pk_bf16(v0[0], v0[1]); w.y = cvt_pk_bf16(v0[2], v0[3]); w.z = cvt_pk_bf16(v1[0], v1[1]); w.w = cvt_pk_bf16(v1[2], v1[3]);
                *(u32x4*)rowp = w; }
    }
};
template <class Epi, class Sched, bool ALIGN_EPI = false, bool SP2 = false>
__device__ __forceinline__ void gemm_phase(PG8_LAS unsigned char* lds, const Gemm g, const Sched& S, const Epi& E) {
    int tid = threadIdx.x; asm volatile("" : "+v"(tid));
    const int wid = __builtin_amdgcn_readfirstlane(tid >> 6), lane = tid & 63, wr = wid >> 2, wc = wid & 3, fr = lane & 15, fq = lane >> 4;
    const int K = g.K, nt = K / BK;
    unsigned voffA[2], voffB[2];
#pragma unroll
    for (int i = 0; i < 2; ++i) { int R, C; stage_rc(tid * 16 + i * 8192, R, C); const int Rb = Epi::PERM ? ((R & ~31) + perm32(R & 31)) : R;
        voffA[i] = (unsigned)(R * K + C) * 2u; voffB[i] = (unsigned)(Rb * K + C) * 2u; }
    const size_t kstep = (size_t)(BK * 2);
    const size_t hstep = (size_t)HALF * K * 2;
    const size_t tstep = 2 * hstep;
    const unsigned ldsw = (unsigned)wid * 1024u;
    const int aoff = lds_byte(wr * 64 + fr, fq * 8), boff = lds_byte(wc * 32 + fr, fq * 8);
#define PG8_SA(b, h) (((b) * 2 + (h)) * HTB)
#define PG8_SB(b, h) ((4 + (b) * 2 + (h)) * HTB)
#define PG8_STAGE(bufoff, gbase, voff) do { _Pragma("unroll") for (int _i = 0; _i < 2; ++_i) \
        __builtin_amdgcn_global_load_lds((const unsigned*)((const char*)(gbase) + (voff)[_i]), (PG8_LAS unsigned*)(lds + (bufoff) + ldsw + _i * 8192), 16, 0, 0); } while (0)
#define PG8_LDA(dst, b, h) do { _Pragma("unroll") for (int m = 0; m < 4; ++m) _Pragma("unroll") for (int k = 0; k < 2; ++k) dst[m][k] = *(const PG8_LAS bf16x8*)(lds + PG8_SA(b, h) + aoff + m * 2048 + k * 1024); } while (0)
#define PG8_LDB(dst, b, h) do { _Pragma("unroll") for (int n = 0; n < 2; ++n) _Pragma("unroll") for (int k = 0; k < 2; ++k) dst[n][k] = *(const PG8_LAS bf16x8*)(lds + PG8_SB(b, h) + boff + n * 2048 + k * 1024); } while (0)
#define PG8_MMA(ai, bj, At, Bt) do { __builtin_amdgcn_s_setprio(1); _Pragma("unroll") for (int m = 0; m < 4; ++m) _Pragma("unroll") for (int n = 0; n < 2; ++n) _Pragma("unroll") for (int k = 0; k < 2; ++k) \
        acc[ai][bj][m][n] = __builtin_amdgcn_mfma_f32_16x16x32_bf16(Bt[n][k], At[m][k], acc[ai][bj][m][n], 0, 0, 0); __builtin_amdgcn_s_setprio(0); } while (0)
#define PG8_WAIT_V(n) asm volatile("s_waitcnt vmcnt(" #n ")" ::: "memory")
#define PG8_WAIT_L(n) asm volatile("s_waitcnt lgkmcnt(" #n ")" ::: "memory")
#define PG8_BAR __builtin_amdgcn_s_barrier()
#define PG8_SCHED __builtin_amdgcn_sched_barrier(0)
    Unit cur, nxt; int ui = 0;
    if (!S.next(0, cur)) return;
    f32x4 acc[2][2][4][2];
#pragma unroll
    for (int a = 0; a < 2; ++a)
#pragma unroll
        for (int b = 0; b < 2; ++b)
#pragma unroll
            for (int m = 0; m < 4; ++m)
#pragma unroll
                for (int n = 0; n < 2; ++n) acc[a][b][m][n] = (f32x4){0.f, 0.f, 0.f, 0.f};
    bf16x8 At[4][2], B0[2][2], B1[2][2];
    const char* cA = (const char*)g.A + (size_t)cur.pm * tstep; const char* cB = (const char*)g.Bt + (size_t)cur.pn * tstep;
    S.a_ready(cur);
    if constexpr (SP2) {
        PG8_STAGE(PG8_SB(0, 0), cB, voffB); PG8_STAGE(PG8_SB(0, 1), cB + hstep, voffB); PG8_STAGE(PG8_SA(0, 0), cA, voffA); PG8_STAGE(PG8_SA(0, 1), cA + hstep, voffA);
        if (wr == 1) PG8_BAR;
        PG8_WAIT_V(2); PG8_BAR;
        PG8_STAGE(PG8_SB(1, 0), cB + kstep, voffB); PG8_STAGE(PG8_SA(1, 0), cA + kstep, voffA); PG8_STAGE(PG8_SB(1, 1), cB + hstep + kstep, voffB);
        PG8_WAIT_V(6); PG8_BAR;
    } else {
        PG8_STAGE(PG8_SB(0, 0), cB, voffB); PG8_STAGE(PG8_SA(0, 0), cA, voffA); PG8_STAGE(PG8_SB(0, 1), cB + hstep, voffB); PG8_STAGE(PG8_SA(0, 1), cA + hstep, voffA);
        if (wr == 1) PG8_BAR;
        PG8_WAIT_V(4); PG8_BAR;
        PG8_STAGE(PG8_SB(1, 0), cB + kstep, voffB); PG8_STAGE(PG8_SA(1, 0), cA + kstep, voffA); PG8_STAGE(PG8_SB(1, 1), cB + hstep + kstep, voffB);
        PG8_WAIT_V(6); PG8_BAR;
    }
    for (;;) {
        const bool has_next = S.next(ui + 1, nxt);
        const char* nA = has_next ? (const char*)g.A + (size_t)nxt.pm * tstep : cA; const char* nB = has_next ? (const char*)g.Bt + (size_t)nxt.pn * tstep : cB;
        for (int t = 0; t < nt; t += 2) {
            const bool last = (t == nt - 2);
            const char* a1 = cA + (size_t)(t + 1) * kstep;
            const char* a2 = last ? nA : cA + (size_t)(t + 2) * kstep; const char* b2 = last ? nB : cB + (size_t)(t + 2) * kstep;
            const char* a3 = a2 + kstep; const char* b3 = b2 + kstep;
            if (last && has_next) S.a_ready(nxt);
            if constexpr (SP2) {
            PG8_LDB(B0, 0, 0); PG8_LDB(B1, 0, 1); PG8_SCHED; PG8_LDA(At, 0, 0); PG8_STAGE(PG8_SA(1, 1), a1 + hstep, voffA);
            PG8_WAIT_V(8); PG8_WAIT_L(0); PG8_BAR; PG8_MMA(0, 0, At, B0); PG8_MMA(0, 1, At, B1); PG8_BAR; PG8_SCHED;
            PG8_LDA(At, 0, 1); PG8_STAGE(PG8_SB(0, 0), b2, voffB); PG8_STAGE(PG8_SB(0, 1), b2 + hstep, voffB); PG8_STAGE(PG8_SA(0, 0), a2, voffA);
            PG8_WAIT_V(8); PG8_WAIT_L(0); PG8_BAR; PG8_MMA(1, 0, At, B0); PG8_MMA(1, 1, At, B1); PG8_BAR; PG8_SCHED;
            PG8_LDB(B0, 1, 0); PG8_LDB(B1, 1, 1); PG8_SCHED; PG8_LDA(At, 1, 0); PG8_STAGE(PG8_SA(0, 1), a2 + hstep, voffA);
            PG8_WAIT_V(8); PG8_WAIT_L(0); PG8_BAR; PG8_MMA(0, 0, At, B0); PG8_MMA(0, 1, At, B1); PG8_BAR; PG8_SCHED;
            PG8_LDA(At, 1, 1); PG8_STAGE(PG8_SB(1, 0), b3, voffB); PG8_STAGE(PG8_SB(1, 1), b3 + hstep, voffB); PG8_STAGE(PG8_SA(1, 0), a3, voffA);
            PG8_WAIT_V(8); PG8_WAIT_L(0); PG8_BAR; PG8_MMA(1, 0, At, B0); PG8_MMA(1, 1, At, B1); PG8_BAR; PG8_SCHED;
            } else {
            PG8_LDB(B0, 0, 0); PG8_SCHED; PG8_LDA(At, 0, 0); PG8_STAGE(PG8_SA(1, 1), a1 + hstep, voffA);
            PG8_WAIT_L(8); PG8_BAR; PG8_WAIT_L(0); PG8_MMA(0, 0, At, B0); PG8_BAR; PG8_SCHED;
            PG8_LDB(B1, 0, 1); PG8_STAGE(PG8_SB(0, 0), b2, voffB);
            PG8_BAR; PG8_WAIT_L(0); PG8_MMA(0, 1, At, B1); PG8_BAR;
            PG8_LDA(At, 0, 1); PG8_STAGE(PG8_SA(0, 0), a2, voffA);
            PG8_BAR; PG8_WAIT_L(0); PG8_MMA(1, 0, At, B0); PG8_BAR; PG8_SCHED;
            PG8_STAGE(PG8_SB(0, 1), b2 + hstep, voffB);
            PG8_WAIT_V(6); PG8_BAR; PG8_MMA(1, 1, At, B1); PG8_BAR;
            PG8_LDB(B0, 1, 0); PG8_SCHED; PG8_LDA(At, 1, 0); PG8_STAGE(PG8_SA(0, 1), a2 + hstep, voffA);
            PG8_WAIT_L(8); PG8_BAR; PG8_WAIT_L(0); PG8_MMA(0, 0, At, B0); PG8_BAR; PG8_SCHED;
            PG8_LDB(B1, 1, 1); PG8_STAGE(PG8_SB(1, 0), b3, voffB);
            PG8_BAR; PG8_WAIT_L(0); PG8_MMA(0, 1, At, B1); PG8_BAR;
            PG8_LDA(At, 1, 1); PG8_STAGE(PG8_SA(1, 0), a3, voffA);
            PG8_BAR; PG8_WAIT_L(0); PG8_MMA(1, 0, At, B0); PG8_BAR; PG8_SCHED;
            PG8_STAGE(PG8_SB(1, 1), b3 + hstep, voffB);
            PG8_WAIT_V(6); PG8_BAR; PG8_MMA(1, 1, At, B1); PG8_BAR;
            }
        }
        if constexpr (ALIGN_EPI) { if (wr == 0) PG8_BAR; }
        if constexpr (!Epi::AFTER_DRAIN) { E(acc, cur, wr, wc, fr, fq); S.done(cur); }
        if (!has_next) break;
#pragma unroll
        for (int a = 0; a < 2; ++a)
#pragma unroll
            for (int b = 0; b < 2; ++b)
#pragma unroll
                for (int m = 0; m < 4; ++m)
#pragma unroll
                    for (int n = 0; n < 2; ++n) acc[a][b][m][n] = (f32x4){0.f, 0.f, 0.f, 0.f};
        cur = nxt; cA = nA; cB = nB; ++ui;
        if constexpr (ALIGN_EPI) { if (wr == 1) PG8_BAR; }
    }
    PG8_WAIT_V(0);
    if constexpr (!ALIGN_EPI) { if (wr == 0) PG8_BAR; }
    PG8_BAR;
    if constexpr (Epi::AFTER_DRAIN) { E.fused(acc, cur, wr, wc, fr, fq, lds, wid, lane); S.done(cur); }
#undef PG8_SA
#undef PG8_SB
#undef PG8_STAGE
#undef PG8_LDA
#undef PG8_LDB
#undef PG8_MMA
#undef PG8_WAIT_V
#undef PG8_WAIT_L
#undef PG8_BAR
#undef PG8_SCHED
}
}

#define LAS __attribute__((address_space(3)))
typedef pg8::bf16_t bf16_t;
typedef pg8::bf16x8 bf16x8;
typedef pg8::f32x4 f32x4;
typedef pg8::u32x4 u32x4;
typedef unsigned u32x2 __attribute__((ext_vector_type(2)));
typedef float f32x2v __attribute__((ext_vector_type(2)));
using pg8::cvt_pk_bf16;
using pg8::fast_sigmoid;
using pg8::fast_silu;

constexpr int D = 1024, NB = 4, SEQ = 8192, NTOK = NB * SEQ;
#ifndef MK_NSPLIT
#define MK_NSPLIT 4
#endif
constexpr int NSPLIT = MK_NSPLIT, TS = SEQ / NSPLIT, MS = NB * TS;
constexpr int CL = 9728;
constexpr int C_R = 0, C_K = 1024, C_V = 2048, C_WLO = 3072, C_ALO = 3136, C_GLO = 3200, C_HQ = 3584, C_HF = 4608, C_HI = 5632, C_HG = 6656, C_GA = 7680, C_GB = 8704;
constexpr int CARRY_LD = 3584;
constexpr int DFF = 2816;
constexpr size_t MiB = 1u << 20, KiB = 1u << 10;
constexpr size_t WS_WIN = 0, WS_WOUT = 19 * MiB, WS_WQ = 21 * MiB, WS_WO = 23 * MiB, WS_WKV = 25 * MiB, WS_W13 = 29 * MiB, WS_W2 = 40 * MiB;
constexpr size_t WS_RW2T = 46 * MiB, WS_RA2T = 46 * MiB + 128 * KiB, WS_RG2T = 46 * MiB + 256 * KiB, WS_CARRY = 46 * MiB + 640 * KiB, WS_LB = 46 * MiB + 704 * KiB;
constexpr size_t WS_MBF = 47 * MiB, WS_KV = 49 * MiB, WS_VT = 53 * MiB, WS_RWST = 55 * MiB, WS_HGST = 56 * MiB, WS_BONUS = 58 * MiB;
constexpr size_t WS_KMAX = 58 * MiB + 768 * KiB;
constexpr size_t WS_G2TP = 59 * MiB;
constexpr size_t WS_SS1 = 60 * MiB, WS_SS2 = 62 * MiB;
constexpr size_t WS_MERGED = 64 * MiB;
constexpr size_t WS_U1 = 128 * MiB, WS_COLS = 144 * MiB, WS_PR = 296 * MiB, WS_PK = 312 * MiB, WS_PA = 328 * MiB, WS_PB = 344 * MiB, WS_PV = 360 * MiB, WS_PW = 376 * MiB, WS_ORAW = 408 * MiB, WS_HGO = 440 * MiB;
constexpr size_t WS_GATE = 472 * MiB, WS_ASG = 488 * MiB;
constexpr size_t WS_KH = 472 * MiB;
constexpr size_t WS_U = 128 * MiB, WS_Q = 192 * MiB, WS_AO = 256 * MiB, WS_FF = 320 * MiB, WS_CTL = 496 * MiB, CTL_BYTES = 64 * KiB, WS_END = 496 * MiB + 64 * KiB;
constexpr int LDS_BYTES = 147456, MISC_OFF = 131072 + 320;
constexpr int T0 = 1 + 5 * NSPLIT, N_PHASES = T0 + 9;

__device__ __forceinline__ float bflo(unsigned u) { return __uint_as_float(u << 16); }
__device__ __forceinline__ float bfhi(unsigned u) { return __uint_as_float(u & 0xffff0000u); }
__device__ __forceinline__ unsigned f2bf(float f) { unsigned u = __float_as_uint(f); return (u + 0x7fffu + ((u >> 16) & 1u)) >> 16; }
__device__ __forceinline__ f32x4 ld4bf(const bf16_t* p) { const u32x2 u = *(const u32x2*)p; return (f32x4){bflo(u.x), bfhi(u.x), bflo(u.y), bfhi(u.y)}; }
__device__ __forceinline__ f32x4 up4(u32x2 u) { return (f32x4){bflo(u.x), bfhi(u.x), bflo(u.y), bfhi(u.y)}; }
__device__ __forceinline__ void ld8bf(const bf16_t* p, float (&o)[8]) { const u32x4 u = *(const u32x4*)p; o[0] = bflo(u.x); o[1] = bfhi(u.x); o[2] = bflo(u.y); o[3] = bfhi(u.y); o[4] = bflo(u.z); o[5] = bfhi(u.z); o[6] = bflo(u.w); o[7] = bfhi(u.w); }
__device__ __forceinline__ void st4bf(bf16_t* p, f32x4 v) { u32x2 w; w.x = cvt_pk_bf16(v[0], v[1]); w.y = cvt_pk_bf16(v[2], v[3]); *(u32x2*)p = w; }
__device__ __forceinline__ bf16x8 pack8(const float (&t)[8]) { u32x4 w; w.x = cvt_pk_bf16(t[0], t[1]); w.y = cvt_pk_bf16(t[2], t[3]); w.z = cvt_pk_bf16(t[4], t[5]); w.w = cvt_pk_bf16(t[6], t[7]); return __builtin_bit_cast(bf16x8, w); }
__device__ __forceinline__ float tanh_fast(float x) { return 1.0f - 2.0f * __builtin_amdgcn_rcpf(1.0f + __expf(2.0f * x)); }
__device__ __forceinline__ float wave_sum(float v) {
#pragma unroll
    for (int o = 1; o < 64; o <<= 1) v += __shfl_xor(v, o);
    return v;
}
__device__ __forceinline__ float fq_sum(float v) { v += __shfl_xor(v, 16); v += __shfl_xor(v, 32); return v; }
template <int CTRL> __device__ __forceinline__ float dpp_add(float x) { return x + __builtin_bit_cast(float, __builtin_amdgcn_update_dpp(0, __builtin_bit_cast(int, x), CTRL, 0xf, 0xf, false)); }
#ifdef MK_SHFL_REDUCE
__device__ __forceinline__ float allreduce16(float x) { x += __shfl_xor(x, 1); x += __shfl_xor(x, 2); x += __shfl_xor(x, 4); x += __shfl_xor(x, 8); return x; }
#else
__device__ __forceinline__ float allreduce16(float x) { x = dpp_add<0xB1>(x); x = dpp_add<0x4E>(x); x = dpp_add<0x141>(x); x = dpp_add<0x140>(x); return x; }
#endif
__device__ __forceinline__ void allreduce16x2(float& x, float& y) {
    x = dpp_add<0xB1>(x); y = dpp_add<0xB1>(y); x = dpp_add<0x4E>(x); y = dpp_add<0x4E>(y); x = dpp_add<0x141>(x); y = dpp_add<0x141>(y); x = dpp_add<0x140>(x); y = dpp_add<0x140>(y); }
#define MFMA16(a, b, c) __builtin_amdgcn_mfma_f32_16x16x32_bf16((a), (b), (c), 0, 0, 0)

#define XB_TMO      128
#define XB_XCNT(j)  (256  + 64 * (j))
#define XB_XSUB(j)  (1280 + 64 * (j))
#define XB_XGEN(j)  (2304 + 64 * (j))
#define XB_TOP      3328
#define XB_TOPGEN   3392
#define XCD_BAR_WORDS 3456
#define XB_SPIN_CAP (1u << 18)

__device__ __forceinline__ unsigned xb_ld(unsigned* p)              { return __hip_atomic_load(p, __ATOMIC_RELAXED, __HIP_MEMORY_SCOPE_AGENT); }
__device__ __forceinline__ unsigned xb_add(unsigned* p, unsigned v) { return __hip_atomic_fetch_add(p, v, __ATOMIC_RELAXED, __HIP_MEMORY_SCOPE_AGENT); }
__device__ __forceinline__ unsigned xb_xcc_id() { return (unsigned)__builtin_amdgcn_s_getreg((3 << 11) | 20) & 0xFu; }
#define XB_SPIN(cond, bar) do { unsigned _sp = 0; while (cond) { __builtin_amdgcn_s_sleep(1); \
    if ((++_sp & 255u) == 0u) { if (xb_ld(&(bar)[XB_TMO])) break; if (_sp > XB_SPIN_CAP) { atomicAdd(&(bar)[XB_TMO], 1u); break; } } } } while (0)

struct XcdBarrier {
    unsigned* bar; unsigned x;
    volatile LAS unsigned* st;
};

__device__ __forceinline__ XcdBarrier xcd_barrier_post(unsigned* bar, volatile LAS unsigned* st) {
    XcdBarrier b; b.bar = bar; b.x = xb_xcc_id(); b.st = st;
    if (threadIdx.x == 0) (void)xb_add(&bar[XB_XCNT(b.x)], 1u);
    return b;
}
__device__ __forceinline__ void xcd_barrier_complete(unsigned* bar, unsigned x, unsigned& nloc, unsigned& nx) {
    const unsigned G = gridDim.x * gridDim.y * gridDim.z;
    unsigned sum, cnt, mine, sp = 0u;
    for (;;) {
        sum = 0u; cnt = 0u; mine = 0u;
#pragma unroll
        for (unsigned j = 0; j < 16; ++j) { const unsigned c = xb_ld(&bar[XB_XCNT(j)]); sum += c; cnt += (c > 0u) ? 1u : 0u; mine = (j == x) ? c : mine; }
        if (sum == G) break;
        __builtin_amdgcn_s_sleep(1);
        if ((++sp & 255u) == 0u) { if (xb_ld(&bar[XB_TMO])) break; if (sp > XB_SPIN_CAP) { atomicAdd(&bar[XB_TMO], 1u); break; } }
    }
    nloc = mine > 0u ? mine : 1u; nx = cnt > 0u ? cnt : 1u;
}

__device__ __forceinline__ void xcd_barrier(const XcdBarrier& b) {
    asm volatile("s_waitcnt vmcnt(0)" ::: "memory");
    __syncthreads();
    if (threadIdx.x == 0) {
        unsigned* bar = b.bar;
        __builtin_amdgcn_s_waitcnt(0);
        unsigned nloc = b.st[0], nx = b.st[1];
        if (nloc == 0u) { xcd_barrier_complete(bar, b.x, nloc, nx); b.st[0] = nloc; b.st[1] = nx; }
        const unsigned old = xb_add(&bar[XB_XSUB(b.x)], 1u);
        const unsigned gen = old / nloc;
        if (old + 1u == (gen + 1u) * nloc) {
            __builtin_amdgcn_fence(__ATOMIC_RELEASE, "agent");
            asm volatile("s_waitcnt vmcnt(0)" ::: "memory");
            const unsigned og = xb_add(&bar[XB_TOP], 1u);
            const unsigned tg = og / nx;
            if (og + 1u == (tg + 1u) * nx) xb_add(&bar[XB_TOPGEN], 1u);
            else XB_SPIN(xb_ld(&bar[XB_TOPGEN]) == tg, bar);
            __builtin_amdgcn_fence(__ATOMIC_ACQUIRE, "agent");
            xb_add(&bar[XB_XGEN(b.x)], 1u);
            asm volatile("s_waitcnt vmcnt(0)" ::: "memory");
        } else {
            XB_SPIN(xb_ld(&bar[XB_XGEN(b.x)]) == gen, bar);
            __builtin_amdgcn_fence(__ATOMIC_ACQUIRE, "agent");
            asm volatile("s_waitcnt vmcnt(0)" ::: "memory");
        }
    }
    __syncthreads();
}

__device__ __forceinline__ void rms_row_bf16(const float* src, const float* g, bf16_t* dst, int lane) {
    f32x4 v[4]; float s = 0.f;
#pragma unroll
    for (int j = 0; j < 4; ++j) { v[j] = ((const f32x4*)src)[lane + 64 * j]; s += (v[j][0] * v[j][0] + v[j][1] * v[j][1]) + (v[j][2] * v[j][2] + v[j][3] * v[j][3]); }
    const float rs = 1.0f / sqrtf(wave_sum(s) * (1.0f / 1024.0f) + 1e-6f);
#pragma unroll
    for (int j = 0; j < 4; ++j) { const f32x4 gv = ((const f32x4*)g)[lane + 64 * j]; st4bf(dst + 4 * (lane + 64 * j), v[j] * rs * gv); }
}
__device__ __forceinline__ void tr_item(const float* W, int K, int N, bf16_t* WT, int kb, int n0, int row_base, LAS float* scr, int lane) {
    const int k0 = 64 * kb;
#pragma unroll 8
    for (int i = 0; i < 32; ++i) { const int kk = 2 * i + (lane >> 5); scr[kk * 33 + (lane & 31)] = W[(size_t)(k0 + kk) * N + n0 + (lane & 31)]; }
    asm volatile("s_waitcnt lgkmcnt(0)" ::: "memory");
    const int c = lane & 7;
#pragma unroll
    for (int j = 0; j < 4; ++j) { const int n = (lane >> 3) + 8 * j; const LAS float* sp = scr + (8 * c) * 33 + n;
        u32x4 o; o.x = cvt_pk_bf16(sp[0 * 33], sp[1 * 33]); o.y = cvt_pk_bf16(sp[2 * 33], sp[3 * 33]); o.z = cvt_pk_bf16(sp[4 * 33], sp[5 * 33]); o.w = cvt_pk_bf16(sp[6 * 33], sp[7 * 33]);
        *(u32x4*)(WT + (size_t)(row_base + n) * K + k0 + 8 * c) = o; }
    asm volatile("s_waitcnt lgkmcnt(0)" ::: "memory");
}

__device__ __forceinline__ void prep_phase(int s, int gw, int NGW, int lane, const bf16_t* cols, const bf16_t* carry,
        const float* mu, const float* w0, const float* a0, const float* k_k, const float* k_a, const float* r_k,
        const bf16_t* w2T, const bf16_t* a2T, bf16_t* PR, bf16_t* PK, bf16_t* PA, bf16_t* PB, bf16_t* PV, float* PW, float* bonus, bf16_t* ASG) {
    const int fr = lane & 15, fq = lane >> 4;
    for (int item = gw; item < (MS / 16) * 4; item += NGW) {
        const int tile = item >> 2, hg4 = item & 3;
        const int lt = tile * 16 + fr, b = lt / TS, tl = lt % TS;
        const bf16_t* crow = cols + (size_t)lt * CL;
        const bf16_t* prow = tl > 0 ? crow - CL : carry + ((s & 1) * 4 + b) * CARRY_LD;
        bf16x8 Aw[2], Aa[2];
#pragma unroll
        for (int ks = 0; ks < 2; ++ks) {
            { const int c = C_WLO + ks * 32 + fq * 8; float cur[8], prv[8], t[8]; ld8bf(crow + c, cur); ld8bf(prow + c, prv);
              const f32x4 m0 = *(const f32x4*)(mu + c), m1 = *(const f32x4*)(mu + c + 4);
#pragma unroll
              for (int e = 0; e < 8; ++e) { const float mm = e < 4 ? m0[e & 3] : m1[e & 3]; t[e] = tanh_fast(cur[e] + mm * (prv[e] - cur[e])); }
              Aw[ks] = pack8(t); }
            { const int c = C_ALO + ks * 32 + fq * 8; float cur[8], prv[8], t[8]; ld8bf(crow + c, cur); ld8bf(prow + c, prv);
              const f32x4 m0 = *(const f32x4*)(mu + c), m1 = *(const f32x4*)(mu + c + 4);
#pragma unroll
              for (int e = 0; e < 8; ++e) { const float mm = e < 4 ? m0[e & 3] : m1[e & 3]; t[e] = cur[e] + mm * (prv[e] - cur[e]); }
              Aa[ks] = pack8(t); }
        }
#pragma unroll 1
        for (int pass = 0; pass < 2; ++pass) {
            const int ks = hg4 + 4 * pass;
            if (ks < 5) { const int c = C_GLO + ks * 32 + fq * 8; float cur[8], prv[8], t[8]; ld8bf(crow + c, cur); ld8bf(prow + c, prv);
                const f32x4 m0 = *(const f32x4*)(mu + c), m1 = *(const f32x4*)(mu + c + 4);
#pragma unroll
                for (int e = 0; e < 8; ++e) { const float mm = e < 4 ? m0[e & 3] : m1[e & 3]; t[e] = fast_sigmoid(cur[e] + mm * (prv[e] - cur[e])); }
                *(bf16x8*)(ASG + (size_t)lt * 256 + ks * 32 + fq * 8) = pack8(t); }
            else *(u32x4*)(ASG + (size_t)lt * 256 + ks * 32 + fq * 8) = (u32x4){0u, 0u, 0u, 0u};
        }
#pragma unroll 1
        for (int hh = 0; hh < 4; ++hh) {
            const int h = hg4 * 4 + hh;
            f32x4 aw[4], aa[4];
#pragma unroll
            for (int nt = 0; nt < 4; ++nt) { aw[nt] = (f32x4){0.f, 0.f, 0.f, 0.f}; aa[nt] = (f32x4){0.f, 0.f, 0.f, 0.f};
                const int n = h * 64 + nt * 16 + fr;
#pragma unroll
                for (int ks = 0; ks < 2; ++ks) { const bf16x8 bw = *(const bf16x8*)(w2T + n * 64 + ks * 32 + fq * 8); aw[nt] = MFMA16(bw, Aw[ks], aw[nt]);
                    const bf16x8 ba = *(const bf16x8*)(a2T + n * 64 + ks * 32 + fq * 8); aa[nt] = MFMA16(ba, Aa[ks], aa[nt]); } }
            u32x2 raw[4][6];
#pragma unroll
            for (int nt = 0; nt < 4; ++nt) { const int c = h * 64 + nt * 16 + 4 * fq;
                raw[nt][0] = *(const u32x2*)(crow + C_R + c); raw[nt][1] = *(const u32x2*)(prow + C_R + c); raw[nt][2] = *(const u32x2*)(crow + C_K + c); raw[nt][3] = *(const u32x2*)(prow + C_K + c); raw[nt][4] = *(const u32x2*)(crow + C_V + c); raw[nt][5] = *(const u32x2*)(prow + C_V + c); }
            asm volatile("" :: "v"(raw[0][0]), "v"(raw[1][0]), "v"(raw[2][0]), "v"(raw[3][0]));
            f32x4 kkv[4], av[4]; float ssq = 0.f, bon = 0.f;
#pragma unroll
            for (int nt = 0; nt < 4; ++nt) {
                const int c = h * 64 + nt * 16 + 4 * fq; const size_t o = ((size_t)(b * 16 + h) * TS + tl) * 64 + nt * 16 + 4 * fq;
                const f32x4 rc = up4(raw[nt][0]), rp = up4(raw[nt][1]), kc = up4(raw[nt][2]), kp = up4(raw[nt][3]), vc = up4(raw[nt][4]), vp = up4(raw[nt][5]);
                const f32x4 r = rc + *(const f32x4*)(mu + C_R + c) * (rp - rc), k = kc + *(const f32x4*)(mu + C_K + c) * (kp - kc), v = vc + *(const f32x4*)(mu + C_V + c) * (vp - vc);
                const f32x4 w0v = *(const f32x4*)(w0 + c), a0v = *(const f32x4*)(a0 + c), kkp = *(const f32x4*)(k_k + c), kap = *(const f32x4*)(k_a + c), rkp = *(const f32x4*)(r_k + c);
                f32x4 wv, a, kk, kmod;
#pragma unroll
                for (int j = 0; j < 4; ++j) {
                    const float z = -(w0v[j] + aw[nt][j]);
                    const float sp = fmaxf(z, 0.f) + __logf(1.0f + __expf(-fabsf(z)));
                    wv[j] = __expf(-__expf(-sp - 0.5f));
                    a[j] = fast_sigmoid(a0v[j] + aa[nt][j]);
                    kk[j] = k[j] * kkp[j]; kmod[j] = k[j] * (1.0f + (a[j] - 1.0f) * kap[j]);
                    ssq += kk[j] * kk[j]; bon += r[j] * kmod[j] * rkp[j];
                }
                kkv[nt] = kk; av[nt] = a;
                st4bf(PR + o, r); st4bf(PK + o, kmod); st4bf(PV + o, v); *(f32x4*)(PW + o) = wv;
            }
            ssq = fq_sum(ssq); bon = fq_sum(bon);
            const float rs = 1.0f / sqrtf(fmaxf(ssq, 1e-24f));
#pragma unroll
            for (int nt = 0; nt < 4; ++nt) { const size_t o = ((size_t)(b * 16 + h) * TS + tl) * 64 + nt * 16 + 4 * fq;
                const f32x4 kn = kkv[nt] * rs; st4bf(PA + o, -kn); st4bf(PB + o, kn * av[nt]); }
            if (fq == 0) bonus[lt * 16 + h] = bon;
        }
    }
}

__device__ __forceinline__ void post_phase(int s, int gw, int NGW, int lane, const bf16_t* cols, const bf16_t* carry, const float* mu, const bf16_t* gate,
        const float* ln_w, const float* ln_b, const float* hg_g, const bf16_t* oraw, const bf16_t* hgo, const bf16_t* PV, const float* bonus, bf16_t* merged) {
    const int fr = lane & 15, fq = lane >> 4;
    for (int item = gw; item < (MS / 16) * 4; item += NGW) {
        const int tile = item >> 2, q4 = item & 3;
        const int lt = tile * 16 + fr, b = lt / TS, tl = lt % TS;
        const size_t gt = (size_t)b * SEQ + s * TS + tl;
        const bf16_t* crow = cols + (size_t)lt * CL;
        const bf16_t* prow = tl > 0 ? crow - CL : carry + ((s & 1) * 4 + b) * CARRY_LD;
#pragma unroll 1
        for (int hgh = 0; hgh < 2; ++hgh) {
            const int h8 = q4 * 2 + hgh;
            f32x4 ho[8]; float ss = 0.f;
#pragma unroll
            for (int n8 = 0; n8 < 8; ++n8) { ho[n8] = ld4bf(hgo + ((size_t)((b * 8 + h8) * 8 + n8) * TS + tl) * 16 + 4 * fq); ss += (ho[n8][0] * ho[n8][0] + ho[n8][1] * ho[n8][1]) + (ho[n8][2] * ho[n8][2] + ho[n8][3] * ho[n8][3]); }
            ss = fq_sum(ss);
            const float rsh = 1.0f / sqrtf(ss * (1.0f / 128.0f) + 1e-6f);
#pragma unroll
            for (int rwh = 0; rwh < 2; ++rwh) {
                const int h = q4 * 4 + hgh * 2 + rwh;
                f32x4 ag[4], o[4]; float sm = 0.f;
                for (int nt = 0; nt < 4; ++nt) { ag[nt] = ld4bf(gate + (size_t)lt * 1024 + h * 64 + nt * 16 + 4 * fq);
                    o[nt] = ld4bf(oraw + ((size_t)((b * 16 + h) * 4 + nt) * TS + tl) * 16 + 4 * fq); sm += (o[nt][0] + o[nt][1]) + (o[nt][2] + o[nt][3]); }
                const float mean = fq_sum(sm) * (1.0f / 64.0f); float vq = 0.f;
#pragma unroll
                for (int nt = 0; nt < 4; ++nt) { o[nt] = o[nt] - mean; vq += (o[nt][0] * o[nt][0] + o[nt][1] * o[nt][1]) + (o[nt][2] * o[nt][2] + o[nt][3] * o[nt][3]); }
                const float rstd = 1.0f / sqrtf(fq_sum(vq) * (1.0f / 64.0f) + 64e-5f);
#ifdef MK_NO_BONUS
                const float bon = 0.f;
#else
                const float bon = bonus[lt * 16 + h];
#endif
#pragma unroll
                for (int nt = 0; nt < 4; ++nt) {
                    const int c = h * 64 + nt * 16 + 4 * fq;
                    const f32x4 lw = *(const f32x4*)(ln_w + c), lb = *(const f32x4*)(ln_b + c), v = ld4bf(PV + ((size_t)(b * 16 + h) * TS + tl) * 64 + nt * 16 + 4 * fq);
                    const f32x4 ya = (o[nt] * rstd * lw + lb + v * bon) * ag[nt];
                    const f32x4 ng = *(const f32x4*)(hg_g + (c & 127)), gh = ld4bf(crow + C_HG + c), gar = ld4bf(crow + C_GA + c), gbr = ld4bf(crow + C_GB + c);
                    const f32x4 hv = ho[rwh * 4 + nt] * rsh * ng;
                    f32x4 m;
#pragma unroll
                    for (int j = 0; j < 4; ++j) {
#if defined(MK_ZERO_YA)
                        m[j] = fast_sigmoid(gbr[j]) * (hv[j] * fast_silu(gh[j]));
#elif defined(MK_ZERO_YB)
                        m[j] = fast_sigmoid(gar[j]) * ya[j];
#else
                        m[j] = gar[j] * ya[j] + gbr[j] * (hv[j] * gh[j]);
#endif
                    }
                    st4bf(merged + gt * 1024 + c, m);
                }
            }
        }
    }
}

#define SCAN_BAR_L() do { asm volatile("s_waitcnt vmcnt(0) lgkmcnt(0)" ::: "memory"); __builtin_amdgcn_s_barrier(); asm volatile("" ::: "memory"); } while (0)
#define SCAN_BAR_S() do { asm volatile("s_waitcnt lgkmcnt(0)" ::: "memory"); __builtin_amdgcn_s_barrier(); asm volatile("" ::: "memory"); } while (0)
constexpr int ST = 32;
constexpr int S_RWA = 8192, S_RWV = 40960, S_RWY = 45056, S_RWB = 61440;
constexpr int S_HGQ = 16384, S_HGI = 32768, S_HGY = 36864, S_HGB = 53248;
__device__ __forceinline__ void s_rw_load(LAS unsigned char* bp, int lt2, size_t htok0  , int hf, const bf16_t* PA, const float* PW, const bf16_t* PB, const bf16_t* PK, const bf16_t* PR, const bf16_t* PV) {
#pragma unroll
    for (int half = 0; half < 2; ++half) {
    const int tok = (lt2 >> 4) + 16 * half, c4 = (lt2 & 15) * 4; const size_t base = (htok0 + tok) * 64 + c4;
    const f32x4 va = ld4bf(PA + base), vb = ld4bf(PB + base), vk = ld4bf(PK + base), vr = ld4bf(PR + base), vw = *(const f32x4*)(PW + base);
    const unsigned rv = *(const unsigned*)(PV + (htok0 + tok) * 64 + hf * 32 + (lt2 & 15) * 2);
    const int off = (tok * 64 + c4) * 4;
    *(LAS f32x4*)(bp + off) = va; *(LAS f32x4*)(bp + S_RWA + off) = vw; *(LAS f32x4*)(bp + 2 * S_RWA + off) = vb; *(LAS f32x4*)(bp + 3 * S_RWA + off) = vk; *(LAS f32x4*)(bp + 4 * S_RWA + off) = vr;
    *(LAS f32x2v*)(bp + S_RWV + (tok * 32 + (lt2 & 15) * 2) * 4) = (f32x2v){bflo(rv), bfhi(rv)}; }
}
__device__ __forceinline__ void s_hg_load(LAS unsigned char* bp, int lt2, size_t ltok0, int h8, int q4, const bf16_t* cols, const float* lbv) {
#pragma unroll
    for (int half = 0; half < 2; ++half) {
    const int tok = (lt2 >> 4) + 16 * half, c8 = (lt2 & 15) * 8; const bf16_t* crow = cols + (ltok0 + tok) * CL;
    float q[8], f[8]; ld8bf(crow + C_HQ + h8 * 128 + c8, q); ld8bf(crow + C_HF + h8 * 128 + c8, f);
    const unsigned rv = *(const unsigned*)(crow + C_HI + h8 * 128 + q4 * 32 + (lt2 & 15) * 2);
    const f32x4 lb0 = *(const f32x4*)(lbv + h8 * 128 + c8), lb1 = *(const f32x4*)(lbv + h8 * 128 + c8 + 4);
    const int off = (tok * 128 + c8) * 4;
    *(LAS f32x4*)(bp + off) = (f32x4){lb0[0] + (1.f - lb0[0]) * f[0], lb0[1] + (1.f - lb0[1]) * f[1], lb0[2] + (1.f - lb0[2]) * f[2], lb0[3] + (1.f - lb0[3]) * f[3]};
    *(LAS f32x4*)(bp + off + 16) = (f32x4){lb1[0] + (1.f - lb1[0]) * f[4], lb1[1] + (1.f - lb1[1]) * f[5], lb1[2] + (1.f - lb1[2]) * f[6], lb1[3] + (1.f - lb1[3]) * f[7]};
    *(LAS f32x4*)(bp + S_HGQ + off) = (f32x4){q[0], q[1], q[2], q[3]}; *(LAS f32x4*)(bp + S_HGQ + off + 16) = (f32x4){q[4], q[5], q[6], q[7]};
    *(LAS f32x2v*)(bp + S_HGI + (tok * 32 + (lt2 & 15) * 2) * 4) = (f32x2v){bflo(rv), bfhi(rv)}; }
}
__device__ __forceinline__ void s_drain(const LAS unsigned char* ybase, int lt2, bf16_t* obase  ) {
#pragma unroll
    for (int half = 0; half < 2; ++half) {
    const int t = (lt2 >> 4) + 16 * half, rp = (lt2 & 15) * 2;
    const f32x4 pa = *(const LAS f32x4*)(ybase + (t * 32 + rp) * 16), pb = *(const LAS f32x4*)(ybase + (t * 32 + rp) * 16 + 16);
    *(unsigned*)(obase + (size_t)(rp >> 4) * (TS * 16) + t * 16 + (rp & 15)) = cvt_pk_bf16((pa[0] + pa[1]) + (pa[2] + pa[3]), (pb[0] + pb[1]) + (pb[2] + pb[3])); }
}
__device__ __forceinline__ float dot4(f32x4 a, f32x4 b) { return __builtin_fmaf(a[3], b[3], __builtin_fmaf(a[2], b[2], __builtin_fmaf(a[1], b[1], a[0] * b[0]))); }
__device__ __forceinline__ float dot4acc(f32x4 a, f32x4 b, float c) { return __builtin_fmaf(a[3], b[3], __builtin_fmaf(a[2], b[2], __builtin_fmaf(a[1], b[1], __builtin_fmaf(a[0], b[0], c)))); }
__device__ __forceinline__ void split_scan(int s, int bid, int G, int tid, int lane, int wave, LAS unsigned char* lds,
        const bf16_t* PA, const float* PW, const bf16_t* PB, const bf16_t* PK, const bf16_t* PR, const bf16_t* PV, const bf16_t* cols, const float* lbv,
        bf16_t* oraw, bf16_t* hgo, float* rwstate, float* hgstate, bool save) {
    constexpr int NBLK = TS / ST;
    const int rowl = lane >> 4, j = lane & 15, r0 = (wave & 3) * 8 + rowl, r1 = r0 + 4;
    for (int it = bid; it < 256; it += G) {
        if (it < 128) {
            const int xq = it & 7, yq = it >> 3; const int hid = (G == 256) ? xq * 8 + (yq >> 1) : (it >> 1); const int hf = (G == 256) ? (yq & 1) : (it & 1);
            const int b = hid >> 4, h = hid & 15;
            const size_t tok0 = (size_t)b * TS;
            float* sp0 = rwstate + ((size_t)((b * 16 + h) * 64 + hf * 32 + r0) * 64 + 4 * j); float* sp1 = sp0 + 4 * 64;
            bf16_t* og = oraw + (size_t)((b * 16 + h) * 4 + hf * 2) * TS * 16;
            f32x4 x0 = (f32x4){0.f, 0.f, 0.f, 0.f}, x1 = x0;
            if (wave < 4 && s > 0) { x0 = *(const f32x4*)sp0; x1 = *(const f32x4*)sp1; }
            if (wave >= 4) { s_rw_load(lds, tid - 256, (size_t)(b * 16 + h) * TS, hf, PA, PW, PB, PK, PR, PV); SCAN_BAR_L(); } else { __builtin_amdgcn_s_setprio(2); asm volatile("s_waitcnt vmcnt(0)" ::: "memory"); SCAN_BAR_S(); }
#pragma unroll 1
            for (int blk = 0; blk < NBLK; ++blk) {
                if (wave >= 4) {
                    if (blk > 0) s_drain(lds + ((blk - 1) & 1) * S_RWB + S_RWY, tid - 256, og + (size_t)(blk - 1) * (ST * 16));
                    if (blk + 1 < NBLK) s_rw_load(lds + ((blk + 1) & 1) * S_RWB, tid - 256, (size_t)(b * 16 + h) * TS + (blk + 1) * ST, hf, PA, PW, PB, PK, PR, PV);
                    SCAN_BAR_L();
                } else {
                    const LAS unsigned char* bp = lds + (blk & 1) * S_RWB;
                    const LAS unsigned char* p4 = bp + 16 * j; const LAS unsigned char* pv = bp + S_RWV + r0 * 4; LAS unsigned char* py = (LAS unsigned char*)bp + S_RWY + (r0 * 4 + (j >> 2)) * 4;
                    f32x4 a4 = *(const LAS f32x4*)(p4), w4 = *(const LAS f32x4*)(p4 + S_RWA), b4 = *(const LAS f32x4*)(p4 + 2 * S_RWA), k4 = *(const LAS f32x4*)(p4 + 3 * S_RWA), r4 = *(const LAS f32x4*)(p4 + 4 * S_RWA);
                    float v0 = *(const LAS float*)(pv), v1 = *(const LAS float*)(pv + 16);
                    float sa0 = dot4(x0, a4), sa1 = dot4(x1, a4);
                    allreduce16x2(sa0, sa1);
#pragma unroll
                    for (int t = 0; t < ST; ++t) {
                        f32x4 na = a4, nw = w4, nb = b4, nk = k4, nr = r4; float n0 = v0, n1 = v1;
                        if (t < ST - 1) { const int o = (t + 1) * 256; na = *(const LAS f32x4*)(p4 + o); nw = *(const LAS f32x4*)(p4 + S_RWA + o); nb = *(const LAS f32x4*)(p4 + 2 * S_RWA + o); nk = *(const LAS f32x4*)(p4 + 3 * S_RWA + o); nr = *(const LAS f32x4*)(p4 + 4 * S_RWA + o);
                            n0 = *(const LAS float*)(pv + (t + 1) * 128); n1 = *(const LAS float*)(pv + (t + 1) * 128 + 16); }
                        x0 = x0 * w4 + (b4 * sa0 + k4 * v0); x1 = x1 * w4 + (b4 * sa1 + k4 * v1);
                        float y0 = dot4(x0, r4), y1 = dot4(x1, r4);
                        float s0n = dot4(x0, na), s1n = dot4(x1, na);
                        s0n = dpp_add<0xB1>(s0n); s1n = dpp_add<0xB1>(s1n); y0 = dpp_add<0xB1>(y0); y1 = dpp_add<0xB1>(y1); s0n = dpp_add<0x4E>(s0n); s1n = dpp_add<0x4E>(s1n); y0 = dpp_add<0x4E>(y0); y1 = dpp_add<0x4E>(y1);
                        s0n = dpp_add<0x141>(s0n); s1n = dpp_add<0x141>(s1n); s0n = dpp_add<0x140>(s0n); s1n = dpp_add<0x140>(s1n);
                        *(LAS float*)(py + t * 512) = y0; *(LAS float*)(py + t * 512 + 64) = y1;
                        sa0 = s0n; sa1 = s1n; a4 = na; w4 = nw; b4 = nb; k4 = nk; r4 = nr; v0 = n0; v1 = n1;
                    }
                    SCAN_BAR_S();
                }
            }
            if (wave >= 4) s_drain(lds + ((NBLK - 1) & 1) * S_RWB + S_RWY, tid - 256, og + (size_t)(NBLK - 1) * (ST * 16));
            else { __builtin_amdgcn_s_setprio(0); if (save) { *(f32x4*)sp0 = x0; *(f32x4*)sp1 = x1; } }
        } else {
            const int i2 = it - 128, xq = i2 & 7, yq = i2 >> 3; const int gid = (G == 256) ? xq * 4 + (yq >> 2) : (i2 >> 2); const int q4 = (G == 256) ? (yq & 3) : (i2 & 3);
            const int b = gid >> 3, h8 = gid & 7;
            const size_t tok0 = (size_t)b * TS;
            float* sp0 = hgstate + ((size_t)((b * 8 + h8) * 128 + q4 * 32 + r0) * 128 + 4 * j); float* sp1 = sp0 + 4 * 128;
            bf16_t* og = hgo + (size_t)((b * 8 + h8) * 8 + q4 * 2) * TS * 16;
            f32x4 a0 = (f32x4){0.f, 0.f, 0.f, 0.f}, a1 = a0, c0 = a0, c1 = a0;
            if (wave < 4 && s > 0) { a0 = *(const f32x4*)sp0; a1 = *(const f32x4*)(sp0 + 64); c0 = *(const f32x4*)sp1; c1 = *(const f32x4*)(sp1 + 64); }
            if (wave >= 4) { s_hg_load(lds, tid - 256, tok0, h8, q4, cols, lbv); SCAN_BAR_L(); } else { __builtin_amdgcn_s_setprio(2); asm volatile("s_waitcnt vmcnt(0)" ::: "memory"); SCAN_BAR_S(); }
#pragma unroll 1
            for (int blk = 0; blk < NBLK; ++blk) {
                if (wave >= 4) {
                    if (blk > 0) s_drain(lds + ((blk - 1) & 1) * S_HGB + S_HGY, tid - 256, og + (size_t)(blk - 1) * (ST * 16));
                    if (blk + 1 < NBLK) s_hg_load(lds + ((blk + 1) & 1) * S_HGB, tid - 256, tok0 + (blk + 1) * ST, h8, q4, cols, lbv);
                    SCAN_BAR_L();
                } else {
                    const LAS unsigned char* bp = lds + (blk & 1) * S_HGB;
                    const LAS unsigned char* g4 = bp + 16 * j; const LAS unsigned char* gi = bp + S_HGI + r0 * 4; LAS unsigned char* gy = (LAS unsigned char*)bp + S_HGY + (r0 * 4 + (j >> 2)) * 4;
                    f32x4 f0 = *(const LAS f32x4*)(g4), f1 = *(const LAS f32x4*)(g4 + 256), q0 = *(const LAS f32x4*)(g4 + S_HGQ), q1 = *(const LAS f32x4*)(g4 + S_HGQ + 256);
                    float i0 = *(const LAS float*)(gi), i1 = *(const LAS float*)(gi + 16);
#pragma unroll
                    for (int t = 0; t < ST; ++t) {
                        f32x4 nf0 = f0, nf1 = f1, nq0 = q0, nq1 = q1; float ni0 = i0, ni1 = i1;
                        if (t < ST - 1) { const int o = (t + 1) * 512; nf0 = *(const LAS f32x4*)(g4 + o); nf1 = *(const LAS f32x4*)(g4 + 256 + o); nq0 = *(const LAS f32x4*)(g4 + S_HGQ + o); nq1 = *(const LAS f32x4*)(g4 + S_HGQ + 256 + o);
                            ni0 = *(const LAS float*)(gi + (t + 1) * 128); ni1 = *(const LAS float*)(gi + (t + 1) * 128 + 16); }
                        { f32x2v iA = (f32x2v){i0, i0}, iB = (f32x2v){i1, i1}; asm volatile("" : "+v"(iA), "+v"(iB));
                          const f32x4 i0v = (f32x4){iA[0], iA[1], iA[0], iA[1]}, i1v = (f32x4){iB[0], iB[1], iB[0], iB[1]};
                          a0 = (a0 - i0v) * f0 + i0v; a1 = (a1 - i0v) * f1 + i0v; c0 = (c0 - i1v) * f0 + i1v; c1 = (c1 - i1v) * f1 + i1v; }
                        float y0 = dot4acc(a1, q1, dot4(a0, q0));
                        float y1 = dot4acc(c1, q1, dot4(c0, q0));
                        y0 = dpp_add<0xB1>(y0); y1 = dpp_add<0xB1>(y1); y0 = dpp_add<0x4E>(y0); y1 = dpp_add<0x4E>(y1);
                        *(LAS float*)(gy + t * 512) = y0; *(LAS float*)(gy + t * 512 + 64) = y1;
                        f0 = nf0; f1 = nf1; q0 = nq0; q1 = nq1; i0 = ni0; i1 = ni1;
                    }
                    SCAN_BAR_S();
                }
            }
            if (wave >= 4) s_drain(lds + ((NBLK - 1) & 1) * S_HGB + S_HGY, tid - 256, og + (size_t)(NBLK - 1) * (ST * 16));
            else { __builtin_amdgcn_s_setprio(0); if (save) { *(f32x4*)sp0 = a0; *(f32x4*)(sp0 + 64) = a1; *(f32x4*)sp1 = c0; *(f32x4*)(sp1 + 64) = c1; } }
        }
    }
}

__device__ __forceinline__ void attn_phase(int gw, int NGW, int lane, const bf16_t* Q, const bf16_t* KV, const bf16_t* Vt, bf16_t* AO, const float* kmax2) {
    const int fr = lane & 15, fq = lane >> 4;
    const bool xcd_map = (NGW == 2048);
    for (int it0 = xcd_map ? 0 : gw; it0 < (xcd_map ? 2 : 4096); it0 += (xcd_map ? 1 : NGW)) {
        int item = it0;
        if (xcd_map) { const int wgi = gw >> 3, wv = gw & 7, xq = wgi & 7, yq = wgi >> 3; item = ((2 * xq + it0) << 8) | (yq * 8 + wv); }
        const int bh = item >> 8, tile = item & 255, b = bh >> 2, hd = bh & 3;
        const size_t g0 = (size_t)b * SEQ + tile * 32 + fr, g1 = g0 + 16;
        const float kmx = sqrtf(fmaxf(fmaxf(kmax2[(bh * 4 + 0) * 32], kmax2[(bh * 4 + 1) * 32]), fmaxf(kmax2[(bh * 4 + 2) * 32], kmax2[(bh * 4 + 3) * 32])));
        bf16x8 qa[8], qb[8]; float na = 0.f, nb = 0.f;
#pragma unroll
        for (int ks = 0; ks < 8; ++ks) { const u32x4 ua = *(const u32x4*)(Q + g0 * 1024 + hd * 256 + ks * 32 + fq * 8), ub = *(const u32x4*)(Q + g1 * 1024 + hd * 256 + ks * 32 + fq * 8);
            qa[ks] = __builtin_bit_cast(bf16x8, ua); qb[ks] = __builtin_bit_cast(bf16x8, ub);
#pragma unroll
            for (int e = 0; e < 4; ++e) { const float a0 = bflo(ua[e]), a1 = bfhi(ua[e]), b0 = bflo(ub[e]), b1 = bfhi(ub[e]); na += a0 * a0 + a1 * a1; nb += b0 * b0 + b1 * b1; } }
        na = fq_sum(na); nb = fq_sum(nb);
        const float ma = sqrtf(na) * kmx * 0.0625f * 1.001f, mb = sqrtf(nb) * kmx * 0.0625f * 1.001f;
        float za = 0.f, zb = 0.f;
        bf16x8 pa[8], pb[8];
        const bf16_t* kbase = KV + (size_t)((b * 4 + hd) * 256 + fr) * 256 + fq * 8;
        bf16x8 kc[8], kn[8];
#pragma unroll
        for (int i = 0; i < 4; ++i) { kc[2 * i] = *(const bf16x8*)(kbase + i * 32); kc[2 * i + 1] = *(const bf16x8*)(kbase + (size_t)16 * 256 + i * 32); }
        f32x4 e0, e1, f0, f1;
#pragma unroll
        for (int st = 0; st < 16; ++st) {
            const int k2 = st >> 1, hs = st & 1;
            if (st < 15) { const int n2 = (st + 1) >> 1, nh = (st + 1) & 1; const bf16_t* p0 = kbase + (size_t)(2 * n2) * 16 * 256 + nh * 128;
#pragma unroll
                for (int i = 0; i < 4; ++i) { kn[2 * i] = *(const bf16x8*)(p0 + i * 32); kn[2 * i + 1] = *(const bf16x8*)(p0 + (size_t)16 * 256 + i * 32); } }
            if (hs == 0) { e0 = (f32x4){0.f, 0.f, 0.f, 0.f}; e1 = e0; f0 = e0; f1 = e0; }
#pragma unroll
            for (int i = 0; i < 4; ++i) { const int ks = hs * 4 + i; e0 = MFMA16(kc[2 * i], qa[ks], e0); f0 = MFMA16(kc[2 * i], qb[ks], f0); e1 = MFMA16(kc[2 * i + 1], qa[ks], e1); f1 = MFMA16(kc[2 * i + 1], qb[ks], f1); }
            if (hs == 1) {
#pragma unroll
                for (int jj = 0; jj < 4; ++jj) { e0[jj] = __expf(e0[jj] * 0.0625f - ma); e1[jj] = __expf(e1[jj] * 0.0625f - ma); f0[jj] = __expf(f0[jj] * 0.0625f - mb); f1[jj] = __expf(f1[jj] * 0.0625f - mb);
                    za += e0[jj] + e1[jj]; zb += f0[jj] + f1[jj]; }
                u32x4 w; w.x = cvt_pk_bf16(e0[0], e0[1]); w.y = cvt_pk_bf16(e0[2], e0[3]); w.z = cvt_pk_bf16(e1[0], e1[1]); w.w = cvt_pk_bf16(e1[2], e1[3]); pa[k2] = __builtin_bit_cast(bf16x8, w);
                u32x4 x; x.x = cvt_pk_bf16(f0[0], f0[1]); x.y = cvt_pk_bf16(f0[2], f0[3]); x.z = cvt_pk_bf16(f1[0], f1[1]); x.w = cvt_pk_bf16(f1[2], f1[3]); pb[k2] = __builtin_bit_cast(bf16x8, x); }
#pragma unroll
            for (int i = 0; i < 8; ++i) kc[i] = kn[i];
        }
        za = fq_sum(za); zb = fq_sum(zb);
        const float ia = 1.0f / za, ib = 1.0f / zb;
#pragma unroll 4
        for (int dt = 0; dt < 16; ++dt) { f32x4 a0 = (f32x4){0.f, 0.f, 0.f, 0.f}, a1 = a0; const bf16_t* vp = Vt + (size_t)((b * 4 + hd) * 256 + dt * 16 + fr) * 256 + fq * 8;
#pragma unroll
            for (int k2 = 0; k2 < 8; ++k2) { const bf16x8 vf = *(const bf16x8*)(vp + k2 * 32); a0 = MFMA16(vf, pa[k2], a0); a1 = MFMA16(vf, pb[k2], a1); }
            st4bf(AO + g0 * 1024 + hd * 256 + dt * 16 + 4 * fq, a0 * ia); st4bf(AO + g1 * 1024 + hd * 256 + dt * 16 + 4 * fq, a1 * ib); }
    }
}

__device__ __forceinline__ int tid_fresh() { int t = threadIdx.x; asm volatile("" : "+v"(t)); return t; }
#define WinT ((bf16_t*)(a.ws + WS_WIN))
#define WoutT ((bf16_t*)(a.ws + WS_WOUT))
#define WqT ((bf16_t*)(a.ws + WS_WQ))
#define WoT ((bf16_t*)(a.ws + WS_WO))
#define WkvT ((bf16_t*)(a.ws + WS_WKV))
#define W13T ((bf16_t*)(a.ws + WS_W13))
#define W2T ((bf16_t*)(a.ws + WS_W2))
#define rw2T ((bf16_t*)(a.ws + WS_RW2T))
#define ra2T ((bf16_t*)(a.ws + WS_RA2T))
#define rg2T ((bf16_t*)(a.ws + WS_RG2T))
#define g2Tp ((bf16_t*)(a.ws + WS_G2TP))
#define SS1 ((float*)(a.ws + WS_SS1))
#define SS2 ((float*)(a.ws + WS_SS2))
#define KMAX2 ((float*)(a.ws + WS_KMAX))
#define KH ((bf16_t*)(a.ws + WS_KH))
#define GATE ((bf16_t*)(a.ws + WS_GATE))
#define ASG ((bf16_t*)(a.ws + WS_ASG))
#define carry ((bf16_t*)(a.ws + WS_CARRY))
#define lbv ((float*)(a.ws + WS_LB))
#define mbf ((bf16_t*)(a.ws + WS_MBF))
#define KV ((bf16_t*)(a.ws + WS_KV))
#define Vt ((bf16_t*)(a.ws + WS_VT))
#define rwst ((float*)(a.ws + WS_RWST))
#define hgst ((float*)(a.ws + WS_HGST))
#define bonus ((float*)(a.ws + WS_BONUS))
#define merged ((bf16_t*)(a.ws + WS_MERGED))
#define u1 ((bf16_t*)(a.ws + WS_U1))
#define cols ((bf16_t*)(a.ws + WS_COLS))
#define PR ((bf16_t*)(a.ws + WS_PR))
#define PK ((bf16_t*)(a.ws + WS_PK))
#define PA ((bf16_t*)(a.ws + WS_PA))
#define PB ((bf16_t*)(a.ws + WS_PB))
#define PV ((bf16_t*)(a.ws + WS_PV))
#define PW ((float*)(a.ws + WS_PW))
#define oraw ((bf16_t*)(a.ws + WS_ORAW))
#define hgo ((bf16_t*)(a.ws + WS_HGO))
#define U ((bf16_t*)(a.ws + WS_U))
#define Qb ((bf16_t*)(a.ws + WS_Q))
#define AO ((bf16_t*)(a.ws + WS_AO))
#define FF ((bf16_t*)(a.ws + WS_FF))
#define XIN (a.in[0])
#define OUTP (a.out)
struct Args { const float* in[29]; float* out; unsigned char* ws; int ph_lo, ph_hi; };

typedef const __attribute__((address_space(4))) Args* CArgsP;
__device__ __forceinline__ CArgsP args_fresh() { CArgsP p = (CArgsP)__builtin_amdgcn_kernarg_segment_ptr(); asm volatile("" : "+s"(p)); return p; }
__global__ void __launch_bounds__(512, 2) mega(Args a0) {
    extern __shared__ __attribute__((aligned(16))) unsigned char lds_raw[];
    LAS unsigned char* lds = (LAS unsigned char*)lds_raw;
    cg::grid_group grid = cg::this_grid();
    const int G = gridDim.x, bid = blockIdx.x, NGW = G * 8, NGT = G * 512;
#define IDS const auto& a = *args_fresh(); const int tid = tid_fresh(), lane = tid & 63, wave = __builtin_amdgcn_readfirstlane(tid >> 6), gw = bid * 8 + wave, gtid = bid * 512 + tid; (void)lane; (void)gw; (void)gtid
    const int lo = a0.ph_lo, hi = a0.ph_hi;
    if (lo < 0) grid.sync();
    { volatile LAS unsigned* misc = (volatile LAS unsigned*)(lds + MISC_OFF); if (threadIdx.x < 2) misc[threadIdx.x] = 0u; __syncthreads();
      if (hi - lo > 1) (void)xcd_barrier_post((unsigned*)(a0.ws + WS_CTL), misc); }
#ifndef MK_REP
#define MK_REP -1
#endif
#ifndef MK_REPN
#define MK_REPN 3
#endif
#define RPT(code) for (int rep_ = 0, nrep_ = (MK_REP == (code)) ? MK_REPN : 1; rep_ < nrep_; ++rep_)
#define LASTREP (rep_ == nrep_ - 1)
#ifdef MK_PROBE
    unsigned long long probe_acc = 0ull, probe_t0 = 0ull;
#define PB_BEGIN(code) do { if ((code) == MK_PROBE) probe_t0 = __builtin_amdgcn_s_memrealtime(); } while (0)
#define PB_END(code) do { if ((code) == MK_PROBE) probe_acc += __builtin_amdgcn_s_memrealtime() - probe_t0; } while (0)
#else
#define PB_BEGIN(code) do { } while (0)
#define PB_END(code) do { } while (0)
#endif
#define IN(k) (lo <= (k) && (k) < hi)
#define SEAM(k) do { if (IN(k) && IN((k) + 1)) RPT(120) { XcdBarrier xb_; xb_.bar = (unsigned*)(args_fresh()->ws + WS_CTL); xb_.x = xb_xcc_id(); xb_.st = (volatile LAS unsigned*)(lds + MISC_OFF); xcd_barrier(xb_); } } while (0)

    PB_BEGIN(100);
    if (IN(0)) RPT(100) { IDS;
        LAS float* scr = (LAS float*)(lds + wave * 16384);
        constexpr int I_IN = 16 * 297, I_SQ = 16 * 32, I_13 = 16 * 88, I_2 = 44 * 32;
        constexpr int NITEMS = I_IN + 5 * I_SQ + 2 * I_13 + I_2;
        for (int it = gw; it < NITEMS; it += NGW) {
            int r = it;
            if (r < I_IN) { const int kb = r / 297, n0 = (r % 297) * 32; tr_item(a.in[3], 1024, 9504, WinT, kb, n0, n0 + (n0 >= 3360 ? 224 : 0), scr, lane); continue; } r -= I_IN;
            if (r < I_SQ) { tr_item(a.in[17], 1024, 1024, WoutT, r / 32, (r % 32) * 32, (r % 32) * 32, scr, lane); continue; } r -= I_SQ;
            if (r < I_SQ) { tr_item(a.in[20], 1024, 1024, WqT, r / 32, (r % 32) * 32, (r % 32) * 32, scr, lane); continue; } r -= I_SQ;
            if (r < I_SQ) { tr_item(a.in[23], 1024, 1024, WoT, r / 32, (r % 32) * 32, (r % 32) * 32, scr, lane); continue; } r -= I_SQ;
            if (r < I_SQ) { tr_item(a.in[21], 1024, 1024, WkvT, r / 32, (r % 32) * 32, (r % 32) * 32, scr, lane); continue; } r -= I_SQ;
            if (r < I_SQ) { tr_item(a.in[22], 1024, 1024, WkvT, r / 32, (r % 32) * 32, 1024 + (r % 32) * 32, scr, lane); continue; } r -= I_SQ;
            if (r < I_13) { const int n0 = (r % 88) * 32; tr_item(a.in[25], 1024, DFF, W13T, r / 88, n0, (n0 / 128) * 256 + (n0 % 128), scr, lane); continue; } r -= I_13;
            if (r < I_13) { const int n0 = (r % 88) * 32; tr_item(a.in[26], 1024, DFF, W13T, r / 88, n0, (n0 / 128) * 256 + 128 + (n0 % 128), scr, lane); continue; } r -= I_13;
            tr_item(a.in[27], DFF, 1024, W2T, r / 32, (r % 32) * 32, (r % 32) * 32, scr, lane);
        }
        for (int i = gtid; i < 28672; i += NGT) ((u32x4*)(WinT + 3360 * 1024))[i] = (u32x4){0u, 0u, 0u, 0u};
        for (int i = gtid; i < 1792; i += NGT) ((u32x4*)carry)[i] = (u32x4){0u, 0u, 0u, 0u};
        for (int n = gw; n < 1024; n += NGW) { rw2T[n * 64 + lane] = (bf16_t)f2bf(a.in[6][lane * 1024 + n]); ra2T[n * 64 + lane] = (bf16_t)f2bf(a.in[8][lane * 1024 + n]); }
        for (int m = gw; m < 512; m += NGW) {
            for (int e = lane; e < 320; e += 64) { const int n = 2 * m + (e >= 160 ? 1 : 0), k = e >= 160 ? e - 160 : e; rg2T[n * 160 + k] = (bf16_t)f2bf(a.in[9][k * 1024 + n]); } }
        for (int n = gw; n < 1024; n += NGW) { f32x4 v;
#pragma unroll
            for (int e = 0; e < 4; ++e) { const int k = 4 * lane + e; v[e] = k < 160 ? a.in[9][k * 1024 + n] : 0.f; }
            st4bf(g2Tp + n * 256 + 4 * lane, v); }
        for (int i = gtid; i < 1024; i += NGT) lbv[i] = 1.0f / (1.0f + __expf(a.in[15][1024 + i] - a.in[15][i]));
        for (int m = gw; m < 1024; m += NGW) rms_row_bf16(a.in[1] + (size_t)m * 1024, a.in[19], mbf + (size_t)m * 1024, lane);
        for (int lt = gw; lt < MS; lt += NGW) { const int b = lt / TS, tl = lt % TS; const size_t gt = (size_t)b * SEQ + tl; rms_row_bf16(XIN + gt * 1024, a.in[2], u1 + (size_t)lt * 1024, lane); }
        __syncthreads();
    }
    SEAM(0);
    PB_END(100);

#pragma unroll 1
    for (int s = 0; s < NSPLIT; ++s) {
        const int pb = 1 + 5 * s;
        PB_BEGIN(102);
        if (IN(pb + 1)) { const auto& a = *args_fresh();
            pg8::Gemm g{u1, WinT, MS, CL, 1024}; pg8::StaticOrder S; S.init(MS, CL, G, bid);
            pg8::EpiColsAct E{cols, CL};
            RPT(102) pg8::gemm_phase<pg8::EpiColsAct, pg8::StaticOrder, true, true>(lds, g, S, E);
            if (s == 0 && (G != 256 || bid >= 224)) {
                pg8::Gemm g2{mbf, WkvT, 1024, 2048, 1024}; pg8::StaticOrder S2; if (G == 256) S2.init(1024, 2048, 32, bid - 224); else S2.init(1024, 2048, G, bid); pg8::EpiStoreBf16 E2{KV, 2048};
                pg8::gemm_phase<pg8::EpiStoreBf16, pg8::StaticOrder, true, true>(lds, g2, S2, E2); }
        }
        SEAM(pb + 1);
        PB_END(102); PB_BEGIN(103);
#ifndef SKIP_PREP
        if (IN(pb + 2)) { IDS; RPT(103) prep_phase(s, gw, NGW, lane, cols, carry, a.in[4], a.in[5], a.in[7], a.in[10], a.in[11], a.in[12], rw2T, ra2T, PR, PK, PA, PB, PV, PW, bonus, ASG); }
#endif
        SEAM(pb + 2);
        PB_END(103); PB_BEGIN(104);
        if (IN(pb + 3)) { IDS;
            RPT(104) { split_scan(s, bid, G, tid, lane, wave, lds, PA, PW, PB, PK, PR, PV, cols, lbv, oraw, hgo, rwst, hgst, LASTREP); __syncthreads(); }
            if (G != 256 || bid < 128) { pg8::Gemm g{ASG, g2Tp, MS, 1024, 256}; pg8::StaticOrder S; if (G == 256) S.init(MS, 1024, 128, bid); else S.init(MS, 1024, G, bid); pg8::EpiStoreBf16 E{GATE, 1024};
              pg8::gemm_phase<pg8::EpiStoreBf16, pg8::StaticOrder, true, true>(lds, g, S, E); }
        }
        SEAM(pb + 3);
        PB_END(104); PB_BEGIN(106);
        if (IN(pb + 4)) { IDS;
#ifdef MK_NOMIX
            for (int i = gtid; i < MS * 128; i += NGT) { const int lt = i >> 7, b = lt / TS, tl = lt % TS; const size_t gt = (size_t)b * SEQ + s * TS + tl; ((u32x4*)(merged + gt * 1024))[i & 127] = (u32x4){0u, 0u, 0u, 0u}; }
#endif
#ifndef SKIP_POST
            RPT(106) post_phase(s, gw, NGW, lane, cols, carry, a.in[4], GATE, a.in[13], a.in[14], a.in[16], oraw, hgo, PV, bonus, merged);
#endif
            if (s + 1 < NSPLIT) for (int lt = gw; lt < MS; lt += NGW) { const int b = lt / TS, tl = lt % TS; const size_t gt = (size_t)b * SEQ + (s + 1) * TS + tl; rms_row_bf16(XIN + gt * 1024, a.in[2], u1 + (size_t)lt * 1024, lane); }
            if (bid < 4 && s + 1 < NSPLIT) { const u32x4* src = (const u32x4*)(cols + (size_t)(bid * TS + TS - 1) * CL); u32x4* dst = (u32x4*)(carry + (((s + 1) & 1) * 4 + bid) * CARRY_LD);
                for (int i = tid; i < CARRY_LD / 8; i += 512) dst[i] = src[i]; }
        }
        SEAM(pb + 4);
        PB_END(106);
    }

    PB_BEGIN(110);
    if (IN(T0 + 0)) { const auto& a = *args_fresh();
        { pg8::Gemm g{merged, WoutT, NTOK, 1024, 1024}; pg8::StaticOrder S; S.init(NTOK, 1024, G, bid); pg8::EpiResNorm E{XIN, OUTP, U, a.in[18], SS1, 1024, NTOK};
          pg8::gemm_phase<pg8::EpiResNorm, pg8::StaticOrder, true, true>(lds, g, S, E); }
    }
    SEAM(T0 + 0);
    PB_END(110); PB_BEGIN(111);
    if (IN(T0 + 2)) { IDS;
        for (int i = gtid; i < 4 * 4 * 256 * 256; i += NGT) { const int kp = i & 255, dim = (i >> 8) & 255, hd = (i >> 16) & 3, b = i >> 18;
            const int k2 = kp >> 5, fq = (kp >> 3) & 3, sl = kp & 7; const int key = 32 * k2 + (sl < 4 ? 4 * fq + sl : 16 + 4 * fq + sl - 4);
            Vt[i] = KV[(size_t)(b * 256 + key) * 2048 + 1024 + hd * 256 + dim]; }
        for (int i = gtid; i < 4 * 4 * 256 * 32; i += NGT) { const int c8 = i & 31, key = (i >> 5) & 255, hd = (i >> 13) & 3, b = i >> 15;
            ((u32x4*)KH)[i] = *(const u32x4*)(KV + (size_t)(b * 256 + key) * 2048 + hd * 256 + c8 * 8); }
        for (int i = gw; i < 64; i += NGW) {
            const int bh = i >> 2, kb = i & 3, b = bh >> 2, hd = bh & 3; const bf16_t* kr = KV + (size_t)(b * 256 + kb * 64 + lane) * 2048 + hd * 256; float ss = 0.f;
#pragma unroll 4
            for (int c = 0; c < 32; ++c) { float t[8]; ld8bf(kr + c * 8, t);
#pragma unroll
                for (int e = 0; e < 8; ++e) ss += t[e] * t[e]; }
#pragma unroll
            for (int o = 1; o < 64; o <<= 1) ss = fmaxf(ss, __shfl_xor(ss, o));
            if (lane == 0) KMAX2[i * 32] = ss; }
    }
    PB_END(111); PB_BEGIN(112);
    if (IN(T0 + 2)) { const auto& a = *args_fresh(); pg8::Gemm g{U, WqT, NTOK, 1024, 1024}; pg8::StaticOrder S; S.init(NTOK, 1024, G, bid); pg8::EpiStoreBf16Rs E{Qb, 1024, SS1, NTOK};
        RPT(112) pg8::gemm_phase<pg8::EpiStoreBf16Rs, pg8::StaticOrder, true, true>(lds, g, S, E); }
    SEAM(T0 + 2);
    PB_END(112); PB_BEGIN(113);
#ifndef SKIP_ATTN
    if (IN(T0 + 3)) { IDS; RPT(113) attn_phase(gw, NGW, lane, Qb, KH, Vt, AO, KMAX2); }
#endif
    SEAM(T0 + 3);
    PB_END(113); PB_BEGIN(114);
#ifndef MK_NOATT
    if (IN(T0 + 4)) { const auto& a = *args_fresh(); pg8::Gemm g{AO, WoT, NTOK, 1024, 1024}; pg8::StaticOrder S; S.init(NTOK, 1024, G, bid); pg8::EpiResNorm E{OUTP, OUTP, U, a.in[24], SS2, 1024, NTOK};
        pg8::gemm_phase<pg8::EpiResNorm, pg8::StaticOrder, true, true>(lds, g, S, E); }
#endif
    SEAM(T0 + 4);
    PB_END(114); PB_BEGIN(116);
    if (IN(T0 + 6)) { const auto& a = *args_fresh(); pg8::Gemm g{U, W13T, NTOK, 2 * DFF, 1024}; pg8::StaticOrder S; S.init(NTOK, 2 * DFF, G, bid); pg8::EpiSwiGLURs E{FF, DFF, SS2, NTOK};
        RPT(116) pg8::gemm_phase<pg8::EpiSwiGLURs, pg8::StaticOrder, true, true>(lds, g, S, E); }
    SEAM(T0 + 6);
    PB_END(116); PB_BEGIN(117);
    if (IN(T0 + 7)) { const auto& a = *args_fresh(); pg8::Gemm g{FF, W2T, NTOK, 1024, DFF}; pg8::StaticOrder S; S.init(NTOK, 1024, G, bid); pg8::EpiResF32 E{OUTP, OUTP, 1024};
        pg8::gemm_phase<pg8::EpiResF32, pg8::StaticOrder, true, true>(lds, g, S, E); }
    SEAM(T0 + 7);
    PB_END(117); PB_BEGIN(118);
    if (IN(T0 + 8)) { IDS;
        const float* gf = a.in[28];
        f32x4 g4[4];
#pragma unroll
        for (int j = 0; j < 4; ++j) g4[j] = ((const f32x4*)gf)[lane + 64 * j];
        for (int g0 = gw * 8; g0 < NTOK; g0 += NGW * 8) {
            f32x4 v[8][4]; float sq[8];
#pragma unroll
            for (int r = 0; r < 8; ++r) { const f32x4* row = (const f32x4*)(OUTP + (size_t)(g0 + r) * 1024);
#pragma unroll
                for (int j = 0; j < 4; ++j) v[r][j] = __builtin_nontemporal_load(row + lane + 64 * j); }
#pragma unroll
            for (int r = 0; r < 8; ++r) { sq[r] = 0.f;
#pragma unroll
                for (int j = 0; j < 4; ++j) sq[r] += (v[r][j][0] * v[r][j][0] + v[r][j][1] * v[r][j][1]) + (v[r][j][2] * v[r][j][2] + v[r][j][3] * v[r][j][3]); }
#pragma unroll
            for (int o = 1; o < 64; o <<= 1) {
#pragma unroll
                for (int r = 0; r < 8; ++r) sq[r] += __shfl_xor(sq[r], o); }
#pragma unroll
            for (int r = 0; r < 8; ++r) { const float rs = 1.0f / sqrtf(sq[r] * (1.0f / 1024.0f) + 1e-6f); f32x4* row = (f32x4*)(OUTP + (size_t)(g0 + r) * 1024);
#pragma unroll
                for (int j = 0; j < 4; ++j) __builtin_nontemporal_store(v[r][j] * rs * g4[j], row + lane + 64 * j); }
        }
    }
#ifdef MK_PROBE
    PB_END(118);
    if (blockIdx.x == 0) { const unsigned long long t1 = __builtin_amdgcn_s_memrealtime(); while (__builtin_amdgcn_s_memrealtime() - t1 < probe_acc) __builtin_amdgcn_s_sleep(8); }
#endif
#undef IN
#undef SEAM
}

#ifndef MK_MULTI
#define MK_MULTI 0
#endif
extern "C" void kernel_launch(void* const* d_in, const int* in_sizes, int n_in, void* d_out, int out_size, void* d_ws, size_t ws_size, hipStream_t stream) {
    static int grid = 0;
    if (grid == 0) {
        if (n_in != 29 || in_sizes[0] != NTOK * D || out_size != NTOK * D || ws_size < WS_END) { fprintf(stderr, "kernel_launch: unexpected shapes / workspace (%d inputs, ws %zu)\n", n_in, ws_size); grid = -1; return; }
        int dev = 0, cus = 0, per_cu = 0;
        hipGetDevice(&dev); hipDeviceGetAttribute(&cus, hipDeviceAttributeMultiprocessorCount, dev);
        hipFuncSetAttribute((const void*)mega, hipFuncAttributeMaxDynamicSharedMemorySize, LDS_BYTES);
        hipOccupancyMaxActiveBlocksPerMultiprocessor(&per_cu, (const void*)mega, 512, LDS_BYTES);
        (void)hipGetLastError();
        if (per_cu < 1) per_cu = 1;
        grid = cus;
    }
    if (grid < 0) return;
    Args a{};
    for (int i = 0; i < 29; ++i) a.in[i] = (const float*)d_in[i];
    a.out = (float*)d_out; a.ws = (unsigned char*)d_ws;
    (void)hipMemsetAsync((char*)d_ws + WS_CTL, 0, CTL_BYTES, stream);
    void* args[] = {&a};
#if MK_MULTI
    for (int ph = 0; ph < N_PHASES; ++ph) { a.ph_lo = ph; a.ph_hi = ph + 1; hipLaunchCooperativeKernel((const void*)mega, dim3(grid), dim3(512), args, LDS_BYTES, stream); }
#else
    a.ph_lo = 0; a.ph_hi = N_PHASES;
    hipError_t e = hipLaunchCooperativeKernel((const void*)mega, dim3(grid), dim3(512), args, LDS_BYTES, stream);
    if (e != hipSuccess) fprintf(stderr, "cooperative launch failed: %s (grid %d)\n", hipGetErrorString(e), grid);
#endif
}
```
